# Optimizing an MI355X kernel written in HIP

```python
import math
import jax, jax.numpy as jnp
from jax import lax
import numpy as np

D_MODEL = 1024
BATCH = 4
SEQ = 4096
DEPTH = 4

N_MIXERS = 3
EPS = 1e-6
CONV_WIDTH = 3
N_HEADS = 16
N_KV_HEADS = 4
HEAD_DIM = D_MODEL // N_HEADS
IDX_HEADS = 8
IDX_DIM = 64
TOPK_MAX = 256
Q_BLOCK = 128
REL_BUCKETS = 32
REL_MAX_DIST = 128
ATTN_IN_SIZES = [N_HEADS * HEAD_DIM, N_KV_HEADS * HEAD_DIM, N_KV_HEADS * HEAD_DIM, IDX_HEADS * IDX_DIM, IDX_DIM, IDX_HEADS]
ATTN_IN_DIM = sum(ATTN_IN_SIZES)
SSM_GROUP = 16
SSM_GROUPS = D_MODEL // SSM_GROUP
SSM_STATE = 64
D_FF = ((8 * D_MODEL // 3 + 127) // 128) * 128
N_EXPERTS = 8
TOP_K_EXPERTS = 2
N_CONV_LAYERS = (DEPTH + 2) // 3
N_ATTN_LAYERS = (DEPTH + 1) // 3
N_SSM_LAYERS = DEPTH // 3
N_DENSE_LAYERS = (DEPTH + 1) // 2
N_MOE_LAYERS = DEPTH // 2

kernel_name = 'hybrid_conv_dsa_s5_moe_trunk'


def rms_norm(x, g):
    x32 = x.astype(jnp.float32)
    y = x32 * lax.rsqrt(jnp.mean(x32 * x32, axis=-1, keepdims=True) + EPS)
    return (y * g.astype(jnp.float32)).astype(x.dtype)


def modulate(h, shift, scale):
    return h * (1 + scale[:, None, :]) + shift[:, None, :]


def short_conv_mixer(h, w_in, w_conv, w_out):
    b_gate, c_gate, v = jnp.split(h @ w_in, 3, axis=-1)
    u = c_gate * v
    conv = lax.conv_general_dilated(
        u, w_conv[:, None, :], window_strides=(1,), padding=[(CONV_WIDTH - 1, 0)],
        dimension_numbers=('NWC', 'WIO', 'NWC'), feature_group_count=u.shape[-1])
    return (b_gate * conv) @ w_out


def rel_bucket(dist):
    max_exact = REL_BUCKETS // 2
    d = jnp.maximum(dist, 1).astype(jnp.float32)
    large = max_exact + (jnp.log(d / max_exact) / math.log(REL_MAX_DIST / max_exact)
                         * (REL_BUCKETS - max_exact)).astype(jnp.int32)
    large = jnp.minimum(large, REL_BUCKETS - 1)
    return jnp.where(dist < max_exact, dist, large)


def dsa_attention(h, w_in, q_gain, k_gain, w_out, rel_bias):
    bsz, seq_len, _ = h.shape
    f32 = jnp.float32
    top_k = min(TOPK_MAX, seq_len // 4)
    n_rep = N_HEADS // N_KV_HEADS
    splits = [int(s) for s in np.cumsum(ATTN_IN_SIZES)[:-1]]
    q, k, v, qi, ki, wi = jnp.split(h @ w_in, splits, axis=-1)
    q = rms_norm(q.reshape(bsz, seq_len, N_KV_HEADS, n_rep, HEAD_DIM), q_gain)
    k = rms_norm(k.reshape(bsz, seq_len, N_KV_HEADS, HEAD_DIM), k_gain)
    v = v.reshape(bsz, seq_len, N_KV_HEADS, HEAD_DIM)
    qi = qi.reshape(bsz, seq_len, IDX_HEADS, IDX_DIM)
    wi = wi * (IDX_HEADS ** -0.5 * IDX_DIM ** -0.5)
    key_pos = jnp.arange(seq_len)
    gather = jax.vmap(lambda arr, idx: arr[idx])
    bias_table = rel_bias.astype(f32)

    def block(start):
        qpos = start + jnp.arange(Q_BLOCK)
        qb = lax.dynamic_slice_in_dim(q, start, Q_BLOCK, axis=1)
        qib = lax.dynamic_slice_in_dim(qi, start, Q_BLOCK, axis=1)
        wib = lax.dynamic_slice_in_dim(wi, start, Q_BLOCK, axis=1)
        dots = jax.nn.relu(jnp.einsum('bthd,bsd->bths', qib, ki).astype(f32))
        score = jnp.einsum('bths,bth->bts', dots, wib.astype(f32))
        score = jnp.where(key_pos[None, None, :] <= qpos[None, :, None], score, -jnp.inf)
        _, sel = lax.top_k(score, top_k)
        valid = sel <= qpos[None, :, None]
        kg = gather(k, sel)
        vg = gather(v, sel)
        logits = jnp.einsum('btngd,btknd->btngk', qb, kg).astype(f32) * (HEAD_DIM ** -0.5)
        bias = bias_table[rel_bucket(jnp.maximum(qpos[None, :, None] - sel, 0))]
        bias = bias.reshape(bsz, Q_BLOCK, top_k, N_KV_HEADS, n_rep).transpose(0, 1, 3, 4, 2)
        logits = jnp.where(valid[:, :, None, None, :], logits + bias, -jnp.inf)
        p = jax.nn.softmax(logits, axis=-1).astype(v.dtype)
        o = jnp.einsum('btngk,btknd->btngd', p, vg)
        return o.reshape(bsz, Q_BLOCK, N_HEADS * HEAD_DIM)

    starts = jnp.arange(seq_len // Q_BLOCK, dtype=jnp.int32) * Q_BLOCK
    out = lax.map(block, starts)
    out = out.transpose(1, 0, 2, 3).reshape(bsz, seq_len, N_HEADS * HEAD_DIM)
    return out @ w_out


def s5_mixer(h, lam_re, lam_im, log_step, b_re, b_im, c_re, c_im, d_skip, w_glu):
    bsz, seq_len, _ = h.shape
    f32 = jnp.float32
    lam = lax.complex(jnp.minimum(lam_re.astype(f32), -1e-4), lam_im.astype(f32))
    step = jnp.exp(log_step.astype(f32))[:, None]
    lam_bar = jnp.exp(lam * step)
    b_bar = ((lam_bar - 1.0) / lam)[..., None] * lax.complex(b_re.astype(f32), b_im.astype(f32))
    c_mat = lax.complex(c_re.astype(f32), c_im.astype(f32))
    u = h.astype(f32).reshape(bsz, seq_len, SSM_GROUPS, SSM_GROUP)
    bu = jnp.einsum('blgc,gpc->blgp', u.astype(jnp.complex64), b_bar)
    a = jnp.broadcast_to(lam_bar, (1, seq_len, SSM_GROUPS, SSM_STATE))

    def combine(left, right):
        a_l, b_l = left
        a_r, b_r = right
        return a_r * a_l, a_r * b_l + b_r

    _, states = lax.associative_scan(combine, (a, bu), axis=1)
    y = jnp.einsum('blgp,gcp->blgc', states, c_mat).real.reshape(bsz, seq_len, D_MODEL)
    y = y + d_skip.astype(f32) * h.astype(f32)
    g = jax.nn.gelu(y).astype(h.dtype)
    lin, gate = jnp.split(g @ w_glu, 2, axis=-1)
    return lin * jax.nn.sigmoid(gate)


def swiglu(h, w_gu, w_down):
    g, u = jnp.split(h @ w_gu, 2, axis=-1)
    return (jax.nn.silu(g) * u) @ w_down


def moe_swiglu(h, router_w, router_b, w_gu, w_down):
    bsz, seq_len, d = h.shape
    f32 = jnp.float32
    t = h.reshape(-1, d)
    logits = t.astype(f32) @ router_w.astype(f32) + router_b.astype(f32)
    probs = jax.nn.softmax(logits, axis=-1)
    top_p, top_i = lax.top_k(probs, TOP_K_EXPERTS)
    top_p = top_p / jnp.sum(top_p, axis=-1, keepdims=True)
    gates = jnp.sum(jax.nn.one_hot(top_i, N_EXPERTS, dtype=f32) * top_p[..., None], axis=1)
    out = jnp.zeros_like(t)
    for e in range(N_EXPERTS):
        out = out + gates[:, e:e + 1].astype(t.dtype) * swiglu(t, w_gu[e], w_down[e])
    return out.reshape(bsz, seq_len, d)


def setup_inputs(seed: int = 0) -> dict:
    key = jax.random.key(seed)
    ks = jax.random.split(key, 32)
    f32 = jnp.float32

    def nrm(k, shape, scale):
        return jax.random.normal(k, shape, f32) * scale

    n_idx = jnp.arange(SSM_STATE, dtype=f32)
    return {
        'x': nrm(ks[0], (BATCH, SEQ, D_MODEL), 1.0),
        'c': nrm(ks[1], (BATCH, D_MODEL), 1.0),
        'ada_w': nrm(ks[2], (DEPTH, D_MODEL, 6 * D_MODEL), 0.5 * D_MODEL ** -0.5),
        'ada_b': nrm(ks[3], (DEPTH, 6 * D_MODEL), 0.02),
        'norm_g': 1.0 + nrm(ks[4], (DEPTH, 2, D_MODEL), 0.02),
        'conv_w_in': nrm(ks[5], (N_CONV_LAYERS, D_MODEL, 3 * D_MODEL), D_MODEL ** -0.5),
        'conv_w': nrm(ks[6], (N_CONV_LAYERS, CONV_WIDTH, D_MODEL), CONV_WIDTH ** -0.5),
        'conv_w_out': nrm(ks[7], (N_CONV_LAYERS, D_MODEL, D_MODEL), D_MODEL ** -0.5),
        'attn_w_in': nrm(ks[8], (N_ATTN_LAYERS, D_MODEL, ATTN_IN_DIM), D_MODEL ** -0.5),
        'attn_q_gain': 1.0 + nrm(ks[9], (N_ATTN_LAYERS, HEAD_DIM), 0.02),
        'attn_k_gain': 1.0 + nrm(ks[10], (N_ATTN_LAYERS, HEAD_DIM), 0.02),
        'attn_w_out': nrm(ks[11], (N_ATTN_LAYERS, N_HEADS * HEAD_DIM, D_MODEL), (N_HEADS * HEAD_DIM) ** -0.5),
        'rel_bias': nrm(ks[12], (REL_BUCKETS, N_HEADS), 0.5),
        'ssm_lambda_re': -0.5 + nrm(ks[13], (N_SSM_LAYERS, SSM_GROUPS, SSM_STATE), 0.01),
        'ssm_lambda_im': math.pi * n_idx + nrm(ks[14], (N_SSM_LAYERS, SSM_GROUPS, SSM_STATE), 0.01),
        'ssm_log_step': jax.random.uniform(ks[15], (N_SSM_LAYERS, SSM_GROUPS), f32, math.log(1e-3), math.log(1e-1)),
        'ssm_b_re': nrm(ks[16], (N_SSM_LAYERS, SSM_GROUPS, SSM_STATE, SSM_GROUP), SSM_GROUP ** -0.5),
        'ssm_b_im': nrm(ks[17], (N_SSM_LAYERS, SSM_GROUPS, SSM_STATE, SSM_GROUP), SSM_GROUP ** -0.5),
        'ssm_c_re': nrm(ks[18], (N_SSM_LAYERS, SSM_GROUPS, SSM_GROUP, SSM_STATE), SSM_STATE ** -0.5),
        'ssm_c_im': nrm(ks[19], (N_SSM_LAYERS, SSM_GROUPS, SSM_GROUP, SSM_STATE), SSM_STATE ** -0.5),
        'ssm_d': nrm(ks[20], (N_SSM_LAYERS, D_MODEL), 1.0),
        'ssm_w_glu': nrm(ks[21], (N_SSM_LAYERS, D_MODEL, 2 * D_MODEL), D_MODEL ** -0.5),
        'ffn_w_gu': nrm(ks[22], (N_DENSE_LAYERS, D_MODEL, 2 * D_FF), D_MODEL ** -0.5),
        'ffn_w_down': nrm(ks[23], (N_DENSE_LAYERS, D_FF, D_MODEL), D_FF ** -0.5),
        'moe_router_w': nrm(ks[24], (N_MOE_LAYERS, D_MODEL, N_EXPERTS), D_MODEL ** -0.5),
        'moe_router_b': nrm(ks[25], (N_MOE_LAYERS, N_EXPERTS), 0.01),
        'moe_w_gu': nrm(ks[26], (N_MOE_LAYERS, N_EXPERTS, D_MODEL, 2 * D_FF), D_MODEL ** -0.5),
        'moe_w_down': nrm(ks[27], (N_MOE_LAYERS, N_EXPERTS, D_FF, D_MODEL), D_FF ** -0.5),
    }


def reference(x, c, ada_w, ada_b, norm_g, conv_w_in, conv_w, conv_w_out, attn_w_in, attn_q_gain,
              attn_k_gain, attn_w_out, rel_bias, ssm_lambda_re, ssm_lambda_im, ssm_log_step, ssm_b_re,
              ssm_b_im, ssm_c_re, ssm_c_im, ssm_d, ssm_w_glu, ffn_w_gu, ffn_w_down, moe_router_w,
              moe_router_b, moe_w_gu, moe_w_down):
    cond = jax.nn.silu(c)
    for i in range(DEPTH):
        mod = cond @ ada_w[i] + ada_b[i]
        sh1, sc1, g1, sh2, sc2, g2 = jnp.split(mod, 6, axis=-1)
        h = modulate(rms_norm(x, norm_g[i, 0]), sh1, sc1)
        j = i // N_MIXERS
        if i % N_MIXERS == 0:
            y = short_conv_mixer(h, conv_w_in[j], conv_w[j], conv_w_out[j])
        elif i % N_MIXERS == 1:
            y = dsa_attention(h, attn_w_in[j], attn_q_gain[j], attn_k_gain[j], attn_w_out[j], rel_bias)
        else:
            y = s5_mixer(h, ssm_lambda_re[j], ssm_lambda_im[j], ssm_log_step[j], ssm_b_re[j], ssm_b_im[j],
                         ssm_c_re[j], ssm_c_im[j], ssm_d[j], ssm_w_glu[j])
        x = x + g1[:, None, :] * y
        h = modulate(rms_norm(x, norm_g[i, 1]), sh2, sc2)
        if i % 2 == 0:
            y = swiglu(h, ffn_w_gu[i // 2], ffn_w_down[i // 2])
        else:
            y = moe_swiglu(h, moe_router_w[i // 2], moe_router_b[i // 2], moe_w_gu[i // 2], moe_w_down[i // 2])
        x = x + g2[:, None, :] * y
    return x
```

```cpp
#include <hip/hip_runtime.h>
#include <cstdio>
#include <cstdint>
#include <cmath>

#ifndef MK_PER_PHASE
#define MK_PER_PHASE 0
#endif

#define GAS __attribute__((address_space(1)))
#define LAS __attribute__((address_space(3)))
typedef unsigned short bf16_t;
typedef short bf16x8 __attribute__((ext_vector_type(8)));
typedef float f32x4 __attribute__((ext_vector_type(4)));
typedef float f32x2 __attribute__((ext_vector_type(2)));
typedef float f32x16 __attribute__((ext_vector_type(16)));
typedef unsigned u32x4 __attribute__((ext_vector_type(4)));
typedef unsigned u32x2 __attribute__((ext_vector_type(2)));
typedef GAS unsigned gu32;
#define RLX_AGENT __ATOMIC_RELAXED, __HIP_MEMORY_SCOPE_AGENT
#define LDS_WAIT() asm volatile("s_waitcnt lgkmcnt(0)" ::: "memory")
#define VM_WAIT() asm volatile("s_waitcnt vmcnt(0)" ::: "memory")
#define CFENCE() asm volatile("" ::: "memory")

constexpr int DM = 1024, NB = 4, SEQ = 4096, M = NB * SEQ, FF = 2816, NEXP = 8;
constexpr int NH = 16, NKV = 4, HD = 64, IH = 8, IDIM = 64, TOPK = 256;
constexpr int ATT_N = 2120, ATT_NP = 2304;
constexpr float EPS = 1e-6f;
constexpr int NWAVES = 8, NTHREADS = 512;

__device__ __forceinline__ unsigned f2bf(float f) { unsigned u = __builtin_bit_cast(unsigned, f); return (u + 0x7fffu + ((u >> 16) & 1u)) >> 16; }
__device__ __forceinline__ unsigned pk2(float lo, float hi) { return f2bf(lo) | (f2bf(hi) << 16); }
__device__ __forceinline__ unsigned cvt_pk_bf16(float lo, float hi) { unsigned r; asm volatile("v_cvt_pk_bf16_f32 %0, %1, %2" : "=v"(r) : "v"(lo), "v"(hi)); return r; }
__device__ __forceinline__ float bflo(unsigned u) { return __uint_as_float(u << 16); }
__device__ __forceinline__ float bfhi(unsigned u) { return __uint_as_float(u & 0xffff0000u); }
__device__ __forceinline__ float wave_sum(float v) {
#pragma unroll
    for (int o = 1; o < 64; o <<= 1) v += __shfl_xor(v, o);
    return v;
}
__device__ __forceinline__ float fast_rcp(float x) { return __builtin_amdgcn_rcpf(x); }
__device__ __forceinline__ float silu_f(float g) { return g * fast_rcp(1.f + __expf(-g)); }
__device__ __forceinline__ float sigmoid_f(float g) { return fast_rcp(1.f + __expf(-g)); }
__device__ __forceinline__ float gelu_tanh_f(float y) { const float z = 0.7978845608028654f * (y + 0.044715f * y * y * y); const float t = 1.f - 2.f * fast_rcp(__expf(2.f * z) + 1.f); return 0.5f * y * (1.f + t); }

constexpr size_t WS_ROWIDX_B = 2u << 20, WS_GATEP_B = (2u << 20) + 512 * 1024, WS_SLOT_B = 3u << 20;
namespace pg8 {
constexpr int BM = 256, BK = 64, HALF = 128, HTB = HALF * BK * 2, STAGE_BYTES = 8 * HTB, NXCD = 8, WGM = 8;
__host__ __device__ __forceinline__ int lds_byte(int r, int c) { const int st = (r >> 4) * 2 + (c >> 5), rr = r & 15, cc = c & 31, ob = rr * 64 + cc * 2; return st * 1024 + (ob ^ (((ob >> 9) & 1) << 5)); }
__host__ __device__ __forceinline__ void stage_rc(int b, int& R, int& C) { const int st = b / 1024, sb = b % 1024, swz = sb ^ (((sb >> 9) & 1) << 5); R = (st >> 1) * 16 + swz / 64; C = (st & 1) * 32 + (swz % 64) / 2; }
__host__ __device__ __forceinline__ int perm32(int rho) { const int n = rho >> 4, i = rho & 15; return 8 * (i >> 2) + 4 * n + (i & 3); }

struct Unit { int pm, pn, e, aux; };
struct Gemm { const bf16_t* A; const bf16_t* Bt; int M, N, K; size_t bstride_e; const int* rowidx; const unsigned* cnt; };

struct StaticOrder {
    int nM, nN, nwg, G, c;
    __device__ __forceinline__ void init(int M_, int N_, int G_, int c_) { nM = M_ / BM; nN = N_ / BM; nwg = nM * nN; G = G_; c = c_; }
    __device__ __forceinline__ bool next(int i, Unit& u) const {
        const long L = (long)i * G + c; if (L >= nwg) return false;
        int wgid = (int)L; { const int q = nwg / NXCD, r = nwg % NXCD, xcd = wgid % NXCD, off = wgid / NXCD; wgid = (xcd < r ? xcd * (q + 1) : r * (q + 1) + (xcd - r) * q) + off; }
        const int nig = WGM * nN, gid = wgid / nig, fm = gid * WGM, gsz = (nM - fm) < WGM ? (nM - fm) : WGM;
        u.pm = fm + ((wgid % nig) % gsz); u.pn = (wgid % nig) / gsz; u.e = 0; u.aux = 0; return true;
    }
};
struct MoeOrder {
    int T1, T2, T3, T4, T5, T6, T7, T8, NT, W, r, lo, ntl;
    static constexpr int RG = 4;
    __device__ __forceinline__ void init(const unsigned* cnt, int NT_, int G_, int c_) {
        int t[9]; int acc = 0;
#pragma unroll
        for (int e = 0; e < 8; ++e) { t[e] = acc; acc += (int)((__hip_atomic_load(cnt + 64 * e, RLX_AGENT) + 255u) >> 8); }
        t[8] = acc; T1 = t[1]; T2 = t[2]; T3 = t[3]; T4 = t[4]; T5 = t[5]; T6 = t[6]; T7 = t[7]; T8 = t[8]; NT = NT_;
        if (G_ % 8 == 0) { const int xv = c_ % 8; W = G_ / 8; r = c_ / 8; lo = (T8 * xv) / 8; ntl = (T8 * (xv + 1)) / 8 - lo; }
        else { W = G_; r = c_; lo = 0; ntl = T8; }
    }
    __device__ __forceinline__ bool next(int i, Unit& u) const {
        const int q = i * W + r; if (q >= ntl * NT) return false;
        const int nig = RG * NT, gid = q / nig, fm = gid * RG, gsz = (ntl - fm) < RG ? (ntl - fm) : RG, w = q - gid * nig;
        const int tt = lo + fm + (w % gsz), pn = w / gsz;
        int e = 0, te = 0;
        if (tt >= T1) { e = 1; te = T1; } if (tt >= T2) { e = 2; te = T2; } if (tt >= T3) { e = 3; te = T3; } if (tt >= T4) { e = 4; te = T4; }
        if (tt >= T5) { e = 5; te = T5; } if (tt >= T6) { e = 6; te = T6; } if (tt >= T7) { e = 7; te = T7; }
        u.pm = tt; u.pn = pn; u.e = e; u.aux = e * 16384 + 256 * (tt - te); return true;
    }
};

template <class Epi, class Sched, bool GATHER>
__device__ __forceinline__ void gemm_phase(LAS unsigned char* lds, const Gemm g, const Sched& S, const Epi& E) {
    const int tid = threadIdx.x, wid = __builtin_amdgcn_readfirstlane(tid >> 6), lane = tid & 63, wr = wid >> 2, wc = wid & 3, fr = lane & 15, fq = lane >> 4;
    const int K = g.K, nt = K / BK;
    unsigned voffB[2]; int stR[2], stC[2];
#pragma unroll
    for (int i = 0; i < 2; ++i) { int R, C; stage_rc(tid * 16 + i * 8192, R, C); const int Rb = (R & ~31) + perm32(R & 31);
        stR[i] = R; stC[i] = C; voffB[i] = (unsigned)(Rb * K + C) * 2u; }
    const size_t kstep = (size_t)(BK * 2);
    const size_t hstep = (size_t)HALF * K * 2;
    const size_t tstep = 2 * hstep;
    const unsigned ldsw = (unsigned)wid * 1024u;
    const int aoff = lds_byte(wr * 64 + fr, fq * 8), boff = lds_byte(wc * 32 + fr, fq * 8);
#define PG8_SA(b, h) (((b) * 2 + (h)) * HTB)
#define PG8_SB(b, h) ((4 + (b) * 2 + (h)) * HTB)
#define PG8_STAGE(bufoff, gbase, voff) do { _Pragma("unroll") for (int _i = 0; _i < 2; ++_i) \
        __builtin_amdgcn_global_load_lds((const unsigned*)((const char*)(gbase) + (voff)[_i]), (LAS unsigned*)(lds + (bufoff) + ldsw + _i * 8192), 16, 0, 0); } while (0)
#define PG8_LDA(dst, b, h) do { _Pragma("unroll") for (int m = 0; m < 4; ++m) _Pragma("unroll") for (int k = 0; k < 2; ++k) dst[m][k] = *(const LAS bf16x8*)(lds + PG8_SA(b, h) + aoff + m * 2048 + k * 1024); } while (0)
#define PG8_LDB(dst, b, h) do { _Pragma("unroll") for (int n = 0; n < 2; ++n) _Pragma("unroll") for (int k = 0; k < 2; ++k) dst[n][k] = *(const LAS bf16x8*)(lds + PG8_SB(b, h) + boff + n * 2048 + k * 1024); } while (0)
#define PG8_MMA(ai, bj, At, Bt) do { __builtin_amdgcn_s_setprio(1); _Pragma("unroll") for (int m = 0; m < 4; ++m) _Pragma("unroll") for (int n = 0; n < 2; ++n) _Pragma("unroll") for (int k = 0; k < 2; ++k) \
        acc[ai][bj][m][n] = __builtin_amdgcn_mfma_f32_16x16x32_bf16(Bt[n][k], At[m][k], acc[ai][bj][m][n], 0, 0, 0); __builtin_amdgcn_s_setprio(0); } while (0)
#define PG8_WAIT_V(n) asm volatile("s_waitcnt vmcnt(" #n ")" ::: "memory")
#define PG8_WAIT_L(n) asm volatile("s_waitcnt lgkmcnt(" #n ")" ::: "memory")
#define PG8_BAR __builtin_amdgcn_s_barrier()
#define PG8_SCHED __builtin_amdgcn_sched_barrier(0)
#define PG8_AOFFS(v, U) do { _Pragma("unroll") for (int _h = 0; _h < 2; ++_h) _Pragma("unroll") for (int _i = 0; _i < 2; ++_i) { \
        if (GATHER) { const int _loc = ((U).aux & 16383) + _h * HALF + stR[_i]; const int _e = (U).aux >> 14; \
            const int _row = (_loc < (int)g.cnt[64 * _e]) ? g.rowidx[(U).aux + _h * HALF + stR[_i]] : 0; \
            v[_h][_i] = (unsigned)(_row * K + stC[_i]) * 2u; } \
        else v[_h][_i] = (unsigned)((_h * HALF + stR[_i]) * K + stC[_i]) * 2u; } } while (0)
    int cn8[8];
#pragma unroll
    for (int e = 0; e < 8; ++e) cn8[e] = GATHER ? __builtin_amdgcn_readfirstlane((int)g.cnt[64 * e]) : 0;
    Unit cur, nxt; int ui = 0;
    if (!S.next(0, cur)) return;
    f32x4 acc[2][2][4][2];
#pragma unroll
    for (int a = 0; a < 2; ++a)
#pragma unroll
        for (int b = 0; b < 2; ++b)
#pragma unroll
            for (int m = 0; m < 4; ++m)
#pragma unroll
                for (int n = 0; n < 2; ++n) acc[a][b][m][n] = (f32x4){0.f, 0.f, 0.f, 0.f};
    bf16x8 At[4][2], B0[2][2], B1[2][2];
    unsigned vAc[2][2], vAn[2][2];
    PG8_AOFFS(vAc, cur);
    const char* cA = (const char*)g.A + (GATHER ? (size_t)0 : (size_t)cur.pm * tstep);
    const char* cB = (const char*)g.Bt + (size_t)cur.e * g.bstride_e + (size_t)cur.pn * tstep;
    PG8_STAGE(PG8_SB(0, 0), cB, voffB); PG8_STAGE(PG8_SB(0, 1), cB + hstep, voffB); PG8_STAGE(PG8_SA(0, 0), cA, vAc[0]); PG8_STAGE(PG8_SA(0, 1), cA, vAc[1]);
    if (wr == 1) PG8_BAR;
    PG8_WAIT_V(2); PG8_BAR;
    PG8_STAGE(PG8_SB(1, 0), cB + kstep, voffB); PG8_STAGE(PG8_SA(1, 0), cA + kstep, vAc[0]); PG8_STAGE(PG8_SB(1, 1), cB + hstep + kstep, voffB);
    PG8_WAIT_V(6); PG8_BAR;
    for (;;) {
        const bool has_next = S.next(ui + 1, nxt);
        const char* nA = cA; const char* nB = cB;
        int rn[2][2];
        if (has_next) { if (GATHER) {
#pragma unroll
                for (int h = 0; h < 2; ++h)
#pragma unroll
                    for (int i = 0; i < 2; ++i) rn[h][i] = g.rowidx[nxt.aux + h * HALF + stR[i]]; }
            else PG8_AOFFS(vAn, nxt);
            nA = (const char*)g.A + (GATHER ? (size_t)0 : (size_t)nxt.pm * tstep); nB = (const char*)g.Bt + (size_t)nxt.e * g.bstride_e + (size_t)nxt.pn * tstep; }
        else {
#pragma unroll
            for (int h = 0; h < 2; ++h)
#pragma unroll
                for (int i = 0; i < 2; ++i) vAn[h][i] = vAc[h][i];
        }
        for (int t = 0; t < nt; t += 2) {
            const bool last = (t == nt - 2);
            const char* a1 = cA + (size_t)(t + 1) * kstep;
            const char* a2 = last ? nA : cA + (size_t)(t + 2) * kstep; const char* b2 = last ? nB : cB + (size_t)(t + 2) * kstep;
            const char* a3 = a2 + kstep; const char* b3 = b2 + kstep;
            if (GATHER && last && has_next) { const int _e = nxt.aux >> 14;
                const int _cn = _e == 0 ? cn8[0] : _e == 1 ? cn8[1] : _e == 2 ? cn8[2] : _e == 3 ? cn8[3] : _e == 4 ? cn8[4] : _e == 5 ? cn8[5] : _e == 6 ? cn8[6] : cn8[7];
#pragma unroll
                for (int h = 0; h < 2; ++h)
#pragma unroll
                    for (int i = 0; i < 2; ++i) { int r_ = rn[h][i]; asm volatile("" : "+v"(r_)); const int _loc = (nxt.aux & 16383) + h * HALF + stR[i];
                        r_ = _loc < _cn ? r_ : 0; vAn[h][i] = (unsigned)(r_ * K + stC[i]) * 2u; } }
            unsigned v2[2][2];
#pragma unroll
            for (int h = 0; h < 2; ++h)
#pragma unroll
                for (int i = 0; i < 2; ++i) v2[h][i] = last ? vAn[h][i] : vAc[h][i];
            PG8_LDB(B0, 0, 0); PG8_LDB(B1, 0, 1); PG8_SCHED; PG8_LDA(At, 0, 0); PG8_STAGE(PG8_SA(1, 1), a1, vAc[1]);
            PG8_WAIT_V(8); PG8_WAIT_L(0); PG8_BAR; PG8_MMA(0, 0, At, B0); PG8_MMA(0, 1, At, B1); PG8_BAR; PG8_SCHED;
            PG8_LDA(At, 0, 1); PG8_STAGE(PG8_SB(0, 0), b2, voffB); PG8_STAGE(PG8_SB(0, 1), b2 + hstep, voffB); PG8_STAGE(PG8_SA(0, 0), a2, v2[0]);
            PG8_WAIT_V(8); PG8_WAIT_L(0); PG8_BAR; PG8_MMA(1, 0, At, B0); PG8_MMA(1, 1, At, B1); PG8_BAR; PG8_SCHED;
            PG8_LDB(B0, 1, 0); PG8_LDB(B1, 1, 1); PG8_SCHED; PG8_LDA(At, 1, 0); PG8_STAGE(PG8_SA(0, 1), a2, v2[1]);
            PG8_WAIT_V(8); PG8_WAIT_L(0); PG8_BAR; PG8_MMA(0, 0, At, B0); PG8_MMA(0, 1, At, B1); PG8_BAR; PG8_SCHED;
            PG8_LDA(At, 1, 1); PG8_STAGE(PG8_SB(1, 0), b3, voffB); PG8_STAGE(PG8_SB(1, 1), b3 + hstep, voffB); PG8_STAGE(PG8_SA(1, 0), a3, v2[0]);
            PG8_WAIT_V(8); PG8_WAIT_L(0); PG8_BAR; PG8_MMA(1, 0, At, B0); PG8_MMA(1, 1, At, B1); PG8_BAR; PG8_SCHED;
        }
        if (wr == 0) PG8_BAR;
        if constexpr (!Epi::FUSED) E(acc, cur, wr, wc, fr, fq);
        if (!has_next) break;
#pragma unroll
        for (int a = 0; a < 2; ++a)
#pragma unroll
            for (int b = 0; b < 2; ++b)
#pragma unroll
                for (int m = 0; m < 4; ++m)
#pragma unroll
                    for (int n = 0; n < 2; ++n) acc[a][b][m][n] = (f32x4){0.f, 0.f, 0.f, 0.f};
        cur = nxt; cA = nA; cB = nB; ++ui;
#pragma unroll
        for (int h = 0; h < 2; ++h)
#pragma unroll
            for (int i = 0; i < 2; ++i) vAc[h][i] = vAn[h][i];
        if (wr == 1) PG8_BAR;
    }
    PG8_WAIT_V(0);
    PG8_BAR;
    if constexpr (Epi::FUSED) E.fused(acc, cur, wr, wc, fr, fq, lds, wid, lane);
#undef PG8_SA
#undef PG8_SB
#undef PG8_STAGE
#undef PG8_LDA
#undef PG8_LDB
#undef PG8_MMA
#undef PG8_WAIT_V
#undef PG8_WAIT_L
#undef PG8_BAR
#undef PG8_SCHED
#undef PG8_AOFFS
}

__device__ __forceinline__ f32x4 ldx16(const float* p) { const GAS unsigned long long* q = (const GAS unsigned long long*)p; const unsigned long long a = __hip_atomic_load(q, RLX_AGENT), c = __hip_atomic_load(q + 1, RLX_AGENT);
    return (f32x4){__uint_as_float((unsigned)a), __uint_as_float((unsigned)(a >> 32)), __uint_as_float((unsigned)c), __uint_as_float((unsigned)(c >> 32))}; }
typedef f32x4 Acc[2][2][4][2];
__device__ __forceinline__ u32x4 pack8(const f32x4 a, const f32x4 b) { u32x4 w; w.x = cvt_pk_bf16(a[0], a[1]); w.y = cvt_pk_bf16(a[2], a[3]); w.z = cvt_pk_bf16(b[0], b[1]); w.w = cvt_pk_bf16(b[2], b[3]); return w; }

template <int MODE> struct EpiPair {
    static constexpr bool FUSED = false;
    bf16_t* O; int ldo;
    __device__ __forceinline__ void operator()(const Acc& acc, const Unit& u, int wr, int wc, int fr, int fq) const {
        const int row0 = u.pm * BM + wr * 64 + fr, col0 = u.pn * HALF + wc * 32 + 8 * fq;
#pragma unroll
        for (int ai = 0; ai < 2; ++ai)
#pragma unroll
            for (int m = 0; m < 4; ++m) { f32x4 r0, r1;
#pragma unroll
                for (int e = 0; e < 4; ++e) { const float a0 = acc[ai][0][m][0][e], a1 = acc[ai][0][m][1][e], b0 = acc[ai][1][m][0][e], b1 = acc[ai][1][m][1][e];
                    r0[e] = (MODE == 1 ? silu_f(a0) : a0) * b0; r1[e] = (MODE == 1 ? silu_f(a1) : a1) * b1; }
                *(u32x4*)(O + (size_t)(row0 + ai * HALF + m * 16) * ldo + col0) = pack8(r0, r1); }
    }
};
struct EpiConvIn {
    static constexpr bool FUSED = false;
    bf16_t* UB;
    __device__ __forceinline__ void operator()(const Acc& acc, const Unit& u, int wr, int wc, int fr, int fq) const {
        const int row0 = u.pm * BM + wr * 64 + fr;
        if (u.pn < 8) { EpiPair<0> P{UB, 2048}; P(acc, u, wr, wc, fr, fq); }
        else { const int col0 = 1024 + (u.pn - 8) * BM + wc * 32 + 8 * fq;
#pragma unroll
            for (int ai = 0; ai < 2; ++ai)
#pragma unroll
                for (int m = 0; m < 4; ++m)
#pragma unroll
                    for (int bj = 0; bj < 2; ++bj) *(u32x4*)(UB + (size_t)(row0 + ai * HALF + m * 16) * 2048 + col0 + bj * HALF) = pack8(acc[ai][bj][m][0], acc[ai][bj][m][1]); }
    }
};
struct EpiRes {
    static constexpr bool FUSED = false;
    float* X; const float* gate; const float* Xin;
    __device__ __forceinline__ void operator()(const Acc& acc, const Unit& u, int wr, int wc, int fr, int fq) const {
        const int row0 = u.pm * BM + wr * 64 + fr, col0 = u.pn * BM + wc * 32 + 8 * fq; const int b = (u.pm * BM) / SEQ;
        f32x4 gv[2][2];
#pragma unroll
        for (int bj = 0; bj < 2; ++bj)
#pragma unroll
            for (int n = 0; n < 2; ++n) gv[bj][n] = *(const f32x4*)(gate + (size_t)b * 6144 + col0 + bj * HALF + 4 * n);
#pragma unroll
        for (int ai = 0; ai < 2; ++ai) {
            f32x4 xv[4][2][2];
#pragma unroll
            for (int m = 0; m < 4; ++m) { const float* ri = Xin + (size_t)(row0 + ai * HALF + m * 16) * DM + col0;
#pragma unroll
                for (int bj = 0; bj < 2; ++bj)
#pragma unroll
                    for (int n = 0; n < 2; ++n) xv[m][bj][n] = ldx16(ri + bj * HALF + 4 * n); }
            asm volatile("" ::: "memory");
#pragma unroll
            for (int m = 0; m < 4; ++m) { float* rp = X + (size_t)(row0 + ai * HALF + m * 16) * DM + col0;
#pragma unroll
                for (int bj = 0; bj < 2; ++bj)
#pragma unroll
                    for (int n = 0; n < 2; ++n) *(f32x4*)(rp + bj * HALF + 4 * n) = xv[m][bj][n] + gv[bj][n] * acc[ai][bj][m][n]; }
            asm volatile("" ::: "memory");
        }
    }
};
struct EpiResNorm {
    static constexpr bool FUSED = true;
    float* X; const float* gate; const float* Xin; const float* ng; const float* shb; bf16_t* H; float* xs; gu32* cnt; gu32* tmo;
    __device__ __forceinline__ void fused(Acc& acc, const Unit& u, int wr, int wc, int fr, int fq, LAS unsigned char* lds, int wid, int lane) const {
        const int row0 = u.pm * BM + wr * 64 + fr, col0 = u.pn * BM + wc * 32 + 8 * fq; const int b = (u.pm * BM) / SEQ;
        LAS float* P = (LAS float*)lds; LAS float* S = (LAS float*)(lds + 4096);
        { f32x4 gv[2][2];
#pragma unroll
          for (int bj = 0; bj < 2; ++bj)
#pragma unroll
              for (int n = 0; n < 2; ++n) gv[bj][n] = *(const f32x4*)(gate + (size_t)b * 6144 + col0 + bj * HALF + 4 * n);
#pragma unroll
          for (int ai = 0; ai < 2; ++ai) {
              f32x4 xv[4][2][2];
#pragma unroll
              for (int m = 0; m < 4; ++m) { const float* ri = Xin + (size_t)(row0 + ai * HALF + m * 16) * DM + col0;
#pragma unroll
                  for (int bj = 0; bj < 2; ++bj)
#pragma unroll
                      for (int n = 0; n < 2; ++n) xv[m][bj][n] = ldx16(ri + bj * HALF + 4 * n); }
              asm volatile("" ::: "memory");
#pragma unroll
              for (int m = 0; m < 4; ++m) { float* rp = X + (size_t)(row0 + ai * HALF + m * 16) * DM + col0; float ss = 0.f;
#pragma unroll
                  for (int bj = 0; bj < 2; ++bj)
#pragma unroll
                      for (int n = 0; n < 2; ++n) { const f32x4 x = xv[m][bj][n] + gv[bj][n] * acc[ai][bj][m][n]; acc[ai][bj][m][n] = x; *(f32x4*)(rp + bj * HALF + 4 * n) = x;
                          ss += (x[0] * x[0] + x[1] * x[1]) + (x[2] * x[2] + x[3] * x[3]); }
                  ss += __shfl_xor(ss, 16); ss += __shfl_xor(ss, 32);
                  if (fq == 0) P[(ai * HALF + wr * 64 + m * 16 + fr) * 4 + wc] = ss; }
              asm volatile("" ::: "memory");
          } }
        asm volatile("s_waitcnt lgkmcnt(0)" ::: "memory"); __builtin_amdgcn_s_barrier(); asm volatile("" ::: "memory");
        const int tid = wid * 64 + lane;
        if (tid < 256) { const f32x4 p4 = *(const LAS f32x4*)(P + tid * 4); const float sp = (p4[0] + p4[1]) + (p4[2] + p4[3]);
            __hip_atomic_store((gu32*)xs + ((size_t)(u.pm * BM + tid) * 4 + u.pn), __float_as_uint(sp), RLX_AGENT); }
        asm volatile("s_waitcnt vmcnt(0)" ::: "memory");
        if (wid < 4 && lane == 0) __hip_atomic_fetch_add(cnt + 64 * u.pm, 1u, RLX_AGENT);
        if (wid == 0) { unsigned spins = 0;
            while ((unsigned)__builtin_amdgcn_readfirstlane(__hip_atomic_load(cnt + 64 * u.pm, RLX_AGENT)) < 16u) { __builtin_amdgcn_s_sleep(2);
                if (++spins > (1u << 20)) { if (lane == 0) __hip_atomic_store(tmo, 1u, RLX_AGENT); break; } } }
        asm volatile("s_waitcnt vmcnt(0) lgkmcnt(0)" ::: "memory"); __builtin_amdgcn_s_barrier(); asm volatile("" ::: "memory");
        if (tid < 256) { const GAS unsigned long long* q = (const GAS unsigned long long*)xs + (size_t)(u.pm * BM + tid) * 2;
            const unsigned long long a = __hip_atomic_load(q, RLX_AGENT), c = __hip_atomic_load(q + 1, RLX_AGENT);
            const float tot = (__uint_as_float((unsigned)a) + __uint_as_float((unsigned)(a >> 32))) + (__uint_as_float((unsigned)c) + __uint_as_float((unsigned)(c >> 32)));
            S[tid] = 1.0f / sqrtf(tot * (1.0f / DM) + EPS); }
        asm volatile("s_waitcnt vmcnt(0) lgkmcnt(0)" ::: "memory"); __builtin_amdgcn_s_barrier(); asm volatile("" ::: "memory");
        f32x4 gm[2][2], sf[2][2];
#pragma unroll
        for (int bj = 0; bj < 2; ++bj)
#pragma unroll
            for (int n = 0; n < 2; ++n) { const int c = col0 + bj * HALF + 4 * n; const f32x4 g4 = *(const f32x4*)(ng + c), s1 = *(const f32x4*)(shb + (size_t)b * 6144 + DM + c);
                gm[bj][n] = g4 * (s1 + 1.0f); sf[bj][n] = *(const f32x4*)(shb + (size_t)b * 6144 + c); }
#pragma unroll
        for (int ai = 0; ai < 2; ++ai)
#pragma unroll
            for (int m = 0; m < 4; ++m) { const float r = S[ai * HALF + wr * 64 + m * 16 + fr]; bf16_t* hp = H + (size_t)(row0 + ai * HALF + m * 16) * DM + col0;
#pragma unroll
                for (int bj = 0; bj < 2; ++bj) *(u32x4*)(hp + bj * HALF) = pack8((acc[ai][bj][m][0] * r) * gm[bj][0] + sf[bj][0], (acc[ai][bj][m][1] * r) * gm[bj][1] + sf[bj][1]); }
    }
};
struct EpiResNormRouter {
    static constexpr bool FUSED = true;
    float* X; const float* gate; const float* ng; const float* shb; bf16_t* H; float* xs9; gu32* cnt; gu32* tmo;
    const float* rw; const float* rb; gu32* ecnt; unsigned char* meta;
    __device__ __forceinline__ void fused(Acc& acc, const Unit& u, int wr, int wc, int fr, int fq, LAS unsigned char* lds, int wid, int lane) const {
        const int row0 = u.pm * BM + wr * 64 + fr, col0 = u.pn * BM + wc * 32 + 8 * fq; const int b = (u.pm * BM) / SEQ; const int tid = wid * 64 + lane;
        LAS float* P9 = (LAS float*)lds; LAS float* RWT = (LAS float*)(lds + 36864); LAS float* S = (LAS float*)(lds + 45056); LAS float* CE = (LAS float*)(lds + 46080);
        LAS int* rE = (LAS int*)(lds + 46144); LAS float* red = (LAS float*)(lds + 47360);
        const float* shp = shb + (size_t)b * 6144;
        for (int i = tid; i < 2048; i += NTHREADS) { const int c = i >> 3, e = i & 7; RWT[e * 256 + c] = rw[(size_t)(u.pn * BM + c) * 8 + e]; }
        { float ce[8]; const float s0 = shp[tid], s1 = shp[tid + 512];
#pragma unroll
          for (int e = 0; e < 8; ++e) ce[e] = wave_sum(s0 * rw[(size_t)tid * 8 + e] + s1 * rw[(size_t)(tid + 512) * 8 + e]);
          if (lane == 0) {
#pragma unroll
              for (int e = 0; e < 8; ++e) red[wid * 8 + e] = ce[e]; } }
        { f32x4 gv[2][2];
#pragma unroll
          for (int bj = 0; bj < 2; ++bj)
#pragma unroll
              for (int n = 0; n < 2; ++n) gv[bj][n] = *(const f32x4*)(gate + (size_t)b * 6144 + col0 + bj * HALF + 4 * n);
#pragma unroll
          for (int ai = 0; ai < 2; ++ai) {
              f32x4 xv[4][2][2];
#pragma unroll
              for (int m = 0; m < 4; ++m) { const float* ri = X + (size_t)(row0 + ai * HALF + m * 16) * DM + col0;
#pragma unroll
                  for (int bj = 0; bj < 2; ++bj)
#pragma unroll
                      for (int n = 0; n < 2; ++n) xv[m][bj][n] = ldx16(ri + bj * HALF + 4 * n); }
              asm volatile("" ::: "memory");
#pragma unroll
              for (int m = 0; m < 4; ++m) { float* rp = X + (size_t)(row0 + ai * HALF + m * 16) * DM + col0; float ss = 0.f;
#pragma unroll
                  for (int bj = 0; bj < 2; ++bj)
#pragma unroll
                      for (int n = 0; n < 2; ++n) { const f32x4 x = xv[m][bj][n] + gv[bj][n] * acc[ai][bj][m][n]; acc[ai][bj][m][n] = x; *(f32x4*)(rp + bj * HALF + 4 * n) = x;
                          ss += (x[0] * x[0] + x[1] * x[1]) + (x[2] * x[2] + x[3] * x[3]); }
                  ss += __shfl_xor(ss, 16); ss += __shfl_xor(ss, 32);
                  if (fq == 0) P9[((ai * HALF + wr * 64 + m * 16 + fr) * 4 + wc) * 9] = ss; }
              asm volatile("" ::: "memory");
          } }
        f32x4 sf[2][2];
#pragma unroll
        for (int bj = 0; bj < 2; ++bj)
#pragma unroll
            for (int n = 0; n < 2; ++n) { const int c = col0 + bj * HALF + 4 * n; const f32x4 gm = *(const f32x4*)(ng + c) * (*(const f32x4*)(shp + DM + c) + 1.0f); sf[bj][n] = *(const f32x4*)(shp + c);
#pragma unroll
                for (int ai = 0; ai < 2; ++ai)
#pragma unroll
                    for (int m = 0; m < 4; ++m) acc[ai][bj][m][n] = acc[ai][bj][m][n] * gm; }
        asm volatile("s_waitcnt lgkmcnt(0)" ::: "memory"); __builtin_amdgcn_s_barrier(); asm volatile("" ::: "memory");
        if (tid < 8) { float c = rb[tid];
#pragma unroll
            for (int w = 0; w < 8; ++w) c += red[w * 8 + tid];
            CE[tid] = c; }
#pragma unroll
        for (int e = 0; e < 8; ++e) { f32x4 rwe[2][2];
#pragma unroll
            for (int bj = 0; bj < 2; ++bj)
#pragma unroll
                for (int n = 0; n < 2; ++n) rwe[bj][n] = *(const LAS f32x4*)(RWT + e * 256 + bj * HALF + wc * 32 + 8 * fq + 4 * n);
#pragma unroll
            for (int ai = 0; ai < 2; ++ai)
#pragma unroll
                for (int m = 0; m < 4; ++m) { float a = 0.f;
#pragma unroll
                    for (int bj = 0; bj < 2; ++bj)
#pragma unroll
                        for (int n = 0; n < 2; ++n) { const f32x4 x = acc[ai][bj][m][n], w4 = rwe[bj][n]; a += (x[0] * w4[0] + x[1] * w4[1]) + (x[2] * w4[2] + x[3] * w4[3]); }
                    a += __shfl_xor(a, 16); a += __shfl_xor(a, 32);
                    if (fq == 0) P9[((ai * HALF + wr * 64 + m * 16 + fr) * 4 + wc) * 9 + 1 + e] = a; } }
        asm volatile("s_waitcnt lgkmcnt(0)" ::: "memory"); __builtin_amdgcn_s_barrier(); asm volatile("" ::: "memory");
        if (tid < 256) { gu32* q = (gu32*)xs9 + ((size_t)(u.pm * BM + tid) * 4 + u.pn) * 9;
#pragma unroll
            for (int k = 0; k < 9; ++k) { const float v = (P9[(tid * 4 + 0) * 9 + k] + P9[(tid * 4 + 1) * 9 + k]) + (P9[(tid * 4 + 2) * 9 + k] + P9[(tid * 4 + 3) * 9 + k]);
                __hip_atomic_store(q + k, __float_as_uint(v), RLX_AGENT); } }
        asm volatile("s_waitcnt vmcnt(0)" ::: "memory");
        if (wid < 4 && lane == 0) __hip_atomic_fetch_add(cnt + 64 * u.pm, 1u, RLX_AGENT);
        if (wid == 0) { unsigned spins = 0;
            while ((unsigned)__builtin_amdgcn_readfirstlane(__hip_atomic_load(cnt + 64 * u.pm, RLX_AGENT)) < 16u) { __builtin_amdgcn_s_sleep(2);
                if (++spins > (1u << 20)) { if (lane == 0) __hip_atomic_store(tmo, 1u, RLX_AGENT); break; } } }
        asm volatile("s_waitcnt vmcnt(0) lgkmcnt(0)" ::: "memory"); __builtin_amdgcn_s_barrier(); asm volatile("" ::: "memory");
        if (tid < 256) { const gu32* q = (const gu32*)xs9 + (size_t)(u.pm * BM + tid) * 36; float tot[9];
#pragma unroll
            for (int k = 0; k < 9; ++k) tot[k] = (__uint_as_float(__hip_atomic_load(q + k, RLX_AGENT)) + __uint_as_float(__hip_atomic_load(q + 9 + k, RLX_AGENT)))
                                               + (__uint_as_float(__hip_atomic_load(q + 18 + k, RLX_AGENT)) + __uint_as_float(__hip_atomic_load(q + 27 + k, RLX_AGENT)));
            const float r = 1.0f / sqrtf(tot[0] * (1.0f / DM) + EPS); S[tid] = r;
            if (wid == u.pn) {
                float lg[8];
#pragma unroll
                for (int e = 0; e < 8; ++e) lg[e] = r * tot[1 + e] + CE[e];
                int e0 = 0; float l0 = lg[0];
#pragma unroll
                for (int e = 1; e < 8; ++e) if (lg[e] > l0) { l0 = lg[e]; e0 = e; }
                int e1 = -1; float l1 = -3.0e38f;
#pragma unroll
                for (int e = 0; e < 8; ++e) if (e != e0 && lg[e] > l1) { l1 = lg[e]; e1 = e; }
                const float g0 = 1.0f / (1.0f + __expf(l1 - l0)), g1 = 1.0f - g0;
                int cmine = 0, r0 = 0, r1 = 0;
#pragma unroll
                for (int e = 0; e < 8; ++e) { const unsigned long long m0 = __ballot(e0 == e), m1 = __ballot(e1 == e);
                    const int below = (int)__builtin_amdgcn_mbcnt_hi((unsigned)(m0 >> 32), __builtin_amdgcn_mbcnt_lo((unsigned)m0, 0u)) + (int)__builtin_amdgcn_mbcnt_hi((unsigned)(m1 >> 32), __builtin_amdgcn_mbcnt_lo((unsigned)m1, 0u));
                    if (e0 == e) r0 = below; if (e1 == e) r1 = below; if (lane == e) cmine = __popcll(m0) + __popcll(m1); }
                unsigned base = 0u; if (lane < 8 && cmine) base = __hip_atomic_fetch_add(ecnt + 64 * lane, (unsigned)cmine, RLX_AGENT);
                const int p0 = (int)__shfl(base, e0) + r0, p1 = (int)__shfl(base, e1) + r1, grow = u.pm * BM + 64 * u.pn + lane;
                gu32* ri = (gu32*)(meta + WS_ROWIDX_B); gu32* gp = (gu32*)(meta + WS_GATEP_B); gu32* sl = (gu32*)(meta + WS_SLOT_B);
                __hip_atomic_store(ri + e0 * 16384 + p0, (unsigned)grow, RLX_AGENT); __hip_atomic_store(ri + e1 * 16384 + p1, (unsigned)grow, RLX_AGENT);
                __hip_atomic_store(gp + e0 * 16384 + p0, __float_as_uint(g0), RLX_AGENT); __hip_atomic_store(gp + e1 * 16384 + p1, __float_as_uint(g1), RLX_AGENT);
                __hip_atomic_store(sl + grow * 2, (unsigned)((e0 << 16) | p0), RLX_AGENT); __hip_atomic_store(sl + grow * 2 + 1, (unsigned)((e1 << 16) | p1), RLX_AGENT); } }
        asm volatile("s_waitcnt vmcnt(0) lgkmcnt(0)" ::: "memory"); __builtin_amdgcn_s_barrier(); asm volatile("" ::: "memory");
#pragma unroll
        for (int ai = 0; ai < 2; ++ai)
#pragma unroll
            for (int m = 0; m < 4; ++m) { const float r = S[ai * HALF + wr * 64 + m * 16 + fr]; bf16_t* hp = H + (size_t)(row0 + ai * HALF + m * 16) * DM + col0;
#pragma unroll
                for (int bj = 0; bj < 2; ++bj) *(u32x4*)(hp + bj * HALF) = pack8(acc[ai][bj][m][0] * r + sf[bj][0], acc[ai][bj][m][1] * r + sf[bj][1]); }
    }
};
struct EpiGluRes {
    static constexpr bool FUSED = false;
    float* X; const float* gate;
    __device__ __forceinline__ void operator()(const Acc& acc, const Unit& u, int wr, int wc, int fr, int fq) const {
        const int row0 = u.pm * BM + wr * 64 + fr, col0 = u.pn * HALF + wc * 32 + 8 * fq; const int b = (u.pm * BM) / SEQ;
        f32x4 gv[2];
#pragma unroll
        for (int n = 0; n < 2; ++n) gv[n] = *(const f32x4*)(gate + (size_t)b * 6144 + col0 + 4 * n);
        f32x4 xv[2][4][2];
#pragma unroll
        for (int ai = 0; ai < 2; ++ai)
#pragma unroll
            for (int m = 0; m < 4; ++m)
#pragma unroll
                for (int n = 0; n < 2; ++n) xv[ai][m][n] = ldx16(X + (size_t)(row0 + ai * HALF + m * 16) * DM + col0 + 4 * n);
        asm volatile("" ::: "memory");
#pragma unroll
        for (int ai = 0; ai < 2; ++ai)
#pragma unroll
            for (int m = 0; m < 4; ++m) { float* rp = X + (size_t)(row0 + ai * HALF + m * 16) * DM + col0;
#pragma unroll
                for (int n = 0; n < 2; ++n) { f32x4 x = xv[ai][m][n]; const f32x4 l = acc[ai][0][m][n], gg = acc[ai][1][m][n];
#pragma unroll
                    for (int e = 0; e < 4; ++e) x[e] += gv[n][e] * l[e] * sigmoid_f(gg[e]);
                    *(f32x4*)(rp + 4 * n) = x; } }
    }
};
struct EpiAttnIn {
    static constexpr bool FUSED = false;
    bf16_t *Q, *Kn, *V, *QI, *KI; float* WI; const float *qg, *kg;
    __device__ __forceinline__ void operator()(const Acc& acc, const Unit& u, int wr, int wc, int fr, int fq) const {
        const int row0 = u.pm * BM + wr * 64 + fr;
        if (u.pn < 5) {
            const bool isq = u.pn < 4; const float* gp = isq ? qg : kg; const float sc = isq ? 0.125f : 1.0f;
            f32x4 gn[2][2];
#pragma unroll
            for (int bj = 0; bj < 2; ++bj)
#pragma unroll
                for (int n = 0; n < 2; ++n) gn[bj][n] = *(const f32x4*)(gp + 32 * bj + 8 * fq + 4 * n) * sc;
            bf16_t* base = isq ? (Q + (size_t)(4 * u.pn + wc) * 64) : (Kn + (size_t)wc * 64); const int ldo = isq ? 1024 : 256;
#pragma unroll
            for (int ai = 0; ai < 2; ++ai)
#pragma unroll
                for (int m = 0; m < 4; ++m) { float ss = 0.f;
#pragma unroll
                    for (int bj = 0; bj < 2; ++bj)
#pragma unroll
                        for (int n = 0; n < 2; ++n) { const f32x4 x = acc[ai][bj][m][n]; ss += (x[0] * x[0] + x[1] * x[1]) + (x[2] * x[2] + x[3] * x[3]); }
                    ss += __shfl_xor(ss, 16); ss += __shfl_xor(ss, 32);
                    const float r = 1.0f / sqrtf(ss * (1.0f / 64.0f) + EPS);
#pragma unroll
                    for (int bj = 0; bj < 2; ++bj) *(u32x4*)(base + (size_t)(row0 + ai * HALF + m * 16) * ldo + 32 * bj + 8 * fq) = pack8(acc[ai][bj][m][0] * r * gn[bj][0], acc[ai][bj][m][1] * r * gn[bj][1]); }
        } else if (u.pn < 8) {
            bf16_t* base = (u.pn == 5) ? V : QI + (size_t)(u.pn - 6) * 256; const int ldo = (u.pn == 5) ? 256 : 512; const int col0 = wc * 32 + 8 * fq;
#pragma unroll
            for (int ai = 0; ai < 2; ++ai)
#pragma unroll
                for (int m = 0; m < 4; ++m)
#pragma unroll
                    for (int bj = 0; bj < 2; ++bj) *(u32x4*)(base + (size_t)(row0 + ai * HALF + m * 16) * ldo + col0 + bj * HALF) = pack8(acc[ai][bj][m][0], acc[ai][bj][m][1]);
        } else {
            if (wc < 2) {
#pragma unroll
                for (int ai = 0; ai < 2; ++ai)
#pragma unroll
                    for (int m = 0; m < 4; ++m) *(u32x4*)(KI + (size_t)(row0 + ai * HALF + m * 16) * 64 + wc * 32 + 8 * fq) = pack8(acc[ai][0][m][0], acc[ai][0][m][1]);
            } else if (wc == 2 && fq == 0) {
                const float s = 0.04419417382415922f;
#pragma unroll
                for (int ai = 0; ai < 2; ++ai)
#pragma unroll
                    for (int m = 0; m < 4; ++m) { float* wp = WI + (size_t)(row0 + ai * HALF + m * 16) * 8; *(f32x4*)wp = acc[ai][0][m][0] * s; *(f32x4*)(wp + 4) = acc[ai][0][m][1] * s; }
            }
        }
    }
};
struct EpiMoeDn {
    static constexpr bool FUSED = false;
    bf16_t* Y; const float* gatep;
    __device__ __forceinline__ void operator()(const Acc& acc, const Unit& u, int wr, int wc, int fr, int fq) const {
        const int row0 = u.pm * BM + wr * 64 + fr, col0 = u.pn * BM + wc * 32 + 8 * fq;
#pragma unroll
        for (int ai = 0; ai < 2; ++ai)
#pragma unroll
            for (int m = 0; m < 4; ++m) { const float gt = gatep[u.aux + ai * HALF + wr * 64 + m * 16 + fr];
#pragma unroll
                for (int bj = 0; bj < 2; ++bj) *(u32x4*)(Y + (size_t)(row0 + ai * HALF + m * 16) * DM + col0 + bj * HALF) = pack8(acc[ai][bj][m][0] * gt, acc[ai][bj][m][1] * gt); }
    }
};
}

constexpr size_t MiB = 1u << 20;
constexpr size_t WS_CTL = 0, CTL_ZERO_BYTES = 1 * MiB;
constexpr size_t WS_MOD = 1 * MiB;
constexpr size_t WS_ROWIDX = 2 * MiB;
constexpr size_t WS_GATEP = 2 * MiB + 512 * 1024;
constexpr size_t WS_SLOT = 3 * MiB;
static_assert(WS_ROWIDX_B == WS_ROWIDX && WS_GATEP_B == WS_GATEP && WS_SLOT_B == WS_SLOT, "metadata offsets");
constexpr size_t WS_WCI = 8 * MiB;
constexpr size_t WS_WCO = 20 * MiB;
constexpr size_t WS_WAI = 24 * MiB;
constexpr size_t WS_WAO = 29 * MiB;
constexpr size_t WS_WGL = 31 * MiB;
constexpr size_t WS_WFG = 35 * MiB;
constexpr size_t WS_WFD = 57 * MiB;
constexpr size_t WS_WMG = 68 * MiB;
constexpr size_t WS_WMD = 244 * MiB;
constexpr size_t WS_HB = 332 * MiB;
constexpr size_t WS_BUF = 364 * MiB;
constexpr size_t WS_ACT = 432 * MiB;
constexpr size_t WS_END = 619 * MiB;
constexpr int MOE_ROWS = 2 * M + NEXP * 256;
constexpr size_t WS_Q = WS_BUF, WS_K = WS_BUF + 32 * MiB, WS_V = WS_BUF + 40 * MiB, WS_QI = WS_BUF + 48 * MiB;
constexpr size_t WS_SC = WS_ACT, WS_O = WS_ACT + 128 * MiB, WS_KI = WS_ACT + 160 * MiB, WS_WI = WS_ACT + 162 * MiB;
static_assert(WS_WMD + (size_t)16 * 1024 * 2816 * 2 <= WS_HB && WS_ACT + (size_t)MOE_ROWS * FF * 2 <= WS_END && WS_BUF + (size_t)MOE_ROWS * DM * 2 <= WS_ACT, "d_ws map");
constexpr int CW_TMO = 0;
constexpr int CW_CNT = 64;
constexpr int CW_BAR = 4096;
constexpr int CW_PAN = 16384;
constexpr size_t WS_XS9 = 5 * MiB + 768 * 1024;
constexpr size_t WS_XS = 5 * MiB + 512 * 1024;

constexpr int RING_BYTES = 131072;
constexpr int LDSCTL_OFF = RING_BYTES, MISC_OFF = LDSCTL_OFF + 320;
constexpr int LDS_BYTES = 147456;

#define XB_TMO      128
#define XB_XCNT(j)  (256  + 64 * (j))
#define XB_XSUB(j)  (1280 + 64 * (j))
#define XB_XGEN(j)  (2304 + 64 * (j))
#define XB_TOP      3328
#define XB_TOPGEN   3392
#define XCD_BAR_WORDS 3456
#define XB_SPIN_CAP (1u << 18)
__device__ __forceinline__ unsigned xb_ld(unsigned* p)              { return __hip_atomic_load(p, __ATOMIC_RELAXED, __HIP_MEMORY_SCOPE_AGENT); }
__device__ __forceinline__ unsigned xb_add(unsigned* p, unsigned v) { return __hip_atomic_fetch_add(p, v, __ATOMIC_RELAXED, __HIP_MEMORY_SCOPE_AGENT); }
__device__ __forceinline__ unsigned xb_xcc_id() { return (unsigned)__builtin_amdgcn_s_getreg((3 << 11) | 20) & 0xFu; }
#define XB_SPIN(cond, bar) do { unsigned _sp = 0; while (cond) { __builtin_amdgcn_s_sleep(1); \
    if ((++_sp & 255u) == 0u) { if (xb_ld(&(bar)[XB_TMO])) break; if (_sp > XB_SPIN_CAP) { atomicAdd(&(bar)[XB_TMO], 1u); break; } } } } while (0)
struct XcdBarrier { unsigned* bar; unsigned x; volatile LAS unsigned* st; };
__device__ __forceinline__ XcdBarrier xcd_barrier_post(unsigned* bar, volatile LAS unsigned* st) {
    XcdBarrier b; b.bar = bar; b.x = xb_xcc_id(); b.st = st;
    if (threadIdx.x == 0) (void)xb_add(&bar[XB_XCNT(b.x)], 1u);
    return b;
}
__device__ __forceinline__ void xcd_barrier_complete(unsigned* bar, unsigned x, unsigned& nloc, unsigned& nx) {
    const unsigned G = gridDim.x * gridDim.y * gridDim.z;
    unsigned sum, cnt, mine, sp = 0u;
    for (;;) {
        sum = 0u; cnt = 0u; mine = 0u;
#pragma unroll
        for (unsigned j = 0; j < 16; ++j) { const unsigned c = xb_ld(&bar[XB_XCNT(j)]); sum += c; cnt += (c > 0u) ? 1u : 0u; mine = (j == x) ? c : mine; }
        if (sum == G) break;
        __builtin_amdgcn_s_sleep(1);
        if ((++sp & 255u) == 0u) { if (xb_ld(&bar[XB_TMO])) break; if (sp > XB_SPIN_CAP) { atomicAdd(&bar[XB_TMO], 1u); break; } }
    }
    nloc = mine > 0u ? mine : 1u; nx = cnt > 0u ? cnt : 1u;
}
__device__ __forceinline__ int lane_probe() { return (int)__builtin_amdgcn_mbcnt_hi(~0u, __builtin_amdgcn_mbcnt_lo(~0u, 0u)); }
__device__ __forceinline__ int lane_probe2() { return (int)__builtin_amdgcn_mbcnt_hi(~0u, __builtin_amdgcn_mbcnt_lo(~0u, 0u)); }
__device__ __forceinline__ void xcd_barrier(const XcdBarrier& b) {
    asm volatile("s_waitcnt vmcnt(0)" ::: "memory");
    __syncthreads();
    if (threadIdx.x == 0) {
        unsigned* bar = b.bar;
        __builtin_amdgcn_s_waitcnt(0);
        unsigned nloc = b.st[0], nx = b.st[1];
        if (nloc == 0u) { xcd_barrier_complete(bar, b.x, nloc, nx); b.st[0] = nloc; b.st[1] = nx; }
        const unsigned old = xb_add(&bar[XB_XSUB(b.x)], 1u);
        const unsigned gen = old / nloc;
        if (old + 1u == (gen + 1u) * nloc) {
            __builtin_amdgcn_fence(__ATOMIC_RELEASE, "agent");
            asm volatile("s_waitcnt vmcnt(0)" ::: "memory");
            const unsigned og = xb_add(&bar[XB_TOP], 1u);
            const unsigned tg = og / nx;
            if (og + 1u == (tg + 1u) * nx) xb_add(&bar[XB_TOPGEN], 1u);
            else XB_SPIN(xb_ld(&bar[XB_TOPGEN]) == tg, bar);
            __builtin_amdgcn_fence(__ATOMIC_ACQUIRE, "agent");
            xb_add(&bar[XB_XGEN(b.x)], 1u);
            { const unsigned dmy = __builtin_nontemporal_load(&bar[XB_TMO]); asm volatile("s_waitcnt vmcnt(0)" :: "v"(dmy) : "memory"); }
        } else {
            XB_SPIN(xb_ld(&bar[XB_XGEN(b.x)]) == gen, bar);
            __builtin_amdgcn_fence(__ATOMIC_ACQUIRE, "agent");
            { const unsigned dmy = __builtin_nontemporal_load(&bar[XB_TMO]); asm volatile("s_waitcnt vmcnt(0)" :: "v"(dmy) : "memory"); }
        }
    }
    __syncthreads();
    if (threadIdx.x == 0) { __builtin_amdgcn_fence(__ATOMIC_ACQUIRE, "agent"); asm volatile("s_waitcnt vmcnt(0)" ::: "memory"); }
    __syncthreads();
}

struct Args { const float* in[28]; float* out; unsigned char* ws; int ph_lo, ph_hi; };
enum { I_X = 0, I_C, I_ADAW, I_ADAB, I_NORMG, I_CWIN, I_CW, I_CWOUT, I_AWIN, I_QG, I_KG, I_AWOUT, I_RELB, I_SLRE, I_SLIM, I_SLOG, I_SBRE, I_SBIM, I_SCRE, I_SCIM, I_SD, I_SGLU,
       I_FGU, I_FDN, I_RW, I_RB, I_MGU, I_MDN };
struct Frame {
    LAS unsigned char* lds; unsigned char* ws; gu32* ctl;
    int tid, lane, wave, vcu, G;
    float* out; const float* mod;
    bf16_t *HB, *BUF, *ACT;
};

enum { MAP_NAT = 0, MAP_PAIR = 1, MAP_CONV = 2, MAP_ATTN = 3 };
__device__ __forceinline__ int map_row(int map, int half, int n) {
    if (map == MAP_NAT) return n;
    if (map == MAP_PAIR) { return n < half ? 256 * (n / 128) + (n % 128) : 256 * ((n - half) / 128) + 128 + ((n - half) % 128); }
    if (map == MAP_CONV) { if (n < 1024) return 2048 + n; if (n < 2048) { const int q = n - 1024; return 256 * (q / 128) + (q % 128); } const int q = n - 2048; return 256 * (q / 128) + 128 + (q % 128); }
    if (n < 1280) { const int hd = n / 64, d = n % 64; return 256 * (hd / 4) + 128 * (d / 32) + 32 * (hd % 4) + (d % 32); }
    return n;
}
__device__ __forceinline__ void p0_transpose_item(const float* W, int K, int N, bf16_t* WT, int map, int half, LAS float* scr, int item, int lane) {
    const int nblk = (N + 31) / 32, kb = item / nblk, nb = item % nblk, k0 = 64 * kb, n0 = 32 * nb;
    const bool cin = (n0 + (lane & 31)) < N;
    float tv[32];
#pragma unroll
    for (int i = 0; i < 32; ++i) { const int kk = 2 * i + (lane >> 5); tv[i] = cin ? W[(size_t)(k0 + kk) * N + n0 + (lane & 31)] : 0.f; }
#pragma unroll
    for (int i = 0; i < 32; ++i) { const int kk = 2 * i + (lane >> 5); scr[kk * 33 + (lane & 31)] = tv[i]; }
    LDS_WAIT(); CFENCE();
    const int c = lane & 7; const int r0 = map_row(map, half, n0);
#pragma unroll
    for (int j = 0; j < 4; ++j) { const int n = (lane >> 3) + 8 * j; const LAS float* s = scr + (8 * c) * 33 + n;
        u32x4 o; o.x = pk2(s[0 * 33], s[1 * 33]); o.y = pk2(s[2 * 33], s[3 * 33]); o.z = pk2(s[4 * 33], s[5 * 33]); o.w = pk2(s[6 * 33], s[7 * 33]);
        *(GAS u32x4*)(WT + (size_t)(r0 + n) * K + k0 + 8 * c) = o; }
    LDS_WAIT(); CFENCE();
}
__device__ __forceinline__ void p0_prologue(Frame& F, const Args& A) {
    {
        LAS float* cs = (LAS float*)F.lds;
        LAS float* red = (LAS float*)(F.lds + 16384);
        for (int i = F.tid; i < NB * DM; i += NTHREADS) { const float c = A.in[I_C][i]; cs[i] = c / (1.f + __expf(-c)); }
        __syncthreads();
        const int kg = F.tid >> 6, cj = F.tid & 63;
        for (int un = blockIdx.x; un < 4 * 96; un += F.G) {
            const int l = un / 96, jb = un % 96, j = jb * 64 + cj;
            const float* w = A.in[I_ADAW] + (size_t)l * DM * 6144 + j;
            float a0 = 0.f, a1 = 0.f, a2 = 0.f, a3 = 0.f;
#pragma unroll 8
            for (int k = kg * 128; k < kg * 128 + 128; ++k) { const float wv = w[(size_t)k * 6144]; a0 += cs[k] * wv; a1 += cs[1024 + k] * wv; a2 += cs[2048 + k] * wv; a3 += cs[3072 + k] * wv; }
            *(LAS f32x4*)(red + (kg * 64 + cj) * 4) = (f32x4){a0, a1, a2, a3};
            __syncthreads();
            if (F.tid < 256) { const int b = F.tid >> 6, cc = F.tid & 63; float s = 0.f;
#pragma unroll
                for (int q = 0; q < 8; ++q) s += red[(q * 64 + cc) * 4 + b];
                ((float*)(F.ws + WS_MOD))[((size_t)l * NB + b) * 6144 + jb * 64 + cc] = s + A.in[I_ADAB][l * 6144 + jb * 64 + cc]; }
            __syncthreads();
        }
    }
    LAS float* scr = (LAS float*)(F.lds + 32768 + F.wave * 8704);
    const int gw = F.vcu * NWAVES + F.wave, NGW = F.G * NWAVES;
    constexpr int I_CI = (DM / 64) * (3072 / 32), I_SQ = (DM / 64) * (DM / 32), I_AI = (DM / 64) * ((ATT_N + 31) / 32), I_GL = (DM / 64) * (2048 / 32), I_GU = (DM / 64) * (2 * FF / 32), I_DN = (FF / 64) * (DM / 32);
    constexpr int NITEMS = 2 * I_CI + 2 * I_SQ + I_AI + I_SQ + I_GL + 2 * I_GU + 2 * I_DN + 16 * I_GU + 16 * I_DN;
    for (int it = gw; it < NITEMS; it += NGW) {
        int r = it;
        if (r < 2 * I_CI) { const int q = r / I_CI; p0_transpose_item(A.in[I_CWIN] + (size_t)q * DM * 3072, DM, 3072, (bf16_t*)(F.ws + WS_WCI) + (size_t)q * 3072 * DM, MAP_CONV, 0, scr, r % I_CI, F.lane); continue; } r -= 2 * I_CI;
        if (r < 2 * I_SQ) { const int q = r / I_SQ; p0_transpose_item(A.in[I_CWOUT] + (size_t)q * DM * DM, DM, DM, (bf16_t*)(F.ws + WS_WCO) + (size_t)q * DM * DM, MAP_NAT, 0, scr, r % I_SQ, F.lane); continue; } r -= 2 * I_SQ;
        if (r < I_AI) { p0_transpose_item(A.in[I_AWIN], DM, ATT_N, (bf16_t*)(F.ws + WS_WAI), MAP_ATTN, 0, scr, r, F.lane); continue; } r -= I_AI;
        if (r < I_SQ) { p0_transpose_item(A.in[I_AWOUT], DM, DM, (bf16_t*)(F.ws + WS_WAO), MAP_NAT, 0, scr, r, F.lane); continue; } r -= I_SQ;
        if (r < I_GL) { p0_transpose_item(A.in[I_SGLU], DM, 2048, (bf16_t*)(F.ws + WS_WGL), MAP_PAIR, 1024, scr, r, F.lane); continue; } r -= I_GL;
        if (r < 2 * I_GU) { const int q = r / I_GU; p0_transpose_item(A.in[I_FGU] + (size_t)q * DM * 2 * FF, DM, 2 * FF, (bf16_t*)(F.ws + WS_WFG) + (size_t)q * 2 * FF * DM, MAP_PAIR, FF, scr, r % I_GU, F.lane); continue; } r -= 2 * I_GU;
        if (r < 2 * I_DN) { const int q = r / I_DN; p0_transpose_item(A.in[I_FDN] + (size_t)q * FF * DM, FF, DM, (bf16_t*)(F.ws + WS_WFD) + (size_t)q * DM * FF, MAP_NAT, 0, scr, r % I_DN, F.lane); continue; } r -= 2 * I_DN;
        if (r < 16 * I_GU) { const int q = r / I_GU; p0_transpose_item(A.in[I_MGU] + (size_t)q * DM * 2 * FF, DM, 2 * FF, (bf16_t*)(F.ws + WS_WMG) + (size_t)q * 2 * FF * DM, MAP_PAIR, FF, scr, r % I_GU, F.lane); continue; } r -= 16 * I_GU;
        { const int q = r / I_DN; p0_transpose_item(A.in[I_MDN] + (size_t)q * FF * DM, FF, DM, (bf16_t*)(F.ws + WS_WMD) + (size_t)q * DM * FF, MAP_NAT, 0, scr, r % I_DN, F.lane); }
    }
    { u32x4* z = (u32x4*)((bf16_t*)(F.ws + WS_WAI) + (size_t)2144 * DM); const int n16 = (ATT_NP - 2144) * DM * 2 / 16;
      for (int i = blockIdx.x * NTHREADS + F.tid; i < n16; i += F.G * NTHREADS) z[i] = (u32x4){0u, 0u, 0u, 0u}; }
}

template <int FLAGS>
__device__ __forceinline__ void thin_phase(Frame& F, const Args& A, const float* src, int nl  , int ns  , int cl  , int rl  , int cs = -1  , size_t roff = 0  ) {
    if (cs < 0) cs = rl;
    const int gw = F.vcu * NWAVES + F.wave, NGW = F.G * NWAVES;
    LAS float* rwt = (LAS float*)F.lds;
    if (FLAGS & 8) {
        const float* rw = A.in[I_RW] + (size_t)rl * DM * NEXP;
        for (int i = F.tid; i < DM * NEXP; i += NTHREADS) rwt[(i & 7) * DM + (i >> 3)] = rw[i];
        __syncthreads();
    }
    int Tb[8];
    if (FLAGS & 2) { int acc = 0;
#pragma unroll
        for (int e = 0; e < 8; ++e) { Tb[e] = acc; acc += (int)((__hip_atomic_load(F.ctl + CW_CNT + 64 * (8 * rl + e), RLX_AGENT) + 255u) >> 8); } }
    const float* ng = A.in[I_NORMG] + (size_t)(nl * 2 + ns) * DM;
    constexpr bool RT = (FLAGS & 8) != 0;
    LAS int* rE = (LAS int*)(F.lds + 32768);
    const int nit = RT ? ((M / 64 - (int)blockIdx.x + F.G - 1) / F.G) * 8 : (M - gw + NGW - 1) / NGW;
    for (int it = 0; it < nit; ++it) {
        const int chunk = (int)blockIdx.x + (it >> 3) * F.G;
        const int row = RT ? chunk * 64 + F.wave * 8 + (it & 7) : gw + it * NGW;
        const int b = row / SEQ;
        f32x4 v[4];
        const GAS unsigned long long* xr = (const GAS unsigned long long*)(src + (size_t)row * DM) + 2 * F.lane;
#pragma unroll
        for (int j = 0; j < 4; ++j) { const unsigned long long lo = __hip_atomic_load(xr + 128 * j, RLX_AGENT), hi = __hip_atomic_load(xr + 128 * j + 1, RLX_AGENT);
            v[j] = (f32x4){__uint_as_float((unsigned)lo), __uint_as_float((unsigned)(lo >> 32)), __uint_as_float((unsigned)hi), __uint_as_float((unsigned)(hi >> 32))}; }
        if (FLAGS & 2) {
            const int s0 = ((const int*)(F.ws + roff + WS_SLOT))[row * 2], s1 = ((const int*)(F.ws + roff + WS_SLOT))[row * 2 + 1];
            int t0 = 0, t1 = 0;
#pragma unroll
            for (int e = 0; e < 8; ++e) { if ((s0 >> 16) == e) t0 = Tb[e]; if ((s1 >> 16) == e) t1 = Tb[e]; }
            const bf16_t* y0 = (const bf16_t*)(F.ws + WS_BUF) + (size_t)(256 * t0 + (s0 & 0xffff)) * DM;
            const bf16_t* y1 = (const bf16_t*)(F.ws + WS_BUF) + (size_t)(256 * t1 + (s1 & 0xffff)) * DM;
            const float* g2 = cl >= 0 ? F.mod + ((size_t)cl * NB + b) * 6144 + 5 * DM : (const float*)(F.ws + 512 * 1024);
#pragma unroll
            for (int j = 0; j < 4; ++j) { const int col = 4 * F.lane + 256 * j; const u32x2 a = *(const u32x2*)(y0 + col), c = *(const u32x2*)(y1 + col); const f32x4 g = *(const f32x4*)(g2 + col);
                v[j][0] += g[0] * (bflo(a.x) + bflo(c.x)); v[j][1] += g[1] * (bfhi(a.x) + bfhi(c.x)); v[j][2] += g[2] * (bflo(a.y) + bflo(c.y)); v[j][3] += g[3] * (bfhi(a.y) + bfhi(c.y)); }
        }
        if (FLAGS & 3) { GAS f32x4* xo = (GAS f32x4*)(F.out + (size_t)row * DM) + F.lane;
#pragma unroll
            for (int j = 0; j < 4; ++j) xo[64 * j] = v[j]; }
        if (FLAGS & 4) {
            float ss = 0.f;
#pragma unroll
            for (int j = 0; j < 4; ++j) ss += (v[j][0] * v[j][0] + v[j][1] * v[j][1]) + (v[j][2] * v[j][2] + v[j][3] * v[j][3]);
            const float r = 1.0f / sqrtf(wave_sum(ss) * (1.0f / DM) + EPS);
            const float* sh = F.mod + ((size_t)nl * NB + b) * 6144 + (ns ? 3 : 0) * DM; const float* sc = sh + DM;
            GAS u32x2* ho = (GAS u32x2*)(F.HB + (size_t)row * DM) + F.lane;
#pragma unroll
            for (int j = 0; j < 4; ++j) { const int col = 4 * F.lane + 256 * j; const f32x4 g = *(const f32x4*)(ng + col), s1 = *(const f32x4*)(sc + col), s0 = *(const f32x4*)(sh + col);
                v[j] = (v[j] * r) * g * (s1 + 1.0f) + s0; u32x2 w; w.x = pk2(v[j][0], v[j][1]); w.y = pk2(v[j][2], v[j][3]); ho[64 * j] = w; }
            if (FLAGS & 8) {
                float lg[8];
#pragma unroll
                for (int e = 0; e < 8; ++e) { float s = 0.f;
#pragma unroll
                    for (int j = 0; j < 4; ++j) { const f32x4 w = *(const LAS f32x4*)(rwt + e * DM + 4 * F.lane + 256 * j); s += (v[j][0] * w[0] + v[j][1] * w[1]) + (v[j][2] * w[2] + v[j][3] * w[3]); }
                    lg[e] = wave_sum(s) + A.in[I_RB][rl * NEXP + e]; }
                int e0 = 0; float l0 = lg[0];
#pragma unroll
                for (int e = 1; e < 8; ++e) if (lg[e] > l0) { l0 = lg[e]; e0 = e; }
                int e1 = -1; float l1 = -3.0e38f;
#pragma unroll
                for (int e = 0; e < 8; ++e) if (e != e0 && lg[e] > l1) { l1 = lg[e]; e1 = e; }
                const float g0 = 1.0f / (1.0f + __expf(l1 - l0)), g1 = 1.0f - g0;
                const int lr = F.wave * 8 + (it & 7);
                if (F.lane == 0) { rE[lr] = e0; rE[64 + lr] = e1; rE[128 + lr] = __float_as_int(g0); rE[192 + lr] = __float_as_int(g1); }
            }
        }
        if (RT && (it & 7) == 7) {
            __syncthreads();
            if (F.tid < 8) { int cnt = 0; for (int q = 0; q < 64; ++q) cnt += (rE[q] == F.tid) + (rE[64 + q] == F.tid);
                rE[256 + F.tid] = cnt ? (int)__hip_atomic_fetch_add(F.ctl + CW_CNT + 64 * (8 * cs + F.tid), (unsigned)cnt, RLX_AGENT) : 0; }
            __syncthreads();
            if (F.tid < 64) { const int e0 = rE[F.tid], e1 = rE[64 + F.tid]; int r0 = 0, r1 = 0;
                for (int q = 0; q < F.tid; ++q) { r0 += (rE[q] == e0) + (rE[64 + q] == e0); r1 += (rE[q] == e1) + (rE[64 + q] == e1); }
                const int p0 = rE[256 + e0] + r0, p1 = rE[256 + e1] + r1, grow = chunk * 64 + F.tid;
                gu32* ri = (gu32*)(F.ws + roff + WS_ROWIDX); gu32* gp = (gu32*)(F.ws + roff + WS_GATEP); gu32* sl = (gu32*)(F.ws + roff + WS_SLOT);
                __hip_atomic_store(ri + e0 * 16384 + p0, (unsigned)grow, RLX_AGENT); __hip_atomic_store(ri + e1 * 16384 + p1, (unsigned)grow, RLX_AGENT);
                __hip_atomic_store(gp + e0 * 16384 + p0, (unsigned)rE[128 + F.tid], RLX_AGENT); __hip_atomic_store(gp + e1 * 16384 + p1, (unsigned)rE[192 + F.tid], RLX_AGENT);
                __hip_atomic_store(sl + grow * 2, (unsigned)((e0 << 16) | p0), RLX_AGENT); __hip_atomic_store(sl + grow * 2 + 1, (unsigned)((e1 << 16) | p1), RLX_AGENT); }
            __syncthreads();
        }
    }
}

__device__ __forceinline__ void unpack8(const u32x4 w, float (&f)[8]) { f[0] = bflo(w.x); f[1] = bfhi(w.x); f[2] = bflo(w.y); f[3] = bfhi(w.y); f[4] = bflo(w.z); f[5] = bfhi(w.z); f[6] = bflo(w.w); f[7] = bfhi(w.w); }
__device__ __forceinline__ void conv_phase(Frame& F, const float* cw  ) {
    const int gw = F.vcu * NWAVES + F.wave, NGW = F.G * NWAVES;
    const bf16_t* UB = F.BUF;
    for (int task = gw; task < M / 8; task += NGW) {
        const int r0 = task * 8; const bool first = (r0 % SEQ) == 0;
#pragma unroll
        for (int j = 0; j < 2; ++j) {
            const int ch = 8 * F.lane + 512 * j;
            float w0[8], w1[8], w2[8];
#pragma unroll
            for (int e = 0; e < 8; ++e) { w0[e] = cw[ch + e]; w1[e] = cw[DM + ch + e]; w2[e] = cw[2 * DM + ch + e]; }
            float um2[8], um1[8];
            if (first) {
#pragma unroll
                for (int e = 0; e < 8; ++e) { um2[e] = 0.f; um1[e] = 0.f; }
            } else { unpack8(*(const u32x4*)(UB + (size_t)(r0 - 2) * 2048 + ch), um2); unpack8(*(const u32x4*)(UB + (size_t)(r0 - 1) * 2048 + ch), um1); }
#pragma unroll
            for (int i = 0; i < 8; ++i) {
                float u0[8], bb[8]; unpack8(*(const u32x4*)(UB + (size_t)(r0 + i) * 2048 + ch), u0); unpack8(*(const u32x4*)(UB + (size_t)(r0 + i) * 2048 + 1024 + ch), bb);
                float z[8];
#pragma unroll
                for (int e = 0; e < 8; ++e) z[e] = bb[e] * (w0[e] * um2[e] + w1[e] * um1[e] + w2[e] * u0[e]);
                u32x4 o; o.x = pk2(z[0], z[1]); o.y = pk2(z[2], z[3]); o.z = pk2(z[4], z[5]); o.w = pk2(z[6], z[7]);
                *(u32x4*)(F.HB + (size_t)(r0 + i) * DM + ch) = o;
#pragma unroll
                for (int e = 0; e < 8; ++e) { um2[e] = um1[e]; um1[e] = u0[e]; }
            }
        }
    }
}

constexpr int QIP = 1040;
constexpr int AL_QI = 0, AL_WI = 33280, AL_SEL = 34304, AL_V = 42496, AL_BIASD = 108032, AL_SUM = 116288, AL_END = 116800;
typedef short v4i16_t __attribute__((ext_vector_type(4)));
__device__ __forceinline__ unsigned okey(float f) { const unsigned u = __float_as_uint(f); return u ^ ((u >> 31) ? 0xFFFFFFFFu : 0x80000000u); }
__device__ __forceinline__ void attn_phase(Frame& F, const Args& A) {
    LAS unsigned char* L = F.lds;
    const bf16_t* Qb = (const bf16_t*)(F.ws + WS_Q); const bf16_t* Kb = (const bf16_t*)(F.ws + WS_K); const bf16_t* Vb = (const bf16_t*)(F.ws + WS_V);
    const bf16_t* QIb = (const bf16_t*)(F.ws + WS_QI); const bf16_t* KIb = (const bf16_t*)(F.ws + WS_KI); const float* WIb = (const float*)(F.ws + WS_WI);
    bf16_t* Ob = (bf16_t*)(F.ws + WS_O);
    float* SC = (float*)(F.ws + WS_SC) + (size_t)blockIdx.x * 32 * SEQ;
    const int lane = F.lane, wave = F.wave;
    { LAS float* bd = (LAS float*)(L + AL_BIASD);
      for (int i = F.tid; i < 129 * 16; i += NTHREADS) { const int d = i >> 4; int bkt; if (d < 16) bkt = d; else { const float dd = (float)d; const int lg2 = 16 + (int)(logf(dd / 16.0f) / 2.0794415416798357f * 16.0f); bkt = lg2 < 31 ? lg2 : 31; }
          bd[i] = A.in[I_RELB][bkt * 16 + (i & 15)]; }
    }
    __syncthreads();
    for (int pass = 0; pass < 2; ++pass) {
        const int un = pass == 0 ? (int)blockIdx.x : 511 - (int)blockIdx.x;
        for (int uu = un; uu >= 0 && uu < 512; uu += (pass == 0 ? F.G * 2 : -F.G * 2)) {
        if ((pass == 0 && uu >= 256) || (pass == 1 && uu < 256)) break;
        const int b = uu & 3, qb = uu >> 2, t0 = qb * 32; const size_t rb = (size_t)b * SEQ;
        for (int i = F.tid; i < 32 * 64; i += NTHREADS) { const int q = i >> 6, c = i & 63; *(LAS u32x4*)(L + AL_QI + q * QIP + c * 16) = *(const u32x4*)(QIb + (rb + t0 + q) * 512 + c * 8); }
        if (F.tid < 256) ((LAS float*)(L + AL_WI))[F.tid] = WIb[(rb + t0) * 8 + F.tid];
        __syncthreads();
        {
            for (int kt = wave; kt <= qb; kt += NWAVES) {
                int ln1 = lane; asm volatile("" : "+v"(ln1));
                const int r = ln1 & 31, hh = ln1 >> 5;
                float wi[8];
#pragma unroll
                for (int h = 0; h < 8; ++h) wi[h] = ((LAS float*)(L + AL_WI))[r * 8 + h];
                bf16x8 ka[4];
#pragma unroll
                for (int ks = 0; ks < 4; ++ks) ka[ks] = *(const bf16x8*)(KIb + (rb + kt * 32 + r) * 64 + 16 * ks + 8 * hh);
                f32x16 sc;
#pragma unroll
                for (int i = 0; i < 16; ++i) sc[i] = 0.f;
#pragma unroll
                for (int h = 0; h < 8; ++h) {
                    f32x16 d;
#pragma unroll
                    for (int i = 0; i < 16; ++i) d[i] = 0.f;
#pragma unroll
                    for (int ks = 0; ks < 4; ++ks) { const bf16x8 qf = *(const LAS bf16x8*)(L + AL_QI + r * QIP + (h * 64 + 16 * ks + 8 * hh) * 2); d = __builtin_amdgcn_mfma_f32_32x32x16_bf16(ka[ks], qf, d, 0, 0, 0); }
#pragma unroll
                    for (int i = 0; i < 16; ++i) sc[i] += wi[h] * fmaxf(d[i], 0.f);
                }
#pragma unroll
                for (int a = 0; a < 4; ++a) { f32x4 o;
#pragma unroll
                    for (int e = 0; e < 4; ++e) { const int krow = 8 * a + 4 * hh + e; o[e] = (kt == qb && krow > r) ? -INFINITY : sc[4 * a + e]; }
                    *(f32x4*)(SC + (size_t)r * SEQ + kt * 32 + 8 * a + 4 * hh) = o; }
            }
        }
        VM_WAIT(); __syncthreads();
        for (int qq = 0; qq < 4; ++qq) {
            const int c = wave + 8 * qq, t = t0 + c; const int nvalid = t + 1;
            int lane = F.lane; asm volatile("" : "+v"(lane));
            LAS int* sel = (LAS int*)(L + AL_SEL) + wave * 256;
            int count;
            if (nvalid <= TOPK) {
                count = nvalid;
#pragma unroll
                for (int j = 0; j < 4; ++j) { const int idx = 64 * j + lane; sel[idx] = idx < nvalid ? idx : 0; }
            } else {
                count = TOPK;
                const int nj = (nvalid + 63) >> 6;
                unsigned key[64];
                const float* srow = SC + (size_t)c * SEQ;
#define SEL_GROUPS(BODY) do { BODY(0) if (nj > 16) { BODY(1) if (nj > 32) { BODY(2) if (nj > 48) { BODY(3) } } } } while (0)
#define SEL_LOAD(g) { _Pragma("unroll") for (int j = 16 * (g); j < 16 * (g) + 16; ++j) { const int idx = 64 * j + lane; const float sv = __uint_as_float(__hip_atomic_load((const gu32*)(srow + idx), RLX_AGENT)); key[j] = idx <= t ? okey(sv) : 0u;     } }
#pragma unroll
                for (int j = 0; j < 64; ++j) key[j] = 0u;
                SEL_GROUPS(SEL_LOAD);
                unsigned T = 0u;
                for (int bit = 31; bit >= 0; --bit) {
                    const unsigned cand = T | (1u << bit); int cnt = 0;
#define SEL_CNT(g) { _Pragma("unroll") for (int j = 16 * (g); j < 16 * (g) + 16; ++j) cnt += __popcll(__ballot(key[j] >= cand)); }
                    SEL_GROUPS(SEL_CNT);
                    if (cnt >= TOPK) T = cand;
                    if (cnt == TOPK) break;
                }
                int base = 0;
#define SEL_GT(g) { _Pragma("unroll") for (int j = 16 * (g); j < 16 * (g) + 16; ++j) { const bool gt = key[j] > T; const unsigned long long mk = __ballot(gt); \
                    const int pos = base + (int)__builtin_amdgcn_mbcnt_hi((unsigned)(mk >> 32), __builtin_amdgcn_mbcnt_lo((unsigned)mk, 0u)); if (gt) sel[pos] = 64 * j + lane; base += __popcll(mk); } }
                SEL_GROUPS(SEL_GT);
                const int need = TOPK - base; int eb = 0;
#define SEL_EQ(g) { _Pragma("unroll") for (int j = 16 * (g); j < 16 * (g) + 16; ++j) { const bool eq = key[j] == T; const unsigned long long mk = __ballot(eq); \
                    const int rank = eb + (int)__builtin_amdgcn_mbcnt_hi((unsigned)(mk >> 32), __builtin_amdgcn_mbcnt_lo((unsigned)mk, 0u)); if (eq && rank < need) sel[base + rank] = 64 * j + lane; eb += __popcll(mk); } }
                SEL_GROUPS(SEL_EQ);
#undef SEL_GROUPS
#undef SEL_LOAD
#undef SEL_CNT
#undef SEL_GT
#undef SEL_EQ
            }
            LDS_WAIT(); CFENCE();
            asm volatile("" : "+v"(lane));
            const int hd = lane & 15, kq = lane >> 4;
            bf16x8 bq[8];
            { bf16x8 qf[2];
#pragma unroll
              for (int s2 = 0; s2 < 2; ++s2) qf[s2] = *(const bf16x8*)(Qb + (rb + t) * 1024 + hd * 64 + 32 * s2 + 8 * kq);
              const bf16x8 zf = (bf16x8){0, 0, 0, 0, 0, 0, 0, 0};
#pragma unroll
              for (int ks = 0; ks < 8; ++ks) bq[ks] = ((ks >> 1) == (hd >> 2)) ? qf[ks & 1] : zf; }
            f32x4 lg[16];
            float mx = -INFINITY;
            bf16x8 kf[3][8];
#pragma unroll
            for (int pre = 0; pre < 2; ++pre) { const int krow = sel[16 * pre + hd]; const bf16_t* kp = Kb + (rb + krow) * 256 + 8 * kq;
#pragma unroll
              for (int ks = 0; ks < 8; ++ks) kf[pre][ks] = *(const bf16x8*)(kp + 32 * ks); }
            const LAS float* biasd = (const LAS float*)(L + AL_BIASD);
#pragma unroll
            for (int kt = 0; kt < 16; ++kt) {
                if (kt < 14) { const int krow = sel[16 * (kt + 2) + hd]; const bf16_t* kp = Kb + (rb + krow) * 256 + 8 * kq;
#pragma unroll
                    for (int ks = 0; ks < 8; ++ks) kf[(kt + 2) % 3][ks] = *(const bf16x8*)(kp + 32 * ks); }
                f32x4 d = (f32x4){0.f, 0.f, 0.f, 0.f};
#pragma unroll
                for (int ks = 0; ks < 8; ++ks) d = __builtin_amdgcn_mfma_f32_16x16x32_bf16(kf[kt % 3][ks], bq[ks], d, 0, 0, 0);
                const u32x4 ks4 = *(const LAS u32x4*)(sel + 16 * kt + 4 * kq);
#pragma unroll
                for (int i = 0; i < 4; ++i) { const int pos = 16 * kt + 4 * kq + i; int dist = t - (int)ks4[i]; dist = dist < 0 ? 0 : (dist > 128 ? 128 : dist);
                    const float bs = biasd[dist * 16 + hd];
                    d[i] = pos < count ? d[i] + bs : -INFINITY; mx = fmaxf(mx, d[i]); }
                lg[kt] = d;
            }
            mx = fmaxf(mx, __shfl_xor(mx, 16)); mx = fmaxf(mx, __shfl_xor(mx, 32));
            float sum = 0.f;
            bf16x8 pa[8];
#pragma unroll
            for (int ks = 0; ks < 8; ++ks) { float p[8];
#pragma unroll
                for (int i = 0; i < 4; ++i) { p[i] = __expf(lg[2 * ks][i] - mx); p[4 + i] = __expf(lg[2 * ks + 1][i] - mx); }
                sum += ((p[0] + p[1]) + (p[2] + p[3])) + ((p[4] + p[5]) + (p[6] + p[7]));
                u32x4 w; w.x = cvt_pk_bf16(p[0], p[1]); w.y = cvt_pk_bf16(p[2], p[3]); w.z = cvt_pk_bf16(p[4], p[5]); w.w = cvt_pk_bf16(p[6], p[7]);
                pa[ks] = __builtin_bit_cast(bf16x8, w); }
            sum += __shfl_xor(sum, 16); sum += __shfl_xor(sum, 32);
            if (kq == 0) ((LAS float*)(L + AL_SUM))[wave * 16 + hd] = sum;
            LDS_WAIT(); CFENCE();
            {
                asm volatile("" : "+v"(lane));
                const int rs = lane >> 3, ch = lane & 7, i16 = lane & 15, tq = i16 >> 2, tp = i16 & 3, kq2 = lane >> 4;
                LAS unsigned char* vb = L + AL_V + wave * 8192;
                const unsigned wr_off = (unsigned)lane * 16u, tr_off = (unsigned)((4 * kq2 + tq) * 128 + 8 * tp);
                f32x4 O[4][4];
#pragma unroll
                for (int n = 0; n < 4; ++n)
#pragma unroll
                    for (int dt = 0; dt < 4; ++dt) O[n][dt] = (f32x4){0.f, 0.f, 0.f, 0.f};
                u32x4 vr[2][4]; int kr[4];
                const bf16_t* vbase = Vb + rb * 256 + 8 * ch;
#pragma unroll
                for (int i = 0; i < 4; ++i) kr[i] = sel[8 * i + rs];
#pragma unroll
                for (int pre = 0; pre < 2; ++pre)
#pragma unroll
                    for (int i = 0; i < 4; ++i) vr[pre][i] = *(const u32x4*)(vbase + (size_t)kr[i] * 256 + pre * 64);
#pragma unroll
                for (int st = 0; st < 32; ++st) {
                    const int ks = st >> 2, n = st & 3;
                    LAS unsigned char* buf = vb + (st & 1) * 4096;
#pragma unroll
                    for (int i = 0; i < 4; ++i) *(LAS u32x4*)(buf + wr_off + i * 1024) = vr[st & 1][i];
                    if (st < 30) { const int ks2 = (st + 2) >> 2, n2 = (st + 2) & 3;
                        if (n2 == 0) {
#pragma unroll
                            for (int i = 0; i < 4; ++i) kr[i] = sel[32 * ks2 + 8 * i + rs]; }
#pragma unroll
                        for (int i = 0; i < 4; ++i) vr[st & 1][i] = *(const u32x4*)(vbase + (size_t)kr[i] * 256 + n2 * 64); }
#pragma unroll
                    for (int dt = 0; dt < 4; ++dt) {
                        const v4i16_t t0 = __builtin_amdgcn_ds_read_tr16_b64_v4i16((LAS v4i16_t*)(buf + tr_off + 32 * dt));
                        const v4i16_t t1 = __builtin_amdgcn_ds_read_tr16_b64_v4i16((LAS v4i16_t*)(buf + tr_off + 2048 + 32 * dt));
                        const bf16x8 bfr = (bf16x8){t0[0], t0[1], t0[2], t0[3], t1[0], t1[1], t1[2], t1[3]};
                        O[n][dt] = __builtin_amdgcn_mfma_f32_16x16x32_bf16(pa[ks], bfr, O[n][dt], 0, 0, 0); }
                    CFENCE();
                }
                const f32x4 sm = *(const LAS f32x4*)(L + AL_SUM + (wave * 16 + 4 * kq2) * 4);
                bf16_t* op = Ob + (rb + t) * 1024 + (4 * kq2) * 64 + i16;
#pragma unroll
                for (int dt = 0; dt < 4; ++dt)
#pragma unroll
                    for (int i = 0; i < 4; ++i) { const float v = kq2 == 0 ? O[0][dt][i] : (kq2 == 1 ? O[1][dt][i] : (kq2 == 2 ? O[2][dt][i] : O[3][dt][i]));
                        op[i * 64 + 16 * dt] = (bf16_t)f2bf(v / sm[i]); }
            }
            LDS_WAIT(); CFENCE();
        }
        __syncthreads();
        }
    }
}

constexpr int SL_BMT = 0;
constexpr int SL_CMA = 4096;
constexpr int SL_AB = 12288;
constexpr int SL_E = 12800;
constexpr int SL_S = 16896;
constexpr int SPITCH = 272;
__device__ __forceinline__ void cmul(float ar, float ai, float br, float bi, float& cr, float& ci) { cr = ar * br - ai * bi; ci = ar * bi + ai * br; }
__device__ __forceinline__ void ssm_phase(Frame& F, const Args& A) {
    LAS unsigned char* L = F.lds;
    const int lane = F.lane, wave = F.wave;
    bf16_t* G = (bf16_t*)(F.ws + WS_ACT);
    for (int un = blockIdx.x; un < NB * 64; un += F.G) {
        const int b = un >> 6, g = un & 63; const size_t rb = (size_t)b * SEQ;
        __syncthreads();
        if (F.tid < 64) {
            const int p = F.tid;
            const float lr = fminf(A.in[I_SLRE][g * 64 + p], -1e-4f), li = A.in[I_SLIM][g * 64 + p];
            const float step = expf(A.in[I_SLOG][g]);
            const float mag = expf(lr * step); float sn, cs; sincosf(li * step, &sn, &cs);
            const float ar = mag * cs, ai = mag * sn;
            ((LAS float*)(L + SL_AB))[2 * p] = ar; ((LAS float*)(L + SL_AB))[2 * p + 1] = ai;
            const float nr = ar - 1.0f, ni = ai, den = lr * lr + li * li;
            const float cr = (nr * lr + ni * li) / den, ci = (ni * lr - nr * li) / den;
            LAS bf16_t* bm = (LAS bf16_t*)(L + SL_BMT);
#pragma unroll
            for (int c = 0; c < 16; ++c) { const float br = A.in[I_SBRE][((size_t)g * 64 + p) * 16 + c], bi = A.in[I_SBIM][((size_t)g * 64 + p) * 16 + c];
                float xr, xi; cmul(cr, ci, br, bi, xr, xi); bm[p * 16 + c] = (bf16_t)f2bf(xr); bm[(64 + p) * 16 + c] = (bf16_t)f2bf(xi); }
        }
        { LAS bf16_t* cm = (LAS bf16_t*)(L + SL_CMA);
          for (int i = F.tid; i < 32 * 128; i += NTHREADS) { const int c = i >> 7, k = i & 127; float v = 0.f;
              if (c < 16) v = (k < 64) ? A.in[I_SCRE][((size_t)g * 16 + c) * 64 + k] : -A.in[I_SCIM][((size_t)g * 16 + c) * 64 + (k - 64)];
              cm[i] = (bf16_t)f2bf(v); } }
        __syncthreads();
        const int r = lane & 31, hh = lane >> 5;
        bf16x8 bfr[4];
#pragma unroll
        for (int n = 0; n < 4; ++n) bfr[n] = *(const LAS bf16x8*)(L + SL_BMT + ((32 * n + r) * 16 + 8 * hh) * 2);
        bf16x8 cfr[8];
#pragma unroll
        for (int ks = 0; ks < 8; ++ks) cfr[ks] = *(const LAS bf16x8*)(L + SL_CMA + (r * 128 + 16 * ks + 8 * hh) * 2);
        float ar[2], ai[2], a16r[2], a16i[2], a512r[2], a512i[2];
#pragma unroll
        for (int s = 0; s < 2; ++s) { ar[s] = ((LAS float*)(L + SL_AB))[2 * (32 * s + r)]; ai[s] = ((LAS float*)(L + SL_AB))[2 * (32 * s + r) + 1];
            float pr = ar[s], pi = ai[s];
#pragma unroll
            for (int q = 0; q < 4; ++q) { float nr, ni; cmul(pr, pi, pr, pi, nr, ni); pr = nr; pi = ni; }
            a16r[s] = pr; a16i[s] = pi;
#pragma unroll
            for (int q = 0; q < 5; ++q) { float nr, ni; cmul(pr, pi, pr, pi, nr, ni); pr = nr; pi = ni; }
            a512r[s] = pr; a512i[s] = pi; }
        const int tokperm = 16 * ((r >> 2) & 1) + 4 * (r >> 3) + (r & 3);
        const float dsk0 = 0.f; (void)dsk0;
        float cin_r[2] = {0.f, 0.f}, cin_i[2] = {0.f, 0.f};
        LAS unsigned char* Sw = L + SL_S + wave * (32 * SPITCH);
        for (int pass = 0; pass < 2; ++pass) {
            if (pass == 1) {
                __syncthreads();
#pragma unroll
                for (int s = 0; s < 2; ++s) { float cr = 0.f, ci = 0.f;
                    for (int w = 0; w < wave; ++w) { float nr, ni; cmul(a512r[s], a512i[s], cr, ci, nr, ni); cr = nr + ((LAS float*)(L + SL_E))[(w * 64 + 32 * s + r) * 2]; ci = ni + ((LAS float*)(L + SL_E))[(w * 64 + 32 * s + r) * 2 + 1]; }
                    cin_r[s] = cr; cin_i[s] = ci; }
            }
            bf16x8 ufn = *(const bf16x8*)(F.HB + (rb + wave * 512 + tokperm) * DM + 16 * g + 8 * hh);
            for (int tile = 0; tile < 16; ++tile) {
                const int tk0 = wave * 512 + tile * 32;
                const bf16x8 uf = ufn;
                if (tile < 15) ufn = *(const bf16x8*)(F.HB + (rb + tk0 + 32 + tokperm) * DM + 16 * g + 8 * hh);

                f32x16 d[4];
#pragma unroll
                for (int n = 0; n < 4; ++n) {
#pragma unroll
                    for (int i = 0; i < 16; ++i) d[n][i] = 0.f;
                    d[n] = __builtin_amdgcn_mfma_f32_32x32x16_bf16(uf, bfr[n], d[n], 0, 0, 0); }
#pragma unroll
                for (int s = 0; s < 2; ++s) {
                    float sr = hh == 0 ? cin_r[s] : 0.f, si = hh == 0 ? cin_i[s] : 0.f;
#pragma unroll
                    for (int i = 0; i < 16; ++i) { const float nr = ar[s] * sr - ai[s] * si + d[s][i], ni = ar[s] * si + ai[s] * sr + d[2 + s][i]; sr = nr; si = ni; d[s][i] = sr; d[2 + s][i] = si; }
                    const float e0r = __shfl_xor(sr, 32), e0i = __shfl_xor(si, 32);
                    float cr = hh == 1 ? e0r : 0.f, ci = hh == 1 ? e0i : 0.f;
                    if (pass == 1) {
#pragma unroll
                        for (int i = 0; i < 16; ++i) { float nr, ni; cmul(ar[s], ai[s], cr, ci, nr, ni); cr = nr; ci = ni; d[s][i] += cr; d[2 + s][i] += ci; }
                    } else { float nr, ni; cmul(a16r[s], a16i[s], cr, ci, nr, ni); cr = nr; ci = ni; }
                    const float endr = (pass == 1) ? d[s][15] : sr + cr, endi = (pass == 1) ? d[2 + s][15] : si + ci;
                    const float xr = __shfl_xor(endr, 32), xi = __shfl_xor(endi, 32);
                    cin_r[s] = hh == 1 ? endr : xr; cin_i[s] = hh == 1 ? endi : xi;
                }
                if (pass == 1) {
#pragma unroll
                    for (int s = 0; s < 2; ++s)
#pragma unroll
                        for (int i = 0; i < 16; ++i) { *(LAS bf16_t*)(Sw + (16 * hh + i) * SPITCH + (32 * s + r) * 2) = (bf16_t)f2bf(d[s][i]); *(LAS bf16_t*)(Sw + (16 * hh + i) * SPITCH + (64 + 32 * s + r) * 2) = (bf16_t)f2bf(d[2 + s][i]); }
                    LDS_WAIT(); CFENCE();
                    f32x16 y;
#pragma unroll
                    for (int i = 0; i < 16; ++i) y[i] = 0.f;
#pragma unroll
                    for (int ks = 0; ks < 8; ++ks) { const bf16x8 sf = *(const LAS bf16x8*)(Sw + r * SPITCH + (16 * ks + 8 * hh) * 2); y = __builtin_amdgcn_mfma_f32_32x32x16_bf16(cfr[ks], sf, y, 0, 0, 0); }
                    LDS_WAIT(); CFENCE();
                    const size_t trow = rb + tk0 + r;
#pragma unroll
                    for (int q = 0; q < 2; ++q) { const int ch = 16 * g + 8 * q + 4 * hh;
                        const u32x2 hv = *(const u32x2*)(F.HB + trow * DM + ch); const f32x4 dk = *(const f32x4*)(A.in[I_SD] + ch);
                        const float y0 = gelu_tanh_f(y[4 * q + 0] + dk[0] * bflo(hv.x)), y1 = gelu_tanh_f(y[4 * q + 1] + dk[1] * bfhi(hv.x)), y2 = gelu_tanh_f(y[4 * q + 2] + dk[2] * bflo(hv.y)), y3 = gelu_tanh_f(y[4 * q + 3] + dk[3] * bfhi(hv.y));
                        u32x2 w; w.x = pk2(y0, y1); w.y = pk2(y2, y3); *(u32x2*)(G + trow * DM + ch) = w; }
                }
            }
            if (pass == 0) {
                if (hh == 1) {
#pragma unroll
                    for (int s = 0; s < 2; ++s) { ((LAS float*)(L + SL_E))[(wave * 64 + 32 * s + r) * 2] = cin_r[s]; ((LAS float*)(L + SL_E))[(wave * 64 + 32 * s + r) * 2 + 1] = cin_i[s]; } }
                cin_r[0] = cin_r[1] = cin_i[0] = cin_i[1] = 0.f;
            }
        }
    }
}

enum { PH_PRO = 0, PH_NORM0,
       L0_G1, L0_CONV, L0_G2, L0_NORM, L0_F1, L0_F2, L0_NORMN,
       L1_G1, L1_ATTN, L1_G2, L1_NORMR, L1_M1, L1_M2, L1_COMB,
       L2_SSM, L2_G2, L2_NORM, L2_F1, L2_F2, L2_NORMN,
       L3_G1, L3_CONV, L3_G2, L3_NORMR, L3_M1, L3_M2, L3_COMB, NPH };

__global__ void __launch_bounds__(NTHREADS, 2) mega_fwd(Args args) {
    extern __shared__ __attribute__((aligned(16))) unsigned char lds_raw[];
    Frame F;
    F.lds = (LAS unsigned char*)lds_raw;
    volatile LAS unsigned* MISC = (volatile LAS unsigned*)(F.lds + MISC_OFF);
    F.tid = threadIdx.x; F.lane = F.tid & 63; F.wave = __builtin_amdgcn_readfirstlane(F.tid >> 6);
    F.G = gridDim.x; { const int bx = blockIdx.x; F.vcu = (F.G % 8 == 0) ? (bx % 8) * (F.G / 8) + bx / 8 : bx; }
    F.ws = args.ws; F.ctl = (gu32*)(args.ws + WS_CTL); F.out = args.out; F.mod = (const float*)(args.ws + WS_MOD);
    F.HB = (bf16_t*)(args.ws + WS_HB); F.BUF = (bf16_t*)(args.ws + WS_BUF); F.ACT = (bf16_t*)(args.ws + WS_ACT);
    for (int u = F.tid; u < (LDS_BYTES - LDSCTL_OFF) / 4; u += NTHREADS) ((LAS unsigned*)(F.lds + LDSCTL_OFF))[u] = 0u;
    __syncthreads();
    XcdBarrier bar; bar.bar = (unsigned*)(F.ctl + CW_BAR); bar.x = 0; bar.st = nullptr;
    const int lo = args.ph_lo, hi = args.ph_hi;
    if (hi - lo > 1) bar = xcd_barrier_post((unsigned*)(F.ctl + CW_BAR), MISC + 8);
#ifndef PH_ONLY
#define PH_EN(k) true
#else
#define PH_EN(k) ((k) == PH_ONLY)
#endif
#define IN(k) (PH_EN(k) && lo <= (k) && (k) < hi)
#define SEAM(k) do { if (IN(k) && IN((k) + 1)) xcd_barrier(bar); } while (0)
#ifndef PH_REP
#define PH_REP (-1)
#endif
#ifndef PH_REPMASK
#define PH_REPMASK 0ull
#endif
#define REPB(k, ...) do { if (PH_REP == (k) || ((PH_REPMASK >> (k)) & 1ull)) { xcd_barrier(bar); __VA_ARGS__; } } while (0)
    LAS unsigned char* ring = F.lds;
    const int cid = (int)blockIdx.x;
    bf16_t* const WCI = (bf16_t*)(F.ws + WS_WCI); bf16_t* const WCO = (bf16_t*)(F.ws + WS_WCO); bf16_t* const WAI = (bf16_t*)(F.ws + WS_WAI); bf16_t* const WAO = (bf16_t*)(F.ws + WS_WAO);
    bf16_t* const WGL = (bf16_t*)(F.ws + WS_WGL); bf16_t* const WFG = (bf16_t*)(F.ws + WS_WFG); bf16_t* const WFD = (bf16_t*)(F.ws + WS_WFD); bf16_t* const WMG = (bf16_t*)(F.ws + WS_WMG); bf16_t* const WMD = (bf16_t*)(F.ws + WS_WMD);

#define ZEROG ((const float*)(F.ws + 512 * 1024))
    const bool fuse = (F.G == 256);
#define FUSED_EPI(inst, gatep, xin, nl, ns, hout) ({F.out, (gatep), (xin), args.in[I_NORMG] + (size_t)((nl) * 2 + (ns)) * DM, F.mod + (size_t)(nl) * NB * 6144 + ((ns) ? 3 : 0) * DM, (hout), (float*)(F.ws + WS_XS), F.ctl + CW_PAN + 64 * 64 * (inst), F.ctl + CW_TMO})
#define FUSED_RT(inst, gatep, nl, rl, roff, hout) ({F.out, (gatep), args.in[I_NORMG] + (size_t)((nl) * 2 + 1) * DM, F.mod + (size_t)(nl) * NB * 6144 + 3 * DM, (hout), (float*)(F.ws + WS_XS9), F.ctl + CW_PAN + 64 * 64 * (inst), F.ctl + CW_TMO, \
        args.in[I_RW] + (size_t)(rl) * DM * NEXP, args.in[I_RB] + (rl) * NEXP, F.ctl + CW_CNT + 64 * 8 * (rl), F.ws + (roff)})
#define MODP(l, chunk) (F.mod + (size_t)(l) * NB * 6144 + (chunk) * DM)
#define GEMM_STATIC(Aptr, Bptr, Nn, Kk, EpiT, EpiInit) do { pg8::Gemm g{(Aptr), (Bptr), M, (Nn), (Kk), 0, nullptr, nullptr}; pg8::StaticOrder S; S.init(M, (Nn), F.G, cid); EpiT E EpiInit; \
        pg8::gemm_phase<EpiT, pg8::StaticOrder, false>(ring, g, S, E); } while (0)

    if (IN(PH_PRO)) { p0_prologue(F, args); REPB(PH_PRO, p0_prologue(F, args)); } SEAM(PH_PRO);
    if (IN(PH_NORM0)) { thin_phase<4>(F, args, args.in[I_X], 0, 0, 0, 0); REPB(PH_NORM0, thin_phase<4>(F, args, args.in[I_X], 0, 0, 0, 0)); } SEAM(PH_NORM0);

    if (IN(L0_G1)) { GEMM_STATIC(F.HB, WCI, 3072, DM, pg8::EpiConvIn, {F.BUF}); REPB(L0_G1, GEMM_STATIC(F.HB, WCI, 3072, DM, pg8::EpiConvIn, {F.BUF})); } SEAM(L0_G1);
    if (IN(L0_CONV)) { conv_phase(F, args.in[I_CW]); REPB(L0_CONV, conv_phase(F, args.in[I_CW])); } SEAM(L0_CONV);
    if (IN(L0_G2)) { if (fuse) GEMM_STATIC(F.HB, WCO, DM, DM, pg8::EpiResNorm, FUSED_EPI(0, MODP(0, 2), args.in[I_X], 0, 1, (fuse ? F.BUF : F.HB))); else GEMM_STATIC(F.HB, WCO, DM, DM, pg8::EpiRes, ({F.out, MODP(0, 2), args.in[I_X]})); } SEAM(L0_G2);
    if (!fuse) { if (IN(L0_NORM)) { thin_phase<4>(F, args, F.out, 0, 1, 0, 0); } SEAM(L0_NORM); }
    if (IN(L0_F1)) { GEMM_STATIC((fuse ? F.BUF : F.HB), WFG, 2 * FF, DM, pg8::EpiPair<1>, ({F.ACT, FF})); REPB(L0_F1, GEMM_STATIC(F.HB, WFG, 2 * FF, DM, pg8::EpiPair<1>, ({F.ACT, FF}))); } SEAM(L0_F1);
    if (IN(L0_F2)) { if (fuse) GEMM_STATIC(F.ACT, WFD, DM, FF, pg8::EpiResNorm, FUSED_EPI(1, MODP(0, 5), F.out, 1, 0, F.HB)); else GEMM_STATIC(F.ACT, WFD, DM, FF, pg8::EpiRes, ({F.out, MODP(0, 5), F.out})); } SEAM(L0_F2);
    if (!fuse) { if (IN(L0_NORMN)) { thin_phase<4>(F, args, F.out, 1, 0, 0, 0); } SEAM(L0_NORMN); }

    if (IN(L1_G1)) { GEMM_STATIC(F.HB, WAI, ATT_NP, DM, pg8::EpiAttnIn, ({(bf16_t*)(F.ws + WS_Q), (bf16_t*)(F.ws + WS_K), (bf16_t*)(F.ws + WS_V), (bf16_t*)(F.ws + WS_QI), (bf16_t*)(F.ws + WS_KI), (float*)(F.ws + WS_WI), args.in[I_QG], args.in[I_KG]})); REPB(L1_G1, GEMM_STATIC(F.HB, WAI, ATT_NP, DM, pg8::EpiAttnIn, ({(bf16_t*)(F.ws + WS_Q), (bf16_t*)(F.ws + WS_K), (bf16_t*)(F.ws + WS_V), (bf16_t*)(F.ws + WS_QI), (bf16_t*)(F.ws + WS_KI), (float*)(F.ws + WS_WI), args.in[I_QG], args.in[I_KG]}))); } SEAM(L1_G1);
    if (IN(L1_ATTN)) { attn_phase(F, args); REPB(L1_ATTN, attn_phase(F, args)); } SEAM(L1_ATTN);
    if (IN(L1_G2)) { if (fuse) GEMM_STATIC((bf16_t*)(F.ws + WS_O), WAO, DM, DM, pg8::EpiResNormRouter, FUSED_RT(3, MODP(1, 2), 1, 0, 0, F.HB)); else GEMM_STATIC((bf16_t*)(F.ws + WS_O), WAO, DM, DM, pg8::EpiRes, ({F.out, MODP(1, 2), F.out})); } SEAM(L1_G2);
    if (!fuse) { if (IN(L1_NORMR)) { thin_phase<4 | 8>(F, args, F.out, 1, 1, 0, 0); } SEAM(L1_NORMR); }
    if (IN(L1_M1)) { pg8::Gemm g{F.HB, WMG, M, 2 * FF, DM, (size_t)2 * FF * DM * 2, (const int*)(F.ws + WS_ROWIDX), (const unsigned*)(F.ctl + CW_CNT)}; pg8::MoeOrder S; S.init((const unsigned*)(F.ctl + CW_CNT), 22, F.G, cid);
        pg8::EpiPair<1> E{F.ACT, FF}; pg8::gemm_phase<pg8::EpiPair<1>, pg8::MoeOrder, true>(ring, g, S, E); REPB(L1_M1, pg8::gemm_phase<pg8::EpiPair<1>, pg8::MoeOrder, true>(ring, g, S, E)); } SEAM(L1_M1);
    if (IN(L1_M2)) { pg8::Gemm g{F.ACT, WMD, M, DM, FF, (size_t)DM * FF * 2, nullptr, nullptr}; pg8::MoeOrder S; S.init((const unsigned*)(F.ctl + CW_CNT), 4, F.G, cid);
        pg8::EpiMoeDn E{F.BUF, (const float*)(F.ws + WS_GATEP)}; pg8::gemm_phase<pg8::EpiMoeDn, pg8::MoeOrder, false>(ring, g, S, E); REPB(L1_M2, pg8::gemm_phase<pg8::EpiMoeDn, pg8::MoeOrder, false>(ring, g, S, E)); } SEAM(L1_M2);
    if (IN(L1_COMB)) { thin_phase<2 | 4>(F, args, F.out, 2, 0, 1, 0); REPB(L1_COMB, thin_phase<2 | 4>(F, args, F.out, 2, 0, -1, 0)); } SEAM(L1_COMB);

    if (IN(L2_SSM)) { ssm_phase(F, args); REPB(L2_SSM, ssm_phase(F, args)); } SEAM(L2_SSM);
    if (IN(L2_G2)) { GEMM_STATIC(F.ACT, WGL, 2048, DM, pg8::EpiGluRes, ({F.out, MODP(2, 2)})); REPB(L2_G2, GEMM_STATIC(F.ACT, WGL, 2048, DM, pg8::EpiGluRes, ({F.out, ZEROG}))); } SEAM(L2_G2);
    if (IN(L2_NORM)) { thin_phase<4>(F, args, F.out, 2, 1, 0, 0); REPB(L2_NORM, thin_phase<4>(F, args, F.out, 2, 1, 0, 0)); } SEAM(L2_NORM);
    if (IN(L2_F1)) { GEMM_STATIC(F.HB, WFG + (size_t)2 * FF * DM, 2 * FF, DM, pg8::EpiPair<1>, ({F.ACT, FF})); REPB(L2_F1, GEMM_STATIC(F.HB, WFG + (size_t)2 * FF * DM, 2 * FF, DM, pg8::EpiPair<1>, ({F.ACT, FF}))); } SEAM(L2_F1);
    if (IN(L2_F2)) { if (fuse) GEMM_STATIC(F.ACT, WFD + (size_t)DM * FF, DM, FF, pg8::EpiResNorm, FUSED_EPI(2, MODP(2, 5), F.out, 3, 0, F.HB)); else GEMM_STATIC(F.ACT, WFD + (size_t)DM * FF, DM, FF, pg8::EpiRes, ({F.out, MODP(2, 5), F.out})); } SEAM(L2_F2);
    if (!fuse) { if (IN(L2_NORMN)) { thin_phase<4>(F, args, F.out, 3, 0, 0, 0); } SEAM(L2_NORMN); }

    if (IN(L3_G1)) { GEMM_STATIC(F.HB, WCI + (size_t)3072 * DM, 3072, DM, pg8::EpiConvIn, {F.BUF}); REPB(L3_G1, GEMM_STATIC(F.HB, WCI + (size_t)3072 * DM, 3072, DM, pg8::EpiConvIn, {F.BUF})); } SEAM(L3_G1);
    if (IN(L3_CONV)) { conv_phase(F, args.in[I_CW] + 3 * DM); REPB(L3_CONV, conv_phase(F, args.in[I_CW] + 3 * DM)); } SEAM(L3_CONV);
    if (IN(L3_G2)) { if (fuse) GEMM_STATIC(F.HB, WCO + (size_t)DM * DM, DM, DM, pg8::EpiResNormRouter, FUSED_RT(4, MODP(3, 2), 3, 1, 2 * MiB, F.BUF)); else GEMM_STATIC(F.HB, WCO + (size_t)DM * DM, DM, DM, pg8::EpiRes, ({F.out, MODP(3, 2), F.out})); } SEAM(L3_G2);
    if (!fuse) { if (IN(L3_NORMR)) { thin_phase<4 | 8>(F, args, F.out, 3, 1, 0, 1, 1, 2 * MiB); } SEAM(L3_NORMR); }
    if (IN(L3_M1)) { pg8::Gemm g{(fuse ? F.BUF : F.HB), WMG + (size_t)8 * 2 * FF * DM, M, 2 * FF, DM, (size_t)2 * FF * DM * 2, (const int*)(F.ws + 2 * MiB + WS_ROWIDX), (const unsigned*)(F.ctl + CW_CNT + 512)}; pg8::MoeOrder S; S.init((const unsigned*)(F.ctl + CW_CNT + 512), 22, F.G, cid);
        pg8::EpiPair<1> E{F.ACT, FF}; pg8::gemm_phase<pg8::EpiPair<1>, pg8::MoeOrder, true>(ring, g, S, E); REPB(L3_M1, pg8::gemm_phase<pg8::EpiPair<1>, pg8::MoeOrder, true>(ring, g, S, E)); } SEAM(L3_M1);
    if (IN(L3_M2)) { pg8::Gemm g{F.ACT, WMD + (size_t)8 * DM * FF, M, DM, FF, (size_t)DM * FF * 2, nullptr, nullptr}; pg8::MoeOrder S; S.init((const unsigned*)(F.ctl + CW_CNT + 512), 4, F.G, cid);
        pg8::EpiMoeDn E{F.BUF, (const float*)(F.ws + 2 * MiB + WS_GATEP)}; pg8::gemm_phase<pg8::EpiMoeDn, pg8::MoeOrder, false>(ring, g, S, E); REPB(L3_M2, pg8::gemm_phase<pg8::EpiMoeDn, pg8::MoeOrder, false>(ring, g, S, E)); } SEAM(L3_M2);
    if (IN(L3_COMB)) { thin_phase<2>(F, args, F.out, 0, 0, 3, 1, 1, 2 * MiB); }
#undef IN
#undef SEAM
}

extern "C" void kernel_launch(void* const* d_in, const int* in_sizes, int n_in, void* d_out, int out_size, void* d_ws, size_t ws_size, hipStream_t stream) {
    static int grid = 0;
    if (grid == 0) {
        if (n_in != 28 || in_sizes[0] != M * DM || out_size != M * DM || ws_size < WS_END) { fprintf(stderr, "kernel_launch: unexpected shapes / workspace (n_in %d, ws %zu, need %zu)\n", n_in, ws_size, (size_t)WS_END); grid = -1; return; }
        int dev = 0, cus = 0, per_cu = 0;
        if (hipGetDevice(&dev) != hipSuccess || hipDeviceGetAttribute(&cus, hipDeviceAttributeMultiprocessorCount, dev) != hipSuccess) { grid = -1; return; }
        if (hipFuncSetAttribute((const void*)mega_fwd, hipFuncAttributeMaxDynamicSharedMemorySize, LDS_BYTES) != hipSuccess) { fprintf(stderr, "kernel_launch: hipFuncSetAttribute failed\n"); grid = -1; return; }
        if (hipOccupancyMaxActiveBlocksPerMultiprocessor(&per_cu, (const void*)mega_fwd, NTHREADS, LDS_BYTES) != hipSuccess || per_cu < 1) fprintf(stderr, "kernel_launch: occupancy query reports %d\n", per_cu);
        (void)hipGetLastError();
        grid = cus;
    }
    if (grid < 0) return;
    (void)hipMemsetAsync((char*)d_ws + WS_CTL, 0, CTL_ZERO_BYTES, stream);
    Args a{};
    for (int i = 0; i < 28; ++i) a.in[i] = (const float*)d_in[i];
    a.out = (float*)d_out; a.ws = (unsigned char*)d_ws;
#if MK_PER_PHASE
    for (int p = 0; p < NPH; ++p) { a.ph_lo = p; a.ph_hi = p + 1; hipLaunchKernelGGL(mega_fwd, dim3(grid), dim3(NTHREADS), LDS_BYTES, stream, a); }
#else
    a.ph_lo = 0; a.ph_hi = NPH; hipLaunchKernelGGL(mega_fwd, dim3(grid), dim3(NTHREADS), LDS_BYTES, stream, a);
#endif
}
```

```cpp
#include <hip/hip_runtime.h>
#include <cstdio>
#include <cstdint>
#include <cmath>

#ifndef MK_PER_PHASE
#define MK_PER_PHASE 0
#endif

#define GAS __attribute__((address_space(1)))
#define LAS __attribute__((address_space(3)))
typedef unsigned short bf16_t;
typedef short bf16x8 __attribute__((ext_vector_type(8)));
typedef float f32x4 __attribute__((ext_vector_type(4)));
typedef float f32x2 __attribute__((ext_vector_type(2)));
typedef float f32x16 __attribute__((ext_vector_type(16)));
typedef unsigned u32x4 __attribute__((ext_vector_type(4)));
typedef unsigned u32x2 __attribute__((ext_vector_type(2)));
typedef GAS unsigned gu32;
#define RLX_AGENT __ATOMIC_RELAXED, __HIP_MEMORY_SCOPE_AGENT
#define LDS_WAIT() asm volatile("s_waitcnt lgkmcnt(0)" ::: "memory")
#define VM_WAIT() asm volatile("s_waitcnt vmcnt(0)" ::: "memory")
#define CFENCE() asm volatile("" ::: "memory")

constexpr int DM = 1024, NB = 4, SEQ = 4096, M = NB * SEQ, FF = 2816, NEXP = 8;
constexpr int NH = 16, NKV = 4, HD = 64, IH = 8, IDIM = 64, TOPK = 256;
constexpr int ATT_N = 2120, ATT_NP = 2304;
constexpr float EPS = 1e-6f;
constexpr int NWAVES = 8, NTHREADS = 512;

__device__ __forceinline__ unsigned f2bf(float f) { unsigned u = __builtin_bit_cast(unsigned, f); return (u + 0x7fffu + ((u >> 16) & 1u)) >> 16; }
__device__ __forceinline__ unsigned pk2(float lo, float hi) { return f2bf(lo) | (f2bf(hi) << 16); }
__device__ __forceinline__ unsigned cvt_pk_bf16(float lo, float hi) { unsigned r; asm volatile("v_cvt_pk_bf16_f32 %0, %1, %2" : "=v"(r) : "v"(lo), "v"(hi)); return r; }
__device__ __forceinline__ float bflo(unsigned u) { return __uint_as_float(u << 16); }
__device__ __forceinline__ float bfhi(unsigned u) { return __uint_as_float(u & 0xffff0000u); }
__device__ __forceinline__ float wave_sum(float v) {
#pragma unroll
    for (int o = 1; o < 64; o <<= 1) v += __shfl_xor(v, o);
    return v;
}
__device__ __forceinline__ float fast_rcp(float x) { return __builtin_amdgcn_rcpf(x); }
__device__ __forceinline__ float silu_f(float g) { return g * fast_rcp(1.f + __expf(-g)); }
__device__ __forceinline__ float sigmoid_f(float g) { return fast_rcp(1.f + __expf(-g)); }
__device__ __forceinline__ float gelu_tanh_f(float y) { const float z = 0.7978845608028654f * (y + 0.044715f * y * y * y); const float t = 1.f - 2.f * fast_rcp(__expf(2.f * z) + 1.f); return 0.5f * y * (1.f + t); }

constexpr size_t WS_ROWIDX_B = 2u << 20, WS_GATEP_B = (2u << 20) + 512 * 1024, WS_SLOT_B = 3u << 20;
__device__ __forceinline__ int lane_id_fresh() { int l; asm volatile("v_mbcnt_lo_u32_b32 %0, -1, 0\n\tv_mbcnt_hi_u32_b32 %0, -1, %0" : "=v"(l)); return l; }
#ifndef FUSE_R
#define FUSE_R 1
#endif
#ifndef FUSE_N
#define FUSE_N 1
#endif
#ifndef M2_FP8
#define M2_FP8 1
#endif
#ifndef F2_FP8
#define F2_FP8 0
#endif
namespace pg8 {
constexpr int BM = 256, BK = 64, HALF = 128, HTB = HALF * BK * 2, STAGE_BYTES = 8 * HTB, NXCD = 8, WGM = 8;
__host__ __device__ __forceinline__ int lds_byte(int r, int c) { const int st = (r >> 4) * 2 + (c >> 5), rr = r & 15, cc = c & 31, ob = rr * 64 + cc * 2; return st * 1024 + (ob ^ (((ob >> 9) & 1) << 5)); }
__host__ __device__ __forceinline__ void stage_rc(int b, int& R, int& C) { const int st = b / 1024, sb = b % 1024, swz = sb ^ (((sb >> 9) & 1) << 5); R = (st >> 1) * 16 + swz / 64; C = (st & 1) * 32 + (swz % 64) / 2; }
__host__ __device__ __forceinline__ int perm32(int rho) { const int n = rho >> 4, i = rho & 15; return 8 * (i >> 2) + 4 * n + (i & 3); }

struct Unit { int pm, pn, e, aux; };
struct Gemm { const bf16_t* A; const bf16_t* Bt; int M, N, K; size_t bstride_e; const int* rowidx; const unsigned* cnt; };

struct StaticOrder {
    int nM, nN, nwg, G, c;
    __device__ __forceinline__ void init(int M_, int N_, int G_, int c_) { nM = M_ / BM; nN = N_ / BM; nwg = nM * nN; G = G_; c = c_; }
    __device__ __forceinline__ bool next(int i, Unit& u) const {
        const long L = (long)i * G + c; if (L >= nwg) return false;
        int wgid = (int)L; { const int q = nwg / NXCD, r = nwg % NXCD, xcd = wgid % NXCD, off = wgid / NXCD; wgid = (xcd < r ? xcd * (q + 1) : r * (q + 1) + (xcd - r) * q) + off; }
        const int nig = WGM * nN, gid = wgid / nig, fm = gid * WGM, gsz = (nM - fm) < WGM ? (nM - fm) : WGM;
        u.pm = fm + ((wgid % nig) % gsz); u.pn = (wgid % nig) / gsz; u.e = 0; u.aux = 0; return true;
    }
};
struct MoeOrder {
    int T1, T2, T3, T4, T5, T6, T7, T8, NT, W, r, lo, ntl;
    static constexpr int RG = 4;
    __device__ __forceinline__ void init(const unsigned* cnt, int NT_, int G_, int c_) {
        int t[9]; int acc = 0;
#pragma unroll
        for (int e = 0; e < 8; ++e) { t[e] = acc; acc += (int)((__hip_atomic_load(cnt + 64 * e, RLX_AGENT) + 255u) >> 8); }
        t[8] = acc; T1 = t[1]; T2 = t[2]; T3 = t[3]; T4 = t[4]; T5 = t[5]; T6 = t[6]; T7 = t[7]; T8 = t[8]; NT = NT_;
        if (G_ % 8 == 0) { const int xv = c_ % 8; W = G_ / 8; r = c_ / 8; lo = (T8 * xv) / 8; ntl = (T8 * (xv + 1)) / 8 - lo; }
        else { W = G_; r = c_; lo = 0; ntl = T8; }
    }
    __device__ __forceinline__ bool next(int i, Unit& u) const {
        const int q = i * W + r; if (q >= ntl * NT) return false;
        const int nig = RG * NT, gid = q / nig, fm = gid * RG, gsz = (ntl - fm) < RG ? (ntl - fm) : RG, w = q - gid * nig;
        const int tt = lo + fm + (w % gsz), pn = w / gsz;
        int e = 0, te = 0;
        if (tt >= T1) { e = 1; te = T1; } if (tt >= T2) { e = 2; te = T2; } if (tt >= T3) { e = 3; te = T3; } if (tt >= T4) { e = 4; te = T4; }
        if (tt >= T5) { e = 5; te = T5; } if (tt >= T6) { e = 6; te = T6; } if (tt >= T7) { e = 7; te = T7; }
        u.pm = tt; u.pn = pn; u.e = e; u.aux = e * 16384 + 256 * (tt - te); return true;
    }
};

typedef int v8i32 __attribute__((ext_vector_type(8)));
typedef int v4i32 __attribute__((ext_vector_type(4)));
constexpr float W8_MUL = 32.0f, W8_INV = 1.0f / 32.0f;
__device__ __forceinline__ void mfma8(f32x4& c, const v8i32 a, const v8i32 b) { asm volatile("v_mfma_f32_16x16x128_f8f6f4 %0, %1, %2, %0" : "+v"(c) : "v"(a), "v"(b)); }
__device__ __forceinline__ v8i32 cat8(const bf16x8 a, const bf16x8 b) { return __builtin_shufflevector(__builtin_bit_cast(v4i32, a), __builtin_bit_cast(v4i32, b), 0, 1, 2, 3, 4, 5, 6, 7); }
template <class Epi, class Sched, bool GATHER, bool FP8 = false>
__device__ __forceinline__ void gemm_phase(LAS unsigned char* lds, const Gemm g, const Sched& S, const Epi& E, const int wid) {
    const int lane = lane_id_fresh(), tid = wid * 64 + lane, wr = wid >> 2, wc = wid & 3, fr = lane & 15, fq = lane >> 4;
    const int K = FP8 ? g.K / 2 : g.K, nt = K / BK;
    unsigned voffB[2]; int stR[2], stC[2];
#pragma unroll
    for (int i = 0; i < 2; ++i) { int R, C; stage_rc(tid * 16 + i * 8192, R, C); const int Rb = (R & ~31) + perm32(R & 31);
        stR[i] = R; stC[i] = C; voffB[i] = (unsigned)(Rb * K + C) * 2u; }
    const size_t kstep = (size_t)(BK * 2);
    const size_t hstep = (size_t)HALF * K * 2;
    const size_t tstep = 2 * hstep;
    const unsigned ldsw = (unsigned)wid * 1024u;
    const int aoff = lds_byte(wr * 64 + fr, fq * 8), boff = lds_byte(wc * 32 + fr, fq * 8);
#define PG8_SA(b, h) (((b) * 2 + (h)) * HTB)
#define PG8_SB(b, h) ((4 + (b) * 2 + (h)) * HTB)
#define PG8_STAGE(bufoff, gbase, voff) do { _Pragma("unroll") for (int _i = 0; _i < 2; ++_i) \
        __builtin_amdgcn_global_load_lds((const unsigned*)((const char*)(gbase) + (voff)[_i]), (LAS unsigned*)(lds + (bufoff) + ldsw + _i * 8192), 16, 0, 0); } while (0)
#define PG8_LDA(dst, b, h) do { _Pragma("unroll") for (int m = 0; m < 4; ++m) _Pragma("unroll") for (int k = 0; k < 2; ++k) dst[m][k] = *(const LAS bf16x8*)(lds + PG8_SA(b, h) + aoff + m * 2048 + k * 1024); } while (0)
#define PG8_LDB(dst, b, h) do { _Pragma("unroll") for (int n = 0; n < 2; ++n) _Pragma("unroll") for (int k = 0; k < 2; ++k) dst[n][k] = *(const LAS bf16x8*)(lds + PG8_SB(b, h) + boff + n * 2048 + k * 1024); } while (0)
#define PG8_MMA(ai, bj, At, Bt) do { __builtin_amdgcn_s_setprio(1); _Pragma("unroll") for (int m = 0; m < 4; ++m) _Pragma("unroll") for (int n = 0; n < 2; ++n) { \
        if (FP8) mfma8(acc[ai][bj][m][n], cat8(Bt[n][0], Bt[n][1]), cat8(At[m][0], At[m][1])); \
        else { _Pragma("unroll") for (int k = 0; k < 2; ++k) acc[ai][bj][m][n] = __builtin_amdgcn_mfma_f32_16x16x32_bf16(Bt[n][k], At[m][k], acc[ai][bj][m][n], 0, 0, 0); } } \
        __builtin_amdgcn_s_setprio(0); } while (0)
#define PG8_MMA_END(At, B0, B1) do { if (FP8) { asm volatile("s_nop 15\n\ts_nop 15\n\ts_nop 15\n\ts_nop 15" :: "v"(cat8(At[0][0], At[0][1])), "v"(cat8(At[1][0], At[1][1])), "v"(cat8(At[2][0], At[2][1])), "v"(cat8(At[3][0], At[3][1])), \
        "v"(cat8(B0[0][0], B0[0][1])), "v"(cat8(B0[1][0], B0[1][1])), "v"(cat8(B1[0][0], B1[0][1])), "v"(cat8(B1[1][0], B1[1][1]))); } } while (0)
#define PG8_WAIT_V(n) asm volatile("s_waitcnt vmcnt(" #n ")" ::: "memory")
#define PG8_WAIT_L(n) asm volatile("s_waitcnt lgkmcnt(" #n ")" ::: "memory")
#define PG8_BAR __builtin_amdgcn_s_barrier()
#define PG8_SCHED __builtin_amdgcn_sched_barrier(0)
#define PG8_AOFFS(v, U) do { _Pragma("unroll") for (int _h = 0; _h < 2; ++_h) _Pragma("unroll") for (int _i = 0; _i < 2; ++_i) { \
        if (GATHER) { const int _loc = ((U).aux & 16383) + _h * HALF + stR[_i]; const int _e = (U).aux >> 14; \
            const int _row = (_loc < (int)g.cnt[64 * _e]) ? g.rowidx[(U).aux + _h * HALF + stR[_i]] : 0; \
            v[_h][_i] = (unsigned)(_row * K + stC[_i]) * 2u; } \
        else v[_h][_i] = (unsigned)((_h * HALF + stR[_i]) * K + stC[_i]) * 2u; } } while (0)
    int cn8[8];
#pragma unroll
    for (int e = 0; e < 8; ++e) cn8[e] = GATHER ? __builtin_amdgcn_readfirstlane((int)g.cnt[64 * e]) : 0;
    Unit cur, nxt; int ui = 0;
    if (!S.next(0, cur)) return;
    f32x4 acc[2][2][4][2];
#pragma unroll
    for (int a = 0; a < 2; ++a)
#pragma unroll
        for (int b = 0; b < 2; ++b)
#pragma unroll
            for (int m = 0; m < 4; ++m)
#pragma unroll
                for (int n = 0; n < 2; ++n) acc[a][b][m][n] = (f32x4){0.f, 0.f, 0.f, 0.f};
    bf16x8 At[4][2], B0[2][2], B1[2][2];
    unsigned vAc[2][2], vAn[2][2];
    PG8_AOFFS(vAc, cur);
    const char* cA = (const char*)g.A + (GATHER ? (size_t)0 : (size_t)cur.pm * tstep);
    const char* cB = (const char*)g.Bt + (size_t)cur.e * g.bstride_e + (size_t)cur.pn * tstep;
    PG8_STAGE(PG8_SB(0, 0), cB, voffB); PG8_STAGE(PG8_SB(0, 1), cB + hstep, voffB); PG8_STAGE(PG8_SA(0, 0), cA, vAc[0]); PG8_STAGE(PG8_SA(0, 1), cA, vAc[1]);
    if (wr == 1) PG8_BAR;
    PG8_WAIT_V(2); PG8_BAR;
    PG8_STAGE(PG8_SB(1, 0), cB + kstep, voffB); PG8_STAGE(PG8_SA(1, 0), cA + kstep, vAc[0]); PG8_STAGE(PG8_SB(1, 1), cB + hstep + kstep, voffB);
    PG8_WAIT_V(6); PG8_BAR;
    for (;;) {
        const bool has_next = S.next(ui + 1, nxt);
        const char* nA = cA; const char* nB = cB;
        int rn[2][2];
        if (has_next) { if (GATHER) {
#pragma unroll
                for (int h = 0; h < 2; ++h)
#pragma unroll
                    for (int i = 0; i < 2; ++i) rn[h][i] = g.rowidx[nxt.aux + h * HALF + stR[i]]; }
            else PG8_AOFFS(vAn, nxt);
            nA = (const char*)g.A + (GATHER ? (size_t)0 : (size_t)nxt.pm * tstep); nB = (const char*)g.Bt + (size_t)nxt.e * g.bstride_e + (size_t)nxt.pn * tstep; }
        else {
#pragma unroll
            for (int h = 0; h < 2; ++h)
#pragma unroll
                for (int i = 0; i < 2; ++i) vAn[h][i] = vAc[h][i];
        }
#pragma nounroll
        for (int t = 0; t < nt; t += 2) {
            const bool last = (t == nt - 2);
            const char* a1 = cA + (size_t)(t + 1) * kstep;
            const char* a2 = last ? nA : cA + (size_t)(t + 2) * kstep; const char* b2 = last ? nB : cB + (size_t)(t + 2) * kstep;
            const char* a3 = a2 + kstep; const char* b3 = b2 + kstep;
            if (GATHER && last && has_next) { const int _e = nxt.aux >> 14;
                const int _cn = _e == 0 ? cn8[0] : _e == 1 ? cn8[1] : _e == 2 ? cn8[2] : _e == 3 ? cn8[3] : _e == 4 ? cn8[4] : _e == 5 ? cn8[5] : _e == 6 ? cn8[6] : cn8[7];
#pragma unroll
                for (int h = 0; h < 2; ++h)
#pragma unroll
                    for (int i = 0; i < 2; ++i) { int r_ = rn[h][i]; asm volatile("" : "+v"(r_)); const int _loc = (nxt.aux & 16383) + h * HALF + stR[i];
                        r_ = _loc < _cn ? r_ : 0; vAn[h][i] = (unsigned)(r_ * K + stC[i]) * 2u; } }
            unsigned v2[2][2];
#pragma unroll
            for (int h = 0; h < 2; ++h)
#pragma unroll
                for (int i = 0; i < 2; ++i) v2[h][i] = last ? vAn[h][i] : vAc[h][i];
            PG8_LDB(B0, 0, 0); PG8_LDB(B1, 0, 1); PG8_SCHED; PG8_LDA(At, 0, 0); PG8_STAGE(PG8_SA(1, 1), a1, vAc[1]);
            PG8_WAIT_V(8); PG8_WAIT_L(0); PG8_BAR; PG8_MMA(0, 0, At, B0); PG8_MMA(0, 1, At, B1); PG8_MMA_END(At, B0, B1); PG8_BAR; PG8_SCHED;
            PG8_LDA(At, 0, 1); PG8_STAGE(PG8_SB(0, 0), b2, voffB); PG8_STAGE(PG8_SB(0, 1), b2 + hstep, voffB); PG8_STAGE(PG8_SA(0, 0), a2, v2[0]);
            PG8_WAIT_V(8); PG8_WAIT_L(0); PG8_BAR; PG8_MMA(1, 0, At, B0); PG8_MMA(1, 1, At, B1); PG8_MMA_END(At, B0, B1); PG8_BAR; PG8_SCHED;
            PG8_LDB(B0, 1, 0); PG8_LDB(B1, 1, 1); PG8_SCHED; PG8_LDA(At, 1, 0); PG8_STAGE(PG8_SA(0, 1), a2, v2[1]);
            PG8_WAIT_V(8); PG8_WAIT_L(0); PG8_BAR; PG8_MMA(0, 0, At, B0); PG8_MMA(0, 1, At, B1); PG8_MMA_END(At, B0, B1); PG8_BAR; PG8_SCHED;
            PG8_LDA(At, 1, 1); PG8_STAGE(PG8_SB(1, 0), b3, voffB); PG8_STAGE(PG8_SB(1, 1), b3 + hstep, voffB); PG8_STAGE(PG8_SA(1, 0), a3, v2[0]);
            PG8_WAIT_V(8); PG8_WAIT_L(0); PG8_BAR; PG8_MMA(1, 0, At, B0); PG8_MMA(1, 1, At, B1); PG8_MMA_END(At, B0, B1); PG8_BAR; PG8_SCHED;
        }
        if (wr == 0) PG8_BAR;
        if (FP8) asm volatile("s_nop 15\n\ts_nop 15\n\ts_nop 15\n\ts_nop 15\n\ts_nop 15\n\ts_nop 15" ::: "memory");
        if constexpr (!Epi::FUSED) E(acc, cur, wr, wc, fr, fq);
        if (!has_next) break;
#pragma unroll
        for (int a = 0; a < 2; ++a)
#pragma unroll
            for (int b = 0; b < 2; ++b)
#pragma unroll
                for (int m = 0; m < 4; ++m)
#pragma unroll
                    for (int n = 0; n < 2; ++n) acc[a][b][m][n] = (f32x4){0.f, 0.f, 0.f, 0.f};
        cur = nxt; cA = nA; cB = nB; ++ui;
#pragma unroll
        for (int h = 0; h < 2; ++h)
#pragma unroll
            for (int i = 0; i < 2; ++i) vAc[h][i] = vAn[h][i];
        if (wr == 1) PG8_BAR;
    }
    PG8_WAIT_V(0);
    PG8_BAR;
    if constexpr (Epi::FUSED) E.fused(acc, cur, wr, wc, fr, fq, lds, wid, lane);
#undef PG8_SA
#undef PG8_SB
#undef PG8_STAGE
#undef PG8_LDA
#undef PG8_LDB
#undef PG8_MMA
#undef PG8_MMA_END
#undef PG8_WAIT_V
#undef PG8_WAIT_L
#undef PG8_BAR
#undef PG8_SCHED
#undef PG8_AOFFS
}

__device__ __forceinline__ f32x4 ldx16(const float* p) { const GAS unsigned long long* q = (const GAS unsigned long long*)p; const unsigned long long a = __hip_atomic_load(q, RLX_AGENT), c = __hip_atomic_load(q + 1, RLX_AGENT);
    return (f32x4){__uint_as_float((unsigned)a), __uint_as_float((unsigned)(a >> 32)), __uint_as_float((unsigned)c), __uint_as_float((unsigned)(c >> 32))}; }
typedef f32x4 Acc[2][2][4][2];
__device__ __forceinline__ u32x4 pack8(const f32x4 a, const f32x4 b) { u32x4 w; w.x = cvt_pk_bf16(a[0], a[1]); w.y = cvt_pk_bf16(a[2], a[3]); w.z = cvt_pk_bf16(b[0], b[1]); w.w = cvt_pk_bf16(b[2], b[3]); return w; }

template <int MODE, bool OUT8 = false, bool SC8 = OUT8> struct EpiPair {
    static constexpr bool FUSED = false;
    bf16_t* O; int ldo;
    __device__ __forceinline__ void operator()(const Acc& acc, const Unit& u, int wr, int wc, int fr, int fq) const {
        const int row0 = u.pm * BM + wr * 64 + fr, col0 = u.pn * HALF + wc * 32 + 8 * fq;
#pragma unroll
        for (int ai = 0; ai < 2; ++ai)
#pragma unroll
            for (int m = 0; m < 4; ++m) { f32x4 r0, r1;
#pragma unroll
                for (int e = 0; e < 4; ++e) { const float sc8 = SC8 ? W8_INV : 1.0f; const float a0 = acc[ai][0][m][0][e] * sc8, a1 = acc[ai][0][m][1][e] * sc8, b0 = acc[ai][1][m][0][e] * sc8, b1 = acc[ai][1][m][1][e] * sc8;
                    r0[e] = (MODE == 1 ? silu_f(a0) : a0) * b0; r1[e] = (MODE == 1 ? silu_f(a1) : a1) * b1; }
                if (OUT8) { u32x2 w; int t0 = 0, t1 = 0; t0 = __builtin_amdgcn_cvt_pk_fp8_f32(r0[0], r0[1], t0, false); t0 = __builtin_amdgcn_cvt_pk_fp8_f32(r0[2], r0[3], t0, true);
                    t1 = __builtin_amdgcn_cvt_pk_fp8_f32(r1[0], r1[1], t1, false); t1 = __builtin_amdgcn_cvt_pk_fp8_f32(r1[2], r1[3], t1, true); w.x = (unsigned)t0; w.y = (unsigned)t1;
                    *(u32x2*)((unsigned char*)O + (size_t)(row0 + ai * HALF + m * 16) * ldo + col0) = w; }
                else *(u32x4*)(O + (size_t)(row0 + ai * HALF + m * 16) * ldo + col0) = pack8(r0, r1); }
    }
};
struct EpiConvIn {
    static constexpr bool FUSED = false;
    bf16_t* UB;
    __device__ __forceinline__ void operator()(const Acc& acc, const Unit& u, int wr, int wc, int fr, int fq) const {
        const int row0 = u.pm * BM + wr * 64 + fr;
        if (u.pn < 8) { EpiPair<0, false, false> P{UB, 2048}; P(acc, u, wr, wc, fr, fq); }
        else { const int col0 = 1024 + (u.pn - 8) * BM + wc * 32 + 8 * fq;
#pragma unroll
            for (int ai = 0; ai < 2; ++ai)
#pragma unroll
                for (int m = 0; m < 4; ++m)
#pragma unroll
                    for (int bj = 0; bj < 2; ++bj) *(u32x4*)(UB + (size_t)(row0 + ai * HALF + m * 16) * 2048 + col0 + bj * HALF) = pack8(acc[ai][bj][m][0], acc[ai][bj][m][1]); }
    }
};
struct EpiRes {
    static constexpr bool FUSED = false;
    float* X; const float* gate; const float* Xin; float asc;
    __device__ __forceinline__ void operator()(const Acc& acc, const Unit& u, int wr, int wc, int fr, int fq) const {
        const int row0 = u.pm * BM + wr * 64 + fr, col0 = u.pn * BM + wc * 32 + 8 * fq; const int b = (u.pm * BM) / SEQ;
        f32x4 gv[2][2];
#pragma unroll
        for (int bj = 0; bj < 2; ++bj)
#pragma unroll
            for (int n = 0; n < 2; ++n) gv[bj][n] = *(const f32x4*)(gate + (size_t)b * 6144 + col0 + bj * HALF + 4 * n) * asc;
#pragma unroll
        for (int ai = 0; ai < 2; ++ai) {
            f32x4 xv[4][2][2];
#pragma unroll
            for (int m = 0; m < 4; ++m) { const float* ri = Xin + (size_t)(row0 + ai * HALF + m * 16) * DM + col0;
#pragma unroll
                for (int bj = 0; bj < 2; ++bj)
#pragma unroll
                    for (int n = 0; n < 2; ++n) xv[m][bj][n] = ldx16(ri + bj * HALF + 4 * n); }
            asm volatile("" ::: "memory");
#pragma unroll
            for (int m = 0; m < 4; ++m) { float* rp = X + (size_t)(row0 + ai * HALF + m * 16) * DM + col0;
#pragma unroll
                for (int bj = 0; bj < 2; ++bj)
#pragma unroll
                    for (int n = 0; n < 2; ++n) *(f32x4*)(rp + bj * HALF + 4 * n) = xv[m][bj][n] + gv[bj][n] * acc[ai][bj][m][n]; }
            asm volatile("" ::: "memory");
        }
    }
};
struct EpiResNorm {
    static constexpr bool FUSED = true;
    float* X; const float* gate; const float* Xin; const float* ng; const float* shb; bf16_t* H; float* xs; gu32* cnt; gu32* tmo; float asc;
    __device__ __forceinline__ void fused(Acc& acc, const Unit& u, int wr, int wc, int fr, int fq, LAS unsigned char* lds, int wid, int lane) const {
        const int row0 = u.pm * BM + wr * 64 + fr, col0 = u.pn * BM + wc * 32 + 8 * fq; const int b = (u.pm * BM) / SEQ;
        LAS float* P = (LAS float*)lds; LAS float* S = (LAS float*)(lds + 4096);
        { f32x4 gv[2][2];
#pragma unroll
          for (int bj = 0; bj < 2; ++bj)
#pragma unroll
              for (int n = 0; n < 2; ++n) gv[bj][n] = *(const f32x4*)(gate + (size_t)b * 6144 + col0 + bj * HALF + 4 * n) * asc;
#pragma unroll
          for (int ai = 0; ai < 2; ++ai) {
              f32x4 xv[4][2][2];
#pragma unroll
              for (int m = 0; m < 4; ++m) { const float* ri = Xin + (size_t)(row0 + ai * HALF + m * 16) * DM + col0;
#pragma unroll
                  for (int bj = 0; bj < 2; ++bj)
#pragma unroll
                      for (int n = 0; n < 2; ++n) xv[m][bj][n] = ldx16(ri + bj * HALF + 4 * n); }
              asm volatile("" ::: "memory");
#pragma unroll
              for (int m = 0; m < 4; ++m) { float* rp = X + (size_t)(row0 + ai * HALF + m * 16) * DM + col0; float ss = 0.f;
#pragma unroll
                  for (int bj = 0; bj < 2; ++bj)
#pragma unroll
                      for (int n = 0; n < 2; ++n) { const f32x4 x = xv[m][bj][n] + gv[bj][n] * acc[ai][bj][m][n]; acc[ai][bj][m][n] = x; *(f32x4*)(rp + bj * HALF + 4 * n) = x;
                          ss += (x[0] * x[0] + x[1] * x[1]) + (x[2] * x[2] + x[3] * x[3]); }
                  ss += __shfl_xor(ss, 16); ss += __shfl_xor(ss, 32);
                  if (fq == 0) P[(ai * HALF + wr * 64 + m * 16 + fr) * 4 + wc] = ss; }
              asm volatile("" ::: "memory");
          } }
        asm volatile("s_waitcnt lgkmcnt(0)" ::: "memory"); __builtin_amdgcn_s_barrier(); asm volatile("" ::: "memory");
        const int tid = wid * 64 + lane;
        if (tid < 256) { const f32x4 p4 = *(const LAS f32x4*)(P + tid * 4); const float sp = (p4[0] + p4[1]) + (p4[2] + p4[3]);
            __hip_atomic_store((gu32*)xs + ((size_t)(u.pm * BM + tid) * 4 + u.pn), __float_as_uint(sp), RLX_AGENT); }
        asm volatile("s_waitcnt vmcnt(0)" ::: "memory");
        if (wid < 4 && lane == 0) __hip_atomic_fetch_add(cnt + 64 * u.pm, 1u, RLX_AGENT);
        if (wid == 0) { unsigned spins = 0;
            while ((unsigned)__builtin_amdgcn_readfirstlane(__hip_atomic_load(cnt + 64 * u.pm, RLX_AGENT)) < 16u) { __builtin_amdgcn_s_sleep(2);
                if (++spins > (1u << 20)) { if (lane == 0) __hip_atomic_store(tmo, 1u, RLX_AGENT); break; } } }
        asm volatile("s_waitcnt vmcnt(0) lgkmcnt(0)" ::: "memory"); __builtin_amdgcn_s_barrier(); asm volatile("" ::: "memory");
        if (tid < 256) { const GAS unsigned long long* q = (const GAS unsigned long long*)xs + (size_t)(u.pm * BM + tid) * 2;
            const unsigned long long a = __hip_atomic_load(q, RLX_AGENT), c = __hip_atomic_load(q + 1, RLX_AGENT);
            const float tot = (__uint_as_float((unsigned)a) + __uint_as_float((unsigned)(a >> 32))) + (__uint_as_float((unsigned)c) + __uint_as_float((unsigned)(c >> 32)));
            S[tid] = 1.0f / sqrtf(tot * (1.0f / DM) + EPS); }
        asm volatile("s_waitcnt vmcnt(0) lgkmcnt(0)" ::: "memory"); __builtin_amdgcn_s_barrier(); asm volatile("" ::: "memory");
        f32x4 gm[2][2], sf[2][2];
#pragma unroll
        for (int bj = 0; bj < 2; ++bj)
#pragma unroll
            for (int n = 0; n < 2; ++n) { const int c = col0 + bj * HALF + 4 * n; const f32x4 g4 = *(const f32x4*)(ng + c), s1 = *(const f32x4*)(shb + (size_t)b * 6144 + DM + c);
                gm[bj][n] = g4 * (s1 + 1.0f); sf[bj][n] = *(const f32x4*)(shb + (size_t)b * 6144 + c); }
#pragma unroll
        for (int ai = 0; ai < 2; ++ai)
#pragma unroll
            for (int m = 0; m < 4; ++m) { const float r = S[ai * HALF + wr * 64 + m * 16 + fr]; bf16_t* hp = H + (size_t)(row0 + ai * HALF + m * 16) * DM + col0;
#pragma unroll
                for (int bj = 0; bj < 2; ++bj) *(u32x4*)(hp + bj * HALF) = pack8((acc[ai][bj][m][0] * r) * gm[bj][0] + sf[bj][0], (acc[ai][bj][m][1] * r) * gm[bj][1] + sf[bj][1]); }
    }
};
struct EpiResNormRouter {
    static constexpr bool FUSED = true;
    float* X; const float* gate; const float* ng; const float* shb; bf16_t* H; float* xs9; gu32* cnt; gu32* tmo;
    const float* rw; const float* rb; gu32* ecnt; unsigned char* meta;
    __device__ __forceinline__ void fused(Acc& acc, const Unit& u, int wr, int wc, int fr, int fq, LAS unsigned char* lds, int wid, int lane) const {
        const int row0 = u.pm * BM + wr * 64 + fr, col0 = u.pn * BM + wc * 32 + 8 * fq; const int b = (u.pm * BM) / SEQ; const int tid = wid * 64 + lane;
        LAS float* P9 = (LAS float*)lds; LAS float* RWT = (LAS float*)(lds + 36864); LAS float* S = (LAS float*)(lds + 45056); LAS float* CE = (LAS float*)(lds + 46080);
        LAS int* rE = (LAS int*)(lds + 46144); LAS float* red = (LAS float*)(lds + 47360);
        const float* shp = shb + (size_t)b * 6144;
        for (int i = tid; i < 2048; i += NTHREADS) { const int c = i >> 3, e = i & 7; RWT[e * 256 + c] = rw[(size_t)(u.pn * BM + c) * 8 + e]; }
        { float ce[8]; const float s0 = shp[tid], s1 = shp[tid + 512];
#pragma unroll
          for (int e = 0; e < 8; ++e) ce[e] = wave_sum(s0 * rw[(size_t)tid * 8 + e] + s1 * rw[(size_t)(tid + 512) * 8 + e]);
          if (lane == 0) {
#pragma unroll
              for (int e = 0; e < 8; ++e) red[wid * 8 + e] = ce[e]; } }
        { f32x4 gv[2][2];
#pragma unroll
          for (int bj = 0; bj < 2; ++bj)
#pragma unroll
              for (int n = 0; n < 2; ++n) gv[bj][n] = *(const f32x4*)(gate + (size_t)b * 6144 + col0 + bj * HALF + 4 * n);
#pragma unroll
          for (int ai = 0; ai < 2; ++ai) {
              f32x4 xv[4][2][2];
#pragma unroll
              for (int m = 0; m < 4; ++m) { const float* ri = X + (size_t)(row0 + ai * HALF + m * 16) * DM + col0;
#pragma unroll
                  for (int bj = 0; bj < 2; ++bj)
#pragma unroll
                      for (int n = 0; n < 2; ++n) xv[m][bj][n] = ldx16(ri + bj * HALF + 4 * n); }
              asm volatile("" ::: "memory");
#pragma unroll
              for (int m = 0; m < 4; ++m) { float* rp = X + (size_t)(row0 + ai * HALF + m * 16) * DM + col0; float ss = 0.f;
#pragma unroll
                  for (int bj = 0; bj < 2; ++bj)
#pragma unroll
                      for (int n = 0; n < 2; ++n) { const f32x4 x = xv[m][bj][n] + gv[bj][n] * acc[ai][bj][m][n]; acc[ai][bj][m][n] = x; *(f32x4*)(rp + bj * HALF + 4 * n) = x;
                          ss += (x[0] * x[0] + x[1] * x[1]) + (x[2] * x[2] + x[3] * x[3]); }
                  ss += __shfl_xor(ss, 16); ss += __shfl_xor(ss, 32);
                  if (fq == 0) P9[((ai * HALF + wr * 64 + m * 16 + fr) * 4 + wc) * 9] = ss; }
              asm volatile("" ::: "memory");
          } }
        f32x4 sf[2][2];
#pragma unroll
        for (int bj = 0; bj < 2; ++bj)
#pragma unroll
            for (int n = 0; n < 2; ++n) { const int c = col0 + bj * HALF + 4 * n; const f32x4 gm = *(const f32x4*)(ng + c) * (*(const f32x4*)(shp + DM + c) + 1.0f); sf[bj][n] = *(const f32x4*)(shp + c);
#pragma unroll
                for (int ai = 0; ai < 2; ++ai)
#pragma unroll
                    for (int m = 0; m < 4; ++m) acc[ai][bj][m][n] = acc[ai][bj][m][n] * gm; }
        asm volatile("s_waitcnt lgkmcnt(0)" ::: "memory"); __builtin_amdgcn_s_barrier(); asm volatile("" ::: "memory");
        if (tid < 8) { float c = rb[tid];
#pragma unroll
            for (int w = 0; w < 8; ++w) c += red[w * 8 + tid];
            CE[tid] = c; }
#pragma unroll
        for (int e = 0; e < 8; ++e) { f32x4 rwe[2][2];
#pragma unroll
            for (int bj = 0; bj < 2; ++bj)
#pragma unroll
                for (int n = 0; n < 2; ++n) rwe[bj][n] = *(const LAS f32x4*)(RWT + e * 256 + bj * HALF + wc * 32 + 8 * fq + 4 * n);
#pragma unroll
            for (int ai = 0; ai < 2; ++ai)
#pragma unroll
                for (int m = 0; m < 4; ++m) { float a = 0.f;
#pragma unroll
                    for (int bj = 0; bj < 2; ++bj)
#pragma unroll
                        for (int n = 0; n < 2; ++n) { const f32x4 x = acc[ai][bj][m][n], w4 = rwe[bj][n]; a += (x[0] * w4[0] + x[1] * w4[1]) + (x[2] * w4[2] + x[3] * w4[3]); }
                    a += __shfl_xor(a, 16); a += __shfl_xor(a, 32);
                    if (fq == 0) P9[((ai * HALF + wr * 64 + m * 16 + fr) * 4 + wc) * 9 + 1 + e] = a; } }
        asm volatile("s_waitcnt lgkmcnt(0)" ::: "memory"); __builtin_amdgcn_s_barrier(); asm volatile("" ::: "memory");
        if (tid < 256) { gu32* q = (gu32*)xs9 + ((size_t)(u.pm * BM + tid) * 4 + u.pn) * 9;
#pragma unroll
            for (int k = 0; k < 9; ++k) { const float v = (P9[(tid * 4 + 0) * 9 + k] + P9[(tid * 4 + 1) * 9 + k]) + (P9[(tid * 4 + 2) * 9 + k] + P9[(tid * 4 + 3) * 9 + k]);
                __hip_atomic_store(q + k, __float_as_uint(v), RLX_AGENT); } }
        asm volatile("s_waitcnt vmcnt(0)" ::: "memory");
        if (wid < 4 && lane == 0) __hip_atomic_fetch_add(cnt + 64 * u.pm, 1u, RLX_AGENT);
        if (wid == 0) { unsigned spins = 0;
            while ((unsigned)__builtin_amdgcn_readfirstlane(__hip_atomic_load(cnt + 64 * u.pm, RLX_AGENT)) < 16u) { __builtin_amdgcn_s_sleep(2);
                if (++spins > (1u << 20)) { if (lane == 0) __hip_atomic_store(tmo, 1u, RLX_AGENT); break; } } }
        asm volatile("s_waitcnt vmcnt(0) lgkmcnt(0)" ::: "memory"); __builtin_amdgcn_s_barrier(); asm volatile("" ::: "memory");
        if (tid < 256) { const gu32* q = (const gu32*)xs9 + (size_t)(u.pm * BM + tid) * 36; float tot[9];
#pragma unroll
            for (int k = 0; k < 9; ++k) tot[k] = (__uint_as_float(__hip_atomic_load(q + k, RLX_AGENT)) + __uint_as_float(__hip_atomic_load(q + 9 + k, RLX_AGENT)))
                                               + (__uint_as_float(__hip_atomic_load(q + 18 + k, RLX_AGENT)) + __uint_as_float(__hip_atomic_load(q + 27 + k, RLX_AGENT)));
            const float r = 1.0f / sqrtf(tot[0] * (1.0f / DM) + EPS); S[tid] = r;
            if (wid == u.pn) {
                float lg[8];
#pragma unroll
                for (int e = 0; e < 8; ++e) lg[e] = r * tot[1 + e] + CE[e];
                int e0 = 0; float l0 = lg[0];
#pragma unroll
                for (int e = 1; e < 8; ++e) if (lg[e] > l0) { l0 = lg[e]; e0 = e; }
                int e1 = -1; float l1 = -3.0e38f;
#pragma unroll
                for (int e = 0; e < 8; ++e) if (e != e0 && lg[e] > l1) { l1 = lg[e]; e1 = e; }
                const float g0 = 1.0f / (1.0f + __expf(l1 - l0)), g1 = 1.0f - g0;
                int cmine = 0, r0 = 0, r1 = 0;
#pragma unroll
                for (int e = 0; e < 8; ++e) { const unsigned long long m0 = __ballot(e0 == e), m1 = __ballot(e1 == e);
                    const int below = (int)__builtin_amdgcn_mbcnt_hi((unsigned)(m0 >> 32), __builtin_amdgcn_mbcnt_lo((unsigned)m0, 0u)) + (int)__builtin_amdgcn_mbcnt_hi((unsigned)(m1 >> 32), __builtin_amdgcn_mbcnt_lo((unsigned)m1, 0u));
                    if (e0 == e) r0 = below; if (e1 == e) r1 = below; if (lane == e) cmine = __popcll(m0) + __popcll(m1); }
                unsigned base = 0u; if (lane < 8 && cmine) base = __hip_atomic_fetch_add(ecnt + 64 * lane, (unsigned)cmine, RLX_AGENT);
                const int p0 = (int)__shfl(base, e0) + r0, p1 = (int)__shfl(base, e1) + r1, grow = u.pm * BM + 64 * u.pn + lane;
                gu32* ri = (gu32*)(meta + WS_ROWIDX_B); gu32* gp = (gu32*)(meta + WS_GATEP_B); gu32* sl = (gu32*)(meta + WS_SLOT_B);
                __hip_atomic_store(ri + e0 * 16384 + p0, (unsigned)grow, RLX_AGENT); __hip_atomic_store(ri + e1 * 16384 + p1, (unsigned)grow, RLX_AGENT);
                __hip_atomic_store(gp + e0 * 16384 + p0, __float_as_uint(g0), RLX_AGENT); __hip_atomic_store(gp + e1 * 16384 + p1, __float_as_uint(g1), RLX_AGENT);
                __hip_atomic_store(sl + grow * 2, (unsigned)((e0 << 16) | p0), RLX_AGENT); __hip_atomic_store(sl + grow * 2 + 1, (unsigned)((e1 << 16) | p1), RLX_AGENT); } }
        asm volatile("s_waitcnt vmcnt(0) lgkmcnt(0)" ::: "memory"); __builtin_amdgcn_s_barrier(); asm volatile("" ::: "memory");
#pragma unroll
        for (int ai = 0; ai < 2; ++ai)
#pragma unroll
            for (int m = 0; m < 4; ++m) { const float r = S[ai * HALF + wr * 64 + m * 16 + fr]; bf16_t* hp = H + (size_t)(row0 + ai * HALF + m * 16) * DM + col0;
#pragma unroll
                for (int bj = 0; bj < 2; ++bj) *(u32x4*)(hp + bj * HALF) = pack8(acc[ai][bj][m][0] * r + sf[bj][0], acc[ai][bj][m][1] * r + sf[bj][1]); }
    }
};
struct EpiGluRes {
    static constexpr bool FUSED = false;
    float* X; const float* gate;
    __device__ __forceinline__ void operator()(const Acc& acc, const Unit& u, int wr, int wc, int fr, int fq) const {
        const int row0 = u.pm * BM + wr * 64 + fr, col0 = u.pn * HALF + wc * 32 + 8 * fq; const int b = (u.pm * BM) / SEQ;
        f32x4 gv[2];
#pragma unroll
        for (int n = 0; n < 2; ++n) gv[n] = *(const f32x4*)(gate + (size_t)b * 6144 + col0 + 4 * n);
        f32x4 xv[2][4][2];
#pragma unroll
        for (int ai = 0; ai < 2; ++ai)
#pragma unroll
            for (int m = 0; m < 4; ++m)
#pragma unroll
                for (int n = 0; n < 2; ++n) xv[ai][m][n] = ldx16(X + (size_t)(row0 + ai * HALF + m * 16) * DM + col0 + 4 * n);
        asm volatile("" ::: "memory");
#pragma unroll
        for (int ai = 0; ai < 2; ++ai)
#pragma unroll
            for (int m = 0; m < 4; ++m) { float* rp = X + (size_t)(row0 + ai * HALF + m * 16) * DM + col0;
#pragma unroll
                for (int n = 0; n < 2; ++n) { f32x4 x = xv[ai][m][n]; const f32x4 l = acc[ai][0][m][n], gg = acc[ai][1][m][n];
#pragma unroll
                    for (int e = 0; e < 4; ++e) x[e] += gv[n][e] * l[e] * sigmoid_f(gg[e]);
                    *(f32x4*)(rp + 4 * n) = x; } }
    }
};
struct EpiAttnIn {
    static constexpr bool FUSED = false;
    bf16_t *Q, *Kn, *V, *QI, *KI; float* WI; const float *qg, *kg;
    __device__ __forceinline__ void operator()(const Acc& acc, const Unit& u, int wr, int wc, int fr, int fq) const {
        const int row0 = u.pm * BM + wr * 64 + fr;
        if (u.pn < 5) {
            const bool isq = u.pn < 4; const float* gp = isq ? qg : kg; const float sc = isq ? 0.125f : 1.0f;
            f32x4 gn[2][2];
#pragma unroll
            for (int bj = 0; bj < 2; ++bj)
#pragma unroll
                for (int n = 0; n < 2; ++n) gn[bj][n] = *(const f32x4*)(gp + 32 * bj + 8 * fq + 4 * n) * sc;
            bf16_t* base = isq ? (Q + (size_t)(4 * u.pn + wc) * 64) : (Kn + (size_t)wc * 64); const int ldo = isq ? 1024 : 256;
#pragma unroll
            for (int ai = 0; ai < 2; ++ai)
#pragma unroll
                for (int m = 0; m < 4; ++m) { float ss = 0.f;
#pragma unroll
                    for (int bj = 0; bj < 2; ++bj)
#pragma unroll
                        for (int n = 0; n < 2; ++n) { const f32x4 x = acc[ai][bj][m][n]; ss += (x[0] * x[0] + x[1] * x[1]) + (x[2] * x[2] + x[3] * x[3]); }
                    ss += __shfl_xor(ss, 16); ss += __shfl_xor(ss, 32);
                    const float r = 1.0f / sqrtf(ss * (1.0f / 64.0f) + EPS);
#pragma unroll
                    for (int bj = 0; bj < 2; ++bj) *(u32x4*)(base + (size_t)(row0 + ai * HALF + m * 16) * ldo + 32 * bj + 8 * fq) = pack8(acc[ai][bj][m][0] * r * gn[bj][0], acc[ai][bj][m][1] * r * gn[bj][1]); }
        } else if (u.pn < 8) {
            bf16_t* base = (u.pn == 5) ? V : QI + (size_t)(u.pn - 6) * 256; const int ldo = (u.pn == 5) ? 256 : 512; const int col0 = wc * 32 + 8 * fq;
#pragma unroll
            for (int ai = 0; ai < 2; ++ai)
#pragma unroll
                for (int m = 0; m < 4; ++m)
#pragma unroll
                    for (int bj = 0; bj < 2; ++bj) *(u32x4*)(base + (size_t)(row0 + ai * HALF + m * 16) * ldo + col0 + bj * HALF) = pack8(acc[ai][bj][m][0], acc[ai][bj][m][1]);
        } else {
            if (wc < 2) {
#pragma unroll
                for (int ai = 0; ai < 2; ++ai)
#pragma unroll
                    for (int m = 0; m < 4; ++m) *(u32x4*)(KI + (size_t)(row0 + ai * HALF + m * 16) * 64 + wc * 32 + 8 * fq) = pack8(acc[ai][0][m][0], acc[ai][0][m][1]);
            } else if (wc == 2 && fq == 0) {
                const float s = 0.04419417382415922f;
#pragma unroll
                for (int ai = 0; ai < 2; ++ai)
#pragma unroll
                    for (int m = 0; m < 4; ++m) { float* wp = WI + (size_t)(row0 + ai * HALF + m * 16) * 8; *(f32x4*)wp = acc[ai][0][m][0] * s; *(f32x4*)(wp + 4) = acc[ai][0][m][1] * s; }
            }
        }
    }
};
struct EpiMoeDn {
    static constexpr bool FUSED = false;
    bf16_t* Y; const float* gatep;
    __device__ __forceinline__ void operator()(const Acc& acc, const Unit& u, int wr, int wc, int fr, int fq) const {
        const int row0 = u.pm * BM + wr * 64 + fr, col0 = u.pn * BM + wc * 32 + 8 * fq;
#pragma unroll
        for (int ai = 0; ai < 2; ++ai)
#pragma unroll
            for (int m = 0; m < 4; ++m) { const float gt = gatep[u.aux + ai * HALF + wr * 64 + m * 16 + fr] * (M2_FP8 ? W8_INV : 1.0f);
#pragma unroll
                for (int bj = 0; bj < 2; ++bj) *(u32x4*)(Y + (size_t)(row0 + ai * HALF + m * 16) * DM + col0 + bj * HALF) = pack8(acc[ai][bj][m][0] * gt, acc[ai][bj][m][1] * gt); }
    }
};
}

constexpr size_t MiB = 1u << 20;
constexpr size_t WS_CTL = 0, CTL_ZERO_BYTES = 1 * MiB;
constexpr size_t WS_MOD = 1 * MiB;
constexpr size_t WS_ROWIDX = 2 * MiB;
constexpr size_t WS_GATEP = 2 * MiB + 512 * 1024;
constexpr size_t WS_SLOT = 3 * MiB;
static_assert(WS_ROWIDX_B == WS_ROWIDX && WS_GATEP_B == WS_GATEP && WS_SLOT_B == WS_SLOT, "metadata offsets");
constexpr size_t WS_WCI = 8 * MiB;
constexpr size_t WS_WCO = 20 * MiB;
constexpr size_t WS_WAI = 24 * MiB;
constexpr size_t WS_WAO = 29 * MiB;
constexpr size_t WS_WGL = 31 * MiB;
constexpr size_t WS_WFG = 35 * MiB;
constexpr size_t WS_WFD = 57 * MiB;
constexpr size_t WS_WMG = 68 * MiB;
constexpr size_t WS_WMD = 244 * MiB;
constexpr size_t WS_HB = 332 * MiB;
constexpr size_t WS_BUF = 364 * MiB;
constexpr size_t WS_ACT = 432 * MiB;
constexpr size_t WS_END = 619 * MiB;
constexpr int MOE_ROWS = 2 * M + NEXP * 256;
constexpr size_t WS_Q = WS_BUF, WS_K = WS_BUF + 32 * MiB, WS_V = WS_BUF + 40 * MiB, WS_QI = WS_BUF + 48 * MiB;
constexpr size_t WS_SC = WS_ACT, WS_O = WS_ACT + 128 * MiB, WS_KI = WS_ACT + 160 * MiB, WS_WI = WS_ACT + 162 * MiB;
static_assert(WS_WMD + (size_t)16 * 1024 * 2816 * 2 <= WS_HB && WS_ACT + (size_t)MOE_ROWS * FF * 2 <= WS_END && WS_BUF + (size_t)MOE_ROWS * DM * 2 <= WS_ACT, "d_ws map");
constexpr int CW_TMO = 0;
constexpr int CW_CNT = 64;
constexpr int CW_BAR = 4096;
constexpr int CW_PAN = 16384;
constexpr size_t WS_XS9 = 5 * MiB + 768 * 1024;
constexpr size_t WS_XS = 5 * MiB + 512 * 1024;

constexpr int RING_BYTES = 131072;
constexpr int LDSCTL_OFF = RING_BYTES, MISC_OFF = LDSCTL_OFF + 320;
constexpr int LDS_BYTES = 147456;

#define XB_TMO      128
#define XB_XCNT(j)  (256  + 64 * (j))
#define XB_XSUB(j)  (1280 + 64 * (j))
#define XB_XGEN(j)  (2304 + 64 * (j))
#define XB_TOP      3328
#define XB_TOPGEN   3392
#define XCD_BAR_WORDS 3456
#define XB_SPIN_CAP (1u << 18)
__device__ __forceinline__ unsigned xb_ld(unsigned* p)              { return __hip_atomic_load(p, __ATOMIC_RELAXED, __HIP_MEMORY_SCOPE_AGENT); }
__device__ __forceinline__ unsigned xb_add(unsigned* p, unsigned v) { return __hip_atomic_fetch_add(p, v, __ATOMIC_RELAXED, __HIP_MEMORY_SCOPE_AGENT); }
__device__ __forceinline__ unsigned xb_xcc_id() { return (unsigned)__builtin_amdgcn_s_getreg((3 << 11) | 20) & 0xFu; }
#define XB_SPIN(cond, bar) do { unsigned _sp = 0; while (cond) { __builtin_amdgcn_s_sleep(1); \
    if ((++_sp & 255u) == 0u) { if (xb_ld(&(bar)[XB_TMO])) break; if (_sp > XB_SPIN_CAP) { atomicAdd(&(bar)[XB_TMO], 1u); break; } } } } while (0)
struct XcdBarrier { unsigned* bar; unsigned x; volatile LAS unsigned* st; int w; };
__device__ __forceinline__ bool xb_thread0(int w) { return w == 0 && lane_id_fresh() == 0; }
__device__ __forceinline__ XcdBarrier xcd_barrier_post(unsigned* bar, volatile LAS unsigned* st, int w) {
    XcdBarrier b; b.bar = bar; b.x = xb_xcc_id(); b.st = st; b.w = w;
    if (xb_thread0(w)) (void)xb_add(&bar[XB_XCNT(b.x)], 1u);
    return b;
}
__device__ __forceinline__ void xcd_barrier_complete(unsigned* bar, unsigned x, unsigned& nloc, unsigned& nx) {
    const unsigned G = gridDim.x * gridDim.y * gridDim.z;
    unsigned sum, cnt, mine, sp = 0u;
    for (;;) {
        sum = 0u; cnt = 0u; mine = 0u;
#pragma unroll
        for (unsigned j = 0; j < 16; ++j) { const unsigned c = xb_ld(&bar[XB_XCNT(j)]); sum += c; cnt += (c > 0u) ? 1u : 0u; mine = (j == x) ? c : mine; }
        if (sum == G) break;
        __builtin_amdgcn_s_sleep(1);
        if ((++sp & 255u) == 0u) { if (xb_ld(&bar[XB_TMO])) break; if (sp > XB_SPIN_CAP) { atomicAdd(&bar[XB_TMO], 1u); break; } }
    }
    nloc = mine > 0u ? mine : 1u; nx = cnt > 0u ? cnt : 1u;
}
__device__ __forceinline__ int lane_probe() { return (int)__builtin_amdgcn_mbcnt_hi(~0u, __builtin_amdgcn_mbcnt_lo(~0u, 0u)); }
__device__ __forceinline__ int lane_probe2() { return (int)__builtin_amdgcn_mbcnt_hi(~0u, __builtin_amdgcn_mbcnt_lo(~0u, 0u)); }
__device__ __forceinline__ void xcd_barrier(const XcdBarrier& b) {
    asm volatile("s_waitcnt vmcnt(0)" ::: "memory");
    __syncthreads();
    if (xb_thread0(b.w)) {
        unsigned* bar = b.bar;
        __builtin_amdgcn_s_waitcnt(0);
        unsigned nloc = b.st[0], nx = b.st[1];
        if (nloc == 0u) { xcd_barrier_complete(bar, b.x, nloc, nx); b.st[0] = nloc; b.st[1] = nx; }
        const unsigned old = xb_add(&bar[XB_XSUB(b.x)], 1u);
        const unsigned gen = old / nloc;
        if (old + 1u == (gen + 1u) * nloc) {
            __builtin_amdgcn_fence(__ATOMIC_RELEASE, "agent");
            asm volatile("s_waitcnt vmcnt(0)" ::: "memory");
            __builtin_amdgcn_fence(__ATOMIC_RELEASE, "agent");
            asm volatile("s_waitcnt vmcnt(0)" ::: "memory");
            const unsigned og = xb_add(&bar[XB_TOP], 1u);
            const unsigned tg = og / nx;
            if (og + 1u == (tg + 1u) * nx) xb_add(&bar[XB_TOPGEN], 1u);
            else XB_SPIN(xb_ld(&bar[XB_TOPGEN]) == tg, bar);
            __builtin_amdgcn_fence(__ATOMIC_ACQUIRE, "agent");
            xb_add(&bar[XB_XGEN(b.x)], 1u);
            { const unsigned dmy = __builtin_nontemporal_load(&bar[XB_TMO]); asm volatile("s_waitcnt vmcnt(0)" :: "v"(dmy) : "memory"); }
        } else {
            XB_SPIN(xb_ld(&bar[XB_XGEN(b.x)]) == gen, bar);
            __builtin_amdgcn_fence(__ATOMIC_ACQUIRE, "agent");
            { const unsigned dmy = __builtin_nontemporal_load(&bar[XB_TMO]); asm volatile("s_waitcnt vmcnt(0)" :: "v"(dmy) : "memory"); }
        }
    }
    __syncthreads();
    if (xb_thread0(b.w)) { __builtin_amdgcn_fence(__ATOMIC_ACQUIRE, "agent"); asm volatile("s_waitcnt vmcnt(0)" ::: "memory"); }
    __syncthreads();
}

struct Args { const float* in[28]; float* out; unsigned char* ws; int ph_lo, ph_hi; };
enum { I_X = 0, I_C, I_ADAW, I_ADAB, I_NORMG, I_CWIN, I_CW, I_CWOUT, I_AWIN, I_QG, I_KG, I_AWOUT, I_RELB, I_SLRE, I_SLIM, I_SLOG, I_SBRE, I_SBIM, I_SCRE, I_SCIM, I_SD, I_SGLU,
       I_FGU, I_FDN, I_RW, I_RB, I_MGU, I_MDN };
struct Frame {
    LAS unsigned char* lds; unsigned char* ws; gu32* ctl;
    int tid, lane, wave, vcu, G;
    float* out; const float* mod;
    bf16_t *HB, *BUF, *ACT;
};

enum { MAP_NAT = 0, MAP_PAIR = 1, MAP_CONV = 2, MAP_ATTN = 3 };
__device__ __forceinline__ int map_row(int map, int half, int n) {
    if (map == MAP_NAT) return n;
    if (map == MAP_PAIR) { return n < half ? 256 * (n / 128) + (n % 128) : 256 * ((n - half) / 128) + 128 + ((n - half) % 128); }
    if (map == MAP_CONV) { if (n < 1024) return 2048 + n; if (n < 2048) { const int q = n - 1024; return 256 * (q / 128) + (q % 128); } const int q = n - 2048; return 256 * (q / 128) + 128 + (q % 128); }
    if (n < 1280) { const int hd = n / 64, d = n % 64; return 256 * (hd / 4) + 128 * (d / 32) + 32 * (hd % 4) + (d % 32); }
    return n;
}
__device__ __forceinline__ void p0_transpose_item(const float* W, int K, int N, bf16_t* WT, int map, int half, LAS float* scr, int item, int lane) {
    const int nblk = (N + 31) / 32, kb = item / nblk, nb = item % nblk, k0 = 64 * kb, n0 = 32 * nb;
    const bool cin = (n0 + (lane & 31)) < N;
    float tv[32];
#pragma unroll
    for (int i = 0; i < 32; ++i) { const int kk = 2 * i + (lane >> 5); tv[i] = cin ? W[(size_t)(k0 + kk) * N + n0 + (lane & 31)] : 0.f; }
#pragma unroll
    for (int i = 0; i < 32; ++i) { const int kk = 2 * i + (lane >> 5); scr[kk * 33 + (lane & 31)] = tv[i]; }
    LDS_WAIT(); CFENCE();
    const int c = lane & 7; const int r0 = map_row(map, half, n0);
#pragma unroll
    for (int j = 0; j < 4; ++j) { const int n = (lane >> 3) + 8 * j; const LAS float* s = scr + (8 * c) * 33 + n;
        u32x4 o; o.x = pk2(s[0 * 33], s[1 * 33]); o.y = pk2(s[2 * 33], s[3 * 33]); o.z = pk2(s[4 * 33], s[5 * 33]); o.w = pk2(s[6 * 33], s[7 * 33]);
        *(GAS u32x4*)(WT + (size_t)(r0 + n) * K + k0 + 8 * c) = o; }
    LDS_WAIT(); CFENCE();
}
__device__ __forceinline__ void p0_transpose_item8(const float* W, int K, int N, unsigned char* WT, int map, int half, LAS float* scr, int item, int lane, int sub) {
    const int nblk = (N + 31) / 32, kb = 2 * (item / nblk) + sub, nb = item % nblk, k0 = 64 * kb, n0 = 32 * nb;
    float tv[32];
#pragma unroll
    for (int i = 0; i < 32; ++i) { const int kk = 2 * i + (lane >> 5); tv[i] = W[(size_t)(k0 + kk) * N + n0 + (lane & 31)]; }
#pragma unroll
    for (int i = 0; i < 32; ++i) { const int kk = 2 * i + (lane >> 5); scr[kk * 33 + (lane & 31)] = tv[i] * pg8::W8_MUL; }
    LDS_WAIT(); CFENCE();
    const int c = lane & 3; const int r0 = map_row(map, half, n0);
#pragma unroll
    for (int j = 0; j < 2; ++j) { const int n = (lane >> 2) + 16 * j; const LAS float* sp = scr + (16 * c) * 33 + n; u32x4 o;
#pragma unroll
        for (int q = 0; q < 4; ++q) { int t = 0; t = __builtin_amdgcn_cvt_pk_fp8_f32(sp[(4 * q) * 33], sp[(4 * q + 1) * 33], t, false); t = __builtin_amdgcn_cvt_pk_fp8_f32(sp[(4 * q + 2) * 33], sp[(4 * q + 3) * 33], t, true); o[q] = (unsigned)t; }
        *(GAS u32x4*)(WT + (size_t)(r0 + n) * K + k0 + 16 * c) = o; }
    LDS_WAIT(); CFENCE();
}
__device__ __forceinline__ void p0_prologue(Frame& F, const Args& A) {
    {
        LAS float* cs = (LAS float*)F.lds;
        LAS float* red = (LAS float*)(F.lds + 16384);
        for (int i = F.tid; i < NB * DM; i += NTHREADS) { const float c = A.in[I_C][i]; cs[i] = c / (1.f + __expf(-c)); }
        __syncthreads();
        const int kg = F.tid >> 6, cj = F.tid & 63;
        for (int un = blockIdx.x; un < 4 * 96; un += F.G) {
            const int l = un / 96, jb = un % 96, j = jb * 64 + cj;
            const float* w = A.in[I_ADAW] + (size_t)l * DM * 6144 + j;
            float a0 = 0.f, a1 = 0.f, a2 = 0.f, a3 = 0.f;
#pragma unroll 8
            for (int k = kg * 128; k < kg * 128 + 128; ++k) { const float wv = w[(size_t)k * 6144]; a0 += cs[k] * wv; a1 += cs[1024 + k] * wv; a2 += cs[2048 + k] * wv; a3 += cs[3072 + k] * wv; }
            *(LAS f32x4*)(red + (kg * 64 + cj) * 4) = (f32x4){a0, a1, a2, a3};
            __syncthreads();
            if (F.tid < 256) { const int b = F.tid >> 6, cc = F.tid & 63; float s = 0.f;
#pragma unroll
                for (int q = 0; q < 8; ++q) s += red[(q * 64 + cc) * 4 + b];
                ((float*)(F.ws + WS_MOD))[((size_t)l * NB + b) * 6144 + jb * 64 + cc] = s + A.in[I_ADAB][l * 6144 + jb * 64 + cc]; }
            __syncthreads();
        }
    }
    LAS float* scr = (LAS float*)(F.lds + 32768 + F.wave * 8704);
    const int gw = F.vcu * NWAVES + F.wave, NGW = F.G * NWAVES;
    constexpr int I_CI = (DM / 64) * (3072 / 32), I_SQ = (DM / 64) * (DM / 32), I_AI = (DM / 64) * ((ATT_N + 31) / 32), I_GL = (DM / 64) * (2048 / 32), I_GU = (DM / 64) * (2 * FF / 32), I_DN = (FF / 128) * (DM / 32), I_DNB = (FF / 64) * (DM / 32);
    constexpr int NITEMS = 2 * I_CI + 2 * I_SQ + I_AI + I_SQ + I_GL + 2 * I_GU + 2 * (F2_FP8 ? I_DN : I_DNB) + 16 * I_GU + 16 * (M2_FP8 ? I_DN : I_DNB);
    for (int it = gw; it < NITEMS; it += NGW) {
        int r = it;
        if (r < 2 * I_CI) { const int q = r / I_CI; p0_transpose_item(A.in[I_CWIN] + (size_t)q * DM * 3072, DM, 3072, (bf16_t*)(F.ws + WS_WCI) + (size_t)q * 3072 * DM, MAP_CONV, 0, scr, r % I_CI, F.lane); continue; } r -= 2 * I_CI;
        if (r < 2 * I_SQ) { const int q = r / I_SQ; p0_transpose_item(A.in[I_CWOUT] + (size_t)q * DM * DM, DM, DM, (bf16_t*)(F.ws + WS_WCO) + (size_t)q * DM * DM, MAP_NAT, 0, scr, r % I_SQ, F.lane); continue; } r -= 2 * I_SQ;
        if (r < I_AI) { p0_transpose_item(A.in[I_AWIN], DM, ATT_N, (bf16_t*)(F.ws + WS_WAI), MAP_ATTN, 0, scr, r, F.lane); continue; } r -= I_AI;
        if (r < I_SQ) { p0_transpose_item(A.in[I_AWOUT], DM, DM, (bf16_t*)(F.ws + WS_WAO), MAP_NAT, 0, scr, r, F.lane); continue; } r -= I_SQ;
        if (r < I_GL) { p0_transpose_item(A.in[I_SGLU], DM, 2048, (bf16_t*)(F.ws + WS_WGL), MAP_PAIR, 1024, scr, r, F.lane); continue; } r -= I_GL;
        if (r < 2 * I_GU) { const int q = r / I_GU; p0_transpose_item(A.in[I_FGU] + (size_t)q * DM * 2 * FF, DM, 2 * FF, (bf16_t*)(F.ws + WS_WFG) + (size_t)q * 2 * FF * DM, MAP_PAIR, FF, scr, r % I_GU, F.lane); continue; } r -= 2 * I_GU;
        if (F2_FP8) { if (r < 2 * I_DN) { const int q = r / I_DN; p0_transpose_item8(A.in[I_FDN] + (size_t)q * FF * DM, FF, DM, (unsigned char*)(F.ws + WS_WFD) + (size_t)q * DM * FF, MAP_NAT, 0, scr, r % I_DN, F.lane, 0); p0_transpose_item8(A.in[I_FDN] + (size_t)q * FF * DM, FF, DM, (unsigned char*)(F.ws + WS_WFD) + (size_t)q * DM * FF, MAP_NAT, 0, scr, r % I_DN, F.lane, 1); continue; } r -= 2 * I_DN; }
        else { if (r < 2 * I_DNB) { const int q = r / I_DNB; p0_transpose_item(A.in[I_FDN] + (size_t)q * FF * DM, FF, DM, (bf16_t*)(F.ws + WS_WFD) + (size_t)q * DM * FF, MAP_NAT, 0, scr, r % I_DNB, F.lane); continue; } r -= 2 * I_DNB; }
        if (r < 16 * I_GU) { const int q = r / I_GU; p0_transpose_item(A.in[I_MGU] + (size_t)q * DM * 2 * FF, DM, 2 * FF, (bf16_t*)(F.ws + WS_WMG) + (size_t)q * 2 * FF * DM, MAP_PAIR, FF, scr, r % I_GU, F.lane); continue; } r -= 16 * I_GU;
        if (M2_FP8) { const int q = r / I_DN; p0_transpose_item8(A.in[I_MDN] + (size_t)q * FF * DM, FF, DM, (unsigned char*)(F.ws + WS_WMD) + (size_t)q * DM * FF, MAP_NAT, 0, scr, r % I_DN, F.lane, 0); p0_transpose_item8(A.in[I_MDN] + (size_t)q * FF * DM, FF, DM, (unsigned char*)(F.ws + WS_WMD) + (size_t)q * DM * FF, MAP_NAT, 0, scr, r % I_DN, F.lane, 1); }
        else { const int q = r / I_DNB; p0_transpose_item(A.in[I_MDN] + (size_t)q * FF * DM, FF, DM, (bf16_t*)(F.ws + WS_WMD) + (size_t)q * DM * FF, MAP_NAT, 0, scr, r % I_DNB, F.lane); }
    }
    { u32x4* z = (u32x4*)((bf16_t*)(F.ws + WS_WAI) + (size_t)2144 * DM); const int n16 = (ATT_NP - 2144) * DM * 2 / 16;
      for (int i = blockIdx.x * NTHREADS + F.tid; i < n16; i += F.G * NTHREADS) z[i] = (u32x4){0u, 0u, 0u, 0u}; }
}

template <int FLAGS>
__device__ __forceinline__ void thin_phase(Frame& F, const Args& A, const float* src, int nl  , int ns  , int cl  , int rl  , int cs = -1  , size_t roff = 0  ) {
    if (cs < 0) cs = rl;
    const int gw = F.vcu * NWAVES + F.wave, NGW = F.G * NWAVES;
    LAS float* rwt = (LAS float*)F.lds;
    if (FLAGS & 8) {
        const float* rw = A.in[I_RW] + (size_t)rl * DM * NEXP;
        for (int i = F.tid; i < DM * NEXP; i += NTHREADS) rwt[(i & 7) * DM + (i >> 3)] = rw[i];
        __syncthreads();
    }
    int Tb[8];
    if (FLAGS & 2) { int acc = 0;
#pragma unroll
        for (int e = 0; e < 8; ++e) { Tb[e] = acc; acc += (int)((__hip_atomic_load(F.ctl + CW_CNT + 64 * (8 * rl + e), RLX_AGENT) + 255u) >> 8); } }
    const float* ng = A.in[I_NORMG] + (size_t)(nl * 2 + ns) * DM;
    constexpr bool RT = (FLAGS & 8) != 0;
    LAS int* rE = (LAS int*)(F.lds + 32768);
    const int nit = RT ? ((M / 64 - (int)blockIdx.x + F.G - 1) / F.G) * 8 : (M - gw + NGW - 1) / NGW;
    for (int it = 0; it < nit; ++it) {
        const int chunk = (int)blockIdx.x + (it >> 3) * F.G;
        const int row = RT ? chunk * 64 + F.wave * 8 + (it & 7) : gw + it * NGW;
        const int b = row / SEQ;
        f32x4 v[4];
        const GAS unsigned long long* xr = (const GAS unsigned long long*)(src + (size_t)row * DM) + 2 * F.lane;
#pragma unroll
        for (int j = 0; j < 4; ++j) { const unsigned long long lo = __hip_atomic_load(xr + 128 * j, RLX_AGENT), hi = __hip_atomic_load(xr + 128 * j + 1, RLX_AGENT);
            v[j] = (f32x4){__uint_as_float((unsigned)lo), __uint_as_float((unsigned)(lo >> 32)), __uint_as_float((unsigned)hi), __uint_as_float((unsigned)(hi >> 32))}; }
        if (FLAGS & 2) {
            const int s0 = ((const int*)(F.ws + roff + WS_SLOT))[row * 2], s1 = ((const int*)(F.ws + roff + WS_SLOT))[row * 2 + 1];
            int t0 = 0, t1 = 0;
#pragma unroll
            for (int e = 0; e < 8; ++e) { if ((s0 >> 16) == e) t0 = Tb[e]; if ((s1 >> 16) == e) t1 = Tb[e]; }
            const bf16_t* y0 = (const bf16_t*)(F.ws + WS_BUF) + (size_t)(256 * t0 + (s0 & 0xffff)) * DM;
            const bf16_t* y1 = (const bf16_t*)(F.ws + WS_BUF) + (size_t)(256 * t1 + (s1 & 0xffff)) * DM;
            const float* g2 = cl >= 0 ? F.mod + ((size_t)cl * NB + b) * 6144 + 5 * DM : (const float*)(F.ws + 512 * 1024);
#pragma unroll
            for (int j = 0; j < 4; ++j) { const int col = 4 * F.lane + 256 * j; const u32x2 a = *(const u32x2*)(y0 + col), c = *(const u32x2*)(y1 + col); const f32x4 g = *(const f32x4*)(g2 + col);
                v[j][0] += g[0] * (bflo(a.x) + bflo(c.x)); v[j][1] += g[1] * (bfhi(a.x) + bfhi(c.x)); v[j][2] += g[2] * (bflo(a.y) + bflo(c.y)); v[j][3] += g[3] * (bfhi(a.y) + bfhi(c.y)); }
        }
        if (FLAGS & 3) { GAS f32x4* xo = (GAS f32x4*)(F.out + (size_t)row * DM) + F.lane;
#pragma unroll
            for (int j = 0; j < 4; ++j) xo[64 * j] = v[j]; }
        if (FLAGS & 4) {
            float ss = 0.f;
#pragma unroll
            for (int j = 0; j < 4; ++j) ss += (v[j][0] * v[j][0] + v[j][1] * v[j][1]) + (v[j][2] * v[j][2] + v[j][3] * v[j][3]);
            const float r = 1.0f / sqrtf(wave_sum(ss) * (1.0f / DM) + EPS);
            const float* sh = F.mod + ((size_t)nl * NB + b) * 6144 + (ns ? 3 : 0) * DM; const float* sc = sh + DM;
            GAS u32x2* ho = (GAS u32x2*)(F.HB + (size_t)row * DM) + F.lane;
#pragma unroll
            for (int j = 0; j < 4; ++j) { const int col = 4 * F.lane + 256 * j; const f32x4 g = *(const f32x4*)(ng + col), s1 = *(const f32x4*)(sc + col), s0 = *(const f32x4*)(sh + col);
                v[j] = (v[j] * r) * g * (s1 + 1.0f) + s0; u32x2 w; w.x = pk2(v[j][0], v[j][1]); w.y = pk2(v[j][2], v[j][3]); ho[64 * j] = w; }
            if (FLAGS & 8) {
                float lg[8];
#pragma unroll
                for (int e = 0; e < 8; ++e) { float s = 0.f;
#pragma unroll
                    for (int j = 0; j < 4; ++j) { const f32x4 w = *(const LAS f32x4*)(rwt + e * DM + 4 * F.lane + 256 * j); s += (v[j][0] * w[0] + v[j][1] * w[1]) + (v[j][2] * w[2] + v[j][3] * w[3]); }
                    lg[e] = wave_sum(s) + A.in[I_RB][rl * NEXP + e]; }
                int e0 = 0; float l0 = lg[0];
#pragma unroll
                for (int e = 1; e < 8; ++e) if (lg[e] > l0) { l0 = lg[e]; e0 = e; }
                int e1 = -1; float l1 = -3.0e38f;
#pragma unroll
                for (int e = 0; e < 8; ++e) if (e != e0 && lg[e] > l1) { l1 = lg[e]; e1 = e; }
                const float g0 = 1.0f / (1.0f + __expf(l1 - l0)), g1 = 1.0f - g0;
                const int lr = F.wave * 8 + (it & 7);
                if (F.lane == 0) { rE[lr] = e0; rE[64 + lr] = e1; rE[128 + lr] = __float_as_int(g0); rE[192 + lr] = __float_as_int(g1); }
            }
        }
        if (RT && (it & 7) == 7) {
            __syncthreads();
            if (F.tid < 8) { int cnt = 0; for (int q = 0; q < 64; ++q) cnt += (rE[q] == F.tid) + (rE[64 + q] == F.tid);
                rE[256 + F.tid] = cnt ? (int)__hip_atomic_fetch_add(F.ctl + CW_CNT + 64 * (8 * cs + F.tid), (unsigned)cnt, RLX_AGENT) : 0; }
            __syncthreads();
            if (F.tid < 64) { const int e0 = rE[F.tid], e1 = rE[64 + F.tid]; int r0 = 0, r1 = 0;
                for (int q = 0; q < F.tid; ++q) { r0 += (rE[q] == e0) + (rE[64 + q] == e0); r1 += (rE[q] == e1) + (rE[64 + q] == e1); }
                const int p0 = rE[256 + e0] + r0, p1 = rE[256 + e1] + r1, grow = chunk * 64 + F.tid;
                gu32* ri = (gu32*)(F.ws + roff + WS_ROWIDX); gu32* gp = (gu32*)(F.ws + roff + WS_GATEP); gu32* sl = (gu32*)(F.ws + roff + WS_SLOT);
                __hip_atomic_store(ri + e0 * 16384 + p0, (unsigned)grow, RLX_AGENT); __hip_atomic_store(ri + e1 * 16384 + p1, (unsigned)grow, RLX_AGENT);
                __hip_atomic_store(gp + e0 * 16384 + p0, (unsigned)rE[128 + F.tid], RLX_AGENT); __hip_atomic_store(gp + e1 * 16384 + p1, (unsigned)rE[192 + F.tid], RLX_AGENT);
                __hip_atomic_store(sl + grow * 2, (unsigned)((e0 << 16) | p0), RLX_AGENT); __hip_atomic_store(sl + grow * 2 + 1, (unsigned)((e1 << 16) | p1), RLX_AGENT); }
            __syncthreads();
        }
    }
}

__device__ __forceinline__ void unpack8(const u32x4 w, float (&f)[8]) { f[0] = bflo(w.x); f[1] = bfhi(w.x); f[2] = bflo(w.y); f[3] = bfhi(w.y); f[4] = bflo(w.z); f[5] = bfhi(w.z); f[6] = bflo(w.w); f[7] = bfhi(w.w); }
__device__ __forceinline__ void conv_phase(Frame& F, const float* cw  ) {
    const int gw = F.vcu * NWAVES + F.wave, NGW = F.G * NWAVES;
    const bf16_t* UB = F.BUF;
    for (int task = gw; task < M / 8; task += NGW) {
        const int r0 = task * 8; const bool first = (r0 % SEQ) == 0;
#pragma unroll
        for (int j = 0; j < 2; ++j) {
            const int ch = 8 * F.lane + 512 * j;
            float w0[8], w1[8], w2[8];
#pragma unroll
            for (int e = 0; e < 8; ++e) { w0[e] = cw[ch + e]; w1[e] = cw[DM + ch + e]; w2[e] = cw[2 * DM + ch + e]; }
            float um2[8], um1[8];
            if (first) {
#pragma unroll
                for (int e = 0; e < 8; ++e) { um2[e] = 0.f; um1[e] = 0.f; }
            } else { unpack8(*(const u32x4*)(UB + (size_t)(r0 - 2) * 2048 + ch), um2); unpack8(*(const u32x4*)(UB + (size_t)(r0 - 1) * 2048 + ch), um1); }
#pragma unroll
            for (int i = 0; i < 8; ++i) {
                float u0[8], bb[8]; unpack8(*(const u32x4*)(UB + (size_t)(r0 + i) * 2048 + ch), u0); unpack8(*(const u32x4*)(UB + (size_t)(r0 + i) * 2048 + 1024 + ch), bb);
                float z[8];
#pragma unroll
                for (int e = 0; e < 8; ++e) z[e] = bb[e] * (w0[e] * um2[e] + w1[e] * um1[e] + w2[e] * u0[e]);
                u32x4 o; o.x = pk2(z[0], z[1]); o.y = pk2(z[2], z[3]); o.z = pk2(z[4], z[5]); o.w = pk2(z[6], z[7]);
                *(u32x4*)(F.HB + (size_t)(r0 + i) * DM + ch) = o;
#pragma unroll
                for (int e = 0; e < 8; ++e) { um2[e] = um1[e]; um1[e] = u0[e]; }
            }
        }
    }
}

constexpr int QIP = 1040;
constexpr int AL_QI = 0, AL_WI = 33280, AL_SEL = 34304, AL_V = 42496, AL_BIASD = 108032, AL_SUM = 116288, AL_END = 116800;
typedef short v4i16_t __attribute__((ext_vector_type(4)));
__device__ __forceinline__ unsigned okey(float f) { const unsigned u = __float_as_uint(f); return u ^ ((u >> 31) ? 0xFFFFFFFFu : 0x80000000u); }
__device__ __forceinline__ void attn_phase(Frame& F, const Args& A) {
    LAS unsigned char* L = F.lds;
    const bf16_t* Qb = (const bf16_t*)(F.ws + WS_Q); const bf16_t* Kb = (const bf16_t*)(F.ws + WS_K); const bf16_t* Vb = (const bf16_t*)(F.ws + WS_V);
    const bf16_t* QIb = (const bf16_t*)(F.ws + WS_QI); const bf16_t* KIb = (const bf16_t*)(F.ws + WS_KI); const float* WIb = (const float*)(F.ws + WS_WI);
    bf16_t* Ob = (bf16_t*)(F.ws + WS_O);
    float* SC = (float*)(F.ws + WS_SC) + (size_t)blockIdx.x * 32 * SEQ;
    const int lane = F.lane, wave = F.wave;
    { LAS float* bd = (LAS float*)(L + AL_BIASD);
      for (int i = F.tid; i < 129 * 16; i += NTHREADS) { const int d = i >> 4; int bkt; if (d < 16) bkt = d; else { const float dd = (float)d; const int lg2 = 16 + (int)(logf(dd / 16.0f) / 2.0794415416798357f * 16.0f); bkt = lg2 < 31 ? lg2 : 31; }
          bd[i] = A.in[I_RELB][bkt * 16 + (i & 15)]; }
    }
    __syncthreads();
    for (int pass = 0; pass < 2; ++pass) {
        const int un = pass == 0 ? (int)blockIdx.x : 511 - (int)blockIdx.x;
        for (int uu = un; uu >= 0 && uu < 512; uu += (pass == 0 ? F.G * 2 : -F.G * 2)) {
        if ((pass == 0 && uu >= 256) || (pass == 1 && uu < 256)) break;
        const int b = uu & 3, qb = uu >> 2, t0 = qb * 32; const size_t rb = (size_t)b * SEQ;
        for (int i = F.tid; i < 32 * 64; i += NTHREADS) { const int q = i >> 6, c = i & 63; *(LAS u32x4*)(L + AL_QI + q * QIP + c * 16) = *(const u32x4*)(QIb + (rb + t0 + q) * 512 + c * 8); }
        if (F.tid < 256) ((LAS float*)(L + AL_WI))[F.tid] = WIb[(rb + t0) * 8 + F.tid];
        __syncthreads();
        {
            for (int kt = wave; kt <= qb; kt += NWAVES) {
                int ln1 = lane; asm volatile("" : "+v"(ln1));
                const int r = ln1 & 31, hh = ln1 >> 5;
                float wi[8];
#pragma unroll
                for (int h = 0; h < 8; ++h) wi[h] = ((LAS float*)(L + AL_WI))[r * 8 + h];
                bf16x8 ka[4];
#pragma unroll
                for (int ks = 0; ks < 4; ++ks) ka[ks] = *(const bf16x8*)(KIb + (rb + kt * 32 + r) * 64 + 16 * ks + 8 * hh);
                f32x16 sc;
#pragma unroll
                for (int i = 0; i < 16; ++i) sc[i] = 0.f;
#pragma unroll
                for (int h = 0; h < 8; ++h) {
                    f32x16 d;
#pragma unroll
                    for (int i = 0; i < 16; ++i) d[i] = 0.f;
#pragma unroll
                    for (int ks = 0; ks < 4; ++ks) { const bf16x8 qf = *(const LAS bf16x8*)(L + AL_QI + r * QIP + (h * 64 + 16 * ks + 8 * hh) * 2); d = __builtin_amdgcn_mfma_f32_32x32x16_bf16(ka[ks], qf, d, 0, 0, 0); }
#pragma unroll
                    for (int i = 0; i < 16; ++i) sc[i] += wi[h] * fmaxf(d[i], 0.f);
                }
#pragma unroll
                for (int a = 0; a < 4; ++a) { f32x4 o;
#pragma unroll
                    for (int e = 0; e < 4; ++e) { const int krow = 8 * a + 4 * hh + e; o[e] = (kt == qb && krow > r) ? -INFINITY : sc[4 * a + e]; }
                    *(f32x4*)(SC + (size_t)r * SEQ + kt * 32 + 8 * a + 4 * hh) = o; }
            }
        }
        VM_WAIT(); __syncthreads();
        for (int qq = 0; qq < 4; ++qq) {
            const int c = wave + 8 * qq, t = t0 + c; const int nvalid = t + 1;
            int lane = F.lane; asm volatile("" : "+v"(lane));
            LAS int* sel = (LAS int*)(L + AL_SEL) + wave * 256;
            int count;
            if (nvalid <= TOPK) {
                count = nvalid;
#pragma unroll
                for (int j = 0; j < 4; ++j) { const int idx = 64 * j + lane; sel[idx] = idx < nvalid ? idx : 0; }
            } else {
                count = TOPK;
                const int nj = (nvalid + 63) >> 6;
                unsigned key[64];
                const float* srow = SC + (size_t)c * SEQ;
#define SEL_GROUPS(BODY) do { BODY(0) if (nj > 16) { BODY(1) if (nj > 32) { BODY(2) if (nj > 48) { BODY(3) } } } } while (0)
#define SEL_LOAD(g) { _Pragma("unroll") for (int j = 16 * (g); j < 16 * (g) + 16; ++j) { const int idx = 64 * j + lane; const float sv = __uint_as_float(__hip_atomic_load((const gu32*)(srow + idx), RLX_AGENT)); key[j] = idx <= t ? okey(sv) : 0u;     } }
#pragma unroll
                for (int j = 0; j < 64; ++j) key[j] = 0u;
                SEL_GROUPS(SEL_LOAD);
                unsigned T = 0u;
                for (int bit = 31; bit >= 0; --bit) {
                    const unsigned cand = T | (1u << bit); int cnt = 0;
#define SEL_CNT(g) { _Pragma("unroll") for (int j = 16 * (g); j < 16 * (g) + 16; ++j) cnt += __popcll(__ballot(key[j] >= cand)); }
                    SEL_GROUPS(SEL_CNT);
                    if (cnt >= TOPK) T = cand;
                    if (cnt == TOPK) break;
                }
                int base = 0;
#define SEL_GT(g) { _Pragma("unroll") for (int j = 16 * (g); j < 16 * (g) + 16; ++j) { const bool gt = key[j] > T; const unsigned long long mk = __ballot(gt); \
                    const int pos = base + (int)__builtin_amdgcn_mbcnt_hi((unsigned)(mk >> 32), __builtin_amdgcn_mbcnt_lo((unsigned)mk, 0u)); if (gt) sel[pos] = 64 * j + lane; base += __popcll(mk); } }
                SEL_GROUPS(SEL_GT);
                const int need = TOPK - base; int eb = 0;
#define SEL_EQ(g) { _Pragma("unroll") for (int j = 16 * (g); j < 16 * (g) + 16; ++j) { const bool eq = key[j] == T; const unsigned long long mk = __ballot(eq); \
                    const int rank = eb + (int)__builtin_amdgcn_mbcnt_hi((unsigned)(mk >> 32), __builtin_amdgcn_mbcnt_lo((unsigned)mk, 0u)); if (eq && rank < need) sel[base + rank] = 64 * j + lane; eb += __popcll(mk); } }
                SEL_GROUPS(SEL_EQ);
#undef SEL_GROUPS
#undef SEL_LOAD
#undef SEL_CNT
#undef SEL_GT
#undef SEL_EQ
            }
            LDS_WAIT(); CFENCE();
            asm volatile("" : "+v"(lane));
            const int hd = lane & 15, kq = lane >> 4;
            bf16x8 bq[8];
            { bf16x8 qf[2];
#pragma unroll
              for (int s2 = 0; s2 < 2; ++s2) qf[s2] = *(const bf16x8*)(Qb + (rb + t) * 1024 + hd * 64 + 32 * s2 + 8 * kq);
              const bf16x8 zf = (bf16x8){0, 0, 0, 0, 0, 0, 0, 0};
#pragma unroll
              for (int ks = 0; ks < 8; ++ks) bq[ks] = ((ks >> 1) == (hd >> 2)) ? qf[ks & 1] : zf; }
            f32x4 lg[16];
            float mx = -INFINITY;
            bf16x8 kf[3][8];
#pragma unroll
            for (int pre = 0; pre < 2; ++pre) { const int krow = sel[16 * pre + hd]; const bf16_t* kp = Kb + (rb + krow) * 256 + 8 * kq;
#pragma unroll
              for (int ks = 0; ks < 8; ++ks) kf[pre][ks] = *(const bf16x8*)(kp + 32 * ks); }
            const LAS float* biasd = (const LAS float*)(L + AL_BIASD);
#pragma unroll
            for (int kt = 0; kt < 16; ++kt) {
                if (kt < 14) { const int krow = sel[16 * (kt + 2) + hd]; const bf16_t* kp = Kb + (rb + krow) * 256 + 8 * kq;
#pragma unroll
                    for (int ks = 0; ks < 8; ++ks) kf[(kt + 2) % 3][ks] = *(const bf16x8*)(kp + 32 * ks); }
                f32x4 d = (f32x4){0.f, 0.f, 0.f, 0.f};
#pragma unroll
                for (int ks = 0; ks < 8; ++ks) d = __builtin_amdgcn_mfma_f32_16x16x32_bf16(kf[kt % 3][ks], bq[ks], d, 0, 0, 0);
                const u32x4 ks4 = *(const LAS u32x4*)(sel + 16 * kt + 4 * kq);
#pragma unroll
                for (int i = 0; i < 4; ++i) { const int pos = 16 * kt + 4 * kq + i; int dist = t - (int)ks4[i]; dist = dist < 0 ? 0 : (dist > 128 ? 128 : dist);
                    const float bs = biasd[dist * 16 + hd];
                    d[i] = pos < count ? d[i] + bs : -INFINITY; mx = fmaxf(mx, d[i]); }
                lg[kt] = d;
            }
            mx = fmaxf(mx, __shfl_xor(mx, 16)); mx = fmaxf(mx, __shfl_xor(mx, 32));
            float sum = 0.f;
            bf16x8 pa[8];
#pragma unroll
            for (int ks = 0; ks < 8; ++ks) { float p[8];
#pragma unroll
                for (int i = 0; i < 4; ++i) { p[i] = __expf(lg[2 * ks][i] - mx); p[4 + i] = __expf(lg[2 * ks + 1][i] - mx); }
                sum += ((p[0] + p[1]) + (p[2] + p[3])) + ((p[4] + p[5]) + (p[6] + p[7]));
                u32x4 w; w.x = cvt_pk_bf16(p[0], p[1]); w.y = cvt_pk_bf16(p[2], p[3]); w.z = cvt_pk_bf16(p[4], p[5]); w.w = cvt_pk_bf16(p[6], p[7]);
                pa[ks] = __builtin_bit_cast(bf16x8, w); }
            sum += __shfl_xor(sum, 16); sum += __shfl_xor(sum, 32);
            if (kq == 0) ((LAS float*)(L + AL_SUM))[wave * 16 + hd] = sum;
            LDS_WAIT(); CFENCE();
            {
                asm volatile("" : "+v"(lane));
                const int rs = lane >> 3, ch = lane & 7, i16 = lane & 15, tq = i16 >> 2, tp = i16 & 3, kq2 = lane >> 4;
                LAS unsigned char* vb = L + AL_V + wave * 8192;
                const unsigned wr_off = (unsigned)lane * 16u, tr_off = (unsigned)((4 * kq2 + tq) * 128 + 8 * tp);
                f32x4 O[4][4];
#pragma unroll
                for (int n = 0; n < 4; ++n)
#pragma unroll
                    for (int dt = 0; dt < 4; ++dt) O[n][dt] = (f32x4){0.f, 0.f, 0.f, 0.f};
                u32x4 vr[2][4]; int kr[4];
                const bf16_t* vbase = Vb + rb * 256 + 8 * ch;
#pragma unroll
                for (int i = 0; i < 4; ++i) kr[i] = sel[8 * i + rs];
#pragma unroll
                for (int pre = 0; pre < 2; ++pre)
#pragma unroll
                    for (int i = 0; i < 4; ++i) vr[pre][i] = *(const u32x4*)(vbase + (size_t)kr[i] * 256 + pre * 64);
#pragma unroll
                for (int st = 0; st < 32; ++st) {
                    const int ks = st >> 2, n = st & 3;
                    LAS unsigned char* buf = vb + (st & 1) * 4096;
#pragma unroll
                    for (int i = 0; i < 4; ++i) *(LAS u32x4*)(buf + wr_off + i * 1024) = vr[st & 1][i];
                    if (st < 30) { const int ks2 = (st + 2) >> 2, n2 = (st + 2) & 3;
                        if (n2 == 0) {
#pragma unroll
                            for (int i = 0; i < 4; ++i) kr[i] = sel[32 * ks2 + 8 * i + rs]; }
#pragma unroll
                        for (int i = 0; i < 4; ++i) vr[st & 1][i] = *(const u32x4*)(vbase + (size_t)kr[i] * 256 + n2 * 64); }
#pragma unroll
                    for (int dt = 0; dt < 4; ++dt) {
                        const v4i16_t t0 = __builtin_amdgcn_ds_read_tr16_b64_v4i16((LAS v4i16_t*)(buf + tr_off + 32 * dt));
                        const v4i16_t t1 = __builtin_amdgcn_ds_read_tr16_b64_v4i16((LAS v4i16_t*)(buf + tr_off + 2048 + 32 * dt));
                        const bf16x8 bfr = (bf16x8){t0[0], t0[1], t0[2], t0[3], t1[0], t1[1], t1[2], t1[3]};
                        O[n][dt] = __builtin_amdgcn_mfma_f32_16x16x32_bf16(pa[ks], bfr, O[n][dt], 0, 0, 0); }
                    CFENCE();
                }
                const f32x4 sm = *(const LAS f32x4*)(L + AL_SUM + (wave * 16 + 4 * kq2) * 4);
                bf16_t* op = Ob + (rb + t) * 1024 + (4 * kq2) * 64 + i16;
#pragma unroll
                for (int dt = 0; dt < 4; ++dt)
#pragma unroll
                    for (int i = 0; i < 4; ++i) { const float v = kq2 == 0 ? O[0][dt][i] : (kq2 == 1 ? O[1][dt][i] : (kq2 == 2 ? O[2][dt][i] : O[3][dt][i]));
                        op[i * 64 + 16 * dt] = (bf16_t)f2bf(v / sm[i]); }
            }
            LDS_WAIT(); CFENCE();
        }
        __syncthreads();
        }
    }
}

constexpr int SL_BMT = 0;
constexpr int SL_CMA = 4096;
constexpr int SL_AB = 12288;
constexpr int SL_E = 12800;
constexpr int SL_S = 16896;
constexpr int SPITCH = 272;
__device__ __forceinline__ void cmul(float ar, float ai, float br, float bi, float& cr, float& ci) { cr = ar * br - ai * bi; ci = ar * bi + ai * br; }
__device__ __forceinline__ void ssm_phase(Frame& F, const Args& A) {
    LAS unsigned char* L = F.lds;
    const int lane = F.lane, wave = F.wave;
    bf16_t* G = (bf16_t*)(F.ws + WS_ACT);
    for (int un = F.vcu; un < NB * 64; un += F.G) {
        const int b = un >> 6, g = un & 63; const size_t rb = (size_t)b * SEQ;
        __syncthreads();
        if (F.tid < 64) {
            const int p = F.tid;
            const float lr = fminf(A.in[I_SLRE][g * 64 + p], -1e-4f), li = A.in[I_SLIM][g * 64 + p];
            const float step = expf(A.in[I_SLOG][g]);
            const float mag = expf(lr * step); float sn, cs; sincosf(li * step, &sn, &cs);
            const float ar = mag * cs, ai = mag * sn;
            ((LAS float*)(L + SL_AB))[2 * p] = ar; ((LAS float*)(L + SL_AB))[2 * p + 1] = ai;
            const float nr = ar - 1.0f, ni = ai, den = lr * lr + li * li;
            const float cr = (nr * lr + ni * li) / den, ci = (ni * lr - nr * li) / den;
            LAS bf16_t* bm = (LAS bf16_t*)(L + SL_BMT);
#pragma unroll
            for (int c = 0; c < 16; ++c) { const float br = A.in[I_SBRE][((size_t)g * 64 + p) * 16 + c], bi = A.in[I_SBIM][((size_t)g * 64 + p) * 16 + c];
                float xr, xi; cmul(cr, ci, br, bi, xr, xi); bm[p * 16 + c] = (bf16_t)f2bf(xr); bm[(64 + p) * 16 + c] = (bf16_t)f2bf(xi); }
        }
        { LAS bf16_t* cm = (LAS bf16_t*)(L + SL_CMA);
          for (int i = F.tid; i < 32 * 128; i += NTHREADS) { const int c = i >> 7, k = i & 127; float v = 0.f;
              if (c < 16) v = (k < 64) ? A.in[I_SCRE][((size_t)g * 16 + c) * 64 + k] : -A.in[I_SCIM][((size_t)g * 16 + c) * 64 + (k - 64)];
              cm[i] = (bf16_t)f2bf(v); } }
        __syncthreads();
        const int r = lane & 31, hh = lane >> 5;
        bf16x8 bfr[4];
#pragma unroll
        for (int n = 0; n < 4; ++n) bfr[n] = *(const LAS bf16x8*)(L + SL_BMT + ((32 * n + r) * 16 + 8 * hh) * 2);
        bf16x8 cfr[8];
#pragma unroll
        for (int ks = 0; ks < 8; ++ks) cfr[ks] = *(const LAS bf16x8*)(L + SL_CMA + (r * 128 + 16 * ks + 8 * hh) * 2);
        float ar[2], ai[2], a16r[2], a16i[2], a512r[2], a512i[2];
#pragma unroll
        for (int s = 0; s < 2; ++s) { ar[s] = ((LAS float*)(L + SL_AB))[2 * (32 * s + r)]; ai[s] = ((LAS float*)(L + SL_AB))[2 * (32 * s + r) + 1];
            float pr = ar[s], pi = ai[s];
#pragma unroll
            for (int q = 0; q < 4; ++q) { float nr, ni; cmul(pr, pi, pr, pi, nr, ni); pr = nr; pi = ni; }
            a16r[s] = pr; a16i[s] = pi;
#pragma unroll
            for (int q = 0; q < 5; ++q) { float nr, ni; cmul(pr, pi, pr, pi, nr, ni); pr = nr; pi = ni; }
            a512r[s] = pr; a512i[s] = pi; }
        const int tokperm = 16 * ((r >> 2) & 1) + 4 * (r >> 3) + (r & 3);
        const float dsk0 = 0.f; (void)dsk0;
        float cin_r[2] = {0.f, 0.f}, cin_i[2] = {0.f, 0.f};
        LAS unsigned char* Sw = L + SL_S + wave * (32 * SPITCH);
        for (int pass = 0; pass < 2; ++pass) {
            if (pass == 1) {
                __syncthreads();
#pragma unroll
                for (int s = 0; s < 2; ++s) { float cr = 0.f, ci = 0.f;
                    for (int w = 0; w < wave; ++w) { float nr, ni; cmul(a512r[s], a512i[s], cr, ci, nr, ni); cr = nr + ((LAS float*)(L + SL_E))[(w * 64 + 32 * s + r) * 2]; ci = ni + ((LAS float*)(L + SL_E))[(w * 64 + 32 * s + r) * 2 + 1]; }
                    cin_r[s] = cr; cin_i[s] = ci; }
            }
            bf16x8 ufn = *(const bf16x8*)(F.HB + (rb + wave * 512 + tokperm) * DM + 16 * g + 8 * hh);
            for (int tile = 0; tile < 16; ++tile) {
                const int tk0 = wave * 512 + tile * 32;
                const bf16x8 uf = ufn;
                if (tile < 15) ufn = *(const bf16x8*)(F.HB + (rb + tk0 + 32 + tokperm) * DM + 16 * g + 8 * hh);

                f32x16 d[4];
#pragma unroll
                for (int n = 0; n < 4; ++n) {
#pragma unroll
                    for (int i = 0; i < 16; ++i) d[n][i] = 0.f;
                    d[n] = __builtin_amdgcn_mfma_f32_32x32x16_bf16(uf, bfr[n], d[n], 0, 0, 0); }
#pragma unroll
                for (int s = 0; s < 2; ++s) {
                    float sr = hh == 0 ? cin_r[s] : 0.f, si = hh == 0 ? cin_i[s] : 0.f;
#pragma unroll
                    for (int i = 0; i < 16; ++i) { const float nr = ar[s] * sr - ai[s] * si + d[s][i], ni = ar[s] * si + ai[s] * sr + d[2 + s][i]; sr = nr; si = ni; d[s][i] = sr; d[2 + s][i] = si; }
                    const float e0r = __shfl_xor(sr, 32), e0i = __shfl_xor(si, 32);
                    float cr = hh == 1 ? e0r : 0.f, ci = hh == 1 ? e0i : 0.f;
                    if (pass == 1) {
#pragma unroll
                        for (int i = 0; i < 16; ++i) { float nr, ni; cmul(ar[s], ai[s], cr, ci, nr, ni); cr = nr; ci = ni; d[s][i] += cr; d[2 + s][i] += ci; }
                    } else { float nr, ni; cmul(a16r[s], a16i[s], cr, ci, nr, ni); cr = nr; ci = ni; }
                    const float endr = (pass == 1) ? d[s][15] : sr + cr, endi = (pass == 1) ? d[2 + s][15] : si + ci;
                    const float xr = __shfl_xor(endr, 32), xi = __shfl_xor(endi, 32);
                    cin_r[s] = hh == 1 ? endr : xr; cin_i[s] = hh == 1 ? endi : xi;
                }
                if (pass == 1) {
#pragma unroll
                    for (int s = 0; s < 2; ++s)
#pragma unroll
                        for (int i = 0; i < 16; ++i) { *(LAS bf16_t*)(Sw + (16 * hh + i) * SPITCH + (32 * s + r) * 2) = (bf16_t)f2bf(d[s][i]); *(LAS bf16_t*)(Sw + (16 * hh + i) * SPITCH + (64 + 32 * s + r) * 2) = (bf16_t)f2bf(d[2 + s][i]); }
                    LDS_WAIT(); CFENCE();
                    f32x16 y;
#pragma unroll
                    for (int i = 0; i < 16; ++i) y[i] = 0.f;
#pragma unroll
                    for (int ks = 0; ks < 8; ++ks) { const bf16x8 sf = *(const LAS bf16x8*)(Sw + r * SPITCH + (16 * ks + 8 * hh) * 2); y = __builtin_amdgcn_mfma_f32_32x32x16_bf16(cfr[ks], sf, y, 0, 0, 0); }
                    LDS_WAIT(); CFENCE();
                    const size_t trow = rb + tk0 + r;
#pragma unroll
                    for (int q = 0; q < 2; ++q) { const int ch = 16 * g + 8 * q + 4 * hh;
                        const u32x2 hv = *(const u32x2*)(F.HB + trow * DM + ch); const f32x4 dk = *(const f32x4*)(A.in[I_SD] + ch);
                        const float y0 = gelu_tanh_f(y[4 * q + 0] + dk[0] * bflo(hv.x)), y1 = gelu_tanh_f(y[4 * q + 1] + dk[1] * bfhi(hv.x)), y2 = gelu_tanh_f(y[4 * q + 2] + dk[2] * bflo(hv.y)), y3 = gelu_tanh_f(y[4 * q + 3] + dk[3] * bfhi(hv.y));
                        u32x2 w; w.x = pk2(y0, y1); w.y = pk2(y2, y3); *(u32x2*)(G + trow * DM + ch) = w; }
                }
            }
            if (pass == 0) {
                if (hh == 1) {
#pragma unroll
                    for (int s = 0; s < 2; ++s) { ((LAS float*)(L + SL_E))[(wave * 64 + 32 * s + r) * 2] = cin_r[s]; ((LAS float*)(L + SL_E))[(wave * 64 + 32 * s + r) * 2 + 1] = cin_i[s]; } }
                cin_r[0] = cin_r[1] = cin_i[0] = cin_i[1] = 0.f;
            }
        }
    }
}

enum { PH_PRO = 0, PH_NORM0,
       L0_G1, L0_CONV, L0_G2, L0_NORM, L0_F1, L0_F2, L0_NORMN,
       L1_G1, L1_ATTN, L1_G2, L1_NORMR, L1_M1, L1_M2, L1_COMB,
       L2_SSM, L2_G2, L2_NORM, L2_F1, L2_F2, L2_NORMN,
       L3_G1, L3_CONV, L3_G2, L3_NORMR, L3_M1, L3_M2, L3_COMB, NPH };

__device__ __forceinline__ bool fresh_ids(Frame& F) { const int l = lane_id_fresh(); F.lane = l; F.tid = F.wave * 64 + l; return true; }
__global__ void __launch_bounds__(NTHREADS, 2) mega_fwd(Args args) {
    extern __shared__ __attribute__((aligned(16))) unsigned char lds_raw[];
    Frame F;
    F.lds = (LAS unsigned char*)lds_raw;
    volatile LAS unsigned* MISC = (volatile LAS unsigned*)(F.lds + MISC_OFF);
    F.tid = threadIdx.x; F.lane = F.tid & 63; F.wave = __builtin_amdgcn_readfirstlane(F.tid >> 6);
    F.G = gridDim.x; { const int bx = blockIdx.x; F.vcu = (F.G % 8 == 0) ? (bx % 8) * (F.G / 8) + bx / 8 : bx; }
    F.ws = args.ws; F.ctl = (gu32*)(args.ws + WS_CTL); F.out = args.out; F.mod = (const float*)(args.ws + WS_MOD);
    F.HB = (bf16_t*)(args.ws + WS_HB); F.BUF = (bf16_t*)(args.ws + WS_BUF); F.ACT = (bf16_t*)(args.ws + WS_ACT);
    for (int u = F.tid; u < (LDS_BYTES - LDSCTL_OFF) / 4; u += NTHREADS) ((LAS unsigned*)(F.lds + LDSCTL_OFF))[u] = 0u;
    __syncthreads();
    XcdBarrier bar; bar.bar = (unsigned*)(F.ctl + CW_BAR); bar.x = 0; bar.st = nullptr; bar.w = F.wave;
    const int lo = args.ph_lo, hi = args.ph_hi;
    if (hi - lo > 1) bar = xcd_barrier_post((unsigned*)(F.ctl + CW_BAR), MISC + 8, F.wave);
#ifndef PH_ONLY
#define PH_EN(k) true
#else
#define PH_EN(k) ((k) == PH_ONLY)
#endif
#define IN(k) (PH_EN(k) && lo <= (k) && (k) < hi && fresh_ids(F))
#define SEAM(k) do { if (IN(k) && IN((k) + 1)) xcd_barrier(bar); } while (0)
#ifndef PH_REP
#define PH_REP (-1)
#endif
#ifndef PH_REPMASK
#define PH_REPMASK 0ull
#endif
#define REPB(k, ...) do { if (PH_REP == (k) || ((PH_REPMASK >> (k)) & 1ull)) { xcd_barrier(bar); __VA_ARGS__; } } while (0)
    LAS unsigned char* ring = F.lds;
    const int cid = (int)blockIdx.x;
    bf16_t* const WCI = (bf16_t*)(F.ws + WS_WCI); bf16_t* const WCO = (bf16_t*)(F.ws + WS_WCO); bf16_t* const WAI = (bf16_t*)(F.ws + WS_WAI); bf16_t* const WAO = (bf16_t*)(F.ws + WS_WAO);
    bf16_t* const WGL = (bf16_t*)(F.ws + WS_WGL); bf16_t* const WFG = (bf16_t*)(F.ws + WS_WFG); bf16_t* const WFD = (bf16_t*)(F.ws + WS_WFD); bf16_t* const WMG = (bf16_t*)(F.ws + WS_WMG); bf16_t* const WMD = (bf16_t*)(F.ws + WS_WMD);

#define ZEROG ((const float*)(F.ws + 512 * 1024))
    const bool fuseR = (F.G == 256) && FUSE_R;
    const bool fuse = (F.G == 256) && FUSE_N;
#define FUSED_EPI(inst, gatep, xin, nl, ns, hout, asc) ({F.out, (gatep), (xin), args.in[I_NORMG] + (size_t)((nl) * 2 + (ns)) * DM, F.mod + (size_t)(nl) * NB * 6144 + ((ns) ? 3 : 0) * DM, (hout), (float*)(F.ws + WS_XS), F.ctl + CW_PAN + 64 * 64 * (inst), F.ctl + CW_TMO, (asc)})
#define FUSED_RT(inst, gatep, nl, rl, roff, hout) ({F.out, (gatep), args.in[I_NORMG] + (size_t)((nl) * 2 + 1) * DM, F.mod + (size_t)(nl) * NB * 6144 + 3 * DM, (hout), (float*)(F.ws + WS_XS9), F.ctl + CW_PAN + 64 * 64 * (inst), F.ctl + CW_TMO, \
        args.in[I_RW] + (size_t)(rl) * DM * NEXP, args.in[I_RB] + (rl) * NEXP, F.ctl + CW_CNT + 64 * 8 * (rl), F.ws + (roff)})
#define MODP(l, chunk) (F.mod + (size_t)(l) * NB * 6144 + (chunk) * DM)
#define GEMM_STATIC(Aptr, Bptr, Nn, Kk, EpiT, EpiInit) do { pg8::Gemm g{(Aptr), (Bptr), M, (Nn), (Kk), 0, nullptr, nullptr}; pg8::StaticOrder S; S.init(M, (Nn), F.G, cid); EpiT E EpiInit; \
        pg8::gemm_phase<EpiT, pg8::StaticOrder, false>(ring, g, S, E, F.wave); } while (0)
#define GEMM_STATIC8(Aptr, Bptr, Nn, Kk, EpiT, EpiInit) do { pg8::Gemm g{(Aptr), (Bptr), M, (Nn), (Kk), 0, nullptr, nullptr}; pg8::StaticOrder S; S.init(M, (Nn), F.G, cid); EpiT E EpiInit; \
        pg8::gemm_phase<EpiT, pg8::StaticOrder, false, true>(ring, g, S, E, F.wave); } while (0)
#define EPAIR8 pg8::EpiPair<1, (M2_FP8 != 0), false>
#define M2_B (M2_FP8 ? 1 : 2)
#define F2_ASC (F2_FP8 ? pg8::W8_INV : 1.0f)
#define GEMM_STATICF(Aptr, Bptr, Nn, Kk, EpiT, EpiInit) do { pg8::Gemm g{(Aptr), (Bptr), M, (Nn), (Kk), 0, nullptr, nullptr}; pg8::StaticOrder S; S.init(M, (Nn), F.G, cid); EpiT E EpiInit; \
        pg8::gemm_phase<EpiT, pg8::StaticOrder, false, (F2_FP8 != 0)>(ring, g, S, E, F.wave); } while (0)
#define EPAIRF pg8::EpiPair<1, (F2_FP8 != 0), false>
#define W8(base, bytes) ((bf16_t*)((unsigned char*)(base) + (size_t)(bytes)))

    if (IN(PH_PRO)) { p0_prologue(F, args); REPB(PH_PRO, p0_prologue(F, args)); } SEAM(PH_PRO);
    if (IN(PH_NORM0)) { thin_phase<4>(F, args, args.in[I_X], 0, 0, 0, 0); REPB(PH_NORM0, thin_phase<4>(F, args, args.in[I_X], 0, 0, 0, 0)); } SEAM(PH_NORM0);

    if (IN(L0_G1)) { GEMM_STATIC(F.HB, WCI, 3072, DM, pg8::EpiConvIn, {F.BUF}); REPB(L0_G1, GEMM_STATIC(F.HB, WCI, 3072, DM, pg8::EpiConvIn, {F.BUF})); } SEAM(L0_G1);
    if (IN(L0_CONV)) { conv_phase(F, args.in[I_CW]); REPB(L0_CONV, conv_phase(F, args.in[I_CW])); } SEAM(L0_CONV);
    if (IN(L0_G2)) { if (fuse) GEMM_STATIC(F.HB, WCO, DM, DM, pg8::EpiResNorm, FUSED_EPI(0, MODP(0, 2), args.in[I_X], 0, 1, (fuse ? F.BUF : F.HB), 1.0f)); else GEMM_STATIC(F.HB, WCO, DM, DM, pg8::EpiRes, ({F.out, MODP(0, 2), args.in[I_X], 1.0f})); } SEAM(L0_G2);
    if (!fuse) { if (IN(L0_NORM)) { thin_phase<4>(F, args, F.out, 0, 1, 0, 0); } SEAM(L0_NORM); }
    if (IN(L0_F1)) { GEMM_STATIC((fuse ? F.BUF : F.HB), WFG, 2 * FF, DM, EPAIRF, ({F.ACT, FF})); REPB(L0_F1, GEMM_STATIC(F.HB, WFG, 2 * FF, DM, EPAIRF, ({F.ACT, FF}))); } SEAM(L0_F1);
    if (IN(L0_F2)) { if (fuse) GEMM_STATICF(F.ACT, WFD, DM, FF, pg8::EpiResNorm, FUSED_EPI(1, MODP(0, 5), F.out, 1, 0, F.HB, F2_ASC)); else GEMM_STATICF(F.ACT, WFD, DM, FF, pg8::EpiRes, ({F.out, MODP(0, 5), F.out, F2_ASC})); } SEAM(L0_F2);
    if (!fuse) { if (IN(L0_NORMN)) { thin_phase<4>(F, args, F.out, 1, 0, 0, 0); } SEAM(L0_NORMN); }

    if (IN(L1_G1)) { GEMM_STATIC(F.HB, WAI, ATT_NP, DM, pg8::EpiAttnIn, ({(bf16_t*)(F.ws + WS_Q), (bf16_t*)(F.ws + WS_K), (bf16_t*)(F.ws + WS_V), (bf16_t*)(F.ws + WS_QI), (bf16_t*)(F.ws + WS_KI), (float*)(F.ws + WS_WI), args.in[I_QG], args.in[I_KG]})); REPB(L1_G1, GEMM_STATIC(F.HB, WAI, ATT_NP, DM, pg8::EpiAttnIn, ({(bf16_t*)(F.ws + WS_Q), (bf16_t*)(F.ws + WS_K), (bf16_t*)(F.ws + WS_V), (bf16_t*)(F.ws + WS_QI), (bf16_t*)(F.ws + WS_KI), (float*)(F.ws + WS_WI), args.in[I_QG], args.in[I_KG]}))); } SEAM(L1_G1);
    if (IN(L1_ATTN)) { attn_phase(F, args); REPB(L1_ATTN, attn_phase(F, args)); } SEAM(L1_ATTN);
    if (IN(L1_G2)) { if (fuseR) GEMM_STATIC((bf16_t*)(F.ws + WS_O), WAO, DM, DM, pg8::EpiResNormRouter, FUSED_RT(3, MODP(1, 2), 1, 0, 0, F.HB)); else GEMM_STATIC((bf16_t*)(F.ws + WS_O), WAO, DM, DM, pg8::EpiRes, ({F.out, MODP(1, 2), F.out, 1.0f})); } SEAM(L1_G2);
    if (!fuseR) { if (IN(L1_NORMR)) { thin_phase<4 | 8>(F, args, F.out, 1, 1, 0, 0); } SEAM(L1_NORMR); }
    if (IN(L1_M1)) { pg8::Gemm g{F.HB, WMG, M, 2 * FF, DM, (size_t)2 * FF * DM * 2, (const int*)(F.ws + WS_ROWIDX), (const unsigned*)(F.ctl + CW_CNT)}; pg8::MoeOrder S; S.init((const unsigned*)(F.ctl + CW_CNT), 22, F.G, cid);
        EPAIR8 E{F.ACT, FF}; pg8::gemm_phase<EPAIR8, pg8::MoeOrder, true>(ring, g, S, E, F.wave); REPB(L1_M1, pg8::gemm_phase<EPAIR8, pg8::MoeOrder, true>(ring, g, S, E, F.wave)); } SEAM(L1_M1);
    if (IN(L1_M2)) { pg8::Gemm g{F.ACT, WMD, M, DM, FF, (size_t)DM * FF * M2_B, nullptr, nullptr}; pg8::MoeOrder S; S.init((const unsigned*)(F.ctl + CW_CNT), 4, F.G, cid);
        pg8::EpiMoeDn E{F.BUF, (const float*)(F.ws + WS_GATEP)}; pg8::gemm_phase<pg8::EpiMoeDn, pg8::MoeOrder, false, (M2_FP8 != 0)>(ring, g, S, E, F.wave); REPB(L1_M2, pg8::gemm_phase<pg8::EpiMoeDn, pg8::MoeOrder, false, (M2_FP8 != 0)>(ring, g, S, E, F.wave)); } SEAM(L1_M2);
    if (IN(L1_COMB)) { thin_phase<2 | 4>(F, args, F.out, 2, 0, 1, 0); REPB(L1_COMB, thin_phase<2 | 4>(F, args, F.out, 2, 0, -1, 0)); } SEAM(L1_COMB);

    if (IN(L2_SSM)) { ssm_phase(F, args); REPB(L2_SSM, ssm_phase(F, args)); } SEAM(L2_SSM);
    if (IN(L2_G2)) { GEMM_STATIC(F.ACT, WGL, 2048, DM, pg8::EpiGluRes, ({F.out, MODP(2, 2)})); REPB(L2_G2, GEMM_STATIC(F.ACT, WGL, 2048, DM, pg8::EpiGluRes, ({F.out, ZEROG}))); } SEAM(L2_G2);
    if (IN(L2_NORM)) { thin_phase<4>(F, args, F.out, 2, 1, 0, 0); REPB(L2_NORM, thin_phase<4>(F, args, F.out, 2, 1, 0, 0)); } SEAM(L2_NORM);
    if (IN(L2_F1)) { GEMM_STATIC(F.HB, WFG + (size_t)2 * FF * DM, 2 * FF, DM, EPAIRF, ({F.ACT, FF})); REPB(L2_F1, GEMM_STATIC(F.HB, WFG + (size_t)2 * FF * DM, 2 * FF, DM, EPAIRF, ({F.ACT, FF}))); } SEAM(L2_F1);
    if (IN(L2_F2)) { if (fuse) GEMM_STATICF(F.ACT, W8(WFD, (size_t)DM * FF * (F2_FP8 ? 1 : 2)), DM, FF, pg8::EpiResNorm, FUSED_EPI(2, MODP(2, 5), F.out, 3, 0, F.HB, F2_ASC)); else GEMM_STATICF(F.ACT, W8(WFD, (size_t)DM * FF * (F2_FP8 ? 1 : 2)), DM, FF, pg8::EpiRes, ({F.out, MODP(2, 5), F.out, F2_ASC})); } SEAM(L2_F2);
    if (!fuse) { if (IN(L2_NORMN)) { thin_phase<4>(F, args, F.out, 3, 0, 0, 0); } SEAM(L2_NORMN); }

    if (IN(L3_G1)) { GEMM_STATIC(F.HB, WCI + (size_t)3072 * DM, 3072, DM, pg8::EpiConvIn, {F.BUF}); REPB(L3_G1, GEMM_STATIC(F.HB, WCI + (size_t)3072 * DM, 3072, DM, pg8::EpiConvIn, {F.BUF})); } SEAM(L3_G1);
    if (IN(L3_CONV)) { conv_phase(F, args.in[I_CW] + 3 * DM); REPB(L3_CONV, conv_phase(F, args.in[I_CW] + 3 * DM)); } SEAM(L3_CONV);
    if (IN(L3_G2)) { if (fuseR) GEMM_STATIC(F.HB, WCO + (size_t)DM * DM, DM, DM, pg8::EpiResNormRouter, FUSED_RT(4, MODP(3, 2), 3, 1, 2 * MiB, F.BUF)); else GEMM_STATIC(F.HB, WCO + (size_t)DM * DM, DM, DM, pg8::EpiRes, ({F.out, MODP(3, 2), F.out, 1.0f})); } SEAM(L3_G2);
    if (!fuseR) { if (IN(L3_NORMR)) { thin_phase<4 | 8>(F, args, F.out, 3, 1, 0, 1, 1, 2 * MiB); } SEAM(L3_NORMR); }
    if (IN(L3_M1)) { pg8::Gemm g{(fuseR ? F.BUF : F.HB), WMG + (size_t)8 * 2 * FF * DM, M, 2 * FF, DM, (size_t)2 * FF * DM * 2, (const int*)(F.ws + 2 * MiB + WS_ROWIDX), (const unsigned*)(F.ctl + CW_CNT + 512)}; pg8::MoeOrder S; S.init((const unsigned*)(F.ctl + CW_CNT + 512), 22, F.G, cid);
        EPAIR8 E{F.ACT, FF}; pg8::gemm_phase<EPAIR8, pg8::MoeOrder, true>(ring, g, S, E, F.wave); REPB(L3_M1, pg8::gemm_phase<EPAIR8, pg8::MoeOrder, true>(ring, g, S, E, F.wave)); } SEAM(L3_M1);
    if (IN(L3_M2)) { pg8::Gemm g{F.ACT, W8(WMD, (size_t)8 * DM * FF * M2_B), M, DM, FF, (size_t)DM * FF * M2_B, nullptr, nullptr}; pg8::MoeOrder S; S.init((const unsigned*)(F.ctl + CW_CNT + 512), 4, F.G, cid);
        pg8::EpiMoeDn E{F.BUF, (const float*)(F.ws + 2 * MiB + WS_GATEP)}; pg8::gemm_phase<pg8::EpiMoeDn, pg8::MoeOrder, false, (M2_FP8 != 0)>(ring, g, S, E, F.wave); REPB(L3_M2, pg8::gemm_phase<pg8::EpiMoeDn, pg8::MoeOrder, false, (M2_FP8 != 0)>(ring, g, S, E, F.wave)); } SEAM(L3_M2);
    if (IN(L3_COMB)) { thin_phase<2>(F, args, F.out, 0, 0, 3, 1, 1, 2 * MiB); }
#undef IN
#undef SEAM
}

extern "C" void kernel_launch(void* const* d_in, const int* in_sizes, int n_in, void* d_out, int out_size, void* d_ws, size_t ws_size, hipStream_t stream) {
    static int grid = 0;
    if (grid == 0) {
        if (n_in != 28 || in_sizes[0] != M * DM || out_size != M * DM || ws_size < WS_END) { fprintf(stderr, "kernel_launch: unexpected shapes / workspace (n_in %d, ws %zu, need %zu)\n", n_in, ws_size, (size_t)WS_END); grid = -1; return; }
        int dev = 0, cus = 0, per_cu = 0;
        if (hipGetDevice(&dev) != hipSuccess || hipDeviceGetAttribute(&cus, hipDeviceAttributeMultiprocessorCount, dev) != hipSuccess) { grid = -1; return; }
        if (hipFuncSetAttribute((const void*)mega_fwd, hipFuncAttributeMaxDynamicSharedMemorySize, LDS_BYTES) != hipSuccess) { fprintf(stderr, "kernel_launch: hipFuncSetAttribute failed\n"); grid = -1; return; }
        if (hipOccupancyMaxActiveBlocksPerMultiprocessor(&per_cu, (const void*)mega_fwd, NTHREADS, LDS_BYTES) != hipSuccess || per_cu < 1) fprintf(stderr, "kernel_launch: occupancy query reports %d\n", per_cu);
        (void)hipGetLastError();
        grid = cus;
    }
    if (grid < 0) return;
    (void)hipMemsetAsync((char*)d_ws + WS_CTL, 0, CTL_ZERO_BYTES, stream);
    Args a{};
    for (int i = 0; i < 28; ++i) a.in[i] = (const float*)d_in[i];
    a.out = (float*)d_out; a.ws = (unsigned char*)d_ws;
#if MK_PER_PHASE
    for (int p = 0; p < NPH; ++p) { a.ph_lo = p; a.ph_hi = p + 1; hipLaunchKernelGGL(mega_fwd, dim3(grid), dim3(NTHREADS), LDS_BYTES, stream, a); }
#else
    a.ph_lo = 0; a.ph_hi = NPH; hipLaunchKernelGGL(mega_fwd, dim3(grid), dim3(NTHREADS), LDS_BYTES, stream, a);
#endif
}
```

```cpp
#include <hip/hip_runtime.h>
#include <cstdio>
#include <cstdint>
#include <cmath>

#ifndef MK_PER_PHASE
#define MK_PER_PHASE 0
#endif

#define GAS __attribute__((address_space(1)))
#define LAS __attribute__((address_space(3)))
typedef unsigned short bf16_t;
typedef short bf16x8 __attribute__((ext_vector_type(8)));
typedef float f32x4 __attribute__((ext_vector_type(4)));
typedef float f32x2 __attribute__((ext_vector_type(2)));
typedef float f32x16 __attribute__((ext_vector_type(16)));
typedef unsigned u32x4 __attribute__((ext_vector_type(4)));
typedef unsigned u32x2 __attribute__((ext_vector_type(2)));
typedef GAS unsigned gu32;
#define RLX_AGENT __ATOMIC_RELAXED, __HIP_MEMORY_SCOPE_AGENT
#define LDS_WAIT() asm volatile("s_waitcnt lgkmcnt(0)" ::: "memory")
#define VM_WAIT() asm volatile("s_waitcnt vmcnt(0)" ::: "memory")
#define CFENCE() asm volatile("" ::: "memory")

constexpr int DM = 1024, NB = 4, SEQ = 4096, M = NB * SEQ, FF = 2816, NEXP = 8;
constexpr int NH = 16, NKV = 4, HD = 64, IH = 8, IDIM = 64, TOPK = 256;
constexpr int ATT_N = 2120, ATT_NP = 2304;
constexpr float EPS = 1e-6f;
constexpr int NWAVES = 8, NTHREADS = 512;

__device__ __forceinline__ unsigned f2bf(float f) { unsigned u = __builtin_bit_cast(unsigned, f); return (u + 0x7fffu + ((u >> 16) & 1u)) >> 16; }
__device__ __forceinline__ unsigned pk2(float lo, float hi) { return f2bf(lo) | (f2bf(hi) << 16); }
__device__ __forceinline__ unsigned cvt_pk_bf16(float lo, float hi) { unsigned r; asm volatile("v_cvt_pk_bf16_f32 %0, %1, %2" : "=v"(r) : "v"(lo), "v"(hi)); return r; }
__device__ __forceinline__ float bflo(unsigned u) { return __uint_as_float(u << 16); }
__device__ __forceinline__ float bfhi(unsigned u) { return __uint_as_float(u & 0xffff0000u); }
__device__ __forceinline__ float wave_sum(float v) {
#pragma unroll
    for (int o = 1; o < 64; o <<= 1) v += __shfl_xor(v, o);
    return v;
}
__device__ __forceinline__ float fast_rcp(float x) { return __builtin_amdgcn_rcpf(x); }
__device__ __forceinline__ float silu_f(float g) { return g * fast_rcp(1.f + __expf(-g)); }
__device__ __forceinline__ float sigmoid_f(float g) { return fast_rcp(1.f + __expf(-g)); }
__device__ __forceinline__ float gelu_tanh_f(float y) { const float z = 0.7978845608028654f * (y + 0.044715f * y * y * y); const float t = 1.f - 2.f * fast_rcp(__expf(2.f * z) + 1.f); return 0.5f * y * (1.f + t); }

constexpr size_t WS_ROWIDX_B = 2u << 20, WS_GATEP_B = (2u << 20) + 512 * 1024, WS_SLOT_B = 3u << 20;
__device__ __forceinline__ int lane_id_fresh() { int l; asm volatile("v_mbcnt_lo_u32_b32 %0, -1, 0\n\tv_mbcnt_hi_u32_b32 %0, -1, %0" : "=v"(l)); return l; }
#ifndef FUSE_R
#define FUSE_R 1
#endif
#ifndef FUSE_N
#define FUSE_N 1
#endif
#ifndef M2_FP8
#define M2_FP8 1
#endif
#ifndef M1_FP8
#define M1_FP8 1
#endif
#ifndef F2L0_FP8
#define F2L0_FP8 1
#endif
#ifndef F2_FP8
#define F2_FP8 1
#endif
namespace pg8 {
constexpr int BM = 256, BK = 64, HALF = 128, HTB = HALF * BK * 2, STAGE_BYTES = 8 * HTB, NXCD = 8, WGM = 8;
__host__ __device__ __forceinline__ int lds_byte(int r, int c) { const int st = (r >> 4) * 2 + (c >> 5), rr = r & 15, cc = c & 31, ob = rr * 64 + cc * 2; return st * 1024 + (ob ^ (((ob >> 9) & 1) << 5)); }
__host__ __device__ __forceinline__ void stage_rc(int b, int& R, int& C) { const int st = b / 1024, sb = b % 1024, swz = sb ^ (((sb >> 9) & 1) << 5); R = (st >> 1) * 16 + swz / 64; C = (st & 1) * 32 + (swz % 64) / 2; }
__host__ __device__ __forceinline__ int perm32(int rho) { const int n = rho >> 4, i = rho & 15; return 8 * (i >> 2) + 4 * n + (i & 3); }

struct Unit { int pm, pn, e, aux; };
struct Gemm { const bf16_t* A; const bf16_t* Bt; int M, N, K; size_t bstride_e; const int* rowidx; const unsigned* cnt; };

struct StaticOrder {
    int nM, nN, nwg, G, c;
    __device__ __forceinline__ void init(int M_, int N_, int G_, int c_) { nM = M_ / BM; nN = N_ / BM; nwg = nM * nN; G = G_; c = c_; }
    __device__ __forceinline__ bool next(int i, Unit& u) const {
        const long L = (long)i * G + c; if (L >= nwg) return false;
        int wgid = (int)L; { const int q = nwg / NXCD, r = nwg % NXCD, xcd = wgid % NXCD, off = wgid / NXCD; wgid = (xcd < r ? xcd * (q + 1) : r * (q + 1) + (xcd - r) * q) + off; }
        const int nig = WGM * nN, gid = wgid / nig, fm = gid * WGM, gsz = (nM - fm) < WGM ? (nM - fm) : WGM;
        u.pm = fm + ((wgid % nig) % gsz); u.pn = (wgid % nig) / gsz; u.e = 0; u.aux = 0; return true;
    }
};
struct MoeOrder {
    int T1, T2, T3, T4, T5, T6, T7, T8, NT, W, r, lo, ntl;
    static constexpr int RG = 4;
    __device__ __forceinline__ void init(const unsigned* cnt, int NT_, int G_, int c_) {
        int t[9]; int acc = 0;
#pragma unroll
        for (int e = 0; e < 8; ++e) { t[e] = acc; acc += (int)((__hip_atomic_load(cnt + 64 * e, RLX_AGENT) + 255u) >> 8); }
        t[8] = acc; T1 = t[1]; T2 = t[2]; T3 = t[3]; T4 = t[4]; T5 = t[5]; T6 = t[6]; T7 = t[7]; T8 = t[8]; NT = NT_;
        if (G_ % 8 == 0) { const int xv = c_ % 8; W = G_ / 8; r = c_ / 8; lo = (T8 * xv) / 8; ntl = (T8 * (xv + 1)) / 8 - lo; }
        else { W = G_; r = c_; lo = 0; ntl = T8; }
    }
    __device__ __forceinline__ bool next(int i, Unit& u) const {
        const int q = i * W + r; if (q >= ntl * NT) return false;
        const int nig = RG * NT, gid = q / nig, fm = gid * RG, gsz = (ntl - fm) < RG ? (ntl - fm) : RG, w = q - gid * nig;
        const int tt = lo + fm + (w % gsz), pn = w / gsz;
        int e = 0, te = 0;
        if (tt >= T1) { e = 1; te = T1; } if (tt >= T2) { e = 2; te = T2; } if (tt >= T3) { e = 3; te = T3; } if (tt >= T4) { e = 4; te = T4; }
        if (tt >= T5) { e = 5; te = T5; } if (tt >= T6) { e = 6; te = T6; } if (tt >= T7) { e = 7; te = T7; }
        u.pm = tt; u.pn = pn; u.e = e; u.aux = e * 16384 + 256 * (tt - te); return true;
    }
};

typedef int v8i32 __attribute__((ext_vector_type(8)));
typedef int v4i32 __attribute__((ext_vector_type(4)));
constexpr float W8_MUL = 32.0f, W8_INV = 1.0f / 32.0f;
__device__ __forceinline__ void mfma8(f32x4& c, const v8i32 a, const v8i32 b) { asm volatile("v_mfma_f32_16x16x128_f8f6f4 %0, %1, %2, %0" : "+v"(c) : "v"(a), "v"(b)); }
__device__ __forceinline__ v8i32 cat8(const bf16x8 a, const bf16x8 b) { return __builtin_shufflevector(__builtin_bit_cast(v4i32, a), __builtin_bit_cast(v4i32, b), 0, 1, 2, 3, 4, 5, 6, 7); }
template <class Epi, class Sched, bool GATHER, bool FP8 = false>
__device__ __forceinline__ void gemm_phase(LAS unsigned char* lds, const Gemm g, const Sched& S, const Epi& E, const int wid) {
    const int lane = lane_id_fresh(), tid = wid * 64 + lane, wr = wid >> 2, wc = wid & 3, fr = lane & 15, fq = lane >> 4;
    const int K = FP8 ? g.K / 2 : g.K, nt = K / BK;
    unsigned voffB[2]; int stR[2], stC[2];
#pragma unroll
    for (int i = 0; i < 2; ++i) { int R, C; stage_rc(tid * 16 + i * 8192, R, C); const int Rb = (R & ~31) + perm32(R & 31);
        stR[i] = R; stC[i] = C; voffB[i] = (unsigned)(Rb * K + C) * 2u; }
    const size_t kstep = (size_t)(BK * 2);
    const size_t hstep = (size_t)HALF * K * 2;
    const size_t tstep = 2 * hstep;
    const unsigned ldsw = (unsigned)wid * 1024u;
    const int aoff = lds_byte(wr * 64 + fr, fq * 8), boff = lds_byte(wc * 32 + fr, fq * 8);
#define PG8_SA(b, h) (((b) * 2 + (h)) * HTB)
#define PG8_SB(b, h) ((4 + (b) * 2 + (h)) * HTB)
#define PG8_STAGE(bufoff, gbase, voff) do { _Pragma("unroll") for (int _i = 0; _i < 2; ++_i) \
        __builtin_amdgcn_global_load_lds((const unsigned*)((const char*)(gbase) + (voff)[_i]), (LAS unsigned*)(lds + (bufoff) + ldsw + _i * 8192), 16, 0, 0); } while (0)
#define PG8_LDA(dst, b, h) do { _Pragma("unroll") for (int m = 0; m < 4; ++m) _Pragma("unroll") for (int k = 0; k < 2; ++k) dst[m][k] = *(const LAS bf16x8*)(lds + PG8_SA(b, h) + aoff + m * 2048 + k * 1024); } while (0)
#define PG8_LDB(dst, b, h) do { _Pragma("unroll") for (int n = 0; n < 2; ++n) _Pragma("unroll") for (int k = 0; k < 2; ++k) dst[n][k] = *(const LAS bf16x8*)(lds + PG8_SB(b, h) + boff + n * 2048 + k * 1024); } while (0)
#define PG8_MMA(ai, bj, At, Bt) do { __builtin_amdgcn_s_setprio(1); _Pragma("unroll") for (int m = 0; m < 4; ++m) _Pragma("unroll") for (int n = 0; n < 2; ++n) { \
        if (FP8) mfma8(acc[ai][bj][m][n], cat8(Bt[n][0], Bt[n][1]), cat8(At[m][0], At[m][1])); \
        else { _Pragma("unroll") for (int k = 0; k < 2; ++k) acc[ai][bj][m][n] = __builtin_amdgcn_mfma_f32_16x16x32_bf16(Bt[n][k], At[m][k], acc[ai][bj][m][n], 0, 0, 0); } } \
        __builtin_amdgcn_s_setprio(0); } while (0)
#define PG8_MMA_END(At, B0, B1) do { if (FP8) { asm volatile("s_nop 15\n\ts_nop 15\n\ts_nop 15\n\ts_nop 15" :: "v"(cat8(At[0][0], At[0][1])), "v"(cat8(At[1][0], At[1][1])), "v"(cat8(At[2][0], At[2][1])), "v"(cat8(At[3][0], At[3][1])), \
        "v"(cat8(B0[0][0], B0[0][1])), "v"(cat8(B0[1][0], B0[1][1])), "v"(cat8(B1[0][0], B1[0][1])), "v"(cat8(B1[1][0], B1[1][1]))); } } while (0)
#define PG8_WAIT_V(n) asm volatile("s_waitcnt vmcnt(" #n ")" ::: "memory")
#define PG8_WAIT_L(n) asm volatile("s_waitcnt lgkmcnt(" #n ")" ::: "memory")
#define PG8_BAR __builtin_amdgcn_s_barrier()
#define PG8_SCHED __builtin_amdgcn_sched_barrier(0)
#define PG8_AOFFS(v, U) do { _Pragma("unroll") for (int _h = 0; _h < 2; ++_h) _Pragma("unroll") for (int _i = 0; _i < 2; ++_i) { \
        if (GATHER) { const int _loc = ((U).aux & 16383) + _h * HALF + stR[_i]; const int _e = (U).aux >> 14; \
            const int _row = (_loc < (int)g.cnt[64 * _e]) ? g.rowidx[(U).aux + _h * HALF + stR[_i]] : 0; \
            v[_h][_i] = (unsigned)(_row * K + stC[_i]) * 2u; } \
        else v[_h][_i] = (unsigned)((_h * HALF + stR[_i]) * K + stC[_i]) * 2u; } } while (0)
    int cn8[8];
#pragma unroll
    for (int e = 0; e < 8; ++e) cn8[e] = GATHER ? __builtin_amdgcn_readfirstlane((int)g.cnt[64 * e]) : 0;
    Unit cur, nxt; int ui = 0;
    if (!S.next(0, cur)) return;
    f32x4 acc[2][2][4][2];
#pragma unroll
    for (int a = 0; a < 2; ++a)
#pragma unroll
        for (int b = 0; b < 2; ++b)
#pragma unroll
            for (int m = 0; m < 4; ++m)
#pragma unroll
                for (int n = 0; n < 2; ++n) acc[a][b][m][n] = (f32x4){0.f, 0.f, 0.f, 0.f};
    bf16x8 At[4][2], B0[2][2], B1[2][2];
    unsigned vAc[2][2], vAn[2][2];
    PG8_AOFFS(vAc, cur);
    const char* cA = (const char*)g.A + (GATHER ? (size_t)0 : (size_t)cur.pm * tstep);
    const char* cB = (const char*)g.Bt + (size_t)cur.e * g.bstride_e + (size_t)cur.pn * tstep;
    PG8_STAGE(PG8_SB(0, 0), cB, voffB); PG8_STAGE(PG8_SB(0, 1), cB + hstep, voffB); PG8_STAGE(PG8_SA(0, 0), cA, vAc[0]); PG8_STAGE(PG8_SA(0, 1), cA, vAc[1]);
    if (wr == 1) PG8_BAR;
    PG8_WAIT_V(2); PG8_BAR;
    PG8_STAGE(PG8_SB(1, 0), cB + kstep, voffB); PG8_STAGE(PG8_SA(1, 0), cA + kstep, vAc[0]); PG8_STAGE(PG8_SB(1, 1), cB + hstep + kstep, voffB);
    PG8_WAIT_V(6); PG8_BAR;
    for (;;) {
        const bool has_next = S.next(ui + 1, nxt);
        const char* nA = cA; const char* nB = cB;
        int rn[2][2];
        if (has_next) { if (GATHER) {
#pragma unroll
                for (int h = 0; h < 2; ++h)
#pragma unroll
                    for (int i = 0; i < 2; ++i) rn[h][i] = g.rowidx[nxt.aux + h * HALF + stR[i]]; }
            else PG8_AOFFS(vAn, nxt);
            nA = (const char*)g.A + (GATHER ? (size_t)0 : (size_t)nxt.pm * tstep); nB = (const char*)g.Bt + (size_t)nxt.e * g.bstride_e + (size_t)nxt.pn * tstep; }
        else {
#pragma unroll
            for (int h = 0; h < 2; ++h)
#pragma unroll
                for (int i = 0; i < 2; ++i) vAn[h][i] = vAc[h][i];
        }
#pragma nounroll
        for (int t = 0; t < nt; t += 2) {
            const bool last = (t == nt - 2);
            const char* a1 = cA + (size_t)(t + 1) * kstep;
            const char* a2 = last ? nA : cA + (size_t)(t + 2) * kstep; const char* b2 = last ? nB : cB + (size_t)(t + 2) * kstep;
            const char* a3 = a2 + kstep; const char* b3 = b2 + kstep;
            if (GATHER && last && has_next) { const int _e = nxt.aux >> 14;
                const int _cn = _e == 0 ? cn8[0] : _e == 1 ? cn8[1] : _e == 2 ? cn8[2] : _e == 3 ? cn8[3] : _e == 4 ? cn8[4] : _e == 5 ? cn8[5] : _e == 6 ? cn8[6] : cn8[7];
#pragma unroll
                for (int h = 0; h < 2; ++h)
#pragma unroll
                    for (int i = 0; i < 2; ++i) { int r_ = rn[h][i]; asm volatile("" : "+v"(r_)); const int _loc = (nxt.aux & 16383) + h * HALF + stR[i];
                        r_ = _loc < _cn ? r_ : 0; vAn[h][i] = (unsigned)(r_ * K + stC[i]) * 2u; } }
            unsigned v2[2][2];
#pragma unroll
            for (int h = 0; h < 2; ++h)
#pragma unroll
                for (int i = 0; i < 2; ++i) v2[h][i] = last ? vAn[h][i] : vAc[h][i];
            PG8_LDB(B0, 0, 0); PG8_LDB(B1, 0, 1); PG8_SCHED; PG8_LDA(At, 0, 0); PG8_STAGE(PG8_SA(1, 1), a1, vAc[1]);
            PG8_WAIT_V(8); PG8_WAIT_L(0); PG8_BAR; PG8_MMA(0, 0, At, B0); PG8_MMA(0, 1, At, B1); PG8_MMA_END(At, B0, B1); PG8_BAR; PG8_SCHED;
            PG8_LDA(At, 0, 1); PG8_STAGE(PG8_SB(0, 0), b2, voffB); PG8_STAGE(PG8_SB(0, 1), b2 + hstep, voffB); PG8_STAGE(PG8_SA(0, 0), a2, v2[0]);
            PG8_WAIT_V(8); PG8_WAIT_L(0); PG8_BAR; PG8_MMA(1, 0, At, B0); PG8_MMA(1, 1, At, B1); PG8_MMA_END(At, B0, B1); PG8_BAR; PG8_SCHED;
            PG8_LDB(B0, 1, 0); PG8_LDB(B1, 1, 1); PG8_SCHED; PG8_LDA(At, 1, 0); PG8_STAGE(PG8_SA(0, 1), a2, v2[1]);
            PG8_WAIT_V(8); PG8_WAIT_L(0); PG8_BAR; PG8_MMA(0, 0, At, B0); PG8_MMA(0, 1, At, B1); PG8_MMA_END(At, B0, B1); PG8_BAR; PG8_SCHED;
            PG8_LDA(At, 1, 1); PG8_STAGE(PG8_SB(1, 0), b3, voffB); PG8_STAGE(PG8_SB(1, 1), b3 + hstep, voffB); PG8_STAGE(PG8_SA(1, 0), a3, v2[0]);
            PG8_WAIT_V(8); PG8_WAIT_L(0); PG8_BAR; PG8_MMA(1, 0, At, B0); PG8_MMA(1, 1, At, B1); PG8_MMA_END(At, B0, B1); PG8_BAR; PG8_SCHED;
        }
        if (wr == 0) PG8_BAR;
        if (FP8) asm volatile("s_nop 15\n\ts_nop 15\n\ts_nop 15\n\ts_nop 15\n\ts_nop 15\n\ts_nop 15" ::: "memory");
        if constexpr (!Epi::FUSED) E(acc, cur, wr, wc, fr, fq);
        if (!has_next) break;
#pragma unroll
        for (int a = 0; a < 2; ++a)
#pragma unroll
            for (int b = 0; b < 2; ++b)
#pragma unroll
                for (int m = 0; m < 4; ++m)
#pragma unroll
                    for (int n = 0; n < 2; ++n) acc[a][b][m][n] = (f32x4){0.f, 0.f, 0.f, 0.f};
        cur = nxt; cA = nA; cB = nB; ++ui;
#pragma unroll
        for (int h = 0; h < 2; ++h)
#pragma unroll
            for (int i = 0; i < 2; ++i) vAc[h][i] = vAn[h][i];
        if (wr == 1) PG8_BAR;
    }
    PG8_WAIT_V(0);
    PG8_BAR;
    if constexpr (Epi::FUSED) E.fused(acc, cur, wr, wc, fr, fq, lds, wid, lane);
#undef PG8_SA
#undef PG8_SB
#undef PG8_STAGE
#undef PG8_LDA
#undef PG8_LDB
#undef PG8_MMA
#undef PG8_MMA_END
#undef PG8_WAIT_V
#undef PG8_WAIT_L
#undef PG8_BAR
#undef PG8_SCHED
#undef PG8_AOFFS
}

__device__ __forceinline__ f32x4 ldx16(const float* p) { const GAS unsigned long long* q = (const GAS unsigned long long*)p; const unsigned long long a = __hip_atomic_load(q, RLX_AGENT), c = __hip_atomic_load(q + 1, RLX_AGENT);
    return (f32x4){__uint_as_float((unsigned)a), __uint_as_float((unsigned)(a >> 32)), __uint_as_float((unsigned)c), __uint_as_float((unsigned)(c >> 32))}; }
typedef f32x4 Acc[2][2][4][2];
__device__ __forceinline__ u32x4 pack8(const f32x4 a, const f32x4 b) { u32x4 w; w.x = cvt_pk_bf16(a[0], a[1]); w.y = cvt_pk_bf16(a[2], a[3]); w.z = cvt_pk_bf16(b[0], b[1]); w.w = cvt_pk_bf16(b[2], b[3]); return w; }

template <int MODE, bool OUT8 = false, bool SC8 = OUT8> struct EpiPair {
    static constexpr bool FUSED = false;
    bf16_t* O; int ldo;
    __device__ __forceinline__ void operator()(const Acc& acc, const Unit& u, int wr, int wc, int fr, int fq) const {
        const int row0 = u.pm * BM + wr * 64 + fr, col0 = u.pn * HALF + wc * 32 + 8 * fq;
#pragma unroll
        for (int ai = 0; ai < 2; ++ai)
#pragma unroll
            for (int m = 0; m < 4; ++m) { f32x4 r0, r1;
#pragma unroll
                for (int e = 0; e < 4; ++e) { const float sc8 = SC8 ? W8_INV : 1.0f; const float a0 = acc[ai][0][m][0][e] * sc8, a1 = acc[ai][0][m][1][e] * sc8, b0 = acc[ai][1][m][0][e] * sc8, b1 = acc[ai][1][m][1][e] * sc8;
                    r0[e] = (MODE == 1 ? silu_f(a0) : a0) * b0; r1[e] = (MODE == 1 ? silu_f(a1) : a1) * b1; }
                if (OUT8) { u32x2 w; int t0 = 0, t1 = 0; t0 = __builtin_amdgcn_cvt_pk_fp8_f32(r0[0], r0[1], t0, false); t0 = __builtin_amdgcn_cvt_pk_fp8_f32(r0[2], r0[3], t0, true);
                    t1 = __builtin_amdgcn_cvt_pk_fp8_f32(r1[0], r1[1], t1, false); t1 = __builtin_amdgcn_cvt_pk_fp8_f32(r1[2], r1[3], t1, true); w.x = (unsigned)t0; w.y = (unsigned)t1;
                    *(u32x2*)((unsigned char*)O + (size_t)(row0 + ai * HALF + m * 16) * ldo + col0) = w; }
                else *(u32x4*)(O + (size_t)(row0 + ai * HALF + m * 16) * ldo + col0) = pack8(r0, r1); }
    }
};
struct EpiConvIn {
    static constexpr bool FUSED = false;
    bf16_t* UB;
    __device__ __forceinline__ void operator()(const Acc& acc, const Unit& u, int wr, int wc, int fr, int fq) const {
        const int row0 = u.pm * BM + wr * 64 + fr;
        if (u.pn < 8) { EpiPair<0, false, false> P{UB, 2048}; P(acc, u, wr, wc, fr, fq); }
        else { const int col0 = 1024 + (u.pn - 8) * BM + wc * 32 + 8 * fq;
#pragma unroll
            for (int ai = 0; ai < 2; ++ai)
#pragma unroll
                for (int m = 0; m < 4; ++m)
#pragma unroll
                    for (int bj = 0; bj < 2; ++bj) *(u32x4*)(UB + (size_t)(row0 + ai * HALF + m * 16) * 2048 + col0 + bj * HALF) = pack8(acc[ai][bj][m][0], acc[ai][bj][m][1]); }
    }
};
struct EpiRes {
    static constexpr bool FUSED = false;
    float* X; const float* gate; const float* Xin; float asc;
    __device__ __forceinline__ void operator()(const Acc& acc, const Unit& u, int wr, int wc, int fr, int fq) const {
        const int row0 = u.pm * BM + wr * 64 + fr, col0 = u.pn * BM + wc * 32 + 8 * fq; const int b = (u.pm * BM) / SEQ;
        f32x4 gv[2][2];
#pragma unroll
        for (int bj = 0; bj < 2; ++bj)
#pragma unroll
            for (int n = 0; n < 2; ++n) gv[bj][n] = *(const f32x4*)(gate + (size_t)b * 6144 + col0 + bj * HALF + 4 * n) * asc;
#pragma unroll
        for (int ai = 0; ai < 2; ++ai) {
            f32x4 xv[4][2][2];
#pragma unroll
            for (int m = 0; m < 4; ++m) { const float* ri = Xin + (size_t)(row0 + ai * HALF + m * 16) * DM + col0;
#pragma unroll
                for (int bj = 0; bj < 2; ++bj)
#pragma unroll
                    for (int n = 0; n < 2; ++n) xv[m][bj][n] = ldx16(ri + bj * HALF + 4 * n); }
            asm volatile("" ::: "memory");
#pragma unroll
            for (int m = 0; m < 4; ++m) { float* rp = X + (size_t)(row0 + ai * HALF + m * 16) * DM + col0;
#pragma unroll
                for (int bj = 0; bj < 2; ++bj)
#pragma unroll
                    for (int n = 0; n < 2; ++n) *(f32x4*)(rp + bj * HALF + 4 * n) = xv[m][bj][n] + gv[bj][n] * acc[ai][bj][m][n]; }
            asm volatile("" ::: "memory");
        }
    }
};
struct EpiResNorm {
    static constexpr bool FUSED = true;
    float* X; const float* gate; const float* Xin; const float* ng; const float* shb; bf16_t* H; float* xs; gu32* cnt; gu32* tmo; float asc;
    __device__ __forceinline__ void fused(Acc& acc, const Unit& u, int wr, int wc, int fr, int fq, LAS unsigned char* lds, int wid, int lane) const {
        const int row0 = u.pm * BM + wr * 64 + fr, col0 = u.pn * BM + wc * 32 + 8 * fq; const int b = (u.pm * BM) / SEQ;
        LAS float* P = (LAS float*)lds; LAS float* S = (LAS float*)(lds + 4096);
        { f32x4 gv[2][2];
#pragma unroll
          for (int bj = 0; bj < 2; ++bj)
#pragma unroll
              for (int n = 0; n < 2; ++n) gv[bj][n] = *(const f32x4*)(gate + (size_t)b * 6144 + col0 + bj * HALF + 4 * n) * asc;
#pragma unroll
          for (int ai = 0; ai < 2; ++ai) {
              f32x4 xv[4][2][2];
#pragma unroll
              for (int m = 0; m < 4; ++m) { const float* ri = Xin + (size_t)(row0 + ai * HALF + m * 16) * DM + col0;
#pragma unroll
                  for (int bj = 0; bj < 2; ++bj)
#pragma unroll
                      for (int n = 0; n < 2; ++n) xv[m][bj][n] = ldx16(ri + bj * HALF + 4 * n); }
              asm volatile("" ::: "memory");
#pragma unroll
              for (int m = 0; m < 4; ++m) { float* rp = X + (size_t)(row0 + ai * HALF + m * 16) * DM + col0; float ss = 0.f;
#pragma unroll
                  for (int bj = 0; bj < 2; ++bj)
#pragma unroll
                      for (int n = 0; n < 2; ++n) { const f32x4 x = xv[m][bj][n] + gv[bj][n] * acc[ai][bj][m][n]; acc[ai][bj][m][n] = x; *(f32x4*)(rp + bj * HALF + 4 * n) = x;
                          ss += (x[0] * x[0] + x[1] * x[1]) + (x[2] * x[2] + x[3] * x[3]); }
                  ss += __shfl_xor(ss, 16); ss += __shfl_xor(ss, 32);
                  if (fq == 0) P[(ai * HALF + wr * 64 + m * 16 + fr) * 4 + wc] = ss; }
              asm volatile("" ::: "memory");
          } }
        asm volatile("s_waitcnt lgkmcnt(0)" ::: "memory"); __builtin_amdgcn_s_barrier(); asm volatile("" ::: "memory");
        const int tid = wid * 64 + lane;
        if (tid < 256) { const f32x4 p4 = *(const LAS f32x4*)(P + tid * 4); const float sp = (p4[0] + p4[1]) + (p4[2] + p4[3]);
            __hip_atomic_store((gu32*)xs + ((size_t)(u.pm * BM + tid) * 4 + u.pn), __float_as_uint(sp), RLX_AGENT); }
        asm volatile("s_waitcnt vmcnt(0)" ::: "memory");
        if (wid < 4 && lane == 0) __hip_atomic_fetch_add(cnt + 64 * u.pm, 1u, RLX_AGENT);
        if (wid == 0) { unsigned spins = 0;
            while ((unsigned)__builtin_amdgcn_readfirstlane(__hip_atomic_load(cnt + 64 * u.pm, RLX_AGENT)) < 16u) { __builtin_amdgcn_s_sleep(2);
                if (++spins > (1u << 20)) { if (lane == 0) __hip_atomic_store(tmo, 1u, RLX_AGENT); break; } } }
        asm volatile("s_waitcnt vmcnt(0) lgkmcnt(0)" ::: "memory"); __builtin_amdgcn_s_barrier(); asm volatile("" ::: "memory");
        if (tid < 256) { const GAS unsigned long long* q = (const GAS unsigned long long*)xs + (size_t)(u.pm * BM + tid) * 2;
            const unsigned long long a = __hip_atomic_load(q, RLX_AGENT), c = __hip_atomic_load(q + 1, RLX_AGENT);
            const float tot = (__uint_as_float((unsigned)a) + __uint_as_float((unsigned)(a >> 32))) + (__uint_as_float((unsigned)c) + __uint_as_float((unsigned)(c >> 32)));
            S[tid] = 1.0f / sqrtf(tot * (1.0f / DM) + EPS); }
        asm volatile("s_waitcnt vmcnt(0) lgkmcnt(0)" ::: "memory"); __builtin_amdgcn_s_barrier(); asm volatile("" ::: "memory");
        f32x4 gm[2][2], sf[2][2];
#pragma unroll
        for (int bj = 0; bj < 2; ++bj)
#pragma unroll
            for (int n = 0; n < 2; ++n) { const int c = col0 + bj * HALF + 4 * n; const f32x4 g4 = *(const f32x4*)(ng + c), s1 = *(const f32x4*)(shb + (size_t)b * 6144 + DM + c);
                gm[bj][n] = g4 * (s1 + 1.0f); sf[bj][n] = *(const f32x4*)(shb + (size_t)b * 6144 + c); }
#pragma unroll
        for (int ai = 0; ai < 2; ++ai)
#pragma unroll
            for (int m = 0; m < 4; ++m) { const float r = S[ai * HALF + wr * 64 + m * 16 + fr]; bf16_t* hp = H + (size_t)(row0 + ai * HALF + m * 16) * DM + col0;
#pragma unroll
                for (int bj = 0; bj < 2; ++bj) *(u32x4*)(hp + bj * HALF) = pack8((acc[ai][bj][m][0] * r) * gm[bj][0] + sf[bj][0], (acc[ai][bj][m][1] * r) * gm[bj][1] + sf[bj][1]); }
    }
};
struct EpiResNormRouter {
    static constexpr bool FUSED = true;
    float* X; const float* gate; const float* ng; const float* shb; bf16_t* H; float* xs9; gu32* cnt; gu32* tmo;
    const float* rw; const float* rb; gu32* ecnt; unsigned char* meta; int h8;
    __device__ __forceinline__ void fused(Acc& acc, const Unit& u, int wr, int wc, int fr, int fq, LAS unsigned char* lds, int wid, int lane) const {
        const int row0 = u.pm * BM + wr * 64 + fr, col0 = u.pn * BM + wc * 32 + 8 * fq; const int b = (u.pm * BM) / SEQ; const int tid = wid * 64 + lane;
        LAS float* P9 = (LAS float*)lds; LAS float* RWT = (LAS float*)(lds + 36864); LAS float* S = (LAS float*)(lds + 45056); LAS float* CE = (LAS float*)(lds + 46080);
        LAS int* rE = (LAS int*)(lds + 46144); LAS float* red = (LAS float*)(lds + 47360);
        const float* shp = shb + (size_t)b * 6144;
        for (int i = tid; i < 2048; i += NTHREADS) { const int c = i >> 3, e = i & 7; RWT[e * 256 + c] = rw[(size_t)(u.pn * BM + c) * 8 + e]; }
        { float ce[8]; const float s0 = shp[tid], s1 = shp[tid + 512];
#pragma unroll
          for (int e = 0; e < 8; ++e) ce[e] = wave_sum(s0 * rw[(size_t)tid * 8 + e] + s1 * rw[(size_t)(tid + 512) * 8 + e]);
          if (lane == 0) {
#pragma unroll
              for (int e = 0; e < 8; ++e) red[wid * 8 + e] = ce[e]; } }
        { f32x4 gv[2][2];
#pragma unroll
          for (int bj = 0; bj < 2; ++bj)
#pragma unroll
              for (int n = 0; n < 2; ++n) gv[bj][n] = *(const f32x4*)(gate + (size_t)b * 6144 + col0 + bj * HALF + 4 * n);
#pragma unroll
          for (int ai = 0; ai < 2; ++ai) {
              f32x4 xv[4][2][2];
#pragma unroll
              for (int m = 0; m < 4; ++m) { const float* ri = X + (size_t)(row0 + ai * HALF + m * 16) * DM + col0;
#pragma unroll
                  for (int bj = 0; bj < 2; ++bj)
#pragma unroll
                      for (int n = 0; n < 2; ++n) xv[m][bj][n] = ldx16(ri + bj * HALF + 4 * n); }
              asm volatile("" ::: "memory");
#pragma unroll
              for (int m = 0; m < 4; ++m) { float* rp = X + (size_t)(row0 + ai * HALF + m * 16) * DM + col0; float ss = 0.f;
#pragma unroll
                  for (int bj = 0; bj < 2; ++bj)
#pragma unroll
                      for (int n = 0; n < 2; ++n) { const f32x4 x = xv[m][bj][n] + gv[bj][n] * acc[ai][bj][m][n]; acc[ai][bj][m][n] = x; *(f32x4*)(rp + bj * HALF + 4 * n) = x;
                          ss += (x[0] * x[0] + x[1] * x[1]) + (x[2] * x[2] + x[3] * x[3]); }
                  ss += __shfl_xor(ss, 16); ss += __shfl_xor(ss, 32);
                  if (fq == 0) P9[((ai * HALF + wr * 64 + m * 16 + fr) * 4 + wc) * 9] = ss; }
              asm volatile("" ::: "memory");
          } }
        f32x4 sf[2][2];
#pragma unroll
        for (int bj = 0; bj < 2; ++bj)
#pragma unroll
            for (int n = 0; n < 2; ++n) { const int c = col0 + bj * HALF + 4 * n; const f32x4 gm = *(const f32x4*)(ng + c) * (*(const f32x4*)(shp + DM + c) + 1.0f); sf[bj][n] = *(const f32x4*)(shp + c);
#pragma unroll
                for (int ai = 0; ai < 2; ++ai)
#pragma unroll
                    for (int m = 0; m < 4; ++m) acc[ai][bj][m][n] = acc[ai][bj][m][n] * gm; }
        asm volatile("s_waitcnt lgkmcnt(0)" ::: "memory"); __builtin_amdgcn_s_barrier(); asm volatile("" ::: "memory");
        if (tid < 8) { float c = rb[tid];
#pragma unroll
            for (int w = 0; w < 8; ++w) c += red[w * 8 + tid];
            CE[tid] = c; }
#pragma unroll
        for (int e = 0; e < 8; ++e) { f32x4 rwe[2][2];
#pragma unroll
            for (int bj = 0; bj < 2; ++bj)
#pragma unroll
                for (int n = 0; n < 2; ++n) rwe[bj][n] = *(const LAS f32x4*)(RWT + e * 256 + bj * HALF + wc * 32 + 8 * fq + 4 * n);
#pragma unroll
            for (int ai = 0; ai < 2; ++ai)
#pragma unroll
                for (int m = 0; m < 4; ++m) { float a = 0.f;
#pragma unroll
                    for (int bj = 0; bj < 2; ++bj)
#pragma unroll
                        for (int n = 0; n < 2; ++n) { const f32x4 x = acc[ai][bj][m][n], w4 = rwe[bj][n]; a += (x[0] * w4[0] + x[1] * w4[1]) + (x[2] * w4[2] + x[3] * w4[3]); }
                    a += __shfl_xor(a, 16); a += __shfl_xor(a, 32);
                    if (fq == 0) P9[((ai * HALF + wr * 64 + m * 16 + fr) * 4 + wc) * 9 + 1 + e] = a; } }
        asm volatile("s_waitcnt lgkmcnt(0)" ::: "memory"); __builtin_amdgcn_s_barrier(); asm volatile("" ::: "memory");
        if (tid < 256) { gu32* q = (gu32*)xs9 + ((size_t)(u.pm * BM + tid) * 4 + u.pn) * 9;
#pragma unroll
            for (int k = 0; k < 9; ++k) { const float v = (P9[(tid * 4 + 0) * 9 + k] + P9[(tid * 4 + 1) * 9 + k]) + (P9[(tid * 4 + 2) * 9 + k] + P9[(tid * 4 + 3) * 9 + k]);
                __hip_atomic_store(q + k, __float_as_uint(v), RLX_AGENT); } }
        asm volatile("s_waitcnt vmcnt(0)" ::: "memory");
        if (wid < 4 && lane == 0) __hip_atomic_fetch_add(cnt + 64 * u.pm, 1u, RLX_AGENT);
        if (wid == 0) { unsigned spins = 0;
            while ((unsigned)__builtin_amdgcn_readfirstlane(__hip_atomic_load(cnt + 64 * u.pm, RLX_AGENT)) < 16u) { __builtin_amdgcn_s_sleep(2);
                if (++spins > (1u << 20)) { if (lane == 0) __hip_atomic_store(tmo, 1u, RLX_AGENT); break; } } }
        asm volatile("s_waitcnt vmcnt(0) lgkmcnt(0)" ::: "memory"); __builtin_amdgcn_s_barrier(); asm volatile("" ::: "memory");
        if (tid < 256) { const gu32* q = (const gu32*)xs9 + (size_t)(u.pm * BM + tid) * 36; float tot[9];
#pragma unroll
            for (int k = 0; k < 9; ++k) tot[k] = (__uint_as_float(__hip_atomic_load(q + k, RLX_AGENT)) + __uint_as_float(__hip_atomic_load(q + 9 + k, RLX_AGENT)))
                                               + (__uint_as_float(__hip_atomic_load(q + 18 + k, RLX_AGENT)) + __uint_as_float(__hip_atomic_load(q + 27 + k, RLX_AGENT)));
            const float r = 1.0f / sqrtf(tot[0] * (1.0f / DM) + EPS); S[tid] = r;
            if (wid == u.pn) {
                float lg[8];
#pragma unroll
                for (int e = 0; e < 8; ++e) lg[e] = r * tot[1 + e] + CE[e];
                int e0 = 0; float l0 = lg[0];
#pragma unroll
                for (int e = 1; e < 8; ++e) if (lg[e] > l0) { l0 = lg[e]; e0 = e; }
                int e1 = -1; float l1 = -3.0e38f;
#pragma unroll
                for (int e = 0; e < 8; ++e) if (e != e0 && lg[e] > l1) { l1 = lg[e]; e1 = e; }
                const float g0 = 1.0f / (1.0f + __expf(l1 - l0)), g1 = 1.0f - g0;
                int cmine = 0, r0 = 0, r1 = 0;
#pragma unroll
                for (int e = 0; e < 8; ++e) { const unsigned long long m0 = __ballot(e0 == e), m1 = __ballot(e1 == e);
                    const int below = (int)__builtin_amdgcn_mbcnt_hi((unsigned)(m0 >> 32), __builtin_amdgcn_mbcnt_lo((unsigned)m0, 0u)) + (int)__builtin_amdgcn_mbcnt_hi((unsigned)(m1 >> 32), __builtin_amdgcn_mbcnt_lo((unsigned)m1, 0u));
                    if (e0 == e) r0 = below; if (e1 == e) r1 = below; if (lane == e) cmine = __popcll(m0) + __popcll(m1); }
                unsigned base = 0u; if (lane < 8 && cmine) base = __hip_atomic_fetch_add(ecnt + 64 * lane, (unsigned)cmine, RLX_AGENT);
                const int p0 = (int)__shfl(base, e0) + r0, p1 = (int)__shfl(base, e1) + r1, grow = u.pm * BM + 64 * u.pn + lane;
                gu32* ri = (gu32*)(meta + WS_ROWIDX_B); gu32* gp = (gu32*)(meta + WS_GATEP_B); gu32* sl = (gu32*)(meta + WS_SLOT_B);
                __hip_atomic_store(ri + e0 * 16384 + p0, (unsigned)grow, RLX_AGENT); __hip_atomic_store(ri + e1 * 16384 + p1, (unsigned)grow, RLX_AGENT);
                __hip_atomic_store(gp + e0 * 16384 + p0, __float_as_uint(g0), RLX_AGENT); __hip_atomic_store(gp + e1 * 16384 + p1, __float_as_uint(g1), RLX_AGENT);
                __hip_atomic_store(sl + grow * 2, (unsigned)((e0 << 16) | p0), RLX_AGENT); __hip_atomic_store(sl + grow * 2 + 1, (unsigned)((e1 << 16) | p1), RLX_AGENT); } }
        asm volatile("s_waitcnt vmcnt(0) lgkmcnt(0)" ::: "memory"); __builtin_amdgcn_s_barrier(); asm volatile("" ::: "memory");
#pragma unroll
        for (int ai = 0; ai < 2; ++ai)
#pragma unroll
            for (int m = 0; m < 4; ++m) { const float r = S[ai * HALF + wr * 64 + m * 16 + fr]; bf16_t* hp = H + (size_t)(row0 + ai * HALF + m * 16) * DM + col0;
#pragma unroll
                for (int bj = 0; bj < 2; ++bj) { const f32x4 h0 = acc[ai][bj][m][0] * r + sf[bj][0], h1 = acc[ai][bj][m][1] * r + sf[bj][1];
                    if (M1_FP8 && h8) { int t0 = 0, t1 = 0; t0 = __builtin_amdgcn_cvt_pk_fp8_f32(h0[0], h0[1], t0, false); t0 = __builtin_amdgcn_cvt_pk_fp8_f32(h0[2], h0[3], t0, true);
                        t1 = __builtin_amdgcn_cvt_pk_fp8_f32(h1[0], h1[1], t1, false); t1 = __builtin_amdgcn_cvt_pk_fp8_f32(h1[2], h1[3], t1, true); u32x2 w; w.x = (unsigned)t0; w.y = (unsigned)t1;
                        *(u32x2*)((unsigned char*)H + (size_t)(row0 + ai * HALF + m * 16) * DM + col0 + bj * HALF) = w; }
                    else *(u32x4*)(hp + bj * HALF) = pack8(h0, h1); } }
    }
};
struct EpiGluRes {
    static constexpr bool FUSED = false;
    float* X; const float* gate;
    __device__ __forceinline__ void operator()(const Acc& acc, const Unit& u, int wr, int wc, int fr, int fq) const {
        const int row0 = u.pm * BM + wr * 64 + fr, col0 = u.pn * HALF + wc * 32 + 8 * fq; const int b = (u.pm * BM) / SEQ;
        f32x4 gv[2];
#pragma unroll
        for (int n = 0; n < 2; ++n) gv[n] = *(const f32x4*)(gate + (size_t)b * 6144 + col0 + 4 * n);
        f32x4 xv[2][4][2];
#pragma unroll
        for (int ai = 0; ai < 2; ++ai)
#pragma unroll
            for (int m = 0; m < 4; ++m)
#pragma unroll
                for (int n = 0; n < 2; ++n) xv[ai][m][n] = ldx16(X + (size_t)(row0 + ai * HALF + m * 16) * DM + col0 + 4 * n);
        asm volatile("" ::: "memory");
#pragma unroll
        for (int ai = 0; ai < 2; ++ai)
#pragma unroll
            for (int m = 0; m < 4; ++m) { float* rp = X + (size_t)(row0 + ai * HALF + m * 16) * DM + col0;
#pragma unroll
                for (int n = 0; n < 2; ++n) { f32x4 x = xv[ai][m][n]; const f32x4 l = acc[ai][0][m][n], gg = acc[ai][1][m][n];
#pragma unroll
                    for (int e = 0; e < 4; ++e) x[e] += gv[n][e] * l[e] * sigmoid_f(gg[e]);
                    *(f32x4*)(rp + 4 * n) = x; } }
    }
};
struct EpiAttnIn {
    static constexpr bool FUSED = false;
    bf16_t *Q, *Kn, *V, *QI, *KI; float* WI; const float *qg, *kg;
    __device__ __forceinline__ void operator()(const Acc& acc, const Unit& u, int wr, int wc, int fr, int fq) const {
        const int row0 = u.pm * BM + wr * 64 + fr;
        if (u.pn < 5) {
            const bool isq = u.pn < 4; const float* gp = isq ? qg : kg; const float sc = isq ? 0.125f : 1.0f;
            f32x4 gn[2][2];
#pragma unroll
            for (int bj = 0; bj < 2; ++bj)
#pragma unroll
                for (int n = 0; n < 2; ++n) gn[bj][n] = *(const f32x4*)(gp + 32 * bj + 8 * fq + 4 * n) * sc;
            bf16_t* base = isq ? (Q + (size_t)(4 * u.pn + wc) * 64) : (Kn + (size_t)wc * 64); const int ldo = isq ? 1024 : 256;
#pragma unroll
            for (int ai = 0; ai < 2; ++ai)
#pragma unroll
                for (int m = 0; m < 4; ++m) { float ss = 0.f;
#pragma unroll
                    for (int bj = 0; bj < 2; ++bj)
#pragma unroll
                        for (int n = 0; n < 2; ++n) { const f32x4 x = acc[ai][bj][m][n]; ss += (x[0] * x[0] + x[1] * x[1]) + (x[2] * x[2] + x[3] * x[3]); }
                    ss += __shfl_xor(ss, 16); ss += __shfl_xor(ss, 32);
                    const float r = 1.0f / sqrtf(ss * (1.0f / 64.0f) + EPS);
#pragma unroll
                    for (int bj = 0; bj < 2; ++bj) *(u32x4*)(base + (size_t)(row0 + ai * HALF + m * 16) * ldo + 32 * bj + 8 * fq) = pack8(acc[ai][bj][m][0] * r * gn[bj][0], acc[ai][bj][m][1] * r * gn[bj][1]); }
        } else if (u.pn < 8) {
            bf16_t* base = (u.pn == 5) ? V : QI + (size_t)(u.pn - 6) * 256; const int ldo = (u.pn == 5) ? 256 : 512; const int col0 = wc * 32 + 8 * fq;
#pragma unroll
            for (int ai = 0; ai < 2; ++ai)
#pragma unroll
                for (int m = 0; m < 4; ++m)
#pragma unroll
                    for (int bj = 0; bj < 2; ++bj) *(u32x4*)(base + (size_t)(row0 + ai * HALF + m * 16) * ldo + col0 + bj * HALF) = pack8(acc[ai][bj][m][0], acc[ai][bj][m][1]);
        } else {
            if (wc < 2) {
#pragma unroll
                for (int ai = 0; ai < 2; ++ai)
#pragma unroll
                    for (int m = 0; m < 4; ++m) *(u32x4*)(KI + (size_t)(row0 + ai * HALF + m * 16) * 64 + wc * 32 + 8 * fq) = pack8(acc[ai][0][m][0], acc[ai][0][m][1]);
            } else if (wc == 2 && fq == 0) {
                const float s = 0.04419417382415922f;
#pragma unroll
                for (int ai = 0; ai < 2; ++ai)
#pragma unroll
                    for (int m = 0; m < 4; ++m) { float* wp = WI + (size_t)(row0 + ai * HALF + m * 16) * 8; *(f32x4*)wp = acc[ai][0][m][0] * s; *(f32x4*)(wp + 4) = acc[ai][0][m][1] * s; }
            }
        }
    }
};
struct EpiMoeDn {
    static constexpr bool FUSED = false;
    bf16_t* Y; const float* gatep;
    __device__ __forceinline__ void operator()(const Acc& acc, const Unit& u, int wr, int wc, int fr, int fq) const {
        const int row0 = u.pm * BM + wr * 64 + fr, col0 = u.pn * BM + wc * 32 + 8 * fq;
#pragma unroll
        for (int ai = 0; ai < 2; ++ai)
#pragma unroll
            for (int m = 0; m < 4; ++m) { const float gt = gatep[u.aux + ai * HALF + wr * 64 + m * 16 + fr] * (M2_FP8 ? W8_INV : 1.0f);
#pragma unroll
                for (int bj = 0; bj < 2; ++bj) *(u32x4*)(Y + (size_t)(row0 + ai * HALF + m * 16) * DM + col0 + bj * HALF) = pack8(acc[ai][bj][m][0] * gt, acc[ai][bj][m][1] * gt); }
    }
};
}

constexpr size_t MiB = 1u << 20;
constexpr size_t WS_CTL = 0, CTL_ZERO_BYTES = 1 * MiB;
constexpr size_t WS_MOD = 1 * MiB;
constexpr size_t WS_ROWIDX = 2 * MiB;
constexpr size_t WS_GATEP = 2 * MiB + 512 * 1024;
constexpr size_t WS_SLOT = 3 * MiB;
static_assert(WS_ROWIDX_B == WS_ROWIDX && WS_GATEP_B == WS_GATEP && WS_SLOT_B == WS_SLOT, "metadata offsets");
constexpr size_t WS_WCI = 8 * MiB;
constexpr size_t WS_WCO = 20 * MiB;
constexpr size_t WS_WAI = 24 * MiB;
constexpr size_t WS_WAO = 29 * MiB;
constexpr size_t WS_WGL = 31 * MiB;
constexpr size_t WS_WFG = 35 * MiB;
constexpr size_t WS_WFD = 57 * MiB;
constexpr size_t WS_WMG = 68 * MiB;
constexpr size_t WS_WMD = 244 * MiB;
constexpr size_t WS_HB = 332 * MiB;
constexpr size_t WS_BUF = 364 * MiB;
constexpr size_t WS_ACT = 432 * MiB;
constexpr size_t WS_END = 619 * MiB;
constexpr int MOE_ROWS = 2 * M + NEXP * 256;
constexpr size_t WS_Q = WS_BUF, WS_K = WS_BUF + 32 * MiB, WS_V = WS_BUF + 40 * MiB, WS_QI = WS_BUF + 48 * MiB;
constexpr size_t WS_SC = WS_ACT, WS_O = WS_ACT + 128 * MiB, WS_KI = WS_ACT + 160 * MiB, WS_WI = WS_ACT + 162 * MiB;
static_assert(WS_WMD + (size_t)16 * 1024 * 2816 * 2 <= WS_HB && WS_ACT + (size_t)MOE_ROWS * FF * 2 <= WS_END && WS_BUF + (size_t)MOE_ROWS * DM * 2 <= WS_ACT, "d_ws map");
constexpr int CW_TMO = 0;
constexpr int CW_CNT = 64;
constexpr int CW_BAR = 4096;
constexpr int CW_PAN = 16384;
constexpr size_t WS_XS9 = 5 * MiB + 768 * 1024;
constexpr size_t WS_XS = 5 * MiB + 512 * 1024;

constexpr int RING_BYTES = 131072;
constexpr int LDSCTL_OFF = RING_BYTES, MISC_OFF = LDSCTL_OFF + 320;
constexpr int LDS_BYTES = 147456;

#define XB_TMO      128
#define XB_XCNT(j)  (256  + 64 * (j))
#define XB_XSUB(j)  (1280 + 64 * (j))
#define XB_XGEN(j)  (2304 + 64 * (j))
#define XB_TOP      3328
#define XB_TOPGEN   3392
#define XCD_BAR_WORDS 3456
#define XB_SPIN_CAP (1u << 18)
__device__ __forceinline__ unsigned xb_ld(unsigned* p)              { return __hip_atomic_load(p, __ATOMIC_RELAXED, __HIP_MEMORY_SCOPE_AGENT); }
__device__ __forceinline__ unsigned xb_add(unsigned* p, unsigned v) { return __hip_atomic_fetch_add(p, v, __ATOMIC_RELAXED, __HIP_MEMORY_SCOPE_AGENT); }
__device__ __forceinline__ unsigned xb_xcc_id() { return (unsigned)__builtin_amdgcn_s_getreg((3 << 11) | 20) & 0xFu; }
#define XB_SPIN(cond, bar) do { unsigned _sp = 0; while (cond) { __builtin_amdgcn_s_sleep(1); \
    if ((++_sp & 255u) == 0u) { if (xb_ld(&(bar)[XB_TMO])) break; if (_sp > XB_SPIN_CAP) { atomicAdd(&(bar)[XB_TMO], 1u); break; } } } } while (0)
struct XcdBarrier { unsigned* bar; unsigned x; volatile LAS unsigned* st; int w; };
__device__ __forceinline__ bool xb_thread0(int w) { return w == 0 && lane_id_fresh() == 0; }
__device__ __forceinline__ XcdBarrier xcd_barrier_post(unsigned* bar, volatile LAS unsigned* st, int w) {
    XcdBarrier b; b.bar = bar; b.x = xb_xcc_id(); b.st = st; b.w = w;
    if (xb_thread0(w)) (void)xb_add(&bar[XB_XCNT(b.x)], 1u);
    return b;
}
__device__ __forceinline__ void xcd_barrier_complete(unsigned* bar, unsigned x, unsigned& nloc, unsigned& nx) {
    const unsigned G = gridDim.x * gridDim.y * gridDim.z;
    unsigned sum, cnt, mine, sp = 0u;
    for (;;) {
        sum = 0u; cnt = 0u; mine = 0u;
#pragma unroll
        for (unsigned j = 0; j < 16; ++j) { const unsigned c = xb_ld(&bar[XB_XCNT(j)]); sum += c; cnt += (c > 0u) ? 1u : 0u; mine = (j == x) ? c : mine; }
        if (sum == G) break;
        __builtin_amdgcn_s_sleep(1);
        if ((++sp & 255u) == 0u) { if (xb_ld(&bar[XB_TMO])) break; if (sp > XB_SPIN_CAP) { atomicAdd(&bar[XB_TMO], 1u); break; } }
    }
    nloc = mine > 0u ? mine : 1u; nx = cnt > 0u ? cnt : 1u;
}
__device__ __forceinline__ int lane_probe() { return (int)__builtin_amdgcn_mbcnt_hi(~0u, __builtin_amdgcn_mbcnt_lo(~0u, 0u)); }
__device__ __forceinline__ int lane_probe2() { return (int)__builtin_amdgcn_mbcnt_hi(~0u, __builtin_amdgcn_mbcnt_lo(~0u, 0u)); }
__device__ __forceinline__ void xcd_barrier(const XcdBarrier& b) {
    asm volatile("s_waitcnt vmcnt(0)" ::: "memory");
    __syncthreads();
    if (xb_thread0(b.w)) {
        unsigned* bar = b.bar;
        __builtin_amdgcn_s_waitcnt(0);
        unsigned nloc = b.st[0], nx = b.st[1];
        if (nloc == 0u) { xcd_barrier_complete(bar, b.x, nloc, nx); b.st[0] = nloc; b.st[1] = nx; }
        const unsigned old = xb_add(&bar[XB_XSUB(b.x)], 1u);
        const unsigned gen = old / nloc;
        if (old + 1u == (gen + 1u) * nloc) {
            __builtin_amdgcn_fence(__ATOMIC_RELEASE, "agent");
            asm volatile("s_waitcnt vmcnt(0)" ::: "memory");
            __builtin_amdgcn_fence(__ATOMIC_RELEASE, "agent");
            asm volatile("s_waitcnt vmcnt(0)" ::: "memory");
            const unsigned og = xb_add(&bar[XB_TOP], 1u);
            const unsigned tg = og / nx;
            if (og + 1u == (tg + 1u) * nx) xb_add(&bar[XB_TOPGEN], 1u);
            else XB_SPIN(xb_ld(&bar[XB_TOPGEN]) == tg, bar);
            __builtin_amdgcn_fence(__ATOMIC_ACQUIRE, "agent");
            xb_add(&bar[XB_XGEN(b.x)], 1u);
            { const unsigned dmy = __builtin_nontemporal_load(&bar[XB_TMO]); asm volatile("s_waitcnt vmcnt(0)" :: "v"(dmy) : "memory"); }
        } else {
            XB_SPIN(xb_ld(&bar[XB_XGEN(b.x)]) == gen, bar);
            __builtin_amdgcn_fence(__ATOMIC_ACQUIRE, "agent");
            { const unsigned dmy = __builtin_nontemporal_load(&bar[XB_TMO]); asm volatile("s_waitcnt vmcnt(0)" :: "v"(dmy) : "memory"); }
        }
    }
    __syncthreads();
    if (xb_thread0(b.w)) { __builtin_amdgcn_fence(__ATOMIC_ACQUIRE, "agent"); asm volatile("s_waitcnt vmcnt(0)" ::: "memory"); }
    __syncthreads();
}

struct Args { const float* in[28]; float* out; unsigned char* ws; int ph_lo, ph_hi; };
enum { I_X = 0, I_C, I_ADAW, I_ADAB, I_NORMG, I_CWIN, I_CW, I_CWOUT, I_AWIN, I_QG, I_KG, I_AWOUT, I_RELB, I_SLRE, I_SLIM, I_SLOG, I_SBRE, I_SBIM, I_SCRE, I_SCIM, I_SD, I_SGLU,
       I_FGU, I_FDN, I_RW, I_RB, I_MGU, I_MDN };
struct Frame {
    LAS unsigned char* lds; unsigned char* ws; gu32* ctl;
    int tid, lane, wave, vcu, G;
    float* out; const float* mod;
    bf16_t *HB, *BUF, *ACT;
};

enum { MAP_NAT = 0, MAP_PAIR = 1, MAP_CONV = 2, MAP_ATTN = 3 };
__device__ __forceinline__ int map_row(int map, int half, int n) {
    if (map == MAP_NAT) return n;
    if (map == MAP_PAIR) { return n < half ? 256 * (n / 128) + (n % 128) : 256 * ((n - half) / 128) + 128 + ((n - half) % 128); }
    if (map == MAP_CONV) { if (n < 1024) return 2048 + n; if (n < 2048) { const int q = n - 1024; return 256 * (q / 128) + (q % 128); } const int q = n - 2048; return 256 * (q / 128) + 128 + (q % 128); }
    if (n < 1280) { const int hd = n / 64, d = n % 64; return 256 * (hd / 4) + 128 * (d / 32) + 32 * (hd % 4) + (d % 32); }
    return n;
}
__device__ __forceinline__ void p0_transpose_item(const float* W, int K, int N, bf16_t* WT, int map, int half, LAS float* scr, int item, int lane) {
    const int nblk = (N + 31) / 32, kb = item / nblk, nb = item % nblk, k0 = 64 * kb, n0 = 32 * nb;
    const bool cin = (n0 + (lane & 31)) < N;
    float tv[32];
#pragma unroll
    for (int i = 0; i < 32; ++i) { const int kk = 2 * i + (lane >> 5); tv[i] = cin ? W[(size_t)(k0 + kk) * N + n0 + (lane & 31)] : 0.f; }
#pragma unroll
    for (int i = 0; i < 32; ++i) { const int kk = 2 * i + (lane >> 5); scr[kk * 33 + (lane & 31)] = tv[i]; }
    LDS_WAIT(); CFENCE();
    const int c = lane & 7; const int r0 = map_row(map, half, n0);
#pragma unroll
    for (int j = 0; j < 4; ++j) { const int n = (lane >> 3) + 8 * j; const LAS float* s = scr + (8 * c) * 33 + n;
        u32x4 o; o.x = pk2(s[0 * 33], s[1 * 33]); o.y = pk2(s[2 * 33], s[3 * 33]); o.z = pk2(s[4 * 33], s[5 * 33]); o.w = pk2(s[6 * 33], s[7 * 33]);
        *(GAS u32x4*)(WT + (size_t)(r0 + n) * K + k0 + 8 * c) = o; }
    LDS_WAIT(); CFENCE();
}
__device__ __forceinline__ void p0_transpose_item8(const float* W, int K, int N, unsigned char* WT, int map, int half, LAS float* scr, int item, int lane, int sub) {
    const int nblk = (N + 31) / 32, kb = 2 * (item / nblk) + sub, nb = item % nblk, k0 = 64 * kb, n0 = 32 * nb;
    float tv[32];
#pragma unroll
    for (int i = 0; i < 32; ++i) { const int kk = 2 * i + (lane >> 5); tv[i] = W[(size_t)(k0 + kk) * N + n0 + (lane & 31)]; }
#pragma unroll
    for (int i = 0; i < 32; ++i) { const int kk = 2 * i + (lane >> 5); scr[kk * 33 + (lane & 31)] = tv[i] * pg8::W8_MUL; }
    LDS_WAIT(); CFENCE();
    const int c = lane & 3; const int r0 = map_row(map, half, n0);
#pragma unroll
    for (int j = 0; j < 2; ++j) { const int n = (lane >> 2) + 16 * j; const LAS float* sp = scr + (16 * c) * 33 + n; u32x4 o;
#pragma unroll
        for (int q = 0; q < 4; ++q) { int t = 0; t = __builtin_amdgcn_cvt_pk_fp8_f32(sp[(4 * q) * 33], sp[(4 * q + 1) * 33], t, false); t = __builtin_amdgcn_cvt_pk_fp8_f32(sp[(4 * q + 2) * 33], sp[(4 * q + 3) * 33], t, true); o[q] = (unsigned)t; }
        *(GAS u32x4*)(WT + (size_t)(r0 + n) * K + k0 + 16 * c) = o; }
    LDS_WAIT(); CFENCE();
}
__device__ __forceinline__ void p0_prologue(Frame& F, const Args& A) {
    {
        LAS float* cs = (LAS float*)F.lds;
        LAS float* red = (LAS float*)(F.lds + 16384);
        for (int i = F.tid; i < NB * DM; i += NTHREADS) { const float c = A.in[I_C][i]; cs[i] = c / (1.f + __expf(-c)); }
        __syncthreads();
        const int kg = F.tid >> 6, cj = F.tid & 63;
        for (int un = blockIdx.x; un < 4 * 96; un += F.G) {
            const int l = un / 96, jb = un % 96, j = jb * 64 + cj;
            const float* w = A.in[I_ADAW] + (size_t)l * DM * 6144 + j;
            float a0 = 0.f, a1 = 0.f, a2 = 0.f, a3 = 0.f;
#pragma unroll 8
            for (int k = kg * 128; k < kg * 128 + 128; ++k) { const float wv = w[(size_t)k * 6144]; a0 += cs[k] * wv; a1 += cs[1024 + k] * wv; a2 += cs[2048 + k] * wv; a3 += cs[3072 + k] * wv; }
            *(LAS f32x4*)(red + (kg * 64 + cj) * 4) = (f32x4){a0, a1, a2, a3};
            __syncthreads();
            if (F.tid < 256) { const int b = F.tid >> 6, cc = F.tid & 63; float s = 0.f;
#pragma unroll
                for (int q = 0; q < 8; ++q) s += red[(q * 64 + cc) * 4 + b];
                ((float*)(F.ws + WS_MOD))[((size_t)l * NB + b) * 6144 + jb * 64 + cc] = s + A.in[I_ADAB][l * 6144 + jb * 64 + cc]; }
            __syncthreads();
        }
    }
    LAS float* scr = (LAS float*)(F.lds + 32768 + F.wave * 8704);
    const int gw = F.vcu * NWAVES + F.wave, NGW = F.G * NWAVES;
    constexpr int I_CI = (DM / 64) * (3072 / 32), I_SQ = (DM / 64) * (DM / 32), I_AI = (DM / 64) * ((ATT_N + 31) / 32), I_GL = (DM / 64) * (2048 / 32), I_GU = (DM / 64) * (2 * FF / 32), I_DN = (FF / 128) * (DM / 32), I_DNB = (FF / 64) * (DM / 32), I_GU8 = (DM / 128) * (2 * FF / 32);
    constexpr int NITEMS = 2 * I_CI + 2 * I_SQ + I_AI + I_SQ + I_GL + 2 * I_GU + (F2_FP8 ? 2 * I_DN : ((F2L0_FP8 ? I_DN : I_DNB) + I_DNB)) + 8 * I_GU + 8 * (M1_FP8 ? I_GU8 : I_GU) + 16 * (M2_FP8 ? I_DN : I_DNB);
    for (int it = gw; it < NITEMS; it += NGW) {
        int r = it;
        if (r < 2 * I_CI) { const int q = r / I_CI; p0_transpose_item(A.in[I_CWIN] + (size_t)q * DM * 3072, DM, 3072, (bf16_t*)(F.ws + WS_WCI) + (size_t)q * 3072 * DM, MAP_CONV, 0, scr, r % I_CI, F.lane); continue; } r -= 2 * I_CI;
        if (r < 2 * I_SQ) { const int q = r / I_SQ; p0_transpose_item(A.in[I_CWOUT] + (size_t)q * DM * DM, DM, DM, (bf16_t*)(F.ws + WS_WCO) + (size_t)q * DM * DM, MAP_NAT, 0, scr, r % I_SQ, F.lane); continue; } r -= 2 * I_SQ;
        if (r < I_AI) { p0_transpose_item(A.in[I_AWIN], DM, ATT_N, (bf16_t*)(F.ws + WS_WAI), MAP_ATTN, 0, scr, r, F.lane); continue; } r -= I_AI;
        if (r < I_SQ) { p0_transpose_item(A.in[I_AWOUT], DM, DM, (bf16_t*)(F.ws + WS_WAO), MAP_NAT, 0, scr, r, F.lane); continue; } r -= I_SQ;
        if (r < I_GL) { p0_transpose_item(A.in[I_SGLU], DM, 2048, (bf16_t*)(F.ws + WS_WGL), MAP_PAIR, 1024, scr, r, F.lane); continue; } r -= I_GL;
        if (r < 2 * I_GU) { const int q = r / I_GU; p0_transpose_item(A.in[I_FGU] + (size_t)q * DM * 2 * FF, DM, 2 * FF, (bf16_t*)(F.ws + WS_WFG) + (size_t)q * 2 * FF * DM, MAP_PAIR, FF, scr, r % I_GU, F.lane); continue; } r -= 2 * I_GU;
        if (F2_FP8) { if (r < 2 * I_DN) { const int q = r / I_DN; p0_transpose_item8(A.in[I_FDN] + (size_t)q * FF * DM, FF, DM, (unsigned char*)(F.ws + WS_WFD) + (size_t)q * DM * FF, MAP_NAT, 0, scr, r % I_DN, F.lane, 0); p0_transpose_item8(A.in[I_FDN] + (size_t)q * FF * DM, FF, DM, (unsigned char*)(F.ws + WS_WFD) + (size_t)q * DM * FF, MAP_NAT, 0, scr, r % I_DN, F.lane, 1); continue; } r -= 2 * I_DN; }
        else if (F2L0_FP8) {
            if (r < I_DN) { p0_transpose_item8(A.in[I_FDN], FF, DM, (unsigned char*)(F.ws + WS_WFD), MAP_NAT, 0, scr, r, F.lane, 0); p0_transpose_item8(A.in[I_FDN], FF, DM, (unsigned char*)(F.ws + WS_WFD), MAP_NAT, 0, scr, r, F.lane, 1); continue; } r -= I_DN;
            if (r < I_DNB) { p0_transpose_item(A.in[I_FDN] + (size_t)FF * DM, FF, DM, (bf16_t*)(F.ws + WS_WFD) + (size_t)DM * FF, MAP_NAT, 0, scr, r, F.lane); continue; } r -= I_DNB; }
        else { if (r < 2 * I_DNB) { const int q = r / I_DNB; p0_transpose_item(A.in[I_FDN] + (size_t)q * FF * DM, FF, DM, (bf16_t*)(F.ws + WS_WFD) + (size_t)q * DM * FF, MAP_NAT, 0, scr, r % I_DNB, F.lane); continue; } r -= 2 * I_DNB; }
        if (r < 8 * I_GU) { const int q = r / I_GU; p0_transpose_item(A.in[I_MGU] + (size_t)q * DM * 2 * FF, DM, 2 * FF, (bf16_t*)(F.ws + WS_WMG) + (size_t)q * 2 * FF * DM, MAP_PAIR, FF, scr, r % I_GU, F.lane); continue; } r -= 8 * I_GU;
        if (M1_FP8) { if (r < 8 * I_GU8) { const int q = 8 + r / I_GU8; unsigned char* dst = (unsigned char*)(F.ws + WS_WMG) + (size_t)8 * 2 * FF * DM * 2 + (size_t)(q - 8) * 2 * FF * DM;
                p0_transpose_item8(A.in[I_MGU] + (size_t)q * DM * 2 * FF, DM, 2 * FF, dst, MAP_PAIR, FF, scr, r % I_GU8, F.lane, 0); p0_transpose_item8(A.in[I_MGU] + (size_t)q * DM * 2 * FF, DM, 2 * FF, dst, MAP_PAIR, FF, scr, r % I_GU8, F.lane, 1); continue; } r -= 8 * I_GU8; }
        else { if (r < 8 * I_GU) { const int q = 8 + r / I_GU; p0_transpose_item(A.in[I_MGU] + (size_t)q * DM * 2 * FF, DM, 2 * FF, (bf16_t*)(F.ws + WS_WMG) + (size_t)q * 2 * FF * DM, MAP_PAIR, FF, scr, r % I_GU, F.lane); continue; } r -= 8 * I_GU; }
        if (M2_FP8) { const int q = r / I_DN; p0_transpose_item8(A.in[I_MDN] + (size_t)q * FF * DM, FF, DM, (unsigned char*)(F.ws + WS_WMD) + (size_t)q * DM * FF, MAP_NAT, 0, scr, r % I_DN, F.lane, 0); p0_transpose_item8(A.in[I_MDN] + (size_t)q * FF * DM, FF, DM, (unsigned char*)(F.ws + WS_WMD) + (size_t)q * DM * FF, MAP_NAT, 0, scr, r % I_DN, F.lane, 1); }
        else { const int q = r / I_DNB; p0_transpose_item(A.in[I_MDN] + (size_t)q * FF * DM, FF, DM, (bf16_t*)(F.ws + WS_WMD) + (size_t)q * DM * FF, MAP_NAT, 0, scr, r % I_DNB, F.lane); }
    }
    { u32x4* z = (u32x4*)((bf16_t*)(F.ws + WS_WAI) + (size_t)2144 * DM); const int n16 = (ATT_NP - 2144) * DM * 2 / 16;
      for (int i = blockIdx.x * NTHREADS + F.tid; i < n16; i += F.G * NTHREADS) z[i] = (u32x4){0u, 0u, 0u, 0u}; }
}

template <int FLAGS>
__device__ __forceinline__ void thin_phase(Frame& F, const Args& A, const float* src, int nl  , int ns  , int cl  , int rl  , int cs = -1  , size_t roff = 0  ) {
    if (cs < 0) cs = rl;
    const int gw = F.vcu * NWAVES + F.wave, NGW = F.G * NWAVES;
    LAS float* rwt = (LAS float*)F.lds;
    if (FLAGS & 8) {
        const float* rw = A.in[I_RW] + (size_t)rl * DM * NEXP;
        for (int i = F.tid; i < DM * NEXP; i += NTHREADS) rwt[(i & 7) * DM + (i >> 3)] = rw[i];
        __syncthreads();
    }
    int Tb[8];
    if (FLAGS & 2) { int acc = 0;
#pragma unroll
        for (int e = 0; e < 8; ++e) { Tb[e] = acc; acc += (int)((__hip_atomic_load(F.ctl + CW_CNT + 64 * (8 * rl + e), RLX_AGENT) + 255u) >> 8); } }
    const float* ng = A.in[I_NORMG] + (size_t)(nl * 2 + ns) * DM;
    constexpr bool RT = (FLAGS & 8) != 0;
    LAS int* rE = (LAS int*)(F.lds + 32768);
    const int nit = RT ? ((M / 64 - (int)blockIdx.x + F.G - 1) / F.G) * 8 : (M - gw + NGW - 1) / NGW;
    for (int it = 0; it < nit; ++it) {
        const int chunk = (int)blockIdx.x + (it >> 3) * F.G;
        const int row = RT ? chunk * 64 + F.wave * 8 + (it & 7) : gw + it * NGW;
        const int b = row / SEQ;
        f32x4 v[4];
        const GAS unsigned long long* xr = (const GAS unsigned long long*)(src + (size_t)row * DM) + 2 * F.lane;
#pragma unroll
        for (int j = 0; j < 4; ++j) { const unsigned long long lo = __hip_atomic_load(xr + 128 * j, RLX_AGENT), hi = __hip_atomic_load(xr + 128 * j + 1, RLX_AGENT);
            v[j] = (f32x4){__uint_as_float((unsigned)lo), __uint_as_float((unsigned)(lo >> 32)), __uint_as_float((unsigned)hi), __uint_as_float((unsigned)(hi >> 32))}; }
        if (FLAGS & 2) {
            const int s0 = ((const int*)(F.ws + roff + WS_SLOT))[row * 2], s1 = ((const int*)(F.ws + roff + WS_SLOT))[row * 2 + 1];
            int t0 = 0, t1 = 0;
#pragma unroll
            for (int e = 0; e < 8; ++e) { if ((s0 >> 16) == e) t0 = Tb[e]; if ((s1 >> 16) == e) t1 = Tb[e]; }
            const bf16_t* y0 = (const bf16_t*)(F.ws + WS_BUF) + (size_t)(256 * t0 + (s0 & 0xffff)) * DM;
            const bf16_t* y1 = (const bf16_t*)(F.ws + WS_BUF) + (size_t)(256 * t1 + (s1 & 0xffff)) * DM;
            const float* g2 = cl >= 0 ? F.mod + ((size_t)cl * NB + b) * 6144 + 5 * DM : (const float*)(F.ws + 512 * 1024);
#pragma unroll
            for (int j = 0; j < 4; ++j) { const int col = 4 * F.lane + 256 * j; const u32x2 a = *(const u32x2*)(y0 + col), c = *(const u32x2*)(y1 + col); const f32x4 g = *(const f32x4*)(g2 + col);
                v[j][0] += g[0] * (bflo(a.x) + bflo(c.x)); v[j][1] += g[1] * (bfhi(a.x) + bfhi(c.x)); v[j][2] += g[2] * (bflo(a.y) + bflo(c.y)); v[j][3] += g[3] * (bfhi(a.y) + bfhi(c.y)); }
        }
        if (FLAGS & 3) { GAS f32x4* xo = (GAS f32x4*)(F.out + (size_t)row * DM) + F.lane;
#pragma unroll
            for (int j = 0; j < 4; ++j) xo[64 * j] = v[j]; }
        if (FLAGS & 4) {
            float ss = 0.f;
#pragma unroll
            for (int j = 0; j < 4; ++j) ss += (v[j][0] * v[j][0] + v[j][1] * v[j][1]) + (v[j][2] * v[j][2] + v[j][3] * v[j][3]);
            const float r = 1.0f / sqrtf(wave_sum(ss) * (1.0f / DM) + EPS);
            const float* sh = F.mod + ((size_t)nl * NB + b) * 6144 + (ns ? 3 : 0) * DM; const float* sc = sh + DM;
            GAS u32x2* ho = (GAS u32x2*)(F.HB + (size_t)row * DM) + F.lane;
#pragma unroll
            for (int j = 0; j < 4; ++j) { const int col = 4 * F.lane + 256 * j; const f32x4 g = *(const f32x4*)(ng + col), s1 = *(const f32x4*)(sc + col), s0 = *(const f32x4*)(sh + col);
                v[j] = (v[j] * r) * g * (s1 + 1.0f) + s0;
                if (RT && M1_FP8 && nl == 3) { int t = 0; t = __builtin_amdgcn_cvt_pk_fp8_f32(v[j][0], v[j][1], t, false); t = __builtin_amdgcn_cvt_pk_fp8_f32(v[j][2], v[j][3], t, true);
                    *(unsigned*)((unsigned char*)F.HB + (size_t)row * DM + col) = (unsigned)t; }
                else { u32x2 w; w.x = pk2(v[j][0], v[j][1]); w.y = pk2(v[j][2], v[j][3]); ho[64 * j] = w; } }
            if (FLAGS & 8) {
                float lg[8];
#pragma unroll
                for (int e = 0; e < 8; ++e) { float s = 0.f;
#pragma unroll
                    for (int j = 0; j < 4; ++j) { const f32x4 w = *(const LAS f32x4*)(rwt + e * DM + 4 * F.lane + 256 * j); s += (v[j][0] * w[0] + v[j][1] * w[1]) + (v[j][2] * w[2] + v[j][3] * w[3]); }
                    lg[e] = wave_sum(s) + A.in[I_RB][rl * NEXP + e]; }
                int e0 = 0; float l0 = lg[0];
#pragma unroll
                for (int e = 1; e < 8; ++e) if (lg[e] > l0) { l0 = lg[e]; e0 = e; }
                int e1 = -1; float l1 = -3.0e38f;
#pragma unroll
                for (int e = 0; e < 8; ++e) if (e != e0 && lg[e] > l1) { l1 = lg[e]; e1 = e; }
                const float g0 = 1.0f / (1.0f + __expf(l1 - l0)), g1 = 1.0f - g0;
                const int lr = F.wave * 8 + (it & 7);
                if (F.lane == 0) { rE[lr] = e0; rE[64 + lr] = e1; rE[128 + lr] = __float_as_int(g0); rE[192 + lr] = __float_as_int(g1); }
            }
        }
        if (RT && (it & 7) == 7) {
            __syncthreads();
            if (F.tid < 8) { int cnt = 0; for (int q = 0; q < 64; ++q) cnt += (rE[q] == F.tid) + (rE[64 + q] == F.tid);
                rE[256 + F.tid] = cnt ? (int)__hip_atomic_fetch_add(F.ctl + CW_CNT + 64 * (8 * cs + F.tid), (unsigned)cnt, RLX_AGENT) : 0; }
            __syncthreads();
            if (F.tid < 64) { const int e0 = rE[F.tid], e1 = rE[64 + F.tid]; int r0 = 0, r1 = 0;
                for (int q = 0; q < F.tid; ++q) { r0 += (rE[q] == e0) + (rE[64 + q] == e0); r1 += (rE[q] == e1) + (rE[64 + q] == e1); }
                const int p0 = rE[256 + e0] + r0, p1 = rE[256 + e1] + r1, grow = chunk * 64 + F.tid;
                gu32* ri = (gu32*)(F.ws + roff + WS_ROWIDX); gu32* gp = (gu32*)(F.ws + roff + WS_GATEP); gu32* sl = (gu32*)(F.ws + roff + WS_SLOT);
                __hip_atomic_store(ri + e0 * 16384 + p0, (unsigned)grow, RLX_AGENT); __hip_atomic_store(ri + e1 * 16384 + p1, (unsigned)grow, RLX_AGENT);
                __hip_atomic_store(gp + e0 * 16384 + p0, (unsigned)rE[128 + F.tid], RLX_AGENT); __hip_atomic_store(gp + e1 * 16384 + p1, (unsigned)rE[192 + F.tid], RLX_AGENT);
                __hip_atomic_store(sl + grow * 2, (unsigned)((e0 << 16) | p0), RLX_AGENT); __hip_atomic_store(sl + grow * 2 + 1, (unsigned)((e1 << 16) | p1), RLX_AGENT); }
            __syncthreads();
        }
    }
}

__device__ __forceinline__ void unpack8(const u32x4 w, float (&f)[8]) { f[0] = bflo(w.x); f[1] = bfhi(w.x); f[2] = bflo(w.y); f[3] = bfhi(w.y); f[4] = bflo(w.z); f[5] = bfhi(w.z); f[6] = bflo(w.w); f[7] = bfhi(w.w); }
__device__ __forceinline__ void conv_phase(Frame& F, const float* cw  ) {
    const int gw = F.vcu * NWAVES + F.wave, NGW = F.G * NWAVES;
    const bf16_t* UB = F.BUF;
    for (int task = gw; task < M / 8; task += NGW) {
        const int r0 = task * 8; const bool first = (r0 % SEQ) == 0;
#pragma unroll
        for (int j = 0; j < 2; ++j) {
            const int ch = 8 * F.lane + 512 * j;
            float w0[8], w1[8], w2[8];
#pragma unroll
            for (int e = 0; e < 8; ++e) { w0[e] = cw[ch + e]; w1[e] = cw[DM + ch + e]; w2[e] = cw[2 * DM + ch + e]; }
            float um2[8], um1[8];
            if (first) {
#pragma unroll
                for (int e = 0; e < 8; ++e) { um2[e] = 0.f; um1[e] = 0.f; }
            } else { unpack8(*(const u32x4*)(UB + (size_t)(r0 - 2) * 2048 + ch), um2); unpack8(*(const u32x4*)(UB + (size_t)(r0 - 1) * 2048 + ch), um1); }
#pragma unroll
            for (int i = 0; i < 8; ++i) {
                float u0[8], bb[8]; unpack8(*(const u32x4*)(UB + (size_t)(r0 + i) * 2048 + ch), u0); unpack8(*(const u32x4*)(UB + (size_t)(r0 + i) * 2048 + 1024 + ch), bb);
                float z[8];
#pragma unroll
                for (int e = 0; e < 8; ++e) z[e] = bb[e] * (w0[e] * um2[e] + w1[e] * um1[e] + w2[e] * u0[e]);
                u32x4 o; o.x = pk2(z[0], z[1]); o.y = pk2(z[2], z[3]); o.z = pk2(z[4], z[5]); o.w = pk2(z[6], z[7]);
                *(u32x4*)(F.HB + (size_t)(r0 + i) * DM + ch) = o;
#pragma unroll
                for (int e = 0; e < 8; ++e) { um2[e] = um1[e]; um1[e] = u0[e]; }
            }
        }
    }
}

constexpr int QIP = 1040;
constexpr int AL_QI = 0, AL_WI = 33280, AL_SEL = 34304, AL_V = 42496, AL_BIASD = 108032, AL_SUM = 116288, AL_END = 116800;
typedef short v4i16_t __attribute__((ext_vector_type(4)));
__device__ __forceinline__ unsigned okey(float f) { const unsigned u = __float_as_uint(f); return u ^ ((u >> 31) ? 0xFFFFFFFFu : 0x80000000u); }
__device__ __forceinline__ void attn_phase(Frame& F, const Args& A) {
    LAS unsigned char* L = F.lds;
    const bf16_t* Qb = (const bf16_t*)(F.ws + WS_Q); const bf16_t* Kb = (const bf16_t*)(F.ws + WS_K); const bf16_t* Vb = (const bf16_t*)(F.ws + WS_V);
    const bf16_t* QIb = (const bf16_t*)(F.ws + WS_QI); const bf16_t* KIb = (const bf16_t*)(F.ws + WS_KI); const float* WIb = (const float*)(F.ws + WS_WI);
    bf16_t* Ob = (bf16_t*)(F.ws + WS_O);
    float* SC = (float*)(F.ws + WS_SC) + (size_t)blockIdx.x * 32 * SEQ;
    const int lane = F.lane, wave = F.wave;
    { LAS float* bd = (LAS float*)(L + AL_BIASD);
      for (int i = F.tid; i < 129 * 16; i += NTHREADS) { const int d = i >> 4; int bkt; if (d < 16) bkt = d; else { const float dd = (float)d; const int lg2 = 16 + (int)(logf(dd / 16.0f) / 2.0794415416798357f * 16.0f); bkt = lg2 < 31 ? lg2 : 31; }
          bd[i] = A.in[I_RELB][bkt * 16 + (i & 15)]; }
    }
    __syncthreads();
    for (int pass = 0; pass < 2; ++pass) {
        const int un = pass == 0 ? (int)blockIdx.x : 511 - (int)blockIdx.x;
        for (int uu = un; uu >= 0 && uu < 512; uu += (pass == 0 ? F.G * 2 : -F.G * 2)) {
        if ((pass == 0 && uu >= 256) || (pass == 1 && uu < 256)) break;
        const int b = uu & 3, qb = uu >> 2, t0 = qb * 32; const size_t rb = (size_t)b * SEQ;
        for (int i = F.tid; i < 32 * 64; i += NTHREADS) { const int q = i >> 6, c = i & 63; *(LAS u32x4*)(L + AL_QI + q * QIP + c * 16) = *(const u32x4*)(QIb + (rb + t0 + q) * 512 + c * 8); }
        if (F.tid < 256) ((LAS float*)(L + AL_WI))[F.tid] = WIb[(rb + t0) * 8 + F.tid];
        __syncthreads();
        {
            for (int kt = wave; kt <= qb; kt += NWAVES) {
                int ln1 = lane; asm volatile("" : "+v"(ln1));
                const int r = ln1 & 31, hh = ln1 >> 5;
                float wi[8];
#pragma unroll
                for (int h = 0; h < 8; ++h) wi[h] = ((LAS float*)(L + AL_WI))[r * 8 + h];
                bf16x8 ka[4];
#pragma unroll
                for (int ks = 0; ks < 4; ++ks) ka[ks] = *(const bf16x8*)(KIb + (rb + kt * 32 + r) * 64 + 16 * ks + 8 * hh);
                f32x16 sc;
#pragma unroll
                for (int i = 0; i < 16; ++i) sc[i] = 0.f;
#pragma unroll
                for (int h = 0; h < 8; ++h) {
                    f32x16 d;
#pragma unroll
                    for (int i = 0; i < 16; ++i) d[i] = 0.f;
#pragma unroll
                    for (int ks = 0; ks < 4; ++ks) { const bf16x8 qf = *(const LAS bf16x8*)(L + AL_QI + r * QIP + (h * 64 + 16 * ks + 8 * hh) * 2); d = __builtin_amdgcn_mfma_f32_32x32x16_bf16(ka[ks], qf, d, 0, 0, 0); }
#pragma unroll
                    for (int i = 0; i < 16; ++i) sc[i] += wi[h] * fmaxf(d[i], 0.f);
                }
#pragma unroll
                for (int a = 0; a < 4; ++a) { f32x4 o;
#pragma unroll
                    for (int e = 0; e < 4; ++e) { const int krow = 8 * a + 4 * hh + e; o[e] = (kt == qb && krow > r) ? -INFINITY : sc[4 * a + e]; }
                    *(f32x4*)(SC + (size_t)r * SEQ + kt * 32 + 8 * a + 4 * hh) = o; }
            }
        }
        VM_WAIT(); __syncthreads();
        for (int qq = 0; qq < 4; ++qq) {
            const int c = wave + 8 * qq, t = t0 + c; const int nvalid = t + 1;
            int lane = F.lane; asm volatile("" : "+v"(lane));
            LAS int* sel = (LAS int*)(L + AL_SEL) + wave * 256;
            int count;
            if (nvalid <= TOPK) {
                count = nvalid;
#pragma unroll
                for (int j = 0; j < 4; ++j) { const int idx = 64 * j + lane; sel[idx] = idx < nvalid ? idx : 0; }
            } else {
                count = TOPK;
                const int nj = (nvalid + 63) >> 6;
                unsigned key[64];
                const float* srow = SC + (size_t)c * SEQ;
#define SEL_GROUPS(BODY) do { BODY(0) if (nj > 16) { BODY(1) if (nj > 32) { BODY(2) if (nj > 48) { BODY(3) } } } } while (0)
#define SEL_LOAD(g) { _Pragma("unroll") for (int j = 16 * (g); j < 16 * (g) + 16; ++j) { const int idx = 64 * j + lane; const float sv = __uint_as_float(__hip_atomic_load((const gu32*)(srow + idx), RLX_AGENT)); key[j] = idx <= t ? okey(sv) : 0u;     } }
#pragma unroll
                for (int j = 0; j < 64; ++j) key[j] = 0u;
                SEL_GROUPS(SEL_LOAD);
                unsigned T = 0u;
                for (int bit = 31; bit >= 0; --bit) {
                    const unsigned cand = T | (1u << bit); int cnt = 0;
#define SEL_CNT(g) { _Pragma("unroll") for (int j = 16 * (g); j < 16 * (g) + 16; ++j) cnt += __popcll(__ballot(key[j] >= cand)); }
                    SEL_GROUPS(SEL_CNT);
                    if (cnt >= TOPK) T = cand;
                    if (cnt == TOPK) break;
                }
                int base = 0;
#define SEL_GT(g) { _Pragma("unroll") for (int j = 16 * (g); j < 16 * (g) + 16; ++j) { const bool gt = key[j] > T; const unsigned long long mk = __ballot(gt); \
                    const int pos = base + (int)__builtin_amdgcn_mbcnt_hi((unsigned)(mk >> 32), __builtin_amdgcn_mbcnt_lo((unsigned)mk, 0u)); if (gt) sel[pos] = 64 * j + lane; base += __popcll(mk); } }
                SEL_GROUPS(SEL_GT);
                const int need = TOPK - base; int eb = 0;
#define SEL_EQ(g) { _Pragma("unroll") for (int j = 16 * (g); j < 16 * (g) + 16; ++j) { const bool eq = key[j] == T; const unsigned long long mk = __ballot(eq); \
                    const int rank = eb + (int)__builtin_amdgcn_mbcnt_hi((unsigned)(mk >> 32), __builtin_amdgcn_mbcnt_lo((unsigned)mk, 0u)); if (eq && rank < need) sel[base + rank] = 64 * j + lane; eb += __popcll(mk); } }
                SEL_GROUPS(SEL_EQ);
#undef SEL_GROUPS
#undef SEL_LOAD
#undef SEL_CNT
#undef SEL_GT
#undef SEL_EQ
            }
            LDS_WAIT(); CFENCE();
            asm volatile("" : "+v"(lane));
            const int hd = lane & 15, kq = lane >> 4;
            bf16x8 bq[8];
            { bf16x8 qf[2];
#pragma unroll
              for (int s2 = 0; s2 < 2; ++s2) qf[s2] = *(const bf16x8*)(Qb + (rb + t) * 1024 + hd * 64 + 32 * s2 + 8 * kq);
              const bf16x8 zf = (bf16x8){0, 0, 0, 0, 0, 0, 0, 0};
#pragma unroll
              for (int ks = 0; ks < 8; ++ks) bq[ks] = ((ks >> 1) == (hd >> 2)) ? qf[ks & 1] : zf; }
            f32x4 lg[16];
            float mx = -INFINITY;
            bf16x8 kf[3][8];
#pragma unroll
            for (int pre = 0; pre < 2; ++pre) { const int krow = sel[16 * pre + hd]; const bf16_t* kp = Kb + (rb + krow) * 256 + 8 * kq;
#pragma unroll
              for (int ks = 0; ks < 8; ++ks) kf[pre][ks] = *(const bf16x8*)(kp + 32 * ks); }
            const LAS float* biasd = (const LAS float*)(L + AL_BIASD);
#pragma unroll
            for (int kt = 0; kt < 16; ++kt) {
                if (kt < 14) { const int krow = sel[16 * (kt + 2) + hd]; const bf16_t* kp = Kb + (rb + krow) * 256 + 8 * kq;
#pragma unroll
                    for (int ks = 0; ks < 8; ++ks) kf[(kt + 2) % 3][ks] = *(const bf16x8*)(kp + 32 * ks); }
                f32x4 d = (f32x4){0.f, 0.f, 0.f, 0.f};
#pragma unroll
                for (int ks = 0; ks < 8; ++ks) d = __builtin_amdgcn_mfma_f32_16x16x32_bf16(kf[kt % 3][ks], bq[ks], d, 0, 0, 0);
                const u32x4 ks4 = *(const LAS u32x4*)(sel + 16 * kt + 4 * kq);
#pragma unroll
                for (int i = 0; i < 4; ++i) { const int pos = 16 * kt + 4 * kq + i; int dist = t - (int)ks4[i]; dist = dist < 0 ? 0 : (dist > 128 ? 128 : dist);
                    const float bs = biasd[dist * 16 + hd];
                    d[i] = pos < count ? d[i] + bs : -INFINITY; mx = fmaxf(mx, d[i]); }
                lg[kt] = d;
            }
            mx = fmaxf(mx, __shfl_xor(mx, 16)); mx = fmaxf(mx, __shfl_xor(mx, 32));
            float sum = 0.f;
            bf16x8 pa[8];
#pragma unroll
            for (int ks = 0; ks < 8; ++ks) { float p[8];
#pragma unroll
                for (int i = 0; i < 4; ++i) { p[i] = __expf(lg[2 * ks][i] - mx); p[4 + i] = __expf(lg[2 * ks + 1][i] - mx); }
                sum += ((p[0] + p[1]) + (p[2] + p[3])) + ((p[4] + p[5]) + (p[6] + p[7]));
                u32x4 w; w.x = cvt_pk_bf16(p[0], p[1]); w.y = cvt_pk_bf16(p[2], p[3]); w.z = cvt_pk_bf16(p[4], p[5]); w.w = cvt_pk_bf16(p[6], p[7]);
                pa[ks] = __builtin_bit_cast(bf16x8, w); }
            sum += __shfl_xor(sum, 16); sum += __shfl_xor(sum, 32);
            if (kq == 0) ((LAS float*)(L + AL_SUM))[wave * 16 + hd] = sum;
            LDS_WAIT(); CFENCE();
            {
                asm volatile("" : "+v"(lane));
                const int rs = lane >> 3, ch = lane & 7, i16 = lane & 15, tq = i16 >> 2, tp = i16 & 3, kq2 = lane >> 4;
                LAS unsigned char* vb = L + AL_V + wave * 8192;
                const unsigned wr_off = (unsigned)lane * 16u, tr_off = (unsigned)((4 * kq2 + tq) * 128 + 8 * tp);
                f32x4 O[4][4];
#pragma unroll
                for (int n = 0; n < 4; ++n)
#pragma unroll
                    for (int dt = 0; dt < 4; ++dt) O[n][dt] = (f32x4){0.f, 0.f, 0.f, 0.f};
                u32x4 vr[2][4]; int kr[4];
                const bf16_t* vbase = Vb + rb * 256 + 8 * ch;
#pragma unroll
                for (int i = 0; i < 4; ++i) kr[i] = sel[8 * i + rs];
#pragma unroll
                for (int pre = 0; pre < 2; ++pre)
#pragma unroll
                    for (int i = 0; i < 4; ++i) vr[pre][i] = *(const u32x4*)(vbase + (size_t)kr[i] * 256 + pre * 64);
#pragma unroll
                for (int st = 0; st < 32; ++st) {
                    const int ks = st >> 2, n = st & 3;
                    LAS unsigned char* buf = vb + (st & 1) * 4096;
#pragma unroll
                    for (int i = 0; i < 4; ++i) *(LAS u32x4*)(buf + wr_off + i * 1024) = vr[st & 1][i];
                    if (st < 30) { const int ks2 = (st + 2) >> 2, n2 = (st + 2) & 3;
                        if (n2 == 0) {
#pragma unroll
                            for (int i = 0; i < 4; ++i) kr[i] = sel[32 * ks2 + 8 * i + rs]; }
#pragma unroll
                        for (int i = 0; i < 4; ++i) vr[st & 1][i] = *(const u32x4*)(vbase + (size_t)kr[i] * 256 + n2 * 64); }
#pragma unroll
                    for (int dt = 0; dt < 4; ++dt) {
                        const v4i16_t t0 = __builtin_amdgcn_ds_read_tr16_b64_v4i16((LAS v4i16_t*)(buf + tr_off + 32 * dt));
                        const v4i16_t t1 = __builtin_amdgcn_ds_read_tr16_b64_v4i16((LAS v4i16_t*)(buf + tr_off + 2048 + 32 * dt));
                        const bf16x8 bfr = (bf16x8){t0[0], t0[1], t0[2], t0[3], t1[0], t1[1], t1[2], t1[3]};
                        O[n][dt] = __builtin_amdgcn_mfma_f32_16x16x32_bf16(pa[ks], bfr, O[n][dt], 0, 0, 0); }
                    CFENCE();
                }
                const f32x4 sm = *(const LAS f32x4*)(L + AL_SUM + (wave * 16 + 4 * kq2) * 4);
                bf16_t* op = Ob + (rb + t) * 1024 + (4 * kq2) * 64 + i16;
#pragma unroll
                for (int dt = 0; dt < 4; ++dt)
#pragma unroll
                    for (int i = 0; i < 4; ++i) { const float v = kq2 == 0 ? O[0][dt][i] : (kq2 == 1 ? O[1][dt][i] : (kq2 == 2 ? O[2][dt][i] : O[3][dt][i]));
                        op[i * 64 + 16 * dt] = (bf16_t)f2bf(v / sm[i]); }
            }
            LDS_WAIT(); CFENCE();
        }
        __syncthreads();
        }
    }
}

constexpr int SL_BMT = 0;
constexpr int SL_CMA = 4096;
constexpr int SL_AB = 12288;
constexpr int SL_E = 12800;
constexpr int SL_S = 16896;
constexpr int SPITCH = 272;
__device__ __forceinline__ void cmul(float ar, float ai, float br, float bi, float& cr, float& ci) { cr = ar * br - ai * bi; ci = ar * bi + ai * br; }
__device__ __forceinline__ void ssm_phase(Frame& F, const Args& A) {
    LAS unsigned char* L = F.lds;
    const int lane = F.lane, wave = F.wave;
    bf16_t* G = (bf16_t*)(F.ws + WS_ACT);
    for (int un = F.vcu; un < NB * 64; un += F.G) {
        const int b = un >> 6, g = un & 63; const size_t rb = (size_t)b * SEQ;
        __syncthreads();
        if (F.tid < 64) {
            const int p = F.tid;
            const float lr = fminf(A.in[I_SLRE][g * 64 + p], -1e-4f), li = A.in[I_SLIM][g * 64 + p];
            const float step = expf(A.in[I_SLOG][g]);
            const float mag = expf(lr * step); float sn, cs; sincosf(li * step, &sn, &cs);
            const float ar = mag * cs, ai = mag * sn;
            ((LAS float*)(L + SL_AB))[2 * p] = ar; ((LAS float*)(L + SL_AB))[2 * p + 1] = ai;
            const float nr = ar - 1.0f, ni = ai, den = lr * lr + li * li;
            const float cr = (nr * lr + ni * li) / den, ci = (ni * lr - nr * li) / den;
            LAS bf16_t* bm = (LAS bf16_t*)(L + SL_BMT);
#pragma unroll
            for (int c = 0; c < 16; ++c) { const float br = A.in[I_SBRE][((size_t)g * 64 + p) * 16 + c], bi = A.in[I_SBIM][((size_t)g * 64 + p) * 16 + c];
                float xr, xi; cmul(cr, ci, br, bi, xr, xi); bm[p * 16 + c] = (bf16_t)f2bf(xr); bm[(64 + p) * 16 + c] = (bf16_t)f2bf(xi); }
        }
        { LAS bf16_t* cm = (LAS bf16_t*)(L + SL_CMA);
          for (int i = F.tid; i < 32 * 128; i += NTHREADS) { const int c = i >> 7, k = i & 127; float v = 0.f;
              if (c < 16) v = (k < 64) ? A.in[I_SCRE][((size_t)g * 16 + c) * 64 + k] : -A.in[I_SCIM][((size_t)g * 16 + c) * 64 + (k - 64)];
              cm[i] = (bf16_t)f2bf(v); } }
        __syncthreads();
        const int r = lane & 31, hh = lane >> 5;
        bf16x8 bfr[4];
#pragma unroll
        for (int n = 0; n < 4; ++n) bfr[n] = *(const LAS bf16x8*)(L + SL_BMT + ((32 * n + r) * 16 + 8 * hh) * 2);
        bf16x8 cfr[8];
#pragma unroll
        for (int ks = 0; ks < 8; ++ks) cfr[ks] = *(const LAS bf16x8*)(L + SL_CMA + (r * 128 + 16 * ks + 8 * hh) * 2);
        float ar[2], ai[2], a16r[2], a16i[2], a512r[2], a512i[2];
#pragma unroll
        for (int s = 0; s < 2; ++s) { ar[s] = ((LAS float*)(L + SL_AB))[2 * (32 * s + r)]; ai[s] = ((LAS float*)(L + SL_AB))[2 * (32 * s + r) + 1];
            float pr = ar[s], pi = ai[s];
#pragma unroll
            for (int q = 0; q < 4; ++q) { float nr, ni; cmul(pr, pi, pr, pi, nr, ni); pr = nr; pi = ni; }
            a16r[s] = pr; a16i[s] = pi;
#pragma unroll
            for (int q = 0; q < 5; ++q) { float nr, ni; cmul(pr, pi, pr, pi, nr, ni); pr = nr; pi = ni; }
            a512r[s] = pr; a512i[s] = pi; }
        const int tokperm = 16 * ((r >> 2) & 1) + 4 * (r >> 3) + (r & 3);
        const float dsk0 = 0.f; (void)dsk0;
        float cin_r[2] = {0.f, 0.f}, cin_i[2] = {0.f, 0.f};
        LAS unsigned char* Sw = L + SL_S + wave * (32 * SPITCH);
        for (int pass = 0; pass < 2; ++pass) {
            if (pass == 1) {
                __syncthreads();
#pragma unroll
                for (int s = 0; s < 2; ++s) { float cr = 0.f, ci = 0.f;
                    for (int w = 0; w < wave; ++w) { float nr, ni; cmul(a512r[s], a512i[s], cr, ci, nr, ni); cr = nr + ((LAS float*)(L + SL_E))[(w * 64 + 32 * s + r) * 2]; ci = ni + ((LAS float*)(L + SL_E))[(w * 64 + 32 * s + r) * 2 + 1]; }
                    cin_r[s] = cr; cin_i[s] = ci; }
            }
            bf16x8 ufn = *(const bf16x8*)(F.HB + (rb + wave * 512 + tokperm) * DM + 16 * g + 8 * hh);
            for (int tile = 0; tile < 16; ++tile) {
                asm volatile("s_waitcnt vmcnt(0) lgkmcnt(0)" ::: "memory"); __builtin_amdgcn_s_barrier(); asm volatile("" ::: "memory");
                const int tk0 = wave * 512 + tile * 32;
                const bf16x8 uf = ufn;
                if (tile < 15) ufn = *(const bf16x8*)(F.HB + (rb + tk0 + 32 + tokperm) * DM + 16 * g + 8 * hh);

                f32x16 d[4];
#pragma unroll
                for (int n = 0; n < 4; ++n) {
#pragma unroll
                    for (int i = 0; i < 16; ++i) d[n][i] = 0.f;
                    d[n] = __builtin_amdgcn_mfma_f32_32x32x16_bf16(uf, bfr[n], d[n], 0, 0, 0); }
                asm volatile("s_nop 15\n\ts_nop 15\n\ts_nop 15" : "+v"(d[0]), "+v"(d[1]), "+v"(d[2]), "+v"(d[3]));
#pragma unroll
                for (int s = 0; s < 2; ++s) {
                    float sr = hh == 0 ? cin_r[s] : 0.f, si = hh == 0 ? cin_i[s] : 0.f;
#pragma unroll
                    for (int i = 0; i < 16; ++i) { const float nr = ar[s] * sr - ai[s] * si + d[s][i], ni = ar[s] * si + ai[s] * sr + d[2 + s][i]; sr = nr; si = ni; d[s][i] = sr; d[2 + s][i] = si; }
                    const float e0r = __shfl_xor(sr, 32), e0i = __shfl_xor(si, 32);
                    float cr = hh == 1 ? e0r : 0.f, ci = hh == 1 ? e0i : 0.f;
                    if (pass == 1) {
#pragma unroll
                        for (int i = 0; i < 16; ++i) { float nr, ni; cmul(ar[s], ai[s], cr, ci, nr, ni); cr = nr; ci = ni; d[s][i] += cr; d[2 + s][i] += ci; }
                    } else { float nr, ni; cmul(a16r[s], a16i[s], cr, ci, nr, ni); cr = nr; ci = ni; }
                    const float endr = (pass == 1) ? d[s][15] : sr + cr, endi = (pass == 1) ? d[2 + s][15] : si + ci;
                    const float xr = __shfl_xor(endr, 32), xi = __shfl_xor(endi, 32);
                    cin_r[s] = hh == 1 ? endr : xr; cin_i[s] = hh == 1 ? endi : xi;
                }
                if (pass == 1) {
#pragma unroll
                    for (int s = 0; s < 2; ++s)
#pragma unroll
                        for (int i = 0; i < 16; ++i) { *(LAS bf16_t*)(Sw + (16 * hh + i) * SPITCH + (32 * s + r) * 2) = (bf16_t)f2bf(d[s][i]); *(LAS bf16_t*)(Sw + (16 * hh + i) * SPITCH + (64 + 32 * s + r) * 2) = (bf16_t)f2bf(d[2 + s][i]); }
                    LDS_WAIT(); CFENCE();
                    f32x16 y;
#pragma unroll
                    for (int i = 0; i < 16; ++i) y[i] = 0.f;
#pragma unroll
                    for (int ks = 0; ks < 8; ++ks) { const bf16x8 sf = *(const LAS bf16x8*)(Sw + r * SPITCH + (16 * ks + 8 * hh) * 2); y = __builtin_amdgcn_mfma_f32_32x32x16_bf16(cfr[ks], sf, y, 0, 0, 0); }
                    LDS_WAIT(); CFENCE();
                    const size_t trow = rb + tk0 + r;
#pragma unroll
                    for (int q = 0; q < 2; ++q) { const int ch = 16 * g + 8 * q + 4 * hh;
                        const u32x2 hv = *(const u32x2*)(F.HB + trow * DM + ch); const f32x4 dk = *(const f32x4*)(A.in[I_SD] + ch);
                        const float y0 = gelu_tanh_f(y[4 * q + 0] + dk[0] * bflo(hv.x)), y1 = gelu_tanh_f(y[4 * q + 1] + dk[1] * bfhi(hv.x)), y2 = gelu_tanh_f(y[4 * q + 2] + dk[2] * bflo(hv.y)), y3 = gelu_tanh_f(y[4 * q + 3] + dk[3] * bfhi(hv.y));
                        u32x2 w; w.x = pk2(y0, y1); w.y = pk2(y2, y3); *(u32x2*)(G + trow * DM + ch) = w; }
                }
            }
            if (pass == 0) {
                if (hh == 1) {
#pragma unroll
                    for (int s = 0; s < 2; ++s) { ((LAS float*)(L + SL_E))[(wave * 64 + 32 * s + r) * 2] = cin_r[s]; ((LAS float*)(L + SL_E))[(wave * 64 + 32 * s + r) * 2 + 1] = cin_i[s]; } }
                cin_r[0] = cin_r[1] = cin_i[0] = cin_i[1] = 0.f;
            }
        }
    }
}

enum { PH_PRO = 0, PH_NORM0,
       L0_G1, L0_CONV, L0_G2, L0_NORM, L0_F1, L0_F2, L0_NORMN,
       L1_G1, L1_ATTN, L1_G2, L1_NORMR, L1_M1, L1_M2, L1_COMB,
       L2_SSM, L2_G2, L2_NORM, L2_F1, L2_F2, L2_NORMN,
       L3_G1, L3_CONV, L3_G2, L3_NORMR, L3_M1, L3_M2, L3_COMB, NPH };

__device__ __forceinline__ bool fresh_ids(Frame& F) { const int l = lane_id_fresh(); F.lane = l; F.tid = F.wave * 64 + l; return true; }
__global__ void __launch_bounds__(NTHREADS, 2) mega_fwd(Args args) {
    extern __shared__ __attribute__((aligned(16))) unsigned char lds_raw[];
    Frame F;
    F.lds = (LAS unsigned char*)lds_raw;
    volatile LAS unsigned* MISC = (volatile LAS unsigned*)(F.lds + MISC_OFF);
    F.tid = threadIdx.x; F.lane = F.tid & 63; F.wave = __builtin_amdgcn_readfirstlane(F.tid >> 6);
    F.G = gridDim.x; { const int bx = blockIdx.x; F.vcu = (F.G % 8 == 0) ? (bx % 8) * (F.G / 8) + bx / 8 : bx; }
    F.ws = args.ws; F.ctl = (gu32*)(args.ws + WS_CTL); F.out = args.out; F.mod = (const float*)(args.ws + WS_MOD);
    F.HB = (bf16_t*)(args.ws + WS_HB); F.BUF = (bf16_t*)(args.ws + WS_BUF); F.ACT = (bf16_t*)(args.ws + WS_ACT);
    for (int u = F.tid; u < (LDS_BYTES - LDSCTL_OFF) / 4; u += NTHREADS) ((LAS unsigned*)(F.lds + LDSCTL_OFF))[u] = 0u;
    __syncthreads();
    XcdBarrier bar; bar.bar = (unsigned*)(F.ctl + CW_BAR); bar.x = 0; bar.st = nullptr; bar.w = F.wave;
    const int lo = args.ph_lo, hi = args.ph_hi;
    if (hi - lo > 1) bar = xcd_barrier_post((unsigned*)(F.ctl + CW_BAR), MISC + 8, F.wave);
#ifndef PH_ONLY
#define PH_EN(k) true
#else
#define PH_EN(k) ((k) == PH_ONLY)
#endif
#define IN(k) (PH_EN(k) && lo <= (k) && (k) < hi && fresh_ids(F))
#define SEAM(k) do { if (IN(k) && IN((k) + 1)) xcd_barrier(bar); } while (0)
#ifndef PH_REP
#define PH_REP (-1)
#endif
#ifndef PH_REPMASK
#define PH_REPMASK 0ull
#endif
#define REPB(k, ...) do { if (PH_REP == (k) || ((PH_REPMASK >> (k)) & 1ull)) { xcd_barrier(bar); __VA_ARGS__; } } while (0)
    LAS unsigned char* ring = F.lds;
    const int cid = (int)blockIdx.x;
    bf16_t* const WCI = (bf16_t*)(F.ws + WS_WCI); bf16_t* const WCO = (bf16_t*)(F.ws + WS_WCO); bf16_t* const WAI = (bf16_t*)(F.ws + WS_WAI); bf16_t* const WAO = (bf16_t*)(F.ws + WS_WAO);
    bf16_t* const WGL = (bf16_t*)(F.ws + WS_WGL); bf16_t* const WFG = (bf16_t*)(F.ws + WS_WFG); bf16_t* const WFD = (bf16_t*)(F.ws + WS_WFD); bf16_t* const WMG = (bf16_t*)(F.ws + WS_WMG); bf16_t* const WMD = (bf16_t*)(F.ws + WS_WMD);

#define ZEROG ((const float*)(F.ws + 512 * 1024))
    const bool fuseR = (F.G == 256) && FUSE_R;
    const bool fuse = (F.G == 256) && FUSE_N;
#define FUSED_EPI(inst, gatep, xin, nl, ns, hout, asc) ({F.out, (gatep), (xin), args.in[I_NORMG] + (size_t)((nl) * 2 + (ns)) * DM, F.mod + (size_t)(nl) * NB * 6144 + ((ns) ? 3 : 0) * DM, (hout), (float*)(F.ws + WS_XS), F.ctl + CW_PAN + 64 * 64 * (inst), F.ctl + CW_TMO, (asc)})
#define FUSED_RT(inst, gatep, nl, rl, roff, hout, h8_) ({F.out, (gatep), args.in[I_NORMG] + (size_t)((nl) * 2 + 1) * DM, F.mod + (size_t)(nl) * NB * 6144 + 3 * DM, (hout), (float*)(F.ws + WS_XS9), F.ctl + CW_PAN + 64 * 64 * (inst), F.ctl + CW_TMO, \
        args.in[I_RW] + (size_t)(rl) * DM * NEXP, args.in[I_RB] + (rl) * NEXP, F.ctl + CW_CNT + 64 * 8 * (rl), F.ws + (roff), (h8_)})
#define MODP(l, chunk) (F.mod + (size_t)(l) * NB * 6144 + (chunk) * DM)
#define GEMM_STATIC(Aptr, Bptr, Nn, Kk, EpiT, EpiInit) do { pg8::Gemm g{(Aptr), (Bptr), M, (Nn), (Kk), 0, nullptr, nullptr}; pg8::StaticOrder S; S.init(M, (Nn), F.G, cid); EpiT E EpiInit; \
        pg8::gemm_phase<EpiT, pg8::StaticOrder, false>(ring, g, S, E, F.wave); } while (0)
#define GEMM_STATIC8(Aptr, Bptr, Nn, Kk, EpiT, EpiInit) do { pg8::Gemm g{(Aptr), (Bptr), M, (Nn), (Kk), 0, nullptr, nullptr}; pg8::StaticOrder S; S.init(M, (Nn), F.G, cid); EpiT E EpiInit; \
        pg8::gemm_phase<EpiT, pg8::StaticOrder, false, true>(ring, g, S, E, F.wave); } while (0)
#define EPAIR8 pg8::EpiPair<1, (M2_FP8 != 0), (M1_FP8 != 0)>
#define M1_B (M1_FP8 ? 1 : 2)
#define EPAIR8L1 pg8::EpiPair<1, (M2_FP8 != 0), false>
#define M2_B (M2_FP8 ? 1 : 2)
#define F2_ASC (F2_FP8 ? pg8::W8_INV : 1.0f)
#define GEMM_STATICF(Aptr, Bptr, Nn, Kk, EpiT, EpiInit) do { pg8::Gemm g{(Aptr), (Bptr), M, (Nn), (Kk), 0, nullptr, nullptr}; pg8::StaticOrder S; S.init(M, (Nn), F.G, cid); EpiT E EpiInit; \
        pg8::gemm_phase<EpiT, pg8::StaticOrder, false, (F2_FP8 != 0)>(ring, g, S, E, F.wave); } while (0)
#define EPAIRF pg8::EpiPair<1, (F2_FP8 != 0), false>
#define F0_FP8 (F2_FP8 || F2L0_FP8)
#define F2L0_ASC (F0_FP8 ? pg8::W8_INV : 1.0f)
#define EPAIR0 pg8::EpiPair<1, (F0_FP8 != 0), false>
#define GEMM_STATICF0(Aptr, Bptr, Nn, Kk, EpiT, EpiInit) do { pg8::Gemm g{(Aptr), (Bptr), M, (Nn), (Kk), 0, nullptr, nullptr}; pg8::StaticOrder S; S.init(M, (Nn), F.G, cid); EpiT E EpiInit; \
        pg8::gemm_phase<EpiT, pg8::StaticOrder, false, (F0_FP8 != 0)>(ring, g, S, E, F.wave); } while (0)
#define W8(base, bytes) ((bf16_t*)((unsigned char*)(base) + (size_t)(bytes)))

    if (IN(PH_PRO)) { p0_prologue(F, args); REPB(PH_PRO, p0_prologue(F, args)); } SEAM(PH_PRO);
    if (IN(PH_NORM0)) { thin_phase<4>(F, args, args.in[I_X], 0, 0, 0, 0); REPB(PH_NORM0, thin_phase<4>(F, args, args.in[I_X], 0, 0, 0, 0)); } SEAM(PH_NORM0);

    if (IN(L0_G1)) { GEMM_STATIC(F.HB, WCI, 3072, DM, pg8::EpiConvIn, {F.BUF}); REPB(L0_G1, GEMM_STATIC(F.HB, WCI, 3072, DM, pg8::EpiConvIn, {F.BUF})); } SEAM(L0_G1);
    if (IN(L0_CONV)) { conv_phase(F, args.in[I_CW]); REPB(L0_CONV, conv_phase(F, args.in[I_CW])); } SEAM(L0_CONV);
    if (IN(L0_G2)) { if (fuse) GEMM_STATIC(F.HB, WCO, DM, DM, pg8::EpiResNorm, FUSED_EPI(0, MODP(0, 2), args.in[I_X], 0, 1, (fuse ? F.BUF : F.HB), 1.0f)); else GEMM_STATIC(F.HB, WCO, DM, DM, pg8::EpiRes, ({F.out, MODP(0, 2), args.in[I_X], 1.0f})); } SEAM(L0_G2);
    if (!fuse) { if (IN(L0_NORM)) { thin_phase<4>(F, args, F.out, 0, 1, 0, 0); } SEAM(L0_NORM); }
    if (IN(L0_F1)) { GEMM_STATIC((fuse ? F.BUF : F.HB), WFG, 2 * FF, DM, EPAIR0, ({F.ACT, FF})); REPB(L0_F1, GEMM_STATIC(F.HB, WFG, 2 * FF, DM, EPAIR0, ({F.ACT, FF}))); } SEAM(L0_F1);
    if (IN(L0_F2)) { if (fuse) GEMM_STATICF0(F.ACT, WFD, DM, FF, pg8::EpiResNorm, FUSED_EPI(1, MODP(0, 5), F.out, 1, 0, F.HB, F2L0_ASC)); else GEMM_STATICF0(F.ACT, WFD, DM, FF, pg8::EpiRes, ({F.out, MODP(0, 5), F.out, F2L0_ASC})); } SEAM(L0_F2);
    if (!fuse) { if (IN(L0_NORMN)) { thin_phase<4>(F, args, F.out, 1, 0, 0, 0); } SEAM(L0_NORMN); }

    if (IN(L1_G1)) { GEMM_STATIC(F.HB, WAI, ATT_NP, DM, pg8::EpiAttnIn, ({(bf16_t*)(F.ws + WS_Q), (bf16_t*)(F.ws + WS_K), (bf16_t*)(F.ws + WS_V), (bf16_t*)(F.ws + WS_QI), (bf16_t*)(F.ws + WS_KI), (float*)(F.ws + WS_WI), args.in[I_QG], args.in[I_KG]})); REPB(L1_G1, GEMM_STATIC(F.HB, WAI, ATT_NP, DM, pg8::EpiAttnIn, ({(bf16_t*)(F.ws + WS_Q), (bf16_t*)(F.ws + WS_K), (bf16_t*)(F.ws + WS_V), (bf16_t*)(F.ws + WS_QI), (bf16_t*)(F.ws + WS_KI), (float*)(F.ws + WS_WI), args.in[I_QG], args.in[I_KG]}))); } SEAM(L1_G1);
    if (IN(L1_ATTN)) { attn_phase(F, args); REPB(L1_ATTN, attn_phase(F, args)); } SEAM(L1_ATTN);
    if (IN(L1_G2)) { if (fuseR) GEMM_STATIC((bf16_t*)(F.ws + WS_O), WAO, DM, DM, pg8::EpiResNormRouter, FUSED_RT(3, MODP(1, 2), 1, 0, 0, F.HB, 0)); else GEMM_STATIC((bf16_t*)(F.ws + WS_O), WAO, DM, DM, pg8::EpiRes, ({F.out, MODP(1, 2), F.out, 1.0f})); } SEAM(L1_G2);
    if (!fuseR) { if (IN(L1_NORMR)) { thin_phase<4 | 8>(F, args, F.out, 1, 1, 0, 0); } SEAM(L1_NORMR); }
    if (IN(L1_M1)) { pg8::Gemm g{F.HB, WMG, M, 2 * FF, DM, (size_t)2 * FF * DM * 2, (const int*)(F.ws + WS_ROWIDX), (const unsigned*)(F.ctl + CW_CNT)}; pg8::MoeOrder S; S.init((const unsigned*)(F.ctl + CW_CNT), 22, F.G, cid);
        EPAIR8L1 E{F.ACT, FF}; pg8::gemm_phase<EPAIR8L1, pg8::MoeOrder, true, false>(ring, g, S, E, F.wave); REPB(L1_M1, pg8::gemm_phase<EPAIR8L1, pg8::MoeOrder, true, false>(ring, g, S, E, F.wave)); } SEAM(L1_M1);
    if (IN(L1_M2)) { pg8::Gemm g{F.ACT, WMD, M, DM, FF, (size_t)DM * FF * M2_B, nullptr, nullptr}; pg8::MoeOrder S; S.init((const unsigned*)(F.ctl + CW_CNT), 4, F.G, cid);
        pg8::EpiMoeDn E{F.BUF, (const float*)(F.ws + WS_GATEP)}; pg8::gemm_phase<pg8::EpiMoeDn, pg8::MoeOrder, false, (M2_FP8 != 0)>(ring, g, S, E, F.wave); REPB(L1_M2, pg8::gemm_phase<pg8::EpiMoeDn, pg8::MoeOrder, false, (M2_FP8 != 0)>(ring, g, S, E, F.wave)); } SEAM(L1_M2);
    if (IN(L1_COMB)) { thin_phase<2 | 4>(F, args, F.out, 2, 0, 1, 0); REPB(L1_COMB, thin_phase<2 | 4>(F, args, F.out, 2, 0, -1, 0)); } SEAM(L1_COMB);

    if (IN(L2_SSM)) { ssm_phase(F, args); REPB(L2_SSM, ssm_phase(F, args)); } SEAM(L2_SSM);
    if (IN(L2_G2)) { GEMM_STATIC(F.ACT, WGL, 2048, DM, pg8::EpiGluRes, ({F.out, MODP(2, 2)})); REPB(L2_G2, GEMM_STATIC(F.ACT, WGL, 2048, DM, pg8::EpiGluRes, ({F.out, ZEROG}))); } SEAM(L2_G2);
    if (IN(L2_NORM)) { thin_phase<4>(F, args, F.out, 2, 1, 0, 0); REPB(L2_NORM, thin_phase<4>(F, args, F.out, 2, 1, 0, 0)); } SEAM(L2_NORM);
    if (IN(L2_F1)) { GEMM_STATIC(F.HB, WFG + (size_t)2 * FF * DM, 2 * FF, DM, EPAIRF, ({F.ACT, FF})); REPB(L2_F1, GEMM_STATIC(F.HB, WFG + (size_t)2 * FF * DM, 2 * FF, DM, EPAIRF, ({F.ACT, FF}))); } SEAM(L2_F1);
    if (IN(L2_F2)) { if (fuse) GEMM_STATICF(F.ACT, W8(WFD, (size_t)DM * FF * (F2_FP8 ? 1 : 2)), DM, FF, pg8::EpiResNorm, FUSED_EPI(2, MODP(2, 5), F.out, 3, 0, F.HB, F2_ASC)); else GEMM_STATICF(F.ACT, W8(WFD, (size_t)DM * FF * (F2_FP8 ? 1 : 2)), DM, FF, pg8::EpiRes, ({F.out, MODP(2, 5), F.out, F2_ASC})); } SEAM(L2_F2);
    if (!fuse) { if (IN(L2_NORMN)) { thin_phase<4>(F, args, F.out, 3, 0, 0, 0); } SEAM(L2_NORMN); }

    if (IN(L3_G1)) { GEMM_STATIC(F.HB, WCI + (size_t)3072 * DM, 3072, DM, pg8::EpiConvIn, {F.BUF}); REPB(L3_G1, GEMM_STATIC(F.HB, WCI + (size_t)3072 * DM, 3072, DM, pg8::EpiConvIn, {F.BUF})); } SEAM(L3_G1);
    if (IN(L3_CONV)) { conv_phase(F, args.in[I_CW] + 3 * DM); REPB(L3_CONV, conv_phase(F, args.in[I_CW] + 3 * DM)); } SEAM(L3_CONV);
    if (IN(L3_G2)) { if (fuseR) GEMM_STATIC(F.HB, WCO + (size_t)DM * DM, DM, DM, pg8::EpiResNormRouter, FUSED_RT(4, MODP(3, 2), 3, 1, 2 * MiB, F.BUF, M1_FP8)); else GEMM_STATIC(F.HB, WCO + (size_t)DM * DM, DM, DM, pg8::EpiRes, ({F.out, MODP(3, 2), F.out, 1.0f})); } SEAM(L3_G2);
    if (!fuseR) { if (IN(L3_NORMR)) { thin_phase<4 | 8>(F, args, F.out, 3, 1, 0, 1, 1, 2 * MiB); } SEAM(L3_NORMR); }
    if (IN(L3_M1)) { pg8::Gemm g{(fuseR ? F.BUF : F.HB), W8(WMG, (size_t)8 * 2 * FF * DM * 2), M, 2 * FF, DM, (size_t)2 * FF * DM * M1_B, (const int*)(F.ws + 2 * MiB + WS_ROWIDX), (const unsigned*)(F.ctl + CW_CNT + 512)}; pg8::MoeOrder S; S.init((const unsigned*)(F.ctl + CW_CNT + 512), 22, F.G, cid);
        EPAIR8 E{F.ACT, FF}; pg8::gemm_phase<EPAIR8, pg8::MoeOrder, true, (M1_FP8 != 0)>(ring, g, S, E, F.wave); REPB(L3_M1, pg8::gemm_phase<EPAIR8, pg8::MoeOrder, true, (M1_FP8 != 0)>(ring, g, S, E, F.wave)); } SEAM(L3_M1);
    if (IN(L3_M2)) { pg8::Gemm g{F.ACT, W8(WMD, (size_t)8 * DM * FF * M2_B), M, DM, FF, (size_t)DM * FF * M2_B, nullptr, nullptr}; pg8::MoeOrder S; S.init((const unsigned*)(F.ctl + CW_CNT + 512), 4, F.G, cid);
        pg8::EpiMoeDn E{F.BUF, (const float*)(F.ws + 2 * MiB + WS_GATEP)}; pg8::gemm_phase<pg8::EpiMoeDn, pg8::MoeOrder, false, (M2_FP8 != 0)>(ring, g, S, E, F.wave); REPB(L3_M2, pg8::gemm_phase<pg8::EpiMoeDn, pg8::MoeOrder, false, (M2_FP8 != 0)>(ring, g, S, E, F.wave)); } SEAM(L3_M2);
    if (IN(L3_COMB)) { thin_phase<2>(F, args, F.out, 0, 0, 3, 1, 1, 2 * MiB); }
#undef IN
#undef SEAM
}

extern "C" void kernel_launch(void* const* d_in, const int* in_sizes, int n_in, void* d_out, int out_size, void* d_ws, size_t ws_size, hipStream_t stream) {
    static int grid = 0;
    if (grid == 0) {
        if (n_in != 28 || in_sizes[0] != M * DM || out_size != M * DM || ws_size < WS_END) { fprintf(stderr, "kernel_launch: unexpected shapes / workspace (n_in %d, ws %zu, need %zu)\n", n_in, ws_size, (size_t)WS_END); grid = -1; return; }
        int dev = 0, cus = 0, per_cu = 0;
        if (hipGetDevice(&dev) != hipSuccess || hipDeviceGetAttribute(&cus, hipDeviceAttributeMultiprocessorCount, dev) != hipSuccess) { grid = -1; return; }
        if (hipFuncSetAttribute((const void*)mega_fwd, hipFuncAttributeMaxDynamicSharedMemorySize, LDS_BYTES) != hipSuccess) { fprintf(stderr, "kernel_launch: hipFuncSetAttribute failed\n"); grid = -1; return; }
        if (hipOccupancyMaxActiveBlocksPerMultiprocessor(&per_cu, (const void*)mega_fwd, NTHREADS, LDS_BYTES) != hipSuccess || per_cu < 1) fprintf(stderr, "kernel_launch: occupancy query reports %d\n", per_cu);
        (void)hipGetLastError();
        grid = cus;
    }
    if (grid < 0) return;
    (void)hipMemsetAsync((char*)d_ws + WS_CTL, 0, CTL_ZERO_BYTES, stream);
    Args a{};
    for (int i = 0; i < 28; ++i) a.in[i] = (const float*)d_in[i];
    a.out = (float*)d_out; a.ws = (unsigned char*)d_ws;
#if MK_PER_PHASE
    for (int p = 0; p < NPH; ++p) { a.ph_lo = p; a.ph_hi = p + 1; hipLaunchKernelGGL(mega_fwd, dim3(grid), dim3(NTHREADS), LDS_BYTES, stream, a); }
#else
    a.ph_lo = 0; a.ph_hi = NPH; hipLaunchKernelGGL(mega_fwd, dim3(grid), dim3(NTHREADS), LDS_BYTES, stream, a);
#endif
}
```

```cpp
#include <hip/hip_runtime.h>
#include <cstdio>
#include <cstdint>
#include <cmath>

#ifndef MK_PER_PHASE
#define MK_PER_PHASE 0
#endif

#define GAS __attribute__((address_space(1)))
#define LAS __attribute__((address_space(3)))
typedef unsigned short bf16_t;
typedef short bf16x8 __attribute__((ext_vector_type(8)));
typedef float f32x4 __attribute__((ext_vector_type(4)));
typedef float f32x2 __attribute__((ext_vector_type(2)));
typedef float f32x16 __attribute__((ext_vector_type(16)));
typedef unsigned u32x4 __attribute__((ext_vector_type(4)));
typedef unsigned u32x2 __attribute__((ext_vector_type(2)));
typedef GAS unsigned gu32;
#define RLX_AGENT __ATOMIC_RELAXED, __HIP_MEMORY_SCOPE_AGENT
#define LDS_WAIT() asm volatile("s_waitcnt lgkmcnt(0)" ::: "memory")
#define VM_WAIT() asm volatile("s_waitcnt vmcnt(0)" ::: "memory")
#define CFENCE() asm volatile("" ::: "memory")

constexpr int DM = 1024, NB = 4, SEQ = 4096, M = NB * SEQ, FF = 2816, NEXP = 8;
constexpr int NH = 16, NKV = 4, HD = 64, IH = 8, IDIM = 64, TOPK = 256;
constexpr int ATT_N = 2120, ATT_NP = 2304;
constexpr float EPS = 1e-6f;
constexpr int NWAVES = 8, NTHREADS = 512;

__device__ __forceinline__ unsigned f2bf(float f) { unsigned u = __builtin_bit_cast(unsigned, f); return (u + 0x7fffu + ((u >> 16) & 1u)) >> 16; }
__device__ __forceinline__ unsigned pk2(float lo, float hi) { return f2bf(lo) | (f2bf(hi) << 16); }
__device__ __forceinline__ unsigned cvt_pk_bf16(float lo, float hi) { unsigned r; asm volatile("v_cvt_pk_bf16_f32 %0, %1, %2" : "=v"(r) : "v"(lo), "v"(hi)); return r; }
__device__ __forceinline__ float bflo(unsigned u) { return __uint_as_float(u << 16); }
__device__ __forceinline__ float bfhi(unsigned u) { return __uint_as_float(u & 0xffff0000u); }
__device__ __forceinline__ float wave_sum(float v) {
#pragma unroll
    for (int o = 1; o < 64; o <<= 1) v += __shfl_xor(v, o);
    return v;
}
__device__ __forceinline__ float fast_rcp(float x) { return __builtin_amdgcn_rcpf(x); }
__device__ __forceinline__ float silu_f(float g) { return g * fast_rcp(1.f + __expf(-g)); }
__device__ __forceinline__ float sigmoid_f(float g) { return fast_rcp(1.f + __expf(-g)); }
__device__ __forceinline__ float gelu_tanh_f(float y) { const float z = 0.7978845608028654f * (y + 0.044715f * y * y * y); const float t = 1.f - 2.f * fast_rcp(__expf(2.f * z) + 1.f); return 0.5f * y * (1.f + t); }

constexpr size_t WS_ROWIDX_B = 2u << 20, WS_GATEP_B = (2u << 20) + 512 * 1024, WS_SLOT_B = 3u << 20;
__device__ __forceinline__ int lane_id_fresh() { int l; asm volatile("v_mbcnt_lo_u32_b32 %0, -1, 0\n\tv_mbcnt_hi_u32_b32 %0, -1, %0" : "=v"(l)); return l; }
#ifndef FUSE_R
#define FUSE_R 1
#endif
#ifndef FUSE_N
#define FUSE_N 1
#endif
#ifndef M2_FP8
#define M2_FP8 1
#endif
#ifndef M1L1_FP8
#define M1L1_FP8 1
#endif
#ifndef M1_FP8
#define M1_FP8 1
#endif
#ifndef F2L0_FP8
#define F2L0_FP8 1
#endif
#ifndef F2_FP8
#define F2_FP8 1
#endif
namespace pg8 {
constexpr int BM = 256, BK = 64, HALF = 128, HTB = HALF * BK * 2, STAGE_BYTES = 8 * HTB, NXCD = 8, WGM = 8;
__host__ __device__ __forceinline__ int lds_byte(int r, int c) { const int st = (r >> 4) * 2 + (c >> 5), rr = r & 15, cc = c & 31, ob = rr * 64 + cc * 2; return st * 1024 + (ob ^ (((ob >> 9) & 1) << 5)); }
__host__ __device__ __forceinline__ void stage_rc(int b, int& R, int& C) { const int st = b / 1024, sb = b % 1024, swz = sb ^ (((sb >> 9) & 1) << 5); R = (st >> 1) * 16 + swz / 64; C = (st & 1) * 32 + (swz % 64) / 2; }
__host__ __device__ __forceinline__ int perm32(int rho) { const int n = rho >> 4, i = rho & 15; return 8 * (i >> 2) + 4 * n + (i & 3); }

struct Unit { int pm, pn, e, aux; };
struct Gemm { const bf16_t* A; const bf16_t* Bt; int M, N, K; size_t bstride_e; const int* rowidx; const unsigned* cnt; };

struct StaticOrder {
    int nM, nN, nwg, G, c;
    __device__ __forceinline__ void init(int M_, int N_, int G_, int c_) { nM = M_ / BM; nN = N_ / BM; nwg = nM * nN; G = G_; c = c_; }
    __device__ __forceinline__ bool next(int i, Unit& u) const {
        const long L = (long)i * G + c; if (L >= nwg) return false;
        int wgid = (int)L; { const int q = nwg / NXCD, r = nwg % NXCD, xcd = wgid % NXCD, off = wgid / NXCD; wgid = (xcd < r ? xcd * (q + 1) : r * (q + 1) + (xcd - r) * q) + off; }
        const int nig = WGM * nN, gid = wgid / nig, fm = gid * WGM, gsz = (nM - fm) < WGM ? (nM - fm) : WGM;
        u.pm = fm + ((wgid % nig) % gsz); u.pn = (wgid % nig) / gsz; u.e = 0; u.aux = 0; return true;
    }
};
struct MoeOrder {
    int T1, T2, T3, T4, T5, T6, T7, T8, NT, W, r, lo, ntl;
    static constexpr int RG = 4;
    __device__ __forceinline__ void init(const unsigned* cnt, int NT_, int G_, int c_) {
        int t[9]; int acc = 0;
#pragma unroll
        for (int e = 0; e < 8; ++e) { t[e] = acc; acc += (int)((__hip_atomic_load(cnt + 64 * e, RLX_AGENT) + 255u) >> 8); }
        t[8] = acc; T1 = t[1]; T2 = t[2]; T3 = t[3]; T4 = t[4]; T5 = t[5]; T6 = t[6]; T7 = t[7]; T8 = t[8]; NT = NT_;
        if (G_ % 8 == 0) { const int xv = c_ % 8; W = G_ / 8; r = c_ / 8; lo = (T8 * xv) / 8; ntl = (T8 * (xv + 1)) / 8 - lo; }
        else { W = G_; r = c_; lo = 0; ntl = T8; }
    }
    __device__ __forceinline__ bool next(int i, Unit& u) const {
        const int q = i * W + r; if (q >= ntl * NT) return false;
        const int nig = RG * NT, gid = q / nig, fm = gid * RG, gsz = (ntl - fm) < RG ? (ntl - fm) : RG, w = q - gid * nig;
        const int tt = lo + fm + (w % gsz), pn = w / gsz;
        int e = 0, te = 0;
        if (tt >= T1) { e = 1; te = T1; } if (tt >= T2) { e = 2; te = T2; } if (tt >= T3) { e = 3; te = T3; } if (tt >= T4) { e = 4; te = T4; }
        if (tt >= T5) { e = 5; te = T5; } if (tt >= T6) { e = 6; te = T6; } if (tt >= T7) { e = 7; te = T7; }
        u.pm = tt; u.pn = pn; u.e = e; u.aux = e * 16384 + 256 * (tt - te); return true;
    }
};

typedef int v8i32 __attribute__((ext_vector_type(8)));
typedef int v4i32 __attribute__((ext_vector_type(4)));
constexpr float W8_MUL = 32.0f, W8_INV = 1.0f / 32.0f;
__device__ __forceinline__ void mfma8(f32x4& c, const v8i32 a, const v8i32 b) { asm volatile("v_mfma_f32_16x16x128_f8f6f4 %0, %1, %2, %0" : "+v"(c) : "v"(a), "v"(b)); }
__device__ __forceinline__ v8i32 cat8(const bf16x8 a, const bf16x8 b) { return __builtin_shufflevector(__builtin_bit_cast(v4i32, a), __builtin_bit_cast(v4i32, b), 0, 1, 2, 3, 4, 5, 6, 7); }
template <class Epi, class Sched, bool GATHER, bool FP8 = false>
__device__ __forceinline__ void gemm_phase(LAS unsigned char* lds, const Gemm g, const Sched& S, const Epi& E, const int wid) {
    const int lane = lane_id_fresh(), tid = wid * 64 + lane, wr = wid >> 2, wc = wid & 3, fr = lane & 15, fq = lane >> 4;
    const int K = FP8 ? g.K / 2 : g.K, nt = K / BK;
    unsigned voffB[2]; int stR[2], stC[2];
#pragma unroll
    for (int i = 0; i < 2; ++i) { int R, C; stage_rc(tid * 16 + i * 8192, R, C); const int Rb = (R & ~31) + perm32(R & 31);
        stR[i] = R; stC[i] = C; voffB[i] = (unsigned)(Rb * K + C) * 2u; }
    const size_t kstep = (size_t)(BK * 2);
    const size_t hstep = (size_t)HALF * K * 2;
    const size_t tstep = 2 * hstep;
    const unsigned ldsw = (unsigned)wid * 1024u;
    const int aoff = lds_byte(wr * 64 + fr, fq * 8), boff = lds_byte(wc * 32 + fr, fq * 8);
#define PG8_SA(b, h) (((b) * 2 + (h)) * HTB)
#define PG8_SB(b, h) ((4 + (b) * 2 + (h)) * HTB)
#define PG8_STAGE(bufoff, gbase, voff) do { _Pragma("unroll") for (int _i = 0; _i < 2; ++_i) \
        __builtin_amdgcn_global_load_lds((const unsigned*)((const char*)(gbase) + (voff)[_i]), (LAS unsigned*)(lds + (bufoff) + ldsw + _i * 8192), 16, 0, 0); } while (0)
#define PG8_LDA(dst, b, h) do { _Pragma("unroll") for (int m = 0; m < 4; ++m) _Pragma("unroll") for (int k = 0; k < 2; ++k) dst[m][k] = *(const LAS bf16x8*)(lds + PG8_SA(b, h) + aoff + m * 2048 + k * 1024); } while (0)
#define PG8_LDB(dst, b, h) do { _Pragma("unroll") for (int n = 0; n < 2; ++n) _Pragma("unroll") for (int k = 0; k < 2; ++k) dst[n][k] = *(const LAS bf16x8*)(lds + PG8_SB(b, h) + boff + n * 2048 + k * 1024); } while (0)
#define PG8_MMA(ai, bj, At, Bt) do { __builtin_amdgcn_s_setprio(1); _Pragma("unroll") for (int m = 0; m < 4; ++m) _Pragma("unroll") for (int n = 0; n < 2; ++n) { \
        if (FP8) mfma8(acc[ai][bj][m][n], cat8(Bt[n][0], Bt[n][1]), cat8(At[m][0], At[m][1])); \
        else { _Pragma("unroll") for (int k = 0; k < 2; ++k) acc[ai][bj][m][n] = __builtin_amdgcn_mfma_f32_16x16x32_bf16(Bt[n][k], At[m][k], acc[ai][bj][m][n], 0, 0, 0); } } \
        __builtin_amdgcn_s_setprio(0); } while (0)
#define PG8_MMA_END(At, B0, B1) do { if (FP8) { asm volatile("s_nop 15\n\ts_nop 15\n\ts_nop 15\n\ts_nop 15" :: "v"(cat8(At[0][0], At[0][1])), "v"(cat8(At[1][0], At[1][1])), "v"(cat8(At[2][0], At[2][1])), "v"(cat8(At[3][0], At[3][1])), \
        "v"(cat8(B0[0][0], B0[0][1])), "v"(cat8(B0[1][0], B0[1][1])), "v"(cat8(B1[0][0], B1[0][1])), "v"(cat8(B1[1][0], B1[1][1]))); } } while (0)
#define PG8_WAIT_V(n) asm volatile("s_waitcnt vmcnt(" #n ")" ::: "memory")
#define PG8_WAIT_L(n) asm volatile("s_waitcnt lgkmcnt(" #n ")" ::: "memory")
#define PG8_BAR __builtin_amdgcn_s_barrier()
#define PG8_SCHED __builtin_amdgcn_sched_barrier(0)
#define PG8_AOFFS(v, U) do { _Pragma("unroll") for (int _h = 0; _h < 2; ++_h) _Pragma("unroll") for (int _i = 0; _i < 2; ++_i) { \
        if (GATHER) { const int _loc = ((U).aux & 16383) + _h * HALF + stR[_i]; const int _e = (U).aux >> 14; \
            const int _row = (_loc < (int)g.cnt[64 * _e]) ? g.rowidx[(U).aux + _h * HALF + stR[_i]] : 0; \
            v[_h][_i] = (unsigned)(_row * K + stC[_i]) * 2u; } \
        else v[_h][_i] = (unsigned)((_h * HALF + stR[_i]) * K + stC[_i]) * 2u; } } while (0)
    int cn8[8];
#pragma unroll
    for (int e = 0; e < 8; ++e) cn8[e] = GATHER ? __builtin_amdgcn_readfirstlane((int)g.cnt[64 * e]) : 0;
    Unit cur, nxt; int ui = 0;
    if (!S.next(0, cur)) return;
    f32x4 acc[2][2][4][2];
#pragma unroll
    for (int a = 0; a < 2; ++a)
#pragma unroll
        for (int b = 0; b < 2; ++b)
#pragma unroll
            for (int m = 0; m < 4; ++m)
#pragma unroll
                for (int n = 0; n < 2; ++n) acc[a][b][m][n] = (f32x4){0.f, 0.f, 0.f, 0.f};
    bf16x8 At[4][2], B0[2][2], B1[2][2];
    unsigned vAc[2][2], vAn[2][2];
    PG8_AOFFS(vAc, cur);
    const char* cA = (const char*)g.A + (GATHER ? (size_t)0 : (size_t)cur.pm * tstep);
    const char* cB = (const char*)g.Bt + (size_t)cur.e * g.bstride_e + (size_t)cur.pn * tstep;
    PG8_STAGE(PG8_SB(0, 0), cB, voffB); PG8_STAGE(PG8_SB(0, 1), cB + hstep, voffB); PG8_STAGE(PG8_SA(0, 0), cA, vAc[0]); PG8_STAGE(PG8_SA(0, 1), cA, vAc[1]);
    if (wr == 1) PG8_BAR;
    PG8_WAIT_V(2); PG8_BAR;
    PG8_STAGE(PG8_SB(1, 0), cB + kstep, voffB); PG8_STAGE(PG8_SA(1, 0), cA + kstep, vAc[0]); PG8_STAGE(PG8_SB(1, 1), cB + hstep + kstep, voffB);
    PG8_WAIT_V(6); PG8_BAR;
    for (;;) {
        const bool has_next = S.next(ui + 1, nxt);
        const char* nA = cA; const char* nB = cB;
        int rn[2][2];
        if (has_next) { if (GATHER) {
#pragma unroll
                for (int h = 0; h < 2; ++h)
#pragma unroll
                    for (int i = 0; i < 2; ++i) rn[h][i] = g.rowidx[nxt.aux + h * HALF + stR[i]]; }
            else PG8_AOFFS(vAn, nxt);
            nA = (const char*)g.A + (GATHER ? (size_t)0 : (size_t)nxt.pm * tstep); nB = (const char*)g.Bt + (size_t)nxt.e * g.bstride_e + (size_t)nxt.pn * tstep; }
        else {
#pragma unroll
            for (int h = 0; h < 2; ++h)
#pragma unroll
                for (int i = 0; i < 2; ++i) vAn[h][i] = vAc[h][i];
        }
#pragma nounroll
        for (int t = 0; t < nt; t += 2) {
            const bool last = (t == nt - 2);
            const char* a1 = cA + (size_t)(t + 1) * kstep;
            const char* a2 = last ? nA : cA + (size_t)(t + 2) * kstep; const char* b2 = last ? nB : cB + (size_t)(t + 2) * kstep;
            const char* a3 = a2 + kstep; const char* b3 = b2 + kstep;
            if (GATHER && last && has_next) { const int _e = nxt.aux >> 14;
                const int _cn = _e == 0 ? cn8[0] : _e == 1 ? cn8[1] : _e == 2 ? cn8[2] : _e == 3 ? cn8[3] : _e == 4 ? cn8[4] : _e == 5 ? cn8[5] : _e == 6 ? cn8[6] : cn8[7];
#pragma unroll
                for (int h = 0; h < 2; ++h)
#pragma unroll
                    for (int i = 0; i < 2; ++i) { int r_ = rn[h][i]; asm volatile("" : "+v"(r_)); const int _loc = (nxt.aux & 16383) + h * HALF + stR[i];
                        r_ = _loc < _cn ? r_ : 0; vAn[h][i] = (unsigned)(r_ * K + stC[i]) * 2u; } }
            unsigned v2[2][2];
#pragma unroll
            for (int h = 0; h < 2; ++h)
#pragma unroll
                for (int i = 0; i < 2; ++i) v2[h][i] = last ? vAn[h][i] : vAc[h][i];
            PG8_LDB(B0, 0, 0); PG8_LDB(B1, 0, 1); PG8_SCHED; PG8_LDA(At, 0, 0); PG8_STAGE(PG8_SA(1, 1), a1, vAc[1]);
            PG8_WAIT_V(8); PG8_WAIT_L(0); PG8_BAR; PG8_MMA(0, 0, At, B0); PG8_MMA(0, 1, At, B1); PG8_MMA_END(At, B0, B1); PG8_BAR; PG8_SCHED;
            PG8_LDA(At, 0, 1); PG8_STAGE(PG8_SB(0, 0), b2, voffB); PG8_STAGE(PG8_SB(0, 1), b2 + hstep, voffB); PG8_STAGE(PG8_SA(0, 0), a2, v2[0]);
            PG8_WAIT_V(8); PG8_WAIT_L(0); PG8_BAR; PG8_MMA(1, 0, At, B0); PG8_MMA(1, 1, At, B1); PG8_MMA_END(At, B0, B1); PG8_BAR; PG8_SCHED;
            PG8_LDB(B0, 1, 0); PG8_LDB(B1, 1, 1); PG8_SCHED; PG8_LDA(At, 1, 0); PG8_STAGE(PG8_SA(0, 1), a2, v2[1]);
            PG8_WAIT_V(8); PG8_WAIT_L(0); PG8_BAR; PG8_MMA(0, 0, At, B0); PG8_MMA(0, 1, At, B1); PG8_MMA_END(At, B0, B1); PG8_BAR; PG8_SCHED;
            PG8_LDA(At, 1, 1); PG8_STAGE(PG8_SB(1, 0), b3, voffB); PG8_STAGE(PG8_SB(1, 1), b3 + hstep, voffB); PG8_STAGE(PG8_SA(1, 0), a3, v2[0]);
            PG8_WAIT_V(8); PG8_WAIT_L(0); PG8_BAR; PG8_MMA(1, 0, At, B0); PG8_MMA(1, 1, At, B1); PG8_MMA_END(At, B0, B1); PG8_BAR; PG8_SCHED;
        }
        if (wr == 0) PG8_BAR;
        if (FP8) asm volatile("s_nop 15\n\ts_nop 15\n\ts_nop 15\n\ts_nop 15\n\ts_nop 15\n\ts_nop 15" ::: "memory");
        if constexpr (!Epi::FUSED) E(acc, cur, wr, wc, fr, fq);
        if (!has_next) break;
#pragma unroll
        for (int a = 0; a < 2; ++a)
#pragma unroll
            for (int b = 0; b < 2; ++b)
#pragma unroll
                for (int m = 0; m < 4; ++m)
#pragma unroll
                    for (int n = 0; n < 2; ++n) acc[a][b][m][n] = (f32x4){0.f, 0.f, 0.f, 0.f};
        cur = nxt; cA = nA; cB = nB; ++ui;
#pragma unroll
        for (int h = 0; h < 2; ++h)
#pragma unroll
            for (int i = 0; i < 2; ++i) vAc[h][i] = vAn[h][i];
        if (wr == 1) PG8_BAR;
    }
    PG8_WAIT_V(0);
    PG8_BAR;
    if constexpr (Epi::FUSED) E.fused(acc, cur, wr, wc, fr, fq, lds, wid, lane);
#undef PG8_SA
#undef PG8_SB
#undef PG8_STAGE
#undef PG8_LDA
#undef PG8_LDB
#undef PG8_MMA
#undef PG8_MMA_END
#undef PG8_WAIT_V
#undef PG8_WAIT_L
#undef PG8_BAR
#undef PG8_SCHED
#undef PG8_AOFFS
}

__device__ __forceinline__ f32x4 ldx16(const float* p) { const GAS unsigned long long* q = (const GAS unsigned long long*)p; const unsigned long long a = __hip_atomic_load(q, RLX_AGENT), c = __hip_atomic_load(q + 1, RLX_AGENT);
    return (f32x4){__uint_as_float((unsigned)a), __uint_as_float((unsigned)(a >> 32)), __uint_as_float((unsigned)c), __uint_as_float((unsigned)(c >> 32))}; }
typedef f32x4 Acc[2][2][4][2];
__device__ __forceinline__ u32x4 pack8(const f32x4 a, const f32x4 b) { u32x4 w; w.x = cvt_pk_bf16(a[0], a[1]); w.y = cvt_pk_bf16(a[2], a[3]); w.z = cvt_pk_bf16(b[0], b[1]); w.w = cvt_pk_bf16(b[2], b[3]); return w; }

template <int MODE, bool OUT8 = false, bool SC8 = OUT8> struct EpiPair {
    static constexpr bool FUSED = false;
    bf16_t* O; int ldo;
    __device__ __forceinline__ void operator()(const Acc& acc, const Unit& u, int wr, int wc, int fr, int fq) const {
        const int row0 = u.pm * BM + wr * 64 + fr, col0 = u.pn * HALF + wc * 32 + 8 * fq;
#pragma unroll
        for (int ai = 0; ai < 2; ++ai)
#pragma unroll
            for (int m = 0; m < 4; ++m) { f32x4 r0, r1;
#pragma unroll
                for (int e = 0; e < 4; ++e) { const float sc8 = SC8 ? W8_INV : 1.0f; const float a0 = acc[ai][0][m][0][e] * sc8, a1 = acc[ai][0][m][1][e] * sc8, b0 = acc[ai][1][m][0][e] * sc8, b1 = acc[ai][1][m][1][e] * sc8;
                    r0[e] = (MODE == 1 ? silu_f(a0) : a0) * b0; r1[e] = (MODE == 1 ? silu_f(a1) : a1) * b1; }
                if (OUT8) { u32x2 w; int t0 = 0, t1 = 0; t0 = __builtin_amdgcn_cvt_pk_fp8_f32(r0[0], r0[1], t0, false); t0 = __builtin_amdgcn_cvt_pk_fp8_f32(r0[2], r0[3], t0, true);
                    t1 = __builtin_amdgcn_cvt_pk_fp8_f32(r1[0], r1[1], t1, false); t1 = __builtin_amdgcn_cvt_pk_fp8_f32(r1[2], r1[3], t1, true); w.x = (unsigned)t0; w.y = (unsigned)t1;
                    *(u32x2*)((unsigned char*)O + (size_t)(row0 + ai * HALF + m * 16) * ldo + col0) = w; }
                else *(u32x4*)(O + (size_t)(row0 + ai * HALF + m * 16) * ldo + col0) = pack8(r0, r1); }
    }
};
struct EpiConvIn {
    static constexpr bool FUSED = false;
    bf16_t* UB;
    __device__ __forceinline__ void operator()(const Acc& acc, const Unit& u, int wr, int wc, int fr, int fq) const {
        const int row0 = u.pm * BM + wr * 64 + fr;
        if (u.pn < 8) { EpiPair<0, false, false> P{UB, 2048}; P(acc, u, wr, wc, fr, fq); }
        else { const int col0 = 1024 + (u.pn - 8) * BM + wc * 32 + 8 * fq;
#pragma unroll
            for (int ai = 0; ai < 2; ++ai)
#pragma unroll
                for (int m = 0; m < 4; ++m)
#pragma unroll
                    for (int bj = 0; bj < 2; ++bj) *(u32x4*)(UB + (size_t)(row0 + ai * HALF + m * 16) * 2048 + col0 + bj * HALF) = pack8(acc[ai][bj][m][0], acc[ai][bj][m][1]); }
    }
};
struct EpiRes {
    static constexpr bool FUSED = false;
    float* X; const float* gate; const float* Xin; float asc;
    __device__ __forceinline__ void operator()(const Acc& acc, const Unit& u, int wr, int wc, int fr, int fq) const {
        const int row0 = u.pm * BM + wr * 64 + fr, col0 = u.pn * BM + wc * 32 + 8 * fq; const int b = (u.pm * BM) / SEQ;
        f32x4 gv[2][2];
#pragma unroll
        for (int bj = 0; bj < 2; ++bj)
#pragma unroll
            for (int n = 0; n < 2; ++n) gv[bj][n] = *(const f32x4*)(gate + (size_t)b * 6144 + col0 + bj * HALF + 4 * n) * asc;
#pragma unroll
        for (int ai = 0; ai < 2; ++ai) {
            f32x4 xv[4][2][2];
#pragma unroll
            for (int m = 0; m < 4; ++m) { const float* ri = Xin + (size_t)(row0 + ai * HALF + m * 16) * DM + col0;
#pragma unroll
                for (int bj = 0; bj < 2; ++bj)
#pragma unroll
                    for (int n = 0; n < 2; ++n) xv[m][bj][n] = ldx16(ri + bj * HALF + 4 * n); }
            asm volatile("" ::: "memory");
#pragma unroll
            for (int m = 0; m < 4; ++m) { float* rp = X + (size_t)(row0 + ai * HALF + m * 16) * DM + col0;
#pragma unroll
                for (int bj = 0; bj < 2; ++bj)
#pragma unroll
                    for (int n = 0; n < 2; ++n) *(f32x4*)(rp + bj * HALF + 4 * n) = xv[m][bj][n] + gv[bj][n] * acc[ai][bj][m][n]; }
            asm volatile("" ::: "memory");
        }
    }
};
struct EpiResNorm {
    static constexpr bool FUSED = true;
    float* X; const float* gate; const float* Xin; const float* ng; const float* shb; bf16_t* H; float* xs; gu32* cnt; gu32* tmo; float asc;
    __device__ __forceinline__ void fused(Acc& acc, const Unit& u, int wr, int wc, int fr, int fq, LAS unsigned char* lds, int wid, int lane) const {
        const int row0 = u.pm * BM + wr * 64 + fr, col0 = u.pn * BM + wc * 32 + 8 * fq; const int b = (u.pm * BM) / SEQ;
        LAS float* P = (LAS float*)lds; LAS float* S = (LAS float*)(lds + 4096);
        { f32x4 gv[2][2];
#pragma unroll
          for (int bj = 0; bj < 2; ++bj)
#pragma unroll
              for (int n = 0; n < 2; ++n) gv[bj][n] = *(const f32x4*)(gate + (size_t)b * 6144 + col0 + bj * HALF + 4 * n) * asc;
#pragma unroll
          for (int ai = 0; ai < 2; ++ai) {
              f32x4 xv[4][2][2];
#pragma unroll
              for (int m = 0; m < 4; ++m) { const float* ri = Xin + (size_t)(row0 + ai * HALF + m * 16) * DM + col0;
#pragma unroll
                  for (int bj = 0; bj < 2; ++bj)
#pragma unroll
                      for (int n = 0; n < 2; ++n) xv[m][bj][n] = ldx16(ri + bj * HALF + 4 * n); }
              asm volatile("" ::: "memory");
#pragma unroll
              for (int m = 0; m < 4; ++m) { float* rp = X + (size_t)(row0 + ai * HALF + m * 16) * DM + col0; float ss = 0.f;
#pragma unroll
                  for (int bj = 0; bj < 2; ++bj)
#pragma unroll
                      for (int n = 0; n < 2; ++n) { const f32x4 x = xv[m][bj][n] + gv[bj][n] * acc[ai][bj][m][n]; acc[ai][bj][m][n] = x; *(f32x4*)(rp + bj * HALF + 4 * n) = x;
                          ss += (x[0] * x[0] + x[1] * x[1]) + (x[2] * x[2] + x[3] * x[3]); }
                  ss += __shfl_xor(ss, 16); ss += __shfl_xor(ss, 32);
                  if (fq == 0) P[(ai * HALF + wr * 64 + m * 16 + fr) * 4 + wc] = ss; }
              asm volatile("" ::: "memory");
          } }
        asm volatile("s_waitcnt lgkmcnt(0)" ::: "memory"); __builtin_amdgcn_s_barrier(); asm volatile("" ::: "memory");
        const int tid = wid * 64 + lane;
        if (tid < 256) { const f32x4 p4 = *(const LAS f32x4*)(P + tid * 4); const float sp = (p4[0] + p4[1]) + (p4[2] + p4[3]);
            __hip_atomic_store((gu32*)xs + ((size_t)(u.pm * BM + tid) * 4 + u.pn), __float_as_uint(sp), RLX_AGENT); }
        asm volatile("s_waitcnt vmcnt(0)" ::: "memory");
        if (wid < 4 && lane == 0) __hip_atomic_fetch_add(cnt + 64 * u.pm, 1u, RLX_AGENT);
        if (wid == 0) { unsigned spins = 0;
            while ((unsigned)__builtin_amdgcn_readfirstlane(__hip_atomic_load(cnt + 64 * u.pm, RLX_AGENT)) < 16u) { __builtin_amdgcn_s_sleep(2);
                if (++spins > (1u << 20)) { if (lane == 0) __hip_atomic_store(tmo, 1u, RLX_AGENT); break; } } }
        asm volatile("s_waitcnt vmcnt(0) lgkmcnt(0)" ::: "memory"); __builtin_amdgcn_s_barrier(); asm volatile("" ::: "memory");
        if (tid < 256) { const GAS unsigned long long* q = (const GAS unsigned long long*)xs + (size_t)(u.pm * BM + tid) * 2;
            const unsigned long long a = __hip_atomic_load(q, RLX_AGENT), c = __hip_atomic_load(q + 1, RLX_AGENT);
            const float tot = (__uint_as_float((unsigned)a) + __uint_as_float((unsigned)(a >> 32))) + (__uint_as_float((unsigned)c) + __uint_as_float((unsigned)(c >> 32)));
            S[tid] = 1.0f / sqrtf(tot * (1.0f / DM) + EPS); }
        asm volatile("s_waitcnt vmcnt(0) lgkmcnt(0)" ::: "memory"); __builtin_amdgcn_s_barrier(); asm volatile("" ::: "memory");
        f32x4 gm[2][2], sf[2][2];
#pragma unroll
        for (int bj = 0; bj < 2; ++bj)
#pragma unroll
            for (int n = 0; n < 2; ++n) { const int c = col0 + bj * HALF + 4 * n; const f32x4 g4 = *(const f32x4*)(ng + c), s1 = *(const f32x4*)(shb + (size_t)b * 6144 + DM + c);
                gm[bj][n] = g4 * (s1 + 1.0f); sf[bj][n] = *(const f32x4*)(shb + (size_t)b * 6144 + c); }
#pragma unroll
        for (int ai = 0; ai < 2; ++ai)
#pragma unroll
            for (int m = 0; m < 4; ++m) { const float r = S[ai * HALF + wr * 64 + m * 16 + fr]; bf16_t* hp = H + (size_t)(row0 + ai * HALF + m * 16) * DM + col0;
#pragma unroll
                for (int bj = 0; bj < 2; ++bj) *(u32x4*)(hp + bj * HALF) = pack8((acc[ai][bj][m][0] * r) * gm[bj][0] + sf[bj][0], (acc[ai][bj][m][1] * r) * gm[bj][1] + sf[bj][1]); }
    }
};
struct EpiResNormRouter {
    static constexpr bool FUSED = true;
    float* X; const float* gate; const float* ng; const float* shb; bf16_t* H; float* xs9; gu32* cnt; gu32* tmo;
    const float* rw; const float* rb; gu32* ecnt; unsigned char* meta; int h8;
    __device__ __forceinline__ void fused(Acc& acc, const Unit& u, int wr, int wc, int fr, int fq, LAS unsigned char* lds, int wid, int lane) const {
        const int row0 = u.pm * BM + wr * 64 + fr, col0 = u.pn * BM + wc * 32 + 8 * fq; const int b = (u.pm * BM) / SEQ; const int tid = wid * 64 + lane;
        LAS float* P9 = (LAS float*)lds; LAS float* RWT = (LAS float*)(lds + 36864); LAS float* S = (LAS float*)(lds + 45056); LAS float* CE = (LAS float*)(lds + 46080);
        LAS int* rE = (LAS int*)(lds + 46144); LAS float* red = (LAS float*)(lds + 47360);
        const float* shp = shb + (size_t)b * 6144;
        for (int i = tid; i < 2048; i += NTHREADS) { const int c = i >> 3, e = i & 7; RWT[e * 256 + c] = rw[(size_t)(u.pn * BM + c) * 8 + e]; }
        { float ce[8]; const float s0 = shp[tid], s1 = shp[tid + 512];
#pragma unroll
          for (int e = 0; e < 8; ++e) ce[e] = wave_sum(s0 * rw[(size_t)tid * 8 + e] + s1 * rw[(size_t)(tid + 512) * 8 + e]);
          if (lane == 0) {
#pragma unroll
              for (int e = 0; e < 8; ++e) red[wid * 8 + e] = ce[e]; } }
        { f32x4 gv[2][2];
#pragma unroll
          for (int bj = 0; bj < 2; ++bj)
#pragma unroll
              for (int n = 0; n < 2; ++n) gv[bj][n] = *(const f32x4*)(gate + (size_t)b * 6144 + col0 + bj * HALF + 4 * n);
#pragma unroll
          for (int ai = 0; ai < 2; ++ai) {
              f32x4 xv[4][2][2];
#pragma unroll
              for (int m = 0; m < 4; ++m) { const float* ri = X + (size_t)(row0 + ai * HALF + m * 16) * DM + col0;
#pragma unroll
                  for (int bj = 0; bj < 2; ++bj)
#pragma unroll
                      for (int n = 0; n < 2; ++n) xv[m][bj][n] = ldx16(ri + bj * HALF + 4 * n); }
              asm volatile("" ::: "memory");
#pragma unroll
              for (int m = 0; m < 4; ++m) { float* rp = X + (size_t)(row0 + ai * HALF + m * 16) * DM + col0; float ss = 0.f;
#pragma unroll
                  for (int bj = 0; bj < 2; ++bj)
#pragma unroll
                      for (int n = 0; n < 2; ++n) { const f32x4 x = xv[m][bj][n] + gv[bj][n] * acc[ai][bj][m][n]; acc[ai][bj][m][n] = x; *(f32x4*)(rp + bj * HALF + 4 * n) = x;
                          ss += (x[0] * x[0] + x[1] * x[1]) + (x[2] * x[2] + x[3] * x[3]); }
                  ss += __shfl_xor(ss, 16); ss += __shfl_xor(ss, 32);
                  if (fq == 0) P9[((ai * HALF + wr * 64 + m * 16 + fr) * 4 + wc) * 9] = ss; }
              asm volatile("" ::: "memory");
          } }
        f32x4 sf[2][2];
#pragma unroll
        for (int bj = 0; bj < 2; ++bj)
#pragma unroll
            for (int n = 0; n < 2; ++n) { const int c = col0 + bj * HALF + 4 * n; const f32x4 gm = *(const f32x4*)(ng + c) * (*(const f32x4*)(shp + DM + c) + 1.0f); sf[bj][n] = *(const f32x4*)(shp + c);
#pragma unroll
                for (int ai = 0; ai < 2; ++ai)
#pragma unroll
                    for (int m = 0; m < 4; ++m) acc[ai][bj][m][n] = acc[ai][bj][m][n] * gm; }
        asm volatile("s_waitcnt lgkmcnt(0)" ::: "memory"); __builtin_amdgcn_s_barrier(); asm volatile("" ::: "memory");
        if (tid < 8) { float c = rb[tid];
#pragma unroll
            for (int w = 0; w < 8; ++w) c += red[w * 8 + tid];
            CE[tid] = c; }
#pragma unroll
        for (int e = 0; e < 8; ++e) { f32x4 rwe[2][2];
#pragma unroll
            for (int bj = 0; bj < 2; ++bj)
#pragma unroll
                for (int n = 0; n < 2; ++n) rwe[bj][n] = *(const LAS f32x4*)(RWT + e * 256 + bj * HALF + wc * 32 + 8 * fq + 4 * n);
#pragma unroll
            for (int ai = 0; ai < 2; ++ai)
#pragma unroll
                for (int m = 0; m < 4; ++m) { float a = 0.f;
#pragma unroll
                    for (int bj = 0; bj < 2; ++bj)
#pragma unroll
                        for (int n = 0; n < 2; ++n) { const f32x4 x = acc[ai][bj][m][n], w4 = rwe[bj][n]; a += (x[0] * w4[0] + x[1] * w4[1]) + (x[2] * w4[2] + x[3] * w4[3]); }
                    a += __shfl_xor(a, 16); a += __shfl_xor(a, 32);
                    if (fq == 0) P9[((ai * HALF + wr * 64 + m * 16 + fr) * 4 + wc) * 9 + 1 + e] = a; } }
        asm volatile("s_waitcnt lgkmcnt(0)" ::: "memory"); __builtin_amdgcn_s_barrier(); asm volatile("" ::: "memory");
        if (tid < 256) { gu32* q = (gu32*)xs9 + ((size_t)(u.pm * BM + tid) * 4 + u.pn) * 9;
#pragma unroll
            for (int k = 0; k < 9; ++k) { const float v = (P9[(tid * 4 + 0) * 9 + k] + P9[(tid * 4 + 1) * 9 + k]) + (P9[(tid * 4 + 2) * 9 + k] + P9[(tid * 4 + 3) * 9 + k]);
                __hip_atomic_store(q + k, __float_as_uint(v), RLX_AGENT); } }
        asm volatile("s_waitcnt vmcnt(0)" ::: "memory");
        if (wid < 4 && lane == 0) __hip_atomic_fetch_add(cnt + 64 * u.pm, 1u, RLX_AGENT);
        if (wid == 0) { unsigned spins = 0;
            while ((unsigned)__builtin_amdgcn_readfirstlane(__hip_atomic_load(cnt + 64 * u.pm, RLX_AGENT)) < 16u) { __builtin_amdgcn_s_sleep(2);
                if (++spins > (1u << 20)) { if (lane == 0) __hip_atomic_store(tmo, 1u, RLX_AGENT); break; } } }
        asm volatile("s_waitcnt vmcnt(0) lgkmcnt(0)" ::: "memory"); __builtin_amdgcn_s_barrier(); asm volatile("" ::: "memory");
        if (tid < 256) { const gu32* q = (const gu32*)xs9 + (size_t)(u.pm * BM + tid) * 36; float tot[9];
#pragma unroll
            for (int k = 0; k < 9; ++k) tot[k] = (__uint_as_float(__hip_atomic_load(q + k, RLX_AGENT)) + __uint_as_float(__hip_atomic_load(q + 9 + k, RLX_AGENT)))
                                               + (__uint_as_float(__hip_atomic_load(q + 18 + k, RLX_AGENT)) + __uint_as_float(__hip_atomic_load(q + 27 + k, RLX_AGENT)));
            const float r = 1.0f / sqrtf(tot[0] * (1.0f / DM) + EPS); S[tid] = r;
            if (wid == u.pn) {
                float lg[8];
#pragma unroll
                for (int e = 0; e < 8; ++e) lg[e] = r * tot[1 + e] + CE[e];
                int e0 = 0; float l0 = lg[0];
#pragma unroll
                for (int e = 1; e < 8; ++e) if (lg[e] > l0) { l0 = lg[e]; e0 = e; }
                int e1 = -1; float l1 = -3.0e38f;
#pragma unroll
                for (int e = 0; e < 8; ++e) if (e != e0 && lg[e] > l1) { l1 = lg[e]; e1 = e; }
                const float g0 = 1.0f / (1.0f + __expf(l1 - l0)), g1 = 1.0f - g0;
                int cmine = 0, r0 = 0, r1 = 0;
#pragma unroll
                for (int e = 0; e < 8; ++e) { const unsigned long long m0 = __ballot(e0 == e), m1 = __ballot(e1 == e);
                    const int below = (int)__builtin_amdgcn_mbcnt_hi((unsigned)(m0 >> 32), __builtin_amdgcn_mbcnt_lo((unsigned)m0, 0u)) + (int)__builtin_amdgcn_mbcnt_hi((unsigned)(m1 >> 32), __builtin_amdgcn_mbcnt_lo((unsigned)m1, 0u));
                    if (e0 == e) r0 = below; if (e1 == e) r1 = below; if (lane == e) cmine = __popcll(m0) + __popcll(m1); }
                unsigned base = 0u; if (lane < 8 && cmine) base = __hip_atomic_fetch_add(ecnt + 64 * lane, (unsigned)cmine, RLX_AGENT);
                const int p0 = (int)__shfl(base, e0) + r0, p1 = (int)__shfl(base, e1) + r1, grow = u.pm * BM + 64 * u.pn + lane;
                gu32* ri = (gu32*)(meta + WS_ROWIDX_B); gu32* gp = (gu32*)(meta + WS_GATEP_B); gu32* sl = (gu32*)(meta + WS_SLOT_B);
                __hip_atomic_store(ri + e0 * 16384 + p0, (unsigned)grow, RLX_AGENT); __hip_atomic_store(ri + e1 * 16384 + p1, (unsigned)grow, RLX_AGENT);
                __hip_atomic_store(gp + e0 * 16384 + p0, __float_as_uint(g0), RLX_AGENT); __hip_atomic_store(gp + e1 * 16384 + p1, __float_as_uint(g1), RLX_AGENT);
                __hip_atomic_store(sl + grow * 2, (unsigned)((e0 << 16) | p0), RLX_AGENT); __hip_atomic_store(sl + grow * 2 + 1, (unsigned)((e1 << 16) | p1), RLX_AGENT); } }
        asm volatile("s_waitcnt vmcnt(0) lgkmcnt(0)" ::: "memory"); __builtin_amdgcn_s_barrier(); asm volatile("" ::: "memory");
#pragma unroll
        for (int ai = 0; ai < 2; ++ai)
#pragma unroll
            for (int m = 0; m < 4; ++m) { const float r = S[ai * HALF + wr * 64 + m * 16 + fr]; bf16_t* hp = H + (size_t)(row0 + ai * HALF + m * 16) * DM + col0;
#pragma unroll
                for (int bj = 0; bj < 2; ++bj) { const f32x4 h0 = acc[ai][bj][m][0] * r + sf[bj][0], h1 = acc[ai][bj][m][1] * r + sf[bj][1];
                    if ((M1_FP8 || M1L1_FP8) && h8) { int t0 = 0, t1 = 0; t0 = __builtin_amdgcn_cvt_pk_fp8_f32(h0[0], h0[1], t0, false); t0 = __builtin_amdgcn_cvt_pk_fp8_f32(h0[2], h0[3], t0, true);
                        t1 = __builtin_amdgcn_cvt_pk_fp8_f32(h1[0], h1[1], t1, false); t1 = __builtin_amdgcn_cvt_pk_fp8_f32(h1[2], h1[3], t1, true); u32x2 w; w.x = (unsigned)t0; w.y = (unsigned)t1;
                        *(u32x2*)((unsigned char*)H + (size_t)(row0 + ai * HALF + m * 16) * DM + col0 + bj * HALF) = w; }
                    else *(u32x4*)(hp + bj * HALF) = pack8(h0, h1); } }
    }
};
struct EpiGluRes {
    static constexpr bool FUSED = false;
    float* X; const float* gate;
    __device__ __forceinline__ void operator()(const Acc& acc, const Unit& u, int wr, int wc, int fr, int fq) const {
        const int row0 = u.pm * BM + wr * 64 + fr, col0 = u.pn * HALF + wc * 32 + 8 * fq; const int b = (u.pm * BM) / SEQ;
        f32x4 gv[2];
#pragma unroll
        for (int n = 0; n < 2; ++n) gv[n] = *(const f32x4*)(gate + (size_t)b * 6144 + col0 + 4 * n);
        f32x4 xv[2][4][2];
#pragma unroll
        for (int ai = 0; ai < 2; ++ai)
#pragma unroll
            for (int m = 0; m < 4; ++m)
#pragma unroll
                for (int n = 0; n < 2; ++n) xv[ai][m][n] = ldx16(X + (size_t)(row0 + ai * HALF + m * 16) * DM + col0 + 4 * n);
        asm volatile("" ::: "memory");
#pragma unroll
        for (int ai = 0; ai < 2; ++ai)
#pragma unroll
            for (int m = 0; m < 4; ++m) { float* rp = X + (size_t)(row0 + ai * HALF + m * 16) * DM + col0;
#pragma unroll
                for (int n = 0; n < 2; ++n) { f32x4 x = xv[ai][m][n]; const f32x4 l = acc[ai][0][m][n], gg = acc[ai][1][m][n];
#pragma unroll
                    for (int e = 0; e < 4; ++e) x[e] += gv[n][e] * l[e] * sigmoid_f(gg[e]);
                    *(f32x4*)(rp + 4 * n) = x; } }
    }
};
struct EpiAttnIn {
    static constexpr bool FUSED = false;
    bf16_t *Q, *Kn, *V, *QI, *KI; float* WI; const float *qg, *kg;
    __device__ __forceinline__ void operator()(const Acc& acc, const Unit& u, int wr, int wc, int fr, int fq) const {
        const int row0 = u.pm * BM + wr * 64 + fr;
        if (u.pn < 5) {
            const bool isq = u.pn < 4; const float* gp = isq ? qg : kg; const float sc = isq ? 0.125f : 1.0f;
            f32x4 gn[2][2];
#pragma unroll
            for (int bj = 0; bj < 2; ++bj)
#pragma unroll
                for (int n = 0; n < 2; ++n) gn[bj][n] = *(const f32x4*)(gp + 32 * bj + 8 * fq + 4 * n) * sc;
            bf16_t* base = isq ? (Q + (size_t)(4 * u.pn + wc) * 64) : (Kn + (size_t)wc * 64); const int ldo = isq ? 1024 : 256;
#pragma unroll
            for (int ai = 0; ai < 2; ++ai)
#pragma unroll
                for (int m = 0; m < 4; ++m) { float ss = 0.f;
#pragma unroll
                    for (int bj = 0; bj < 2; ++bj)
#pragma unroll
                        for (int n = 0; n < 2; ++n) { const f32x4 x = acc[ai][bj][m][n]; ss += (x[0] * x[0] + x[1] * x[1]) + (x[2] * x[2] + x[3] * x[3]); }
                    ss += __shfl_xor(ss, 16); ss += __shfl_xor(ss, 32);
                    const float r = 1.0f / sqrtf(ss * (1.0f / 64.0f) + EPS);
#pragma unroll
                    for (int bj = 0; bj < 2; ++bj) *(u32x4*)(base + (size_t)(row0 + ai * HALF + m * 16) * ldo + 32 * bj + 8 * fq) = pack8(acc[ai][bj][m][0] * r * gn[bj][0], acc[ai][bj][m][1] * r * gn[bj][1]); }
        } else if (u.pn < 8) {
            bf16_t* base = (u.pn == 5) ? V : QI + (size_t)(u.pn - 6) * 256; const int ldo = (u.pn == 5) ? 256 : 512; const int col0 = wc * 32 + 8 * fq;
#pragma unroll
            for (int ai = 0; ai < 2; ++ai)
#pragma unroll
                for (int m = 0; m < 4; ++m)
#pragma unroll
                    for (int bj = 0; bj < 2; ++bj) *(u32x4*)(base + (size_t)(row0 + ai * HALF + m * 16) * ldo + col0 + bj * HALF) = pack8(acc[ai][bj][m][0], acc[ai][bj][m][1]);
        } else {
            if (wc < 2) {
#pragma unroll
                for (int ai = 0; ai < 2; ++ai)
#pragma unroll
                    for (int m = 0; m < 4; ++m) *(u32x4*)(KI + (size_t)(row0 + ai * HALF + m * 16) * 64 + wc * 32 + 8 * fq) = pack8(acc[ai][0][m][0], acc[ai][0][m][1]);
            } else if (wc == 2 && fq == 0) {
                const float s = 0.04419417382415922f;
#pragma unroll
                for (int ai = 0; ai < 2; ++ai)
#pragma unroll
                    for (int m = 0; m < 4; ++m) { float* wp = WI + (size_t)(row0 + ai * HALF + m * 16) * 8; *(f32x4*)wp = acc[ai][0][m][0] * s; *(f32x4*)(wp + 4) = acc[ai][0][m][1] * s; }
            }
        }
    }
};
struct EpiMoeDn {
    static constexpr bool FUSED = false;
    bf16_t* Y; const float* gatep;
    __device__ __forceinline__ void operator()(const Acc& acc, const Unit& u, int wr, int wc, int fr, int fq) const {
        const int row0 = u.pm * BM + wr * 64 + fr, col0 = u.pn * BM + wc * 32 + 8 * fq;
#pragma unroll
        for (int ai = 0; ai < 2; ++ai)
#pragma unroll
            for (int m = 0; m < 4; ++m) { const float gt = gatep[u.aux + ai * HALF + wr * 64 + m * 16 + fr] * (M2_FP8 ? W8_INV : 1.0f);
#pragma unroll
                for (int bj = 0; bj < 2; ++bj) *(u32x4*)(Y + (size_t)(row0 + ai * HALF + m * 16) * DM + col0 + bj * HALF) = pack8(acc[ai][bj][m][0] * gt, acc[ai][bj][m][1] * gt); }
    }
};
}

constexpr size_t MiB = 1u << 20;
constexpr size_t WS_CTL = 0, CTL_ZERO_BYTES = 1 * MiB;
constexpr size_t WS_MOD = 1 * MiB;
constexpr size_t WS_ROWIDX = 2 * MiB;
constexpr size_t WS_GATEP = 2 * MiB + 512 * 1024;
constexpr size_t WS_SLOT = 3 * MiB;
static_assert(WS_ROWIDX_B == WS_ROWIDX && WS_GATEP_B == WS_GATEP && WS_SLOT_B == WS_SLOT, "metadata offsets");
constexpr size_t WS_WCI = 8 * MiB;
constexpr size_t WS_WCO = 20 * MiB;
constexpr size_t WS_WAI = 24 * MiB;
constexpr size_t WS_WAO = 29 * MiB;
constexpr size_t WS_WGL = 31 * MiB;
constexpr size_t WS_WFG = 35 * MiB;
constexpr size_t WS_WFD = 57 * MiB;
constexpr size_t WS_WMG = 68 * MiB;
constexpr size_t WS_WMD = 244 * MiB;
constexpr size_t WS_HB = 332 * MiB;
constexpr size_t WS_BUF = 364 * MiB;
constexpr size_t WS_ACT = 432 * MiB;
constexpr size_t WS_END = 619 * MiB;
constexpr int MOE_ROWS = 2 * M + NEXP * 256;
constexpr size_t WS_Q = WS_BUF, WS_K = WS_BUF + 32 * MiB, WS_V = WS_BUF + 40 * MiB, WS_QI = WS_BUF + 48 * MiB;
constexpr size_t WS_SC = WS_ACT, WS_O = WS_ACT + 128 * MiB, WS_KI = WS_ACT + 160 * MiB, WS_WI = WS_ACT + 162 * MiB;
static_assert(WS_WMD + (size_t)16 * 1024 * 2816 * 2 <= WS_HB && WS_ACT + (size_t)MOE_ROWS * FF * 2 <= WS_END && WS_BUF + (size_t)MOE_ROWS * DM * 2 <= WS_ACT, "d_ws map");
constexpr int CW_TMO = 0;
constexpr int CW_CNT = 64;
constexpr int CW_BAR = 4096;
constexpr int CW_PAN = 16384;
constexpr size_t WS_XS9 = 5 * MiB + 768 * 1024;
constexpr size_t WS_XS = 5 * MiB + 512 * 1024;

constexpr int RING_BYTES = 131072;
constexpr int LDSCTL_OFF = RING_BYTES, MISC_OFF = LDSCTL_OFF + 320;
constexpr int LDS_BYTES = 147456;

#define XB_TMO      128
#define XB_XCNT(j)  (256  + 64 * (j))
#define XB_XSUB(j)  (1280 + 64 * (j))
#define XB_XGEN(j)  (2304 + 64 * (j))
#define XB_TOP      3328
#define XB_TOPGEN   3392
#define XCD_BAR_WORDS 3456
#define XB_SPIN_CAP (1u << 18)
__device__ __forceinline__ unsigned xb_ld(unsigned* p)              { return __hip_atomic_load(p, __ATOMIC_RELAXED, __HIP_MEMORY_SCOPE_AGENT); }
__device__ __forceinline__ unsigned xb_add(unsigned* p, unsigned v) { return __hip_atomic_fetch_add(p, v, __ATOMIC_RELAXED, __HIP_MEMORY_SCOPE_AGENT); }
__device__ __forceinline__ unsigned xb_xcc_id() { return (unsigned)__builtin_amdgcn_s_getreg((3 << 11) | 20) & 0xFu; }
#define XB_SPIN(cond, bar) do { unsigned _sp = 0; while (cond) { __builtin_amdgcn_s_sleep(1); \
    if ((++_sp & 255u) == 0u) { if (xb_ld(&(bar)[XB_TMO])) break; if (_sp > XB_SPIN_CAP) { atomicAdd(&(bar)[XB_TMO], 1u); break; } } } } while (0)
struct XcdBarrier { unsigned* bar; unsigned x; volatile LAS unsigned* st; int w; };
__device__ __forceinline__ bool xb_thread0(int w) { return w == 0 && lane_id_fresh() == 0; }
__device__ __forceinline__ XcdBarrier xcd_barrier_post(unsigned* bar, volatile LAS unsigned* st, int w) {
    XcdBarrier b; b.bar = bar; b.x = xb_xcc_id(); b.st = st; b.w = w;
    if (xb_thread0(w)) (void)xb_add(&bar[XB_XCNT(b.x)], 1u);
    return b;
}
__device__ __forceinline__ void xcd_barrier_complete(unsigned* bar, unsigned x, unsigned& nloc, unsigned& nx) {
    const unsigned G = gridDim.x * gridDim.y * gridDim.z;
    unsigned sum, cnt, mine, sp = 0u;
    for (;;) {
        sum = 0u; cnt = 0u; mine = 0u;
#pragma unroll
        for (unsigned j = 0; j < 16; ++j) { const unsigned c = xb_ld(&bar[XB_XCNT(j)]); sum += c; cnt += (c > 0u) ? 1u : 0u; mine = (j == x) ? c : mine; }
        if (sum == G) break;
        __builtin_amdgcn_s_sleep(1);
        if ((++sp & 255u) == 0u) { if (xb_ld(&bar[XB_TMO])) break; if (sp > XB_SPIN_CAP) { atomicAdd(&bar[XB_TMO], 1u); break; } }
    }
    nloc = mine > 0u ? mine : 1u; nx = cnt > 0u ? cnt : 1u;
}
__device__ __forceinline__ int lane_probe() { return (int)__builtin_amdgcn_mbcnt_hi(~0u, __builtin_amdgcn_mbcnt_lo(~0u, 0u)); }
__device__ __forceinline__ int lane_probe2() { return (int)__builtin_amdgcn_mbcnt_hi(~0u, __builtin_amdgcn_mbcnt_lo(~0u, 0u)); }
__device__ __forceinline__ void xcd_barrier(const XcdBarrier& b) {
    asm volatile("s_waitcnt vmcnt(0)" ::: "memory");
    __syncthreads();
    if (xb_thread0(b.w)) {
        unsigned* bar = b.bar;
        __builtin_amdgcn_s_waitcnt(0);
        unsigned nloc = b.st[0], nx = b.st[1];
        if (nloc == 0u) { xcd_barrier_complete(bar, b.x, nloc, nx); b.st[0] = nloc; b.st[1] = nx; }
        const unsigned old = xb_add(&bar[XB_XSUB(b.x)], 1u);
        const unsigned gen = old / nloc;
        if (old + 1u == (gen + 1u) * nloc) {
            __builtin_amdgcn_fence(__ATOMIC_RELEASE, "agent");
            asm volatile("s_waitcnt vmcnt(0)" ::: "memory");
            __builtin_amdgcn_fence(__ATOMIC_RELEASE, "agent");
            asm volatile("s_waitcnt vmcnt(0)" ::: "memory");
            const unsigned og = xb_add(&bar[XB_TOP], 1u);
            const unsigned tg = og / nx;
            if (og + 1u == (tg + 1u) * nx) xb_add(&bar[XB_TOPGEN], 1u);
            else XB_SPIN(xb_ld(&bar[XB_TOPGEN]) == tg, bar);
            __builtin_amdgcn_fence(__ATOMIC_ACQUIRE, "agent");
            xb_add(&bar[XB_XGEN(b.x)], 1u);
            { const unsigned dmy = __builtin_nontemporal_load(&bar[XB_TMO]); asm volatile("s_waitcnt vmcnt(0)" :: "v"(dmy) : "memory"); }
        } else {
            XB_SPIN(xb_ld(&bar[XB_XGEN(b.x)]) == gen, bar);
            __builtin_amdgcn_fence(__ATOMIC_ACQUIRE, "agent");
            { const unsigned dmy = __builtin_nontemporal_load(&bar[XB_TMO]); asm volatile("s_waitcnt vmcnt(0)" :: "v"(dmy) : "memory"); }
        }
    }
    __syncthreads();
    if (xb_thread0(b.w)) { __builtin_amdgcn_fence(__ATOMIC_ACQUIRE, "agent"); asm volatile("s_waitcnt vmcnt(0)" ::: "memory"); }
    __syncthreads();
}

struct Args { const float* in[28]; float* out; unsigned char* ws; int ph_lo, ph_hi; };
enum { I_X = 0, I_C, I_ADAW, I_ADAB, I_NORMG, I_CWIN, I_CW, I_CWOUT, I_AWIN, I_QG, I_KG, I_AWOUT, I_RELB, I_SLRE, I_SLIM, I_SLOG, I_SBRE, I_SBIM, I_SCRE, I_SCIM, I_SD, I_SGLU,
       I_FGU, I_FDN, I_RW, I_RB, I_MGU, I_MDN };
struct Frame {
    LAS unsigned char* lds; unsigned char* ws; gu32* ctl;
    int tid, lane, wave, vcu, G;
    float* out; const float* mod;
    bf16_t *HB, *BUF, *ACT;
};

enum { MAP_NAT = 0, MAP_PAIR = 1, MAP_CONV = 2, MAP_ATTN = 3 };
__device__ __forceinline__ int map_row(int map, int half, int n) {
    if (map == MAP_NAT) return n;
    if (map == MAP_PAIR) { return n < half ? 256 * (n / 128) + (n % 128) : 256 * ((n - half) / 128) + 128 + ((n - half) % 128); }
    if (map == MAP_CONV) { if (n < 1024) return 2048 + n; if (n < 2048) { const int q = n - 1024; return 256 * (q / 128) + (q % 128); } const int q = n - 2048; return 256 * (q / 128) + 128 + (q % 128); }
    if (n < 1280) { const int hd = n / 64, d = n % 64; return 256 * (hd / 4) + 128 * (d / 32) + 32 * (hd % 4) + (d % 32); }
    return n;
}
__device__ __forceinline__ void p0_transpose_item(const float* W, int K, int N, bf16_t* WT, int map, int half, LAS float* scr, int item, int lane) {
    const int nblk = (N + 31) / 32, kb = item / nblk, nb = item % nblk, k0 = 64 * kb, n0 = 32 * nb;
    const bool cin = (n0 + (lane & 31)) < N;
    float tv[32];
#pragma unroll
    for (int i = 0; i < 32; ++i) { const int kk = 2 * i + (lane >> 5); tv[i] = cin ? W[(size_t)(k0 + kk) * N + n0 + (lane & 31)] : 0.f; }
#pragma unroll
    for (int i = 0; i < 32; ++i) { const int kk = 2 * i + (lane >> 5); scr[kk * 33 + (lane & 31)] = tv[i]; }
    LDS_WAIT(); CFENCE();
    const int c = lane & 7; const int r0 = map_row(map, half, n0);
#pragma unroll
    for (int j = 0; j < 4; ++j) { const int n = (lane >> 3) + 8 * j; const LAS float* s = scr + (8 * c) * 33 + n;
        u32x4 o; o.x = pk2(s[0 * 33], s[1 * 33]); o.y = pk2(s[2 * 33], s[3 * 33]); o.z = pk2(s[4 * 33], s[5 * 33]); o.w = pk2(s[6 * 33], s[7 * 33]);
        *(GAS u32x4*)(WT + (size_t)(r0 + n) * K + k0 + 8 * c) = o; }
    LDS_WAIT(); CFENCE();
}
__device__ __forceinline__ void p0_transpose_item8(const float* W, int K, int N, unsigned char* WT, int map, int half, LAS float* scr, int item, int lane, int sub) {
    const int nblk = (N + 31) / 32, kb = 2 * (item / nblk) + sub, nb = item % nblk, k0 = 64 * kb, n0 = 32 * nb;
    float tv[32];
#pragma unroll
    for (int i = 0; i < 32; ++i) { const int kk = 2 * i + (lane >> 5); tv[i] = W[(size_t)(k0 + kk) * N + n0 + (lane & 31)]; }
#pragma unroll
    for (int i = 0; i < 32; ++i) { const int kk = 2 * i + (lane >> 5); scr[kk * 33 + (lane & 31)] = tv[i] * pg8::W8_MUL; }
    LDS_WAIT(); CFENCE();
    const int c = lane & 3; const int r0 = map_row(map, half, n0);
#pragma unroll
    for (int j = 0; j < 2; ++j) { const int n = (lane >> 2) + 16 * j; const LAS float* sp = scr + (16 * c) * 33 + n; u32x4 o;
#pragma unroll
        for (int q = 0; q < 4; ++q) { int t = 0; t = __builtin_amdgcn_cvt_pk_fp8_f32(sp[(4 * q) * 33], sp[(4 * q + 1) * 33], t, false); t = __builtin_amdgcn_cvt_pk_fp8_f32(sp[(4 * q + 2) * 33], sp[(4 * q + 3) * 33], t, true); o[q] = (unsigned)t; }
        *(GAS u32x4*)(WT + (size_t)(r0 + n) * K + k0 + 16 * c) = o; }
    LDS_WAIT(); CFENCE();
}
__device__ __forceinline__ void p0_prologue(Frame& F, const Args& A) {
    {
        LAS float* cs = (LAS float*)F.lds;
        LAS float* red = (LAS float*)(F.lds + 16384);
        for (int i = F.tid; i < NB * DM; i += NTHREADS) { const float c = A.in[I_C][i]; cs[i] = c / (1.f + __expf(-c)); }
        __syncthreads();
        const int kg = F.tid >> 6, cj = F.tid & 63;
        for (int un = blockIdx.x; un < 4 * 96; un += F.G) {
            const int l = un / 96, jb = un % 96, j = jb * 64 + cj;
            const float* w = A.in[I_ADAW] + (size_t)l * DM * 6144 + j;
            float a0 = 0.f, a1 = 0.f, a2 = 0.f, a3 = 0.f;
#pragma unroll 8
            for (int k = kg * 128; k < kg * 128 + 128; ++k) { const float wv = w[(size_t)k * 6144]; a0 += cs[k] * wv; a1 += cs[1024 + k] * wv; a2 += cs[2048 + k] * wv; a3 += cs[3072 + k] * wv; }
            *(LAS f32x4*)(red + (kg * 64 + cj) * 4) = (f32x4){a0, a1, a2, a3};
            __syncthreads();
            if (F.tid < 256) { const int b = F.tid >> 6, cc = F.tid & 63; float s = 0.f;
#pragma unroll
                for (int q = 0; q < 8; ++q) s += red[(q * 64 + cc) * 4 + b];
                ((float*)(F.ws + WS_MOD))[((size_t)l * NB + b) * 6144 + jb * 64 + cc] = s + A.in[I_ADAB][l * 6144 + jb * 64 + cc]; }
            __syncthreads();
        }
    }
    LAS float* scr = (LAS float*)(F.lds + 32768 + F.wave * 8704);
    const int gw = F.vcu * NWAVES + F.wave, NGW = F.G * NWAVES;
    constexpr int I_CI = (DM / 64) * (3072 / 32), I_SQ = (DM / 64) * (DM / 32), I_AI = (DM / 64) * ((ATT_N + 31) / 32), I_GL = (DM / 64) * (2048 / 32), I_GU = (DM / 64) * (2 * FF / 32), I_DN = (FF / 128) * (DM / 32), I_DNB = (FF / 64) * (DM / 32), I_GU8 = (DM / 128) * (2 * FF / 32);
    constexpr int NITEMS = 2 * I_CI + 2 * I_SQ + I_AI + I_SQ + I_GL + 2 * I_GU + (F2_FP8 ? 2 * I_DN : ((F2L0_FP8 ? I_DN : I_DNB) + I_DNB)) + 8 * (M1L1_FP8 ? I_GU8 : I_GU) + 8 * (M1_FP8 ? I_GU8 : I_GU) + 16 * (M2_FP8 ? I_DN : I_DNB);
    for (int it = gw; it < NITEMS; it += NGW) {
        int r = it;
        if (r < 2 * I_CI) { const int q = r / I_CI; p0_transpose_item(A.in[I_CWIN] + (size_t)q * DM * 3072, DM, 3072, (bf16_t*)(F.ws + WS_WCI) + (size_t)q * 3072 * DM, MAP_CONV, 0, scr, r % I_CI, F.lane); continue; } r -= 2 * I_CI;
        if (r < 2 * I_SQ) { const int q = r / I_SQ; p0_transpose_item(A.in[I_CWOUT] + (size_t)q * DM * DM, DM, DM, (bf16_t*)(F.ws + WS_WCO) + (size_t)q * DM * DM, MAP_NAT, 0, scr, r % I_SQ, F.lane); continue; } r -= 2 * I_SQ;
        if (r < I_AI) { p0_transpose_item(A.in[I_AWIN], DM, ATT_N, (bf16_t*)(F.ws + WS_WAI), MAP_ATTN, 0, scr, r, F.lane); continue; } r -= I_AI;
        if (r < I_SQ) { p0_transpose_item(A.in[I_AWOUT], DM, DM, (bf16_t*)(F.ws + WS_WAO), MAP_NAT, 0, scr, r, F.lane); continue; } r -= I_SQ;
        if (r < I_GL) { p0_transpose_item(A.in[I_SGLU], DM, 2048, (bf16_t*)(F.ws + WS_WGL), MAP_PAIR, 1024, scr, r, F.lane); continue; } r -= I_GL;
        if (r < 2 * I_GU) { const int q = r / I_GU; p0_transpose_item(A.in[I_FGU] + (size_t)q * DM * 2 * FF, DM, 2 * FF, (bf16_t*)(F.ws + WS_WFG) + (size_t)q * 2 * FF * DM, MAP_PAIR, FF, scr, r % I_GU, F.lane); continue; } r -= 2 * I_GU;
        if (F2_FP8) { if (r < 2 * I_DN) { const int q = r / I_DN; p0_transpose_item8(A.in[I_FDN] + (size_t)q * FF * DM, FF, DM, (unsigned char*)(F.ws + WS_WFD) + (size_t)q * DM * FF, MAP_NAT, 0, scr, r % I_DN, F.lane, 0); p0_transpose_item8(A.in[I_FDN] + (size_t)q * FF * DM, FF, DM, (unsigned char*)(F.ws + WS_WFD) + (size_t)q * DM * FF, MAP_NAT, 0, scr, r % I_DN, F.lane, 1); continue; } r -= 2 * I_DN; }
        else if (F2L0_FP8) {
            if (r < I_DN) { p0_transpose_item8(A.in[I_FDN], FF, DM, (unsigned char*)(F.ws + WS_WFD), MAP_NAT, 0, scr, r, F.lane, 0); p0_transpose_item8(A.in[I_FDN], FF, DM, (unsigned char*)(F.ws + WS_WFD), MAP_NAT, 0, scr, r, F.lane, 1); continue; } r -= I_DN;
            if (r < I_DNB) { p0_transpose_item(A.in[I_FDN] + (size_t)FF * DM, FF, DM, (bf16_t*)(F.ws + WS_WFD) + (size_t)DM * FF, MAP_NAT, 0, scr, r, F.lane); continue; } r -= I_DNB; }
        else { if (r < 2 * I_DNB) { const int q = r / I_DNB; p0_transpose_item(A.in[I_FDN] + (size_t)q * FF * DM, FF, DM, (bf16_t*)(F.ws + WS_WFD) + (size_t)q * DM * FF, MAP_NAT, 0, scr, r % I_DNB, F.lane); continue; } r -= 2 * I_DNB; }
        if (M1L1_FP8) { if (r < 8 * I_GU8) { const int q = r / I_GU8; unsigned char* dst = (unsigned char*)(F.ws + WS_WMG) + (size_t)q * 2 * FF * DM;
                p0_transpose_item8(A.in[I_MGU] + (size_t)q * DM * 2 * FF, DM, 2 * FF, dst, MAP_PAIR, FF, scr, r % I_GU8, F.lane, 0); p0_transpose_item8(A.in[I_MGU] + (size_t)q * DM * 2 * FF, DM, 2 * FF, dst, MAP_PAIR, FF, scr, r % I_GU8, F.lane, 1); continue; } r -= 8 * I_GU8; }
        else { if (r < 8 * I_GU) { const int q = r / I_GU; p0_transpose_item(A.in[I_MGU] + (size_t)q * DM * 2 * FF, DM, 2 * FF, (bf16_t*)(F.ws + WS_WMG) + (size_t)q * 2 * FF * DM, MAP_PAIR, FF, scr, r % I_GU, F.lane); continue; } r -= 8 * I_GU; }
        if (M1_FP8) { if (r < 8 * I_GU8) { const int q = 8 + r / I_GU8; unsigned char* dst = (unsigned char*)(F.ws + WS_WMG) + (size_t)8 * 2 * FF * DM * 2 + (size_t)(q - 8) * 2 * FF * DM;
                p0_transpose_item8(A.in[I_MGU] + (size_t)q * DM * 2 * FF, DM, 2 * FF, dst, MAP_PAIR, FF, scr, r % I_GU8, F.lane, 0); p0_transpose_item8(A.in[I_MGU] + (size_t)q * DM * 2 * FF, DM, 2 * FF, dst, MAP_PAIR, FF, scr, r % I_GU8, F.lane, 1); continue; } r -= 8 * I_GU8; }
        else { if (r < 8 * I_GU) { const int q = 8 + r / I_GU; p0_transpose_item(A.in[I_MGU] + (size_t)q * DM * 2 * FF, DM, 2 * FF, (bf16_t*)(F.ws + WS_WMG) + (size_t)q * 2 * FF * DM, MAP_PAIR, FF, scr, r % I_GU, F.lane); continue; } r -= 8 * I_GU; }
        if (M2_FP8) { const int q = r / I_DN; p0_transpose_item8(A.in[I_MDN] + (size_t)q * FF * DM, FF, DM, (unsigned char*)(F.ws + WS_WMD) + (size_t)q * DM * FF, MAP_NAT, 0, scr, r % I_DN, F.lane, 0); p0_transpose_item8(A.in[I_MDN] + (size_t)q * FF * DM, FF, DM, (unsigned char*)(F.ws + WS_WMD) + (size_t)q * DM * FF, MAP_NAT, 0, scr, r % I_DN, F.lane, 1); }
        else { const int q = r / I_DNB; p0_transpose_item(A.in[I_MDN] + (size_t)q * FF * DM, FF, DM, (bf16_t*)(F.ws + WS_WMD) + (size_t)q * DM * FF, MAP_NAT, 0, scr, r % I_DNB, F.lane); }
    }
    { u32x4* z = (u32x4*)((bf16_t*)(F.ws + WS_WAI) + (size_t)2144 * DM); const int n16 = (ATT_NP - 2144) * DM * 2 / 16;
      for (int i = blockIdx.x * NTHREADS + F.tid; i < n16; i += F.G * NTHREADS) z[i] = (u32x4){0u, 0u, 0u, 0u}; }
}

template <int FLAGS>
__device__ __forceinline__ void thin_phase(Frame& F, const Args& A, const float* src, int nl  , int ns  , int cl  , int rl  , int cs = -1  , size_t roff = 0  ) {
    if (cs < 0) cs = rl;
    const int gw = F.vcu * NWAVES + F.wave, NGW = F.G * NWAVES;
    LAS float* rwt = (LAS float*)F.lds;
    if (FLAGS & 8) {
        const float* rw = A.in[I_RW] + (size_t)rl * DM * NEXP;
        for (int i = F.tid; i < DM * NEXP; i += NTHREADS) rwt[(i & 7) * DM + (i >> 3)] = rw[i];
        __syncthreads();
    }
    int Tb[8];
    if (FLAGS & 2) { int acc = 0;
#pragma unroll
        for (int e = 0; e < 8; ++e) { Tb[e] = acc; acc += (int)((__hip_atomic_load(F.ctl + CW_CNT + 64 * (8 * rl + e), RLX_AGENT) + 255u) >> 8); } }
    const float* ng = A.in[I_NORMG] + (size_t)(nl * 2 + ns) * DM;
    constexpr bool RT = (FLAGS & 8) != 0;
    LAS int* rE = (LAS int*)(F.lds + 32768);
    const int nit = RT ? ((M / 64 - (int)blockIdx.x + F.G - 1) / F.G) * 8 : (M - gw + NGW - 1) / NGW;
    for (int it = 0; it < nit; ++it) {
        const int chunk = (int)blockIdx.x + (it >> 3) * F.G;
        const int row = RT ? chunk * 64 + F.wave * 8 + (it & 7) : gw + it * NGW;
        const int b = row / SEQ;
        f32x4 v[4];
        const GAS unsigned long long* xr = (const GAS unsigned long long*)(src + (size_t)row * DM) + 2 * F.lane;
#pragma unroll
        for (int j = 0; j < 4; ++j) { const unsigned long long lo = __hip_atomic_load(xr + 128 * j, RLX_AGENT), hi = __hip_atomic_load(xr + 128 * j + 1, RLX_AGENT);
            v[j] = (f32x4){__uint_as_float((unsigned)lo), __uint_as_float((unsigned)(lo >> 32)), __uint_as_float((unsigned)hi), __uint_as_float((unsigned)(hi >> 32))}; }
        if (FLAGS & 2) {
            const int s0 = ((const int*)(F.ws + roff + WS_SLOT))[row * 2], s1 = ((const int*)(F.ws + roff + WS_SLOT))[row * 2 + 1];
            int t0 = 0, t1 = 0;
#pragma unroll
            for (int e = 0; e < 8; ++e) { if ((s0 >> 16) == e) t0 = Tb[e]; if ((s1 >> 16) == e) t1 = Tb[e]; }
            const bf16_t* y0 = (const bf16_t*)(F.ws + WS_BUF) + (size_t)(256 * t0 + (s0 & 0xffff)) * DM;
            const bf16_t* y1 = (const bf16_t*)(F.ws + WS_BUF) + (size_t)(256 * t1 + (s1 & 0xffff)) * DM;
            const float* g2 = cl >= 0 ? F.mod + ((size_t)cl * NB + b) * 6144 + 5 * DM : (const float*)(F.ws + 512 * 1024);
#pragma unroll
            for (int j = 0; j < 4; ++j) { const int col = 4 * F.lane + 256 * j; const u32x2 a = *(const u32x2*)(y0 + col), c = *(const u32x2*)(y1 + col); const f32x4 g = *(const f32x4*)(g2 + col);
                v[j][0] += g[0] * (bflo(a.x) + bflo(c.x)); v[j][1] += g[1] * (bfhi(a.x) + bfhi(c.x)); v[j][2] += g[2] * (bflo(a.y) + bflo(c.y)); v[j][3] += g[3] * (bfhi(a.y) + bfhi(c.y)); }
        }
        if (FLAGS & 3) { GAS f32x4* xo = (GAS f32x4*)(F.out + (size_t)row * DM) + F.lane;
#pragma unroll
            for (int j = 0; j < 4; ++j) xo[64 * j] = v[j]; }
        if (FLAGS & 4) {
            float ss = 0.f;
#pragma unroll
            for (int j = 0; j < 4; ++j) ss += (v[j][0] * v[j][0] + v[j][1] * v[j][1]) + (v[j][2] * v[j][2] + v[j][3] * v[j][3]);
            const float r = 1.0f / sqrtf(wave_sum(ss) * (1.0f / DM) + EPS);
            const float* sh = F.mod + ((size_t)nl * NB + b) * 6144 + (ns ? 3 : 0) * DM; const float* sc = sh + DM;
            GAS u32x2* ho = (GAS u32x2*)(F.HB + (size_t)row * DM) + F.lane;
#pragma unroll
            for (int j = 0; j < 4; ++j) { const int col = 4 * F.lane + 256 * j; const f32x4 g = *(const f32x4*)(ng + col), s1 = *(const f32x4*)(sc + col), s0 = *(const f32x4*)(sh + col);
                v[j] = (v[j] * r) * g * (s1 + 1.0f) + s0;
                if (RT && ((M1_FP8 && nl == 3) || (M1L1_FP8 && nl == 1))) { int t = 0; t = __builtin_amdgcn_cvt_pk_fp8_f32(v[j][0], v[j][1], t, false); t = __builtin_amdgcn_cvt_pk_fp8_f32(v[j][2], v[j][3], t, true);
                    *(unsigned*)((unsigned char*)F.HB + (size_t)row * DM + col) = (unsigned)t; }
                else { u32x2 w; w.x = pk2(v[j][0], v[j][1]); w.y = pk2(v[j][2], v[j][3]); ho[64 * j] = w; } }
            if (FLAGS & 8) {
                float lg[8];
#pragma unroll
                for (int e = 0; e < 8; ++e) { float s = 0.f;
#pragma unroll
                    for (int j = 0; j < 4; ++j) { const f32x4 w = *(const LAS f32x4*)(rwt + e * DM + 4 * F.lane + 256 * j); s += (v[j][0] * w[0] + v[j][1] * w[1]) + (v[j][2] * w[2] + v[j][3] * w[3]); }
                    lg[e] = wave_sum(s) + A.in[I_RB][rl * NEXP + e]; }
                int e0 = 0; float l0 = lg[0];
#pragma unroll
                for (int e = 1; e < 8; ++e) if (lg[e] > l0) { l0 = lg[e]; e0 = e; }
                int e1 = -1; float l1 = -3.0e38f;
#pragma unroll
                for (int e = 0; e < 8; ++e) if (e != e0 && lg[e] > l1) { l1 = lg[e]; e1 = e; }
                const float g0 = 1.0f / (1.0f + __expf(l1 - l0)), g1 = 1.0f - g0;
                const int lr = F.wave * 8 + (it & 7);
                if (F.lane == 0) { rE[lr] = e0; rE[64 + lr] = e1; rE[128 + lr] = __float_as_int(g0); rE[192 + lr] = __float_as_int(g1); }
            }
        }
        if (RT && (it & 7) == 7) {
            __syncthreads();
            if (F.tid < 8) { int cnt = 0; for (int q = 0; q < 64; ++q) cnt += (rE[q] == F.tid) + (rE[64 + q] == F.tid);
                rE[256 + F.tid] = cnt ? (int)__hip_atomic_fetch_add(F.ctl + CW_CNT + 64 * (8 * cs + F.tid), (unsigned)cnt, RLX_AGENT) : 0; }
            __syncthreads();
            if (F.tid < 64) { const int e0 = rE[F.tid], e1 = rE[64 + F.tid]; int r0 = 0, r1 = 0;
                for (int q = 0; q < F.tid; ++q) { r0 += (rE[q] == e0) + (rE[64 + q] == e0); r1 += (rE[q] == e1) + (rE[64 + q] == e1); }
                const int p0 = rE[256 + e0] + r0, p1 = rE[256 + e1] + r1, grow = chunk * 64 + F.tid;
                gu32* ri = (gu32*)(F.ws + roff + WS_ROWIDX); gu32* gp = (gu32*)(F.ws + roff + WS_GATEP); gu32* sl = (gu32*)(F.ws + roff + WS_SLOT);
                __hip_atomic_store(ri + e0 * 16384 + p0, (unsigned)grow, RLX_AGENT); __hip_atomic_store(ri + e1 * 16384 + p1, (unsigned)grow, RLX_AGENT);
                __hip_atomic_store(gp + e0 * 16384 + p0, (unsigned)rE[128 + F.tid], RLX_AGENT); __hip_atomic_store(gp + e1 * 16384 + p1, (unsigned)rE[192 + F.tid], RLX_AGENT);
                __hip_atomic_store(sl + grow * 2, (unsigned)((e0 << 16) | p0), RLX_AGENT); __hip_atomic_store(sl + grow * 2 + 1, (unsigned)((e1 << 16) | p1), RLX_AGENT); }
            __syncthreads();
        }
    }
}

__device__ __forceinline__ void unpack8(const u32x4 w, float (&f)[8]) { f[0] = bflo(w.x); f[1] = bfhi(w.x); f[2] = bflo(w.y); f[3] = bfhi(w.y); f[4] = bflo(w.z); f[5] = bfhi(w.z); f[6] = bflo(w.w); f[7] = bfhi(w.w); }
__device__ __forceinline__ void conv_phase(Frame& F, const float* cw  ) {
    const int gw = F.vcu * NWAVES + F.wave, NGW = F.G * NWAVES;
    const bf16_t* UB = F.BUF;
    for (int task = gw; task < M / 8; task += NGW) {
        const int r0 = task * 8; const bool first = (r0 % SEQ) == 0;
#pragma unroll
        for (int j = 0; j < 2; ++j) {
            const int ch = 8 * F.lane + 512 * j;
            float w0[8], w1[8], w2[8];
#pragma unroll
            for (int e = 0; e < 8; ++e) { w0[e] = cw[ch + e]; w1[e] = cw[DM + ch + e]; w2[e] = cw[2 * DM + ch + e]; }
            float um2[8], um1[8];
            if (first) {
#pragma unroll
                for (int e = 0; e < 8; ++e) { um2[e] = 0.f; um1[e] = 0.f; }
            } else { unpack8(*(const u32x4*)(UB + (size_t)(r0 - 2) * 2048 + ch), um2); unpack8(*(const u32x4*)(UB + (size_t)(r0 - 1) * 2048 + ch), um1); }
#pragma unroll
            for (int i = 0; i < 8; ++i) {
                float u0[8], bb[8]; unpack8(*(const u32x4*)(UB + (size_t)(r0 + i) * 2048 + ch), u0); unpack8(*(const u32x4*)(UB + (size_t)(r0 + i) * 2048 + 1024 + ch), bb);
                float z[8];
#pragma unroll
                for (int e = 0; e < 8; ++e) z[e] = bb[e] * (w0[e] * um2[e] + w1[e] * um1[e] + w2[e] * u0[e]);
                u32x4 o; o.x = pk2(z[0], z[1]); o.y = pk2(z[2], z[3]); o.z = pk2(z[4], z[5]); o.w = pk2(z[6], z[7]);
                *(u32x4*)(F.HB + (size_t)(r0 + i) * DM + ch) = o;
#pragma unroll
                for (int e = 0; e < 8; ++e) { um2[e] = um1[e]; um1[e] = u0[e]; }
            }
        }
    }
}

constexpr int QIP = 1040;
constexpr int AL_QI = 0, AL_WI = 33280, AL_SEL = 34304, AL_V = 42496, AL_BIASD = 108032, AL_SUM = 116288, AL_END = 116800;
typedef short v4i16_t __attribute__((ext_vector_type(4)));
__device__ __forceinline__ unsigned okey(float f) { const unsigned u = __float_as_uint(f); return u ^ ((u >> 31) ? 0xFFFFFFFFu : 0x80000000u); }
__device__ __forceinline__ void attn_phase(Frame& F, const Args& A) {
    LAS unsigned char* L = F.lds;
    const bf16_t* Qb = (const bf16_t*)(F.ws + WS_Q); const bf16_t* Kb = (const bf16_t*)(F.ws + WS_K); const bf16_t* Vb = (const bf16_t*)(F.ws + WS_V);
    const bf16_t* QIb = (const bf16_t*)(F.ws + WS_QI); const bf16_t* KIb = (const bf16_t*)(F.ws + WS_KI); const float* WIb = (const float*)(F.ws + WS_WI);
    bf16_t* Ob = (bf16_t*)(F.ws + WS_O);
    float* SC = (float*)(F.ws + WS_SC) + (size_t)blockIdx.x * 32 * SEQ;
    const int lane = F.lane, wave = F.wave;
    { LAS float* bd = (LAS float*)(L + AL_BIASD);
      for (int i = F.tid; i < 129 * 16; i += NTHREADS) { const int d = i >> 4; int bkt; if (d < 16) bkt = d; else { const float dd = (float)d; const int lg2 = 16 + (int)(logf(dd / 16.0f) / 2.0794415416798357f * 16.0f); bkt = lg2 < 31 ? lg2 : 31; }
          bd[i] = A.in[I_RELB][bkt * 16 + (i & 15)]; }
    }
    __syncthreads();
    for (int pass = 0; pass < 2; ++pass) {
        const int un = pass == 0 ? (int)blockIdx.x : 511 - (int)blockIdx.x;
        for (int uu = un; uu >= 0 && uu < 512; uu += (pass == 0 ? F.G * 2 : -F.G * 2)) {
        if ((pass == 0 && uu >= 256) || (pass == 1 && uu < 256)) break;
        const int b = uu & 3, qb = uu >> 2, t0 = qb * 32; const size_t rb = (size_t)b * SEQ;
        for (int i = F.tid; i < 32 * 64; i += NTHREADS) { const int q = i >> 6, c = i & 63; *(LAS u32x4*)(L + AL_QI + q * QIP + c * 16) = *(const u32x4*)(QIb + (rb + t0 + q) * 512 + c * 8); }
        if (F.tid < 256) ((LAS float*)(L + AL_WI))[F.tid] = WIb[(rb + t0) * 8 + F.tid];
        __syncthreads();
        {
            for (int kt = wave; kt <= qb; kt += NWAVES) {
                int ln1 = lane; asm volatile("" : "+v"(ln1));
                const int r = ln1 & 31, hh = ln1 >> 5;
                float wi[8];
#pragma unroll
                for (int h = 0; h < 8; ++h) wi[h] = ((LAS float*)(L + AL_WI))[r * 8 + h];
                bf16x8 ka[4];
#pragma unroll
                for (int ks = 0; ks < 4; ++ks) ka[ks] = *(const bf16x8*)(KIb + (rb + kt * 32 + r) * 64 + 16 * ks + 8 * hh);
                f32x16 sc;
#pragma unroll
                for (int i = 0; i < 16; ++i) sc[i] = 0.f;
#pragma unroll
                for (int h = 0; h < 8; ++h) {
                    f32x16 d;
#pragma unroll
                    for (int i = 0; i < 16; ++i) d[i] = 0.f;
#pragma unroll
                    for (int ks = 0; ks < 4; ++ks) { const bf16x8 qf = *(const LAS bf16x8*)(L + AL_QI + r * QIP + (h * 64 + 16 * ks + 8 * hh) * 2); d = __builtin_amdgcn_mfma_f32_32x32x16_bf16(ka[ks], qf, d, 0, 0, 0); }
#pragma unroll
                    for (int i = 0; i < 16; ++i) sc[i] += wi[h] * fmaxf(d[i], 0.f);
                }
#pragma unroll
                for (int a = 0; a < 4; ++a) { f32x4 o;
#pragma unroll
                    for (int e = 0; e < 4; ++e) { const int krow = 8 * a + 4 * hh + e; o[e] = (kt == qb && krow > r) ? -INFINITY : sc[4 * a + e]; }
                    *(f32x4*)(SC + (size_t)r * SEQ + kt * 32 + 8 * a + 4 * hh) = o; }
            }
        }
        VM_WAIT(); __syncthreads();
        for (int qq = 0; qq < 4; ++qq) {
            const int c = wave + 8 * qq, t = t0 + c; const int nvalid = t + 1;
            int lane = F.lane; asm volatile("" : "+v"(lane));
            LAS int* sel = (LAS int*)(L + AL_SEL) + wave * 256;
            int count;
            if (nvalid <= TOPK) {
                count = nvalid;
#pragma unroll
                for (int j = 0; j < 4; ++j) { const int idx = 64 * j + lane; sel[idx] = idx < nvalid ? idx : 0; }
            } else {
                count = TOPK;
                const int nj = (nvalid + 63) >> 6;
                unsigned key[64];
                const float* srow = SC + (size_t)c * SEQ;
#define SEL_GROUPS(BODY) do { BODY(0) if (nj > 16) { BODY(1) if (nj > 32) { BODY(2) if (nj > 48) { BODY(3) } } } } while (0)
#define SEL_LOAD(g) { _Pragma("unroll") for (int j = 16 * (g); j < 16 * (g) + 16; ++j) { const int idx = 64 * j + lane; const float sv = __uint_as_float(__hip_atomic_load((const gu32*)(srow + idx), RLX_AGENT)); key[j] = idx <= t ? okey(sv) : 0u;     } }
#pragma unroll
                for (int j = 0; j < 64; ++j) key[j] = 0u;
                SEL_GROUPS(SEL_LOAD);
                unsigned T = 0u;
                for (int bit = 31; bit >= 0; --bit) {
                    const unsigned cand = T | (1u << bit); int cnt = 0;
#define SEL_CNT(g) { _Pragma("unroll") for (int j = 16 * (g); j < 16 * (g) + 16; ++j) cnt += __popcll(__ballot(key[j] >= cand)); }
                    SEL_GROUPS(SEL_CNT);
                    if (cnt >= TOPK) T = cand;
                    if (cnt == TOPK) break;
                }
                int base = 0;
#define SEL_GT(g) { _Pragma("unroll") for (int j = 16 * (g); j < 16 * (g) + 16; ++j) { const bool gt = key[j] > T; const unsigned long long mk = __ballot(gt); \
                    const int pos = base + (int)__builtin_amdgcn_mbcnt_hi((unsigned)(mk >> 32), __builtin_amdgcn_mbcnt_lo((unsigned)mk, 0u)); if (gt) sel[pos] = 64 * j + lane; base += __popcll(mk); } }
                SEL_GROUPS(SEL_GT);
                const int need = TOPK - base; int eb = 0;
#define SEL_EQ(g) { _Pragma("unroll") for (int j = 16 * (g); j < 16 * (g) + 16; ++j) { const bool eq = key[j] == T; const unsigned long long mk = __ballot(eq); \
                    const int rank = eb + (int)__builtin_amdgcn_mbcnt_hi((unsigned)(mk >> 32), __builtin_amdgcn_mbcnt_lo((unsigned)mk, 0u)); if (eq && rank < need) sel[base + rank] = 64 * j + lane; eb += __popcll(mk); } }
                SEL_GROUPS(SEL_EQ);
#undef SEL_GROUPS
#undef SEL_LOAD
#undef SEL_CNT
#undef SEL_GT
#undef SEL_EQ
            }
            LDS_WAIT(); CFENCE();
            asm volatile("" : "+v"(lane));
            const int hd = lane & 15, kq = lane >> 4;
            bf16x8 bq[8];
            { bf16x8 qf[2];
#pragma unroll
              for (int s2 = 0; s2 < 2; ++s2) qf[s2] = *(const bf16x8*)(Qb + (rb + t) * 1024 + hd * 64 + 32 * s2 + 8 * kq);
              const bf16x8 zf = (bf16x8){0, 0, 0, 0, 0, 0, 0, 0};
#pragma unroll
              for (int ks = 0; ks < 8; ++ks) bq[ks] = ((ks >> 1) == (hd >> 2)) ? qf[ks & 1] : zf; }
            f32x4 lg[16];
            float mx = -INFINITY;
            bf16x8 kf[3][8];
#pragma unroll
            for (int pre = 0; pre < 2; ++pre) { const int krow = sel[16 * pre + hd]; const bf16_t* kp = Kb + (rb + krow) * 256 + 8 * kq;
#pragma unroll
              for (int ks = 0; ks < 8; ++ks) kf[pre][ks] = *(const bf16x8*)(kp + 32 * ks); }
            const LAS float* biasd = (const LAS float*)(L + AL_BIASD);
#pragma unroll
            for (int kt = 0; kt < 16; ++kt) {
                if (kt < 14) { const int krow = sel[16 * (kt + 2) + hd]; const bf16_t* kp = Kb + (rb + krow) * 256 + 8 * kq;
#pragma unroll
                    for (int ks = 0; ks < 8; ++ks) kf[(kt + 2) % 3][ks] = *(const bf16x8*)(kp + 32 * ks); }
                f32x4 d = (f32x4){0.f, 0.f, 0.f, 0.f};
#pragma unroll
                for (int ks = 0; ks < 8; ++ks) d = __builtin_amdgcn_mfma_f32_16x16x32_bf16(kf[kt % 3][ks], bq[ks], d, 0, 0, 0);
                const u32x4 ks4 = *(const LAS u32x4*)(sel + 16 * kt + 4 * kq);
#pragma unroll
                for (int i = 0; i < 4; ++i) { const int pos = 16 * kt + 4 * kq + i; int dist = t - (int)ks4[i]; dist = dist < 0 ? 0 : (dist > 128 ? 128 : dist);
                    const float bs = biasd[dist * 16 + hd];
                    d[i] = pos < count ? d[i] + bs : -INFINITY; mx = fmaxf(mx, d[i]); }
                lg[kt] = d;
            }
            mx = fmaxf(mx, __shfl_xor(mx, 16)); mx = fmaxf(mx, __shfl_xor(mx, 32));
            float sum = 0.f;
            bf16x8 pa[8];
#pragma unroll
            for (int ks = 0; ks < 8; ++ks) { float p[8];
#pragma unroll
                for (int i = 0; i < 4; ++i) { p[i] = __expf(lg[2 * ks][i] - mx); p[4 + i] = __expf(lg[2 * ks + 1][i] - mx); }
                sum += ((p[0] + p[1]) + (p[2] + p[3])) + ((p[4] + p[5]) + (p[6] + p[7]));
                u32x4 w; w.x = cvt_pk_bf16(p[0], p[1]); w.y = cvt_pk_bf16(p[2], p[3]); w.z = cvt_pk_bf16(p[4], p[5]); w.w = cvt_pk_bf16(p[6], p[7]);
                pa[ks] = __builtin_bit_cast(bf16x8, w); }
            sum += __shfl_xor(sum, 16); sum += __shfl_xor(sum, 32);
            if (kq == 0) ((LAS float*)(L + AL_SUM))[wave * 16 + hd] = sum;
            LDS_WAIT(); CFENCE();
            {
                asm volatile("" : "+v"(lane));
                const int rs = lane >> 3, ch = lane & 7, i16 = lane & 15, tq = i16 >> 2, tp = i16 & 3, kq2 = lane >> 4;
                LAS unsigned char* vb = L + AL_V + wave * 8192;
                const unsigned wr_off = (unsigned)lane * 16u, tr_off = (unsigned)((4 * kq2 + tq) * 128 + 8 * tp);
                f32x4 O[4][4];
#pragma unroll
                for (int n = 0; n < 4; ++n)
#pragma unroll
                    for (int dt = 0; dt < 4; ++dt) O[n][dt] = (f32x4){0.f, 0.f, 0.f, 0.f};
                u32x4 vr[2][4]; int kr[4];
                const bf16_t* vbase = Vb + rb * 256 + 8 * ch;
#pragma unroll
                for (int i = 0; i < 4; ++i) kr[i] = sel[8 * i + rs];
#pragma unroll
                for (int pre = 0; pre < 2; ++pre)
#pragma unroll
                    for (int i = 0; i < 4; ++i) vr[pre][i] = *(const u32x4*)(vbase + (size_t)kr[i] * 256 + pre * 64);
#pragma unroll
                for (int st = 0; st < 32; ++st) {
                    const int ks = st >> 2, n = st & 3;
                    LAS unsigned char* buf = vb + (st & 1) * 4096;
#pragma unroll
                    for (int i = 0; i < 4; ++i) *(LAS u32x4*)(buf + wr_off + i * 1024) = vr[st & 1][i];
                    if (st < 30) { const int ks2 = (st + 2) >> 2, n2 = (st + 2) & 3;
                        if (n2 == 0) {
#pragma unroll
                            for (int i = 0; i < 4; ++i) kr[i] = sel[32 * ks2 + 8 * i + rs]; }
#pragma unroll
                        for (int i = 0; i < 4; ++i) vr[st & 1][i] = *(const u32x4*)(vbase + (size_t)kr[i] * 256 + n2 * 64); }
#pragma unroll
                    for (int dt = 0; dt < 4; ++dt) {
                        const v4i16_t t0 = __builtin_amdgcn_ds_read_tr16_b64_v4i16((LAS v4i16_t*)(buf + tr_off + 32 * dt));
                        const v4i16_t t1 = __builtin_amdgcn_ds_read_tr16_b64_v4i16((LAS v4i16_t*)(buf + tr_off + 2048 + 32 * dt));
                        const bf16x8 bfr = (bf16x8){t0[0], t0[1], t0[2], t0[3], t1[0], t1[1], t1[2], t1[3]};
                        O[n][dt] = __builtin_amdgcn_mfma_f32_16x16x32_bf16(pa[ks], bfr, O[n][dt], 0, 0, 0); }
                    CFENCE();
                }
                const f32x4 sm = *(const LAS f32x4*)(L + AL_SUM + (wave * 16 + 4 * kq2) * 4);
                bf16_t* op = Ob + (rb + t) * 1024 + (4 * kq2) * 64 + i16;
#pragma unroll
                for (int dt = 0; dt < 4; ++dt)
#pragma unroll
                    for (int i = 0; i < 4; ++i) { const float v = kq2 == 0 ? O[0][dt][i] : (kq2 == 1 ? O[1][dt][i] : (kq2 == 2 ? O[2][dt][i] : O[3][dt][i]));
                        op[i * 64 + 16 * dt] = (bf16_t)f2bf(v / sm[i]); }
            }
            LDS_WAIT(); CFENCE();
        }
        __syncthreads();
        }
    }
}

constexpr int SL_BMT = 0;
constexpr int SL_CMA = 4096;
constexpr int SL_AB = 12288;
constexpr int SL_E = 12800;
constexpr int SL_S = 16896;
constexpr int SPITCH = 272;
__device__ __forceinline__ void cmul(float ar, float ai, float br, float bi, float& cr, float& ci) { cr = ar * br - ai * bi; ci = ar * bi + ai * br; }
__device__ __forceinline__ void ssm_phase(Frame& F, const Args& A) {
    LAS unsigned char* L = F.lds;
    const int lane = F.lane, wave = F.wave;
    bf16_t* G = (bf16_t*)(F.ws + WS_ACT);
    for (int un = F.vcu; un < NB * 64; un += F.G) {
        const int b = un >> 6, g = un & 63; const size_t rb = (size_t)b * SEQ;
        __syncthreads();
        if (F.tid < 64) {
            const int p = F.tid;
            const float lr = fminf(A.in[I_SLRE][g * 64 + p], -1e-4f), li = A.in[I_SLIM][g * 64 + p];
            const float step = expf(A.in[I_SLOG][g]);
            const float mag = expf(lr * step); float sn, cs; sincosf(li * step, &sn, &cs);
            const float ar = mag * cs, ai = mag * sn;
            ((LAS float*)(L + SL_AB))[2 * p] = ar; ((LAS float*)(L + SL_AB))[2 * p + 1] = ai;
            const float nr = ar - 1.0f, ni = ai, den = lr * lr + li * li;
            const float cr = (nr * lr + ni * li) / den, ci = (ni * lr - nr * li) / den;
            LAS bf16_t* bm = (LAS bf16_t*)(L + SL_BMT);
#pragma unroll
            for (int c = 0; c < 16; ++c) { const float br = A.in[I_SBRE][((size_t)g * 64 + p) * 16 + c], bi = A.in[I_SBIM][((size_t)g * 64 + p) * 16 + c];
                float xr, xi; cmul(cr, ci, br, bi, xr, xi); bm[p * 16 + c] = (bf16_t)f2bf(xr); bm[(64 + p) * 16 + c] = (bf16_t)f2bf(xi); }
        }
        { LAS bf16_t* cm = (LAS bf16_t*)(L + SL_CMA);
          for (int i = F.tid; i < 32 * 128; i += NTHREADS) { const int c = i >> 7, k = i & 127; float v = 0.f;
              if (c < 16) v = (k < 64) ? A.in[I_SCRE][((size_t)g * 16 + c) * 64 + k] : -A.in[I_SCIM][((size_t)g * 16 + c) * 64 + (k - 64)];
              cm[i] = (bf16_t)f2bf(v); } }
        __syncthreads();
        const int r = lane & 31, hh = lane >> 5;
        bf16x8 bfr[4];
#pragma unroll
        for (int n = 0; n < 4; ++n) bfr[n] = *(const LAS bf16x8*)(L + SL_BMT + ((32 * n + r) * 16 + 8 * hh) * 2);
        bf16x8 cfr[8];
#pragma unroll
        for (int ks = 0; ks < 8; ++ks) cfr[ks] = *(const LAS bf16x8*)(L + SL_CMA + (r * 128 + 16 * ks + 8 * hh) * 2);
        float ar[2], ai[2], a16r[2], a16i[2], a512r[2], a512i[2];
#pragma unroll
        for (int s = 0; s < 2; ++s) { ar[s] = ((LAS float*)(L + SL_AB))[2 * (32 * s + r)]; ai[s] = ((LAS float*)(L + SL_AB))[2 * (32 * s + r) + 1];
            float pr = ar[s], pi = ai[s];
#pragma unroll
            for (int q = 0; q < 4; ++q) { float nr, ni; cmul(pr, pi, pr, pi, nr, ni); pr = nr; pi = ni; }
            a16r[s] = pr; a16i[s] = pi;
#pragma unroll
            for (int q = 0; q < 5; ++q) { float nr, ni; cmul(pr, pi, pr, pi, nr, ni); pr = nr; pi = ni; }
            a512r[s] = pr; a512i[s] = pi; }
        const int tokperm = 16 * ((r >> 2) & 1) + 4 * (r >> 3) + (r & 3);
        const float dsk0 = 0.f; (void)dsk0;
        float cin_r[2] = {0.f, 0.f}, cin_i[2] = {0.f, 0.f};
        LAS unsigned char* Sw = L + SL_S + wave * (32 * SPITCH);
        for (int pass = 0; pass < 2; ++pass) {
            if (pass == 1) {
                __syncthreads();
#pragma unroll
                for (int s = 0; s < 2; ++s) { float cr = 0.f, ci = 0.f;
                    for (int w = 0; w < wave; ++w) { float nr, ni; cmul(a512r[s], a512i[s], cr, ci, nr, ni); cr = nr + ((LAS float*)(L + SL_E))[(w * 64 + 32 * s + r) * 2]; ci = ni + ((LAS float*)(L + SL_E))[(w * 64 + 32 * s + r) * 2 + 1]; }
                    cin_r[s] = cr; cin_i[s] = ci; }
            }
            bf16x8 ufn = *(const bf16x8*)(F.HB + (rb + wave * 512 + tokperm) * DM + 16 * g + 8 * hh);
            for (int tile = 0; tile < 16; ++tile) {
                asm volatile("s_waitcnt vmcnt(0) lgkmcnt(0)" ::: "memory"); __builtin_amdgcn_s_barrier(); asm volatile("" ::: "memory");
                const int tk0 = wave * 512 + tile * 32;
                const bf16x8 uf = ufn;
                if (tile < 15) ufn = *(const bf16x8*)(F.HB + (rb + tk0 + 32 + tokperm) * DM + 16 * g + 8 * hh);

                f32x16 d[4];
#pragma unroll
                for (int n = 0; n < 4; ++n) {
#pragma unroll
                    for (int i = 0; i < 16; ++i) d[n][i] = 0.f;
                    d[n] = __builtin_amdgcn_mfma_f32_32x32x16_bf16(uf, bfr[n], d[n], 0, 0, 0); }
                asm volatile("s_nop 15\n\ts_nop 15\n\ts_nop 15" : "+v"(d[0]), "+v"(d[1]), "+v"(d[2]), "+v"(d[3]));
#pragma unroll
                for (int s = 0; s < 2; ++s) {
                    float sr = hh == 0 ? cin_r[s] : 0.f, si = hh == 0 ? cin_i[s] : 0.f;
#pragma unroll
                    for (int i = 0; i < 16; ++i) { const float nr = ar[s] * sr - ai[s] * si + d[s][i], ni = ar[s] * si + ai[s] * sr + d[2 + s][i]; sr = nr; si = ni; d[s][i] = sr; d[2 + s][i] = si; }
                    const float e0r = __shfl_xor(sr, 32), e0i = __shfl_xor(si, 32);
                    float cr = hh == 1 ? e0r : 0.f, ci = hh == 1 ? e0i : 0.f;
                    if (pass == 1) {
#pragma unroll
                        for (int i = 0; i < 16; ++i) { float nr, ni; cmul(ar[s], ai[s], cr, ci, nr, ni); cr = nr; ci = ni; d[s][i] += cr; d[2 + s][i] += ci; }
                    } else { float nr, ni; cmul(a16r[s], a16i[s], cr, ci, nr, ni); cr = nr; ci = ni; }
                    const float endr = (pass == 1) ? d[s][15] : sr + cr, endi = (pass == 1) ? d[2 + s][15] : si + ci;
                    const float xr = __shfl_xor(endr, 32), xi = __shfl_xor(endi, 32);
                    cin_r[s] = hh == 1 ? endr : xr; cin_i[s] = hh == 1 ? endi : xi;
                }
                if (pass == 1) {
#pragma unroll
                    for (int s = 0; s < 2; ++s)
#pragma unroll
                        for (int i = 0; i < 16; ++i) { *(LAS bf16_t*)(Sw + (16 * hh + i) * SPITCH + (32 * s + r) * 2) = (bf16_t)f2bf(d[s][i]); *(LAS bf16_t*)(Sw + (16 * hh + i) * SPITCH + (64 + 32 * s + r) * 2) = (bf16_t)f2bf(d[2 + s][i]); }
                    LDS_WAIT(); CFENCE();
                    f32x16 y;
#pragma unroll
                    for (int i = 0; i < 16; ++i) y[i] = 0.f;
#pragma unroll
                    for (int ks = 0; ks < 8; ++ks) { const bf16x8 sf = *(const LAS bf16x8*)(Sw + r * SPITCH + (16 * ks + 8 * hh) * 2); y = __builtin_amdgcn_mfma_f32_32x32x16_bf16(cfr[ks], sf, y, 0, 0, 0); }
                    LDS_WAIT(); CFENCE();
                    const size_t trow = rb + tk0 + r;
#pragma unroll
                    for (int q = 0; q < 2; ++q) { const int ch = 16 * g + 8 * q + 4 * hh;
                        const u32x2 hv = *(const u32x2*)(F.HB + trow * DM + ch); const f32x4 dk = *(const f32x4*)(A.in[I_SD] + ch);
                        const float y0 = gelu_tanh_f(y[4 * q + 0] + dk[0] * bflo(hv.x)), y1 = gelu_tanh_f(y[4 * q + 1] + dk[1] * bfhi(hv.x)), y2 = gelu_tanh_f(y[4 * q + 2] + dk[2] * bflo(hv.y)), y3 = gelu_tanh_f(y[4 * q + 3] + dk[3] * bfhi(hv.y));
                        u32x2 w; w.x = pk2(y0, y1); w.y = pk2(y2, y3); *(u32x2*)(G + trow * DM + ch) = w; }
                }
            }
            if (pass == 0) {
                if (hh == 1) {
#pragma unroll
                    for (int s = 0; s < 2; ++s) { ((LAS float*)(L + SL_E))[(wave * 64 + 32 * s + r) * 2] = cin_r[s]; ((LAS float*)(L + SL_E))[(wave * 64 + 32 * s + r) * 2 + 1] = cin_i[s]; } }
                cin_r[0] = cin_r[1] = cin_i[0] = cin_i[1] = 0.f;
            }
        }
    }
}

enum { PH_PRO = 0, PH_NORM0,
       L0_G1, L0_CONV, L0_G2, L0_NORM, L0_F1, L0_F2, L0_NORMN,
       L1_G1, L1_ATTN, L1_G2, L1_NORMR, L1_M1, L1_M2, L1_COMB,
       L2_SSM, L2_G2, L2_NORM, L2_F1, L2_F2, L2_NORMN,
       L3_G1, L3_CONV, L3_G2, L3_NORMR, L3_M1, L3_M2, L3_COMB, NPH };

__device__ __forceinline__ bool fresh_ids(Frame& F) { const int l = lane_id_fresh(); F.lane = l; F.tid = F.wave * 64 + l; return true; }
__global__ void __launch_bounds__(NTHREADS, 2) mega_fwd(Args args) {
    extern __shared__ __attribute__((aligned(16))) unsigned char lds_raw[];
    Frame F;
    F.lds = (LAS unsigned char*)lds_raw;
    volatile LAS unsigned* MISC = (volatile LAS unsigned*)(F.lds + MISC_OFF);
    F.tid = threadIdx.x; F.lane = F.tid & 63; F.wave = __builtin_amdgcn_readfirstlane(F.tid >> 6);
    F.G = gridDim.x; { const int bx = blockIdx.x; F.vcu = (F.G % 8 == 0) ? (bx % 8) * (F.G / 8) + bx / 8 : bx; }
    F.ws = args.ws; F.ctl = (gu32*)(args.ws + WS_CTL); F.out = args.out; F.mod = (const float*)(args.ws + WS_MOD);
    F.HB = (bf16_t*)(args.ws + WS_HB); F.BUF = (bf16_t*)(args.ws + WS_BUF); F.ACT = (bf16_t*)(args.ws + WS_ACT);
    for (int u = F.tid; u < (LDS_BYTES - LDSCTL_OFF) / 4; u += NTHREADS) ((LAS unsigned*)(F.lds + LDSCTL_OFF))[u] = 0u;
    __syncthreads();
    XcdBarrier bar; bar.bar = (unsigned*)(F.ctl + CW_BAR); bar.x = 0; bar.st = nullptr; bar.w = F.wave;
    const int lo = args.ph_lo, hi = args.ph_hi;
    if (hi - lo > 1) bar = xcd_barrier_post((unsigned*)(F.ctl + CW_BAR), MISC + 8, F.wave);
#ifndef PH_ONLY
#define PH_EN(k) true
#else
#define PH_EN(k) ((k) == PH_ONLY)
#endif
#define IN(k) (PH_EN(k) && lo <= (k) && (k) < hi && fresh_ids(F))
#define SEAM(k) do { if (IN(k) && IN((k) + 1)) xcd_barrier(bar); } while (0)
#ifndef PH_REP
#define PH_REP (-1)
#endif
#ifndef PH_REPMASK
#define PH_REPMASK 0ull
#endif
#define REPB(k, ...) do { if (PH_REP == (k) || ((PH_REPMASK >> (k)) & 1ull)) { xcd_barrier(bar); __VA_ARGS__; } } while (0)
    LAS unsigned char* ring = F.lds;
    const int cid = (int)blockIdx.x;
    bf16_t* const WCI = (bf16_t*)(F.ws + WS_WCI); bf16_t* const WCO = (bf16_t*)(F.ws + WS_WCO); bf16_t* const WAI = (bf16_t*)(F.ws + WS_WAI); bf16_t* const WAO = (bf16_t*)(F.ws + WS_WAO);
    bf16_t* const WGL = (bf16_t*)(F.ws + WS_WGL); bf16_t* const WFG = (bf16_t*)(F.ws + WS_WFG); bf16_t* const WFD = (bf16_t*)(F.ws + WS_WFD); bf16_t* const WMG = (bf16_t*)(F.ws + WS_WMG); bf16_t* const WMD = (bf16_t*)(F.ws + WS_WMD);

#define ZEROG ((const float*)(F.ws + 512 * 1024))
    const bool fuseR = (F.G == 256) && FUSE_R;
    const bool fuse = (F.G == 256) && FUSE_N;
#define FUSED_EPI(inst, gatep, xin, nl, ns, hout, asc) ({F.out, (gatep), (xin), args.in[I_NORMG] + (size_t)((nl) * 2 + (ns)) * DM, F.mod + (size_t)(nl) * NB * 6144 + ((ns) ? 3 : 0) * DM, (hout), (float*)(F.ws + WS_XS), F.ctl + CW_PAN + 64 * 64 * (inst), F.ctl + CW_TMO, (asc)})
#define FUSED_RT(inst, gatep, nl, rl, roff, hout, h8_) ({F.out, (gatep), args.in[I_NORMG] + (size_t)((nl) * 2 + 1) * DM, F.mod + (size_t)(nl) * NB * 6144 + 3 * DM, (hout), (float*)(F.ws + WS_XS9), F.ctl + CW_PAN + 64 * 64 * (inst), F.ctl + CW_TMO, \
        args.in[I_RW] + (size_t)(rl) * DM * NEXP, args.in[I_RB] + (rl) * NEXP, F.ctl + CW_CNT + 64 * 8 * (rl), F.ws + (roff), (h8_)})
#define MODP(l, chunk) (F.mod + (size_t)(l) * NB * 6144 + (chunk) * DM)
#define GEMM_STATIC(Aptr, Bptr, Nn, Kk, EpiT, EpiInit) do { pg8::Gemm g{(Aptr), (Bptr), M, (Nn), (Kk), 0, nullptr, nullptr}; pg8::StaticOrder S; S.init(M, (Nn), F.G, cid); EpiT E EpiInit; \
        pg8::gemm_phase<EpiT, pg8::StaticOrder, false>(ring, g, S, E, F.wave); } while (0)
#define GEMM_STATIC8(Aptr, Bptr, Nn, Kk, EpiT, EpiInit) do { pg8::Gemm g{(Aptr), (Bptr), M, (Nn), (Kk), 0, nullptr, nullptr}; pg8::StaticOrder S; S.init(M, (Nn), F.G, cid); EpiT E EpiInit; \
        pg8::gemm_phase<EpiT, pg8::StaticOrder, false, true>(ring, g, S, E, F.wave); } while (0)
#define EPAIR8 pg8::EpiPair<1, (M2_FP8 != 0), (M1_FP8 != 0)>
#define M1_B (M1_FP8 ? 1 : 2)
#define EPAIR8L1 pg8::EpiPair<1, (M2_FP8 != 0), (M1L1_FP8 != 0)>
#define M2_B (M2_FP8 ? 1 : 2)
#define F2_ASC (F2_FP8 ? pg8::W8_INV : 1.0f)
#define GEMM_STATICF(Aptr, Bptr, Nn, Kk, EpiT, EpiInit) do { pg8::Gemm g{(Aptr), (Bptr), M, (Nn), (Kk), 0, nullptr, nullptr}; pg8::StaticOrder S; S.init(M, (Nn), F.G, cid); EpiT E EpiInit; \
        pg8::gemm_phase<EpiT, pg8::StaticOrder, false, (F2_FP8 != 0)>(ring, g, S, E, F.wave); } while (0)
#define EPAIRF pg8::EpiPair<1, (F2_FP8 != 0), false>
#define F0_FP8 (F2_FP8 || F2L0_FP8)
#define F2L0_ASC (F0_FP8 ? pg8::W8_INV : 1.0f)
#define EPAIR0 pg8::EpiPair<1, (F0_FP8 != 0), false>
#define GEMM_STATICF0(Aptr, Bptr, Nn, Kk, EpiT, EpiInit) do { pg8::Gemm g{(Aptr), (Bptr), M, (Nn), (Kk), 0, nullptr, nullptr}; pg8::StaticOrder S; S.init(M, (Nn), F.G, cid); EpiT E EpiInit; \
        pg8::gemm_phase<EpiT, pg8::StaticOrder, false, (F0_FP8 != 0)>(ring, g, S, E, F.wave); } while (0)
#define W8(base, bytes) ((bf16_t*)((unsigned char*)(base) + (size_t)(bytes)))

    if (IN(PH_PRO)) { p0_prologue(F, args); REPB(PH_PRO, p0_prologue(F, args)); } SEAM(PH_PRO);
    if (IN(PH_NORM0)) { thin_phase<4>(F, args, args.in[I_X], 0, 0, 0, 0); REPB(PH_NORM0, thin_phase<4>(F, args, args.in[I_X], 0, 0, 0, 0)); } SEAM(PH_NORM0);

    if (IN(L0_G1)) { GEMM_STATIC(F.HB, WCI, 3072, DM, pg8::EpiConvIn, {F.BUF}); REPB(L0_G1, GEMM_STATIC(F.HB, WCI, 3072, DM, pg8::EpiConvIn, {F.BUF})); } SEAM(L0_G1);
    if (IN(L0_CONV)) { conv_phase(F, args.in[I_CW]); REPB(L0_CONV, conv_phase(F, args.in[I_CW])); } SEAM(L0_CONV);
    if (IN(L0_G2)) { if (fuse) GEMM_STATIC(F.HB, WCO, DM, DM, pg8::EpiResNorm, FUSED_EPI(0, MODP(0, 2), args.in[I_X], 0, 1, (fuse ? F.BUF : F.HB), 1.0f)); else GEMM_STATIC(F.HB, WCO, DM, DM, pg8::EpiRes, ({F.out, MODP(0, 2), args.in[I_X], 1.0f})); } SEAM(L0_G2);
    if (!fuse) { if (IN(L0_NORM)) { thin_phase<4>(F, args, F.out, 0, 1, 0, 0); } SEAM(L0_NORM); }
    if (IN(L0_F1)) { GEMM_STATIC((fuse ? F.BUF : F.HB), WFG, 2 * FF, DM, EPAIR0, ({F.ACT, FF})); REPB(L0_F1, GEMM_STATIC(F.HB, WFG, 2 * FF, DM, EPAIR0, ({F.ACT, FF}))); } SEAM(L0_F1);
    if (IN(L0_F2)) { if (fuse) GEMM_STATICF0(F.ACT, WFD, DM, FF, pg8::EpiResNorm, FUSED_EPI(1, MODP(0, 5), F.out, 1, 0, F.HB, F2L0_ASC)); else GEMM_STATICF0(F.ACT, WFD, DM, FF, pg8::EpiRes, ({F.out, MODP(0, 5), F.out, F2L0_ASC})); } SEAM(L0_F2);
    if (!fuse) { if (IN(L0_NORMN)) { thin_phase<4>(F, args, F.out, 1, 0, 0, 0); } SEAM(L0_NORMN); }

    if (IN(L1_G1)) { GEMM_STATIC(F.HB, WAI, ATT_NP, DM, pg8::EpiAttnIn, ({(bf16_t*)(F.ws + WS_Q), (bf16_t*)(F.ws + WS_K), (bf16_t*)(F.ws + WS_V), (bf16_t*)(F.ws + WS_QI), (bf16_t*)(F.ws + WS_KI), (float*)(F.ws + WS_WI), args.in[I_QG], args.in[I_KG]})); REPB(L1_G1, GEMM_STATIC(F.HB, WAI, ATT_NP, DM, pg8::EpiAttnIn, ({(bf16_t*)(F.ws + WS_Q), (bf16_t*)(F.ws + WS_K), (bf16_t*)(F.ws + WS_V), (bf16_t*)(F.ws + WS_QI), (bf16_t*)(F.ws + WS_KI), (float*)(F.ws + WS_WI), args.in[I_QG], args.in[I_KG]}))); } SEAM(L1_G1);
    if (IN(L1_ATTN)) { attn_phase(F, args); REPB(L1_ATTN, attn_phase(F, args)); } SEAM(L1_ATTN);
    if (IN(L1_G2)) { if (fuseR) GEMM_STATIC((bf16_t*)(F.ws + WS_O), WAO, DM, DM, pg8::EpiResNormRouter, FUSED_RT(3, MODP(1, 2), 1, 0, 0, F.HB, M1L1_FP8)); else GEMM_STATIC((bf16_t*)(F.ws + WS_O), WAO, DM, DM, pg8::EpiRes, ({F.out, MODP(1, 2), F.out, 1.0f})); } SEAM(L1_G2);
    if (!fuseR) { if (IN(L1_NORMR)) { thin_phase<4 | 8>(F, args, F.out, 1, 1, 0, 0); } SEAM(L1_NORMR); }
    if (IN(L1_M1)) { pg8::Gemm g{F.HB, WMG, M, 2 * FF, DM, (size_t)2 * FF * DM * (M1L1_FP8 ? 1 : 2), (const int*)(F.ws + WS_ROWIDX), (const unsigned*)(F.ctl + CW_CNT)}; pg8::MoeOrder S; S.init((const unsigned*)(F.ctl + CW_CNT), 22, F.G, cid);
        EPAIR8L1 E{F.ACT, FF}; pg8::gemm_phase<EPAIR8L1, pg8::MoeOrder, true, (M1L1_FP8 != 0)>(ring, g, S, E, F.wave); REPB(L1_M1, pg8::gemm_phase<EPAIR8L1, pg8::MoeOrder, true, (M1L1_FP8 != 0)>(ring, g, S, E, F.wave)); } SEAM(L1_M1);
    if (IN(L1_M2)) { pg8::Gemm g{F.ACT, WMD, M, DM, FF, (size_t)DM * FF * M2_B, nullptr, nullptr}; pg8::MoeOrder S; S.init((const unsigned*)(F.ctl + CW_CNT), 4, F.G, cid);
        pg8::EpiMoeDn E{F.BUF, (const float*)(F.ws + WS_GATEP)}; pg8::gemm_phase<pg8::EpiMoeDn, pg8::MoeOrder, false, (M2_FP8 != 0)>(ring, g, S, E, F.wave); REPB(L1_M2, pg8::gemm_phase<pg8::EpiMoeDn, pg8::MoeOrder, false, (M2_FP8 != 0)>(ring, g, S, E, F.wave)); } SEAM(L1_M2);
    if (IN(L1_COMB)) { thin_phase<2 | 4>(F, args, F.out, 2, 0, 1, 0); REPB(L1_COMB, thin_phase<2 | 4>(F, args, F.out, 2, 0, -1, 0)); } SEAM(L1_COMB);

    if (IN(L2_SSM)) { ssm_phase(F, args); REPB(L2_SSM, ssm_phase(F, args)); } SEAM(L2_SSM);
    if (IN(L2_G2)) { GEMM_STATIC(F.ACT, WGL, 2048, DM, pg8::EpiGluRes, ({F.out, MODP(2, 2)})); REPB(L2_G2, GEMM_STATIC(F.ACT, WGL, 2048, DM, pg8::EpiGluRes, ({F.out, ZEROG}))); } SEAM(L2_G2);
    if (IN(L2_NORM)) { thin_phase<4>(F, args, F.out, 2, 1, 0, 0); REPB(L2_NORM, thin_phase<4>(F, args, F.out, 2, 1, 0, 0)); } SEAM(L2_NORM);
    if (IN(L2_F1)) { GEMM_STATIC(F.HB, WFG + (size_t)2 * FF * DM, 2 * FF, DM, EPAIRF, ({F.ACT, FF})); REPB(L2_F1, GEMM_STATIC(F.HB, WFG + (size_t)2 * FF * DM, 2 * FF, DM, EPAIRF, ({F.ACT, FF}))); } SEAM(L2_F1);
    if (IN(L2_F2)) { if (fuse) GEMM_STATICF(F.ACT, W8(WFD, (size_t)DM * FF * (F2_FP8 ? 1 : 2)), DM, FF, pg8::EpiResNorm, FUSED_EPI(2, MODP(2, 5), F.out, 3, 0, F.HB, F2_ASC)); else GEMM_STATICF(F.ACT, W8(WFD, (size_t)DM * FF * (F2_FP8 ? 1 : 2)), DM, FF, pg8::EpiRes, ({F.out, MODP(2, 5), F.out, F2_ASC})); } SEAM(L2_F2);
    if (!fuse) { if (IN(L2_NORMN)) { thin_phase<4>(F, args, F.out, 3, 0, 0, 0); } SEAM(L2_NORMN); }

    if (IN(L3_G1)) { GEMM_STATIC(F.HB, WCI + (size_t)3072 * DM, 3072, DM, pg8::EpiConvIn, {F.BUF}); REPB(L3_G1, GEMM_STATIC(F.HB, WCI + (size_t)3072 * DM, 3072, DM, pg8::EpiConvIn, {F.BUF})); } SEAM(L3_G1);
    if (IN(L3_CONV)) { conv_phase(F, args.in[I_CW] + 3 * DM); REPB(L3_CONV, conv_phase(F, args.in[I_CW] + 3 * DM)); } SEAM(L3_CONV);
    if (IN(L3_G2)) { if (fuseR) GEMM_STATIC(F.HB, WCO + (size_t)DM * DM, DM, DM, pg8::EpiResNormRouter, FUSED_RT(4, MODP(3, 2), 3, 1, 2 * MiB, F.BUF, M1_FP8)); else GEMM_STATIC(F.HB, WCO + (size_t)DM * DM, DM, DM, pg8::EpiRes, ({F.out, MODP(3, 2), F.out, 1.0f})); } SEAM(L3_G2);
    if (!fuseR) { if (IN(L3_NORMR)) { thin_phase<4 | 8>(F, args, F.out, 3, 1, 0, 1, 1, 2 * MiB); } SEAM(L3_NORMR); }
    if (IN(L3_M1)) { pg8::Gemm g{(fuseR ? F.BUF : F.HB), W8(WMG, (size_t)8 * 2 * FF * DM * 2), M, 2 * FF, DM, (size_t)2 * FF * DM * M1_B, (const int*)(F.ws + 2 * MiB + WS_ROWIDX), (const unsigned*)(F.ctl + CW_CNT + 512)}; pg8::MoeOrder S; S.init((const unsigned*)(F.ctl + CW_CNT + 512), 22, F.G, cid);
        EPAIR8 E{F.ACT, FF}; pg8::gemm_phase<EPAIR8, pg8::MoeOrder, true, (M1_FP8 != 0)>(ring, g, S, E, F.wave); REPB(L3_M1, pg8::gemm_phase<EPAIR8, pg8::MoeOrder, true, (M1_FP8 != 0)>(ring, g, S, E, F.wave)); } SEAM(L3_M1);
    if (IN(L3_M2)) { pg8::Gemm g{F.ACT, W8(WMD, (size_t)8 * DM * FF * M2_B), M, DM, FF, (size_t)DM * FF * M2_B, nullptr, nullptr}; pg8::MoeOrder S; S.init((const unsigned*)(F.ctl + CW_CNT + 512), 4, F.G, cid);
        pg8::EpiMoeDn E{F.BUF, (const float*)(F.ws + 2 * MiB + WS_GATEP)}; pg8::gemm_phase<pg8::EpiMoeDn, pg8::MoeOrder, false, (M2_FP8 != 0)>(ring, g, S, E, F.wave); REPB(L3_M2, pg8::gemm_phase<pg8::EpiMoeDn, pg8::MoeOrder, false, (M2_FP8 != 0)>(ring, g, S, E, F.wave)); } SEAM(L3_M2);
    if (IN(L3_COMB)) { thin_phase<2>(F, args, F.out, 0, 0, 3, 1, 1, 2 * MiB); }
#undef IN
#undef SEAM
}

extern "C" void kernel_launch(void* const* d_in, const int* in_sizes, int n_in, void* d_out, int out_size, void* d_ws, size_t ws_size, hipStream_t stream) {
    static int grid = 0;
    if (grid == 0) {
        if (n_in != 28 || in_sizes[0] != M * DM || out_size != M * DM || ws_size < WS_END) { fprintf(stderr, "kernel_launch: unexpected shapes / workspace (n_in %d, ws %zu, need %zu)\n", n_in, ws_size, (size_t)WS_END); grid = -1; return; }
        int dev = 0, cus = 0, per_cu = 0;
        if (hipGetDevice(&dev) != hipSuccess || hipDeviceGetAttribute(&cus, hipDeviceAttributeMultiprocessorCount, dev) != hipSuccess) { grid = -1; return; }
        if (hipFuncSetAttribute((const void*)mega_fwd, hipFuncAttributeMaxDynamicSharedMemorySize, LDS_BYTES) != hipSuccess) { fprintf(stderr, "kernel_launch: hipFuncSetAttribute failed\n"); grid = -1; return; }
        if (hipOccupancyMaxActiveBlocksPerMultiprocessor(&per_cu, (const void*)mega_fwd, NTHREADS, LDS_BYTES) != hipSuccess || per_cu < 1) fprintf(stderr, "kernel_launch: occupancy query reports %d\n", per_cu);
        (void)hipGetLastError();
        grid = cus;
    }
    if (grid < 0) return;
    (void)hipMemsetAsync((char*)d_ws + WS_CTL, 0, CTL_ZERO_BYTES, stream);
    Args a{};
    for (int i = 0; i < 28; ++i) a.in[i] = (const float*)d_in[i];
    a.out = (float*)d_out; a.ws = (unsigned char*)d_ws;
#if MK_PER_PHASE
    for (int p = 0; p < NPH; ++p) { a.ph_lo = p; a.ph_hi = p + 1; hipLaunchKernelGGL(mega_fwd, dim3(grid), dim3(NTHREADS), LDS_BYTES, stream, a); }
#else
    a.ph_lo = 0; a.ph_hi = NPH; hipLaunchKernelGGL(mega_fwd, dim3(grid), dim3(NTHREADS), LDS_BYTES, stream, a);
#endif
}
```

```cpp
#include <hip/hip_runtime.h>
#include <cstdio>
#include <cstdint>
#include <cmath>

#ifndef MK_PER_PHASE
#define MK_PER_PHASE 0
#endif

#define GAS __attribute__((address_space(1)))
#define LAS __attribute__((address_space(3)))
typedef unsigned short bf16_t;
typedef short bf16x8 __attribute__((ext_vector_type(8)));
typedef float f32x4 __attribute__((ext_vector_type(4)));
typedef float f32x2 __attribute__((ext_vector_type(2)));
typedef float f32x16 __attribute__((ext_vector_type(16)));
typedef unsigned u32x4 __attribute__((ext_vector_type(4)));
typedef unsigned u32x2 __attribute__((ext_vector_type(2)));
typedef GAS unsigned gu32;
#define RLX_AGENT __ATOMIC_RELAXED, __HIP_MEMORY_SCOPE_AGENT
#define LDS_WAIT() asm volatile("s_waitcnt lgkmcnt(0)" ::: "memory")
#define VM_WAIT() asm volatile("s_waitcnt vmcnt(0)" ::: "memory")
#define CFENCE() asm volatile("" ::: "memory")

constexpr int DM = 1024, NB = 4, SEQ = 4096, M = NB * SEQ, FF = 2816, NEXP = 8;
constexpr int NH = 16, NKV = 4, HD = 64, IH = 8, IDIM = 64, TOPK = 256;
constexpr int ATT_N = 2120, ATT_NP = 2304;
constexpr float EPS = 1e-6f;
constexpr int NWAVES = 8, NTHREADS = 512;

__device__ __forceinline__ unsigned f2bf(float f) { unsigned u = __builtin_bit_cast(unsigned, f); return (u + 0x7fffu + ((u >> 16) & 1u)) >> 16; }
__device__ __forceinline__ unsigned pk2(float lo, float hi) { return f2bf(lo) | (f2bf(hi) << 16); }
__device__ __forceinline__ unsigned cvt_pk_bf16(float lo, float hi) { unsigned r; asm volatile("v_cvt_pk_bf16_f32 %0, %1, %2" : "=v"(r) : "v"(lo), "v"(hi)); return r; }
__device__ __forceinline__ float bflo(unsigned u) { return __uint_as_float(u << 16); }
__device__ __forceinline__ float bfhi(unsigned u) { return __uint_as_float(u & 0xffff0000u); }
__device__ __forceinline__ float wave_sum(float v) {
#pragma unroll
    for (int o = 1; o < 64; o <<= 1) v += __shfl_xor(v, o);
    return v;
}
__device__ __forceinline__ float fast_rcp(float x) { return __builtin_amdgcn_rcpf(x); }
__device__ __forceinline__ float silu_f(float g) { return g * fast_rcp(1.f + __expf(-g)); }
__device__ __forceinline__ float sigmoid_f(float g) { return fast_rcp(1.f + __expf(-g)); }
__device__ __forceinline__ float gelu_tanh_f(float y) { const float z = 0.7978845608028654f * (y + 0.044715f * y * y * y); const float t = 1.f - 2.f * fast_rcp(__expf(2.f * z) + 1.f); return 0.5f * y * (1.f + t); }

constexpr size_t WS_ROWIDX_B = 2u << 20, WS_GATEP_B = (2u << 20) + 512 * 1024, WS_SLOT_B = 3u << 20;
__device__ __forceinline__ int lane_id_fresh() { int l; asm volatile("v_mbcnt_lo_u32_b32 %0, -1, 0\n\tv_mbcnt_hi_u32_b32 %0, -1, %0" : "=v"(l)); return l; }
#ifndef FUSE_R
#define FUSE_R 1
#endif
#ifndef FUSE_N
#define FUSE_N 1
#endif
#ifndef M2_FP8
#define M2_FP8 1
#endif
#ifndef F1L0_FP8
#define F1L0_FP8 1
#endif
#ifndef M1L1_FP8
#define M1L1_FP8 1
#endif
#ifndef M1_FP8
#define M1_FP8 1
#endif
#ifndef F2L0_FP8
#define F2L0_FP8 1
#endif
#ifndef F2_FP8
#define F2_FP8 1
#endif
namespace pg8 {
constexpr int BM = 256, BK = 64, HALF = 128, HTB = HALF * BK * 2, STAGE_BYTES = 8 * HTB, NXCD = 8, WGM = 8;
__host__ __device__ __forceinline__ int lds_byte(int r, int c) { const int st = (r >> 4) * 2 + (c >> 5), rr = r & 15, cc = c & 31, ob = rr * 64 + cc * 2; return st * 1024 + (ob ^ (((ob >> 9) & 1) << 5)); }
__host__ __device__ __forceinline__ void stage_rc(int b, int& R, int& C) { const int st = b / 1024, sb = b % 1024, swz = sb ^ (((sb >> 9) & 1) << 5); R = (st >> 1) * 16 + swz / 64; C = (st & 1) * 32 + (swz % 64) / 2; }
__host__ __device__ __forceinline__ int perm32(int rho) { const int n = rho >> 4, i = rho & 15; return 8 * (i >> 2) + 4 * n + (i & 3); }

struct Unit { int pm, pn, e, aux; };
struct Gemm { const bf16_t* A; const bf16_t* Bt; int M, N, K; size_t bstride_e; const int* rowidx; const unsigned* cnt; };

struct StaticOrder {
    int nM, nN, nwg, G, c;
    __device__ __forceinline__ void init(int M_, int N_, int G_, int c_) { nM = M_ / BM; nN = N_ / BM; nwg = nM * nN; G = G_; c = c_; }
    __device__ __forceinline__ bool next(int i, Unit& u) const {
        const long L = (long)i * G + c; if (L >= nwg) return false;
        int wgid = (int)L; { const int q = nwg / NXCD, r = nwg % NXCD, xcd = wgid % NXCD, off = wgid / NXCD; wgid = (xcd < r ? xcd * (q + 1) : r * (q + 1) + (xcd - r) * q) + off; }
        const int nig = WGM * nN, gid = wgid / nig, fm = gid * WGM, gsz = (nM - fm) < WGM ? (nM - fm) : WGM;
        u.pm = fm + ((wgid % nig) % gsz); u.pn = (wgid % nig) / gsz; u.e = 0; u.aux = 0; return true;
    }
};
struct MoeOrder {
    int T1, T2, T3, T4, T5, T6, T7, T8, NT, W, r, lo, ntl;
    static constexpr int RG = 4;
    __device__ __forceinline__ void init(const unsigned* cnt, int NT_, int G_, int c_) {
        int t[9]; int acc = 0;
#pragma unroll
        for (int e = 0; e < 8; ++e) { t[e] = acc; acc += (int)((__hip_atomic_load(cnt + 64 * e, RLX_AGENT) + 255u) >> 8); }
        t[8] = acc; T1 = t[1]; T2 = t[2]; T3 = t[3]; T4 = t[4]; T5 = t[5]; T6 = t[6]; T7 = t[7]; T8 = t[8]; NT = NT_;
        if (G_ % 8 == 0) { const int xv = c_ % 8; W = G_ / 8; r = c_ / 8; lo = (T8 * xv) / 8; ntl = (T8 * (xv + 1)) / 8 - lo; }
        else { W = G_; r = c_; lo = 0; ntl = T8; }
    }
    __device__ __forceinline__ bool next(int i, Unit& u) const {
        const int q = i * W + r; if (q >= ntl * NT) return false;
        const int nig = RG * NT, gid = q / nig, fm = gid * RG, gsz = (ntl - fm) < RG ? (ntl - fm) : RG, w = q - gid * nig;
        const int tt = lo + fm + (w % gsz), pn = w / gsz;
        int e = 0, te = 0;
        if (tt >= T1) { e = 1; te = T1; } if (tt >= T2) { e = 2; te = T2; } if (tt >= T3) { e = 3; te = T3; } if (tt >= T4) { e = 4; te = T4; }
        if (tt >= T5) { e = 5; te = T5; } if (tt >= T6) { e = 6; te = T6; } if (tt >= T7) { e = 7; te = T7; }
        u.pm = tt; u.pn = pn; u.e = e; u.aux = e * 16384 + 256 * (tt - te); return true;
    }
};

typedef int v8i32 __attribute__((ext_vector_type(8)));
typedef int v4i32 __attribute__((ext_vector_type(4)));
constexpr float W8_MUL = 32.0f, W8_INV = 1.0f / 32.0f;
__device__ __forceinline__ void mfma8(f32x4& c, const v8i32 a, const v8i32 b) { asm volatile("v_mfma_f32_16x16x128_f8f6f4 %0, %1, %2, %0" : "+v"(c) : "v"(a), "v"(b)); }
__device__ __forceinline__ v8i32 cat8(const bf16x8 a, const bf16x8 b) { return __builtin_shufflevector(__builtin_bit_cast(v4i32, a), __builtin_bit_cast(v4i32, b), 0, 1, 2, 3, 4, 5, 6, 7); }
template <class Epi, class Sched, bool GATHER, bool FP8 = false>
__device__ __forceinline__ void gemm_phase(LAS unsigned char* lds, const Gemm g, const Sched& S, const Epi& E, const int wid) {
    const int lane = lane_id_fresh(), tid = wid * 64 + lane, wr = wid >> 2, wc = wid & 3, fr = lane & 15, fq = lane >> 4;
    const int K = FP8 ? g.K / 2 : g.K, nt = K / BK;
    unsigned voffB[2]; int stR[2], stC[2];
#pragma unroll
    for (int i = 0; i < 2; ++i) { int R, C; stage_rc(tid * 16 + i * 8192, R, C); const int Rb = (R & ~31) + perm32(R & 31);
        stR[i] = R; stC[i] = C; voffB[i] = (unsigned)(Rb * K + C) * 2u; }
    const size_t kstep = (size_t)(BK * 2);
    const size_t hstep = (size_t)HALF * K * 2;
    const size_t tstep = 2 * hstep;
    const unsigned ldsw = (unsigned)wid * 1024u;
    const int aoff = lds_byte(wr * 64 + fr, fq * 8), boff = lds_byte(wc * 32 + fr, fq * 8);
#define PG8_SA(b, h) (((b) * 2 + (h)) * HTB)
#define PG8_SB(b, h) ((4 + (b) * 2 + (h)) * HTB)
#define PG8_STAGE(bufoff, gbase, voff) do { _Pragma("unroll") for (int _i = 0; _i < 2; ++_i) \
        __builtin_amdgcn_global_load_lds((const unsigned*)((const char*)(gbase) + (voff)[_i]), (LAS unsigned*)(lds + (bufoff) + ldsw + _i * 8192), 16, 0, 0); } while (0)
#define PG8_LDA(dst, b, h) do { _Pragma("unroll") for (int m = 0; m < 4; ++m) _Pragma("unroll") for (int k = 0; k < 2; ++k) dst[m][k] = *(const LAS bf16x8*)(lds + PG8_SA(b, h) + aoff + m * 2048 + k * 1024); } while (0)
#define PG8_LDB(dst, b, h) do { _Pragma("unroll") for (int n = 0; n < 2; ++n) _Pragma("unroll") for (int k = 0; k < 2; ++k) dst[n][k] = *(const LAS bf16x8*)(lds + PG8_SB(b, h) + boff + n * 2048 + k * 1024); } while (0)
#define PG8_MMA(ai, bj, At, Bt) do { __builtin_amdgcn_s_setprio(1); _Pragma("unroll") for (int m = 0; m < 4; ++m) _Pragma("unroll") for (int n = 0; n < 2; ++n) { \
        if (FP8) mfma8(acc[ai][bj][m][n], cat8(Bt[n][0], Bt[n][1]), cat8(At[m][0], At[m][1])); \
        else { _Pragma("unroll") for (int k = 0; k < 2; ++k) acc[ai][bj][m][n] = __builtin_amdgcn_mfma_f32_16x16x32_bf16(Bt[n][k], At[m][k], acc[ai][bj][m][n], 0, 0, 0); } } \
        __builtin_amdgcn_s_setprio(0); } while (0)
#define PG8_MMA_END(At, B0, B1) do { if (FP8) { asm volatile("s_nop 15\n\ts_nop 15\n\ts_nop 15\n\ts_nop 15" :: "v"(cat8(At[0][0], At[0][1])), "v"(cat8(At[1][0], At[1][1])), "v"(cat8(At[2][0], At[2][1])), "v"(cat8(At[3][0], At[3][1])), \
        "v"(cat8(B0[0][0], B0[0][1])), "v"(cat8(B0[1][0], B0[1][1])), "v"(cat8(B1[0][0], B1[0][1])), "v"(cat8(B1[1][0], B1[1][1]))); } } while (0)
#define PG8_WAIT_V(n) asm volatile("s_waitcnt vmcnt(" #n ")" ::: "memory")
#define PG8_WAIT_L(n) asm volatile("s_waitcnt lgkmcnt(" #n ")" ::: "memory")
#define PG8_BAR __builtin_amdgcn_s_barrier()
#define PG8_SCHED __builtin_amdgcn_sched_barrier(0)
#define PG8_AOFFS(v, U) do { _Pragma("unroll") for (int _h = 0; _h < 2; ++_h) _Pragma("unroll") for (int _i = 0; _i < 2; ++_i) { \
        if (GATHER) { const int _loc = ((U).aux & 16383) + _h * HALF + stR[_i]; const int _e = (U).aux >> 14; \
            const int _row = (_loc < (int)g.cnt[64 * _e]) ? g.rowidx[(U).aux + _h * HALF + stR[_i]] : 0; \
            v[_h][_i] = (unsigned)(_row * K + stC[_i]) * 2u; } \
        else v[_h][_i] = (unsigned)((_h * HALF + stR[_i]) * K + stC[_i]) * 2u; } } while (0)
    int cn8[8];
#pragma unroll
    for (int e = 0; e < 8; ++e) cn8[e] = GATHER ? __builtin_amdgcn_readfirstlane((int)g.cnt[64 * e]) : 0;
    Unit cur, nxt; int ui = 0;
    if (!S.next(0, cur)) return;
    f32x4 acc[2][2][4][2];
#pragma unroll
    for (int a = 0; a < 2; ++a)
#pragma unroll
        for (int b = 0; b < 2; ++b)
#pragma unroll
            for (int m = 0; m < 4; ++m)
#pragma unroll
                for (int n = 0; n < 2; ++n) acc[a][b][m][n] = (f32x4){0.f, 0.f, 0.f, 0.f};
    bf16x8 At[4][2], B0[2][2], B1[2][2];
    unsigned vAc[2][2], vAn[2][2];
    PG8_AOFFS(vAc, cur);
    const char* cA = (const char*)g.A + (GATHER ? (size_t)0 : (size_t)cur.pm * tstep);
    const char* cB = (const char*)g.Bt + (size_t)cur.e * g.bstride_e + (size_t)cur.pn * tstep;
    PG8_STAGE(PG8_SB(0, 0), cB, voffB); PG8_STAGE(PG8_SB(0, 1), cB + hstep, voffB); PG8_STAGE(PG8_SA(0, 0), cA, vAc[0]); PG8_STAGE(PG8_SA(0, 1), cA, vAc[1]);
    if (wr == 1) PG8_BAR;
    PG8_WAIT_V(2); PG8_BAR;
    PG8_STAGE(PG8_SB(1, 0), cB + kstep, voffB); PG8_STAGE(PG8_SA(1, 0), cA + kstep, vAc[0]); PG8_STAGE(PG8_SB(1, 1), cB + hstep + kstep, voffB);
    PG8_WAIT_V(6); PG8_BAR;
    for (;;) {
        const bool has_next = S.next(ui + 1, nxt);
        const char* nA = cA; const char* nB = cB;
        int rn[2][2];
        if (has_next) { if (GATHER) {
#pragma unroll
                for (int h = 0; h < 2; ++h)
#pragma unroll
                    for (int i = 0; i < 2; ++i) rn[h][i] = g.rowidx[nxt.aux + h * HALF + stR[i]]; }
            else PG8_AOFFS(vAn, nxt);
            nA = (const char*)g.A + (GATHER ? (size_t)0 : (size_t)nxt.pm * tstep); nB = (const char*)g.Bt + (size_t)nxt.e * g.bstride_e + (size_t)nxt.pn * tstep; }
        else {
#pragma unroll
            for (int h = 0; h < 2; ++h)
#pragma unroll
                for (int i = 0; i < 2; ++i) vAn[h][i] = vAc[h][i];
        }
#pragma nounroll
        for (int t = 0; t < nt; t += 2) {
            const bool last = (t == nt - 2);
            const char* a1 = cA + (size_t)(t + 1) * kstep;
            const char* a2 = last ? nA : cA + (size_t)(t + 2) * kstep; const char* b2 = last ? nB : cB + (size_t)(t + 2) * kstep;
            const char* a3 = a2 + kstep; const char* b3 = b2 + kstep;
            if (GATHER && last && has_next) { const int _e = nxt.aux >> 14;
                const int _cn = _e == 0 ? cn8[0] : _e == 1 ? cn8[1] : _e == 2 ? cn8[2] : _e == 3 ? cn8[3] : _e == 4 ? cn8[4] : _e == 5 ? cn8[5] : _e == 6 ? cn8[6] : cn8[7];
#pragma unroll
                for (int h = 0; h < 2; ++h)
#pragma unroll
                    for (int i = 0; i < 2; ++i) { int r_ = rn[h][i]; asm volatile("" : "+v"(r_)); const int _loc = (nxt.aux & 16383) + h * HALF + stR[i];
                        r_ = _loc < _cn ? r_ : 0; vAn[h][i] = (unsigned)(r_ * K + stC[i]) * 2u; } }
            unsigned v2[2][2];
#pragma unroll
            for (int h = 0; h < 2; ++h)
#pragma unroll
                for (int i = 0; i < 2; ++i) v2[h][i] = last ? vAn[h][i] : vAc[h][i];
            PG8_LDB(B0, 0, 0); PG8_LDB(B1, 0, 1); PG8_SCHED; PG8_LDA(At, 0, 0); PG8_STAGE(PG8_SA(1, 1), a1, vAc[1]);
            PG8_WAIT_V(8); PG8_WAIT_L(0); PG8_BAR; PG8_MMA(0, 0, At, B0); PG8_MMA(0, 1, At, B1); PG8_MMA_END(At, B0, B1); PG8_BAR; PG8_SCHED;
            PG8_LDA(At, 0, 1); PG8_STAGE(PG8_SB(0, 0), b2, voffB); PG8_STAGE(PG8_SB(0, 1), b2 + hstep, voffB); PG8_STAGE(PG8_SA(0, 0), a2, v2[0]);
            PG8_WAIT_V(8); PG8_WAIT_L(0); PG8_BAR; PG8_MMA(1, 0, At, B0); PG8_MMA(1, 1, At, B1); PG8_MMA_END(At, B0, B1); PG8_BAR; PG8_SCHED;
            PG8_LDB(B0, 1, 0); PG8_LDB(B1, 1, 1); PG8_SCHED; PG8_LDA(At, 1, 0); PG8_STAGE(PG8_SA(0, 1), a2, v2[1]);
            PG8_WAIT_V(8); PG8_WAIT_L(0); PG8_BAR; PG8_MMA(0, 0, At, B0); PG8_MMA(0, 1, At, B1); PG8_MMA_END(At, B0, B1); PG8_BAR; PG8_SCHED;
            PG8_LDA(At, 1, 1); PG8_STAGE(PG8_SB(1, 0), b3, voffB); PG8_STAGE(PG8_SB(1, 1), b3 + hstep, voffB); PG8_STAGE(PG8_SA(1, 0), a3, v2[0]);
            PG8_WAIT_V(8); PG8_WAIT_L(0); PG8_BAR; PG8_MMA(1, 0, At, B0); PG8_MMA(1, 1, At, B1); PG8_MMA_END(At, B0, B1); PG8_BAR; PG8_SCHED;
        }
        if (wr == 0) PG8_BAR;
        if (FP8) asm volatile("s_nop 15\n\ts_nop 15\n\ts_nop 15\n\ts_nop 15\n\ts_nop 15\n\ts_nop 15" ::: "memory");
        if constexpr (!Epi::FUSED) E(acc, cur, wr, wc, fr, fq);
        if (!has_next) break;
#pragma unroll
        for (int a = 0; a < 2; ++a)
#pragma unroll
            for (int b = 0; b < 2; ++b)
#pragma unroll
                for (int m = 0; m < 4; ++m)
#pragma unroll
                    for (int n = 0; n < 2; ++n) acc[a][b][m][n] = (f32x4){0.f, 0.f, 0.f, 0.f};
        cur = nxt; cA = nA; cB = nB; ++ui;
#pragma unroll
        for (int h = 0; h < 2; ++h)
#pragma unroll
            for (int i = 0; i < 2; ++i) vAc[h][i] = vAn[h][i];
        if (wr == 1) PG8_BAR;
    }
    PG8_WAIT_V(0);
    PG8_BAR;
    if constexpr (Epi::FUSED) E.fused(acc, cur, wr, wc, fr, fq, lds, wid, lane);
#undef PG8_SA
#undef PG8_SB
#undef PG8_STAGE
#undef PG8_LDA
#undef PG8_LDB
#undef PG8_MMA
#undef PG8_MMA_END
#undef PG8_WAIT_V
#undef PG8_WAIT_L
#undef PG8_BAR
#undef PG8_SCHED
#undef PG8_AOFFS
}

__device__ __forceinline__ f32x4 ldx16(const float* p) { const GAS unsigned long long* q = (const GAS unsigned long long*)p; const unsigned long long a = __hip_atomic_load(q, RLX_AGENT), c = __hip_atomic_load(q + 1, RLX_AGENT);
    return (f32x4){__uint_as_float((unsigned)a), __uint_as_float((unsigned)(a >> 32)), __uint_as_float((unsigned)c), __uint_as_float((unsigned)(c >> 32))}; }
typedef f32x4 Acc[2][2][4][2];
__device__ __forceinline__ u32x4 pack8(const f32x4 a, const f32x4 b) { u32x4 w; w.x = cvt_pk_bf16(a[0], a[1]); w.y = cvt_pk_bf16(a[2], a[3]); w.z = cvt_pk_bf16(b[0], b[1]); w.w = cvt_pk_bf16(b[2], b[3]); return w; }

template <int MODE, bool OUT8 = false, bool SC8 = OUT8> struct EpiPair {
    static constexpr bool FUSED = false;
    bf16_t* O; int ldo;
    __device__ __forceinline__ void operator()(const Acc& acc, const Unit& u, int wr, int wc, int fr, int fq) const {
        const int row0 = u.pm * BM + wr * 64 + fr, col0 = u.pn * HALF + wc * 32 + 8 * fq;
#pragma unroll
        for (int ai = 0; ai < 2; ++ai)
#pragma unroll
            for (int m = 0; m < 4; ++m) { f32x4 r0, r1;
#pragma unroll
                for (int e = 0; e < 4; ++e) { const float sc8 = SC8 ? W8_INV : 1.0f; const float a0 = acc[ai][0][m][0][e] * sc8, a1 = acc[ai][0][m][1][e] * sc8, b0 = acc[ai][1][m][0][e] * sc8, b1 = acc[ai][1][m][1][e] * sc8;
                    r0[e] = (MODE == 1 ? silu_f(a0) : a0) * b0; r1[e] = (MODE == 1 ? silu_f(a1) : a1) * b1; }
                if (OUT8) { u32x2 w; int t0 = 0, t1 = 0; t0 = __builtin_amdgcn_cvt_pk_fp8_f32(r0[0], r0[1], t0, false); t0 = __builtin_amdgcn_cvt_pk_fp8_f32(r0[2], r0[3], t0, true);
                    t1 = __builtin_amdgcn_cvt_pk_fp8_f32(r1[0], r1[1], t1, false); t1 = __builtin_amdgcn_cvt_pk_fp8_f32(r1[2], r1[3], t1, true); w.x = (unsigned)t0; w.y = (unsigned)t1;
                    *(u32x2*)((unsigned char*)O + (size_t)(row0 + ai * HALF + m * 16) * ldo + col0) = w; }
                else *(u32x4*)(O + (size_t)(row0 + ai * HALF + m * 16) * ldo + col0) = pack8(r0, r1); }
    }
};
struct EpiConvIn {
    static constexpr bool FUSED = false;
    bf16_t* UB;
    __device__ __forceinline__ void operator()(const Acc& acc, const Unit& u, int wr, int wc, int fr, int fq) const {
        const int row0 = u.pm * BM + wr * 64 + fr;
        if (u.pn < 8) { EpiPair<0, false, false> P{UB, 2048}; P(acc, u, wr, wc, fr, fq); }
        else { const int col0 = 1024 + (u.pn - 8) * BM + wc * 32 + 8 * fq;
#pragma unroll
            for (int ai = 0; ai < 2; ++ai)
#pragma unroll
                for (int m = 0; m < 4; ++m)
#pragma unroll
                    for (int bj = 0; bj < 2; ++bj) *(u32x4*)(UB + (size_t)(row0 + ai * HALF + m * 16) * 2048 + col0 + bj * HALF) = pack8(acc[ai][bj][m][0], acc[ai][bj][m][1]); }
    }
};
struct EpiRes {
    static constexpr bool FUSED = false;
    float* X; const float* gate; const float* Xin; float asc;
    __device__ __forceinline__ void operator()(const Acc& acc, const Unit& u, int wr, int wc, int fr, int fq) const {
        const int row0 = u.pm * BM + wr * 64 + fr, col0 = u.pn * BM + wc * 32 + 8 * fq; const int b = (u.pm * BM) / SEQ;
        f32x4 gv[2][2];
#pragma unroll
        for (int bj = 0; bj < 2; ++bj)
#pragma unroll
            for (int n = 0; n < 2; ++n) gv[bj][n] = *(const f32x4*)(gate + (size_t)b * 6144 + col0 + bj * HALF + 4 * n) * asc;
#pragma unroll
        for (int ai = 0; ai < 2; ++ai) {
            f32x4 xv[4][2][2];
#pragma unroll
            for (int m = 0; m < 4; ++m) { const float* ri = Xin + (size_t)(row0 + ai * HALF + m * 16) * DM + col0;
#pragma unroll
                for (int bj = 0; bj < 2; ++bj)
#pragma unroll
                    for (int n = 0; n < 2; ++n) xv[m][bj][n] = ldx16(ri + bj * HALF + 4 * n); }
            asm volatile("" ::: "memory");
#pragma unroll
            for (int m = 0; m < 4; ++m) { float* rp = X + (size_t)(row0 + ai * HALF + m * 16) * DM + col0;
#pragma unroll
                for (int bj = 0; bj < 2; ++bj)
#pragma unroll
                    for (int n = 0; n < 2; ++n) *(f32x4*)(rp + bj * HALF + 4 * n) = xv[m][bj][n] + gv[bj][n] * acc[ai][bj][m][n]; }
            asm volatile("" ::: "memory");
        }
    }
};
struct EpiResNorm {
    static constexpr bool FUSED = true;
    float* X; const float* gate; const float* Xin; const float* ng; const float* shb; bf16_t* H; float* xs; gu32* cnt; gu32* tmo; float asc; int h8;
    __device__ __forceinline__ void fused(Acc& acc, const Unit& u, int wr, int wc, int fr, int fq, LAS unsigned char* lds, int wid, int lane) const {
        const int row0 = u.pm * BM + wr * 64 + fr, col0 = u.pn * BM + wc * 32 + 8 * fq; const int b = (u.pm * BM) / SEQ;
        LAS float* P = (LAS float*)lds; LAS float* S = (LAS float*)(lds + 4096);
        { f32x4 gv[2][2];
#pragma unroll
          for (int bj = 0; bj < 2; ++bj)
#pragma unroll
              for (int n = 0; n < 2; ++n) gv[bj][n] = *(const f32x4*)(gate + (size_t)b * 6144 + col0 + bj * HALF + 4 * n) * asc;
#pragma unroll
          for (int ai = 0; ai < 2; ++ai) {
              f32x4 xv[4][2][2];
#pragma unroll
              for (int m = 0; m < 4; ++m) { const float* ri = Xin + (size_t)(row0 + ai * HALF + m * 16) * DM + col0;
#pragma unroll
                  for (int bj = 0; bj < 2; ++bj)
#pragma unroll
                      for (int n = 0; n < 2; ++n) xv[m][bj][n] = ldx16(ri + bj * HALF + 4 * n); }
              asm volatile("" ::: "memory");
#pragma unroll
              for (int m = 0; m < 4; ++m) { float* rp = X + (size_t)(row0 + ai * HALF + m * 16) * DM + col0; float ss = 0.f;
#pragma unroll
                  for (int bj = 0; bj < 2; ++bj)
#pragma unroll
                      for (int n = 0; n < 2; ++n) { const f32x4 x = xv[m][bj][n] + gv[bj][n] * acc[ai][bj][m][n]; acc[ai][bj][m][n] = x; *(f32x4*)(rp + bj * HALF + 4 * n) = x;
                          ss += (x[0] * x[0] + x[1] * x[1]) + (x[2] * x[2] + x[3] * x[3]); }
                  ss += __shfl_xor(ss, 16); ss += __shfl_xor(ss, 32);
                  if (fq == 0) P[(ai * HALF + wr * 64 + m * 16 + fr) * 4 + wc] = ss; }
              asm volatile("" ::: "memory");
          } }
        asm volatile("s_waitcnt lgkmcnt(0)" ::: "memory"); __builtin_amdgcn_s_barrier(); asm volatile("" ::: "memory");
        const int tid = wid * 64 + lane;
        if (tid < 256) { const f32x4 p4 = *(const LAS f32x4*)(P + tid * 4); const float sp = (p4[0] + p4[1]) + (p4[2] + p4[3]);
            __hip_atomic_store((gu32*)xs + ((size_t)(u.pm * BM + tid) * 4 + u.pn), __float_as_uint(sp), RLX_AGENT); }
        asm volatile("s_waitcnt vmcnt(0)" ::: "memory");
        if (wid < 4 && lane == 0) __hip_atomic_fetch_add(cnt + 64 * u.pm, 1u, RLX_AGENT);
        if (wid == 0) { unsigned spins = 0;
            while ((unsigned)__builtin_amdgcn_readfirstlane(__hip_atomic_load(cnt + 64 * u.pm, RLX_AGENT)) < 16u) { __builtin_amdgcn_s_sleep(2);
                if (++spins > (1u << 20)) { if (lane == 0) __hip_atomic_store(tmo, 1u, RLX_AGENT); break; } } }
        asm volatile("s_waitcnt vmcnt(0) lgkmcnt(0)" ::: "memory"); __builtin_amdgcn_s_barrier(); asm volatile("" ::: "memory");
        if (tid < 256) { const GAS unsigned long long* q = (const GAS unsigned long long*)xs + (size_t)(u.pm * BM + tid) * 2;
            const unsigned long long a = __hip_atomic_load(q, RLX_AGENT), c = __hip_atomic_load(q + 1, RLX_AGENT);
            const float tot = (__uint_as_float((unsigned)a) + __uint_as_float((unsigned)(a >> 32))) + (__uint_as_float((unsigned)c) + __uint_as_float((unsigned)(c >> 32)));
            S[tid] = 1.0f / sqrtf(tot * (1.0f / DM) + EPS); }
        asm volatile("s_waitcnt vmcnt(0) lgkmcnt(0)" ::: "memory"); __builtin_amdgcn_s_barrier(); asm volatile("" ::: "memory");
        f32x4 gm[2][2], sf[2][2];
#pragma unroll
        for (int bj = 0; bj < 2; ++bj)
#pragma unroll
            for (int n = 0; n < 2; ++n) { const int c = col0 + bj * HALF + 4 * n; const f32x4 g4 = *(const f32x4*)(ng + c), s1 = *(const f32x4*)(shb + (size_t)b * 6144 + DM + c);
                gm[bj][n] = g4 * (s1 + 1.0f); sf[bj][n] = *(const f32x4*)(shb + (size_t)b * 6144 + c); }
#pragma unroll
        for (int ai = 0; ai < 2; ++ai)
#pragma unroll
            for (int m = 0; m < 4; ++m) { const float r = S[ai * HALF + wr * 64 + m * 16 + fr]; bf16_t* hp = H + (size_t)(row0 + ai * HALF + m * 16) * DM + col0;
#pragma unroll
                for (int bj = 0; bj < 2; ++bj) { const f32x4 h0 = (acc[ai][bj][m][0] * r) * gm[bj][0] + sf[bj][0], h1 = (acc[ai][bj][m][1] * r) * gm[bj][1] + sf[bj][1];
                    if (F1L0_FP8 && h8) { int t0 = 0, t1 = 0; t0 = __builtin_amdgcn_cvt_pk_fp8_f32(h0[0], h0[1], t0, false); t0 = __builtin_amdgcn_cvt_pk_fp8_f32(h0[2], h0[3], t0, true);
                        t1 = __builtin_amdgcn_cvt_pk_fp8_f32(h1[0], h1[1], t1, false); t1 = __builtin_amdgcn_cvt_pk_fp8_f32(h1[2], h1[3], t1, true); u32x2 w; w.x = (unsigned)t0; w.y = (unsigned)t1;
                        *(u32x2*)((unsigned char*)H + (size_t)(row0 + ai * HALF + m * 16) * DM + col0 + bj * HALF) = w; }
                    else *(u32x4*)(hp + bj * HALF) = pack8(h0, h1); } }
    }
};
struct EpiResNormRouter {
    static constexpr bool FUSED = true;
    float* X; const float* gate; const float* ng; const float* shb; bf16_t* H; float* xs9; gu32* cnt; gu32* tmo;
    const float* rw; const float* rb; gu32* ecnt; unsigned char* meta; int h8;
    __device__ __forceinline__ void fused(Acc& acc, const Unit& u, int wr, int wc, int fr, int fq, LAS unsigned char* lds, int wid, int lane) const {
        const int row0 = u.pm * BM + wr * 64 + fr, col0 = u.pn * BM + wc * 32 + 8 * fq; const int b = (u.pm * BM) / SEQ; const int tid = wid * 64 + lane;
        LAS float* P9 = (LAS float*)lds; LAS float* RWT = (LAS float*)(lds + 36864); LAS float* S = (LAS float*)(lds + 45056); LAS float* CE = (LAS float*)(lds + 46080);
        LAS int* rE = (LAS int*)(lds + 46144); LAS float* red = (LAS float*)(lds + 47360);
        const float* shp = shb + (size_t)b * 6144;
        for (int i = tid; i < 2048; i += NTHREADS) { const int c = i >> 3, e = i & 7; RWT[e * 256 + c] = rw[(size_t)(u.pn * BM + c) * 8 + e]; }
        { float ce[8]; const float s0 = shp[tid], s1 = shp[tid + 512];
#pragma unroll
          for (int e = 0; e < 8; ++e) ce[e] = wave_sum(s0 * rw[(size_t)tid * 8 + e] + s1 * rw[(size_t)(tid + 512) * 8 + e]);
          if (lane == 0) {
#pragma unroll
              for (int e = 0; e < 8; ++e) red[wid * 8 + e] = ce[e]; } }
        { f32x4 gv[2][2];
#pragma unroll
          for (int bj = 0; bj < 2; ++bj)
#pragma unroll
              for (int n = 0; n < 2; ++n) gv[bj][n] = *(const f32x4*)(gate + (size_t)b * 6144 + col0 + bj * HALF + 4 * n);
#pragma unroll
          for (int ai = 0; ai < 2; ++ai) {
              f32x4 xv[4][2][2];
#pragma unroll
              for (int m = 0; m < 4; ++m) { const float* ri = X + (size_t)(row0 + ai * HALF + m * 16) * DM + col0;
#pragma unroll
                  for (int bj = 0; bj < 2; ++bj)
#pragma unroll
                      for (int n = 0; n < 2; ++n) xv[m][bj][n] = ldx16(ri + bj * HALF + 4 * n); }
              asm volatile("" ::: "memory");
#pragma unroll
              for (int m = 0; m < 4; ++m) { float* rp = X + (size_t)(row0 + ai * HALF + m * 16) * DM + col0; float ss = 0.f;
#pragma unroll
                  for (int bj = 0; bj < 2; ++bj)
#pragma unroll
                      for (int n = 0; n < 2; ++n) { const f32x4 x = xv[m][bj][n] + gv[bj][n] * acc[ai][bj][m][n]; acc[ai][bj][m][n] = x; *(f32x4*)(rp + bj * HALF + 4 * n) = x;
                          ss += (x[0] * x[0] + x[1] * x[1]) + (x[2] * x[2] + x[3] * x[3]); }
                  ss += __shfl_xor(ss, 16); ss += __shfl_xor(ss, 32);
                  if (fq == 0) P9[((ai * HALF + wr * 64 + m * 16 + fr) * 4 + wc) * 9] = ss; }
              asm volatile("" ::: "memory");
          } }
        f32x4 sf[2][2];
#pragma unroll
        for (int bj = 0; bj < 2; ++bj)
#pragma unroll
            for (int n = 0; n < 2; ++n) { const int c = col0 + bj * HALF + 4 * n; const f32x4 gm = *(const f32x4*)(ng + c) * (*(const f32x4*)(shp + DM + c) + 1.0f); sf[bj][n] = *(const f32x4*)(shp + c);
#pragma unroll
                for (int ai = 0; ai < 2; ++ai)
#pragma unroll
                    for (int m = 0; m < 4; ++m) acc[ai][bj][m][n] = acc[ai][bj][m][n] * gm; }
        asm volatile("s_waitcnt lgkmcnt(0)" ::: "memory"); __builtin_amdgcn_s_barrier(); asm volatile("" ::: "memory");
        if (tid < 8) { float c = rb[tid];
#pragma unroll
            for (int w = 0; w < 8; ++w) c += red[w * 8 + tid];
            CE[tid] = c; }
#pragma unroll
        for (int e = 0; e < 8; ++e) { f32x4 rwe[2][2];
#pragma unroll
            for (int bj = 0; bj < 2; ++bj)
#pragma unroll
                for (int n = 0; n < 2; ++n) rwe[bj][n] = *(const LAS f32x4*)(RWT + e * 256 + bj * HALF + wc * 32 + 8 * fq + 4 * n);
#pragma unroll
            for (int ai = 0; ai < 2; ++ai)
#pragma unroll
                for (int m = 0; m < 4; ++m) { float a = 0.f;
#pragma unroll
                    for (int bj = 0; bj < 2; ++bj)
#pragma unroll
                        for (int n = 0; n < 2; ++n) { const f32x4 x = acc[ai][bj][m][n], w4 = rwe[bj][n]; a += (x[0] * w4[0] + x[1] * w4[1]) + (x[2] * w4[2] + x[3] * w4[3]); }
                    a += __shfl_xor(a, 16); a += __shfl_xor(a, 32);
                    if (fq == 0) P9[((ai * HALF + wr * 64 + m * 16 + fr) * 4 + wc) * 9 + 1 + e] = a; } }
        asm volatile("s_waitcnt lgkmcnt(0)" ::: "memory"); __builtin_amdgcn_s_barrier(); asm volatile("" ::: "memory");
        if (tid < 256) { gu32* q = (gu32*)xs9 + ((size_t)(u.pm * BM + tid) * 4 + u.pn) * 9;
#pragma unroll
            for (int k = 0; k < 9; ++k) { const float v = (P9[(tid * 4 + 0) * 9 + k] + P9[(tid * 4 + 1) * 9 + k]) + (P9[(tid * 4 + 2) * 9 + k] + P9[(tid * 4 + 3) * 9 + k]);
                __hip_atomic_store(q + k, __float_as_uint(v), RLX_AGENT); } }
        asm volatile("s_waitcnt vmcnt(0)" ::: "memory");
        if (wid < 4 && lane == 0) __hip_atomic_fetch_add(cnt + 64 * u.pm, 1u, RLX_AGENT);
        if (wid == 0) { unsigned spins = 0;
            while ((unsigned)__builtin_amdgcn_readfirstlane(__hip_atomic_load(cnt + 64 * u.pm, RLX_AGENT)) < 16u) { __builtin_amdgcn_s_sleep(2);
                if (++spins > (1u << 20)) { if (lane == 0) __hip_atomic_store(tmo, 1u, RLX_AGENT); break; } } }
        asm volatile("s_waitcnt vmcnt(0) lgkmcnt(0)" ::: "memory"); __builtin_amdgcn_s_barrier(); asm volatile("" ::: "memory");
        if (tid < 256) { const gu32* q = (const gu32*)xs9 + (size_t)(u.pm * BM + tid) * 36; float tot[9];
#pragma unroll
            for (int k = 0; k < 9; ++k) tot[k] = (__uint_as_float(__hip_atomic_load(q + k, RLX_AGENT)) + __uint_as_float(__hip_atomic_load(q + 9 + k, RLX_AGENT)))
                                               + (__uint_as_float(__hip_atomic_load(q + 18 + k, RLX_AGENT)) + __uint_as_float(__hip_atomic_load(q + 27 + k, RLX_AGENT)));
            const float r = 1.0f / sqrtf(tot[0] * (1.0f / DM) + EPS); S[tid] = r;
            if (wid == u.pn) {
                float lg[8];
#pragma unroll
                for (int e = 0; e < 8; ++e) lg[e] = r * tot[1 + e] + CE[e];
                int e0 = 0; float l0 = lg[0];
#pragma unroll
                for (int e = 1; e < 8; ++e) if (lg[e] > l0) { l0 = lg[e]; e0 = e; }
                int e1 = -1; float l1 = -3.0e38f;
#pragma unroll
                for (int e = 0; e < 8; ++e) if (e != e0 && lg[e] > l1) { l1 = lg[e]; e1 = e; }
                const float g0 = 1.0f / (1.0f + __expf(l1 - l0)), g1 = 1.0f - g0;
                int cmine = 0, r0 = 0, r1 = 0;
#pragma unroll
                for (int e = 0; e < 8; ++e) { const unsigned long long m0 = __ballot(e0 == e), m1 = __ballot(e1 == e);
                    const int below = (int)__builtin_amdgcn_mbcnt_hi((unsigned)(m0 >> 32), __builtin_amdgcn_mbcnt_lo((unsigned)m0, 0u)) + (int)__builtin_amdgcn_mbcnt_hi((unsigned)(m1 >> 32), __builtin_amdgcn_mbcnt_lo((unsigned)m1, 0u));
                    if (e0 == e) r0 = below; if (e1 == e) r1 = below; if (lane == e) cmine = __popcll(m0) + __popcll(m1); }
                unsigned base = 0u; if (lane < 8 && cmine) base = __hip_atomic_fetch_add(ecnt + 64 * lane, (unsigned)cmine, RLX_AGENT);
                const int p0 = (int)__shfl(base, e0) + r0, p1 = (int)__shfl(base, e1) + r1, grow = u.pm * BM + 64 * u.pn + lane;
                gu32* ri = (gu32*)(meta + WS_ROWIDX_B); gu32* gp = (gu32*)(meta + WS_GATEP_B); gu32* sl = (gu32*)(meta + WS_SLOT_B);
                __hip_atomic_store(ri + e0 * 16384 + p0, (unsigned)grow, RLX_AGENT); __hip_atomic_store(ri + e1 * 16384 + p1, (unsigned)grow, RLX_AGENT);
                __hip_atomic_store(gp + e0 * 16384 + p0, __float_as_uint(g0), RLX_AGENT); __hip_atomic_store(gp + e1 * 16384 + p1, __float_as_uint(g1), RLX_AGENT);
                __hip_atomic_store(sl + grow * 2, (unsigned)((e0 << 16) | p0), RLX_AGENT); __hip_atomic_store(sl + grow * 2 + 1, (unsigned)((e1 << 16) | p1), RLX_AGENT); } }
        asm volatile("s_waitcnt vmcnt(0) lgkmcnt(0)" ::: "memory"); __builtin_amdgcn_s_barrier(); asm volatile("" ::: "memory");
#pragma unroll
        for (int ai = 0; ai < 2; ++ai)
#pragma unroll
            for (int m = 0; m < 4; ++m) { const float r = S[ai * HALF + wr * 64 + m * 16 + fr]; bf16_t* hp = H + (size_t)(row0 + ai * HALF + m * 16) * DM + col0;
#pragma unroll
                for (int bj = 0; bj < 2; ++bj) { const f32x4 h0 = acc[ai][bj][m][0] * r + sf[bj][0], h1 = acc[ai][bj][m][1] * r + sf[bj][1];
                    if ((M1_FP8 || M1L1_FP8) && h8) { int t0 = 0, t1 = 0; t0 = __builtin_amdgcn_cvt_pk_fp8_f32(h0[0], h0[1], t0, false); t0 = __builtin_amdgcn_cvt_pk_fp8_f32(h0[2], h0[3], t0, true);
                        t1 = __builtin_amdgcn_cvt_pk_fp8_f32(h1[0], h1[1], t1, false); t1 = __builtin_amdgcn_cvt_pk_fp8_f32(h1[2], h1[3], t1, true); u32x2 w; w.x = (unsigned)t0; w.y = (unsigned)t1;
                        *(u32x2*)((unsigned char*)H + (size_t)(row0 + ai * HALF + m * 16) * DM + col0 + bj * HALF) = w; }
                    else *(u32x4*)(hp + bj * HALF) = pack8(h0, h1); } }
    }
};
struct EpiGluRes {
    static constexpr bool FUSED = false;
    float* X; const float* gate;
    __device__ __forceinline__ void operator()(const Acc& acc, const Unit& u, int wr, int wc, int fr, int fq) const {
        const int row0 = u.pm * BM + wr * 64 + fr, col0 = u.pn * HALF + wc * 32 + 8 * fq; const int b = (u.pm * BM) / SEQ;
        f32x4 gv[2];
#pragma unroll
        for (int n = 0; n < 2; ++n) gv[n] = *(const f32x4*)(gate + (size_t)b * 6144 + col0 + 4 * n);
        f32x4 xv[2][4][2];
#pragma unroll
        for (int ai = 0; ai < 2; ++ai)
#pragma unroll
            for (int m = 0; m < 4; ++m)
#pragma unroll
                for (int n = 0; n < 2; ++n) xv[ai][m][n] = ldx16(X + (size_t)(row0 + ai * HALF + m * 16) * DM + col0 + 4 * n);
        asm volatile("" ::: "memory");
#pragma unroll
        for (int ai = 0; ai < 2; ++ai)
#pragma unroll
            for (int m = 0; m < 4; ++m) { float* rp = X + (size_t)(row0 + ai * HALF + m * 16) * DM + col0;
#pragma unroll
                for (int n = 0; n < 2; ++n) { f32x4 x = xv[ai][m][n]; const f32x4 l = acc[ai][0][m][n], gg = acc[ai][1][m][n];
#pragma unroll
                    for (int e = 0; e < 4; ++e) x[e] += gv[n][e] * l[e] * sigmoid_f(gg[e]);
                    *(f32x4*)(rp + 4 * n) = x; } }
    }
};
struct EpiAttnIn {
    static constexpr bool FUSED = false;
    bf16_t *Q, *Kn, *V, *QI, *KI; float* WI; const float *qg, *kg;
    __device__ __forceinline__ void operator()(const Acc& acc, const Unit& u, int wr, int wc, int fr, int fq) const {
        const int row0 = u.pm * BM + wr * 64 + fr;
        if (u.pn < 5) {
            const bool isq = u.pn < 4; const float* gp = isq ? qg : kg; const float sc = isq ? 0.125f : 1.0f;
            f32x4 gn[2][2];
#pragma unroll
            for (int bj = 0; bj < 2; ++bj)
#pragma unroll
                for (int n = 0; n < 2; ++n) gn[bj][n] = *(const f32x4*)(gp + 32 * bj + 8 * fq + 4 * n) * sc;
            bf16_t* base = isq ? (Q + (size_t)(4 * u.pn + wc) * 64) : (Kn + (size_t)wc * 64); const int ldo = isq ? 1024 : 256;
#pragma unroll
            for (int ai = 0; ai < 2; ++ai)
#pragma unroll
                for (int m = 0; m < 4; ++m) { float ss = 0.f;
#pragma unroll
                    for (int bj = 0; bj < 2; ++bj)
#pragma unroll
                        for (int n = 0; n < 2; ++n) { const f32x4 x = acc[ai][bj][m][n]; ss += (x[0] * x[0] + x[1] * x[1]) + (x[2] * x[2] + x[3] * x[3]); }
                    ss += __shfl_xor(ss, 16); ss += __shfl_xor(ss, 32);
                    const float r = 1.0f / sqrtf(ss * (1.0f / 64.0f) + EPS);
#pragma unroll
                    for (int bj = 0; bj < 2; ++bj) *(u32x4*)(base + (size_t)(row0 + ai * HALF + m * 16) * ldo + 32 * bj + 8 * fq) = pack8(acc[ai][bj][m][0] * r * gn[bj][0], acc[ai][bj][m][1] * r * gn[bj][1]); }
        } else if (u.pn < 8) {
            bf16_t* base = (u.pn == 5) ? V : QI + (size_t)(u.pn - 6) * 256; const int ldo = (u.pn == 5) ? 256 : 512; const int col0 = wc * 32 + 8 * fq;
#pragma unroll
            for (int ai = 0; ai < 2; ++ai)
#pragma unroll
                for (int m = 0; m < 4; ++m)
#pragma unroll
                    for (int bj = 0; bj < 2; ++bj) *(u32x4*)(base + (size_t)(row0 + ai * HALF + m * 16) * ldo + col0 + bj * HALF) = pack8(acc[ai][bj][m][0], acc[ai][bj][m][1]);
        } else {
            if (wc < 2) {
#pragma unroll
                for (int ai = 0; ai < 2; ++ai)
#pragma unroll
                    for (int m = 0; m < 4; ++m) *(u32x4*)(KI + (size_t)(row0 + ai * HALF + m * 16) * 64 + wc * 32 + 8 * fq) = pack8(acc[ai][0][m][0], acc[ai][0][m][1]);
            } else if (wc == 2 && fq == 0) {
                const float s = 0.04419417382415922f;
#pragma unroll
                for (int ai = 0; ai < 2; ++ai)
#pragma unroll
                    for (int m = 0; m < 4; ++m) { float* wp = WI + (size_t)(row0 + ai * HALF + m * 16) * 8; *(f32x4*)wp = acc[ai][0][m][0] * s; *(f32x4*)(wp + 4) = acc[ai][0][m][1] * s; }
            }
        }
    }
};
struct EpiMoeDn {
    static constexpr bool FUSED = false;
    bf16_t* Y; const float* gatep;
    __device__ __forceinline__ void operator()(const Acc& acc, const Unit& u, int wr, int wc, int fr, int fq) const {
        const int row0 = u.pm * BM + wr * 64 + fr, col0 = u.pn * BM + wc * 32 + 8 * fq;
#pragma unroll
        for (int ai = 0; ai < 2; ++ai)
#pragma unroll
            for (int m = 0; m < 4; ++m) { const float gt = gatep[u.aux + ai * HALF + wr * 64 + m * 16 + fr] * (M2_FP8 ? W8_INV : 1.0f);
#pragma unroll
                for (int bj = 0; bj < 2; ++bj) *(u32x4*)(Y + (size_t)(row0 + ai * HALF + m * 16) * DM + col0 + bj * HALF) = pack8(acc[ai][bj][m][0] * gt, acc[ai][bj][m][1] * gt); }
    }
};
}

constexpr size_t MiB = 1u << 20;
constexpr size_t WS_CTL = 0, CTL_ZERO_BYTES = 1 * MiB;
constexpr size_t WS_MOD = 1 * MiB;
constexpr size_t WS_ROWIDX = 2 * MiB;
constexpr size_t WS_GATEP = 2 * MiB + 512 * 1024;
constexpr size_t WS_SLOT = 3 * MiB;
static_assert(WS_ROWIDX_B == WS_ROWIDX && WS_GATEP_B == WS_GATEP && WS_SLOT_B == WS_SLOT, "metadata offsets");
constexpr size_t WS_WCI = 8 * MiB;
constexpr size_t WS_WCO = 20 * MiB;
constexpr size_t WS_WAI = 24 * MiB;
constexpr size_t WS_WAO = 29 * MiB;
constexpr size_t WS_WGL = 31 * MiB;
constexpr size_t WS_WFG = 35 * MiB;
constexpr size_t WS_WFD = 57 * MiB;
constexpr size_t WS_WMG = 68 * MiB;
constexpr size_t WS_WMD = 244 * MiB;
constexpr size_t WS_HB = 332 * MiB;
constexpr size_t WS_BUF = 364 * MiB;
constexpr size_t WS_ACT = 432 * MiB;
constexpr size_t WS_END = 619 * MiB;
constexpr int MOE_ROWS = 2 * M + NEXP * 256;
constexpr size_t WS_Q = WS_BUF, WS_K = WS_BUF + 32 * MiB, WS_V = WS_BUF + 40 * MiB, WS_QI = WS_BUF + 48 * MiB;
constexpr size_t WS_SC = WS_ACT, WS_O = WS_ACT + 128 * MiB, WS_KI = WS_ACT + 160 * MiB, WS_WI = WS_ACT + 162 * MiB;
static_assert(WS_WMD + (size_t)16 * 1024 * 2816 * 2 <= WS_HB && WS_ACT + (size_t)MOE_ROWS * FF * 2 <= WS_END && WS_BUF + (size_t)MOE_ROWS * DM * 2 <= WS_ACT, "d_ws map");
constexpr int CW_TMO = 0;
constexpr int CW_CNT = 64;
constexpr int CW_BAR = 4096;
constexpr int CW_PAN = 16384;
constexpr size_t WS_XS9 = 5 * MiB + 768 * 1024;
constexpr size_t WS_XS = 5 * MiB + 512 * 1024;

constexpr int RING_BYTES = 131072;
constexpr int LDSCTL_OFF = RING_BYTES, MISC_OFF = LDSCTL_OFF + 320;
constexpr int LDS_BYTES = 147456;

#define XB_TMO      128
#define XB_XCNT(j)  (256  + 64 * (j))
#define XB_XSUB(j)  (1280 + 64 * (j))
#define XB_XGEN(j)  (2304 + 64 * (j))
#define XB_TOP      3328
#define XB_TOPGEN   3392
#define XCD_BAR_WORDS 3456
#define XB_SPIN_CAP (1u << 18)
__device__ __forceinline__ unsigned xb_ld(unsigned* p)              { return __hip_atomic_load(p, __ATOMIC_RELAXED, __HIP_MEMORY_SCOPE_AGENT); }
__device__ __forceinline__ unsigned xb_add(unsigned* p, unsigned v) { return __hip_atomic_fetch_add(p, v, __ATOMIC_RELAXED, __HIP_MEMORY_SCOPE_AGENT); }
__device__ __forceinline__ unsigned xb_xcc_id() { return (unsigned)__builtin_amdgcn_s_getreg((3 << 11) | 20) & 0xFu; }
#define XB_SPIN(cond, bar) do { unsigned _sp = 0; while (cond) { __builtin_amdgcn_s_sleep(1); \
    if ((++_sp & 255u) == 0u) { if (xb_ld(&(bar)[XB_TMO])) break; if (_sp > XB_SPIN_CAP) { atomicAdd(&(bar)[XB_TMO], 1u); break; } } } } while (0)
struct XcdBarrier { unsigned* bar; unsigned x; volatile LAS unsigned* st; int w; };
__device__ __forceinline__ bool xb_thread0(int w) { return w == 0 && lane_id_fresh() == 0; }
__device__ __forceinline__ XcdBarrier xcd_barrier_post(unsigned* bar, volatile LAS unsigned* st, int w) {
    XcdBarrier b; b.bar = bar; b.x = xb_xcc_id(); b.st = st; b.w = w;
    if (xb_thread0(w)) (void)xb_add(&bar[XB_XCNT(b.x)], 1u);
    return b;
}
__device__ __forceinline__ void xcd_barrier_complete(unsigned* bar, unsigned x, unsigned& nloc, unsigned& nx) {
    const unsigned G = gridDim.x * gridDim.y * gridDim.z;
    unsigned sum, cnt, mine, sp = 0u;
    for (;;) {
        sum = 0u; cnt = 0u; mine = 0u;
#pragma unroll
        for (unsigned j = 0; j < 16; ++j) { const unsigned c = xb_ld(&bar[XB_XCNT(j)]); sum += c; cnt += (c > 0u) ? 1u : 0u; mine = (j == x) ? c : mine; }
        if (sum == G) break;
        __builtin_amdgcn_s_sleep(1);
        if ((++sp & 255u) == 0u) { if (xb_ld(&bar[XB_TMO])) break; if (sp > XB_SPIN_CAP) { atomicAdd(&bar[XB_TMO], 1u); break; } }
    }
    nloc = mine > 0u ? mine : 1u; nx = cnt > 0u ? cnt : 1u;
}
__device__ __forceinline__ int lane_probe() { return (int)__builtin_amdgcn_mbcnt_hi(~0u, __builtin_amdgcn_mbcnt_lo(~0u, 0u)); }
__device__ __forceinline__ int lane_probe2() { return (int)__builtin_amdgcn_mbcnt_hi(~0u, __builtin_amdgcn_mbcnt_lo(~0u, 0u)); }
__device__ __forceinline__ void xcd_barrier(const XcdBarrier& b) {
    asm volatile("s_waitcnt vmcnt(0)" ::: "memory");
    __syncthreads();
    if (xb_thread0(b.w)) {
        unsigned* bar = b.bar;
        __builtin_amdgcn_s_waitcnt(0);
        unsigned nloc = b.st[0], nx = b.st[1];
        if (nloc == 0u) { xcd_barrier_complete(bar, b.x, nloc, nx); b.st[0] = nloc; b.st[1] = nx; }
        const unsigned old = xb_add(&bar[XB_XSUB(b.x)], 1u);
        const unsigned gen = old / nloc;
        if (old + 1u == (gen + 1u) * nloc) {
            __builtin_amdgcn_fence(__ATOMIC_RELEASE, "agent");
            asm volatile("s_waitcnt vmcnt(0)" ::: "memory");
            __builtin_amdgcn_fence(__ATOMIC_RELEASE, "agent");
            asm volatile("s_waitcnt vmcnt(0)" ::: "memory");
            const unsigned og = xb_add(&bar[XB_TOP], 1u);
            const unsigned tg = og / nx;
            if (og + 1u == (tg + 1u) * nx) xb_add(&bar[XB_TOPGEN], 1u);
            else XB_SPIN(xb_ld(&bar[XB_TOPGEN]) == tg, bar);
            __builtin_amdgcn_fence(__ATOMIC_ACQUIRE, "agent");
            xb_add(&bar[XB_XGEN(b.x)], 1u);
            { const unsigned dmy = __builtin_nontemporal_load(&bar[XB_TMO]); asm volatile("s_waitcnt vmcnt(0)" :: "v"(dmy) : "memory"); }
        } else {
            XB_SPIN(xb_ld(&bar[XB_XGEN(b.x)]) == gen, bar);
            __builtin_amdgcn_fence(__ATOMIC_ACQUIRE, "agent");
            { const unsigned dmy = __builtin_nontemporal_load(&bar[XB_TMO]); asm volatile("s_waitcnt vmcnt(0)" :: "v"(dmy) : "memory"); }
        }
    }
    __syncthreads();
    if (xb_thread0(b.w)) { __builtin_amdgcn_fence(__ATOMIC_ACQUIRE, "agent"); asm volatile("s_waitcnt vmcnt(0)" ::: "memory"); }
    __syncthreads();
}

struct Args { const float* in[28]; float* out; unsigned char* ws; int ph_lo, ph_hi; };
enum { I_X = 0, I_C, I_ADAW, I_ADAB, I_NORMG, I_CWIN, I_CW, I_CWOUT, I_AWIN, I_QG, I_KG, I_AWOUT, I_RELB, I_SLRE, I_SLIM, I_SLOG, I_SBRE, I_SBIM, I_SCRE, I_SCIM, I_SD, I_SGLU,
       I_FGU, I_FDN, I_RW, I_RB, I_MGU, I_MDN };
struct Frame {
    LAS unsigned char* lds; unsigned char* ws; gu32* ctl;
    int tid, lane, wave, vcu, G;
    float* out; const float* mod;
    bf16_t *HB, *BUF, *ACT;
};

enum { MAP_NAT = 0, MAP_PAIR = 1, MAP_CONV = 2, MAP_ATTN = 3 };
__device__ __forceinline__ int map_row(int map, int half, int n) {
    if (map == MAP_NAT) return n;
    if (map == MAP_PAIR) { return n < half ? 256 * (n / 128) + (n % 128) : 256 * ((n - half) / 128) + 128 + ((n - half) % 128); }
    if (map == MAP_CONV) { if (n < 1024) return 2048 + n; if (n < 2048) { const int q = n - 1024; return 256 * (q / 128) + (q % 128); } const int q = n - 2048; return 256 * (q / 128) + 128 + (q % 128); }
    if (n < 1280) { const int hd = n / 64, d = n % 64; return 256 * (hd / 4) + 128 * (d / 32) + 32 * (hd % 4) + (d % 32); }
    return n;
}
__device__ __forceinline__ void p0_transpose_item(const float* W, int K, int N, bf16_t* WT, int map, int half, LAS float* scr, int item, int lane) {
    const int nblk = (N + 31) / 32, kb = item / nblk, nb = item % nblk, k0 = 64 * kb, n0 = 32 * nb;
    const bool cin = (n0 + (lane & 31)) < N;
    float tv[32];
#pragma unroll
    for (int i = 0; i < 32; ++i) { const int kk = 2 * i + (lane >> 5); tv[i] = cin ? W[(size_t)(k0 + kk) * N + n0 + (lane & 31)] : 0.f; }
#pragma unroll
    for (int i = 0; i < 32; ++i) { const int kk = 2 * i + (lane >> 5); scr[kk * 33 + (lane & 31)] = tv[i]; }
    LDS_WAIT(); CFENCE();
    const int c = lane & 7; const int r0 = map_row(map, half, n0);
#pragma unroll
    for (int j = 0; j < 4; ++j) { const int n = (lane >> 3) + 8 * j; const LAS float* s = scr + (8 * c) * 33 + n;
        u32x4 o; o.x = pk2(s[0 * 33], s[1 * 33]); o.y = pk2(s[2 * 33], s[3 * 33]); o.z = pk2(s[4 * 33], s[5 * 33]); o.w = pk2(s[6 * 33], s[7 * 33]);
        *(GAS u32x4*)(WT + (size_t)(r0 + n) * K + k0 + 8 * c) = o; }
    LDS_WAIT(); CFENCE();
}
__device__ __forceinline__ void p0_transpose_item8(const float* W, int K, int N, unsigned char* WT, int map, int half, LAS float* scr, int item, int lane, int sub) {
    const int nblk = (N + 31) / 32, kb = 2 * (item / nblk) + sub, nb = item % nblk, k0 = 64 * kb, n0 = 32 * nb;
    float tv[32];
#pragma unroll
    for (int i = 0; i < 32; ++i) { const int kk = 2 * i + (lane >> 5); tv[i] = W[(size_t)(k0 + kk) * N + n0 + (lane & 31)]; }
#pragma unroll
    for (int i = 0; i < 32; ++i) { const int kk = 2 * i + (lane >> 5); scr[kk * 33 + (lane & 31)] = tv[i] * pg8::W8_MUL; }
    LDS_WAIT(); CFENCE();
    const int c = lane & 3; const int r0 = map_row(map, half, n0);
#pragma unroll
    for (int j = 0; j < 2; ++j) { const int n = (lane >> 2) + 16 * j; const LAS float* sp = scr + (16 * c) * 33 + n; u32x4 o;
#pragma unroll
        for (int q = 0; q < 4; ++q) { int t = 0; t = __builtin_amdgcn_cvt_pk_fp8_f32(sp[(4 * q) * 33], sp[(4 * q + 1) * 33], t, false); t = __builtin_amdgcn_cvt_pk_fp8_f32(sp[(4 * q + 2) * 33], sp[(4 * q + 3) * 33], t, true); o[q] = (unsigned)t; }
        *(GAS u32x4*)(WT + (size_t)(r0 + n) * K + k0 + 16 * c) = o; }
    LDS_WAIT(); CFENCE();
}
__device__ __forceinline__ void p0_prologue(Frame& F, const Args& A) {
    {
        LAS float* cs = (LAS float*)F.lds;
        LAS float* red = (LAS float*)(F.lds + 16384);
        for (int i = F.tid; i < NB * DM; i += NTHREADS) { const float c = A.in[I_C][i]; cs[i] = c / (1.f + __expf(-c)); }
        __syncthreads();
        const int kg = F.tid >> 6, cj = F.tid & 63;
        for (int un = blockIdx.x; un < 4 * 96; un += F.G) {
            const int l = un / 96, jb = un % 96, j = jb * 64 + cj;
            const float* w = A.in[I_ADAW] + (size_t)l * DM * 6144 + j;
            float a0 = 0.f, a1 = 0.f, a2 = 0.f, a3 = 0.f;
#pragma unroll 8
            for (int k = kg * 128; k < kg * 128 + 128; ++k) { const float wv = w[(size_t)k * 6144]; a0 += cs[k] * wv; a1 += cs[1024 + k] * wv; a2 += cs[2048 + k] * wv; a3 += cs[3072 + k] * wv; }
            *(LAS f32x4*)(red + (kg * 64 + cj) * 4) = (f32x4){a0, a1, a2, a3};
            __syncthreads();
            if (F.tid < 256) { const int b = F.tid >> 6, cc = F.tid & 63; float s = 0.f;
#pragma unroll
                for (int q = 0; q < 8; ++q) s += red[(q * 64 + cc) * 4 + b];
                ((float*)(F.ws + WS_MOD))[((size_t)l * NB + b) * 6144 + jb * 64 + cc] = s + A.in[I_ADAB][l * 6144 + jb * 64 + cc]; }
            __syncthreads();
        }
    }
    LAS float* scr = (LAS float*)(F.lds + 32768 + F.wave * 8704);
    const int gw = F.vcu * NWAVES + F.wave, NGW = F.G * NWAVES;
    constexpr int I_CI = (DM / 64) * (3072 / 32), I_SQ = (DM / 64) * (DM / 32), I_AI = (DM / 64) * ((ATT_N + 31) / 32), I_GL = (DM / 64) * (2048 / 32), I_GU = (DM / 64) * (2 * FF / 32), I_DN = (FF / 128) * (DM / 32), I_DNB = (FF / 64) * (DM / 32), I_GU8 = (DM / 128) * (2 * FF / 32);
    constexpr int NITEMS = 2 * I_CI + 2 * I_SQ + I_AI + I_SQ + I_GL + (F1L0_FP8 ? I_GU8 : I_GU) + I_GU + (F2_FP8 ? 2 * I_DN : ((F2L0_FP8 ? I_DN : I_DNB) + I_DNB)) + 8 * (M1L1_FP8 ? I_GU8 : I_GU) + 8 * (M1_FP8 ? I_GU8 : I_GU) + 16 * (M2_FP8 ? I_DN : I_DNB);
    for (int it = gw; it < NITEMS; it += NGW) {
        int r = it;
        if (r < 2 * I_CI) { const int q = r / I_CI; p0_transpose_item(A.in[I_CWIN] + (size_t)q * DM * 3072, DM, 3072, (bf16_t*)(F.ws + WS_WCI) + (size_t)q * 3072 * DM, MAP_CONV, 0, scr, r % I_CI, F.lane); continue; } r -= 2 * I_CI;
        if (r < 2 * I_SQ) { const int q = r / I_SQ; p0_transpose_item(A.in[I_CWOUT] + (size_t)q * DM * DM, DM, DM, (bf16_t*)(F.ws + WS_WCO) + (size_t)q * DM * DM, MAP_NAT, 0, scr, r % I_SQ, F.lane); continue; } r -= 2 * I_SQ;
        if (r < I_AI) { p0_transpose_item(A.in[I_AWIN], DM, ATT_N, (bf16_t*)(F.ws + WS_WAI), MAP_ATTN, 0, scr, r, F.lane); continue; } r -= I_AI;
        if (r < I_SQ) { p0_transpose_item(A.in[I_AWOUT], DM, DM, (bf16_t*)(F.ws + WS_WAO), MAP_NAT, 0, scr, r, F.lane); continue; } r -= I_SQ;
        if (r < I_GL) { p0_transpose_item(A.in[I_SGLU], DM, 2048, (bf16_t*)(F.ws + WS_WGL), MAP_PAIR, 1024, scr, r, F.lane); continue; } r -= I_GL;
        if (F1L0_FP8) { if (r < I_GU8) { p0_transpose_item8(A.in[I_FGU], DM, 2 * FF, (unsigned char*)(F.ws + WS_WFG), MAP_PAIR, FF, scr, r, F.lane, 0); p0_transpose_item8(A.in[I_FGU], DM, 2 * FF, (unsigned char*)(F.ws + WS_WFG), MAP_PAIR, FF, scr, r, F.lane, 1); continue; } r -= I_GU8; }
        else { if (r < I_GU) { p0_transpose_item(A.in[I_FGU], DM, 2 * FF, (bf16_t*)(F.ws + WS_WFG), MAP_PAIR, FF, scr, r, F.lane); continue; } r -= I_GU; }
        if (r < I_GU) { p0_transpose_item(A.in[I_FGU] + (size_t)DM * 2 * FF, DM, 2 * FF, (bf16_t*)(F.ws + WS_WFG) + (size_t)2 * FF * DM, MAP_PAIR, FF, scr, r, F.lane); continue; } r -= I_GU;
        if (F2_FP8) { if (r < 2 * I_DN) { const int q = r / I_DN; p0_transpose_item8(A.in[I_FDN] + (size_t)q * FF * DM, FF, DM, (unsigned char*)(F.ws + WS_WFD) + (size_t)q * DM * FF, MAP_NAT, 0, scr, r % I_DN, F.lane, 0); p0_transpose_item8(A.in[I_FDN] + (size_t)q * FF * DM, FF, DM, (unsigned char*)(F.ws + WS_WFD) + (size_t)q * DM * FF, MAP_NAT, 0, scr, r % I_DN, F.lane, 1); continue; } r -= 2 * I_DN; }
        else if (F2L0_FP8) {
            if (r < I_DN) { p0_transpose_item8(A.in[I_FDN], FF, DM, (unsigned char*)(F.ws + WS_WFD), MAP_NAT, 0, scr, r, F.lane, 0); p0_transpose_item8(A.in[I_FDN], FF, DM, (unsigned char*)(F.ws + WS_WFD), MAP_NAT, 0, scr, r, F.lane, 1); continue; } r -= I_DN;
            if (r < I_DNB) { p0_transpose_item(A.in[I_FDN] + (size_t)FF * DM, FF, DM, (bf16_t*)(F.ws + WS_WFD) + (size_t)DM * FF, MAP_NAT, 0, scr, r, F.lane); continue; } r -= I_DNB; }
        else { if (r < 2 * I_DNB) { const int q = r / I_DNB; p0_transpose_item(A.in[I_FDN] + (size_t)q * FF * DM, FF, DM, (bf16_t*)(F.ws + WS_WFD) + (size_t)q * DM * FF, MAP_NAT, 0, scr, r % I_DNB, F.lane); continue; } r -= 2 * I_DNB; }
        if (M1L1_FP8) { if (r < 8 * I_GU8) { const int q = r / I_GU8; unsigned char* dst = (unsigned char*)(F.ws + WS_WMG) + (size_t)q * 2 * FF * DM;
                p0_transpose_item8(A.in[I_MGU] + (size_t)q * DM * 2 * FF, DM, 2 * FF, dst, MAP_PAIR, FF, scr, r % I_GU8, F.lane, 0); p0_transpose_item8(A.in[I_MGU] + (size_t)q * DM * 2 * FF, DM, 2 * FF, dst, MAP_PAIR, FF, scr, r % I_GU8, F.lane, 1); continue; } r -= 8 * I_GU8; }
        else { if (r < 8 * I_GU) { const int q = r / I_GU; p0_transpose_item(A.in[I_MGU] + (size_t)q * DM * 2 * FF, DM, 2 * FF, (bf16_t*)(F.ws + WS_WMG) + (size_t)q * 2 * FF * DM, MAP_PAIR, FF, scr, r % I_GU, F.lane); continue; } r -= 8 * I_GU; }
        if (M1_FP8) { if (r < 8 * I_GU8) { const int q = 8 + r / I_GU8; unsigned char* dst = (unsigned char*)(F.ws + WS_WMG) + (size_t)8 * 2 * FF * DM * 2 + (size_t)(q - 8) * 2 * FF * DM;
                p0_transpose_item8(A.in[I_MGU] + (size_t)q * DM * 2 * FF, DM, 2 * FF, dst, MAP_PAIR, FF, scr, r % I_GU8, F.lane, 0); p0_transpose_item8(A.in[I_MGU] + (size_t)q * DM * 2 * FF, DM, 2 * FF, dst, MAP_PAIR, FF, scr, r % I_GU8, F.lane, 1); continue; } r -= 8 * I_GU8; }
        else { if (r < 8 * I_GU) { const int q = 8 + r / I_GU; p0_transpose_item(A.in[I_MGU] + (size_t)q * DM * 2 * FF, DM, 2 * FF, (bf16_t*)(F.ws + WS_WMG) + (size_t)q * 2 * FF * DM, MAP_PAIR, FF, scr, r % I_GU, F.lane); continue; } r -= 8 * I_GU; }
        if (M2_FP8) { const int q = r / I_DN; p0_transpose_item8(A.in[I_MDN] + (size_t)q * FF * DM, FF, DM, (unsigned char*)(F.ws + WS_WMD) + (size_t)q * DM * FF, MAP_NAT, 0, scr, r % I_DN, F.lane, 0); p0_transpose_item8(A.in[I_MDN] + (size_t)q * FF * DM, FF, DM, (unsigned char*)(F.ws + WS_WMD) + (size_t)q * DM * FF, MAP_NAT, 0, scr, r % I_DN, F.lane, 1); }
        else { const int q = r / I_DNB; p0_transpose_item(A.in[I_MDN] + (size_t)q * FF * DM, FF, DM, (bf16_t*)(F.ws + WS_WMD) + (size_t)q * DM * FF, MAP_NAT, 0, scr, r % I_DNB, F.lane); }
    }
    { u32x4* z = (u32x4*)((bf16_t*)(F.ws + WS_WAI) + (size_t)2144 * DM); const int n16 = (ATT_NP - 2144) * DM * 2 / 16;
      for (int i = blockIdx.x * NTHREADS + F.tid; i < n16; i += F.G * NTHREADS) z[i] = (u32x4){0u, 0u, 0u, 0u}; }
}

template <int FLAGS>
__device__ __forceinline__ void thin_phase(Frame& F, const Args& A, const float* src, int nl  , int ns  , int cl  , int rl  , int cs = -1  , size_t roff = 0  ) {
    if (cs < 0) cs = rl;
    const int gw = F.vcu * NWAVES + F.wave, NGW = F.G * NWAVES;
    LAS float* rwt = (LAS float*)F.lds;
    if (FLAGS & 8) {
        const float* rw = A.in[I_RW] + (size_t)rl * DM * NEXP;
        for (int i = F.tid; i < DM * NEXP; i += NTHREADS) rwt[(i & 7) * DM + (i >> 3)] = rw[i];
        __syncthreads();
    }
    int Tb[8];
    if (FLAGS & 2) { int acc = 0;
#pragma unroll
        for (int e = 0; e < 8; ++e) { Tb[e] = acc; acc += (int)((__hip_atomic_load(F.ctl + CW_CNT + 64 * (8 * rl + e), RLX_AGENT) + 255u) >> 8); } }
    const float* ng = A.in[I_NORMG] + (size_t)(nl * 2 + ns) * DM;
    constexpr bool RT = (FLAGS & 8) != 0;
    LAS int* rE = (LAS int*)(F.lds + 32768);
    const int nit = RT ? ((M / 64 - (int)blockIdx.x + F.G - 1) / F.G) * 8 : (M - gw + NGW - 1) / NGW;
    for (int it = 0; it < nit; ++it) {
        const int chunk = (int)blockIdx.x + (it >> 3) * F.G;
        const int row = RT ? chunk * 64 + F.wave * 8 + (it & 7) : gw + it * NGW;
        const int b = row / SEQ;
        f32x4 v[4];
        const GAS unsigned long long* xr = (const GAS unsigned long long*)(src + (size_t)row * DM) + 2 * F.lane;
#pragma unroll
        for (int j = 0; j < 4; ++j) { const unsigned long long lo = __hip_atomic_load(xr + 128 * j, RLX_AGENT), hi = __hip_atomic_load(xr + 128 * j + 1, RLX_AGENT);
            v[j] = (f32x4){__uint_as_float((unsigned)lo), __uint_as_float((unsigned)(lo >> 32)), __uint_as_float((unsigned)hi), __uint_as_float((unsigned)(hi >> 32))}; }
        if (FLAGS & 2) {
            const int s0 = ((const int*)(F.ws + roff + WS_SLOT))[row * 2], s1 = ((const int*)(F.ws + roff + WS_SLOT))[row * 2 + 1];
            int t0 = 0, t1 = 0;
#pragma unroll
            for (int e = 0; e < 8; ++e) { if ((s0 >> 16) == e) t0 = Tb[e]; if ((s1 >> 16) == e) t1 = Tb[e]; }
            const bf16_t* y0 = (const bf16_t*)(F.ws + WS_BUF) + (size_t)(256 * t0 + (s0 & 0xffff)) * DM;
            const bf16_t* y1 = (const bf16_t*)(F.ws + WS_BUF) + (size_t)(256 * t1 + (s1 & 0xffff)) * DM;
            const float* g2 = cl >= 0 ? F.mod + ((size_t)cl * NB + b) * 6144 + 5 * DM : (const float*)(F.ws + 512 * 1024);
#pragma unroll
            for (int j = 0; j < 4; ++j) { const int col = 4 * F.lane + 256 * j; const u32x2 a = *(const u32x2*)(y0 + col), c = *(const u32x2*)(y1 + col); const f32x4 g = *(const f32x4*)(g2 + col);
                v[j][0] += g[0] * (bflo(a.x) + bflo(c.x)); v[j][1] += g[1] * (bfhi(a.x) + bfhi(c.x)); v[j][2] += g[2] * (bflo(a.y) + bflo(c.y)); v[j][3] += g[3] * (bfhi(a.y) + bfhi(c.y)); }
        }
        if (FLAGS & 3) { GAS f32x4* xo = (GAS f32x4*)(F.out + (size_t)row * DM) + F.lane;
#pragma unroll
            for (int j = 0; j < 4; ++j) xo[64 * j] = v[j]; }
        if (FLAGS & 4) {
            float ss = 0.f;
#pragma unroll
            for (int j = 0; j < 4; ++j) ss += (v[j][0] * v[j][0] + v[j][1] * v[j][1]) + (v[j][2] * v[j][2] + v[j][3] * v[j][3]);
            const float r = 1.0f / sqrtf(wave_sum(ss) * (1.0f / DM) + EPS);
            const float* sh = F.mod + ((size_t)nl * NB + b) * 6144 + (ns ? 3 : 0) * DM; const float* sc = sh + DM;
            GAS u32x2* ho = (GAS u32x2*)(F.HB + (size_t)row * DM) + F.lane;
#pragma unroll
            for (int j = 0; j < 4; ++j) { const int col = 4 * F.lane + 256 * j; const f32x4 g = *(const f32x4*)(ng + col), s1 = *(const f32x4*)(sc + col), s0 = *(const f32x4*)(sh + col);
                v[j] = (v[j] * r) * g * (s1 + 1.0f) + s0;
                if ((RT && ((M1_FP8 && nl == 3) || (M1L1_FP8 && nl == 1))) || (FLAGS == 4 && F1L0_FP8 && nl == 0 && ns == 1)) { int t = 0; t = __builtin_amdgcn_cvt_pk_fp8_f32(v[j][0], v[j][1], t, false); t = __builtin_amdgcn_cvt_pk_fp8_f32(v[j][2], v[j][3], t, true);
                    *(unsigned*)((unsigned char*)F.HB + (size_t)row * DM + col) = (unsigned)t; }
                else { u32x2 w; w.x = pk2(v[j][0], v[j][1]); w.y = pk2(v[j][2], v[j][3]); ho[64 * j] = w; } }
            if (FLAGS & 8) {
                float lg[8];
#pragma unroll
                for (int e = 0; e < 8; ++e) { float s = 0.f;
#pragma unroll
                    for (int j = 0; j < 4; ++j) { const f32x4 w = *(const LAS f32x4*)(rwt + e * DM + 4 * F.lane + 256 * j); s += (v[j][0] * w[0] + v[j][1] * w[1]) + (v[j][2] * w[2] + v[j][3] * w[3]); }
                    lg[e] = wave_sum(s) + A.in[I_RB][rl * NEXP + e]; }
                int e0 = 0; float l0 = lg[0];
#pragma unroll
                for (int e = 1; e < 8; ++e) if (lg[e] > l0) { l0 = lg[e]; e0 = e; }
                int e1 = -1; float l1 = -3.0e38f;
#pragma unroll
                for (int e = 0; e < 8; ++e) if (e != e0 && lg[e] > l1) { l1 = lg[e]; e1 = e; }
                const float g0 = 1.0f / (1.0f + __expf(l1 - l0)), g1 = 1.0f - g0;
                const int lr = F.wave * 8 + (it & 7);
                if (F.lane == 0) { rE[lr] = e0; rE[64 + lr] = e1; rE[128 + lr] = __float_as_int(g0); rE[192 + lr] = __float_as_int(g1); }
            }
        }
        if (RT && (it & 7) == 7) {
            __syncthreads();
            if (F.tid < 8) { int cnt = 0; for (int q = 0; q < 64; ++q) cnt += (rE[q] == F.tid) + (rE[64 + q] == F.tid);
                rE[256 + F.tid] = cnt ? (int)__hip_atomic_fetch_add(F.ctl + CW_CNT + 64 * (8 * cs + F.tid), (unsigned)cnt, RLX_AGENT) : 0; }
            __syncthreads();
            if (F.tid < 64) { const int e0 = rE[F.tid], e1 = rE[64 + F.tid]; int r0 = 0, r1 = 0;
                for (int q = 0; q < F.tid; ++q) { r0 += (rE[q] == e0) + (rE[64 + q] == e0); r1 += (rE[q] == e1) + (rE[64 + q] == e1); }
                const int p0 = rE[256 + e0] + r0, p1 = rE[256 + e1] + r1, grow = chunk * 64 + F.tid;
                gu32* ri = (gu32*)(F.ws + roff + WS_ROWIDX); gu32* gp = (gu32*)(F.ws + roff + WS_GATEP); gu32* sl = (gu32*)(F.ws + roff + WS_SLOT);
                __hip_atomic_store(ri + e0 * 16384 + p0, (unsigned)grow, RLX_AGENT); __hip_atomic_store(ri + e1 * 16384 + p1, (unsigned)grow, RLX_AGENT);
                __hip_atomic_store(gp + e0 * 16384 + p0, (unsigned)rE[128 + F.tid], RLX_AGENT); __hip_atomic_store(gp + e1 * 16384 + p1, (unsigned)rE[192 + F.tid], RLX_AGENT);
                __hip_atomic_store(sl + grow * 2, (unsigned)((e0 << 16) | p0), RLX_AGENT); __hip_atomic_store(sl + grow * 2 + 1, (unsigned)((e1 << 16) | p1), RLX_AGENT); }
            __syncthreads();
        }
    }
}

__device__ __forceinline__ void unpack8(const u32x4 w, float (&f)[8]) { f[0] = bflo(w.x); f[1] = bfhi(w.x); f[2] = bflo(w.y); f[3] = bfhi(w.y); f[4] = bflo(w.z); f[5] = bfhi(w.z); f[6] = bflo(w.w); f[7] = bfhi(w.w); }
__device__ __forceinline__ void conv_phase(Frame& F, const float* cw  ) {
    const int gw = F.vcu * NWAVES + F.wave, NGW = F.G * NWAVES;
    const bf16_t* UB = F.BUF;
    for (int task = gw; task < M / 8; task += NGW) {
        const int r0 = task * 8; const bool first = (r0 % SEQ) == 0;
#pragma unroll
        for (int j = 0; j < 2; ++j) {
            const int ch = 8 * F.lane + 512 * j;
            float w0[8], w1[8], w2[8];
#pragma unroll
            for (int e = 0; e < 8; ++e) { w0[e] = cw[ch + e]; w1[e] = cw[DM + ch + e]; w2[e] = cw[2 * DM + ch + e]; }
            float um2[8], um1[8];
            if (first) {
#pragma unroll
                for (int e = 0; e < 8; ++e) { um2[e] = 0.f; um1[e] = 0.f; }
            } else { unpack8(*(const u32x4*)(UB + (size_t)(r0 - 2) * 2048 + ch), um2); unpack8(*(const u32x4*)(UB + (size_t)(r0 - 1) * 2048 + ch), um1); }
#pragma unroll
            for (int i = 0; i < 8; ++i) {
                float u0[8], bb[8]; unpack8(*(const u32x4*)(UB + (size_t)(r0 + i) * 2048 + ch), u0); unpack8(*(const u32x4*)(UB + (size_t)(r0 + i) * 2048 + 1024 + ch), bb);
                float z[8];
#pragma unroll
                for (int e = 0; e < 8; ++e) z[e] = bb[e] * (w0[e] * um2[e] + w1[e] * um1[e] + w2[e] * u0[e]);
                u32x4 o; o.x = pk2(z[0], z[1]); o.y = pk2(z[2], z[3]); o.z = pk2(z[4], z[5]); o.w = pk2(z[6], z[7]);
                *(u32x4*)(F.HB + (size_t)(r0 + i) * DM + ch) = o;
#pragma unroll
                for (int e = 0; e < 8; ++e) { um2[e] = um1[e]; um1[e] = u0[e]; }
            }
        }
    }
}

constexpr int QIP = 1040;
constexpr int AL_QI = 0, AL_WI = 33280, AL_SEL = 34304, AL_V = 42496, AL_BIASD = 108032, AL_SUM = 116288, AL_END = 116800;
typedef short v4i16_t __attribute__((ext_vector_type(4)));
__device__ __forceinline__ unsigned okey(float f) { const unsigned u = __float_as_uint(f); return u ^ ((u >> 31) ? 0xFFFFFFFFu : 0x80000000u); }
__device__ __forceinline__ void attn_phase(Frame& F, const Args& A) {
    LAS unsigned char* L = F.lds;
    const bf16_t* Qb = (const bf16_t*)(F.ws + WS_Q); const bf16_t* Kb = (const bf16_t*)(F.ws + WS_K); const bf16_t* Vb = (const bf16_t*)(F.ws + WS_V);
    const bf16_t* QIb = (const bf16_t*)(F.ws + WS_QI); const bf16_t* KIb = (const bf16_t*)(F.ws + WS_KI); const float* WIb = (const float*)(F.ws + WS_WI);
    bf16_t* Ob = (bf16_t*)(F.ws + WS_O);
    float* SC = (float*)(F.ws + WS_SC) + (size_t)blockIdx.x * 32 * SEQ;
    const int lane = F.lane, wave = F.wave;
    { LAS float* bd = (LAS float*)(L + AL_BIASD);
      for (int i = F.tid; i < 129 * 16; i += NTHREADS) { const int d = i >> 4; int bkt; if (d < 16) bkt = d; else { const float dd = (float)d; const int lg2 = 16 + (int)(logf(dd / 16.0f) / 2.0794415416798357f * 16.0f); bkt = lg2 < 31 ? lg2 : 31; }
          bd[i] = A.in[I_RELB][bkt * 16 + (i & 15)]; }
    }
    __syncthreads();
    for (int pass = 0; pass < 2; ++pass) {
        const int un = pass == 0 ? (int)blockIdx.x : 511 - (int)blockIdx.x;
        for (int uu = un; uu >= 0 && uu < 512; uu += (pass == 0 ? F.G * 2 : -F.G * 2)) {
        if ((pass == 0 && uu >= 256) || (pass == 1 && uu < 256)) break;
        const int b = uu & 3, qb = uu >> 2, t0 = qb * 32; const size_t rb = (size_t)b * SEQ;
        for (int i = F.tid; i < 32 * 64; i += NTHREADS) { const int q = i >> 6, c = i & 63; *(LAS u32x4*)(L + AL_QI + q * QIP + c * 16) = *(const u32x4*)(QIb + (rb + t0 + q) * 512 + c * 8); }
        if (F.tid < 256) ((LAS float*)(L + AL_WI))[F.tid] = WIb[(rb + t0) * 8 + F.tid];
        __syncthreads();
        {
            for (int kt = wave; kt <= qb; kt += NWAVES) {
                int ln1 = lane; asm volatile("" : "+v"(ln1));
                const int r = ln1 & 31, hh = ln1 >> 5;
                float wi[8];
#pragma unroll
                for (int h = 0; h < 8; ++h) wi[h] = ((LAS float*)(L + AL_WI))[r * 8 + h];
                bf16x8 ka[4];
#pragma unroll
                for (int ks = 0; ks < 4; ++ks) ka[ks] = *(const bf16x8*)(KIb + (rb + kt * 32 + r) * 64 + 16 * ks + 8 * hh);
                f32x16 sc;
#pragma unroll
                for (int i = 0; i < 16; ++i) sc[i] = 0.f;
#pragma unroll
                for (int h = 0; h < 8; ++h) {
                    f32x16 d;
#pragma unroll
                    for (int i = 0; i < 16; ++i) d[i] = 0.f;
#pragma unroll
                    for (int ks = 0; ks < 4; ++ks) { const bf16x8 qf = *(const LAS bf16x8*)(L + AL_QI + r * QIP + (h * 64 + 16 * ks + 8 * hh) * 2); d = __builtin_amdgcn_mfma_f32_32x32x16_bf16(ka[ks], qf, d, 0, 0, 0); }
#pragma unroll
                    for (int i = 0; i < 16; ++i) sc[i] += wi[h] * fmaxf(d[i], 0.f);
                }
#pragma unroll
                for (int a = 0; a < 4; ++a) { f32x4 o;
#pragma unroll
                    for (int e = 0; e < 4; ++e) { const int krow = 8 * a + 4 * hh + e; o[e] = (kt == qb && krow > r) ? -INFINITY : sc[4 * a + e]; }
                    *(f32x4*)(SC + (size_t)r * SEQ + kt * 32 + 8 * a + 4 * hh) = o; }
            }
        }
        VM_WAIT(); __syncthreads();
        for (int qq = 0; qq < 4; ++qq) {
            const int c = wave + 8 * qq, t = t0 + c; const int nvalid = t + 1;
            int lane = F.lane; asm volatile("" : "+v"(lane));
            LAS int* sel = (LAS int*)(L + AL_SEL) + wave * 256;
            int count;
            if (nvalid <= TOPK) {
                count = nvalid;
#pragma unroll
                for (int j = 0; j < 4; ++j) { const int idx = 64 * j + lane; sel[idx] = idx < nvalid ? idx : 0; }
            } else {
                count = TOPK;
                const int nj = (nvalid + 63) >> 6;
                unsigned key[64];
                const float* srow = SC + (size_t)c * SEQ;
#define SEL_GROUPS(BODY) do { BODY(0) if (nj > 16) { BODY(1) if (nj > 32) { BODY(2) if (nj > 48) { BODY(3) } } } } while (0)
#define SEL_LOAD(g) { _Pragma("unroll") for (int j = 16 * (g); j < 16 * (g) + 16; ++j) { const int idx = 64 * j + lane; const float sv = __uint_as_float(__hip_atomic_load((const gu32*)(srow + idx), RLX_AGENT)); key[j] = idx <= t ? okey(sv) : 0u;     } }
#pragma unroll
                for (int j = 0; j < 64; ++j) key[j] = 0u;
                SEL_GROUPS(SEL_LOAD);
                unsigned T = 0u;
                for (int bit = 31; bit >= 0; --bit) {
                    const unsigned cand = T | (1u << bit); int cnt = 0;
#define SEL_CNT(g) { _Pragma("unroll") for (int j = 16 * (g); j < 16 * (g) + 16; ++j) cnt += __popcll(__ballot(key[j] >= cand)); }
                    SEL_GROUPS(SEL_CNT);
                    if (cnt >= TOPK) T = cand;
                    if (cnt == TOPK) break;
                }
                int base = 0;
#define SEL_GT(g) { _Pragma("unroll") for (int j = 16 * (g); j < 16 * (g) + 16; ++j) { const bool gt = key[j] > T; const unsigned long long mk = __ballot(gt); \
                    const int pos = base + (int)__builtin_amdgcn_mbcnt_hi((unsigned)(mk >> 32), __builtin_amdgcn_mbcnt_lo((unsigned)mk, 0u)); if (gt) sel[pos] = 64 * j + lane; base += __popcll(mk); } }
                SEL_GROUPS(SEL_GT);
                const int need = TOPK - base; int eb = 0;
#define SEL_EQ(g) { _Pragma("unroll") for (int j = 16 * (g); j < 16 * (g) + 16; ++j) { const bool eq = key[j] == T; const unsigned long long mk = __ballot(eq); \
                    const int rank = eb + (int)__builtin_amdgcn_mbcnt_hi((unsigned)(mk >> 32), __builtin_amdgcn_mbcnt_lo((unsigned)mk, 0u)); if (eq && rank < need) sel[base + rank] = 64 * j + lane; eb += __popcll(mk); } }
                SEL_GROUPS(SEL_EQ);
#undef SEL_GROUPS
#undef SEL_LOAD
#undef SEL_CNT
#undef SEL_GT
#undef SEL_EQ
            }
            LDS_WAIT(); CFENCE();
            asm volatile("" : "+v"(lane));
            const int hd = lane & 15, kq = lane >> 4;
            bf16x8 bq[8];
            { bf16x8 qf[2];
#pragma unroll
              for (int s2 = 0; s2 < 2; ++s2) qf[s2] = *(const bf16x8*)(Qb + (rb + t) * 1024 + hd * 64 + 32 * s2 + 8 * kq);
              const bf16x8 zf = (bf16x8){0, 0, 0, 0, 0, 0, 0, 0};
#pragma unroll
              for (int ks = 0; ks < 8; ++ks) bq[ks] = ((ks >> 1) == (hd >> 2)) ? qf[ks & 1] : zf; }
            f32x4 lg[16];
            float mx = -INFINITY;
            bf16x8 kf[3][8];
#pragma unroll
            for (int pre = 0; pre < 2; ++pre) { const int krow = sel[16 * pre + hd]; const bf16_t* kp = Kb + (rb + krow) * 256 + 8 * kq;
#pragma unroll
              for (int ks = 0; ks < 8; ++ks) kf[pre][ks] = *(const bf16x8*)(kp + 32 * ks); }
            const LAS float* biasd = (const LAS float*)(L + AL_BIASD);
#pragma unroll
            for (int kt = 0; kt < 16; ++kt) {
                if (kt < 14) { const int krow = sel[16 * (kt + 2) + hd]; const bf16_t* kp = Kb + (rb + krow) * 256 + 8 * kq;
#pragma unroll
                    for (int ks = 0; ks < 8; ++ks) kf[(kt + 2) % 3][ks] = *(const bf16x8*)(kp + 32 * ks); }
                f32x4 d = (f32x4){0.f, 0.f, 0.f, 0.f};
#pragma unroll
                for (int ks = 0; ks < 8; ++ks) d = __builtin_amdgcn_mfma_f32_16x16x32_bf16(kf[kt % 3][ks], bq[ks], d, 0, 0, 0);
                const u32x4 ks4 = *(const LAS u32x4*)(sel + 16 * kt + 4 * kq);
#pragma unroll
                for (int i = 0; i < 4; ++i) { const int pos = 16 * kt + 4 * kq + i; int dist = t - (int)ks4[i]; dist = dist < 0 ? 0 : (dist > 128 ? 128 : dist);
                    const float bs = biasd[dist * 16 + hd];
                    d[i] = pos < count ? d[i] + bs : -INFINITY; mx = fmaxf(mx, d[i]); }
                lg[kt] = d;
            }
            mx = fmaxf(mx, __shfl_xor(mx, 16)); mx = fmaxf(mx, __shfl_xor(mx, 32));
            float sum = 0.f;
            bf16x8 pa[8];
#pragma unroll
            for (int ks = 0; ks < 8; ++ks) { float p[8];
#pragma unroll
                for (int i = 0; i < 4; ++i) { p[i] = __expf(lg[2 * ks][i] - mx); p[4 + i] = __expf(lg[2 * ks + 1][i] - mx); }
                sum += ((p[0] + p[1]) + (p[2] + p[3])) + ((p[4] + p[5]) + (p[6] + p[7]));
                u32x4 w; w.x = cvt_pk_bf16(p[0], p[1]); w.y = cvt_pk_bf16(p[2], p[3]); w.z = cvt_pk_bf16(p[4], p[5]); w.w = cvt_pk_bf16(p[6], p[7]);
                pa[ks] = __builtin_bit_cast(bf16x8, w); }
            sum += __shfl_xor(sum, 16); sum += __shfl_xor(sum, 32);
            if (kq == 0) ((LAS float*)(L + AL_SUM))[wave * 16 + hd] = sum;
            LDS_WAIT(); CFENCE();
            {
                asm volatile("" : "+v"(lane));
                const int rs = lane >> 3, ch = lane & 7, i16 = lane & 15, tq = i16 >> 2, tp = i16 & 3, kq2 = lane >> 4;
                LAS unsigned char* vb = L + AL_V + wave * 8192;
                const unsigned wr_off = (unsigned)lane * 16u, tr_off = (unsigned)((4 * kq2 + tq) * 128 + 8 * tp);
                f32x4 O[4][4];
#pragma unroll
                for (int n = 0; n < 4; ++n)
#pragma unroll
                    for (int dt = 0; dt < 4; ++dt) O[n][dt] = (f32x4){0.f, 0.f, 0.f, 0.f};
                u32x4 vr[2][4]; int kr[4];
                const bf16_t* vbase = Vb + rb * 256 + 8 * ch;
#pragma unroll
                for (int i = 0; i < 4; ++i) kr[i] = sel[8 * i + rs];
#pragma unroll
                for (int pre = 0; pre < 2; ++pre)
#pragma unroll
                    for (int i = 0; i < 4; ++i) vr[pre][i] = *(const u32x4*)(vbase + (size_t)kr[i] * 256 + pre * 64);
#pragma unroll
                for (int st = 0; st < 32; ++st) {
                    const int ks = st >> 2, n = st & 3;
                    LAS unsigned char* buf = vb + (st & 1) * 4096;
#pragma unroll
                    for (int i = 0; i < 4; ++i) *(LAS u32x4*)(buf + wr_off + i * 1024) = vr[st & 1][i];
                    if (st < 30) { const int ks2 = (st + 2) >> 2, n2 = (st + 2) & 3;
                        if (n2 == 0) {
#pragma unroll
                            for (int i = 0; i < 4; ++i) kr[i] = sel[32 * ks2 + 8 * i + rs]; }
#pragma unroll
                        for (int i = 0; i < 4; ++i) vr[st & 1][i] = *(const u32x4*)(vbase + (size_t)kr[i] * 256 + n2 * 64); }
#pragma unroll
                    for (int dt = 0; dt < 4; ++dt) {
                        const v4i16_t t0 = __builtin_amdgcn_ds_read_tr16_b64_v4i16((LAS v4i16_t*)(buf + tr_off + 32 * dt));
                        const v4i16_t t1 = __builtin_amdgcn_ds_read_tr16_b64_v4i16((LAS v4i16_t*)(buf + tr_off + 2048 + 32 * dt));
                        const bf16x8 bfr = (bf16x8){t0[0], t0[1], t0[2], t0[3], t1[0], t1[1], t1[2], t1[3]};
                        O[n][dt] = __builtin_amdgcn_mfma_f32_16x16x32_bf16(pa[ks], bfr, O[n][dt], 0, 0, 0); }
                    CFENCE();
                }
                const f32x4 sm = *(const LAS f32x4*)(L + AL_SUM + (wave * 16 + 4 * kq2) * 4);
                bf16_t* op = Ob + (rb + t) * 1024 + (4 * kq2) * 64 + i16;
#pragma unroll
                for (int dt = 0; dt < 4; ++dt)
#pragma unroll
                    for (int i = 0; i < 4; ++i) { const float v = kq2 == 0 ? O[0][dt][i] : (kq2 == 1 ? O[1][dt][i] : (kq2 == 2 ? O[2][dt][i] : O[3][dt][i]));
                        op[i * 64 + 16 * dt] = (bf16_t)f2bf(v / sm[i]); }
            }
            LDS_WAIT(); CFENCE();
        }
        __syncthreads();
        }
    }
}

constexpr int SL_BMT = 0;
constexpr int SL_CMA = 4096;
constexpr int SL_AB = 12288;
constexpr int SL_E = 12800;
constexpr int SL_S = 16896;
constexpr int SPITCH = 272;
__device__ __forceinline__ void cmul(float ar, float ai, float br, float bi, float& cr, float& ci) { cr = ar * br - ai * bi; ci = ar * bi + ai * br; }
__device__ __forceinline__ void ssm_phase(Frame& F, const Args& A) {
    LAS unsigned char* L = F.lds;
    const int lane = F.lane, wave = F.wave;
    bf16_t* G = (bf16_t*)(F.ws + WS_ACT);
    for (int un = F.vcu; un < NB * 64; un += F.G) {
        const int b = un >> 6, g = un & 63; const size_t rb = (size_t)b * SEQ;
        __syncthreads();
        if (F.tid < 64) {
            const int p = F.tid;
            const float lr = fminf(A.in[I_SLRE][g * 64 + p], -1e-4f), li = A.in[I_SLIM][g * 64 + p];
            const float step = expf(A.in[I_SLOG][g]);
            const float mag = expf(lr * step); float sn, cs; sincosf(li * step, &sn, &cs);
            const float ar = mag * cs, ai = mag * sn;
            ((LAS float*)(L + SL_AB))[2 * p] = ar; ((LAS float*)(L + SL_AB))[2 * p + 1] = ai;
            const float nr = ar - 1.0f, ni = ai, den = lr * lr + li * li;
            const float cr = (nr * lr + ni * li) / den, ci = (ni * lr - nr * li) / den;
            LAS bf16_t* bm = (LAS bf16_t*)(L + SL_BMT);
#pragma unroll
            for (int c = 0; c < 16; ++c) { const float br = A.in[I_SBRE][((size_t)g * 64 + p) * 16 + c], bi = A.in[I_SBIM][((size_t)g * 64 + p) * 16 + c];
                float xr, xi; cmul(cr, ci, br, bi, xr, xi); bm[p * 16 + c] = (bf16_t)f2bf(xr); bm[(64 + p) * 16 + c] = (bf16_t)f2bf(xi); }
        }
        { LAS bf16_t* cm = (LAS bf16_t*)(L + SL_CMA);
          for (int i = F.tid; i < 32 * 128; i += NTHREADS) { const int c = i >> 7, k = i & 127; float v = 0.f;
              if (c < 16) v = (k < 64) ? A.in[I_SCRE][((size_t)g * 16 + c) * 64 + k] : -A.in[I_SCIM][((size_t)g * 16 + c) * 64 + (k - 64)];
              cm[i] = (bf16_t)f2bf(v); } }
        __syncthreads();
        const int r = lane & 31, hh = lane >> 5;
        bf16x8 bfr[4];
#pragma unroll
        for (int n = 0; n < 4; ++n) bfr[n] = *(const LAS bf16x8*)(L + SL_BMT + ((32 * n + r) * 16 + 8 * hh) * 2);
        bf16x8 cfr[8];
#pragma unroll
        for (int ks = 0; ks < 8; ++ks) cfr[ks] = *(const LAS bf16x8*)(L + SL_CMA + (r * 128 + 16 * ks + 8 * hh) * 2);
        float ar[2], ai[2], a16r[2], a16i[2], a512r[2], a512i[2];
#pragma unroll
        for (int s = 0; s < 2; ++s) { ar[s] = ((LAS float*)(L + SL_AB))[2 * (32 * s + r)]; ai[s] = ((LAS float*)(L + SL_AB))[2 * (32 * s + r) + 1];
            float pr = ar[s], pi = ai[s];
#pragma unroll
            for (int q = 0; q < 4; ++q) { float nr, ni; cmul(pr, pi, pr, pi, nr, ni); pr = nr; pi = ni; }
            a16r[s] = pr; a16i[s] = pi;
#pragma unroll
            for (int q = 0; q < 5; ++q) { float nr, ni; cmul(pr, pi, pr, pi, nr, ni); pr = nr; pi = ni; }
            a512r[s] = pr; a512i[s] = pi; }
        const int tokperm = 16 * ((r >> 2) & 1) + 4 * (r >> 3) + (r & 3);
        const float dsk0 = 0.f; (void)dsk0;
        float cin_r[2] = {0.f, 0.f}, cin_i[2] = {0.f, 0.f};
        LAS unsigned char* Sw = L + SL_S + wave * (32 * SPITCH);
        for (int pass = 0; pass < 2; ++pass) {
            if (pass == 1) {
                __syncthreads();
#pragma unroll
                for (int s = 0; s < 2; ++s) { float cr = 0.f, ci = 0.f;
                    for (int w = 0; w < wave; ++w) { float nr, ni; cmul(a512r[s], a512i[s], cr, ci, nr, ni); cr = nr + ((LAS float*)(L + SL_E))[(w * 64 + 32 * s + r) * 2]; ci = ni + ((LAS float*)(L + SL_E))[(w * 64 + 32 * s + r) * 2 + 1]; }
                    cin_r[s] = cr; cin_i[s] = ci; }
            }
            bf16x8 ufn = *(const bf16x8*)(F.HB + (rb + wave * 512 + tokperm) * DM + 16 * g + 8 * hh);
            for (int tile = 0; tile < 16; ++tile) {
                asm volatile("s_waitcnt vmcnt(0) lgkmcnt(0)" ::: "memory"); __builtin_amdgcn_s_barrier(); asm volatile("" ::: "memory");
                const int tk0 = wave * 512 + tile * 32;
                const bf16x8 uf = ufn;
                if (tile < 15) ufn = *(const bf16x8*)(F.HB + (rb + tk0 + 32 + tokperm) * DM + 16 * g + 8 * hh);

                f32x16 d[4];
#pragma unroll
                for (int n = 0; n < 4; ++n) {
#pragma unroll
                    for (int i = 0; i < 16; ++i) d[n][i] = 0.f;
                    d[n] = __builtin_amdgcn_mfma_f32_32x32x16_bf16(uf, bfr[n], d[n], 0, 0, 0); }
                asm volatile("s_nop 15\n\ts_nop 15\n\ts_nop 15" : "+v"(d[0]), "+v"(d[1]), "+v"(d[2]), "+v"(d[3]));
#pragma unroll
                for (int s = 0; s < 2; ++s) {
                    float sr = hh == 0 ? cin_r[s] : 0.f, si = hh == 0 ? cin_i[s] : 0.f;
#pragma unroll
                    for (int i = 0; i < 16; ++i) { const float nr = ar[s] * sr - ai[s] * si + d[s][i], ni = ar[s] * si + ai[s] * sr + d[2 + s][i]; sr = nr; si = ni; d[s][i] = sr; d[2 + s][i] = si; }
                    const float e0r = __shfl_xor(sr, 32), e0i = __shfl_xor(si, 32);
                    float cr = hh == 1 ? e0r : 0.f, ci = hh == 1 ? e0i : 0.f;
                    if (pass == 1) {
#pragma unroll
                        for (int i = 0; i < 16; ++i) { float nr, ni; cmul(ar[s], ai[s], cr, ci, nr, ni); cr = nr; ci = ni; d[s][i] += cr; d[2 + s][i] += ci; }
                    } else { float nr, ni; cmul(a16r[s], a16i[s], cr, ci, nr, ni); cr = nr; ci = ni; }
                    const float endr = (pass == 1) ? d[s][15] : sr + cr, endi = (pass == 1) ? d[2 + s][15] : si + ci;
                    const float xr = __shfl_xor(endr, 32), xi = __shfl_xor(endi, 32);
                    cin_r[s] = hh == 1 ? endr : xr; cin_i[s] = hh == 1 ? endi : xi;
                }
                if (pass == 1) {
#pragma unroll
                    for (int s = 0; s < 2; ++s)
#pragma unroll
                        for (int i = 0; i < 16; ++i) { *(LAS bf16_t*)(Sw + (16 * hh + i) * SPITCH + (32 * s + r) * 2) = (bf16_t)f2bf(d[s][i]); *(LAS bf16_t*)(Sw + (16 * hh + i) * SPITCH + (64 + 32 * s + r) * 2) = (bf16_t)f2bf(d[2 + s][i]); }
                    LDS_WAIT(); CFENCE();
                    f32x16 y;
#pragma unroll
                    for (int i = 0; i < 16; ++i) y[i] = 0.f;
#pragma unroll
                    for (int ks = 0; ks < 8; ++ks) { const bf16x8 sf = *(const LAS bf16x8*)(Sw + r * SPITCH + (16 * ks + 8 * hh) * 2); y = __builtin_amdgcn_mfma_f32_32x32x16_bf16(cfr[ks], sf, y, 0, 0, 0); }
                    LDS_WAIT(); CFENCE();
                    const size_t trow = rb + tk0 + r;
#pragma unroll
                    for (int q = 0; q < 2; ++q) { const int ch = 16 * g + 8 * q + 4 * hh;
                        const u32x2 hv = *(const u32x2*)(F.HB + trow * DM + ch); const f32x4 dk = *(const f32x4*)(A.in[I_SD] + ch);
                        const float y0 = gelu_tanh_f(y[4 * q + 0] + dk[0] * bflo(hv.x)), y1 = gelu_tanh_f(y[4 * q + 1] + dk[1] * bfhi(hv.x)), y2 = gelu_tanh_f(y[4 * q + 2] + dk[2] * bflo(hv.y)), y3 = gelu_tanh_f(y[4 * q + 3] + dk[3] * bfhi(hv.y));
                        u32x2 w; w.x = pk2(y0, y1); w.y = pk2(y2, y3); *(u32x2*)(G + trow * DM + ch) = w; }
                }
            }
            if (pass == 0) {
                if (hh == 1) {
#pragma unroll
                    for (int s = 0; s < 2; ++s) { ((LAS float*)(L + SL_E))[(wave * 64 + 32 * s + r) * 2] = cin_r[s]; ((LAS float*)(L + SL_E))[(wave * 64 + 32 * s + r) * 2 + 1] = cin_i[s]; } }
                cin_r[0] = cin_r[1] = cin_i[0] = cin_i[1] = 0.f;
            }
        }
    }
}

enum { PH_PRO = 0, PH_NORM0,
       L0_G1, L0_CONV, L0_G2, L0_NORM, L0_F1, L0_F2, L0_NORMN,
       L1_G1, L1_ATTN, L1_G2, L1_NORMR, L1_M1, L1_M2, L1_COMB,
       L2_SSM, L2_G2, L2_NORM, L2_F1, L2_F2, L2_NORMN,
       L3_G1, L3_CONV, L3_G2, L3_NORMR, L3_M1, L3_M2, L3_COMB, NPH };

__device__ __forceinline__ bool fresh_ids(Frame& F) { const int l = lane_id_fresh(); F.lane = l; F.tid = F.wave * 64 + l; return true; }
__global__ void __launch_bounds__(NTHREADS, 2) mega_fwd(Args args) {
    extern __shared__ __attribute__((aligned(16))) unsigned char lds_raw[];
    Frame F;
    F.lds = (LAS unsigned char*)lds_raw;
    volatile LAS unsigned* MISC = (volatile LAS unsigned*)(F.lds + MISC_OFF);
    F.tid = threadIdx.x; F.lane = F.tid & 63; F.wave = __builtin_amdgcn_readfirstlane(F.tid >> 6);
    F.G = gridDim.x; { const int bx = blockIdx.x; F.vcu = (F.G % 8 == 0) ? (bx % 8) * (F.G / 8) + bx / 8 : bx; }
    F.ws = args.ws; F.ctl = (gu32*)(args.ws + WS_CTL); F.out = args.out; F.mod = (const float*)(args.ws + WS_MOD);
    F.HB = (bf16_t*)(args.ws + WS_HB); F.BUF = (bf16_t*)(args.ws + WS_BUF); F.ACT = (bf16_t*)(args.ws + WS_ACT);
    for (int u = F.tid; u < (LDS_BYTES - LDSCTL_OFF) / 4; u += NTHREADS) ((LAS unsigned*)(F.lds + LDSCTL_OFF))[u] = 0u;
    __syncthreads();
    XcdBarrier bar; bar.bar = (unsigned*)(F.ctl + CW_BAR); bar.x = 0; bar.st = nullptr; bar.w = F.wave;
    const int lo = args.ph_lo, hi = args.ph_hi;
    if (hi - lo > 1) bar = xcd_barrier_post((unsigned*)(F.ctl + CW_BAR), MISC + 8, F.wave);
#ifndef PH_ONLY
#define PH_EN(k) true
#else
#define PH_EN(k) ((k) == PH_ONLY)
#endif
#define IN(k) (PH_EN(k) && lo <= (k) && (k) < hi && fresh_ids(F))
#define SEAM(k) do { if (IN(k) && IN((k) + 1)) xcd_barrier(bar); } while (0)
#ifndef PH_REP
#define PH_REP (-1)
#endif
#ifndef PH_REPMASK
#define PH_REPMASK 0ull
#endif
#define REPB(k, ...) do { if (PH_REP == (k) || ((PH_REPMASK >> (k)) & 1ull)) { xcd_barrier(bar); __VA_ARGS__; } } while (0)
    LAS unsigned char* ring = F.lds;
    const int cid = (int)blockIdx.x;
    bf16_t* const WCI = (bf16_t*)(F.ws + WS_WCI); bf16_t* const WCO = (bf16_t*)(F.ws + WS_WCO); bf16_t* const WAI = (bf16_t*)(F.ws + WS_WAI); bf16_t* const WAO = (bf16_t*)(F.ws + WS_WAO);
    bf16_t* const WGL = (bf16_t*)(F.ws + WS_WGL); bf16_t* const WFG = (bf16_t*)(F.ws + WS_WFG); bf16_t* const WFD = (bf16_t*)(F.ws + WS_WFD); bf16_t* const WMG = (bf16_t*)(F.ws + WS_WMG); bf16_t* const WMD = (bf16_t*)(F.ws + WS_WMD);

#define ZEROG ((const float*)(F.ws + 512 * 1024))
    const bool fuseR = (F.G == 256) && FUSE_R;
    const bool fuse = (F.G == 256) && FUSE_N;
#define FUSED_EPI(inst, gatep, xin, nl, ns, hout, asc, h8_) ({F.out, (gatep), (xin), args.in[I_NORMG] + (size_t)((nl) * 2 + (ns)) * DM, F.mod + (size_t)(nl) * NB * 6144 + ((ns) ? 3 : 0) * DM, (hout), (float*)(F.ws + WS_XS), F.ctl + CW_PAN + 64 * 64 * (inst), F.ctl + CW_TMO, (asc), (h8_)})
#define FUSED_RT(inst, gatep, nl, rl, roff, hout, h8_) ({F.out, (gatep), args.in[I_NORMG] + (size_t)((nl) * 2 + 1) * DM, F.mod + (size_t)(nl) * NB * 6144 + 3 * DM, (hout), (float*)(F.ws + WS_XS9), F.ctl + CW_PAN + 64 * 64 * (inst), F.ctl + CW_TMO, \
        args.in[I_RW] + (size_t)(rl) * DM * NEXP, args.in[I_RB] + (rl) * NEXP, F.ctl + CW_CNT + 64 * 8 * (rl), F.ws + (roff), (h8_)})
#define MODP(l, chunk) (F.mod + (size_t)(l) * NB * 6144 + (chunk) * DM)
#define GEMM_STATIC(Aptr, Bptr, Nn, Kk, EpiT, EpiInit) do { pg8::Gemm g{(Aptr), (Bptr), M, (Nn), (Kk), 0, nullptr, nullptr}; pg8::StaticOrder S; S.init(M, (Nn), F.G, cid); EpiT E EpiInit; \
        pg8::gemm_phase<EpiT, pg8::StaticOrder, false>(ring, g, S, E, F.wave); } while (0)
#define GEMM_STATIC8(Aptr, Bptr, Nn, Kk, EpiT, EpiInit) do { pg8::Gemm g{(Aptr), (Bptr), M, (Nn), (Kk), 0, nullptr, nullptr}; pg8::StaticOrder S; S.init(M, (Nn), F.G, cid); EpiT E EpiInit; \
        pg8::gemm_phase<EpiT, pg8::StaticOrder, false, true>(ring, g, S, E, F.wave); } while (0)
#define EPAIR8 pg8::EpiPair<1, (M2_FP8 != 0), (M1_FP8 != 0)>
#define M1_B (M1_FP8 ? 1 : 2)
#define EPAIR8L1 pg8::EpiPair<1, (M2_FP8 != 0), (M1L1_FP8 != 0)>
#define M2_B (M2_FP8 ? 1 : 2)
#define F2_ASC (F2_FP8 ? pg8::W8_INV : 1.0f)
#define GEMM_STATICF(Aptr, Bptr, Nn, Kk, EpiT, EpiInit) do { pg8::Gemm g{(Aptr), (Bptr), M, (Nn), (Kk), 0, nullptr, nullptr}; pg8::StaticOrder S; S.init(M, (Nn), F.G, cid); EpiT E EpiInit; \
        pg8::gemm_phase<EpiT, pg8::StaticOrder, false, (F2_FP8 != 0)>(ring, g, S, E, F.wave); } while (0)
#define EPAIRF pg8::EpiPair<1, (F2_FP8 != 0), false>
#define F0_FP8 (F2_FP8 || F2L0_FP8)
#define F2L0_ASC (F0_FP8 ? pg8::W8_INV : 1.0f)
#define EPAIR0 pg8::EpiPair<1, (F0_FP8 != 0), false>
#define EPAIR0S pg8::EpiPair<1, (F0_FP8 != 0), (F1L0_FP8 != 0)>
#define GEMM_STATICF0(Aptr, Bptr, Nn, Kk, EpiT, EpiInit) do { pg8::Gemm g{(Aptr), (Bptr), M, (Nn), (Kk), 0, nullptr, nullptr}; pg8::StaticOrder S; S.init(M, (Nn), F.G, cid); EpiT E EpiInit; \
        pg8::gemm_phase<EpiT, pg8::StaticOrder, false, (F0_FP8 != 0)>(ring, g, S, E, F.wave); } while (0)
#define W8(base, bytes) ((bf16_t*)((unsigned char*)(base) + (size_t)(bytes)))

    if (IN(PH_PRO)) { p0_prologue(F, args); REPB(PH_PRO, p0_prologue(F, args)); } SEAM(PH_PRO);
    if (IN(PH_NORM0)) { thin_phase<4>(F, args, args.in[I_X], 0, 0, 0, 0); REPB(PH_NORM0, thin_phase<4>(F, args, args.in[I_X], 0, 0, 0, 0)); } SEAM(PH_NORM0);

    if (IN(L0_G1)) { GEMM_STATIC(F.HB, WCI, 3072, DM, pg8::EpiConvIn, {F.BUF}); REPB(L0_G1, GEMM_STATIC(F.HB, WCI, 3072, DM, pg8::EpiConvIn, {F.BUF})); } SEAM(L0_G1);
    if (IN(L0_CONV)) { conv_phase(F, args.in[I_CW]); REPB(L0_CONV, conv_phase(F, args.in[I_CW])); } SEAM(L0_CONV);
    if (IN(L0_G2)) { if (fuse) GEMM_STATIC(F.HB, WCO, DM, DM, pg8::EpiResNorm, FUSED_EPI(0, MODP(0, 2), args.in[I_X], 0, 1, (fuse ? F.BUF : F.HB), 1.0f, F1L0_FP8)); else GEMM_STATIC(F.HB, WCO, DM, DM, pg8::EpiRes, ({F.out, MODP(0, 2), args.in[I_X], 1.0f})); } SEAM(L0_G2);
    if (!fuse) { if (IN(L0_NORM)) { thin_phase<4>(F, args, F.out, 0, 1, 0, 0); } SEAM(L0_NORM); }
    if (IN(L0_F1)) { pg8::Gemm g{(fuse ? F.BUF : F.HB), WFG, M, 2 * FF, DM, 0, nullptr, nullptr}; pg8::StaticOrder S; S.init(M, 2 * FF, F.G, cid); EPAIR0S E{F.ACT, FF};
        pg8::gemm_phase<EPAIR0S, pg8::StaticOrder, false, (F1L0_FP8 != 0)>(ring, g, S, E, F.wave); } SEAM(L0_F1);
    if (IN(L0_F2)) { if (fuse) GEMM_STATICF0(F.ACT, WFD, DM, FF, pg8::EpiResNorm, FUSED_EPI(1, MODP(0, 5), F.out, 1, 0, F.HB, F2L0_ASC, 0)); else GEMM_STATICF0(F.ACT, WFD, DM, FF, pg8::EpiRes, ({F.out, MODP(0, 5), F.out, F2L0_ASC})); } SEAM(L0_F2);
    if (!fuse) { if (IN(L0_NORMN)) { thin_phase<4>(F, args, F.out, 1, 0, 0, 0); } SEAM(L0_NORMN); }

    if (IN(L1_G1)) { GEMM_STATIC(F.HB, WAI, ATT_NP, DM, pg8::EpiAttnIn, ({(bf16_t*)(F.ws + WS_Q), (bf16_t*)(F.ws + WS_K), (bf16_t*)(F.ws + WS_V), (bf16_t*)(F.ws + WS_QI), (bf16_t*)(F.ws + WS_KI), (float*)(F.ws + WS_WI), args.in[I_QG], args.in[I_KG]})); REPB(L1_G1, GEMM_STATIC(F.HB, WAI, ATT_NP, DM, pg8::EpiAttnIn, ({(bf16_t*)(F.ws + WS_Q), (bf16_t*)(F.ws + WS_K), (bf16_t*)(F.ws + WS_V), (bf16_t*)(F.ws + WS_QI), (bf16_t*)(F.ws + WS_KI), (float*)(F.ws + WS_WI), args.in[I_QG], args.in[I_KG]}))); } SEAM(L1_G1);
    if (IN(L1_ATTN)) { attn_phase(F, args); REPB(L1_ATTN, attn_phase(F, args)); } SEAM(L1_ATTN);
    if (IN(L1_G2)) { if (fuseR) GEMM_STATIC((bf16_t*)(F.ws + WS_O), WAO, DM, DM, pg8::EpiResNormRouter, FUSED_RT(3, MODP(1, 2), 1, 0, 0, F.HB, M1L1_FP8)); else GEMM_STATIC((bf16_t*)(F.ws + WS_O), WAO, DM, DM, pg8::EpiRes, ({F.out, MODP(1, 2), F.out, 1.0f})); } SEAM(L1_G2);
    if (!fuseR) { if (IN(L1_NORMR)) { thin_phase<4 | 8>(F, args, F.out, 1, 1, 0, 0); } SEAM(L1_NORMR); }
    if (IN(L1_M1)) { pg8::Gemm g{F.HB, WMG, M, 2 * FF, DM, (size_t)2 * FF * DM * (M1L1_FP8 ? 1 : 2), (const int*)(F.ws + WS_ROWIDX), (const unsigned*)(F.ctl + CW_CNT)}; pg8::MoeOrder S; S.init((const unsigned*)(F.ctl + CW_CNT), 22, F.G, cid);
        EPAIR8L1 E{F.ACT, FF}; pg8::gemm_phase<EPAIR8L1, pg8::MoeOrder, true, (M1L1_FP8 != 0)>(ring, g, S, E, F.wave); REPB(L1_M1, pg8::gemm_phase<EPAIR8L1, pg8::MoeOrder, true, (M1L1_FP8 != 0)>(ring, g, S, E, F.wave)); } SEAM(L1_M1);
    if (IN(L1_M2)) { pg8::Gemm g{F.ACT, WMD, M, DM, FF, (size_t)DM * FF * M2_B, nullptr, nullptr}; pg8::MoeOrder S; S.init((const unsigned*)(F.ctl + CW_CNT), 4, F.G, cid);
        pg8::EpiMoeDn E{F.BUF, (const float*)(F.ws + WS_GATEP)}; pg8::gemm_phase<pg8::EpiMoeDn, pg8::MoeOrder, false, (M2_FP8 != 0)>(ring, g, S, E, F.wave); REPB(L1_M2, pg8::gemm_phase<pg8::EpiMoeDn, pg8::MoeOrder, false, (M2_FP8 != 0)>(ring, g, S, E, F.wave)); } SEAM(L1_M2);
    if (IN(L1_COMB)) { thin_phase<2 | 4>(F, args, F.out, 2, 0, 1, 0); REPB(L1_COMB, thin_phase<2 | 4>(F, args, F.out, 2, 0, -1, 0)); } SEAM(L1_COMB);

    if (IN(L2_SSM)) { ssm_phase(F, args); REPB(L2_SSM, ssm_phase(F, args)); } SEAM(L2_SSM);
    if (IN(L2_G2)) { GEMM_STATIC(F.ACT, WGL, 2048, DM, pg8::EpiGluRes, ({F.out, MODP(2, 2)})); REPB(L2_G2, GEMM_STATIC(F.ACT, WGL, 2048, DM, pg8::EpiGluRes, ({F.out, ZEROG}))); } SEAM(L2_G2);
    if (IN(L2_NORM)) { thin_phase<4>(F, args, F.out, 2, 1, 0, 0); REPB(L2_NORM, thin_phase<4>(F, args, F.out, 2, 1, 0, 0)); } SEAM(L2_NORM);
    if (IN(L2_F1)) { GEMM_STATIC(F.HB, WFG + (size_t)2 * FF * DM, 2 * FF, DM, EPAIRF, ({F.ACT, FF})); REPB(L2_F1, GEMM_STATIC(F.HB, WFG + (size_t)2 * FF * DM, 2 * FF, DM, EPAIRF, ({F.ACT, FF}))); } SEAM(L2_F1);
    if (IN(L2_F2)) { if (fuse) GEMM_STATICF(F.ACT, W8(WFD, (size_t)DM * FF * (F2_FP8 ? 1 : 2)), DM, FF, pg8::EpiResNorm, FUSED_EPI(2, MODP(2, 5), F.out, 3, 0, F.HB, F2_ASC, 0)); else GEMM_STATICF(F.ACT, W8(WFD, (size_t)DM * FF * (F2_FP8 ? 1 : 2)), DM, FF, pg8::EpiRes, ({F.out, MODP(2, 5), F.out, F2_ASC})); } SEAM(L2_F2);
    if (!fuse) { if (IN(L2_NORMN)) { thin_phase<4>(F, args, F.out, 3, 0, 0, 0); } SEAM(L2_NORMN); }

    if (IN(L3_G1)) { GEMM_STATIC(F.HB, WCI + (size_t)3072 * DM, 3072, DM, pg8::EpiConvIn, {F.BUF}); REPB(L3_G1, GEMM_STATIC(F.HB, WCI + (size_t)3072 * DM, 3072, DM, pg8::EpiConvIn, {F.BUF})); } SEAM(L3_G1);
    if (IN(L3_CONV)) { conv_phase(F, args.in[I_CW] + 3 * DM); REPB(L3_CONV, conv_phase(F, args.in[I_CW] + 3 * DM)); } SEAM(L3_CONV);
    if (IN(L3_G2)) { if (fuseR) GEMM_STATIC(F.HB, WCO + (size_t)DM * DM, DM, DM, pg8::EpiResNormRouter, FUSED_RT(4, MODP(3, 2), 3, 1, 2 * MiB, F.BUF, M1_FP8)); else GEMM_STATIC(F.HB, WCO + (size_t)DM * DM, DM, DM, pg8::EpiRes, ({F.out, MODP(3, 2), F.out, 1.0f})); } SEAM(L3_G2);
    if (!fuseR) { if (IN(L3_NORMR)) { thin_phase<4 | 8>(F, args, F.out, 3, 1, 0, 1, 1, 2 * MiB); } SEAM(L3_NORMR); }
    if (IN(L3_M1)) { pg8::Gemm g{(fuseR ? F.BUF : F.HB), W8(WMG, (size_t)8 * 2 * FF * DM * 2), M, 2 * FF, DM, (size_t)2 * FF * DM * M1_B, (const int*)(F.ws + 2 * MiB + WS_ROWIDX), (const unsigned*)(F.ctl + CW_CNT + 512)}; pg8::MoeOrder S; S.init((const unsigned*)(F.ctl + CW_CNT + 512), 22, F.G, cid);
        EPAIR8 E{F.ACT, FF}; pg8::gemm_phase<EPAIR8, pg8::MoeOrder, true, (M1_FP8 != 0)>(ring, g, S, E, F.wave); REPB(L3_M1, pg8::gemm_phase<EPAIR8, pg8::MoeOrder, true, (M1_FP8 != 0)>(ring, g, S, E, F.wave)); } SEAM(L3_M1);
    if (IN(L3_M2)) { pg8::Gemm g{F.ACT, W8(WMD, (size_t)8 * DM * FF * M2_B), M, DM, FF, (size_t)DM * FF * M2_B, nullptr, nullptr}; pg8::MoeOrder S; S.init((const unsigned*)(F.ctl + CW_CNT + 512), 4, F.G, cid);
        pg8::EpiMoeDn E{F.BUF, (const float*)(F.ws + 2 * MiB + WS_GATEP)}; pg8::gemm_phase<pg8::EpiMoeDn, pg8::MoeOrder, false, (M2_FP8 != 0)>(ring, g, S, E, F.wave); REPB(L3_M2, pg8::gemm_phase<pg8::EpiMoeDn, pg8::MoeOrder, false, (M2_FP8 != 0)>(ring, g, S, E, F.wave)); } SEAM(L3_M2);
    if (IN(L3_COMB)) { thin_phase<2>(F, args, F.out, 0, 0, 3, 1, 1, 2 * MiB); }
#undef IN
#undef SEAM
}

extern "C" void kernel_launch(void* const* d_in, const int* in_sizes, int n_in, void* d_out, int out_size, void* d_ws, size_t ws_size, hipStream_t stream) {
    static int grid = 0;
    if (grid == 0) {
        if (n_in != 28 || in_sizes[0] != M * DM || out_size != M * DM || ws_size < WS_END) { fprintf(stderr, "kernel_launch: unexpected shapes / workspace (n_in %d, ws %zu, need %zu)\n", n_in, ws_size, (size_t)WS_END); grid = -1; return; }
        int dev = 0, cus = 0, per_cu = 0;
        if (hipGetDevice(&dev) != hipSuccess || hipDeviceGetAttribute(&cus, hipDeviceAttributeMultiprocessorCount, dev) != hipSuccess) { grid = -1; return; }
        if (hipFuncSetAttribute((const void*)mega_fwd, hipFuncAttributeMaxDynamicSharedMemorySize, LDS_BYTES) != hipSuccess) { fprintf(stderr, "kernel_launch: hipFuncSetAttribute failed\n"); grid = -1; return; }
        if (hipOccupancyMaxActiveBlocksPerMultiprocessor(&per_cu, (const void*)mega_fwd, NTHREADS, LDS_BYTES) != hipSuccess || per_cu < 1) fprintf(stderr, "kernel_launch: occupancy query reports %d\n", per_cu);
        (void)hipGetLastError();
        grid = cus;
    }
    if (grid < 0) return;
    (void)hipMemsetAsync((char*)d_ws + WS_CTL, 0, CTL_ZERO_BYTES, stream);
    Args a{};
    for (int i = 0; i < 28; ++i) a.in[i] = (const float*)d_in[i];
    a.out = (float*)d_out; a.ws = (unsigned char*)d_ws;
#if MK_PER_PHASE
    for (int p = 0; p < NPH; ++p) { a.ph_lo = p; a.ph_hi = p + 1; hipLaunchKernelGGL(mega_fwd, dim3(grid), dim3(NTHREADS), LDS_BYTES, stream, a); }
#else
    a.ph_lo = 0; a.ph_hi = NPH; hipLaunchKernelGGL(mega_fwd, dim3(grid), dim3(NTHREADS), LDS_BYTES, stream, a);
#endif
}
```

```cpp
#include <hip/hip_runtime.h>
#include <cstdio>
#include <cstdint>
#include <cmath>

#ifndef MK_PER_PHASE
#define MK_PER_PHASE 0
#endif

#define GAS __attribute__((address_space(1)))
#define LAS __attribute__((address_space(3)))
typedef unsigned short bf16_t;
typedef short bf16x8 __attribute__((ext_vector_type(8)));
typedef float f32x4 __attribute__((ext_vector_type(4)));
typedef float f32x2 __attribute__((ext_vector_type(2)));
typedef float f32x16 __attribute__((ext_vector_type(16)));
typedef unsigned u32x4 __attribute__((ext_vector_type(4)));
typedef unsigned u32x2 __attribute__((ext_vector_type(2)));
typedef GAS unsigned gu32;
#define RLX_AGENT __ATOMIC_RELAXED, __HIP_MEMORY_SCOPE_AGENT
#define LDS_WAIT() asm volatile("s_waitcnt lgkmcnt(0)" ::: "memory")
#define VM_WAIT() asm volatile("s_waitcnt vmcnt(0)" ::: "memory")
#define CFENCE() asm volatile("" ::: "memory")

constexpr int DM = 1024, NB = 4, SEQ = 4096, M = NB * SEQ, FF = 2816, NEXP = 8;
constexpr int NH = 16, NKV = 4, HD = 64, IH = 8, IDIM = 64, TOPK = 256;
constexpr int ATT_N = 2120, ATT_NP = 2304;
constexpr float EPS = 1e-6f;
constexpr int NWAVES = 8, NTHREADS = 512;

__device__ __forceinline__ unsigned f2bf(float f) { unsigned u = __builtin_bit_cast(unsigned, f); return (u + 0x7fffu + ((u >> 16) & 1u)) >> 16; }
__device__ __forceinline__ unsigned pk2(float lo, float hi) { return f2bf(lo) | (f2bf(hi) << 16); }
__device__ __forceinline__ unsigned cvt_pk_bf16(float lo, float hi) { unsigned r; asm volatile("v_cvt_pk_bf16_f32 %0, %1, %2" : "=v"(r) : "v"(lo), "v"(hi)); return r; }
__device__ __forceinline__ float bflo(unsigned u) { return __uint_as_float(u << 16); }
__device__ __forceinline__ float bfhi(unsigned u) { return __uint_as_float(u & 0xffff0000u); }
__device__ __forceinline__ float wave_sum(float v) {
#pragma unroll
    for (int o = 1; o < 64; o <<= 1) v += __shfl_xor(v, o);
    return v;
}
__device__ __forceinline__ float fast_rcp(float x) { return __builtin_amdgcn_rcpf(x); }
__device__ __forceinline__ float silu_f(float g) { return g * fast_rcp(1.f + __expf(-g)); }
__device__ __forceinline__ float sigmoid_f(float g) { return fast_rcp(1.f + __expf(-g)); }
__device__ __forceinline__ float gelu_tanh_f(float y) { const float z = 0.7978845608028654f * (y + 0.044715f * y * y * y); const float t = 1.f - 2.f * fast_rcp(__expf(2.f * z) + 1.f); return 0.5f * y * (1.f + t); }

constexpr size_t WS_ROWIDX_B = 2u << 20, WS_GATEP_B = (2u << 20) + 512 * 1024, WS_SLOT_B = 3u << 20;
__device__ __forceinline__ int lane_id_fresh() { int l; asm volatile("v_mbcnt_lo_u32_b32 %0, -1, 0\n\tv_mbcnt_hi_u32_b32 %0, -1, %0" : "=v"(l)); return l; }
#ifndef FUSE_R
#define FUSE_R 1
#endif
#ifndef FUSE_N
#define FUSE_N 1
#endif
#ifndef M2_FP8
#define M2_FP8 1
#endif
#ifndef F1L0_FP8
#define F1L0_FP8 1
#endif
#ifndef M1L1_FP8
#define M1L1_FP8 1
#endif
#ifndef M1_FP8
#define M1_FP8 1
#endif
#ifndef F2L0_FP8
#define F2L0_FP8 1
#endif
#ifndef F2_FP8
#define F2_FP8 1
#endif
namespace pg8 {
constexpr int BM = 256, BK = 64, HALF = 128, HTB = HALF * BK * 2, STAGE_BYTES = 8 * HTB, NXCD = 8, WGM = 8;
__host__ __device__ __forceinline__ int lds_byte(int r, int c) { const int st = (r >> 4) * 2 + (c >> 5), rr = r & 15, cc = c & 31, ob = rr * 64 + cc * 2; return st * 1024 + (ob ^ (((ob >> 9) & 1) << 5)); }
__host__ __device__ __forceinline__ void stage_rc(int b, int& R, int& C) { const int st = b / 1024, sb = b % 1024, swz = sb ^ (((sb >> 9) & 1) << 5); R = (st >> 1) * 16 + swz / 64; C = (st & 1) * 32 + (swz % 64) / 2; }
__host__ __device__ __forceinline__ int perm32(int rho) { const int n = rho >> 4, i = rho & 15; return 8 * (i >> 2) + 4 * n + (i & 3); }

struct Unit { int pm, pn, e, aux; };
struct Gemm { const bf16_t* A; const bf16_t* Bt; int M, N, K; size_t bstride_e; const int* rowidx; const unsigned* cnt; };

struct StaticOrder {
    int nM, nN, nwg, G, c;
    __device__ __forceinline__ void init(int M_, int N_, int G_, int c_) { nM = M_ / BM; nN = N_ / BM; nwg = nM * nN; G = G_; c = c_; }
    __device__ __forceinline__ bool next(int i, Unit& u) const {
        const long L = (long)i * G + c; if (L >= nwg) return false;
        int wgid = (int)L; { const int q = nwg / NXCD, r = nwg % NXCD, xcd = wgid % NXCD, off = wgid / NXCD; wgid = (xcd < r ? xcd * (q + 1) : r * (q + 1) + (xcd - r) * q) + off; }
        const int nig = WGM * nN, gid = wgid / nig, fm = gid * WGM, gsz = (nM - fm) < WGM ? (nM - fm) : WGM;
        u.pm = fm + ((wgid % nig) % gsz); u.pn = (wgid % nig) / gsz; u.e = 0; u.aux = 0; return true;
    }
};
struct MoeOrder {
    int T1, T2, T3, T4, T5, T6, T7, T8, NT, W, r, lo, ntl;
    static constexpr int RG = 4;
    __device__ __forceinline__ void init(const unsigned* cnt, int NT_, int G_, int c_) {
        int t[9]; int acc = 0;
#pragma unroll
        for (int e = 0; e < 8; ++e) { t[e] = acc; acc += (int)((__hip_atomic_load(cnt + 64 * e, RLX_AGENT) + 255u) >> 8); }
        t[8] = acc; T1 = t[1]; T2 = t[2]; T3 = t[3]; T4 = t[4]; T5 = t[5]; T6 = t[6]; T7 = t[7]; T8 = t[8]; NT = NT_;
        if (G_ % 8 == 0) { const int xv = c_ % 8; W = G_ / 8; r = c_ / 8; lo = (T8 * xv) / 8; ntl = (T8 * (xv + 1)) / 8 - lo; }
        else { W = G_; r = c_; lo = 0; ntl = T8; }
    }
    __device__ __forceinline__ bool next(int i, Unit& u) const {
        const int q = i * W + r; if (q >= ntl * NT) return false;
        const int nig = RG * NT, gid = q / nig, fm = gid * RG, gsz = (ntl - fm) < RG ? (ntl - fm) : RG, w = q - gid * nig;
        const int tt = lo + fm + (w % gsz), pn = w / gsz;
        int e = 0, te = 0;
        if (tt >= T1) { e = 1; te = T1; } if (tt >= T2) { e = 2; te = T2; } if (tt >= T3) { e = 3; te = T3; } if (tt >= T4) { e = 4; te = T4; }
        if (tt >= T5) { e = 5; te = T5; } if (tt >= T6) { e = 6; te = T6; } if (tt >= T7) { e = 7; te = T7; }
        u.pm = tt; u.pn = pn; u.e = e; u.aux = e * 16384 + 256 * (tt - te); return true;
    }
};

typedef int v8i32 __attribute__((ext_vector_type(8)));
typedef int v4i32 __attribute__((ext_vector_type(4)));
constexpr float W8_MUL = 32.0f, W8_INV = 1.0f / 32.0f;
__device__ __forceinline__ void mfma8(f32x4& c, const v8i32 a, const v8i32 b) { asm volatile("v_mfma_f32_16x16x128_f8f6f4 %0, %1, %2, %0" : "+v"(c) : "v"(a), "v"(b)); }
__device__ __forceinline__ v8i32 cat8(const bf16x8 a, const bf16x8 b) { return __builtin_shufflevector(__builtin_bit_cast(v4i32, a), __builtin_bit_cast(v4i32, b), 0, 1, 2, 3, 4, 5, 6, 7); }
template <class Epi, class Sched, bool GATHER, bool FP8 = false>
__device__ __forceinline__ void gemm_phase(LAS unsigned char* lds, const Gemm g, const Sched& S, const Epi& E, const int wid) {
    const int lane = lane_id_fresh(), tid = wid * 64 + lane, wr = wid >> 2, wc = wid & 3, fr = lane & 15, fq = lane >> 4;
    const int K = FP8 ? g.K / 2 : g.K, nt = K / BK;
    unsigned voffB[2]; int stR[2], stC[2];
#pragma unroll
    for (int i = 0; i < 2; ++i) { int R, C; stage_rc(tid * 16 + i * 8192, R, C); const int Rb = (R & ~31) + perm32(R & 31);
        stR[i] = R; stC[i] = C; voffB[i] = (unsigned)(Rb * K + C) * 2u; }
    const size_t kstep = (size_t)(BK * 2);
    const size_t hstep = (size_t)HALF * K * 2;
    const size_t tstep = 2 * hstep;
    const unsigned ldsw = (unsigned)wid * 1024u;
    const int aoff = lds_byte(wr * 64 + fr, fq * 8), boff = lds_byte(wc * 32 + fr, fq * 8);
#define PG8_SA(b, h) (((b) * 2 + (h)) * HTB)
#define PG8_SB(b, h) ((4 + (b) * 2 + (h)) * HTB)
#define PG8_STAGE(bufoff, gbase, voff) do { _Pragma("unroll") for (int _i = 0; _i < 2; ++_i) \
        __builtin_amdgcn_global_load_lds((const unsigned*)((const char*)(gbase) + (voff)[_i]), (LAS unsigned*)(lds + (bufoff) + ldsw + _i * 8192), 16, 0, 0); } while (0)
#define PG8_LDA(dst, b, h) do { _Pragma("unroll") for (int m = 0; m < 4; ++m) _Pragma("unroll") for (int k = 0; k < 2; ++k) dst[m][k] = *(const LAS bf16x8*)(lds + PG8_SA(b, h) + aoff + m * 2048 + k * 1024); } while (0)
#define PG8_LDB(dst, b, h) do { _Pragma("unroll") for (int n = 0; n < 2; ++n) _Pragma("unroll") for (int k = 0; k < 2; ++k) dst[n][k] = *(const LAS bf16x8*)(lds + PG8_SB(b, h) + boff + n * 2048 + k * 1024); } while (0)
#define PG8_MMA(ai, bj, At, Bt) do { __builtin_amdgcn_s_setprio(1); _Pragma("unroll") for (int m = 0; m < 4; ++m) _Pragma("unroll") for (int n = 0; n < 2; ++n) { \
        if (FP8) mfma8(acc[ai][bj][m][n], cat8(Bt[n][0], Bt[n][1]), cat8(At[m][0], At[m][1])); \
        else { _Pragma("unroll") for (int k = 0; k < 2; ++k) acc[ai][bj][m][n] = __builtin_amdgcn_mfma_f32_16x16x32_bf16(Bt[n][k], At[m][k], acc[ai][bj][m][n], 0, 0, 0); } } \
        __builtin_amdgcn_s_setprio(0); } while (0)
#define PG8_MMA_END(At, B0, B1) do { if (FP8) { asm volatile("s_nop 15\n\ts_nop 15\n\ts_nop 15\n\ts_nop 15" :: "v"(cat8(At[0][0], At[0][1])), "v"(cat8(At[1][0], At[1][1])), "v"(cat8(At[2][0], At[2][1])), "v"(cat8(At[3][0], At[3][1])), \
        "v"(cat8(B0[0][0], B0[0][1])), "v"(cat8(B0[1][0], B0[1][1])), "v"(cat8(B1[0][0], B1[0][1])), "v"(cat8(B1[1][0], B1[1][1]))); } } while (0)
#define PG8_WAIT_V(n) asm volatile("s_waitcnt vmcnt(" #n ")" ::: "memory")
#define PG8_WAIT_L(n) asm volatile("s_waitcnt lgkmcnt(" #n ")" ::: "memory")
#define PG8_BAR __builtin_amdgcn_s_barrier()
#define PG8_SCHED __builtin_amdgcn_sched_barrier(0)
#define PG8_AOFFS(v, U) do { _Pragma("unroll") for (int _h = 0; _h < 2; ++_h) _Pragma("unroll") for (int _i = 0; _i < 2; ++_i) { \
        if (GATHER) { const int _loc = ((U).aux & 16383) + _h * HALF + stR[_i]; const int _e = (U).aux >> 14; \
            const int _row = (_loc < (int)g.cnt[64 * _e]) ? g.rowidx[(U).aux + _h * HALF + stR[_i]] : 0; \
            v[_h][_i] = (unsigned)(_row * K + stC[_i]) * 2u; } \
        else v[_h][_i] = (unsigned)((_h * HALF + stR[_i]) * K + stC[_i]) * 2u; } } while (0)
    int cn8[8];
#pragma unroll
    for (int e = 0; e < 8; ++e) cn8[e] = GATHER ? __builtin_amdgcn_readfirstlane((int)g.cnt[64 * e]) : 0;
    Unit cur, nxt; int ui = 0;
    if (!S.next(0, cur)) return;
    f32x4 acc[2][2][4][2];
#pragma unroll
    for (int a = 0; a < 2; ++a)
#pragma unroll
        for (int b = 0; b < 2; ++b)
#pragma unroll
            for (int m = 0; m < 4; ++m)
#pragma unroll
                for (int n = 0; n < 2; ++n) acc[a][b][m][n] = (f32x4){0.f, 0.f, 0.f, 0.f};
    bf16x8 At[4][2], B0[2][2], B1[2][2];
    unsigned vAc[2][2], vAn[2][2];
    PG8_AOFFS(vAc, cur);
    const char* cA = (const char*)g.A + (GATHER ? (size_t)0 : (size_t)cur.pm * tstep);
    const char* cB = (const char*)g.Bt + (size_t)cur.e * g.bstride_e + (size_t)cur.pn * tstep;
    PG8_STAGE(PG8_SB(0, 0), cB, voffB); PG8_STAGE(PG8_SB(0, 1), cB + hstep, voffB); PG8_STAGE(PG8_SA(0, 0), cA, vAc[0]); PG8_STAGE(PG8_SA(0, 1), cA, vAc[1]);
    if (wr == 1) PG8_BAR;
    PG8_WAIT_V(2); PG8_BAR;
    PG8_STAGE(PG8_SB(1, 0), cB + kstep, voffB); PG8_STAGE(PG8_SA(1, 0), cA + kstep, vAc[0]); PG8_STAGE(PG8_SB(1, 1), cB + hstep + kstep, voffB);
    PG8_WAIT_V(6); PG8_BAR;
    for (;;) {
        const bool has_next = S.next(ui + 1, nxt);
        const char* nA = cA; const char* nB = cB;
        int rn[2][2];
        if (has_next) { if (GATHER) {
#pragma unroll
                for (int h = 0; h < 2; ++h)
#pragma unroll
                    for (int i = 0; i < 2; ++i) rn[h][i] = g.rowidx[nxt.aux + h * HALF + stR[i]]; }
            else PG8_AOFFS(vAn, nxt);
            nA = (const char*)g.A + (GATHER ? (size_t)0 : (size_t)nxt.pm * tstep); nB = (const char*)g.Bt + (size_t)nxt.e * g.bstride_e + (size_t)nxt.pn * tstep; }
        else {
#pragma unroll
            for (int h = 0; h < 2; ++h)
#pragma unroll
                for (int i = 0; i < 2; ++i) vAn[h][i] = vAc[h][i];
        }
#pragma nounroll
        for (int t = 0; t < nt; t += 2) {
            const bool last = (t == nt - 2);
            const char* a1 = cA + (size_t)(t + 1) * kstep;
            const char* a2 = last ? nA : cA + (size_t)(t + 2) * kstep; const char* b2 = last ? nB : cB + (size_t)(t + 2) * kstep;
            const char* a3 = a2 + kstep; const char* b3 = b2 + kstep;
            if (GATHER && last && has_next) { const int _e = nxt.aux >> 14;
                const int _cn = _e == 0 ? cn8[0] : _e == 1 ? cn8[1] : _e == 2 ? cn8[2] : _e == 3 ? cn8[3] : _e == 4 ? cn8[4] : _e == 5 ? cn8[5] : _e == 6 ? cn8[6] : cn8[7];
#pragma unroll
                for (int h = 0; h < 2; ++h)
#pragma unroll
                    for (int i = 0; i < 2; ++i) { int r_ = rn[h][i]; asm volatile("" : "+v"(r_)); const int _loc = (nxt.aux & 16383) + h * HALF + stR[i];
                        r_ = _loc < _cn ? r_ : 0; vAn[h][i] = (unsigned)(r_ * K + stC[i]) * 2u; } }
            unsigned v2[2][2];
#pragma unroll
            for (int h = 0; h < 2; ++h)
#pragma unroll
                for (int i = 0; i < 2; ++i) v2[h][i] = last ? vAn[h][i] : vAc[h][i];
            PG8_LDB(B0, 0, 0); PG8_LDB(B1, 0, 1); PG8_SCHED; PG8_LDA(At, 0, 0); PG8_STAGE(PG8_SA(1, 1), a1, vAc[1]);
            PG8_WAIT_V(8); PG8_WAIT_L(0); PG8_BAR; PG8_MMA(0, 0, At, B0); PG8_MMA(0, 1, At, B1); PG8_MMA_END(At, B0, B1); PG8_BAR; PG8_SCHED;
            PG8_LDA(At, 0, 1); PG8_STAGE(PG8_SB(0, 0), b2, voffB); PG8_STAGE(PG8_SB(0, 1), b2 + hstep, voffB); PG8_STAGE(PG8_SA(0, 0), a2, v2[0]);
            PG8_WAIT_V(8); PG8_WAIT_L(0); PG8_BAR; PG8_MMA(1, 0, At, B0); PG8_MMA(1, 1, At, B1); PG8_MMA_END(At, B0, B1); PG8_BAR; PG8_SCHED;
            PG8_LDB(B0, 1, 0); PG8_LDB(B1, 1, 1); PG8_SCHED; PG8_LDA(At, 1, 0); PG8_STAGE(PG8_SA(0, 1), a2, v2[1]);
            PG8_WAIT_V(8); PG8_WAIT_L(0); PG8_BAR; PG8_MMA(0, 0, At, B0); PG8_MMA(0, 1, At, B1); PG8_MMA_END(At, B0, B1); PG8_BAR; PG8_SCHED;
            PG8_LDA(At, 1, 1); PG8_STAGE(PG8_SB(1, 0), b3, voffB); PG8_STAGE(PG8_SB(1, 1), b3 + hstep, voffB); PG8_STAGE(PG8_SA(1, 0), a3, v2[0]);
            PG8_WAIT_V(8); PG8_WAIT_L(0); PG8_BAR; PG8_MMA(1, 0, At, B0); PG8_MMA(1, 1, At, B1); PG8_MMA_END(At, B0, B1); PG8_BAR; PG8_SCHED;
        }
        if (wr == 0) PG8_BAR;
        if (FP8) asm volatile("s_nop 15\n\ts_nop 15\n\ts_nop 15\n\ts_nop 15\n\ts_nop 15\n\ts_nop 15" ::: "memory");
        if constexpr (!Epi::FUSED) E(acc, cur, wr, wc, fr, fq);
        if (!has_next) break;
#pragma unroll
        for (int a = 0; a < 2; ++a)
#pragma unroll
            for (int b = 0; b < 2; ++b)
#pragma unroll
                for (int m = 0; m < 4; ++m)
#pragma unroll
                    for (int n = 0; n < 2; ++n) acc[a][b][m][n] = (f32x4){0.f, 0.f, 0.f, 0.f};
        cur = nxt; cA = nA; cB = nB; ++ui;
#pragma unroll
        for (int h = 0; h < 2; ++h)
#pragma unroll
            for (int i = 0; i < 2; ++i) vAc[h][i] = vAn[h][i];
        if (wr == 1) PG8_BAR;
    }
    PG8_WAIT_V(0);
    PG8_BAR;
    if constexpr (Epi::FUSED) E.fused(acc, cur, wr, wc, fr, fq, lds, wid, lane);
#undef PG8_SA
#undef PG8_SB
#undef PG8_STAGE
#undef PG8_LDA
#undef PG8_LDB
#undef PG8_MMA
#undef PG8_MMA_END
#undef PG8_WAIT_V
#undef PG8_WAIT_L
#undef PG8_BAR
#undef PG8_SCHED
#undef PG8_AOFFS
}

__device__ __forceinline__ f32x4 ldx16(const float* p) { const GAS unsigned long long* q = (const GAS unsigned long long*)p; const unsigned long long a = __hip_atomic_load(q, RLX_AGENT), c = __hip_atomic_load(q + 1, RLX_AGENT);
    return (f32x4){__uint_as_float((unsigned)a), __uint_as_float((unsigned)(a >> 32)), __uint_as_float((unsigned)c), __uint_as_float((unsigned)(c >> 32))}; }
typedef f32x4 Acc[2][2][4][2];
__device__ __forceinline__ u32x4 pack8(const f32x4 a, const f32x4 b) { u32x4 w; w.x = cvt_pk_bf16(a[0], a[1]); w.y = cvt_pk_bf16(a[2], a[3]); w.z = cvt_pk_bf16(b[0], b[1]); w.w = cvt_pk_bf16(b[2], b[3]); return w; }

template <int MODE, bool OUT8 = false, bool SC8 = OUT8> struct EpiPair {
    static constexpr bool FUSED = false;
    bf16_t* O; int ldo;
    __device__ __forceinline__ void operator()(const Acc& acc, const Unit& u, int wr, int wc, int fr, int fq) const {
        const int row0 = u.pm * BM + wr * 64 + fr, col0 = u.pn * HALF + wc * 32 + 8 * fq;
#pragma unroll
        for (int ai = 0; ai < 2; ++ai)
#pragma unroll
            for (int m = 0; m < 4; ++m) { f32x4 r0, r1;
#pragma unroll
                for (int e = 0; e < 4; ++e) { const float sc8 = SC8 ? W8_INV : 1.0f; const float a0 = acc[ai][0][m][0][e] * sc8, a1 = acc[ai][0][m][1][e] * sc8, b0 = acc[ai][1][m][0][e] * sc8, b1 = acc[ai][1][m][1][e] * sc8;
                    r0[e] = (MODE == 1 ? silu_f(a0) : a0) * b0; r1[e] = (MODE == 1 ? silu_f(a1) : a1) * b1; }
                if (OUT8) { u32x2 w; int t0 = 0, t1 = 0; t0 = __builtin_amdgcn_cvt_pk_fp8_f32(r0[0], r0[1], t0, false); t0 = __builtin_amdgcn_cvt_pk_fp8_f32(r0[2], r0[3], t0, true);
                    t1 = __builtin_amdgcn_cvt_pk_fp8_f32(r1[0], r1[1], t1, false); t1 = __builtin_amdgcn_cvt_pk_fp8_f32(r1[2], r1[3], t1, true); w.x = (unsigned)t0; w.y = (unsigned)t1;
                    *(u32x2*)((unsigned char*)O + (size_t)(row0 + ai * HALF + m * 16) * ldo + col0) = w; }
                else *(u32x4*)(O + (size_t)(row0 + ai * HALF + m * 16) * ldo + col0) = pack8(r0, r1); }
    }
};
struct EpiConvIn {
    static constexpr bool FUSED = false;
    bf16_t* UB;
    __device__ __forceinline__ void operator()(const Acc& acc, const Unit& u, int wr, int wc, int fr, int fq) const {
        const int row0 = u.pm * BM + wr * 64 + fr;
        if (u.pn < 8) { EpiPair<0, false, false> P{UB, 2048}; P(acc, u, wr, wc, fr, fq); }
        else { const int col0 = 1024 + (u.pn - 8) * BM + wc * 32 + 8 * fq;
#pragma unroll
            for (int ai = 0; ai < 2; ++ai)
#pragma unroll
                for (int m = 0; m < 4; ++m)
#pragma unroll
                    for (int bj = 0; bj < 2; ++bj) *(u32x4*)(UB + (size_t)(row0 + ai * HALF + m * 16) * 2048 + col0 + bj * HALF) = pack8(acc[ai][bj][m][0], acc[ai][bj][m][1]); }
    }
};
struct EpiRes {
    static constexpr bool FUSED = false;
    float* X; const float* gate; const float* Xin; float asc;
    __device__ __forceinline__ void operator()(const Acc& acc, const Unit& u, int wr, int wc, int fr, int fq) const {
        const int row0 = u.pm * BM + wr * 64 + fr, col0 = u.pn * BM + wc * 32 + 8 * fq; const int b = (u.pm * BM) / SEQ;
        f32x4 gv[2][2];
#pragma unroll
        for (int bj = 0; bj < 2; ++bj)
#pragma unroll
            for (int n = 0; n < 2; ++n) gv[bj][n] = *(const f32x4*)(gate + (size_t)b * 6144 + col0 + bj * HALF + 4 * n) * asc;
#pragma unroll
        for (int ai = 0; ai < 2; ++ai) {
            f32x4 xv[4][2][2];
#pragma unroll
            for (int m = 0; m < 4; ++m) { const float* ri = Xin + (size_t)(row0 + ai * HALF + m * 16) * DM + col0;
#pragma unroll
                for (int bj = 0; bj < 2; ++bj)
#pragma unroll
                    for (int n = 0; n < 2; ++n) xv[m][bj][n] = ldx16(ri + bj * HALF + 4 * n); }
            asm volatile("" ::: "memory");
#pragma unroll
            for (int m = 0; m < 4; ++m) { float* rp = X + (size_t)(row0 + ai * HALF + m * 16) * DM + col0;
#pragma unroll
                for (int bj = 0; bj < 2; ++bj)
#pragma unroll
                    for (int n = 0; n < 2; ++n) *(f32x4*)(rp + bj * HALF + 4 * n) = xv[m][bj][n] + gv[bj][n] * acc[ai][bj][m][n]; }
            asm volatile("" ::: "memory");
        }
    }
};
struct EpiResNorm {
    static constexpr bool FUSED = true;
    float* X; const float* gate; const float* Xin; const float* ng; const float* shb; bf16_t* H; float* xs; gu32* cnt; gu32* tmo; float asc; int h8;
    __device__ __forceinline__ void fused(Acc& acc, const Unit& u, int wr, int wc, int fr, int fq, LAS unsigned char* lds, int wid, int lane) const {
        const int row0 = u.pm * BM + wr * 64 + fr, col0 = u.pn * BM + wc * 32 + 8 * fq; const int b = (u.pm * BM) / SEQ;
        LAS float* P = (LAS float*)lds; LAS float* S = (LAS float*)(lds + 4096);
        { f32x4 gv[2][2];
#pragma unroll
          for (int bj = 0; bj < 2; ++bj)
#pragma unroll
              for (int n = 0; n < 2; ++n) gv[bj][n] = *(const f32x4*)(gate + (size_t)b * 6144 + col0 + bj * HALF + 4 * n) * asc;
#pragma unroll
          for (int ai = 0; ai < 2; ++ai) {
              f32x4 xv[4][2][2];
#pragma unroll
              for (int m = 0; m < 4; ++m) { const float* ri = Xin + (size_t)(row0 + ai * HALF + m * 16) * DM + col0;
#pragma unroll
                  for (int bj = 0; bj < 2; ++bj)
#pragma unroll
                      for (int n = 0; n < 2; ++n) xv[m][bj][n] = ldx16(ri + bj * HALF + 4 * n); }
              asm volatile("" ::: "memory");
#pragma unroll
              for (int m = 0; m < 4; ++m) { float* rp = X + (size_t)(row0 + ai * HALF + m * 16) * DM + col0; float ss = 0.f;
#pragma unroll
                  for (int bj = 0; bj < 2; ++bj)
#pragma unroll
                      for (int n = 0; n < 2; ++n) { const f32x4 x = xv[m][bj][n] + gv[bj][n] * acc[ai][bj][m][n]; acc[ai][bj][m][n] = x; *(f32x4*)(rp + bj * HALF + 4 * n) = x;
                          ss += (x[0] * x[0] + x[1] * x[1]) + (x[2] * x[2] + x[3] * x[3]); }
                  ss += __shfl_xor(ss, 16); ss += __shfl_xor(ss, 32);
                  if (fq == 0) P[(ai * HALF + wr * 64 + m * 16 + fr) * 4 + wc] = ss; }
              asm volatile("" ::: "memory");
          } }
        asm volatile("s_waitcnt lgkmcnt(0)" ::: "memory"); __builtin_amdgcn_s_barrier(); asm volatile("" ::: "memory");
        const int tid = wid * 64 + lane;
        if (tid < 256) { const f32x4 p4 = *(const LAS f32x4*)(P + tid * 4); const float sp = (p4[0] + p4[1]) + (p4[2] + p4[3]);
            __hip_atomic_store((gu32*)xs + ((size_t)(u.pm * BM + tid) * 4 + u.pn), __float_as_uint(sp), RLX_AGENT); }
        asm volatile("s_waitcnt vmcnt(0)" ::: "memory");
        if (wid < 4 && lane == 0) __hip_atomic_fetch_add(cnt + 64 * u.pm, 1u, RLX_AGENT);
        if (wid == 0) { unsigned spins = 0;
            while ((unsigned)__builtin_amdgcn_readfirstlane(__hip_atomic_load(cnt + 64 * u.pm, RLX_AGENT)) < 16u) { __builtin_amdgcn_s_sleep(2);
                if (++spins > (1u << 20)) { if (lane == 0) __hip_atomic_store(tmo, 1u, RLX_AGENT); break; } } }
        asm volatile("s_waitcnt vmcnt(0) lgkmcnt(0)" ::: "memory"); __builtin_amdgcn_s_barrier(); asm volatile("" ::: "memory");
        if (tid < 256) { const GAS unsigned long long* q = (const GAS unsigned long long*)xs + (size_t)(u.pm * BM + tid) * 2;
            const unsigned long long a = __hip_atomic_load(q, RLX_AGENT), c = __hip_atomic_load(q + 1, RLX_AGENT);
            const float tot = (__uint_as_float((unsigned)a) + __uint_as_float((unsigned)(a >> 32))) + (__uint_as_float((unsigned)c) + __uint_as_float((unsigned)(c >> 32)));
            S[tid] = 1.0f / sqrtf(tot * (1.0f / DM) + EPS); }
        asm volatile("s_waitcnt vmcnt(0) lgkmcnt(0)" ::: "memory"); __builtin_amdgcn_s_barrier(); asm volatile("" ::: "memory");
        f32x4 gm[2][2], sf[2][2];
#pragma unroll
        for (int bj = 0; bj < 2; ++bj)
#pragma unroll
            for (int n = 0; n < 2; ++n) { const int c = col0 + bj * HALF + 4 * n; const f32x4 g4 = *(const f32x4*)(ng + c), s1 = *(const f32x4*)(shb + (size_t)b * 6144 + DM + c);
                gm[bj][n] = g4 * (s1 + 1.0f); sf[bj][n] = *(const f32x4*)(shb + (size_t)b * 6144 + c); }
#pragma unroll
        for (int ai = 0; ai < 2; ++ai)
#pragma unroll
            for (int m = 0; m < 4; ++m) { const float r = S[ai * HALF + wr * 64 + m * 16 + fr]; bf16_t* hp = H + (size_t)(row0 + ai * HALF + m * 16) * DM + col0;
#pragma unroll
                for (int bj = 0; bj < 2; ++bj) { const f32x4 h0 = (acc[ai][bj][m][0] * r) * gm[bj][0] + sf[bj][0], h1 = (acc[ai][bj][m][1] * r) * gm[bj][1] + sf[bj][1];
                    if (F1L0_FP8 && h8) { int t0 = 0, t1 = 0; t0 = __builtin_amdgcn_cvt_pk_fp8_f32(h0[0], h0[1], t0, false); t0 = __builtin_amdgcn_cvt_pk_fp8_f32(h0[2], h0[3], t0, true);
                        t1 = __builtin_amdgcn_cvt_pk_fp8_f32(h1[0], h1[1], t1, false); t1 = __builtin_amdgcn_cvt_pk_fp8_f32(h1[2], h1[3], t1, true); u32x2 w; w.x = (unsigned)t0; w.y = (unsigned)t1;
                        *(u32x2*)((unsigned char*)H + (size_t)(row0 + ai * HALF + m * 16) * DM + col0 + bj * HALF) = w; }
                    else *(u32x4*)(hp + bj * HALF) = pack8(h0, h1); } }
    }
};
struct EpiResNormRouter {
    static constexpr bool FUSED = true;
    float* X; const float* gate; const float* ng; const float* shb; bf16_t* H; float* xs9; gu32* cnt; gu32* tmo;
    const float* rw; const float* rb; gu32* ecnt; unsigned char* meta; int h8;
    __device__ __forceinline__ void fused(Acc& acc, const Unit& u, int wr, int wc, int fr, int fq, LAS unsigned char* lds, int wid, int lane) const {
        const int row0 = u.pm * BM + wr * 64 + fr, col0 = u.pn * BM + wc * 32 + 8 * fq; const int b = (u.pm * BM) / SEQ; const int tid = wid * 64 + lane;
        LAS float* P9 = (LAS float*)lds; LAS float* RWT = (LAS float*)(lds + 36864); LAS float* S = (LAS float*)(lds + 45056); LAS float* CE = (LAS float*)(lds + 46080);
        LAS int* rE = (LAS int*)(lds + 46144); LAS float* red = (LAS float*)(lds + 47360);
        const float* shp = shb + (size_t)b * 6144;
        for (int i = tid; i < 2048; i += NTHREADS) { const int c = i >> 3, e = i & 7; RWT[e * 256 + c] = rw[(size_t)(u.pn * BM + c) * 8 + e]; }
        { float ce[8]; const float s0 = shp[tid], s1 = shp[tid + 512];
#pragma unroll
          for (int e = 0; e < 8; ++e) ce[e] = wave_sum(s0 * rw[(size_t)tid * 8 + e] + s1 * rw[(size_t)(tid + 512) * 8 + e]);
          if (lane == 0) {
#pragma unroll
              for (int e = 0; e < 8; ++e) red[wid * 8 + e] = ce[e]; } }
        { f32x4 gv[2][2];
#pragma unroll
          for (int bj = 0; bj < 2; ++bj)
#pragma unroll
              for (int n = 0; n < 2; ++n) gv[bj][n] = *(const f32x4*)(gate + (size_t)b * 6144 + col0 + bj * HALF + 4 * n);
#pragma unroll
          for (int ai = 0; ai < 2; ++ai) {
              f32x4 xv[4][2][2];
#pragma unroll
              for (int m = 0; m < 4; ++m) { const float* ri = X + (size_t)(row0 + ai * HALF + m * 16) * DM + col0;
#pragma unroll
                  for (int bj = 0; bj < 2; ++bj)
#pragma unroll
                      for (int n = 0; n < 2; ++n) xv[m][bj][n] = ldx16(ri + bj * HALF + 4 * n); }
              asm volatile("" ::: "memory");
#pragma unroll
              for (int m = 0; m < 4; ++m) { float* rp = X + (size_t)(row0 + ai * HALF + m * 16) * DM + col0; float ss = 0.f;
#pragma unroll
                  for (int bj = 0; bj < 2; ++bj)
#pragma unroll
                      for (int n = 0; n < 2; ++n) { const f32x4 x = xv[m][bj][n] + gv[bj][n] * acc[ai][bj][m][n]; acc[ai][bj][m][n] = x; *(f32x4*)(rp + bj * HALF + 4 * n) = x;
                          ss += (x[0] * x[0] + x[1] * x[1]) + (x[2] * x[2] + x[3] * x[3]); }
                  ss += __shfl_xor(ss, 16); ss += __shfl_xor(ss, 32);
                  if (fq == 0) P9[((ai * HALF + wr * 64 + m * 16 + fr) * 4 + wc) * 9] = ss; }
              asm volatile("" ::: "memory");
          } }
        f32x4 sf[2][2];
#pragma unroll
        for (int bj = 0; bj < 2; ++bj)
#pragma unroll
            for (int n = 0; n < 2; ++n) { const int c = col0 + bj * HALF + 4 * n; const f32x4 gm = *(const f32x4*)(ng + c) * (*(const f32x4*)(shp + DM + c) + 1.0f); sf[bj][n] = *(const f32x4*)(shp + c);
#pragma unroll
                for (int ai = 0; ai < 2; ++ai)
#pragma unroll
                    for (int m = 0; m < 4; ++m) acc[ai][bj][m][n] = acc[ai][bj][m][n] * gm; }
        asm volatile("s_waitcnt lgkmcnt(0)" ::: "memory"); __builtin_amdgcn_s_barrier(); asm volatile("" ::: "memory");
        if (tid < 8) { float c = rb[tid];
#pragma unroll
            for (int w = 0; w < 8; ++w) c += red[w * 8 + tid];
            CE[tid] = c; }
#pragma unroll
        for (int e = 0; e < 8; ++e) { f32x4 rwe[2][2];
#pragma unroll
            for (int bj = 0; bj < 2; ++bj)
#pragma unroll
                for (int n = 0; n < 2; ++n) rwe[bj][n] = *(const LAS f32x4*)(RWT + e * 256 + bj * HALF + wc * 32 + 8 * fq + 4 * n);
#pragma unroll
            for (int ai = 0; ai < 2; ++ai)
#pragma unroll
                for (int m = 0; m < 4; ++m) { float a = 0.f;
#pragma unroll
                    for (int bj = 0; bj < 2; ++bj)
#pragma unroll
                        for (int n = 0; n < 2; ++n) { const f32x4 x = acc[ai][bj][m][n], w4 = rwe[bj][n]; a += (x[0] * w4[0] + x[1] * w4[1]) + (x[2] * w4[2] + x[3] * w4[3]); }
                    a += __shfl_xor(a, 16); a += __shfl_xor(a, 32);
                    if (fq == 0) P9[((ai * HALF + wr * 64 + m * 16 + fr) * 4 + wc) * 9 + 1 + e] = a; } }
        asm volatile("s_waitcnt lgkmcnt(0)" ::: "memory"); __builtin_amdgcn_s_barrier(); asm volatile("" ::: "memory");
        if (tid < 256) { gu32* q = (gu32*)xs9 + ((size_t)(u.pm * BM + tid) * 4 + u.pn) * 9;
#pragma unroll
            for (int k = 0; k < 9; ++k) { const float v = (P9[(tid * 4 + 0) * 9 + k] + P9[(tid * 4 + 1) * 9 + k]) + (P9[(tid * 4 + 2) * 9 + k] + P9[(tid * 4 + 3) * 9 + k]);
                __hip_atomic_store(q + k, __float_as_uint(v), RLX_AGENT); } }
        asm volatile("s_waitcnt vmcnt(0)" ::: "memory");
        if (wid < 4 && lane == 0) __hip_atomic_fetch_add(cnt + 64 * u.pm, 1u, RLX_AGENT);
        if (wid == 0) { unsigned spins = 0;
            while ((unsigned)__builtin_amdgcn_readfirstlane(__hip_atomic_load(cnt + 64 * u.pm, RLX_AGENT)) < 16u) { __builtin_amdgcn_s_sleep(2);
                if (++spins > (1u << 20)) { if (lane == 0) __hip_atomic_store(tmo, 1u, RLX_AGENT); break; } } }
        asm volatile("s_waitcnt vmcnt(0) lgkmcnt(0)" ::: "memory"); __builtin_amdgcn_s_barrier(); asm volatile("" ::: "memory");
        if (tid < 256) { const gu32* q = (const gu32*)xs9 + (size_t)(u.pm * BM + tid) * 36; float tot[9];
#pragma unroll
            for (int k = 0; k < 9; ++k) tot[k] = (__uint_as_float(__hip_atomic_load(q + k, RLX_AGENT)) + __uint_as_float(__hip_atomic_load(q + 9 + k, RLX_AGENT)))
                                               + (__uint_as_float(__hip_atomic_load(q + 18 + k, RLX_AGENT)) + __uint_as_float(__hip_atomic_load(q + 27 + k, RLX_AGENT)));
            const float r = 1.0f / sqrtf(tot[0] * (1.0f / DM) + EPS); S[tid] = r;
            if (wid == u.pn) {
                float lg[8];
#pragma unroll
                for (int e = 0; e < 8; ++e) lg[e] = r * tot[1 + e] + CE[e];
                int e0 = 0; float l0 = lg[0];
#pragma unroll
                for (int e = 1; e < 8; ++e) if (lg[e] > l0) { l0 = lg[e]; e0 = e; }
                int e1 = -1; float l1 = -3.0e38f;
#pragma unroll
                for (int e = 0; e < 8; ++e) if (e != e0 && lg[e] > l1) { l1 = lg[e]; e1 = e; }
                const float g0 = 1.0f / (1.0f + __expf(l1 - l0)), g1 = 1.0f - g0;
                int cmine = 0, r0 = 0, r1 = 0;
#pragma unroll
                for (int e = 0; e < 8; ++e) { const unsigned long long m0 = __ballot(e0 == e), m1 = __ballot(e1 == e);
                    const int below = (int)__builtin_amdgcn_mbcnt_hi((unsigned)(m0 >> 32), __builtin_amdgcn_mbcnt_lo((unsigned)m0, 0u)) + (int)__builtin_amdgcn_mbcnt_hi((unsigned)(m1 >> 32), __builtin_amdgcn_mbcnt_lo((unsigned)m1, 0u));
                    if (e0 == e) r0 = below; if (e1 == e) r1 = below; if (lane == e) cmine = __popcll(m0) + __popcll(m1); }
                unsigned base = 0u; if (lane < 8 && cmine) base = __hip_atomic_fetch_add(ecnt + 64 * lane, (unsigned)cmine, RLX_AGENT);
                const int p0 = (int)__shfl(base, e0) + r0, p1 = (int)__shfl(base, e1) + r1, grow = u.pm * BM + 64 * u.pn + lane;
                gu32* ri = (gu32*)(meta + WS_ROWIDX_B); gu32* gp = (gu32*)(meta + WS_GATEP_B); gu32* sl = (gu32*)(meta + WS_SLOT_B);
                __hip_atomic_store(ri + e0 * 16384 + p0, (unsigned)grow, RLX_AGENT); __hip_atomic_store(ri + e1 * 16384 + p1, (unsigned)grow, RLX_AGENT);
                __hip_atomic_store(gp + e0 * 16384 + p0, __float_as_uint(g0), RLX_AGENT); __hip_atomic_store(gp + e1 * 16384 + p1, __float_as_uint(g1), RLX_AGENT);
                __hip_atomic_store(sl + grow * 2, (unsigned)((e0 << 16) | p0), RLX_AGENT); __hip_atomic_store(sl + grow * 2 + 1, (unsigned)((e1 << 16) | p1), RLX_AGENT); } }
        asm volatile("s_waitcnt vmcnt(0) lgkmcnt(0)" ::: "memory"); __builtin_amdgcn_s_barrier(); asm volatile("" ::: "memory");
#pragma unroll
        for (int ai = 0; ai < 2; ++ai)
#pragma unroll
            for (int m = 0; m < 4; ++m) { const float r = S[ai * HALF + wr * 64 + m * 16 + fr]; bf16_t* hp = H + (size_t)(row0 + ai * HALF + m * 16) * DM + col0;
#pragma unroll
                for (int bj = 0; bj < 2; ++bj) { const f32x4 h0 = acc[ai][bj][m][0] * r + sf[bj][0], h1 = acc[ai][bj][m][1] * r + sf[bj][1];
                    if ((M1_FP8 || M1L1_FP8) && h8) { int t0 = 0, t1 = 0; t0 = __builtin_amdgcn_cvt_pk_fp8_f32(h0[0], h0[1], t0, false); t0 = __builtin_amdgcn_cvt_pk_fp8_f32(h0[2], h0[3], t0, true);
                        t1 = __builtin_amdgcn_cvt_pk_fp8_f32(h1[0], h1[1], t1, false); t1 = __builtin_amdgcn_cvt_pk_fp8_f32(h1[2], h1[3], t1, true); u32x2 w; w.x = (unsigned)t0; w.y = (unsigned)t1;
                        *(u32x2*)((unsigned char*)H + (size_t)(row0 + ai * HALF + m * 16) * DM + col0 + bj * HALF) = w; }
                    else *(u32x4*)(hp + bj * HALF) = pack8(h0, h1); } }
    }
};
struct EpiGluRes {
    static constexpr bool FUSED = false;
    float* X; const float* gate;
    __device__ __forceinline__ void operator()(const Acc& acc, const Unit& u, int wr, int wc, int fr, int fq) const {
        const int row0 = u.pm * BM + wr * 64 + fr, col0 = u.pn * HALF + wc * 32 + 8 * fq; const int b = (u.pm * BM) / SEQ;
        f32x4 gv[2];
#pragma unroll
        for (int n = 0; n < 2; ++n) gv[n] = *(const f32x4*)(gate + (size_t)b * 6144 + col0 + 4 * n);
        f32x4 xv[2][4][2];
#pragma unroll
        for (int ai = 0; ai < 2; ++ai)
#pragma unroll
            for (int m = 0; m < 4; ++m)
#pragma unroll
                for (int n = 0; n < 2; ++n) xv[ai][m][n] = ldx16(X + (size_t)(row0 + ai * HALF + m * 16) * DM + col0 + 4 * n);
        asm volatile("" ::: "memory");
#pragma unroll
        for (int ai = 0; ai < 2; ++ai)
#pragma unroll
            for (int m = 0; m < 4; ++m) { float* rp = X + (size_t)(row0 + ai * HALF + m * 16) * DM + col0;
#pragma unroll
                for (int n = 0; n < 2; ++n) { f32x4 x = xv[ai][m][n]; const f32x4 l = acc[ai][0][m][n], gg = acc[ai][1][m][n];
#pragma unroll
                    for (int e = 0; e < 4; ++e) x[e] += gv[n][e] * l[e] * sigmoid_f(gg[e]);
                    *(f32x4*)(rp + 4 * n) = x; } }
    }
};
struct EpiAttnIn {
    static constexpr bool FUSED = false;
    bf16_t *Q, *Kn, *V, *QI, *KI; float* WI; const float *qg, *kg;
    __device__ __forceinline__ void operator()(const Acc& acc, const Unit& u, int wr, int wc, int fr, int fq) const {
        const int row0 = u.pm * BM + wr * 64 + fr;
        if (u.pn < 5) {
            const bool isq = u.pn < 4; const float* gp = isq ? qg : kg; const float sc = isq ? 0.125f : 1.0f;
            f32x4 gn[2][2];
#pragma unroll
            for (int bj = 0; bj < 2; ++bj)
#pragma unroll
                for (int n = 0; n < 2; ++n) gn[bj][n] = *(const f32x4*)(gp + 32 * bj + 8 * fq + 4 * n) * sc;
            bf16_t* base = isq ? (Q + (size_t)(4 * u.pn + wc) * 64) : (Kn + (size_t)wc * 64); const int ldo = isq ? 1024 : 256;
#pragma unroll
            for (int ai = 0; ai < 2; ++ai)
#pragma unroll
                for (int m = 0; m < 4; ++m) { float ss = 0.f;
#pragma unroll
                    for (int bj = 0; bj < 2; ++bj)
#pragma unroll
                        for (int n = 0; n < 2; ++n) { const f32x4 x = acc[ai][bj][m][n]; ss += (x[0] * x[0] + x[1] * x[1]) + (x[2] * x[2] + x[3] * x[3]); }
                    ss += __shfl_xor(ss, 16); ss += __shfl_xor(ss, 32);
                    const float r = 1.0f / sqrtf(ss * (1.0f / 64.0f) + EPS);
#pragma unroll
                    for (int bj = 0; bj < 2; ++bj) *(u32x4*)(base + (size_t)(row0 + ai * HALF + m * 16) * ldo + 32 * bj + 8 * fq) = pack8(acc[ai][bj][m][0] * r * gn[bj][0], acc[ai][bj][m][1] * r * gn[bj][1]); }
        } else if (u.pn < 8) {
            bf16_t* base = (u.pn == 5) ? V : QI + (size_t)(u.pn - 6) * 256; const int ldo = (u.pn == 5) ? 256 : 512; const int col0 = wc * 32 + 8 * fq;
#pragma unroll
            for (int ai = 0; ai < 2; ++ai)
#pragma unroll
                for (int m = 0; m < 4; ++m)
#pragma unroll
                    for (int bj = 0; bj < 2; ++bj) *(u32x4*)(base + (size_t)(row0 + ai * HALF + m * 16) * ldo + col0 + bj * HALF) = pack8(acc[ai][bj][m][0], acc[ai][bj][m][1]);
        } else {
            if (wc < 2) {
#pragma unroll
                for (int ai = 0; ai < 2; ++ai)
#pragma unroll
                    for (int m = 0; m < 4; ++m) *(u32x4*)(KI + (size_t)(row0 + ai * HALF + m * 16) * 64 + wc * 32 + 8 * fq) = pack8(acc[ai][0][m][0], acc[ai][0][m][1]);
            } else if (wc == 2 && fq == 0) {
                const float s = 0.04419417382415922f;
#pragma unroll
                for (int ai = 0; ai < 2; ++ai)
#pragma unroll
                    for (int m = 0; m < 4; ++m) { float* wp = WI + (size_t)(row0 + ai * HALF + m * 16) * 8; *(f32x4*)wp = acc[ai][0][m][0] * s; *(f32x4*)(wp + 4) = acc[ai][0][m][1] * s; }
            }
        }
    }
};
struct EpiMoeDn {
    static constexpr bool FUSED = false;
    bf16_t* Y; const float* gatep;
    __device__ __forceinline__ void operator()(const Acc& acc, const Unit& u, int wr, int wc, int fr, int fq) const {
        const int row0 = u.pm * BM + wr * 64 + fr, col0 = u.pn * BM + wc * 32 + 8 * fq;
#pragma unroll
        for (int ai = 0; ai < 2; ++ai)
#pragma unroll
            for (int m = 0; m < 4; ++m) { const float gt = gatep[u.aux + ai * HALF + wr * 64 + m * 16 + fr] * (M2_FP8 ? W8_INV : 1.0f);
#pragma unroll
                for (int bj = 0; bj < 2; ++bj) *(u32x4*)(Y + (size_t)(row0 + ai * HALF + m * 16) * DM + col0 + bj * HALF) = pack8(acc[ai][bj][m][0] * gt, acc[ai][bj][m][1] * gt); }
    }
};
}

constexpr size_t MiB = 1u << 20;
constexpr size_t WS_CTL = 0, CTL_ZERO_BYTES = 1 * MiB;
constexpr size_t WS_MOD = 1 * MiB;
constexpr size_t WS_ROWIDX = 2 * MiB;
constexpr size_t WS_GATEP = 2 * MiB + 512 * 1024;
constexpr size_t WS_SLOT = 3 * MiB;
static_assert(WS_ROWIDX_B == WS_ROWIDX && WS_GATEP_B == WS_GATEP && WS_SLOT_B == WS_SLOT, "metadata offsets");
constexpr size_t WS_WCI = 8 * MiB;
constexpr size_t WS_WCO = 20 * MiB;
constexpr size_t WS_WAI = 24 * MiB;
constexpr size_t WS_WAO = 29 * MiB;
constexpr size_t WS_WGL = 31 * MiB;
constexpr size_t WS_WFG = 35 * MiB;
constexpr size_t WS_WFD = 57 * MiB;
constexpr size_t WS_WMG = 68 * MiB;
constexpr size_t WS_WMD = 244 * MiB;
constexpr size_t WS_HB = 332 * MiB;
constexpr size_t WS_BUF = 364 * MiB;
constexpr size_t WS_ACT = 432 * MiB;
constexpr size_t WS_END = 619 * MiB;
constexpr int MOE_ROWS = 2 * M + NEXP * 256;
constexpr size_t WS_Q = WS_BUF, WS_K = WS_BUF + 32 * MiB, WS_V = WS_BUF + 40 * MiB, WS_QI = WS_BUF + 48 * MiB;
constexpr size_t WS_SC = WS_ACT, WS_O = WS_ACT + 128 * MiB, WS_KI = WS_ACT + 160 * MiB, WS_WI = WS_ACT + 162 * MiB;
static_assert(WS_WMD + (size_t)16 * 1024 * 2816 * 2 <= WS_HB && WS_ACT + (size_t)MOE_ROWS * FF * 2 <= WS_END && WS_BUF + (size_t)MOE_ROWS * DM * 2 <= WS_ACT, "d_ws map");
constexpr int CW_TMO = 0;
constexpr int CW_CNT = 64;
constexpr int CW_BAR = 4096;
constexpr int CW_PAN = 16384;
constexpr size_t WS_XS9 = 5 * MiB + 768 * 1024;
constexpr size_t WS_XS = 5 * MiB + 512 * 1024;

constexpr int RING_BYTES = 131072;
constexpr int LDSCTL_OFF = RING_BYTES, MISC_OFF = LDSCTL_OFF + 320;
constexpr int LDS_BYTES = 147456;

#define XB_TMO      128
#define XB_XCNT(j)  (256  + 64 * (j))
#define XB_XSUB(j)  (1280 + 64 * (j))
#define XB_XGEN(j)  (2304 + 64 * (j))
#define XB_TOP      3328
#define XB_TOPGEN   3392
#define XCD_BAR_WORDS 3456
#define XB_SPIN_CAP (1u << 18)
__device__ __forceinline__ unsigned xb_ld(unsigned* p)              { return __hip_atomic_load(p, __ATOMIC_RELAXED, __HIP_MEMORY_SCOPE_AGENT); }
__device__ __forceinline__ unsigned xb_add(unsigned* p, unsigned v) { return __hip_atomic_fetch_add(p, v, __ATOMIC_RELAXED, __HIP_MEMORY_SCOPE_AGENT); }
__device__ __forceinline__ unsigned xb_xcc_id() { return (unsigned)__builtin_amdgcn_s_getreg((3 << 11) | 20) & 0xFu; }
#define XB_SPIN(cond, bar) do { unsigned _sp = 0; while (cond) { __builtin_amdgcn_s_sleep(1); \
    if ((++_sp & 255u) == 0u) { if (xb_ld(&(bar)[XB_TMO])) break; if (_sp > XB_SPIN_CAP) { atomicAdd(&(bar)[XB_TMO], 1u); break; } } } } while (0)
struct XcdBarrier { unsigned* bar; unsigned x; volatile LAS unsigned* st; int w; };
__device__ __forceinline__ bool xb_thread0(int w) { return w == 0 && lane_id_fresh() == 0; }
__device__ __forceinline__ XcdBarrier xcd_barrier_post(unsigned* bar, volatile LAS unsigned* st, int w) {
    XcdBarrier b; b.bar = bar; b.x = xb_xcc_id(); b.st = st; b.w = w;
    if (xb_thread0(w)) (void)xb_add(&bar[XB_XCNT(b.x)], 1u);
    return b;
}
__device__ __forceinline__ void xcd_barrier_complete(unsigned* bar, unsigned x, unsigned& nloc, unsigned& nx) {
    const unsigned G = gridDim.x * gridDim.y * gridDim.z;
    unsigned sum, cnt, mine, sp = 0u;
    for (;;) {
        sum = 0u; cnt = 0u; mine = 0u;
#pragma unroll
        for (unsigned j = 0; j < 16; ++j) { const unsigned c = xb_ld(&bar[XB_XCNT(j)]); sum += c; cnt += (c > 0u) ? 1u : 0u; mine = (j == x) ? c : mine; }
        if (sum == G) break;
        __builtin_amdgcn_s_sleep(1);
        if ((++sp & 255u) == 0u) { if (xb_ld(&bar[XB_TMO])) break; if (sp > XB_SPIN_CAP) { atomicAdd(&bar[XB_TMO], 1u); break; } }
    }
    nloc = mine > 0u ? mine : 1u; nx = cnt > 0u ? cnt : 1u;
}
__device__ __forceinline__ int lane_probe() { return (int)__builtin_amdgcn_mbcnt_hi(~0u, __builtin_amdgcn_mbcnt_lo(~0u, 0u)); }
__device__ __forceinline__ int lane_probe2() { return (int)__builtin_amdgcn_mbcnt_hi(~0u, __builtin_amdgcn_mbcnt_lo(~0u, 0u)); }
__device__ __forceinline__ void xcd_barrier(const XcdBarrier& b) {
    asm volatile("s_waitcnt vmcnt(0)" ::: "memory");
    __syncthreads();
    if (xb_thread0(b.w)) {
        unsigned* bar = b.bar;
        __builtin_amdgcn_s_waitcnt(0);
        unsigned nloc = b.st[0], nx = b.st[1];
        if (nloc == 0u) { xcd_barrier_complete(bar, b.x, nloc, nx); b.st[0] = nloc; b.st[1] = nx; }
        const unsigned old = xb_add(&bar[XB_XSUB(b.x)], 1u);
        const unsigned gen = old / nloc;
        if (old + 1u == (gen + 1u) * nloc) {
            __builtin_amdgcn_fence(__ATOMIC_RELEASE, "agent");
            asm volatile("s_waitcnt vmcnt(0)" ::: "memory");
            const unsigned og = xb_add(&bar[XB_TOP], 1u);
            const unsigned tg = og / nx;
            if (og + 1u == (tg + 1u) * nx) xb_add(&bar[XB_TOPGEN], 1u);
            else XB_SPIN(xb_ld(&bar[XB_TOPGEN]) == tg, bar);
            __builtin_amdgcn_fence(__ATOMIC_ACQUIRE, "agent");
            xb_add(&bar[XB_XGEN(b.x)], 1u);
        } else {
            XB_SPIN(xb_ld(&bar[XB_XGEN(b.x)]) == gen, bar);
            __builtin_amdgcn_fence(__ATOMIC_ACQUIRE, "agent");
        }
    }
    __syncthreads();
}

struct Args { const float* in[28]; float* out; unsigned char* ws; int ph_lo, ph_hi; };
enum { I_X = 0, I_C, I_ADAW, I_ADAB, I_NORMG, I_CWIN, I_CW, I_CWOUT, I_AWIN, I_QG, I_KG, I_AWOUT, I_RELB, I_SLRE, I_SLIM, I_SLOG, I_SBRE, I_SBIM, I_SCRE, I_SCIM, I_SD, I_SGLU,
       I_FGU, I_FDN, I_RW, I_RB, I_MGU, I_MDN };
struct Frame {
    LAS unsigned char* lds; unsigned char* ws; gu32* ctl;
    int tid, lane, wave, vcu, G;
    float* out; const float* mod;
    bf16_t *HB, *BUF, *ACT;
};

enum { MAP_NAT = 0, MAP_PAIR = 1, MAP_CONV = 2, MAP_ATTN = 3 };
__device__ __forceinline__ int map_row(int map, int half, int n) {
    if (map == MAP_NAT) return n;
    if (map == MAP_PAIR) { return n < half ? 256 * (n / 128) + (n % 128) : 256 * ((n - half) / 128) + 128 + ((n - half) % 128); }
    if (map == MAP_CONV) { if (n < 1024) return 2048 + n; if (n < 2048) { const int q = n - 1024; return 256 * (q / 128) + (q % 128); } const int q = n - 2048; return 256 * (q / 128) + 128 + (q % 128); }
    if (n < 1280) { const int hd = n / 64, d = n % 64; return 256 * (hd / 4) + 128 * (d / 32) + 32 * (hd % 4) + (d % 32); }
    return n;
}
__device__ __forceinline__ void p0_transpose_item(const float* W, int K, int N, bf16_t* WT, int map, int half, LAS float* scr, int item, int lane) {
    const int nblk = (N + 31) / 32, kb = item / nblk, nb = item % nblk, k0 = 64 * kb, n0 = 32 * nb;
    const bool cin = (n0 + (lane & 31)) < N;
    float tv[32];
#pragma unroll
    for (int i = 0; i < 32; ++i) { const int kk = 2 * i + (lane >> 5); tv[i] = cin ? W[(size_t)(k0 + kk) * N + n0 + (lane & 31)] : 0.f; }
#pragma unroll
    for (int i = 0; i < 32; ++i) { const int kk = 2 * i + (lane >> 5); scr[kk * 33 + (lane & 31)] = tv[i]; }
    LDS_WAIT(); CFENCE();
    const int c = lane & 7; const int r0 = map_row(map, half, n0);
#pragma unroll
    for (int j = 0; j < 4; ++j) { const int n = (lane >> 3) + 8 * j; const LAS float* s = scr + (8 * c) * 33 + n;
        u32x4 o; o.x = pk2(s[0 * 33], s[1 * 33]); o.y = pk2(s[2 * 33], s[3 * 33]); o.z = pk2(s[4 * 33], s[5 * 33]); o.w = pk2(s[6 * 33], s[7 * 33]);
        *(GAS u32x4*)(WT + (size_t)(r0 + n) * K + k0 + 8 * c) = o; }
    LDS_WAIT(); CFENCE();
}
__device__ __forceinline__ void p0_transpose_item8(const float* W, int K, int N, unsigned char* WT, int map, int half, LAS float* scr, int item, int lane, int sub) {
    const int nblk = (N + 31) / 32, kb = 2 * (item / nblk) + sub, nb = item % nblk, k0 = 64 * kb, n0 = 32 * nb;
    float tv[32];
#pragma unroll
    for (int i = 0; i < 32; ++i) { const int kk = 2 * i + (lane >> 5); tv[i] = W[(size_t)(k0 + kk) * N + n0 + (lane & 31)]; }
#pragma unroll
    for (int i = 0; i < 32; ++i) { const int kk = 2 * i + (lane >> 5); scr[kk * 33 + (lane & 31)] = tv[i] * pg8::W8_MUL; }
    LDS_WAIT(); CFENCE();
    const int c = lane & 3; const int r0 = map_row(map, half, n0);
#pragma unroll
    for (int j = 0; j < 2; ++j) { const int n = (lane >> 2) + 16 * j; const LAS float* sp = scr + (16 * c) * 33 + n; u32x4 o;
#pragma unroll
        for (int q = 0; q < 4; ++q) { int t = 0; t = __builtin_amdgcn_cvt_pk_fp8_f32(sp[(4 * q) * 33], sp[(4 * q + 1) * 33], t, false); t = __builtin_amdgcn_cvt_pk_fp8_f32(sp[(4 * q + 2) * 33], sp[(4 * q + 3) * 33], t, true); o[q] = (unsigned)t; }
        *(GAS u32x4*)(WT + (size_t)(r0 + n) * K + k0 + 16 * c) = o; }
    LDS_WAIT(); CFENCE();
}
__device__ __forceinline__ void p0_prologue(Frame& F, const Args& A) {
    {
        LAS float* cs = (LAS float*)F.lds;
        LAS float* red = (LAS float*)(F.lds + 16384);
        for (int i = F.tid; i < NB * DM; i += NTHREADS) { const float c = A.in[I_C][i]; cs[i] = c / (1.f + __expf(-c)); }
        __syncthreads();
        const int kg = F.tid >> 6, cj = F.tid & 63;
        for (int un = blockIdx.x; un < 4 * 96; un += F.G) {
            const int l = un / 96, jb = un % 96, j = jb * 64 + cj;
            const float* w = A.in[I_ADAW] + (size_t)l * DM * 6144 + j;
            float a0 = 0.f, a1 = 0.f, a2 = 0.f, a3 = 0.f;
#pragma unroll 8
            for (int k = kg * 128; k < kg * 128 + 128; ++k) { const float wv = w[(size_t)k * 6144]; a0 += cs[k] * wv; a1 += cs[1024 + k] * wv; a2 += cs[2048 + k] * wv; a3 += cs[3072 + k] * wv; }
            *(LAS f32x4*)(red + (kg * 64 + cj) * 4) = (f32x4){a0, a1, a2, a3};
            __syncthreads();
            if (F.tid < 256) { const int b = F.tid >> 6, cc = F.tid & 63; float s = 0.f;
#pragma unroll
                for (int q = 0; q < 8; ++q) s += red[(q * 64 + cc) * 4 + b];
                ((float*)(F.ws + WS_MOD))[((size_t)l * NB + b) * 6144 + jb * 64 + cc] = s + A.in[I_ADAB][l * 6144 + jb * 64 + cc]; }
            __syncthreads();
        }
    }
    LAS float* scr = (LAS float*)(F.lds + 32768 + F.wave * 8704);
    const int gw = F.vcu * NWAVES + F.wave, NGW = F.G * NWAVES;
    constexpr int I_CI = (DM / 64) * (3072 / 32), I_SQ = (DM / 64) * (DM / 32), I_AI = (DM / 64) * ((ATT_N + 31) / 32), I_GL = (DM / 64) * (2048 / 32), I_GU = (DM / 64) * (2 * FF / 32), I_DN = (FF / 128) * (DM / 32), I_DNB = (FF / 64) * (DM / 32), I_GU8 = (DM / 128) * (2 * FF / 32);
    constexpr int NITEMS = 2 * I_CI + 2 * I_SQ + I_AI + I_SQ + I_GL + (F1L0_FP8 ? I_GU8 : I_GU) + I_GU + (F2_FP8 ? 2 * I_DN : ((F2L0_FP8 ? I_DN : I_DNB) + I_DNB)) + 8 * (M1L1_FP8 ? I_GU8 : I_GU) + 8 * (M1_FP8 ? I_GU8 : I_GU) + 16 * (M2_FP8 ? I_DN : I_DNB);
    for (int it = gw; it < NITEMS; it += NGW) {
        int r = it;
        if (r < 2 * I_CI) { const int q = r / I_CI; p0_transpose_item(A.in[I_CWIN] + (size_t)q * DM * 3072, DM, 3072, (bf16_t*)(F.ws + WS_WCI) + (size_t)q * 3072 * DM, MAP_CONV, 0, scr, r % I_CI, F.lane); continue; } r -= 2 * I_CI;
        if (r < 2 * I_SQ) { const int q = r / I_SQ; p0_transpose_item(A.in[I_CWOUT] + (size_t)q * DM * DM, DM, DM, (bf16_t*)(F.ws + WS_WCO) + (size_t)q * DM * DM, MAP_NAT, 0, scr, r % I_SQ, F.lane); continue; } r -= 2 * I_SQ;
        if (r < I_AI) { p0_transpose_item(A.in[I_AWIN], DM, ATT_N, (bf16_t*)(F.ws + WS_WAI), MAP_ATTN, 0, scr, r, F.lane); continue; } r -= I_AI;
        if (r < I_SQ) { p0_transpose_item(A.in[I_AWOUT], DM, DM, (bf16_t*)(F.ws + WS_WAO), MAP_NAT, 0, scr, r, F.lane); continue; } r -= I_SQ;
        if (r < I_GL) { p0_transpose_item(A.in[I_SGLU], DM, 2048, (bf16_t*)(F.ws + WS_WGL), MAP_PAIR, 1024, scr, r, F.lane); continue; } r -= I_GL;
        if (F1L0_FP8) { if (r < I_GU8) { p0_transpose_item8(A.in[I_FGU], DM, 2 * FF, (unsigned char*)(F.ws + WS_WFG), MAP_PAIR, FF, scr, r, F.lane, 0); p0_transpose_item8(A.in[I_FGU], DM, 2 * FF, (unsigned char*)(F.ws + WS_WFG), MAP_PAIR, FF, scr, r, F.lane, 1); continue; } r -= I_GU8; }
        else { if (r < I_GU) { p0_transpose_item(A.in[I_FGU], DM, 2 * FF, (bf16_t*)(F.ws + WS_WFG), MAP_PAIR, FF, scr, r, F.lane); continue; } r -= I_GU; }
        if (r < I_GU) { p0_transpose_item(A.in[I_FGU] + (size_t)DM * 2 * FF, DM, 2 * FF, (bf16_t*)(F.ws + WS_WFG) + (size_t)2 * FF * DM, MAP_PAIR, FF, scr, r, F.lane); continue; } r -= I_GU;
        if (F2_FP8) { if (r < 2 * I_DN) { const int q = r / I_DN; p0_transpose_item8(A.in[I_FDN] + (size_t)q * FF * DM, FF, DM, (unsigned char*)(F.ws + WS_WFD) + (size_t)q * DM * FF, MAP_NAT, 0, scr, r % I_DN, F.lane, 0); p0_transpose_item8(A.in[I_FDN] + (size_t)q * FF * DM, FF, DM, (unsigned char*)(F.ws + WS_WFD) + (size_t)q * DM * FF, MAP_NAT, 0, scr, r % I_DN, F.lane, 1); continue; } r -= 2 * I_DN; }
        else if (F2L0_FP8) {
            if (r < I_DN) { p0_transpose_item8(A.in[I_FDN], FF, DM, (unsigned char*)(F.ws + WS_WFD), MAP_NAT, 0, scr, r, F.lane, 0); p0_transpose_item8(A.in[I_FDN], FF, DM, (unsigned char*)(F.ws + WS_WFD), MAP_NAT, 0, scr, r, F.lane, 1); continue; } r -= I_DN;
            if (r < I_DNB) { p0_transpose_item(A.in[I_FDN] + (size_t)FF * DM, FF, DM, (bf16_t*)(F.ws + WS_WFD) + (size_t)DM * FF, MAP_NAT, 0, scr, r, F.lane); continue; } r -= I_DNB; }
        else { if (r < 2 * I_DNB) { const int q = r / I_DNB; p0_transpose_item(A.in[I_FDN] + (size_t)q * FF * DM, FF, DM, (bf16_t*)(F.ws + WS_WFD) + (size_t)q * DM * FF, MAP_NAT, 0, scr, r % I_DNB, F.lane); continue; } r -= 2 * I_DNB; }
        if (M1L1_FP8) { if (r < 8 * I_GU8) { const int q = r / I_GU8; unsigned char* dst = (unsigned char*)(F.ws + WS_WMG) + (size_t)q * 2 * FF * DM;
                p0_transpose_item8(A.in[I_MGU] + (size_t)q * DM * 2 * FF, DM, 2 * FF, dst, MAP_PAIR, FF, scr, r % I_GU8, F.lane, 0); p0_transpose_item8(A.in[I_MGU] + (size_t)q * DM * 2 * FF, DM, 2 * FF, dst, MAP_PAIR, FF, scr, r % I_GU8, F.lane, 1); continue; } r -= 8 * I_GU8; }
        else { if (r < 8 * I_GU) { const int q = r / I_GU; p0_transpose_item(A.in[I_MGU] + (size_t)q * DM * 2 * FF, DM, 2 * FF, (bf16_t*)(F.ws + WS_WMG) + (size_t)q * 2 * FF * DM, MAP_PAIR, FF, scr, r % I_GU, F.lane); continue; } r -= 8 * I_GU; }
        if (M1_FP8) { if (r < 8 * I_GU8) { const int q = 8 + r / I_GU8; unsigned char* dst = (unsigned char*)(F.ws + WS_WMG) + (size_t)8 * 2 * FF * DM * 2 + (size_t)(q - 8) * 2 * FF * DM;
                p0_transpose_item8(A.in[I_MGU] + (size_t)q * DM * 2 * FF, DM, 2 * FF, dst, MAP_PAIR, FF, scr, r % I_GU8, F.lane, 0); p0_transpose_item8(A.in[I_MGU] + (size_t)q * DM * 2 * FF, DM, 2 * FF, dst, MAP_PAIR, FF, scr, r % I_GU8, F.lane, 1); continue; } r -= 8 * I_GU8; }
        else { if (r < 8 * I_GU) { const int q = 8 + r / I_GU; p0_transpose_item(A.in[I_MGU] + (size_t)q * DM * 2 * FF, DM, 2 * FF, (bf16_t*)(F.ws + WS_WMG) + (size_t)q * 2 * FF * DM, MAP_PAIR, FF, scr, r % I_GU, F.lane); continue; } r -= 8 * I_GU; }
        if (M2_FP8) { const int q = r / I_DN; p0_transpose_item8(A.in[I_MDN] + (size_t)q * FF * DM, FF, DM, (unsigned char*)(F.ws + WS_WMD) + (size_t)q * DM * FF, MAP_NAT, 0, scr, r % I_DN, F.lane, 0); p0_transpose_item8(A.in[I_MDN] + (size_t)q * FF * DM, FF, DM, (unsigned char*)(F.ws + WS_WMD) + (size_t)q * DM * FF, MAP_NAT, 0, scr, r % I_DN, F.lane, 1); }
        else { const int q = r / I_DNB; p0_transpose_item(A.in[I_MDN] + (size_t)q * FF * DM, FF, DM, (bf16_t*)(F.ws + WS_WMD) + (size_t)q * DM * FF, MAP_NAT, 0, scr, r % I_DNB, F.lane); }
    }
    { u32x4* z = (u32x4*)((bf16_t*)(F.ws + WS_WAI) + (size_t)2144 * DM); const int n16 = (ATT_NP - 2144) * DM * 2 / 16;
      for (int i = blockIdx.x * NTHREADS + F.tid; i < n16; i += F.G * NTHREADS) z[i] = (u32x4){0u, 0u, 0u, 0u}; }
}

template <int FLAGS>
__device__ __forceinline__ void thin_phase(Frame& F, const Args& A, const float* src, int nl  , int ns  , int cl  , int rl  , int cs = -1  , size_t roff = 0  ) {
    if (cs < 0) cs = rl;
    const int gw = F.vcu * NWAVES + F.wave, NGW = F.G * NWAVES;
    LAS float* rwt = (LAS float*)F.lds;
    if (FLAGS & 8) {
        const float* rw = A.in[I_RW] + (size_t)rl * DM * NEXP;
        for (int i = F.tid; i < DM * NEXP; i += NTHREADS) rwt[(i & 7) * DM + (i >> 3)] = rw[i];
        __syncthreads();
    }
    int Tb[8];
    if (FLAGS & 2) { int acc = 0;
#pragma unroll
        for (int e = 0; e < 8; ++e) { Tb[e] = acc; acc += (int)((__hip_atomic_load(F.ctl + CW_CNT + 64 * (8 * rl + e), RLX_AGENT) + 255u) >> 8); } }
    const float* ng = A.in[I_NORMG] + (size_t)(nl * 2 + ns) * DM;
    constexpr bool RT = (FLAGS & 8) != 0;
    LAS int* rE = (LAS int*)(F.lds + 32768);
    const int nit = RT ? ((M / 64 - (int)blockIdx.x + F.G - 1) / F.G) * 8 : (M - gw + NGW - 1) / NGW;
    for (int it = 0; it < nit; ++it) {
        const int chunk = (int)blockIdx.x + (it >> 3) * F.G;
        const int row = RT ? chunk * 64 + F.wave * 8 + (it & 7) : gw + it * NGW;
        const int b = row / SEQ;
        f32x4 v[4];
        const GAS unsigned long long* xr = (const GAS unsigned long long*)(src + (size_t)row * DM) + 2 * F.lane;
#pragma unroll
        for (int j = 0; j < 4; ++j) { const unsigned long long lo = __hip_atomic_load(xr + 128 * j, RLX_AGENT), hi = __hip_atomic_load(xr + 128 * j + 1, RLX_AGENT);
            v[j] = (f32x4){__uint_as_float((unsigned)lo), __uint_as_float((unsigned)(lo >> 32)), __uint_as_float((unsigned)hi), __uint_as_float((unsigned)(hi >> 32))}; }
        if (FLAGS & 2) {
            const int s0 = ((const int*)(F.ws + roff + WS_SLOT))[row * 2], s1 = ((const int*)(F.ws + roff + WS_SLOT))[row * 2 + 1];
            int t0 = 0, t1 = 0;
#pragma unroll
            for (int e = 0; e < 8; ++e) { if ((s0 >> 16) == e) t0 = Tb[e]; if ((s1 >> 16) == e) t1 = Tb[e]; }
            const bf16_t* y0 = (const bf16_t*)(F.ws + WS_BUF) + (size_t)(256 * t0 + (s0 & 0xffff)) * DM;
            const bf16_t* y1 = (const bf16_t*)(F.ws + WS_BUF) + (size_t)(256 * t1 + (s1 & 0xffff)) * DM;
            const float* g2 = cl >= 0 ? F.mod + ((size_t)cl * NB + b) * 6144 + 5 * DM : (const float*)(F.ws + 512 * 1024);
#pragma unroll
            for (int j = 0; j < 4; ++j) { const int col = 4 * F.lane + 256 * j; const u32x2 a = *(const u32x2*)(y0 + col), c = *(const u32x2*)(y1 + col); const f32x4 g = *(const f32x4*)(g2 + col);
                v[j][0] += g[0] * (bflo(a.x) + bflo(c.x)); v[j][1] += g[1] * (bfhi(a.x) + bfhi(c.x)); v[j][2] += g[2] * (bflo(a.y) + bflo(c.y)); v[j][3] += g[3] * (bfhi(a.y) + bfhi(c.y)); }
        }
        if (FLAGS & 3) { GAS f32x4* xo = (GAS f32x4*)(F.out + (size_t)row * DM) + F.lane;
#pragma unroll
            for (int j = 0; j < 4; ++j) xo[64 * j] = v[j]; }
        if (FLAGS & 4) {
            float ss = 0.f;
#pragma unroll
            for (int j = 0; j < 4; ++j) ss += (v[j][0] * v[j][0] + v[j][1] * v[j][1]) + (v[j][2] * v[j][2] + v[j][3] * v[j][3]);
            const float r = 1.0f / sqrtf(wave_sum(ss) * (1.0f / DM) + EPS);
            const float* sh = F.mod + ((size_t)nl * NB + b) * 6144 + (ns ? 3 : 0) * DM; const float* sc = sh + DM;
            GAS u32x2* ho = (GAS u32x2*)(F.HB + (size_t)row * DM) + F.lane;
#pragma unroll
            for (int j = 0; j < 4; ++j) { const int col = 4 * F.lane + 256 * j; const f32x4 g = *(const f32x4*)(ng + col), s1 = *(const f32x4*)(sc + col), s0 = *(const f32x4*)(sh + col);
                v[j] = (v[j] * r) * g * (s1 + 1.0f) + s0;
                if ((RT && ((M1_FP8 && nl == 3) || (M1L1_FP8 && nl == 1))) || (FLAGS == 4 && F1L0_FP8 && nl == 0 && ns == 1)) { int t = 0; t = __builtin_amdgcn_cvt_pk_fp8_f32(v[j][0], v[j][1], t, false); t = __builtin_amdgcn_cvt_pk_fp8_f32(v[j][2], v[j][3], t, true);
                    *(unsigned*)((unsigned char*)F.HB + (size_t)row * DM + col) = (unsigned)t; }
                else { u32x2 w; w.x = pk2(v[j][0], v[j][1]); w.y = pk2(v[j][2], v[j][3]); ho[64 * j] = w; } }
            if (FLAGS & 8) {
                float lg[8];
#pragma unroll
                for (int e = 0; e < 8; ++e) { float s = 0.f;
#pragma unroll
                    for (int j = 0; j < 4; ++j) { const f32x4 w = *(const LAS f32x4*)(rwt + e * DM + 4 * F.lane + 256 * j); s += (v[j][0] * w[0] + v[j][1] * w[1]) + (v[j][2] * w[2] + v[j][3] * w[3]); }
                    lg[e] = wave_sum(s) + A.in[I_RB][rl * NEXP + e]; }
                int e0 = 0; float l0 = lg[0];
#pragma unroll
                for (int e = 1; e < 8; ++e) if (lg[e] > l0) { l0 = lg[e]; e0 = e; }
                int e1 = -1; float l1 = -3.0e38f;
#pragma unroll
                for (int e = 0; e < 8; ++e) if (e != e0 && lg[e] > l1) { l1 = lg[e]; e1 = e; }
                const float g0 = 1.0f / (1.0f + __expf(l1 - l0)), g1 = 1.0f - g0;
                const int lr = F.wave * 8 + (it & 7);
                if (F.lane == 0) { rE[lr] = e0; rE[64 + lr] = e1; rE[128 + lr] = __float_as_int(g0); rE[192 + lr] = __float_as_int(g1); }
            }
        }
        if (RT && (it & 7) == 7) {
            __syncthreads();
            if (F.tid < 8) { int cnt = 0; for (int q = 0; q < 64; ++q) cnt += (rE[q] == F.tid) + (rE[64 + q] == F.tid);
                rE[256 + F.tid] = cnt ? (int)__hip_atomic_fetch_add(F.ctl + CW_CNT + 64 * (8 * cs + F.tid), (unsigned)cnt, RLX_AGENT) : 0; }
            __syncthreads();
            if (F.tid < 64) { const int e0 = rE[F.tid], e1 = rE[64 + F.tid]; int r0 = 0, r1 = 0;
                for (int q = 0; q < F.tid; ++q) { r0 += (rE[q] == e0) + (rE[64 + q] == e0); r1 += (rE[q] == e1) + (rE[64 + q] == e1); }
                const int p0 = rE[256 + e0] + r0, p1 = rE[256 + e1] + r1, grow = chunk * 64 + F.tid;
                gu32* ri = (gu32*)(F.ws + roff + WS_ROWIDX); gu32* gp = (gu32*)(F.ws + roff + WS_GATEP); gu32* sl = (gu32*)(F.ws + roff + WS_SLOT);
                __hip_atomic_store(ri + e0 * 16384 + p0, (unsigned)grow, RLX_AGENT); __hip_atomic_store(ri + e1 * 16384 + p1, (unsigned)grow, RLX_AGENT);
                __hip_atomic_store(gp + e0 * 16384 + p0, (unsigned)rE[128 + F.tid], RLX_AGENT); __hip_atomic_store(gp + e1 * 16384 + p1, (unsigned)rE[192 + F.tid], RLX_AGENT);
                __hip_atomic_store(sl + grow * 2, (unsigned)((e0 << 16) | p0), RLX_AGENT); __hip_atomic_store(sl + grow * 2 + 1, (unsigned)((e1 << 16) | p1), RLX_AGENT); }
            __syncthreads();
        }
    }
}

__device__ __forceinline__ void unpack8(const u32x4 w, float (&f)[8]) { f[0] = bflo(w.x); f[1] = bfhi(w.x); f[2] = bflo(w.y); f[3] = bfhi(w.y); f[4] = bflo(w.z); f[5] = bfhi(w.z); f[6] = bflo(w.w); f[7] = bfhi(w.w); }
__device__ __forceinline__ void conv_phase(Frame& F, const float* cw  ) {
    const int gw = F.vcu * NWAVES + F.wave, NGW = F.G * NWAVES;
    const bf16_t* UB = F.BUF;
    for (int task = gw; task < M / 8; task += NGW) {
        const int r0 = task * 8; const bool first = (r0 % SEQ) == 0;
#pragma unroll
        for (int j = 0; j < 2; ++j) {
            const int ch = 8 * F.lane + 512 * j;
            float w0[8], w1[8], w2[8];
#pragma unroll
            for (int e = 0; e < 8; ++e) { w0[e] = cw[ch + e]; w1[e] = cw[DM + ch + e]; w2[e] = cw[2 * DM + ch + e]; }
            float um2[8], um1[8];
            if (first) {
#pragma unroll
                for (int e = 0; e < 8; ++e) { um2[e] = 0.f; um1[e] = 0.f; }
            } else { unpack8(*(const u32x4*)(UB + (size_t)(r0 - 2) * 2048 + ch), um2); unpack8(*(const u32x4*)(UB + (size_t)(r0 - 1) * 2048 + ch), um1); }
#pragma unroll
            for (int i = 0; i < 8; ++i) {
                float u0[8], bb[8]; unpack8(*(const u32x4*)(UB + (size_t)(r0 + i) * 2048 + ch), u0); unpack8(*(const u32x4*)(UB + (size_t)(r0 + i) * 2048 + 1024 + ch), bb);
                float z[8];
#pragma unroll
                for (int e = 0; e < 8; ++e) z[e] = bb[e] * (w0[e] * um2[e] + w1[e] * um1[e] + w2[e] * u0[e]);
                u32x4 o; o.x = pk2(z[0], z[1]); o.y = pk2(z[2], z[3]); o.z = pk2(z[4], z[5]); o.w = pk2(z[6], z[7]);
                *(u32x4*)(F.HB + (size_t)(r0 + i) * DM + ch) = o;
#pragma unroll
                for (int e = 0; e < 8; ++e) { um2[e] = um1[e]; um1[e] = u0[e]; }
            }
        }
    }
}

constexpr int QIP = 1040;
constexpr int AL_QI = 0, AL_WI = 33280, AL_SEL = 34304, AL_V = 42496, AL_BIASD = 108032, AL_SUM = 116288, AL_END = 116800;
typedef short v4i16_t __attribute__((ext_vector_type(4)));
__device__ __forceinline__ unsigned okey(float f) { const unsigned u = __float_as_uint(f); return u ^ ((u >> 31) ? 0xFFFFFFFFu : 0x80000000u); }
__device__ __forceinline__ void attn_phase(Frame& F, const Args& A) {
    LAS unsigned char* L = F.lds;
    const bf16_t* Qb = (const bf16_t*)(F.ws + WS_Q); const bf16_t* Kb = (const bf16_t*)(F.ws + WS_K); const bf16_t* Vb = (const bf16_t*)(F.ws + WS_V);
    const bf16_t* QIb = (const bf16_t*)(F.ws + WS_QI); const bf16_t* KIb = (const bf16_t*)(F.ws + WS_KI); const float* WIb = (const float*)(F.ws + WS_WI);
    bf16_t* Ob = (bf16_t*)(F.ws + WS_O);
    float* SC = (float*)(F.ws + WS_SC) + (size_t)blockIdx.x * 32 * SEQ;
    const int lane = F.lane, wave = F.wave;
    { LAS float* bd = (LAS float*)(L + AL_BIASD);
      for (int i = F.tid; i < 129 * 16; i += NTHREADS) { const int d = i >> 4; int bkt; if (d < 16) bkt = d; else { const float dd = (float)d; const int lg2 = 16 + (int)(logf(dd / 16.0f) / 2.0794415416798357f * 16.0f); bkt = lg2 < 31 ? lg2 : 31; }
          bd[i] = A.in[I_RELB][bkt * 16 + (i & 15)]; }
    }
    __syncthreads();
    for (int pass = 0; pass < 2; ++pass) {
        const int un = pass == 0 ? (int)blockIdx.x : 511 - (int)blockIdx.x;
        for (int uu = un; uu >= 0 && uu < 512; uu += (pass == 0 ? F.G * 2 : -F.G * 2)) {
        if ((pass == 0 && uu >= 256) || (pass == 1 && uu < 256)) break;
        const int b = uu & 3, qb = uu >> 2, t0 = qb * 32; const size_t rb = (size_t)b * SEQ;
        for (int i = F.tid; i < 32 * 64; i += NTHREADS) { const int q = i >> 6, c = i & 63; *(LAS u32x4*)(L + AL_QI + q * QIP + c * 16) = *(const u32x4*)(QIb + (rb + t0 + q) * 512 + c * 8); }
        if (F.tid < 256) ((LAS float*)(L + AL_WI))[F.tid] = WIb[(rb + t0) * 8 + F.tid];
        __syncthreads();
        {
            for (int kt = wave; kt <= qb; kt += NWAVES) {
                int ln1 = lane; asm volatile("" : "+v"(ln1));
                const int r = ln1 & 31, hh = ln1 >> 5;
                float wi[8];
#pragma unroll
                for (int h = 0; h < 8; ++h) wi[h] = ((LAS float*)(L + AL_WI))[r * 8 + h];
                bf16x8 ka[4];
#pragma unroll
                for (int ks = 0; ks < 4; ++ks) ka[ks] = *(const bf16x8*)(KIb + (rb + kt * 32 + r) * 64 + 16 * ks + 8 * hh);
                f32x16 sc;
#pragma unroll
                for (int i = 0; i < 16; ++i) sc[i] = 0.f;
#pragma unroll
                for (int h = 0; h < 8; ++h) {
                    f32x16 d;
#pragma unroll
                    for (int i = 0; i < 16; ++i) d[i] = 0.f;
#pragma unroll
                    for (int ks = 0; ks < 4; ++ks) { const bf16x8 qf = *(const LAS bf16x8*)(L + AL_QI + r * QIP + (h * 64 + 16 * ks + 8 * hh) * 2); d = __builtin_amdgcn_mfma_f32_32x32x16_bf16(ka[ks], qf, d, 0, 0, 0); }
#pragma unroll
                    for (int i = 0; i < 16; ++i) sc[i] += wi[h] * fmaxf(d[i], 0.f);
                }
#pragma unroll
                for (int a = 0; a < 4; ++a) { f32x4 o;
#pragma unroll
                    for (int e = 0; e < 4; ++e) { const int krow = 8 * a + 4 * hh + e; o[e] = (kt == qb && krow > r) ? -INFINITY : sc[4 * a + e]; }
                    *(f32x4*)(SC + (size_t)r * SEQ + kt * 32 + 8 * a + 4 * hh) = o; }
            }
        }
        VM_WAIT(); __syncthreads();
        for (int qq = 0; qq < 4; ++qq) {
            const int c = wave + 8 * qq, t = t0 + c; const int nvalid = t + 1;
            int lane = F.lane; asm volatile("" : "+v"(lane));
            LAS int* sel = (LAS int*)(L + AL_SEL) + wave * 256;
            int count;
            if (nvalid <= TOPK) {
                count = nvalid;
#pragma unroll
                for (int j = 0; j < 4; ++j) { const int idx = 64 * j + lane; sel[idx] = idx < nvalid ? idx : 0; }
            } else {
                count = TOPK;
                const int nj = (nvalid + 63) >> 6;
                unsigned key[64];
                const float* srow = SC + (size_t)c * SEQ;
#define SEL_GROUPS(BODY) do { BODY(0) if (nj > 16) { BODY(1) if (nj > 32) { BODY(2) if (nj > 48) { BODY(3) } } } } while (0)
#define SEL_LOAD(g) { _Pragma("unroll") for (int j = 16 * (g); j < 16 * (g) + 16; ++j) { const int idx = 64 * j + lane; const float sv = __uint_as_float(__hip_atomic_load((const gu32*)(srow + idx), RLX_AGENT)); key[j] = idx <= t ? okey(sv) : 0u;     } }
#pragma unroll
                for (int j = 0; j < 64; ++j) key[j] = 0u;
                SEL_GROUPS(SEL_LOAD);
                unsigned T = 0u;
                for (int bit = 31; bit >= 0; --bit) {
                    const unsigned cand = T | (1u << bit); int cnt = 0;
#define SEL_CNT(g) { _Pragma("unroll") for (int j = 16 * (g); j < 16 * (g) + 16; ++j) cnt += __popcll(__ballot(key[j] >= cand)); }
                    SEL_GROUPS(SEL_CNT);
                    if (cnt >= TOPK) T = cand;
                    if (cnt == TOPK) break;
                }
                int base = 0;
#define SEL_GT(g) { _Pragma("unroll") for (int j = 16 * (g); j < 16 * (g) + 16; ++j) { const bool gt = key[j] > T; const unsigned long long mk = __ballot(gt); \
                    const int pos = base + (int)__builtin_amdgcn_mbcnt_hi((unsigned)(mk >> 32), __builtin_amdgcn_mbcnt_lo((unsigned)mk, 0u)); if (gt) sel[pos] = 64 * j + lane; base += __popcll(mk); } }
                SEL_GROUPS(SEL_GT);
                const int need = TOPK - base; int eb = 0;
#define SEL_EQ(g) { _Pragma("unroll") for (int j = 16 * (g); j < 16 * (g) + 16; ++j) { const bool eq = key[j] == T; const unsigned long long mk = __ballot(eq); \
                    const int rank = eb + (int)__builtin_amdgcn_mbcnt_hi((unsigned)(mk >> 32), __builtin_amdgcn_mbcnt_lo((unsigned)mk, 0u)); if (eq && rank < need) sel[base + rank] = 64 * j + lane; eb += __popcll(mk); } }
                SEL_GROUPS(SEL_EQ);
#undef SEL_GROUPS
#undef SEL_LOAD
#undef SEL_CNT
#undef SEL_GT
#undef SEL_EQ
            }
            LDS_WAIT(); CFENCE();
            asm volatile("" : "+v"(lane));
            const int hd = lane & 15, kq = lane >> 4;
            bf16x8 bq[8];
            { bf16x8 qf[2];
#pragma unroll
              for (int s2 = 0; s2 < 2; ++s2) qf[s2] = *(const bf16x8*)(Qb + (rb + t) * 1024 + hd * 64 + 32 * s2 + 8 * kq);
              const bf16x8 zf = (bf16x8){0, 0, 0, 0, 0, 0, 0, 0};
#pragma unroll
              for (int ks = 0; ks < 8; ++ks) bq[ks] = ((ks >> 1) == (hd >> 2)) ? qf[ks & 1] : zf; }
            f32x4 lg[16];
            float mx = -INFINITY;
            bf16x8 kf[3][8];
#pragma unroll
            for (int pre = 0; pre < 2; ++pre) { const int krow = sel[16 * pre + hd]; const bf16_t* kp = Kb + (rb + krow) * 256 + 8 * kq;
#pragma unroll
              for (int ks = 0; ks < 8; ++ks) kf[pre][ks] = *(const bf16x8*)(kp + 32 * ks); }
            const LAS float* biasd = (const LAS float*)(L + AL_BIASD);
#pragma unroll
            for (int kt = 0; kt < 16; ++kt) {
                if (kt < 14) { const int krow = sel[16 * (kt + 2) + hd]; const bf16_t* kp = Kb + (rb + krow) * 256 + 8 * kq;
#pragma unroll
                    for (int ks = 0; ks < 8; ++ks) kf[(kt + 2) % 3][ks] = *(const bf16x8*)(kp + 32 * ks); }
                f32x4 d = (f32x4){0.f, 0.f, 0.f, 0.f};
#pragma unroll
                for (int ks = 0; ks < 8; ++ks) d = __builtin_amdgcn_mfma_f32_16x16x32_bf16(kf[kt % 3][ks], bq[ks], d, 0, 0, 0);
                const u32x4 ks4 = *(const LAS u32x4*)(sel + 16 * kt + 4 * kq);
#pragma unroll
                for (int i = 0; i < 4; ++i) { const int pos = 16 * kt + 4 * kq + i; int dist = t - (int)ks4[i]; dist = dist < 0 ? 0 : (dist > 128 ? 128 : dist);
                    const float bs = biasd[dist * 16 + hd];
                    d[i] = pos < count ? d[i] + bs : -INFINITY; mx = fmaxf(mx, d[i]); }
                lg[kt] = d;
            }
            mx = fmaxf(mx, __shfl_xor(mx, 16)); mx = fmaxf(mx, __shfl_xor(mx, 32));
            float sum = 0.f;
            bf16x8 pa[8];
#pragma unroll
            for (int ks = 0; ks < 8; ++ks) { float p[8];
#pragma unroll
                for (int i = 0; i < 4; ++i) { p[i] = __expf(lg[2 * ks][i] - mx); p[4 + i] = __expf(lg[2 * ks + 1][i] - mx); }
                sum += ((p[0] + p[1]) + (p[2] + p[3])) + ((p[4] + p[5]) + (p[6] + p[7]));
                u32x4 w; w.x = cvt_pk_bf16(p[0], p[1]); w.y = cvt_pk_bf16(p[2], p[3]); w.z = cvt_pk_bf16(p[4], p[5]); w.w = cvt_pk_bf16(p[6], p[7]);
                pa[ks] = __builtin_bit_cast(bf16x8, w); }
            sum += __shfl_xor(sum, 16); sum += __shfl_xor(sum, 32);
            if (kq == 0) ((LAS float*)(L + AL_SUM))[wave * 16 + hd] = sum;
            LDS_WAIT(); CFENCE();
            {
                asm volatile("" : "+v"(lane));
                const int rs = lane >> 3, ch = lane & 7, i16 = lane & 15, tq = i16 >> 2, tp = i16 & 3, kq2 = lane >> 4;
                LAS unsigned char* vb = L + AL_V + wave * 8192;
                const unsigned wr_off = (unsigned)lane * 16u, tr_off = (unsigned)((4 * kq2 + tq) * 128 + 8 * tp);
                f32x4 O[4][4];
#pragma unroll
                for (int n = 0; n < 4; ++n)
#pragma unroll
                    for (int dt = 0; dt < 4; ++dt) O[n][dt] = (f32x4){0.f, 0.f, 0.f, 0.f};
                u32x4 vr[2][4]; int kr[4];
                const bf16_t* vbase = Vb + rb * 256 + 8 * ch;
#pragma unroll
                for (int i = 0; i < 4; ++i) kr[i] = sel[8 * i + rs];
#pragma unroll
                for (int pre = 0; pre < 2; ++pre)
#pragma unroll
                    for (int i = 0; i < 4; ++i) vr[pre][i] = *(const u32x4*)(vbase + (size_t)kr[i] * 256 + pre * 64);
#pragma unroll
                for (int st = 0; st < 32; ++st) {
                    const int ks = st >> 2, n = st & 3;
                    LAS unsigned char* buf = vb + (st & 1) * 4096;
#pragma unroll
                    for (int i = 0; i < 4; ++i) *(LAS u32x4*)(buf + wr_off + i * 1024) = vr[st & 1][i];
                    if (st < 30) { const int ks2 = (st + 2) >> 2, n2 = (st + 2) & 3;
                        if (n2 == 0) {
#pragma unroll
                            for (int i = 0; i < 4; ++i) kr[i] = sel[32 * ks2 + 8 * i + rs]; }
#pragma unroll
                        for (int i = 0; i < 4; ++i) vr[st & 1][i] = *(const u32x4*)(vbase + (size_t)kr[i] * 256 + n2 * 64); }
#pragma unroll
                    for (int dt = 0; dt < 4; ++dt) {
                        const v4i16_t t0 = __builtin_amdgcn_ds_read_tr16_b64_v4i16((LAS v4i16_t*)(buf + tr_off + 32 * dt));
                        const v4i16_t t1 = __builtin_amdgcn_ds_read_tr16_b64_v4i16((LAS v4i16_t*)(buf + tr_off + 2048 + 32 * dt));
                        const bf16x8 bfr = (bf16x8){t0[0], t0[1], t0[2], t0[3], t1[0], t1[1], t1[2], t1[3]};
                        O[n][dt] = __builtin_amdgcn_mfma_f32_16x16x32_bf16(pa[ks], bfr, O[n][dt], 0, 0, 0); }
                    CFENCE();
                }
                const f32x4 sm = *(const LAS f32x4*)(L + AL_SUM + (wave * 16 + 4 * kq2) * 4);
                bf16_t* op = Ob + (rb + t) * 1024 + (4 * kq2) * 64 + i16;
#pragma unroll
                for (int dt = 0; dt < 4; ++dt)
#pragma unroll
                    for (int i = 0; i < 4; ++i) { const float v = kq2 == 0 ? O[0][dt][i] : (kq2 == 1 ? O[1][dt][i] : (kq2 == 2 ? O[2][dt][i] : O[3][dt][i]));
                        op[i * 64 + 16 * dt] = (bf16_t)f2bf(v / sm[i]); }
            }
            LDS_WAIT(); CFENCE();
        }
        __syncthreads();
        }
    }
}

constexpr int SL_BMT = 0;
constexpr int SL_CMA = 4096;
constexpr int SL_AB = 12288;
constexpr int SL_E = 12800;
constexpr int SL_S = 16896;
constexpr int SPITCH = 272;
__device__ __forceinline__ void cmul(float ar, float ai, float br, float bi, float& cr, float& ci) { cr = ar * br - ai * bi; ci = ar * bi + ai * br; }
__device__ __forceinline__ void ssm_phase(Frame& F, const Args& A) {
    LAS unsigned char* L = F.lds;
    const int lane = F.lane, wave = F.wave;
    bf16_t* G = (bf16_t*)(F.ws + WS_ACT);
    for (int un = F.vcu; un < NB * 64; un += F.G) {
        const int b = un >> 6, g = un & 63; const size_t rb = (size_t)b * SEQ;
        __syncthreads();
        if (F.tid < 64) {
            const int p = F.tid;
            const float lr = fminf(A.in[I_SLRE][g * 64 + p], -1e-4f), li = A.in[I_SLIM][g * 64 + p];
            const float step = expf(A.in[I_SLOG][g]);
            const float mag = expf(lr * step); float sn, cs; sincosf(li * step, &sn, &cs);
            const float ar = mag * cs, ai = mag * sn;
            ((LAS float*)(L + SL_AB))[2 * p] = ar; ((LAS float*)(L + SL_AB))[2 * p + 1] = ai;
            const float nr = ar - 1.0f, ni = ai, den = lr * lr + li * li;
            const float cr = (nr * lr + ni * li) / den, ci = (ni * lr - nr * li) / den;
            LAS bf16_t* bm = (LAS bf16_t*)(L + SL_BMT);
#pragma unroll
            for (int c = 0; c < 16; ++c) { const float br = A.in[I_SBRE][((size_t)g * 64 + p) * 16 + c], bi = A.in[I_SBIM][((size_t)g * 64 + p) * 16 + c];
                float xr, xi; cmul(cr, ci, br, bi, xr, xi); bm[p * 16 + c] = (bf16_t)f2bf(xr); bm[(64 + p) * 16 + c] = (bf16_t)f2bf(xi); }
        }
        { LAS bf16_t* cm = (LAS bf16_t*)(L + SL_CMA);
          for (int i = F.tid; i < 32 * 128; i += NTHREADS) { const int c = i >> 7, k = i & 127; float v = 0.f;
              if (c < 16) v = (k < 64) ? A.in[I_SCRE][((size_t)g * 16 + c) * 64 + k] : -A.in[I_SCIM][((size_t)g * 16 + c) * 64 + (k - 64)];
              cm[i] = (bf16_t)f2bf(v); } }
        __syncthreads();
        const int r = lane & 31, hh = lane >> 5;
        bf16x8 bfr[4];
#pragma unroll
        for (int n = 0; n < 4; ++n) bfr[n] = *(const LAS bf16x8*)(L + SL_BMT + ((32 * n + r) * 16 + 8 * hh) * 2);
        bf16x8 cfr[8];
#pragma unroll
        for (int ks = 0; ks < 8; ++ks) cfr[ks] = *(const LAS bf16x8*)(L + SL_CMA + (r * 128 + 16 * ks + 8 * hh) * 2);
        float ar[2], ai[2], a16r[2], a16i[2], a512r[2], a512i[2];
#pragma unroll
        for (int s = 0; s < 2; ++s) { ar[s] = ((LAS float*)(L + SL_AB))[2 * (32 * s + r)]; ai[s] = ((LAS float*)(L + SL_AB))[2 * (32 * s + r) + 1];
            float pr = ar[s], pi = ai[s];
#pragma unroll
            for (int q = 0; q < 4; ++q) { float nr, ni; cmul(pr, pi, pr, pi, nr, ni); pr = nr; pi = ni; }
            a16r[s] = pr; a16i[s] = pi;
#pragma unroll
            for (int q = 0; q < 5; ++q) { float nr, ni; cmul(pr, pi, pr, pi, nr, ni); pr = nr; pi = ni; }
            a512r[s] = pr; a512i[s] = pi; }
        const int tokperm = 16 * ((r >> 2) & 1) + 4 * (r >> 3) + (r & 3);
        const float dsk0 = 0.f; (void)dsk0;
        float cin_r[2] = {0.f, 0.f}, cin_i[2] = {0.f, 0.f};
        LAS unsigned char* Sw = L + SL_S + wave * (32 * SPITCH);
        for (int pass = 0; pass < 2; ++pass) {
            if (pass == 1) {
                __syncthreads();
#pragma unroll
                for (int s = 0; s < 2; ++s) { float cr = 0.f, ci = 0.f;
                    for (int w = 0; w < wave; ++w) { float nr, ni; cmul(a512r[s], a512i[s], cr, ci, nr, ni); cr = nr + ((LAS float*)(L + SL_E))[(w * 64 + 32 * s + r) * 2]; ci = ni + ((LAS float*)(L + SL_E))[(w * 64 + 32 * s + r) * 2 + 1]; }
                    cin_r[s] = cr; cin_i[s] = ci; }
            }
            bf16x8 ufn = *(const bf16x8*)(F.HB + (rb + wave * 512 + tokperm) * DM + 16 * g + 8 * hh);
            for (int tile = 0; tile < 16; ++tile) {
                asm volatile("s_waitcnt vmcnt(0) lgkmcnt(0)" ::: "memory"); __builtin_amdgcn_s_barrier(); asm volatile("" ::: "memory");
                const int tk0 = wave * 512 + tile * 32;
                const bf16x8 uf = ufn;
                if (tile < 15) ufn = *(const bf16x8*)(F.HB + (rb + tk0 + 32 + tokperm) * DM + 16 * g + 8 * hh);

                f32x16 d[4];
#pragma unroll
                for (int n = 0; n < 4; ++n) {
#pragma unroll
                    for (int i = 0; i < 16; ++i) d[n][i] = 0.f;
                    d[n] = __builtin_amdgcn_mfma_f32_32x32x16_bf16(uf, bfr[n], d[n], 0, 0, 0); }
                asm volatile("s_nop 15\n\ts_nop 15\n\ts_nop 15" : "+v"(d[0]), "+v"(d[1]), "+v"(d[2]), "+v"(d[3]));
#pragma unroll
                for (int s = 0; s < 2; ++s) {
                    float sr = hh == 0 ? cin_r[s] : 0.f, si = hh == 0 ? cin_i[s] : 0.f;
#pragma unroll
                    for (int i = 0; i < 16; ++i) { const float nr = ar[s] * sr - ai[s] * si + d[s][i], ni = ar[s] * si + ai[s] * sr + d[2 + s][i]; sr = nr; si = ni; d[s][i] = sr; d[2 + s][i] = si; }
                    const float e0r = __shfl_xor(sr, 32), e0i = __shfl_xor(si, 32);
                    float cr = hh == 1 ? e0r : 0.f, ci = hh == 1 ? e0i : 0.f;
                    if (pass == 1) {
#pragma unroll
                        for (int i = 0; i < 16; ++i) { float nr, ni; cmul(ar[s], ai[s], cr, ci, nr, ni); cr = nr; ci = ni; d[s][i] += cr; d[2 + s][i] += ci; }
                    } else { float nr, ni; cmul(a16r[s], a16i[s], cr, ci, nr, ni); cr = nr; ci = ni; }
                    const float endr = (pass == 1) ? d[s][15] : sr + cr, endi = (pass == 1) ? d[2 + s][15] : si + ci;
                    const float xr = __shfl_xor(endr, 32), xi = __shfl_xor(endi, 32);
                    cin_r[s] = hh == 1 ? endr : xr; cin_i[s] = hh == 1 ? endi : xi;
                }
                if (pass == 1) {
#pragma unroll
                    for (int s = 0; s < 2; ++s)
#pragma unroll
                        for (int i = 0; i < 16; ++i) { *(LAS bf16_t*)(Sw + (16 * hh + i) * SPITCH + (32 * s + r) * 2) = (bf16_t)f2bf(d[s][i]); *(LAS bf16_t*)(Sw + (16 * hh + i) * SPITCH + (64 + 32 * s + r) * 2) = (bf16_t)f2bf(d[2 + s][i]); }
                    LDS_WAIT(); CFENCE();
                    f32x16 y;
#pragma unroll
                    for (int i = 0; i < 16; ++i) y[i] = 0.f;
#pragma unroll
                    for (int ks = 0; ks < 8; ++ks) { const bf16x8 sf = *(const LAS bf16x8*)(Sw + r * SPITCH + (16 * ks + 8 * hh) * 2); y = __builtin_amdgcn_mfma_f32_32x32x16_bf16(cfr[ks], sf, y, 0, 0, 0); }
                    LDS_WAIT(); CFENCE();
                    const size_t trow = rb + tk0 + r;
#pragma unroll
                    for (int q = 0; q < 2; ++q) { const int ch = 16 * g + 8 * q + 4 * hh;
                        const u32x2 hv = *(const u32x2*)(F.HB + trow * DM + ch); const f32x4 dk = *(const f32x4*)(A.in[I_SD] + ch);
                        const float y0 = gelu_tanh_f(y[4 * q + 0] + dk[0] * bflo(hv.x)), y1 = gelu_tanh_f(y[4 * q + 1] + dk[1] * bfhi(hv.x)), y2 = gelu_tanh_f(y[4 * q + 2] + dk[2] * bflo(hv.y)), y3 = gelu_tanh_f(y[4 * q + 3] + dk[3] * bfhi(hv.y));
                        u32x2 w; w.x = pk2(y0, y1); w.y = pk2(y2, y3); *(u32x2*)(G + trow * DM + ch) = w; }
                }
            }
            if (pass == 0) {
                if (hh == 1) {
#pragma unroll
                    for (int s = 0; s < 2; ++s) { ((LAS float*)(L + SL_E))[(wave * 64 + 32 * s + r) * 2] = cin_r[s]; ((LAS float*)(L + SL_E))[(wave * 64 + 32 * s + r) * 2 + 1] = cin_i[s]; } }
                cin_r[0] = cin_r[1] = cin_i[0] = cin_i[1] = 0.f;
            }
        }
    }
}

enum { PH_PRO = 0, PH_NORM0,
       L0_G1, L0_CONV, L0_G2, L0_NORM, L0_F1, L0_F2, L0_NORMN,
       L1_G1, L1_ATTN, L1_G2, L1_NORMR, L1_M1, L1_M2, L1_COMB,
       L2_SSM, L2_G2, L2_NORM, L2_F1, L2_F2, L2_NORMN,
       L3_G1, L3_CONV, L3_G2, L3_NORMR, L3_M1, L3_M2, L3_COMB, NPH };

__device__ __forceinline__ bool fresh_ids(Frame& F) { const int l = lane_id_fresh(); F.lane = l; F.tid = F.wave * 64 + l; return true; }
__global__ void __launch_bounds__(NTHREADS, 2) mega_fwd(Args args) {
    extern __shared__ __attribute__((aligned(16))) unsigned char lds_raw[];
    Frame F;
    F.lds = (LAS unsigned char*)lds_raw;
    volatile LAS unsigned* MISC = (volatile LAS unsigned*)(F.lds + MISC_OFF);
    F.tid = threadIdx.x; F.lane = F.tid & 63; F.wave = __builtin_amdgcn_readfirstlane(F.tid >> 6);
    F.G = gridDim.x; { const int bx = blockIdx.x; F.vcu = (F.G % 8 == 0) ? (bx % 8) * (F.G / 8) + bx / 8 : bx; }
    F.ws = args.ws; F.ctl = (gu32*)(args.ws + WS_CTL); F.out = args.out; F.mod = (const float*)(args.ws + WS_MOD);
    F.HB = (bf16_t*)(args.ws + WS_HB); F.BUF = (bf16_t*)(args.ws + WS_BUF); F.ACT = (bf16_t*)(args.ws + WS_ACT);
    for (int u = F.tid; u < (LDS_BYTES - LDSCTL_OFF) / 4; u += NTHREADS) ((LAS unsigned*)(F.lds + LDSCTL_OFF))[u] = 0u;
    __syncthreads();
    XcdBarrier bar; bar.bar = (unsigned*)(F.ctl + CW_BAR); bar.x = 0; bar.st = nullptr; bar.w = F.wave;
    const int lo = args.ph_lo, hi = args.ph_hi;
    if (hi - lo > 1) bar = xcd_barrier_post((unsigned*)(F.ctl + CW_BAR), MISC + 8, F.wave);
#ifndef PH_ONLY
#define PH_EN(k) true
#else
#define PH_EN(k) ((k) == PH_ONLY)
#endif
#define IN(k) (PH_EN(k) && lo <= (k) && (k) < hi && fresh_ids(F))
#define SEAM(k) do { if (IN(k) && IN((k) + 1)) xcd_barrier(bar); } while (0)
#ifndef PH_REP
#define PH_REP (-1)
#endif
#ifndef PH_REPMASK
#define PH_REPMASK 0ull
#endif
#define REPB(k, ...) do { if (PH_REP == (k) || ((PH_REPMASK >> (k)) & 1ull)) { xcd_barrier(bar); __VA_ARGS__; } } while (0)
    LAS unsigned char* ring = F.lds;
    const int cid = (int)blockIdx.x;
    bf16_t* const WCI = (bf16_t*)(F.ws + WS_WCI); bf16_t* const WCO = (bf16_t*)(F.ws + WS_WCO); bf16_t* const WAI = (bf16_t*)(F.ws + WS_WAI); bf16_t* const WAO = (bf16_t*)(F.ws + WS_WAO);
    bf16_t* const WGL = (bf16_t*)(F.ws + WS_WGL); bf16_t* const WFG = (bf16_t*)(F.ws + WS_WFG); bf16_t* const WFD = (bf16_t*)(F.ws + WS_WFD); bf16_t* const WMG = (bf16_t*)(F.ws + WS_WMG); bf16_t* const WMD = (bf16_t*)(F.ws + WS_WMD);

#define ZEROG ((const float*)(F.ws + 512 * 1024))
    const bool fuseR = (F.G == 256) && FUSE_R;
    const bool fuse = (F.G == 256) && FUSE_N;
#define FUSED_EPI(inst, gatep, xin, nl, ns, hout, asc, h8_) ({F.out, (gatep), (xin), args.in[I_NORMG] + (size_t)((nl) * 2 + (ns)) * DM, F.mod + (size_t)(nl) * NB * 6144 + ((ns) ? 3 : 0) * DM, (hout), (float*)(F.ws + WS_XS), F.ctl + CW_PAN + 64 * 64 * (inst), F.ctl + CW_TMO, (asc), (h8_)})
#define FUSED_RT(inst, gatep, nl, rl, roff, hout, h8_) ({F.out, (gatep), args.in[I_NORMG] + (size_t)((nl) * 2 + 1) * DM, F.mod + (size_t)(nl) * NB * 6144 + 3 * DM, (hout), (float*)(F.ws + WS_XS9), F.ctl + CW_PAN + 64 * 64 * (inst), F.ctl + CW_TMO, \
        args.in[I_RW] + (size_t)(rl) * DM * NEXP, args.in[I_RB] + (rl) * NEXP, F.ctl + CW_CNT + 64 * 8 * (rl), F.ws + (roff), (h8_)})
#define MODP(l, chunk) (F.mod + (size_t)(l) * NB * 6144 + (chunk) * DM)
#define GEMM_STATIC(Aptr, Bptr, Nn, Kk, EpiT, EpiInit) do { pg8::Gemm g{(Aptr), (Bptr), M, (Nn), (Kk), 0, nullptr, nullptr}; pg8::StaticOrder S; S.init(M, (Nn), F.G, cid); EpiT E EpiInit; \
        pg8::gemm_phase<EpiT, pg8::StaticOrder, false>(ring, g, S, E, F.wave); } while (0)
#define GEMM_STATIC8(Aptr, Bptr, Nn, Kk, EpiT, EpiInit) do { pg8::Gemm g{(Aptr), (Bptr), M, (Nn), (Kk), 0, nullptr, nullptr}; pg8::StaticOrder S; S.init(M, (Nn), F.G, cid); EpiT E EpiInit; \
        pg8::gemm_phase<EpiT, pg8::StaticOrder, false, true>(ring, g, S, E, F.wave); } while (0)
#define EPAIR8 pg8::EpiPair<1, (M2_FP8 != 0), (M1_FP8 != 0)>
#define M1_B (M1_FP8 ? 1 : 2)
#define EPAIR8L1 pg8::EpiPair<1, (M2_FP8 != 0), (M1L1_FP8 != 0)>
#define M2_B (M2_FP8 ? 1 : 2)
#define F2_ASC (F2_FP8 ? pg8::W8_INV : 1.0f)
#define GEMM_STATICF(Aptr, Bptr, Nn, Kk, EpiT, EpiInit) do { pg8::Gemm g{(Aptr), (Bptr), M, (Nn), (Kk), 0, nullptr, nullptr}; pg8::StaticOrder S; S.init(M, (Nn), F.G, cid); EpiT E EpiInit; \
        pg8::gemm_phase<EpiT, pg8::StaticOrder, false, (F2_FP8 != 0)>(ring, g, S, E, F.wave); } while (0)
#define EPAIRF pg8::EpiPair<1, (F2_FP8 != 0), false>
#define F0_FP8 (F2_FP8 || F2L0_FP8)
#define F2L0_ASC (F0_FP8 ? pg8::W8_INV : 1.0f)
#define EPAIR0 pg8::EpiPair<1, (F0_FP8 != 0), false>
#define EPAIR0S pg8::EpiPair<1, (F0_FP8 != 0), (F1L0_FP8 != 0)>
#define GEMM_STATICF0(Aptr, Bptr, Nn, Kk, EpiT, EpiInit) do { pg8::Gemm g{(Aptr), (Bptr), M, (Nn), (Kk), 0, nullptr, nullptr}; pg8::StaticOrder S; S.init(M, (Nn), F.G, cid); EpiT E EpiInit; \
        pg8::gemm_phase<EpiT, pg8::StaticOrder, false, (F0_FP8 != 0)>(ring, g, S, E, F.wave); } while (0)
#define W8(base, bytes) ((bf16_t*)((unsigned char*)(base) + (size_t)(bytes)))

    if (IN(PH_PRO)) { p0_prologue(F, args); REPB(PH_PRO, p0_prologue(F, args)); } SEAM(PH_PRO);
    if (IN(PH_NORM0)) { thin_phase<4>(F, args, args.in[I_X], 0, 0, 0, 0); REPB(PH_NORM0, thin_phase<4>(F, args, args.in[I_X], 0, 0, 0, 0)); } SEAM(PH_NORM0);

    if (IN(L0_G1)) { GEMM_STATIC(F.HB, WCI, 3072, DM, pg8::EpiConvIn, {F.BUF}); REPB(L0_G1, GEMM_STATIC(F.HB, WCI, 3072, DM, pg8::EpiConvIn, {F.BUF})); } SEAM(L0_G1);
    if (IN(L0_CONV)) { conv_phase(F, args.in[I_CW]); REPB(L0_CONV, conv_phase(F, args.in[I_CW])); } SEAM(L0_CONV);
    if (IN(L0_G2)) { if (fuse) GEMM_STATIC(F.HB, WCO, DM, DM, pg8::EpiResNorm, FUSED_EPI(0, MODP(0, 2), args.in[I_X], 0, 1, (fuse ? F.BUF : F.HB), 1.0f, F1L0_FP8)); else GEMM_STATIC(F.HB, WCO, DM, DM, pg8::EpiRes, ({F.out, MODP(0, 2), args.in[I_X], 1.0f})); } SEAM(L0_G2);
    if (!fuse) { if (IN(L0_NORM)) { thin_phase<4>(F, args, F.out, 0, 1, 0, 0); } SEAM(L0_NORM); }
    if (IN(L0_F1)) { pg8::Gemm g{(fuse ? F.BUF : F.HB), WFG, M, 2 * FF, DM, 0, nullptr, nullptr}; pg8::StaticOrder S; S.init(M, 2 * FF, F.G, cid); EPAIR0S E{F.ACT, FF};
        pg8::gemm_phase<EPAIR0S, pg8::StaticOrder, false, (F1L0_FP8 != 0)>(ring, g, S, E, F.wave); } SEAM(L0_F1);
    if (IN(L0_F2)) { if (fuse) GEMM_STATICF0(F.ACT, WFD, DM, FF, pg8::EpiResNorm, FUSED_EPI(1, MODP(0, 5), F.out, 1, 0, F.HB, F2L0_ASC, 0)); else GEMM_STATICF0(F.ACT, WFD, DM, FF, pg8::EpiRes, ({F.out, MODP(0, 5), F.out, F2L0_ASC})); } SEAM(L0_F2);
    if (!fuse) { if (IN(L0_NORMN)) { thin_phase<4>(F, args, F.out, 1, 0, 0, 0); } SEAM(L0_NORMN); }

    if (IN(L1_G1)) { GEMM_STATIC(F.HB, WAI, ATT_NP, DM, pg8::EpiAttnIn, ({(bf16_t*)(F.ws + WS_Q), (bf16_t*)(F.ws + WS_K), (bf16_t*)(F.ws + WS_V), (bf16_t*)(F.ws + WS_QI), (bf16_t*)(F.ws + WS_KI), (float*)(F.ws + WS_WI), args.in[I_QG], args.in[I_KG]})); REPB(L1_G1, GEMM_STATIC(F.HB, WAI, ATT_NP, DM, pg8::EpiAttnIn, ({(bf16_t*)(F.ws + WS_Q), (bf16_t*)(F.ws + WS_K), (bf16_t*)(F.ws + WS_V), (bf16_t*)(F.ws + WS_QI), (bf16_t*)(F.ws + WS_KI), (float*)(F.ws + WS_WI), args.in[I_QG], args.in[I_KG]}))); } SEAM(L1_G1);
    if (IN(L1_ATTN)) { attn_phase(F, args); REPB(L1_ATTN, attn_phase(F, args)); } SEAM(L1_ATTN);
    if (IN(L1_G2)) { if (fuseR) GEMM_STATIC((bf16_t*)(F.ws + WS_O), WAO, DM, DM, pg8::EpiResNormRouter, FUSED_RT(3, MODP(1, 2), 1, 0, 0, F.HB, M1L1_FP8)); else GEMM_STATIC((bf16_t*)(F.ws + WS_O), WAO, DM, DM, pg8::EpiRes, ({F.out, MODP(1, 2), F.out, 1.0f})); } SEAM(L1_G2);
    if (!fuseR) { if (IN(L1_NORMR)) { thin_phase<4 | 8>(F, args, F.out, 1, 1, 0, 0); } SEAM(L1_NORMR); }
    if (IN(L1_M1)) { pg8::Gemm g{F.HB, WMG, M, 2 * FF, DM, (size_t)2 * FF * DM * (M1L1_FP8 ? 1 : 2), (const int*)(F.ws + WS_ROWIDX), (const unsigned*)(F.ctl + CW_CNT)}; pg8::MoeOrder S; S.init((const unsigned*)(F.ctl + CW_CNT), 22, F.G, cid);
        EPAIR8L1 E{F.ACT, FF}; pg8::gemm_phase<EPAIR8L1, pg8::MoeOrder, true, (M1L1_FP8 != 0)>(ring, g, S, E, F.wave); REPB(L1_M1, pg8::gemm_phase<EPAIR8L1, pg8::MoeOrder, true, (M1L1_FP8 != 0)>(ring, g, S, E, F.wave)); } SEAM(L1_M1);
    if (IN(L1_M2)) { pg8::Gemm g{F.ACT, WMD, M, DM, FF, (size_t)DM * FF * M2_B, nullptr, nullptr}; pg8::MoeOrder S; S.init((const unsigned*)(F.ctl + CW_CNT), 4, F.G, cid);
        pg8::EpiMoeDn E{F.BUF, (const float*)(F.ws + WS_GATEP)}; pg8::gemm_phase<pg8::EpiMoeDn, pg8::MoeOrder, false, (M2_FP8 != 0)>(ring, g, S, E, F.wave); REPB(L1_M2, pg8::gemm_phase<pg8::EpiMoeDn, pg8::MoeOrder, false, (M2_FP8 != 0)>(ring, g, S, E, F.wave)); } SEAM(L1_M2);
    if (IN(L1_COMB)) { thin_phase<2 | 4>(F, args, F.out, 2, 0, 1, 0); REPB(L1_COMB, thin_phase<2 | 4>(F, args, F.out, 2, 0, -1, 0)); } SEAM(L1_COMB);

    if (IN(L2_SSM)) { ssm_phase(F, args); REPB(L2_SSM, ssm_phase(F, args)); } SEAM(L2_SSM);
    if (IN(L2_G2)) { GEMM_STATIC(F.ACT, WGL, 2048, DM, pg8::EpiGluRes, ({F.out, MODP(2, 2)})); REPB(L2_G2, GEMM_STATIC(F.ACT, WGL, 2048, DM, pg8::EpiGluRes, ({F.out, ZEROG}))); } SEAM(L2_G2);
    if (IN(L2_NORM)) { thin_phase<4>(F, args, F.out, 2, 1, 0, 0); REPB(L2_NORM, thin_phase<4>(F, args, F.out, 2, 1, 0, 0)); } SEAM(L2_NORM);
    if (IN(L2_F1)) { GEMM_STATIC(F.HB, WFG + (size_t)2 * FF * DM, 2 * FF, DM, EPAIRF, ({F.ACT, FF})); REPB(L2_F1, GEMM_STATIC(F.HB, WFG + (size_t)2 * FF * DM, 2 * FF, DM, EPAIRF, ({F.ACT, FF}))); } SEAM(L2_F1);
    if (IN(L2_F2)) { if (fuse) GEMM_STATICF(F.ACT, W8(WFD, (size_t)DM * FF * (F2_FP8 ? 1 : 2)), DM, FF, pg8::EpiResNorm, FUSED_EPI(2, MODP(2, 5), F.out, 3, 0, F.HB, F2_ASC, 0)); else GEMM_STATICF(F.ACT, W8(WFD, (size_t)DM * FF * (F2_FP8 ? 1 : 2)), DM, FF, pg8::EpiRes, ({F.out, MODP(2, 5), F.out, F2_ASC})); } SEAM(L2_F2);
    if (!fuse) { if (IN(L2_NORMN)) { thin_phase<4>(F, args, F.out, 3, 0, 0, 0); } SEAM(L2_NORMN); }

    if (IN(L3_G1)) { GEMM_STATIC(F.HB, WCI + (size_t)3072 * DM, 3072, DM, pg8::EpiConvIn, {F.BUF}); REPB(L3_G1, GEMM_STATIC(F.HB, WCI + (size_t)3072 * DM, 3072, DM, pg8::EpiConvIn, {F.BUF})); } SEAM(L3_G1);
    if (IN(L3_CONV)) { conv_phase(F, args.in[I_CW] + 3 * DM); REPB(L3_CONV, conv_phase(F, args.in[I_CW] + 3 * DM)); } SEAM(L3_CONV);
    if (IN(L3_G2)) { if (fuseR) GEMM_STATIC(F.HB, WCO + (size_t)DM * DM, DM, DM, pg8::EpiResNormRouter, FUSED_RT(4, MODP(3, 2), 3, 1, 2 * MiB, F.BUF, M1_FP8)); else GEMM_STATIC(F.HB, WCO + (size_t)DM * DM, DM, DM, pg8::EpiRes, ({F.out, MODP(3, 2), F.out, 1.0f})); } SEAM(L3_G2);
    if (!fuseR) { if (IN(L3_NORMR)) { thin_phase<4 | 8>(F, args, F.out, 3, 1, 0, 1, 1, 2 * MiB); } SEAM(L3_NORMR); }
    if (IN(L3_M1)) { pg8::Gemm g{(fuseR ? F.BUF : F.HB), W8(WMG, (size_t)8 * 2 * FF * DM * 2), M, 2 * FF, DM, (size_t)2 * FF * DM * M1_B, (const int*)(F.ws + 2 * MiB + WS_ROWIDX), (const unsigned*)(F.ctl + CW_CNT + 512)}; pg8::MoeOrder S; S.init((const unsigned*)(F.ctl + CW_CNT + 512), 22, F.G, cid);
        EPAIR8 E{F.ACT, FF}; pg8::gemm_phase<EPAIR8, pg8::MoeOrder, true, (M1_FP8 != 0)>(ring, g, S, E, F.wave); REPB(L3_M1, pg8::gemm_phase<EPAIR8, pg8::MoeOrder, true, (M1_FP8 != 0)>(ring, g, S, E, F.wave)); } SEAM(L3_M1);
    if (IN(L3_M2)) { pg8::Gemm g{F.ACT, W8(WMD, (size_t)8 * DM * FF * M2_B), M, DM, FF, (size_t)DM * FF * M2_B, nullptr, nullptr}; pg8::MoeOrder S; S.init((const unsigned*)(F.ctl + CW_CNT + 512), 4, F.G, cid);
        pg8::EpiMoeDn E{F.BUF, (const float*)(F.ws + 2 * MiB + WS_GATEP)}; pg8::gemm_phase<pg8::EpiMoeDn, pg8::MoeOrder, false, (M2_FP8 != 0)>(ring, g, S, E, F.wave); REPB(L3_M2, pg8::gemm_phase<pg8::EpiMoeDn, pg8::MoeOrder, false, (M2_FP8 != 0)>(ring, g, S, E, F.wave)); } SEAM(L3_M2);
    if (IN(L3_COMB)) { thin_phase<2>(F, args, F.out, 0, 0, 3, 1, 1, 2 * MiB); }
#undef IN
#undef SEAM
}

extern "C" void kernel_launch(void* const* d_in, const int* in_sizes, int n_in, void* d_out, int out_size, void* d_ws, size_t ws_size, hipStream_t stream) {
    static int grid = 0;
    if (grid == 0) {
        if (n_in != 28 || in_sizes[0] != M * DM || out_size != M * DM || ws_size < WS_END) { fprintf(stderr, "kernel_launch: unexpected shapes / workspace (n_in %d, ws %zu, need %zu)\n", n_in, ws_size, (size_t)WS_END); grid = -1; return; }
        int dev = 0, cus = 0, per_cu = 0;
        if (hipGetDevice(&dev) != hipSuccess || hipDeviceGetAttribute(&cus, hipDeviceAttributeMultiprocessorCount, dev) != hipSuccess) { grid = -1; return; }
        if (hipFuncSetAttribute((const void*)mega_fwd, hipFuncAttributeMaxDynamicSharedMemorySize, LDS_BYTES) != hipSuccess) { fprintf(stderr, "kernel_launch: hipFuncSetAttribute failed\n"); grid = -1; return; }
        if (hipOccupancyMaxActiveBlocksPerMultiprocessor(&per_cu, (const void*)mega_fwd, NTHREADS, LDS_BYTES) != hipSuccess || per_cu < 1) fprintf(stderr, "kernel_launch: occupancy query reports %d\n", per_cu);
        (void)hipGetLastError();
        grid = cus;
    }
    if (grid < 0) return;
    (void)hipMemsetAsync((char*)d_ws + WS_CTL, 0, CTL_ZERO_BYTES, stream);
    Args a{};
    for (int i = 0; i < 28; ++i) a.in[i] = (const float*)d_in[i];
    a.out = (float*)d_out; a.ws = (unsigned char*)d_ws;
#if MK_PER_PHASE
    for (int p = 0; p < NPH; ++p) { a.ph_lo = p; a.ph_hi = p + 1; hipLaunchKernelGGL(mega_fwd, dim3(grid), dim3(NTHREADS), LDS_BYTES, stream, a); }
#else
    a.ph_lo = 0; a.ph_hi = NPH; hipLaunchKernelGGL(mega_fwd, dim3(grid), dim3(NTHREADS), LDS_BYTES, stream, a);
#endif
}
```

```cpp
#include <hip/hip_runtime.h>
#include <cstdio>
#include <cstdint>
#include <cmath>

#ifndef MK_PER_PHASE
#define MK_PER_PHASE 0
#endif

#define GAS __attribute__((address_space(1)))
#define LAS __attribute__((address_space(3)))
typedef unsigned short bf16_t;
typedef short bf16x8 __attribute__((ext_vector_type(8)));
typedef float f32x4 __attribute__((ext_vector_type(4)));
typedef float f32x2 __attribute__((ext_vector_type(2)));
typedef float f32x16 __attribute__((ext_vector_type(16)));
typedef unsigned u32x4 __attribute__((ext_vector_type(4)));
typedef unsigned u32x2 __attribute__((ext_vector_type(2)));
typedef GAS unsigned gu32;
#define RLX_AGENT __ATOMIC_RELAXED, __HIP_MEMORY_SCOPE_AGENT
#define LDS_WAIT() asm volatile("s_waitcnt lgkmcnt(0)" ::: "memory")
#define VM_WAIT() asm volatile("s_waitcnt vmcnt(0)" ::: "memory")
#define CFENCE() asm volatile("" ::: "memory")

constexpr int DM = 1024, NB = 4, SEQ = 4096, M = NB * SEQ, FF = 2816, NEXP = 8;
constexpr int NH = 16, NKV = 4, HD = 64, IH = 8, IDIM = 64, TOPK = 256;
constexpr int ATT_N = 2120, ATT_NP = 2304;
constexpr float EPS = 1e-6f;
constexpr int NWAVES = 8, NTHREADS = 512;

__device__ __forceinline__ unsigned f2bf(float f) { unsigned u = __builtin_bit_cast(unsigned, f); return (u + 0x7fffu + ((u >> 16) & 1u)) >> 16; }
__device__ __forceinline__ unsigned pk2(float lo, float hi) { return f2bf(lo) | (f2bf(hi) << 16); }
__device__ __forceinline__ unsigned cvt_pk_bf16(float lo, float hi) { unsigned r; asm volatile("v_cvt_pk_bf16_f32 %0, %1, %2" : "=v"(r) : "v"(lo), "v"(hi)); return r; }
__device__ __forceinline__ float bflo(unsigned u) { return __uint_as_float(u << 16); }
__device__ __forceinline__ float bfhi(unsigned u) { return __uint_as_float(u & 0xffff0000u); }
__device__ __forceinline__ float wave_sum(float v) {
#pragma unroll
    for (int o = 1; o < 64; o <<= 1) v += __shfl_xor(v, o);
    return v;
}
__device__ __forceinline__ float fast_rcp(float x) { return __builtin_amdgcn_rcpf(x); }
__device__ __forceinline__ float silu_f(float g) { return g * fast_rcp(1.f + __expf(-g)); }
__device__ __forceinline__ float sigmoid_f(float g) { return fast_rcp(1.f + __expf(-g)); }
__device__ __forceinline__ float gelu_tanh_f(float y) { const float z = 0.7978845608028654f * (y + 0.044715f * y * y * y); const float t = 1.f - 2.f * fast_rcp(__expf(2.f * z) + 1.f); return 0.5f * y * (1.f + t); }

constexpr size_t WS_ROWIDX_B = 2u << 20, WS_GATEP_B = (2u << 20) + 512 * 1024, WS_SLOT_B = 3u << 20;
__device__ __forceinline__ int lane_id_fresh() { int l; asm volatile("v_mbcnt_lo_u32_b32 %0, -1, 0\n\tv_mbcnt_hi_u32_b32 %0, -1, %0" : "=v"(l)); return l; }
#ifndef FUSE_R
#define FUSE_R 1
#endif
#ifndef FUSE_N
#define FUSE_N 1
#endif
#ifndef M2_FP8
#define M2_FP8 1
#endif
#ifndef F1L0_FP8
#define F1L0_FP8 1
#endif
#ifndef M1L1_FP8
#define M1L1_FP8 1
#endif
#ifndef M1_FP8
#define M1_FP8 1
#endif
#ifndef F2L0_FP8
#define F2L0_FP8 1
#endif
#ifndef F2_FP8
#define F2_FP8 1
#endif
namespace pg8 {
constexpr int BM = 256, BK = 64, HALF = 128, HTB = HALF * BK * 2, STAGE_BYTES = 8 * HTB, NXCD = 8, WGM = 8;
__host__ __device__ __forceinline__ int lds_byte(int r, int c) { const int st = (r >> 4) * 2 + (c >> 5), rr = r & 15, cc = c & 31, ob = rr * 64 + cc * 2; return st * 1024 + (ob ^ (((ob >> 9) & 1) << 5)); }
__host__ __device__ __forceinline__ void stage_rc(int b, int& R, int& C) { const int st = b / 1024, sb = b % 1024, swz = sb ^ (((sb >> 9) & 1) << 5); R = (st >> 1) * 16 + swz / 64; C = (st & 1) * 32 + (swz % 64) / 2; }
__host__ __device__ __forceinline__ int perm32(int rho) { const int n = rho >> 4, i = rho & 15; return 8 * (i >> 2) + 4 * n + (i & 3); }

struct Unit { int pm, pn, e, aux; };
struct Gemm { const bf16_t* A; const bf16_t* Bt; int M, N, K; size_t bstride_e; const int* rowidx; const unsigned* cnt; };

struct StaticOrder {
    int nM, nN, nwg, G, c;
    __device__ __forceinline__ void init(int M_, int N_, int G_, int c_) { nM = M_ / BM; nN = N_ / BM; nwg = nM * nN; G = G_; c = c_; }
    __device__ __forceinline__ bool next(int i, Unit& u) const {
        const long L = (long)i * G + c; if (L >= nwg) return false;
        int wgid = (int)L; { const int q = nwg / NXCD, r = nwg % NXCD, xcd = wgid % NXCD, off = wgid / NXCD; wgid = (xcd < r ? xcd * (q + 1) : r * (q + 1) + (xcd - r) * q) + off; }
        const int nig = WGM * nN, gid = wgid / nig, fm = gid * WGM, gsz = (nM - fm) < WGM ? (nM - fm) : WGM;
        u.pm = fm + ((wgid % nig) % gsz); u.pn = (wgid % nig) / gsz; u.e = 0; u.aux = 0; return true;
    }
};
struct MoeOrder {
    int T1, T2, T3, T4, T5, T6, T7, T8, NT, W, r, lo, ntl;
    static constexpr int RG = 4;
    __device__ __forceinline__ void init(const unsigned* cnt, int NT_, int G_, int c_) {
        int t[9]; int acc = 0;
#pragma unroll
        for (int e = 0; e < 8; ++e) { t[e] = acc; acc += (int)((__hip_atomic_load(cnt + 64 * e, RLX_AGENT) + 255u) >> 8); }
        t[8] = acc; T1 = t[1]; T2 = t[2]; T3 = t[3]; T4 = t[4]; T5 = t[5]; T6 = t[6]; T7 = t[7]; T8 = t[8]; NT = NT_;
        if (G_ % 8 == 0) { const int xv = c_ % 8; W = G_ / 8; r = c_ / 8; lo = (T8 * xv) / 8; ntl = (T8 * (xv + 1)) / 8 - lo; }
        else { W = G_; r = c_; lo = 0; ntl = T8; }
    }
    __device__ __forceinline__ bool next(int i, Unit& u) const {
        const int q = i * W + r; if (q >= ntl * NT) return false;
        const int nig = RG * NT, gid = q / nig, fm = gid * RG, gsz = (ntl - fm) < RG ? (ntl - fm) : RG, w = q - gid * nig;
        const int tt = lo + fm + (w % gsz), pn = w / gsz;
        int e = 0, te = 0;
        if (tt >= T1) { e = 1; te = T1; } if (tt >= T2) { e = 2; te = T2; } if (tt >= T3) { e = 3; te = T3; } if (tt >= T4) { e = 4; te = T4; }
        if (tt >= T5) { e = 5; te = T5; } if (tt >= T6) { e = 6; te = T6; } if (tt >= T7) { e = 7; te = T7; }
        u.pm = tt; u.pn = pn; u.e = e; u.aux = e * 16384 + 256 * (tt - te); return true;
    }
};

typedef int v8i32 __attribute__((ext_vector_type(8)));
typedef int v4i32 __attribute__((ext_vector_type(4)));
constexpr float W8_MUL = 32.0f, W8_INV = 1.0f / 32.0f;
__device__ __forceinline__ void mfma8(f32x4& c, const v8i32 a, const v8i32 b) { asm volatile("v_mfma_f32_16x16x128_f8f6f4 %0, %1, %2, %0" : "+v"(c) : "v"(a), "v"(b)); }
__device__ __forceinline__ v8i32 cat8(const bf16x8 a, const bf16x8 b) { return __builtin_shufflevector(__builtin_bit_cast(v4i32, a), __builtin_bit_cast(v4i32, b), 0, 1, 2, 3, 4, 5, 6, 7); }
template <class Epi, class Sched, bool GATHER, bool FP8 = false>
__device__ __forceinline__ void gemm_phase(LAS unsigned char* lds, const Gemm g, const Sched& S, const Epi& E, const int wid) {
    const int lane = lane_id_fresh(), tid = wid * 64 + lane, wr = wid >> 2, wc = wid & 3, fr = lane & 15, fq = lane >> 4;
    const int K = FP8 ? g.K / 2 : g.K, nt = K / BK;
    unsigned voffB[2]; int stR[2], stC[2];
#pragma unroll
    for (int i = 0; i < 2; ++i) { int R, C; stage_rc(tid * 16 + i * 8192, R, C); const int Rb = (R & ~31) + perm32(R & 31);
        stR[i] = R; stC[i] = C; voffB[i] = (unsigned)(Rb * K + C) * 2u; }
    const size_t kstep = (size_t)(BK * 2);
    const size_t hstep = (size_t)HALF * K * 2;
    const size_t tstep = 2 * hstep;
    const unsigned ldsw = (unsigned)wid * 1024u;
    const int aoff = lds_byte(wr * 64 + fr, fq * 8), boff = lds_byte(wc * 32 + fr, fq * 8);
#define PG8_SA(b, h) (((b) * 2 + (h)) * HTB)
#define PG8_SB(b, h) ((4 + (b) * 2 + (h)) * HTB)
#define PG8_STAGE(bufoff, gbase, voff) do { _Pragma("unroll") for (int _i = 0; _i < 2; ++_i) \
        __builtin_amdgcn_global_load_lds((const unsigned*)((const char*)(gbase) + (voff)[_i]), (LAS unsigned*)(lds + (bufoff) + ldsw + _i * 8192), 16, 0, 0); } while (0)
#define PG8_LDA(dst, b, h) do { _Pragma("unroll") for (int m = 0; m < 4; ++m) _Pragma("unroll") for (int k = 0; k < 2; ++k) dst[m][k] = *(const LAS bf16x8*)(lds + PG8_SA(b, h) + aoff + m * 2048 + k * 1024); } while (0)
#define PG8_LDB(dst, b, h) do { _Pragma("unroll") for (int n = 0; n < 2; ++n) _Pragma("unroll") for (int k = 0; k < 2; ++k) dst[n][k] = *(const LAS bf16x8*)(lds + PG8_SB(b, h) + boff + n * 2048 + k * 1024); } while (0)
#define PG8_MMA(ai, bj, At, Bt) do { __builtin_amdgcn_s_setprio(1); _Pragma("unroll") for (int m = 0; m < 4; ++m) _Pragma("unroll") for (int n = 0; n < 2; ++n) { \
        if (FP8) mfma8(acc[ai][bj][m][n], cat8(Bt[n][0], Bt[n][1]), cat8(At[m][0], At[m][1])); \
        else { _Pragma("unroll") for (int k = 0; k < 2; ++k) acc[ai][bj][m][n] = __builtin_amdgcn_mfma_f32_16x16x32_bf16(Bt[n][k], At[m][k], acc[ai][bj][m][n], 0, 0, 0); } } \
        __builtin_amdgcn_s_setprio(0); } while (0)
#define PG8_MMA_END(At, B0, B1) do { if (FP8) { asm volatile("s_nop 15\n\ts_nop 15\n\ts_nop 15\n\ts_nop 15" :: "v"(cat8(At[0][0], At[0][1])), "v"(cat8(At[1][0], At[1][1])), "v"(cat8(At[2][0], At[2][1])), "v"(cat8(At[3][0], At[3][1])), \
        "v"(cat8(B0[0][0], B0[0][1])), "v"(cat8(B0[1][0], B0[1][1])), "v"(cat8(B1[0][0], B1[0][1])), "v"(cat8(B1[1][0], B1[1][1]))); } } while (0)
#define PG8_WAIT_V(n) asm volatile("s_waitcnt vmcnt(" #n ")" ::: "memory")
#define PG8_WAIT_L(n) asm volatile("s_waitcnt lgkmcnt(" #n ")" ::: "memory")
#define PG8_BAR __builtin_amdgcn_s_barrier()
#define PG8_SCHED __builtin_amdgcn_sched_barrier(0)
#define PG8_AOFFS(v, U) do { _Pragma("unroll") for (int _h = 0; _h < 2; ++_h) _Pragma("unroll") for (int _i = 0; _i < 2; ++_i) { \
        if (GATHER) { const int _loc = ((U).aux & 16383) + _h * HALF + stR[_i]; const int _e = (U).aux >> 14; \
            const int _row = (_loc < (int)g.cnt[64 * _e]) ? g.rowidx[(U).aux + _h * HALF + stR[_i]] : 0; \
            v[_h][_i] = (unsigned)(_row * K + stC[_i]) * 2u; } \
        else v[_h][_i] = (unsigned)((_h * HALF + stR[_i]) * K + stC[_i]) * 2u; } } while (0)
    int cn8[8];
#pragma unroll
    for (int e = 0; e < 8; ++e) cn8[e] = GATHER ? __builtin_amdgcn_readfirstlane((int)g.cnt[64 * e]) : 0;
    Unit cur, nxt; int ui = 0;
    if (!S.next(0, cur)) return;
    f32x4 acc[2][2][4][2];
#pragma unroll
    for (int a = 0; a < 2; ++a)
#pragma unroll
        for (int b = 0; b < 2; ++b)
#pragma unroll
            for (int m = 0; m < 4; ++m)
#pragma unroll
                for (int n = 0; n < 2; ++n) acc[a][b][m][n] = (f32x4){0.f, 0.f, 0.f, 0.f};
    bf16x8 At[4][2], B0[2][2], B1[2][2];
    unsigned vAc[2][2], vAn[2][2];
    PG8_AOFFS(vAc, cur);
    const char* cA = (const char*)g.A + (GATHER ? (size_t)0 : (size_t)cur.pm * tstep);
    const char* cB = (const char*)g.Bt + (size_t)cur.e * g.bstride_e + (size_t)cur.pn * tstep;
    PG8_STAGE(PG8_SB(0, 0), cB, voffB); PG8_STAGE(PG8_SB(0, 1), cB + hstep, voffB); PG8_STAGE(PG8_SA(0, 0), cA, vAc[0]); PG8_STAGE(PG8_SA(0, 1), cA, vAc[1]);
    if (wr == 1) PG8_BAR;
    PG8_WAIT_V(2); PG8_BAR;
    PG8_STAGE(PG8_SB(1, 0), cB + kstep, voffB); PG8_STAGE(PG8_SA(1, 0), cA + kstep, vAc[0]); PG8_STAGE(PG8_SB(1, 1), cB + hstep + kstep, voffB);
    PG8_WAIT_V(6); PG8_BAR;
    for (;;) {
        const bool has_next = S.next(ui + 1, nxt);
        const char* nA = cA; const char* nB = cB;
        int rn[2][2];
        if (has_next) { if (GATHER) {
#pragma unroll
                for (int h = 0; h < 2; ++h)
#pragma unroll
                    for (int i = 0; i < 2; ++i) rn[h][i] = g.rowidx[nxt.aux + h * HALF + stR[i]]; }
            else PG8_AOFFS(vAn, nxt);
            nA = (const char*)g.A + (GATHER ? (size_t)0 : (size_t)nxt.pm * tstep); nB = (const char*)g.Bt + (size_t)nxt.e * g.bstride_e + (size_t)nxt.pn * tstep; }
        else {
#pragma unroll
            for (int h = 0; h < 2; ++h)
#pragma unroll
                for (int i = 0; i < 2; ++i) vAn[h][i] = vAc[h][i];
        }
#pragma nounroll
        for (int t = 0; t < nt; t += 2) {
            const bool last = (t == nt - 2);
            const char* a1 = cA + (size_t)(t + 1) * kstep;
            const char* a2 = last ? nA : cA + (size_t)(t + 2) * kstep; const char* b2 = last ? nB : cB + (size_t)(t + 2) * kstep;
            const char* a3 = a2 + kstep; const char* b3 = b2 + kstep;
            if (GATHER && last && has_next) { const int _e = nxt.aux >> 14;
                const int _cn = _e == 0 ? cn8[0] : _e == 1 ? cn8[1] : _e == 2 ? cn8[2] : _e == 3 ? cn8[3] : _e == 4 ? cn8[4] : _e == 5 ? cn8[5] : _e == 6 ? cn8[6] : cn8[7];
#pragma unroll
                for (int h = 0; h < 2; ++h)
#pragma unroll
                    for (int i = 0; i < 2; ++i) { int r_ = rn[h][i]; asm volatile("" : "+v"(r_)); const int _loc = (nxt.aux & 16383) + h * HALF + stR[i];
                        r_ = _loc < _cn ? r_ : 0; vAn[h][i] = (unsigned)(r_ * K + stC[i]) * 2u; } }
            unsigned v2[2][2];
#pragma unroll
            for (int h = 0; h < 2; ++h)
#pragma unroll
                for (int i = 0; i < 2; ++i) v2[h][i] = last ? vAn[h][i] : vAc[h][i];
            PG8_LDB(B0, 0, 0); PG8_LDB(B1, 0, 1); PG8_SCHED; PG8_LDA(At, 0, 0); PG8_STAGE(PG8_SA(1, 1), a1, vAc[1]);
            PG8_WAIT_V(8); PG8_WAIT_L(0); PG8_BAR; PG8_MMA(0, 0, At, B0); PG8_MMA(0, 1, At, B1); PG8_MMA_END(At, B0, B1); PG8_BAR; PG8_SCHED;
            PG8_LDA(At, 0, 1); PG8_STAGE(PG8_SB(0, 0), b2, voffB); PG8_STAGE(PG8_SB(0, 1), b2 + hstep, voffB); PG8_STAGE(PG8_SA(0, 0), a2, v2[0]);
            PG8_WAIT_V(8); PG8_WAIT_L(0); PG8_BAR; PG8_MMA(1, 0, At, B0); PG8_MMA(1, 1, At, B1); PG8_MMA_END(At, B0, B1); PG8_BAR; PG8_SCHED;
            PG8_LDB(B0, 1, 0); PG8_LDB(B1, 1, 1); PG8_SCHED; PG8_LDA(At, 1, 0); PG8_STAGE(PG8_SA(0, 1), a2, v2[1]);
            PG8_WAIT_V(8); PG8_WAIT_L(0); PG8_BAR; PG8_MMA(0, 0, At, B0); PG8_MMA(0, 1, At, B1); PG8_MMA_END(At, B0, B1); PG8_BAR; PG8_SCHED;
            PG8_LDA(At, 1, 1); PG8_STAGE(PG8_SB(1, 0), b3, voffB); PG8_STAGE(PG8_SB(1, 1), b3 + hstep, voffB); PG8_STAGE(PG8_SA(1, 0), a3, v2[0]);
            PG8_WAIT_V(8); PG8_WAIT_L(0); PG8_BAR; PG8_MMA(1, 0, At, B0); PG8_MMA(1, 1, At, B1); PG8_MMA_END(At, B0, B1); PG8_BAR; PG8_SCHED;
        }
        if (wr == 0) PG8_BAR;
        if (FP8) asm volatile("s_nop 15\n\ts_nop 15\n\ts_nop 15\n\ts_nop 15\n\ts_nop 15\n\ts_nop 15" ::: "memory");
        if constexpr (!Epi::FUSED) E(acc, cur, wr, wc, fr, fq);
        if (!has_next) break;
#pragma unroll
        for (int a = 0; a < 2; ++a)
#pragma unroll
            for (int b = 0; b < 2; ++b)
#pragma unroll
                for (int m = 0; m < 4; ++m)
#pragma unroll
                    for (int n = 0; n < 2; ++n) acc[a][b][m][n] = (f32x4){0.f, 0.f, 0.f, 0.f};
        cur = nxt; cA = nA; cB = nB; ++ui;
#pragma unroll
        for (int h = 0; h < 2; ++h)
#pragma unroll
            for (int i = 0; i < 2; ++i) vAc[h][i] = vAn[h][i];
        if (wr == 1) PG8_BAR;
    }
    PG8_WAIT_V(0);
    PG8_BAR;
    if constexpr (Epi::FUSED) E.fused(acc, cur, wr, wc, fr, fq, lds, wid, lane);
#undef PG8_SA
#undef PG8_SB
#undef PG8_STAGE
#undef PG8_LDA
#undef PG8_LDB
#undef PG8_MMA
#undef PG8_MMA_END
#undef PG8_WAIT_V
#undef PG8_WAIT_L
#undef PG8_BAR
#undef PG8_SCHED
#undef PG8_AOFFS
}

__device__ __forceinline__ f32x4 ldx16(const float* p) { return *(const f32x4*)p; }
typedef f32x4 Acc[2][2][4][2];
__device__ __forceinline__ u32x4 pack8(const f32x4 a, const f32x4 b) { u32x4 w; w.x = cvt_pk_bf16(a[0], a[1]); w.y = cvt_pk_bf16(a[2], a[3]); w.z = cvt_pk_bf16(b[0], b[1]); w.w = cvt_pk_bf16(b[2], b[3]); return w; }

template <int MODE, bool OUT8 = false, bool SC8 = OUT8> struct EpiPair {
    static constexpr bool FUSED = false;
    bf16_t* O; int ldo;
    __device__ __forceinline__ void operator()(const Acc& acc, const Unit& u, int wr, int wc, int fr, int fq) const {
        const int row0 = u.pm * BM + wr * 64 + fr, col0 = u.pn * HALF + wc * 32 + 8 * fq;
#pragma unroll
        for (int ai = 0; ai < 2; ++ai)
#pragma unroll
            for (int m = 0; m < 4; ++m) { f32x4 r0, r1;
#pragma unroll
                for (int e = 0; e < 4; ++e) { const float sc8 = SC8 ? W8_INV : 1.0f; const float a0 = acc[ai][0][m][0][e] * sc8, a1 = acc[ai][0][m][1][e] * sc8, b0 = acc[ai][1][m][0][e] * sc8, b1 = acc[ai][1][m][1][e] * sc8;
                    r0[e] = (MODE == 1 ? silu_f(a0) : a0) * b0; r1[e] = (MODE == 1 ? silu_f(a1) : a1) * b1; }
                if (OUT8) { u32x2 w; int t0 = 0, t1 = 0; t0 = __builtin_amdgcn_cvt_pk_fp8_f32(r0[0], r0[1], t0, false); t0 = __builtin_amdgcn_cvt_pk_fp8_f32(r0[2], r0[3], t0, true);
                    t1 = __builtin_amdgcn_cvt_pk_fp8_f32(r1[0], r1[1], t1, false); t1 = __builtin_amdgcn_cvt_pk_fp8_f32(r1[2], r1[3], t1, true); w.x = (unsigned)t0; w.y = (unsigned)t1;
                    *(u32x2*)((unsigned char*)O + (size_t)(row0 + ai * HALF + m * 16) * ldo + col0) = w; }
                else *(u32x4*)(O + (size_t)(row0 + ai * HALF + m * 16) * ldo + col0) = pack8(r0, r1); }
    }
};
struct EpiConvIn {
    static constexpr bool FUSED = false;
    bf16_t* UB;
    __device__ __forceinline__ void operator()(const Acc& acc, const Unit& u, int wr, int wc, int fr, int fq) const {
        const int row0 = u.pm * BM + wr * 64 + fr;
        if (u.pn < 8) { EpiPair<0, false, false> P{UB, 2048}; P(acc, u, wr, wc, fr, fq); }
        else { const int col0 = 1024 + (u.pn - 8) * BM + wc * 32 + 8 * fq;
#pragma unroll
            for (int ai = 0; ai < 2; ++ai)
#pragma unroll
                for (int m = 0; m < 4; ++m)
#pragma unroll
                    for (int bj = 0; bj < 2; ++bj) *(u32x4*)(UB + (size_t)(row0 + ai * HALF + m * 16) * 2048 + col0 + bj * HALF) = pack8(acc[ai][bj][m][0], acc[ai][bj][m][1]); }
    }
};
struct EpiRes {
    static constexpr bool FUSED = false;
    float* X; const float* gate; const float* Xin; float asc;
    __device__ __forceinline__ void operator()(const Acc& acc, const Unit& u, int wr, int wc, int fr, int fq) const {
        const int row0 = u.pm * BM + wr * 64 + fr, col0 = u.pn * BM + wc * 32 + 8 * fq; const int b = (u.pm * BM) / SEQ;
        f32x4 gv[2][2];
#pragma unroll
        for (int bj = 0; bj < 2; ++bj)
#pragma unroll
            for (int n = 0; n < 2; ++n) gv[bj][n] = *(const f32x4*)(gate + (size_t)b * 6144 + col0 + bj * HALF + 4 * n) * asc;
#pragma unroll
        for (int ai = 0; ai < 2; ++ai) {
            f32x4 xv[4][2][2];
#pragma unroll
            for (int m = 0; m < 4; ++m) { const float* ri = Xin + (size_t)(row0 + ai * HALF + m * 16) * DM + col0;
#pragma unroll
                for (int bj = 0; bj < 2; ++bj)
#pragma unroll
                    for (int n = 0; n < 2; ++n) xv[m][bj][n] = ldx16(ri + bj * HALF + 4 * n); }
            asm volatile("" ::: "memory");
#pragma unroll
            for (int m = 0; m < 4; ++m) { float* rp = X + (size_t)(row0 + ai * HALF + m * 16) * DM + col0;
#pragma unroll
                for (int bj = 0; bj < 2; ++bj)
#pragma unroll
                    for (int n = 0; n < 2; ++n) *(f32x4*)(rp + bj * HALF + 4 * n) = xv[m][bj][n] + gv[bj][n] * acc[ai][bj][m][n]; }
            asm volatile("" ::: "memory");
        }
    }
};
struct EpiResNorm {
    static constexpr bool FUSED = true;
    float* X; const float* gate; const float* Xin; const float* ng; const float* shb; bf16_t* H; float* xs; gu32* cnt; gu32* tmo; float asc; int h8;
    __device__ __forceinline__ void fused(Acc& acc, const Unit& u, int wr, int wc, int fr, int fq, LAS unsigned char* lds, int wid, int lane) const {
        const int row0 = u.pm * BM + wr * 64 + fr, col0 = u.pn * BM + wc * 32 + 8 * fq; const int b = (u.pm * BM) / SEQ;
        LAS float* P = (LAS float*)lds; LAS float* S = (LAS float*)(lds + 4096);
        { f32x4 gv[2][2];
#pragma unroll
          for (int bj = 0; bj < 2; ++bj)
#pragma unroll
              for (int n = 0; n < 2; ++n) gv[bj][n] = *(const f32x4*)(gate + (size_t)b * 6144 + col0 + bj * HALF + 4 * n) * asc;
#pragma unroll
          for (int ai = 0; ai < 2; ++ai) {
              f32x4 xv[4][2][2];
#pragma unroll
              for (int m = 0; m < 4; ++m) { const float* ri = Xin + (size_t)(row0 + ai * HALF + m * 16) * DM + col0;
#pragma unroll
                  for (int bj = 0; bj < 2; ++bj)
#pragma unroll
                      for (int n = 0; n < 2; ++n) xv[m][bj][n] = ldx16(ri + bj * HALF + 4 * n); }
              asm volatile("" ::: "memory");
#pragma unroll
              for (int m = 0; m < 4; ++m) { float* rp = X + (size_t)(row0 + ai * HALF + m * 16) * DM + col0; float ss = 0.f;
#pragma unroll
                  for (int bj = 0; bj < 2; ++bj)
#pragma unroll
                      for (int n = 0; n < 2; ++n) { const f32x4 x = xv[m][bj][n] + gv[bj][n] * acc[ai][bj][m][n]; acc[ai][bj][m][n] = x; *(f32x4*)(rp + bj * HALF + 4 * n) = x;
                          ss += (x[0] * x[0] + x[1] * x[1]) + (x[2] * x[2] + x[3] * x[3]); }
                  ss += __shfl_xor(ss, 16); ss += __shfl_xor(ss, 32);
                  if (fq == 0) P[(ai * HALF + wr * 64 + m * 16 + fr) * 4 + wc] = ss; }
              asm volatile("" ::: "memory");
          } }
        asm volatile("s_waitcnt lgkmcnt(0)" ::: "memory"); __builtin_amdgcn_s_barrier(); asm volatile("" ::: "memory");
        const int tid = wid * 64 + lane;
        if (tid < 256) { const f32x4 p4 = *(const LAS f32x4*)(P + tid * 4); const float sp = (p4[0] + p4[1]) + (p4[2] + p4[3]);
            __hip_atomic_store((gu32*)xs + ((size_t)(u.pm * BM + tid) * 4 + u.pn), __float_as_uint(sp), RLX_AGENT); }
        asm volatile("s_waitcnt vmcnt(0)" ::: "memory");
        if (wid < 4 && lane == 0) __hip_atomic_fetch_add(cnt + 64 * u.pm, 1u, RLX_AGENT);
        if (wid == 0) { unsigned spins = 0;
            while ((unsigned)__builtin_amdgcn_readfirstlane(__hip_atomic_load(cnt + 64 * u.pm, RLX_AGENT)) < 16u) { __builtin_amdgcn_s_sleep(2);
                if (++spins > (1u << 20)) { if (lane == 0) __hip_atomic_store(tmo, 1u, RLX_AGENT); break; } } }
        asm volatile("s_waitcnt vmcnt(0) lgkmcnt(0)" ::: "memory"); __builtin_amdgcn_s_barrier(); asm volatile("" ::: "memory");
        if (tid < 256) { const GAS unsigned long long* q = (const GAS unsigned long long*)xs + (size_t)(u.pm * BM + tid) * 2;
            const unsigned long long a = __hip_atomic_load(q, RLX_AGENT), c = __hip_atomic_load(q + 1, RLX_AGENT);
            const float tot = (__uint_as_float((unsigned)a) + __uint_as_float((unsigned)(a >> 32))) + (__uint_as_float((unsigned)c) + __uint_as_float((unsigned)(c >> 32)));
            S[tid] = 1.0f / sqrtf(tot * (1.0f / DM) + EPS); }
        asm volatile("s_waitcnt vmcnt(0) lgkmcnt(0)" ::: "memory"); __builtin_amdgcn_s_barrier(); asm volatile("" ::: "memory");
        f32x4 gm[2][2], sf[2][2];
#pragma unroll
        for (int bj = 0; bj < 2; ++bj)
#pragma unroll
            for (int n = 0; n < 2; ++n) { const int c = col0 + bj * HALF + 4 * n; const f32x4 g4 = *(const f32x4*)(ng + c), s1 = *(const f32x4*)(shb + (size_t)b * 6144 + DM + c);
                gm[bj][n] = g4 * (s1 + 1.0f); sf[bj][n] = *(const f32x4*)(shb + (size_t)b * 6144 + c); }
#pragma unroll
        for (int ai = 0; ai < 2; ++ai)
#pragma unroll
            for (int m = 0; m < 4; ++m) { const float r = S[ai * HALF + wr * 64 + m * 16 + fr]; bf16_t* hp = H + (size_t)(row0 + ai * HALF + m * 16) * DM + col0;
#pragma unroll
                for (int bj = 0; bj < 2; ++bj) { const f32x4 h0 = (acc[ai][bj][m][0] * r) * gm[bj][0] + sf[bj][0], h1 = (acc[ai][bj][m][1] * r) * gm[bj][1] + sf[bj][1];
                    if (F1L0_FP8 && h8) { int t0 = 0, t1 = 0; t0 = __builtin_amdgcn_cvt_pk_fp8_f32(h0[0], h0[1], t0, false); t0 = __builtin_amdgcn_cvt_pk_fp8_f32(h0[2], h0[3], t0, true);
                        t1 = __builtin_amdgcn_cvt_pk_fp8_f32(h1[0], h1[1], t1, false); t1 = __builtin_amdgcn_cvt_pk_fp8_f32(h1[2], h1[3], t1, true); u32x2 w; w.x = (unsigned)t0; w.y = (unsigned)t1;
                        *(u32x2*)((unsigned char*)H + (size_t)(row0 + ai * HALF + m * 16) * DM + col0 + bj * HALF) = w; }
                    else *(u32x4*)(hp + bj * HALF) = pack8(h0, h1); } }
    }
};
struct EpiResNormRouter {
    static constexpr bool FUSED = true;
    float* X; const float* gate; const float* ng; const float* shb; bf16_t* H; float* xs9; gu32* cnt; gu32* tmo;
    const float* rw; const float* rb; gu32* ecnt; unsigned char* meta; int h8;
    __device__ __forceinline__ void fused(Acc& acc, const Unit& u, int wr, int wc, int fr, int fq, LAS unsigned char* lds, int wid, int lane) const {
        const int row0 = u.pm * BM + wr * 64 + fr, col0 = u.pn * BM + wc * 32 + 8 * fq; const int b = (u.pm * BM) / SEQ; const int tid = wid * 64 + lane;
        LAS float* P9 = (LAS float*)lds; LAS float* RWT = (LAS float*)(lds + 36864); LAS float* S = (LAS float*)(lds + 45056); LAS float* CE = (LAS float*)(lds + 46080);
        LAS int* rE = (LAS int*)(lds + 46144); LAS float* red = (LAS float*)(lds + 47360);
        const float* shp = shb + (size_t)b * 6144;
        for (int i = tid; i < 2048; i += NTHREADS) { const int c = i >> 3, e = i & 7; RWT[e * 256 + c] = rw[(size_t)(u.pn * BM + c) * 8 + e]; }
        { float ce[8]; const float s0 = shp[tid], s1 = shp[tid + 512];
#pragma unroll
          for (int e = 0; e < 8; ++e) ce[e] = wave_sum(s0 * rw[(size_t)tid * 8 + e] + s1 * rw[(size_t)(tid + 512) * 8 + e]);
          if (lane == 0) {
#pragma unroll
              for (int e = 0; e < 8; ++e) red[wid * 8 + e] = ce[e]; } }
        { f32x4 gv[2][2];
#pragma unroll
          for (int bj = 0; bj < 2; ++bj)
#pragma unroll
              for (int n = 0; n < 2; ++n) gv[bj][n] = *(const f32x4*)(gate + (size_t)b * 6144 + col0 + bj * HALF + 4 * n);
#pragma unroll
          for (int ai = 0; ai < 2; ++ai) {
              f32x4 xv[4][2][2];
#pragma unroll
              for (int m = 0; m < 4; ++m) { const float* ri = X + (size_t)(row0 + ai * HALF + m * 16) * DM + col0;
#pragma unroll
                  for (int bj = 0; bj < 2; ++bj)
#pragma unroll
                      for (int n = 0; n < 2; ++n) xv[m][bj][n] = ldx16(ri + bj * HALF + 4 * n); }
              asm volatile("" ::: "memory");
#pragma unroll
              for (int m = 0; m < 4; ++m) { float* rp = X + (size_t)(row0 + ai * HALF + m * 16) * DM + col0; float ss = 0.f;
#pragma unroll
                  for (int bj = 0; bj < 2; ++bj)
#pragma unroll
                      for (int n = 0; n < 2; ++n) { const f32x4 x = xv[m][bj][n] + gv[bj][n] * acc[ai][bj][m][n]; acc[ai][bj][m][n] = x; *(f32x4*)(rp + bj * HALF + 4 * n) = x;
                          ss += (x[0] * x[0] + x[1] * x[1]) + (x[2] * x[2] + x[3] * x[3]); }
                  ss += __shfl_xor(ss, 16); ss += __shfl_xor(ss, 32);
                  if (fq == 0) P9[((ai * HALF + wr * 64 + m * 16 + fr) * 4 + wc) * 9] = ss; }
              asm volatile("" ::: "memory");
          } }
        f32x4 sf[2][2];
#pragma unroll
        for (int bj = 0; bj < 2; ++bj)
#pragma unroll
            for (int n = 0; n < 2; ++n) { const int c = col0 + bj * HALF + 4 * n; const f32x4 gm = *(const f32x4*)(ng + c) * (*(const f32x4*)(shp + DM + c) + 1.0f); sf[bj][n] = *(const f32x4*)(shp + c);
#pragma unroll
                for (int ai = 0; ai < 2; ++ai)
#pragma unroll
                    for (int m = 0; m < 4; ++m) acc[ai][bj][m][n] = acc[ai][bj][m][n] * gm; }
        asm volatile("s_waitcnt lgkmcnt(0)" ::: "memory"); __builtin_amdgcn_s_barrier(); asm volatile("" ::: "memory");
        if (tid < 8) { float c = rb[tid];
#pragma unroll
            for (int w = 0; w < 8; ++w) c += red[w * 8 + tid];
            CE[tid] = c; }
#pragma unroll
        for (int e = 0; e < 8; ++e) { f32x4 rwe[2][2];
#pragma unroll
            for (int bj = 0; bj < 2; ++bj)
#pragma unroll
                for (int n = 0; n < 2; ++n) rwe[bj][n] = *(const LAS f32x4*)(RWT + e * 256 + bj * HALF + wc * 32 + 8 * fq + 4 * n);
#pragma unroll
            for (int ai = 0; ai < 2; ++ai)
#pragma unroll
                for (int m = 0; m < 4; ++m) { float a = 0.f;
#pragma unroll
                    for (int bj = 0; bj < 2; ++bj)
#pragma unroll
                        for (int n = 0; n < 2; ++n) { const f32x4 x = acc[ai][bj][m][n], w4 = rwe[bj][n]; a += (x[0] * w4[0] + x[1] * w4[1]) + (x[2] * w4[2] + x[3] * w4[3]); }
                    a += __shfl_xor(a, 16); a += __shfl_xor(a, 32);
                    if (fq == 0) P9[((ai * HALF + wr * 64 + m * 16 + fr) * 4 + wc) * 9 + 1 + e] = a; } }
        asm volatile("s_waitcnt lgkmcnt(0)" ::: "memory"); __builtin_amdgcn_s_barrier(); asm volatile("" ::: "memory");
        if (tid < 256) { gu32* q = (gu32*)xs9 + ((size_t)(u.pm * BM + tid) * 4 + u.pn) * 9;
#pragma unroll
            for (int k = 0; k < 9; ++k) { const float v = (P9[(tid * 4 + 0) * 9 + k] + P9[(tid * 4 + 1) * 9 + k]) + (P9[(tid * 4 + 2) * 9 + k] + P9[(tid * 4 + 3) * 9 + k]);
                __hip_atomic_store(q + k, __float_as_uint(v), RLX_AGENT); } }
        asm volatile("s_waitcnt vmcnt(0)" ::: "memory");
        if (wid < 4 && lane == 0) __hip_atomic_fetch_add(cnt + 64 * u.pm, 1u, RLX_AGENT);
        if (wid == 0) { unsigned spins = 0;
            while ((unsigned)__builtin_amdgcn_readfirstlane(__hip_atomic_load(cnt + 64 * u.pm, RLX_AGENT)) < 16u) { __builtin_amdgcn_s_sleep(2);
                if (++spins > (1u << 20)) { if (lane == 0) __hip_atomic_store(tmo, 1u, RLX_AGENT); break; } } }
        asm volatile("s_waitcnt vmcnt(0) lgkmcnt(0)" ::: "memory"); __builtin_amdgcn_s_barrier(); asm volatile("" ::: "memory");
        if (tid < 256) { const gu32* q = (const gu32*)xs9 + (size_t)(u.pm * BM + tid) * 36; float tot[9];
#pragma unroll
            for (int k = 0; k < 9; ++k) tot[k] = (__uint_as_float(__hip_atomic_load(q + k, RLX_AGENT)) + __uint_as_float(__hip_atomic_load(q + 9 + k, RLX_AGENT)))
                                               + (__uint_as_float(__hip_atomic_load(q + 18 + k, RLX_AGENT)) + __uint_as_float(__hip_atomic_load(q + 27 + k, RLX_AGENT)));
            const float r = 1.0f / sqrtf(tot[0] * (1.0f / DM) + EPS); S[tid] = r;
            if (wid == u.pn) {
                float lg[8];
#pragma unroll
                for (int e = 0; e < 8; ++e) lg[e] = r * tot[1 + e] + CE[e];
                int e0 = 0; float l0 = lg[0];
#pragma unroll
                for (int e = 1; e < 8; ++e) if (lg[e] > l0) { l0 = lg[e]; e0 = e; }
                int e1 = -1; float l1 = -3.0e38f;
#pragma unroll
                for (int e = 0; e < 8; ++e) if (e != e0 && lg[e] > l1) { l1 = lg[e]; e1 = e; }
                const float g0 = 1.0f / (1.0f + __expf(l1 - l0)), g1 = 1.0f - g0;
                int cmine = 0, r0 = 0, r1 = 0;
#pragma unroll
                for (int e = 0; e < 8; ++e) { const unsigned long long m0 = __ballot(e0 == e), m1 = __ballot(e1 == e);
                    const int below = (int)__builtin_amdgcn_mbcnt_hi((unsigned)(m0 >> 32), __builtin_amdgcn_mbcnt_lo((unsigned)m0, 0u)) + (int)__builtin_amdgcn_mbcnt_hi((unsigned)(m1 >> 32), __builtin_amdgcn_mbcnt_lo((unsigned)m1, 0u));
                    if (e0 == e) r0 = below; if (e1 == e) r1 = below; if (lane == e) cmine = __popcll(m0) + __popcll(m1); }
                unsigned base = 0u; if (lane < 8 && cmine) base = __hip_atomic_fetch_add(ecnt + 64 * lane, (unsigned)cmine, RLX_AGENT);
                const int p0 = (int)__shfl(base, e0) + r0, p1 = (int)__shfl(base, e1) + r1, grow = u.pm * BM + 64 * u.pn + lane;
                gu32* ri = (gu32*)(meta + WS_ROWIDX_B); gu32* gp = (gu32*)(meta + WS_GATEP_B); gu32* sl = (gu32*)(meta + WS_SLOT_B);
                __hip_atomic_store(ri + e0 * 16384 + p0, (unsigned)grow, RLX_AGENT); __hip_atomic_store(ri + e1 * 16384 + p1, (unsigned)grow, RLX_AGENT);
                __hip_atomic_store(gp + e0 * 16384 + p0, __float_as_uint(g0), RLX_AGENT); __hip_atomic_store(gp + e1 * 16384 + p1, __float_as_uint(g1), RLX_AGENT);
                __hip_atomic_store(sl + grow * 2, (unsigned)((e0 << 16) | p0), RLX_AGENT); __hip_atomic_store(sl + grow * 2 + 1, (unsigned)((e1 << 16) | p1), RLX_AGENT); } }
        asm volatile("s_waitcnt vmcnt(0) lgkmcnt(0)" ::: "memory"); __builtin_amdgcn_s_barrier(); asm volatile("" ::: "memory");
#pragma unroll
        for (int ai = 0; ai < 2; ++ai)
#pragma unroll
            for (int m = 0; m < 4; ++m) { const float r = S[ai * HALF + wr * 64 + m * 16 + fr]; bf16_t* hp = H + (size_t)(row0 + ai * HALF + m * 16) * DM + col0;
#pragma unroll
                for (int bj = 0; bj < 2; ++bj) { const f32x4 h0 = acc[ai][bj][m][0] * r + sf[bj][0], h1 = acc[ai][bj][m][1] * r + sf[bj][1];
                    if ((M1_FP8 || M1L1_FP8) && h8) { int t0 = 0, t1 = 0; t0 = __builtin_amdgcn_cvt_pk_fp8_f32(h0[0], h0[1], t0, false); t0 = __builtin_amdgcn_cvt_pk_fp8_f32(h0[2], h0[3], t0, true);
                        t1 = __builtin_amdgcn_cvt_pk_fp8_f32(h1[0], h1[1], t1, false); t1 = __builtin_amdgcn_cvt_pk_fp8_f32(h1[2], h1[3], t1, true); u32x2 w; w.x = (unsigned)t0; w.y = (unsigned)t1;
                        *(u32x2*)((unsigned char*)H + (size_t)(row0 + ai * HALF + m * 16) * DM + col0 + bj * HALF) = w; }
                    else *(u32x4*)(hp + bj * HALF) = pack8(h0, h1); } }
    }
};
struct EpiGluRes {
    static constexpr bool FUSED = false;
    float* X; const float* gate;
    __device__ __forceinline__ void operator()(const Acc& acc, const Unit& u, int wr, int wc, int fr, int fq) const {
        const int row0 = u.pm * BM + wr * 64 + fr, col0 = u.pn * HALF + wc * 32 + 8 * fq; const int b = (u.pm * BM) / SEQ;
        f32x4 gv[2];
#pragma unroll
        for (int n = 0; n < 2; ++n) gv[n] = *(const f32x4*)(gate + (size_t)b * 6144 + col0 + 4 * n);
        f32x4 xv[2][4][2];
#pragma unroll
        for (int ai = 0; ai < 2; ++ai)
#pragma unroll
            for (int m = 0; m < 4; ++m)
#pragma unroll
                for (int n = 0; n < 2; ++n) xv[ai][m][n] = ldx16(X + (size_t)(row0 + ai * HALF + m * 16) * DM + col0 + 4 * n);
        asm volatile("" ::: "memory");
#pragma unroll
        for (int ai = 0; ai < 2; ++ai)
#pragma unroll
            for (int m = 0; m < 4; ++m) { float* rp = X + (size_t)(row0 + ai * HALF + m * 16) * DM + col0;
#pragma unroll
                for (int n = 0; n < 2; ++n) { f32x4 x = xv[ai][m][n]; const f32x4 l = acc[ai][0][m][n], gg = acc[ai][1][m][n];
#pragma unroll
                    for (int e = 0; e < 4; ++e) x[e] += gv[n][e] * l[e] * sigmoid_f(gg[e]);
                    *(f32x4*)(rp + 4 * n) = x; } }
    }
};
struct EpiAttnIn {
    static constexpr bool FUSED = false;
    bf16_t *Q, *Kn, *V, *QI, *KI; float* WI; const float *qg, *kg;
    __device__ __forceinline__ void operator()(const Acc& acc, const Unit& u, int wr, int wc, int fr, int fq) const {
        const int row0 = u.pm * BM + wr * 64 + fr;
        if (u.pn < 5) {
            const bool isq = u.pn < 4; const float* gp = isq ? qg : kg; const float sc = isq ? 0.125f : 1.0f;
            f32x4 gn[2][2];
#pragma unroll
            for (int bj = 0; bj < 2; ++bj)
#pragma unroll
                for (int n = 0; n < 2; ++n) gn[bj][n] = *(const f32x4*)(gp + 32 * bj + 8 * fq + 4 * n) * sc;
            bf16_t* base = isq ? (Q + (size_t)(4 * u.pn + wc) * 64) : (Kn + (size_t)wc * 64); const int ldo = isq ? 1024 : 256;
#pragma unroll
            for (int ai = 0; ai < 2; ++ai)
#pragma unroll
                for (int m = 0; m < 4; ++m) { float ss = 0.f;
#pragma unroll
                    for (int bj = 0; bj < 2; ++bj)
#pragma unroll
                        for (int n = 0; n < 2; ++n) { const f32x4 x = acc[ai][bj][m][n]; ss += (x[0] * x[0] + x[1] * x[1]) + (x[2] * x[2] + x[3] * x[3]); }
                    ss += __shfl_xor(ss, 16); ss += __shfl_xor(ss, 32);
                    const float r = 1.0f / sqrtf(ss * (1.0f / 64.0f) + EPS);
#pragma unroll
                    for (int bj = 0; bj < 2; ++bj) *(u32x4*)(base + (size_t)(row0 + ai * HALF + m * 16) * ldo + 32 * bj + 8 * fq) = pack8(acc[ai][bj][m][0] * r * gn[bj][0], acc[ai][bj][m][1] * r * gn[bj][1]); }
        } else if (u.pn < 8) {
            bf16_t* base = (u.pn == 5) ? V : QI + (size_t)(u.pn - 6) * 256; const int ldo = (u.pn == 5) ? 256 : 512; const int col0 = wc * 32 + 8 * fq;
#pragma unroll
            for (int ai = 0; ai < 2; ++ai)
#pragma unroll
                for (int m = 0; m < 4; ++m)
#pragma unroll
                    for (int bj = 0; bj < 2; ++bj) *(u32x4*)(base + (size_t)(row0 + ai * HALF + m * 16) * ldo + col0 + bj * HALF) = pack8(acc[ai][bj][m][0], acc[ai][bj][m][1]);
        } else {
            if (wc < 2) {
#pragma unroll
                for (int ai = 0; ai < 2; ++ai)
#pragma unroll
                    for (int m = 0; m < 4; ++m) *(u32x4*)(KI + (size_t)(row0 + ai * HALF + m * 16) * 64 + wc * 32 + 8 * fq) = pack8(acc[ai][0][m][0], acc[ai][0][m][1]);
            } else if (wc == 2 && fq == 0) {
                const float s = 0.04419417382415922f;
#pragma unroll
                for (int ai = 0; ai < 2; ++ai)
#pragma unroll
                    for (int m = 0; m < 4; ++m) { float* wp = WI + (size_t)(row0 + ai * HALF + m * 16) * 8; *(f32x4*)wp = acc[ai][0][m][0] * s; *(f32x4*)(wp + 4) = acc[ai][0][m][1] * s; }
            }
        }
    }
};
struct EpiMoeDn {
    static constexpr bool FUSED = false;
    bf16_t* Y; const float* gatep;
    __device__ __forceinline__ void operator()(const Acc& acc, const Unit& u, int wr, int wc, int fr, int fq) const {
        const int row0 = u.pm * BM + wr * 64 + fr, col0 = u.pn * BM + wc * 32 + 8 * fq;
#pragma unroll
        for (int ai = 0; ai < 2; ++ai)
#pragma unroll
            for (int m = 0; m < 4; ++m) { const float gt = gatep[u.aux + ai * HALF + wr * 64 + m * 16 + fr] * (M2_FP8 ? W8_INV : 1.0f);
#pragma unroll
                for (int bj = 0; bj < 2; ++bj) *(u32x4*)(Y + (size_t)(row0 + ai * HALF + m * 16) * DM + col0 + bj * HALF) = pack8(acc[ai][bj][m][0] * gt, acc[ai][bj][m][1] * gt); }
    }
};
}

constexpr size_t MiB = 1u << 20;
constexpr size_t WS_CTL = 0, CTL_ZERO_BYTES = 1 * MiB;
constexpr size_t WS_MOD = 1 * MiB;
constexpr size_t WS_ROWIDX = 2 * MiB;
constexpr size_t WS_GATEP = 2 * MiB + 512 * 1024;
constexpr size_t WS_SLOT = 3 * MiB;
static_assert(WS_ROWIDX_B == WS_ROWIDX && WS_GATEP_B == WS_GATEP && WS_SLOT_B == WS_SLOT, "metadata offsets");
constexpr size_t WS_WCI = 8 * MiB;
constexpr size_t WS_WCO = 20 * MiB;
constexpr size_t WS_WAI = 24 * MiB;
constexpr size_t WS_WAO = 29 * MiB;
constexpr size_t WS_WGL = 31 * MiB;
constexpr size_t WS_WFG = 35 * MiB;
constexpr size_t WS_WFD = 57 * MiB;
constexpr size_t WS_WMG = 68 * MiB;
constexpr size_t WS_WMD = 244 * MiB;
constexpr size_t WS_HB = 332 * MiB;
constexpr size_t WS_BUF = 364 * MiB;
constexpr size_t WS_ACT = 432 * MiB;
constexpr size_t WS_END = 619 * MiB;
constexpr int MOE_ROWS = 2 * M + NEXP * 256;
constexpr size_t WS_Q = WS_BUF, WS_K = WS_BUF + 32 * MiB, WS_V = WS_BUF + 40 * MiB, WS_QI = WS_BUF + 48 * MiB;
constexpr size_t WS_SC = WS_ACT, WS_O = WS_ACT + 128 * MiB, WS_KI = WS_ACT + 160 * MiB, WS_WI = WS_ACT + 162 * MiB;
static_assert(WS_WMD + (size_t)16 * 1024 * 2816 * 2 <= WS_HB && WS_ACT + (size_t)MOE_ROWS * FF * 2 <= WS_END && WS_BUF + (size_t)MOE_ROWS * DM * 2 <= WS_ACT, "d_ws map");
constexpr int CW_TMO = 0;
constexpr int CW_CNT = 64;
constexpr int CW_BAR = 4096;
constexpr int CW_PAN = 16384;
constexpr size_t WS_XS9 = 5 * MiB + 768 * 1024;
constexpr size_t WS_XS = 5 * MiB + 512 * 1024;

constexpr int RING_BYTES = 131072;
constexpr int LDSCTL_OFF = RING_BYTES, MISC_OFF = LDSCTL_OFF + 320;
constexpr int LDS_BYTES = 147456;

#define XB_TMO      128
#define XB_XCNT(j)  (256  + 64 * (j))
#define XB_XSUB(j)  (1280 + 64 * (j))
#define XB_XGEN(j)  (2304 + 64 * (j))
#define XB_TOP      3328
#define XB_TOPGEN   3392
#define XCD_BAR_WORDS 3456
#define XB_SPIN_CAP (1u << 18)
__device__ __forceinline__ unsigned xb_ld(unsigned* p)              { return __hip_atomic_load(p, __ATOMIC_RELAXED, __HIP_MEMORY_SCOPE_AGENT); }
__device__ __forceinline__ unsigned xb_add(unsigned* p, unsigned v) { return __hip_atomic_fetch_add(p, v, __ATOMIC_RELAXED, __HIP_MEMORY_SCOPE_AGENT); }
__device__ __forceinline__ unsigned xb_xcc_id() { return (unsigned)__builtin_amdgcn_s_getreg((3 << 11) | 20) & 0xFu; }
#define XB_SPIN(cond, bar) do { unsigned _sp = 0; while (cond) { __builtin_amdgcn_s_sleep(1); \
    if ((++_sp & 255u) == 0u) { if (xb_ld(&(bar)[XB_TMO])) break; if (_sp > XB_SPIN_CAP) { atomicAdd(&(bar)[XB_TMO], 1u); break; } } } } while (0)
struct XcdBarrier { unsigned* bar; unsigned x; volatile LAS unsigned* st; int w; };
__device__ __forceinline__ bool xb_thread0(int w) { return w == 0 && lane_id_fresh() == 0; }
__device__ __forceinline__ XcdBarrier xcd_barrier_post(unsigned* bar, volatile LAS unsigned* st, int w) {
    XcdBarrier b; b.bar = bar; b.x = xb_xcc_id(); b.st = st; b.w = w;
    if (xb_thread0(w)) (void)xb_add(&bar[XB_XCNT(b.x)], 1u);
    return b;
}
__device__ __forceinline__ void xcd_barrier_complete(unsigned* bar, unsigned x, unsigned& nloc, unsigned& nx) {
    const unsigned G = gridDim.x * gridDim.y * gridDim.z;
    unsigned sum, cnt, mine, sp = 0u;
    for (;;) {
        sum = 0u; cnt = 0u; mine = 0u;
#pragma unroll
        for (unsigned j = 0; j < 16; ++j) { const unsigned c = xb_ld(&bar[XB_XCNT(j)]); sum += c; cnt += (c > 0u) ? 1u : 0u; mine = (j == x) ? c : mine; }
        if (sum == G) break;
        __builtin_amdgcn_s_sleep(1);
        if ((++sp & 255u) == 0u) { if (xb_ld(&bar[XB_TMO])) break; if (sp > XB_SPIN_CAP) { atomicAdd(&bar[XB_TMO], 1u); break; } }
    }
    nloc = mine > 0u ? mine : 1u; nx = cnt > 0u ? cnt : 1u;
}
__device__ __forceinline__ int lane_probe() { return (int)__builtin_amdgcn_mbcnt_hi(~0u, __builtin_amdgcn_mbcnt_lo(~0u, 0u)); }
__device__ __forceinline__ int lane_probe2() { return (int)__builtin_amdgcn_mbcnt_hi(~0u, __builtin_amdgcn_mbcnt_lo(~0u, 0u)); }
__device__ __forceinline__ void xcd_barrier(const XcdBarrier& b) {
    asm volatile("s_waitcnt vmcnt(0)" ::: "memory");
    __syncthreads();
    if (xb_thread0(b.w)) {
        unsigned* bar = b.bar;
        __builtin_amdgcn_s_waitcnt(0);
        unsigned nloc = b.st[0], nx = b.st[1];
        if (nloc == 0u) { xcd_barrier_complete(bar, b.x, nloc, nx); b.st[0] = nloc; b.st[1] = nx; }
        const unsigned old = xb_add(&bar[XB_XSUB(b.x)], 1u);
        const unsigned gen = old / nloc;
        if (old + 1u == (gen + 1u) * nloc) {
            __builtin_amdgcn_fence(__ATOMIC_RELEASE, "agent");
            asm volatile("s_waitcnt vmcnt(0)" ::: "memory");
            const unsigned og = xb_add(&bar[XB_TOP], 1u);
            const unsigned tg = og / nx;
            if (og + 1u == (tg + 1u) * nx) xb_add(&bar[XB_TOPGEN], 1u);
            else XB_SPIN(xb_ld(&bar[XB_TOPGEN]) == tg, bar);
            __builtin_amdgcn_fence(__ATOMIC_ACQUIRE, "agent");
            xb_add(&bar[XB_XGEN(b.x)], 1u);
        } else {
            XB_SPIN(xb_ld(&bar[XB_XGEN(b.x)]) == gen, bar);
            __builtin_amdgcn_fence(__ATOMIC_ACQUIRE, "agent");
        }
    }
    __syncthreads();
}

struct Args { const float* in[28]; float* out; unsigned char* ws; int ph_lo, ph_hi; };
enum { I_X = 0, I_C, I_ADAW, I_ADAB, I_NORMG, I_CWIN, I_CW, I_CWOUT, I_AWIN, I_QG, I_KG, I_AWOUT, I_RELB, I_SLRE, I_SLIM, I_SLOG, I_SBRE, I_SBIM, I_SCRE, I_SCIM, I_SD, I_SGLU,
       I_FGU, I_FDN, I_RW, I_RB, I_MGU, I_MDN };
struct Frame {
    LAS unsigned char* lds; unsigned char* ws; gu32* ctl;
    int tid, lane, wave, vcu, G;
    float* out; const float* mod;
    bf16_t *HB, *BUF, *ACT;
};

enum { MAP_NAT = 0, MAP_PAIR = 1, MAP_CONV = 2, MAP_ATTN = 3 };
__device__ __forceinline__ int map_row(int map, int half, int n) {
    if (map == MAP_NAT) return n;
    if (map == MAP_PAIR) { return n < half ? 256 * (n / 128) + (n % 128) : 256 * ((n - half) / 128) + 128 + ((n - half) % 128); }
    if (map == MAP_CONV) { if (n < 1024) return 2048 + n; if (n < 2048) { const int q = n - 1024; return 256 * (q / 128) + (q % 128); } const int q = n - 2048; return 256 * (q / 128) + 128 + (q % 128); }
    if (n < 1280) { const int hd = n / 64, d = n % 64; return 256 * (hd / 4) + 128 * (d / 32) + 32 * (hd % 4) + (d % 32); }
    return n;
}
__device__ __forceinline__ void p0_transpose_item(const float* W, int K, int N, bf16_t* WT, int map, int half, LAS float* scr, int item, int lane) {
    const int nblk = (N + 31) / 32, kb = item / nblk, nb = item % nblk, k0 = 64 * kb, n0 = 32 * nb;
    const bool cin = (n0 + (lane & 31)) < N;
    float tv[32];
#pragma unroll
    for (int i = 0; i < 32; ++i) { const int kk = 2 * i + (lane >> 5); tv[i] = cin ? W[(size_t)(k0 + kk) * N + n0 + (lane & 31)] : 0.f; }
#pragma unroll
    for (int i = 0; i < 32; ++i) { const int kk = 2 * i + (lane >> 5); scr[kk * 33 + (lane & 31)] = tv[i]; }
    LDS_WAIT(); CFENCE();
    const int c = lane & 7; const int r0 = map_row(map, half, n0);
#pragma unroll
    for (int j = 0; j < 4; ++j) { const int n = (lane >> 3) + 8 * j; const LAS float* s = scr + (8 * c) * 33 + n;
        u32x4 o; o.x = pk2(s[0 * 33], s[1 * 33]); o.y = pk2(s[2 * 33], s[3 * 33]); o.z = pk2(s[4 * 33], s[5 * 33]); o.w = pk2(s[6 * 33], s[7 * 33]);
        *(GAS u32x4*)(WT + (size_t)(r0 + n) * K + k0 + 8 * c) = o; }
    LDS_WAIT(); CFENCE();
}
__device__ __forceinline__ void p0_transpose_item8(const float* W, int K, int N, unsigned char* WT, int map, int half, LAS float* scr, int item, int lane, int sub) {
    const int nblk = (N + 31) / 32, kb = 2 * (item / nblk) + sub, nb = item % nblk, k0 = 64 * kb, n0 = 32 * nb;
    float tv[32];
#pragma unroll
    for (int i = 0; i < 32; ++i) { const int kk = 2 * i + (lane >> 5); tv[i] = W[(size_t)(k0 + kk) * N + n0 + (lane & 31)]; }
#pragma unroll
    for (int i = 0; i < 32; ++i) { const int kk = 2 * i + (lane >> 5); scr[kk * 33 + (lane & 31)] = tv[i] * pg8::W8_MUL; }
    LDS_WAIT(); CFENCE();
    const int c = lane & 3; const int r0 = map_row(map, half, n0);
#pragma unroll
    for (int j = 0; j < 2; ++j) { const int n = (lane >> 2) + 16 * j; const LAS float* sp = scr + (16 * c) * 33 + n; u32x4 o;
#pragma unroll
        for (int q = 0; q < 4; ++q) { int t = 0; t = __builtin_amdgcn_cvt_pk_fp8_f32(sp[(4 * q) * 33], sp[(4 * q + 1) * 33], t, false); t = __builtin_amdgcn_cvt_pk_fp8_f32(sp[(4 * q + 2) * 33], sp[(4 * q + 3) * 33], t, true); o[q] = (unsigned)t; }
        *(GAS u32x4*)(WT + (size_t)(r0 + n) * K + k0 + 16 * c) = o; }
    LDS_WAIT(); CFENCE();
}
__device__ __forceinline__ void p0_prologue(Frame& F, const Args& A) {
    {
        LAS float* cs = (LAS float*)F.lds;
        LAS float* red = (LAS float*)(F.lds + 16384);
        for (int i = F.tid; i < NB * DM; i += NTHREADS) { const float c = A.in[I_C][i]; cs[i] = c / (1.f + __expf(-c)); }
        __syncthreads();
        const int kg = F.tid >> 6, cj = F.tid & 63;
        for (int un = blockIdx.x; un < 4 * 96; un += F.G) {
            const int l = un / 96, jb = un % 96, j = jb * 64 + cj;
            const float* w = A.in[I_ADAW] + (size_t)l * DM * 6144 + j;
            float a0 = 0.f, a1 = 0.f, a2 = 0.f, a3 = 0.f;
#pragma unroll 8
            for (int k = kg * 128; k < kg * 128 + 128; ++k) { const float wv = w[(size_t)k * 6144]; a0 += cs[k] * wv; a1 += cs[1024 + k] * wv; a2 += cs[2048 + k] * wv; a3 += cs[3072 + k] * wv; }
            *(LAS f32x4*)(red + (kg * 64 + cj) * 4) = (f32x4){a0, a1, a2, a3};
            __syncthreads();
            if (F.tid < 256) { const int b = F.tid >> 6, cc = F.tid & 63; float s = 0.f;
#pragma unroll
                for (int q = 0; q < 8; ++q) s += red[(q * 64 + cc) * 4 + b];
                ((float*)(F.ws + WS_MOD))[((size_t)l * NB + b) * 6144 + jb * 64 + cc] = s + A.in[I_ADAB][l * 6144 + jb * 64 + cc]; }
            __syncthreads();
        }
    }
    LAS float* scr = (LAS float*)(F.lds + 32768 + F.wave * 8704);
    const int gw = F.vcu * NWAVES + F.wave, NGW = F.G * NWAVES;
    constexpr int I_CI = (DM / 64) * (3072 / 32), I_SQ = (DM / 64) * (DM / 32), I_AI = (DM / 64) * ((ATT_N + 31) / 32), I_GL = (DM / 64) * (2048 / 32), I_GU = (DM / 64) * (2 * FF / 32), I_DN = (FF / 128) * (DM / 32), I_DNB = (FF / 64) * (DM / 32), I_GU8 = (DM / 128) * (2 * FF / 32);
    constexpr int NITEMS = 2 * I_CI + 2 * I_SQ + I_AI + I_SQ + I_GL + (F1L0_FP8 ? I_GU8 : I_GU) + I_GU + (F2_FP8 ? 2 * I_DN : ((F2L0_FP8 ? I_DN : I_DNB) + I_DNB)) + 8 * (M1L1_FP8 ? I_GU8 : I_GU) + 8 * (M1_FP8 ? I_GU8 : I_GU) + 16 * (M2_FP8 ? I_DN : I_DNB);
    for (int it = gw; it < NITEMS; it += NGW) {
        int r = it;
        if (r < 2 * I_CI) { const int q = r / I_CI; p0_transpose_item(A.in[I_CWIN] + (size_t)q * DM * 3072, DM, 3072, (bf16_t*)(F.ws + WS_WCI) + (size_t)q * 3072 * DM, MAP_CONV, 0, scr, r % I_CI, F.lane); continue; } r -= 2 * I_CI;
        if (r < 2 * I_SQ) { const int q = r / I_SQ; p0_transpose_item(A.in[I_CWOUT] + (size_t)q * DM * DM, DM, DM, (bf16_t*)(F.ws + WS_WCO) + (size_t)q * DM * DM, MAP_NAT, 0, scr, r % I_SQ, F.lane); continue; } r -= 2 * I_SQ;
        if (r < I_AI) { p0_transpose_item(A.in[I_AWIN], DM, ATT_N, (bf16_t*)(F.ws + WS_WAI), MAP_ATTN, 0, scr, r, F.lane); continue; } r -= I_AI;
        if (r < I_SQ) { p0_transpose_item(A.in[I_AWOUT], DM, DM, (bf16_t*)(F.ws + WS_WAO), MAP_NAT, 0, scr, r, F.lane); continue; } r -= I_SQ;
        if (r < I_GL) { p0_transpose_item(A.in[I_SGLU], DM, 2048, (bf16_t*)(F.ws + WS_WGL), MAP_PAIR, 1024, scr, r, F.lane); continue; } r -= I_GL;
        if (F1L0_FP8) { if (r < I_GU8) { p0_transpose_item8(A.in[I_FGU], DM, 2 * FF, (unsigned char*)(F.ws + WS_WFG), MAP_PAIR, FF, scr, r, F.lane, 0); p0_transpose_item8(A.in[I_FGU], DM, 2 * FF, (unsigned char*)(F.ws + WS_WFG), MAP_PAIR, FF, scr, r, F.lane, 1); continue; } r -= I_GU8; }
        else { if (r < I_GU) { p0_transpose_item(A.in[I_FGU], DM, 2 * FF, (bf16_t*)(F.ws + WS_WFG), MAP_PAIR, FF, scr, r, F.lane); continue; } r -= I_GU; }
        if (r < I_GU) { p0_transpose_item(A.in[I_FGU] + (size_t)DM * 2 * FF, DM, 2 * FF, (bf16_t*)(F.ws + WS_WFG) + (size_t)2 * FF * DM, MAP_PAIR, FF, scr, r, F.lane); continue; } r -= I_GU;
        if (F2_FP8) { if (r < 2 * I_DN) { const int q = r / I_DN; p0_transpose_item8(A.in[I_FDN] + (size_t)q * FF * DM, FF, DM, (unsigned char*)(F.ws + WS_WFD) + (size_t)q * DM * FF, MAP_NAT, 0, scr, r % I_DN, F.lane, 0); p0_transpose_item8(A.in[I_FDN] + (size_t)q * FF * DM, FF, DM, (unsigned char*)(F.ws + WS_WFD) + (size_t)q * DM * FF, MAP_NAT, 0, scr, r % I_DN, F.lane, 1); continue; } r -= 2 * I_DN; }
        else if (F2L0_FP8) {
            if (r < I_DN) { p0_transpose_item8(A.in[I_FDN], FF, DM, (unsigned char*)(F.ws + WS_WFD), MAP_NAT, 0, scr, r, F.lane, 0); p0_transpose_item8(A.in[I_FDN], FF, DM, (unsigned char*)(F.ws + WS_WFD), MAP_NAT, 0, scr, r, F.lane, 1); continue; } r -= I_DN;
            if (r < I_DNB) { p0_transpose_item(A.in[I_FDN] + (size_t)FF * DM, FF, DM, (bf16_t*)(F.ws + WS_WFD) + (size_t)DM * FF, MAP_NAT, 0, scr, r, F.lane); continue; } r -= I_DNB; }
        else { if (r < 2 * I_DNB) { const int q = r / I_DNB; p0_transpose_item(A.in[I_FDN] + (size_t)q * FF * DM, FF, DM, (bf16_t*)(F.ws + WS_WFD) + (size_t)q * DM * FF, MAP_NAT, 0, scr, r % I_DNB, F.lane); continue; } r -= 2 * I_DNB; }
        if (M1L1_FP8) { if (r < 8 * I_GU8) { const int q = r / I_GU8; unsigned char* dst = (unsigned char*)(F.ws + WS_WMG) + (size_t)q * 2 * FF * DM;
                p0_transpose_item8(A.in[I_MGU] + (size_t)q * DM * 2 * FF, DM, 2 * FF, dst, MAP_PAIR, FF, scr, r % I_GU8, F.lane, 0); p0_transpose_item8(A.in[I_MGU] + (size_t)q * DM * 2 * FF, DM, 2 * FF, dst, MAP_PAIR, FF, scr, r % I_GU8, F.lane, 1); continue; } r -= 8 * I_GU8; }
        else { if (r < 8 * I_GU) { const int q = r / I_GU; p0_transpose_item(A.in[I_MGU] + (size_t)q * DM * 2 * FF, DM, 2 * FF, (bf16_t*)(F.ws + WS_WMG) + (size_t)q * 2 * FF * DM, MAP_PAIR, FF, scr, r % I_GU, F.lane); continue; } r -= 8 * I_GU; }
        if (M1_FP8) { if (r < 8 * I_GU8) { const int q = 8 + r / I_GU8; unsigned char* dst = (unsigned char*)(F.ws + WS_WMG) + (size_t)8 * 2 * FF * DM * 2 + (size_t)(q - 8) * 2 * FF * DM;
                p0_transpose_item8(A.in[I_MGU] + (size_t)q * DM * 2 * FF, DM, 2 * FF, dst, MAP_PAIR, FF, scr, r % I_GU8, F.lane, 0); p0_transpose_item8(A.in[I_MGU] + (size_t)q * DM * 2 * FF, DM, 2 * FF, dst, MAP_PAIR, FF, scr, r % I_GU8, F.lane, 1); continue; } r -= 8 * I_GU8; }
        else { if (r < 8 * I_GU) { const int q = 8 + r / I_GU; p0_transpose_item(A.in[I_MGU] + (size_t)q * DM * 2 * FF, DM, 2 * FF, (bf16_t*)(F.ws + WS_WMG) + (size_t)q * 2 * FF * DM, MAP_PAIR, FF, scr, r % I_GU, F.lane); continue; } r -= 8 * I_GU; }
        if (M2_FP8) { const int q = r / I_DN; p0_transpose_item8(A.in[I_MDN] + (size_t)q * FF * DM, FF, DM, (unsigned char*)(F.ws + WS_WMD) + (size_t)q * DM * FF, MAP_NAT, 0, scr, r % I_DN, F.lane, 0); p0_transpose_item8(A.in[I_MDN] + (size_t)q * FF * DM, FF, DM, (unsigned char*)(F.ws + WS_WMD) + (size_t)q * DM * FF, MAP_NAT, 0, scr, r % I_DN, F.lane, 1); }
        else { const int q = r / I_DNB; p0_transpose_item(A.in[I_MDN] + (size_t)q * FF * DM, FF, DM, (bf16_t*)(F.ws + WS_WMD) + (size_t)q * DM * FF, MAP_NAT, 0, scr, r % I_DNB, F.lane); }
    }
    { u32x4* z = (u32x4*)((bf16_t*)(F.ws + WS_WAI) + (size_t)2144 * DM); const int n16 = (ATT_NP - 2144) * DM * 2 / 16;
      for (int i = blockIdx.x * NTHREADS + F.tid; i < n16; i += F.G * NTHREADS) z[i] = (u32x4){0u, 0u, 0u, 0u}; }
}

template <int FLAGS>
__device__ __forceinline__ void thin_phase(Frame& F, const Args& A, const float* src, int nl  , int ns  , int cl  , int rl  , int cs = -1  , size_t roff = 0  ) {
    if (cs < 0) cs = rl;
    const int gw = F.vcu * NWAVES + F.wave, NGW = F.G * NWAVES;
    LAS float* rwt = (LAS float*)F.lds;
    if (FLAGS & 8) {
        const float* rw = A.in[I_RW] + (size_t)rl * DM * NEXP;
        for (int i = F.tid; i < DM * NEXP; i += NTHREADS) rwt[(i & 7) * DM + (i >> 3)] = rw[i];
        __syncthreads();
    }
    int Tb[8];
    if (FLAGS & 2) { int acc = 0;
#pragma unroll
        for (int e = 0; e < 8; ++e) { Tb[e] = acc; acc += (int)((__hip_atomic_load(F.ctl + CW_CNT + 64 * (8 * rl + e), RLX_AGENT) + 255u) >> 8); } }
    const float* ng = A.in[I_NORMG] + (size_t)(nl * 2 + ns) * DM;
    constexpr bool RT = (FLAGS & 8) != 0;
    LAS int* rE = (LAS int*)(F.lds + 32768);
    const int nit = RT ? ((M / 64 - (int)blockIdx.x + F.G - 1) / F.G) * 8 : (M - gw + NGW - 1) / NGW;
    for (int it = 0; it < nit; ++it) {
        const int chunk = (int)blockIdx.x + (it >> 3) * F.G;
        const int row = RT ? chunk * 64 + F.wave * 8 + (it & 7) : gw + it * NGW;
        const int b = row / SEQ;
        f32x4 v[4];
        const f32x4* xr = (const f32x4*)(src + (size_t)row * DM) + F.lane;
#pragma unroll
        for (int j = 0; j < 4; ++j) v[j] = xr[64 * j];
        if (FLAGS & 2) {
            const int s0 = ((const int*)(F.ws + roff + WS_SLOT))[row * 2], s1 = ((const int*)(F.ws + roff + WS_SLOT))[row * 2 + 1];
            int t0 = 0, t1 = 0;
#pragma unroll
            for (int e = 0; e < 8; ++e) { if ((s0 >> 16) == e) t0 = Tb[e]; if ((s1 >> 16) == e) t1 = Tb[e]; }
            const bf16_t* y0 = (const bf16_t*)(F.ws + WS_BUF) + (size_t)(256 * t0 + (s0 & 0xffff)) * DM;
            const bf16_t* y1 = (const bf16_t*)(F.ws + WS_BUF) + (size_t)(256 * t1 + (s1 & 0xffff)) * DM;
            const float* g2 = cl >= 0 ? F.mod + ((size_t)cl * NB + b) * 6144 + 5 * DM : (const float*)(F.ws + 512 * 1024);
#pragma unroll
            for (int j = 0; j < 4; ++j) { const int col = 4 * F.lane + 256 * j; const u32x2 a = *(const u32x2*)(y0 + col), c = *(const u32x2*)(y1 + col); const f32x4 g = *(const f32x4*)(g2 + col);
                v[j][0] += g[0] * (bflo(a.x) + bflo(c.x)); v[j][1] += g[1] * (bfhi(a.x) + bfhi(c.x)); v[j][2] += g[2] * (bflo(a.y) + bflo(c.y)); v[j][3] += g[3] * (bfhi(a.y) + bfhi(c.y)); }
        }
        if (FLAGS & 3) { GAS f32x4* xo = (GAS f32x4*)(F.out + (size_t)row * DM) + F.lane;
#pragma unroll
            for (int j = 0; j < 4; ++j) xo[64 * j] = v[j]; }
        if (FLAGS & 4) {
            float ss = 0.f;
#pragma unroll
            for (int j = 0; j < 4; ++j) ss += (v[j][0] * v[j][0] + v[j][1] * v[j][1]) + (v[j][2] * v[j][2] + v[j][3] * v[j][3]);
            const float r = 1.0f / sqrtf(wave_sum(ss) * (1.0f / DM) + EPS);
            const float* sh = F.mod + ((size_t)nl * NB + b) * 6144 + (ns ? 3 : 0) * DM; const float* sc = sh + DM;
            GAS u32x2* ho = (GAS u32x2*)(F.HB + (size_t)row * DM) + F.lane;
#pragma unroll
            for (int j = 0; j < 4; ++j) { const int col = 4 * F.lane + 256 * j; const f32x4 g = *(const f32x4*)(ng + col), s1 = *(const f32x4*)(sc + col), s0 = *(const f32x4*)(sh + col);
                v[j] = (v[j] * r) * g * (s1 + 1.0f) + s0;
                if ((RT && ((M1_FP8 && nl == 3) || (M1L1_FP8 && nl == 1))) || (FLAGS == 4 && F1L0_FP8 && nl == 0 && ns == 1)) { int t = 0; t = __builtin_amdgcn_cvt_pk_fp8_f32(v[j][0], v[j][1], t, false); t = __builtin_amdgcn_cvt_pk_fp8_f32(v[j][2], v[j][3], t, true);
                    *(unsigned*)((unsigned char*)F.HB + (size_t)row * DM + col) = (unsigned)t; }
                else { u32x2 w; w.x = pk2(v[j][0], v[j][1]); w.y = pk2(v[j][2], v[j][3]); ho[64 * j] = w; } }
            if (FLAGS & 8) {
                float lg[8];
#pragma unroll
                for (int e = 0; e < 8; ++e) { float s = 0.f;
#pragma unroll
                    for (int j = 0; j < 4; ++j) { const f32x4 w = *(const LAS f32x4*)(rwt + e * DM + 4 * F.lane + 256 * j); s += (v[j][0] * w[0] + v[j][1] * w[1]) + (v[j][2] * w[2] + v[j][3] * w[3]); }
                    lg[e] = wave_sum(s) + A.in[I_RB][rl * NEXP + e]; }
                int e0 = 0; float l0 = lg[0];
#pragma unroll
                for (int e = 1; e < 8; ++e) if (lg[e] > l0) { l0 = lg[e]; e0 = e; }
                int e1 = -1; float l1 = -3.0e38f;
#pragma unroll
                for (int e = 0; e < 8; ++e) if (e != e0 && lg[e] > l1) { l1 = lg[e]; e1 = e; }
                const float g0 = 1.0f / (1.0f + __expf(l1 - l0)), g1 = 1.0f - g0;
                const int lr = F.wave * 8 + (it & 7);
                if (F.lane == 0) { rE[lr] = e0; rE[64 + lr] = e1; rE[128 + lr] = __float_as_int(g0); rE[192 + lr] = __float_as_int(g1); }
            }
        }
        if (RT && (it & 7) == 7) {
            __syncthreads();
            if (F.tid < 8) { int cnt = 0; for (int q = 0; q < 64; ++q) cnt += (rE[q] == F.tid) + (rE[64 + q] == F.tid);
                rE[256 + F.tid] = cnt ? (int)__hip_atomic_fetch_add(F.ctl + CW_CNT + 64 * (8 * cs + F.tid), (unsigned)cnt, RLX_AGENT) : 0; }
            __syncthreads();
            if (F.tid < 64) { const int e0 = rE[F.tid], e1 = rE[64 + F.tid]; int r0 = 0, r1 = 0;
                for (int q = 0; q < F.tid; ++q) { r0 += (rE[q] == e0) + (rE[64 + q] == e0); r1 += (rE[q] == e1) + (rE[64 + q] == e1); }
                const int p0 = rE[256 + e0] + r0, p1 = rE[256 + e1] + r1, grow = chunk * 64 + F.tid;
                gu32* ri = (gu32*)(F.ws + roff + WS_ROWIDX); gu32* gp = (gu32*)(F.ws + roff + WS_GATEP); gu32* sl = (gu32*)(F.ws + roff + WS_SLOT);
                __hip_atomic_store(ri + e0 * 16384 + p0, (unsigned)grow, RLX_AGENT); __hip_atomic_store(ri + e1 * 16384 + p1, (unsigned)grow, RLX_AGENT);
                __hip_atomic_store(gp + e0 * 16384 + p0, (unsigned)rE[128 + F.tid], RLX_AGENT); __hip_atomic_store(gp + e1 * 16384 + p1, (unsigned)rE[192 + F.tid], RLX_AGENT);
                __hip_atomic_store(sl + grow * 2, (unsigned)((e0 << 16) | p0), RLX_AGENT); __hip_atomic_store(sl + grow * 2 + 1, (unsigned)((e1 << 16) | p1), RLX_AGENT); }
            __syncthreads();
        }
    }
}

__device__ __forceinline__ void unpack8(const u32x4 w, float (&f)[8]) { f[0] = bflo(w.x); f[1] = bfhi(w.x); f[2] = bflo(w.y); f[3] = bfhi(w.y); f[4] = bflo(w.z); f[5] = bfhi(w.z); f[6] = bflo(w.w); f[7] = bfhi(w.w); }
__device__ __forceinline__ void conv_phase(Frame& F, const float* cw  ) {
    const int gw = F.vcu * NWAVES + F.wave, NGW = F.G * NWAVES;
    const bf16_t* UB = F.BUF;
    for (int task = gw; task < M / 8; task += NGW) {
        const int r0 = task * 8; const bool first = (r0 % SEQ) == 0;
#pragma unroll
        for (int j = 0; j < 2; ++j) {
            const int ch = 8 * F.lane + 512 * j;
            float w0[8], w1[8], w2[8];
#pragma unroll
            for (int e = 0; e < 8; ++e) { w0[e] = cw[ch + e]; w1[e] = cw[DM + ch + e]; w2[e] = cw[2 * DM + ch + e]; }
            float um2[8], um1[8];
            if (first) {
#pragma unroll
                for (int e = 0; e < 8; ++e) { um2[e] = 0.f; um1[e] = 0.f; }
            } else { unpack8(*(const u32x4*)(UB + (size_t)(r0 - 2) * 2048 + ch), um2); unpack8(*(const u32x4*)(UB + (size_t)(r0 - 1) * 2048 + ch), um1); }
#pragma unroll
            for (int i = 0; i < 8; ++i) {
                float u0[8], bb[8]; unpack8(*(const u32x4*)(UB + (size_t)(r0 + i) * 2048 + ch), u0); unpack8(*(const u32x4*)(UB + (size_t)(r0 + i) * 2048 + 1024 + ch), bb);
                float z[8];
#pragma unroll
                for (int e = 0; e < 8; ++e) z[e] = bb[e] * (w0[e] * um2[e] + w1[e] * um1[e] + w2[e] * u0[e]);
                u32x4 o; o.x = pk2(z[0], z[1]); o.y = pk2(z[2], z[3]); o.z = pk2(z[4], z[5]); o.w = pk2(z[6], z[7]);
                *(u32x4*)(F.HB + (size_t)(r0 + i) * DM + ch) = o;
#pragma unroll
                for (int e = 0; e < 8; ++e) { um2[e] = um1[e]; um1[e] = u0[e]; }
            }
        }
    }
}

constexpr int QIP = 1040;
constexpr int AL_QI = 0, AL_WI = 33280, AL_SEL = 34304, AL_V = 42496, AL_BIASD = 108032, AL_SUM = 116288, AL_END = 116800;
typedef short v4i16_t __attribute__((ext_vector_type(4)));
__device__ __forceinline__ unsigned okey(float f) { const unsigned u = __float_as_uint(f); return u ^ ((u >> 31) ? 0xFFFFFFFFu : 0x80000000u); }
__device__ __forceinline__ void attn_phase(Frame& F, const Args& A) {
    LAS unsigned char* L = F.lds;
    const bf16_t* Qb = (const bf16_t*)(F.ws + WS_Q); const bf16_t* Kb = (const bf16_t*)(F.ws + WS_K); const bf16_t* Vb = (const bf16_t*)(F.ws + WS_V);
    const bf16_t* QIb = (const bf16_t*)(F.ws + WS_QI); const bf16_t* KIb = (const bf16_t*)(F.ws + WS_KI); const float* WIb = (const float*)(F.ws + WS_WI);
    bf16_t* Ob = (bf16_t*)(F.ws + WS_O);
    float* SC = (float*)(F.ws + WS_SC) + (size_t)blockIdx.x * 32 * SEQ;
    const int lane = F.lane, wave = F.wave;
    { LAS float* bd = (LAS float*)(L + AL_BIASD);
      for (int i = F.tid; i < 129 * 16; i += NTHREADS) { const int d = i >> 4; int bkt; if (d < 16) bkt = d; else { const float dd = (float)d; const int lg2 = 16 + (int)(logf(dd / 16.0f) / 2.0794415416798357f * 16.0f); bkt = lg2 < 31 ? lg2 : 31; }
          bd[i] = A.in[I_RELB][bkt * 16 + (i & 15)]; }
    }
    __syncthreads();
    for (int pass = 0; pass < 2; ++pass) {
        const int un = pass == 0 ? (int)blockIdx.x : 511 - (int)blockIdx.x;
        for (int uu = un; uu >= 0 && uu < 512; uu += (pass == 0 ? F.G * 2 : -F.G * 2)) {
        if ((pass == 0 && uu >= 256) || (pass == 1 && uu < 256)) break;
        const int b = uu & 3, qb = uu >> 2, t0 = qb * 32; const size_t rb = (size_t)b * SEQ;
        for (int i = F.tid; i < 32 * 64; i += NTHREADS) { const int q = i >> 6, c = i & 63; *(LAS u32x4*)(L + AL_QI + q * QIP + c * 16) = *(const u32x4*)(QIb + (rb + t0 + q) * 512 + c * 8); }
        if (F.tid < 256) ((LAS float*)(L + AL_WI))[F.tid] = WIb[(rb + t0) * 8 + F.tid];
        __syncthreads();
        {
            for (int kt = wave; kt <= qb; kt += NWAVES) {
                int ln1 = lane; asm volatile("" : "+v"(ln1));
                const int r = ln1 & 31, hh = ln1 >> 5;
                float wi[8];
#pragma unroll
                for (int h = 0; h < 8; ++h) wi[h] = ((LAS float*)(L + AL_WI))[r * 8 + h];
                bf16x8 ka[4];
#pragma unroll
                for (int ks = 0; ks < 4; ++ks) ka[ks] = *(const bf16x8*)(KIb + (rb + kt * 32 + r) * 64 + 16 * ks + 8 * hh);
                f32x16 sc;
#pragma unroll
                for (int i = 0; i < 16; ++i) sc[i] = 0.f;
#pragma unroll
                for (int h = 0; h < 8; ++h) {
                    f32x16 d;
#pragma unroll
                    for (int i = 0; i < 16; ++i) d[i] = 0.f;
#pragma unroll
                    for (int ks = 0; ks < 4; ++ks) { const bf16x8 qf = *(const LAS bf16x8*)(L + AL_QI + r * QIP + (h * 64 + 16 * ks + 8 * hh) * 2); d = __builtin_amdgcn_mfma_f32_32x32x16_bf16(ka[ks], qf, d, 0, 0, 0); }
#pragma unroll
                    for (int i = 0; i < 16; ++i) sc[i] += wi[h] * fmaxf(d[i], 0.f);
                }
#pragma unroll
                for (int a = 0; a < 4; ++a) { f32x4 o;
#pragma unroll
                    for (int e = 0; e < 4; ++e) { const int krow = 8 * a + 4 * hh + e; o[e] = (kt == qb && krow > r) ? -INFINITY : sc[4 * a + e]; }
                    *(f32x4*)(SC + (size_t)r * SEQ + kt * 32 + 8 * a + 4 * hh) = o; }
            }
        }
        VM_WAIT(); __syncthreads();
        for (int qq = 0; qq < 4; ++qq) {
            const int c = wave + 8 * qq, t = t0 + c; const int nvalid = t + 1;
            int lane = F.lane; asm volatile("" : "+v"(lane));
            LAS int* sel = (LAS int*)(L + AL_SEL) + wave * 256;
            int count;
            if (nvalid <= TOPK) {
                count = nvalid;
#pragma unroll
                for (int j = 0; j < 4; ++j) { const int idx = 64 * j + lane; sel[idx] = idx < nvalid ? idx : 0; }
            } else {
                count = TOPK;
                const int nj = (nvalid + 63) >> 6;
                unsigned key[64];
                const float* srow = SC + (size_t)c * SEQ;
#define SEL_GROUPS(BODY) do { BODY(0) if (nj > 16) { BODY(1) if (nj > 32) { BODY(2) if (nj > 48) { BODY(3) } } } } while (0)
#define SEL_LOAD(g) { _Pragma("unroll") for (int j = 16 * (g); j < 16 * (g) + 16; ++j) { const int idx = 64 * j + lane; const float sv = __uint_as_float(__hip_atomic_load((const gu32*)(srow + idx), RLX_AGENT)); key[j] = idx <= t ? okey(sv) : 0u;     } }
#pragma unroll
                for (int j = 0; j < 64; ++j) key[j] = 0u;
                SEL_GROUPS(SEL_LOAD);
                unsigned T = 0u;
                for (int bit = 31; bit >= 0; --bit) {
                    const unsigned cand = T | (1u << bit); int cnt = 0;
#define SEL_CNT(g) { _Pragma("unroll") for (int j = 16 * (g); j < 16 * (g) + 16; ++j) cnt += __popcll(__ballot(key[j] >= cand)); }
                    SEL_GROUPS(SEL_CNT);
                    if (cnt >= TOPK) T = cand;
                    if (cnt == TOPK) break;
                }
                int base = 0;
#define SEL_GT(g) { _Pragma("unroll") for (int j = 16 * (g); j < 16 * (g) + 16; ++j) { const bool gt = key[j] > T; const unsigned long long mk = __ballot(gt); \
                    const int pos = base + (int)__builtin_amdgcn_mbcnt_hi((unsigned)(mk >> 32), __builtin_amdgcn_mbcnt_lo((unsigned)mk, 0u)); if (gt) sel[pos] = 64 * j + lane; base += __popcll(mk); } }
                SEL_GROUPS(SEL_GT);
                const int need = TOPK - base; int eb = 0;
#define SEL_EQ(g) { _Pragma("unroll") for (int j = 16 * (g); j < 16 * (g) + 16; ++j) { const bool eq = key[j] == T; const unsigned long long mk = __ballot(eq); \
                    const int rank = eb + (int)__builtin_amdgcn_mbcnt_hi((unsigned)(mk >> 32), __builtin_amdgcn_mbcnt_lo((unsigned)mk, 0u)); if (eq && rank < need) sel[base + rank] = 64 * j + lane; eb += __popcll(mk); } }
                SEL_GROUPS(SEL_EQ);
#undef SEL_GROUPS
#undef SEL_LOAD
#undef SEL_CNT
#undef SEL_GT
#undef SEL_EQ
            }
            LDS_WAIT(); CFENCE();
            asm volatile("" : "+v"(lane));
            const int hd = lane & 15, kq = lane >> 4;
            bf16x8 bq[8];
            { bf16x8 qf[2];
#pragma unroll
              for (int s2 = 0; s2 < 2; ++s2) qf[s2] = *(const bf16x8*)(Qb + (rb + t) * 1024 + hd * 64 + 32 * s2 + 8 * kq);
              const bf16x8 zf = (bf16x8){0, 0, 0, 0, 0, 0, 0, 0};
#pragma unroll
              for (int ks = 0; ks < 8; ++ks) bq[ks] = ((ks >> 1) == (hd >> 2)) ? qf[ks & 1] : zf; }
            f32x4 lg[16];
            float mx = -INFINITY;
            bf16x8 kf[3][8];
#pragma unroll
            for (int pre = 0; pre < 2; ++pre) { const int krow = sel[16 * pre + hd]; const bf16_t* kp = Kb + (rb + krow) * 256 + 8 * kq;
#pragma unroll
              for (int ks = 0; ks < 8; ++ks) kf[pre][ks] = *(const bf16x8*)(kp + 32 * ks); }
            const LAS float* biasd = (const LAS float*)(L + AL_BIASD);
#pragma unroll
            for (int kt = 0; kt < 16; ++kt) {
                if (kt < 14) { const int krow = sel[16 * (kt + 2) + hd]; const bf16_t* kp = Kb + (rb + krow) * 256 + 8 * kq;
#pragma unroll
                    for (int ks = 0; ks < 8; ++ks) kf[(kt + 2) % 3][ks] = *(const bf16x8*)(kp + 32 * ks); }
                f32x4 d = (f32x4){0.f, 0.f, 0.f, 0.f};
#pragma unroll
                for (int ks = 0; ks < 8; ++ks) d = __builtin_amdgcn_mfma_f32_16x16x32_bf16(kf[kt % 3][ks], bq[ks], d, 0, 0, 0);
                const u32x4 ks4 = *(const LAS u32x4*)(sel + 16 * kt + 4 * kq);
#pragma unroll
                for (int i = 0; i < 4; ++i) { const int pos = 16 * kt + 4 * kq + i; int dist = t - (int)ks4[i]; dist = dist < 0 ? 0 : (dist > 128 ? 128 : dist);
                    const float bs = biasd[dist * 16 + hd];
                    d[i] = pos < count ? d[i] + bs : -INFINITY; mx = fmaxf(mx, d[i]); }
                lg[kt] = d;
            }
            mx = fmaxf(mx, __shfl_xor(mx, 16)); mx = fmaxf(mx, __shfl_xor(mx, 32));
            float sum = 0.f;
            bf16x8 pa[8];
#pragma unroll
            for (int ks = 0; ks < 8; ++ks) { float p[8];
#pragma unroll
                for (int i = 0; i < 4; ++i) { p[i] = __expf(lg[2 * ks][i] - mx); p[4 + i] = __expf(lg[2 * ks + 1][i] - mx); }
                sum += ((p[0] + p[1]) + (p[2] + p[3])) + ((p[4] + p[5]) + (p[6] + p[7]));
                u32x4 w; w.x = cvt_pk_bf16(p[0], p[1]); w.y = cvt_pk_bf16(p[2], p[3]); w.z = cvt_pk_bf16(p[4], p[5]); w.w = cvt_pk_bf16(p[6], p[7]);
                pa[ks] = __builtin_bit_cast(bf16x8, w); }
            sum += __shfl_xor(sum, 16); sum += __shfl_xor(sum, 32);
            if (kq == 0) ((LAS float*)(L + AL_SUM))[wave * 16 + hd] = sum;
            LDS_WAIT(); CFENCE();
            {
                asm volatile("" : "+v"(lane));
                const int rs = lane >> 3, ch = lane & 7, i16 = lane & 15, tq = i16 >> 2, tp = i16 & 3, kq2 = lane >> 4;
                LAS unsigned char* vb = L + AL_V + wave * 8192;
                const unsigned wr_off = (unsigned)lane * 16u, tr_off = (unsigned)((4 * kq2 + tq) * 128 + 8 * tp);
                f32x4 O[4][4];
#pragma unroll
                for (int n = 0; n < 4; ++n)
#pragma unroll
                    for (int dt = 0; dt < 4; ++dt) O[n][dt] = (f32x4){0.f, 0.f, 0.f, 0.f};
                u32x4 vr[2][4]; int kr[4];
                const bf16_t* vbase = Vb + rb * 256 + 8 * ch;
#pragma unroll
                for (int i = 0; i < 4; ++i) kr[i] = sel[8 * i + rs];
#pragma unroll
                for (int pre = 0; pre < 2; ++pre)
#pragma unroll
                    for (int i = 0; i < 4; ++i) vr[pre][i] = *(const u32x4*)(vbase + (size_t)kr[i] * 256 + pre * 64);
#pragma unroll
                for (int st = 0; st < 32; ++st) {
                    const int ks = st >> 2, n = st & 3;
                    LAS unsigned char* buf = vb + (st & 1) * 4096;
#pragma unroll
                    for (int i = 0; i < 4; ++i) *(LAS u32x4*)(buf + wr_off + i * 1024) = vr[st & 1][i];
                    if (st < 30) { const int ks2 = (st + 2) >> 2, n2 = (st + 2) & 3;
                        if (n2 == 0) {
#pragma unroll
                            for (int i = 0; i < 4; ++i) kr[i] = sel[32 * ks2 + 8 * i + rs]; }
#pragma unroll
                        for (int i = 0; i < 4; ++i) vr[st & 1][i] = *(const u32x4*)(vbase + (size_t)kr[i] * 256 + n2 * 64); }
#pragma unroll
                    for (int dt = 0; dt < 4; ++dt) {
                        const v4i16_t t0 = __builtin_amdgcn_ds_read_tr16_b64_v4i16((LAS v4i16_t*)(buf + tr_off + 32 * dt));
                        const v4i16_t t1 = __builtin_amdgcn_ds_read_tr16_b64_v4i16((LAS v4i16_t*)(buf + tr_off + 2048 + 32 * dt));
                        const bf16x8 bfr = (bf16x8){t0[0], t0[1], t0[2], t0[3], t1[0], t1[1], t1[2], t1[3]};
                        O[n][dt] = __builtin_amdgcn_mfma_f32_16x16x32_bf16(pa[ks], bfr, O[n][dt], 0, 0, 0); }
                    CFENCE();
                }
                const f32x4 sm = *(const LAS f32x4*)(L + AL_SUM + (wave * 16 + 4 * kq2) * 4);
                bf16_t* op = Ob + (rb + t) * 1024 + (4 * kq2) * 64 + i16;
#pragma unroll
                for (int dt = 0; dt < 4; ++dt)
#pragma unroll
                    for (int i = 0; i < 4; ++i) { const float v = kq2 == 0 ? O[0][dt][i] : (kq2 == 1 ? O[1][dt][i] : (kq2 == 2 ? O[2][dt][i] : O[3][dt][i]));
                        op[i * 64 + 16 * dt] = (bf16_t)f2bf(v / sm[i]); }
            }
            LDS_WAIT(); CFENCE();
        }
        __syncthreads();
        }
    }
}

constexpr int SL_BMT = 0;
constexpr int SL_CMA = 4096;
constexpr int SL_AB = 12288;
constexpr int SL_E = 12800;
constexpr int SL_S = 16896;
constexpr int SPITCH = 272;
__device__ __forceinline__ void cmul(float ar, float ai, float br, float bi, float& cr, float& ci) { cr = ar * br - ai * bi; ci = ar * bi + ai * br; }
__device__ __forceinline__ void ssm_phase(Frame& F, const Args& A) {
    LAS unsigned char* L = F.lds;
    const int lane = F.lane, wave = F.wave;
    bf16_t* G = (bf16_t*)(F.ws + WS_ACT);
    for (int un = F.vcu; un < NB * 64; un += F.G) {
        const int b = un >> 6, g = un & 63; const size_t rb = (size_t)b * SEQ;
        __syncthreads();
        if (F.tid < 64) {
            const int p = F.tid;
            const float lr = fminf(A.in[I_SLRE][g * 64 + p], -1e-4f), li = A.in[I_SLIM][g * 64 + p];
            const float step = expf(A.in[I_SLOG][g]);
            const float mag = expf(lr * step); float sn, cs; sincosf(li * step, &sn, &cs);
            const float ar = mag * cs, ai = mag * sn;
            ((LAS float*)(L + SL_AB))[2 * p] = ar; ((LAS float*)(L + SL_AB))[2 * p + 1] = ai;
            const float nr = ar - 1.0f, ni = ai, den = lr * lr + li * li;
            const float cr = (nr * lr + ni * li) / den, ci = (ni * lr - nr * li) / den;
            LAS bf16_t* bm = (LAS bf16_t*)(L + SL_BMT);
#pragma unroll
            for (int c = 0; c < 16; ++c) { const float br = A.in[I_SBRE][((size_t)g * 64 + p) * 16 + c], bi = A.in[I_SBIM][((size_t)g * 64 + p) * 16 + c];
                float xr, xi; cmul(cr, ci, br, bi, xr, xi); bm[p * 16 + c] = (bf16_t)f2bf(xr); bm[(64 + p) * 16 + c] = (bf16_t)f2bf(xi); }
        }
        { LAS bf16_t* cm = (LAS bf16_t*)(L + SL_CMA);
          for (int i = F.tid; i < 32 * 128; i += NTHREADS) { const int c = i >> 7, k = i & 127; float v = 0.f;
              if (c < 16) v = (k < 64) ? A.in[I_SCRE][((size_t)g * 16 + c) * 64 + k] : -A.in[I_SCIM][((size_t)g * 16 + c) * 64 + (k - 64)];
              cm[i] = (bf16_t)f2bf(v); } }
        __syncthreads();
        const int r = lane & 31, hh = lane >> 5;
        bf16x8 bfr[4];
#pragma unroll
        for (int n = 0; n < 4; ++n) bfr[n] = *(const LAS bf16x8*)(L + SL_BMT + ((32 * n + r) * 16 + 8 * hh) * 2);
        bf16x8 cfr[8];
#pragma unroll
        for (int ks = 0; ks < 8; ++ks) cfr[ks] = *(const LAS bf16x8*)(L + SL_CMA + (r * 128 + 16 * ks + 8 * hh) * 2);
        float ar[2], ai[2], a16r[2], a16i[2], a512r[2], a512i[2];
#pragma unroll
        for (int s = 0; s < 2; ++s) { ar[s] = ((LAS float*)(L + SL_AB))[2 * (32 * s + r)]; ai[s] = ((LAS float*)(L + SL_AB))[2 * (32 * s + r) + 1];
            float pr = ar[s], pi = ai[s];
#pragma unroll
            for (int q = 0; q < 4; ++q) { float nr, ni; cmul(pr, pi, pr, pi, nr, ni); pr = nr; pi = ni; }
            a16r[s] = pr; a16i[s] = pi;
#pragma unroll
            for (int q = 0; q < 5; ++q) { float nr, ni; cmul(pr, pi, pr, pi, nr, ni); pr = nr; pi = ni; }
            a512r[s] = pr; a512i[s] = pi; }
        const int tokperm = 16 * ((r >> 2) & 1) + 4 * (r >> 3) + (r & 3);
        const float dsk0 = 0.f; (void)dsk0;
        float cin_r[2] = {0.f, 0.f}, cin_i[2] = {0.f, 0.f};
        LAS unsigned char* Sw = L + SL_S + wave * (32 * SPITCH);
        for (int pass = 0; pass < 2; ++pass) {
            if (pass == 1) {
                __syncthreads();
#pragma unroll
                for (int s = 0; s < 2; ++s) { float cr = 0.f, ci = 0.f;
                    for (int w = 0; w < wave; ++w) { float nr, ni; cmul(a512r[s], a512i[s], cr, ci, nr, ni); cr = nr + ((LAS float*)(L + SL_E))[(w * 64 + 32 * s + r) * 2]; ci = ni + ((LAS float*)(L + SL_E))[(w * 64 + 32 * s + r) * 2 + 1]; }
                    cin_r[s] = cr; cin_i[s] = ci; }
            }
            bf16x8 ufn = *(const bf16x8*)(F.HB + (rb + wave * 512 + tokperm) * DM + 16 * g + 8 * hh);
            for (int tile = 0; tile < 16; ++tile) {
                asm volatile("s_waitcnt vmcnt(0) lgkmcnt(0)" ::: "memory"); __builtin_amdgcn_s_barrier(); asm volatile("" ::: "memory");
                const int tk0 = wave * 512 + tile * 32;
                const bf16x8 uf = ufn;
                if (tile < 15) ufn = *(const bf16x8*)(F.HB + (rb + tk0 + 32 + tokperm) * DM + 16 * g + 8 * hh);

                f32x16 d[4];
#pragma unroll
                for (int n = 0; n < 4; ++n) {
#pragma unroll
                    for (int i = 0; i < 16; ++i) d[n][i] = 0.f;
                    d[n] = __builtin_amdgcn_mfma_f32_32x32x16_bf16(uf, bfr[n], d[n], 0, 0, 0); }
                asm volatile("s_nop 15\n\ts_nop 15\n\ts_nop 15" : "+v"(d[0]), "+v"(d[1]), "+v"(d[2]), "+v"(d[3]));
#pragma unroll
                for (int s = 0; s < 2; ++s) {
                    float sr = hh == 0 ? cin_r[s] : 0.f, si = hh == 0 ? cin_i[s] : 0.f;
#pragma unroll
                    for (int i = 0; i < 16; ++i) { const float nr = ar[s] * sr - ai[s] * si + d[s][i], ni = ar[s] * si + ai[s] * sr + d[2 + s][i]; sr = nr; si = ni; d[s][i] = sr; d[2 + s][i] = si; }
                    const float e0r = __shfl_xor(sr, 32), e0i = __shfl_xor(si, 32);
                    float cr = hh == 1 ? e0r : 0.f, ci = hh == 1 ? e0i : 0.f;
                    if (pass == 1) {
#pragma unroll
                        for (int i = 0; i < 16; ++i) { float nr, ni; cmul(ar[s], ai[s], cr, ci, nr, ni); cr = nr; ci = ni; d[s][i] += cr; d[2 + s][i] += ci; }
                    } else { float nr, ni; cmul(a16r[s], a16i[s], cr, ci, nr, ni); cr = nr; ci = ni; }
                    const float endr = (pass == 1) ? d[s][15] : sr + cr, endi = (pass == 1) ? d[2 + s][15] : si + ci;
                    const float xr = __shfl_xor(endr, 32), xi = __shfl_xor(endi, 32);
                    cin_r[s] = hh == 1 ? endr : xr; cin_i[s] = hh == 1 ? endi : xi;
                }
                if (pass == 1) {
#pragma unroll
                    for (int s = 0; s < 2; ++s)
#pragma unroll
                        for (int i = 0; i < 16; ++i) { *(LAS bf16_t*)(Sw + (16 * hh + i) * SPITCH + (32 * s + r) * 2) = (bf16_t)f2bf(d[s][i]); *(LAS bf16_t*)(Sw + (16 * hh + i) * SPITCH + (64 + 32 * s + r) * 2) = (bf16_t)f2bf(d[2 + s][i]); }
                    LDS_WAIT(); CFENCE();
                    f32x16 y;
#pragma unroll
                    for (int i = 0; i < 16; ++i) y[i] = 0.f;
#pragma unroll
                    for (int ks = 0; ks < 8; ++ks) { const bf16x8 sf = *(const LAS bf16x8*)(Sw + r * SPITCH + (16 * ks + 8 * hh) * 2); y = __builtin_amdgcn_mfma_f32_32x32x16_bf16(cfr[ks], sf, y, 0, 0, 0); }
                    LDS_WAIT(); CFENCE();
                    const size_t trow = rb + tk0 + r;
#pragma unroll
                    for (int q = 0; q < 2; ++q) { const int ch = 16 * g + 8 * q + 4 * hh;
                        const u32x2 hv = *(const u32x2*)(F.HB + trow * DM + ch); const f32x4 dk = *(const f32x4*)(A.in[I_SD] + ch);
                        const float y0 = gelu_tanh_f(y[4 * q + 0] + dk[0] * bflo(hv.x)), y1 = gelu_tanh_f(y[4 * q + 1] + dk[1] * bfhi(hv.x)), y2 = gelu_tanh_f(y[4 * q + 2] + dk[2] * bflo(hv.y)), y3 = gelu_tanh_f(y[4 * q + 3] + dk[3] * bfhi(hv.y));
                        u32x2 w; w.x = pk2(y0, y1); w.y = pk2(y2, y3); *(u32x2*)(G + trow * DM + ch) = w; }
                }
            }
            if (pass == 0) {
                if (hh == 1) {
#pragma unroll
                    for (int s = 0; s < 2; ++s) { ((LAS float*)(L + SL_E))[(wave * 64 + 32 * s + r) * 2] = cin_r[s]; ((LAS float*)(L + SL_E))[(wave * 64 + 32 * s + r) * 2 + 1] = cin_i[s]; } }
                cin_r[0] = cin_r[1] = cin_i[0] = cin_i[1] = 0.f;
            }
        }
    }
}

enum { PH_PRO = 0, PH_NORM0,
       L0_G1, L0_CONV, L0_G2, L0_NORM, L0_F1, L0_F2, L0_NORMN,
       L1_G1, L1_ATTN, L1_G2, L1_NORMR, L1_M1, L1_M2, L1_COMB,
       L2_SSM, L2_G2, L2_NORM, L2_F1, L2_F2, L2_NORMN,
       L3_G1, L3_CONV, L3_G2, L3_NORMR, L3_M1, L3_M2, L3_COMB, NPH };

__device__ __forceinline__ bool fresh_ids(Frame& F) { const int l = lane_id_fresh(); F.lane = l; F.tid = F.wave * 64 + l; return true; }
__global__ void __launch_bounds__(NTHREADS, 2) mega_fwd(Args args) {
    extern __shared__ __attribute__((aligned(16))) unsigned char lds_raw[];
    Frame F;
    F.lds = (LAS unsigned char*)lds_raw;
    volatile LAS unsigned* MISC = (volatile LAS unsigned*)(F.lds + MISC_OFF);
    F.tid = threadIdx.x; F.lane = F.tid & 63; F.wave = __builtin_amdgcn_readfirstlane(F.tid >> 6);
    F.G = gridDim.x; { const int bx = blockIdx.x; F.vcu = (F.G % 8 == 0) ? (bx % 8) * (F.G / 8) + bx / 8 : bx; }
    F.ws = args.ws; F.ctl = (gu32*)(args.ws + WS_CTL); F.out = args.out; F.mod = (const float*)(args.ws + WS_MOD);
    F.HB = (bf16_t*)(args.ws + WS_HB); F.BUF = (bf16_t*)(args.ws + WS_BUF); F.ACT = (bf16_t*)(args.ws + WS_ACT);
    for (int u = F.tid; u < (LDS_BYTES - LDSCTL_OFF) / 4; u += NTHREADS) ((LAS unsigned*)(F.lds + LDSCTL_OFF))[u] = 0u;
    __syncthreads();
    XcdBarrier bar; bar.bar = (unsigned*)(F.ctl + CW_BAR); bar.x = 0; bar.st = nullptr; bar.w = F.wave;
    const int lo = args.ph_lo, hi = args.ph_hi;
    if (hi - lo > 1) bar = xcd_barrier_post((unsigned*)(F.ctl + CW_BAR), MISC + 8, F.wave);
#ifndef PH_ONLY
#define PH_EN(k) true
#else
#define PH_EN(k) ((k) == PH_ONLY)
#endif
#define IN(k) (PH_EN(k) && lo <= (k) && (k) < hi && fresh_ids(F))
#define SEAM(k) do { if (IN(k) && IN((k) + 1)) xcd_barrier(bar); } while (0)
#ifndef PH_REP
#define PH_REP (-1)
#endif
#ifndef PH_REPMASK
#define PH_REPMASK 0ull
#endif
#define REPB(k, ...) do { if (PH_REP == (k) || ((PH_REPMASK >> (k)) & 1ull)) { xcd_barrier(bar); __VA_ARGS__; } } while (0)
    LAS unsigned char* ring = F.lds;
    const int cid = (int)blockIdx.x;
    bf16_t* const WCI = (bf16_t*)(F.ws + WS_WCI); bf16_t* const WCO = (bf16_t*)(F.ws + WS_WCO); bf16_t* const WAI = (bf16_t*)(F.ws + WS_WAI); bf16_t* const WAO = (bf16_t*)(F.ws + WS_WAO);
    bf16_t* const WGL = (bf16_t*)(F.ws + WS_WGL); bf16_t* const WFG = (bf16_t*)(F.ws + WS_WFG); bf16_t* const WFD = (bf16_t*)(F.ws + WS_WFD); bf16_t* const WMG = (bf16_t*)(F.ws + WS_WMG); bf16_t* const WMD = (bf16_t*)(F.ws + WS_WMD);

#define ZEROG ((const float*)(F.ws + 512 * 1024))
    const bool fuseR = (F.G == 256) && FUSE_R;
    const bool fuse = (F.G == 256) && FUSE_N;
#define FUSED_EPI(inst, gatep, xin, nl, ns, hout, asc, h8_) ({F.out, (gatep), (xin), args.in[I_NORMG] + (size_t)((nl) * 2 + (ns)) * DM, F.mod + (size_t)(nl) * NB * 6144 + ((ns) ? 3 : 0) * DM, (hout), (float*)(F.ws + WS_XS), F.ctl + CW_PAN + 64 * 64 * (inst), F.ctl + CW_TMO, (asc), (h8_)})
#define FUSED_RT(inst, gatep, nl, rl, roff, hout, h8_) ({F.out, (gatep), args.in[I_NORMG] + (size_t)((nl) * 2 + 1) * DM, F.mod + (size_t)(nl) * NB * 6144 + 3 * DM, (hout), (float*)(F.ws + WS_XS9), F.ctl + CW_PAN + 64 * 64 * (inst), F.ctl + CW_TMO, \
        args.in[I_RW] + (size_t)(rl) * DM * NEXP, args.in[I_RB] + (rl) * NEXP, F.ctl + CW_CNT + 64 * 8 * (rl), F.ws + (roff), (h8_)})
#define MODP(l, chunk) (F.mod + (size_t)(l) * NB * 6144 + (chunk) * DM)
#define GEMM_STATIC(Aptr, Bptr, Nn, Kk, EpiT, EpiInit) do { pg8::Gemm g{(Aptr), (Bptr), M, (Nn), (Kk), 0, nullptr, nullptr}; pg8::StaticOrder S; S.init(M, (Nn), F.G, cid); EpiT E EpiInit; \
        pg8::gemm_phase<EpiT, pg8::StaticOrder, false>(ring, g, S, E, F.wave); } while (0)
#define GEMM_STATIC8(Aptr, Bptr, Nn, Kk, EpiT, EpiInit) do { pg8::Gemm g{(Aptr), (Bptr), M, (Nn), (Kk), 0, nullptr, nullptr}; pg8::StaticOrder S; S.init(M, (Nn), F.G, cid); EpiT E EpiInit; \
        pg8::gemm_phase<EpiT, pg8::StaticOrder, false, true>(ring, g, S, E, F.wave); } while (0)
#define EPAIR8 pg8::EpiPair<1, (M2_FP8 != 0), (M1_FP8 != 0)>
#define M1_B (M1_FP8 ? 1 : 2)
#define EPAIR8L1 pg8::EpiPair<1, (M2_FP8 != 0), (M1L1_FP8 != 0)>
#define M2_B (M2_FP8 ? 1 : 2)
#define F2_ASC (F2_FP8 ? pg8::W8_INV : 1.0f)
#define GEMM_STATICF(Aptr, Bptr, Nn, Kk, EpiT, EpiInit) do { pg8::Gemm g{(Aptr), (Bptr), M, (Nn), (Kk), 0, nullptr, nullptr}; pg8::StaticOrder S; S.init(M, (Nn), F.G, cid); EpiT E EpiInit; \
        pg8::gemm_phase<EpiT, pg8::StaticOrder, false, (F2_FP8 != 0)>(ring, g, S, E, F.wave); } while (0)
#define EPAIRF pg8::EpiPair<1, (F2_FP8 != 0), false>
#define F0_FP8 (F2_FP8 || F2L0_FP8)
#define F2L0_ASC (F0_FP8 ? pg8::W8_INV : 1.0f)
#define EPAIR0 pg8::EpiPair<1, (F0_FP8 != 0), false>
#define EPAIR0S pg8::EpiPair<1, (F0_FP8 != 0), (F1L0_FP8 != 0)>
#define GEMM_STATICF0(Aptr, Bptr, Nn, Kk, EpiT, EpiInit) do { pg8::Gemm g{(Aptr), (Bptr), M, (Nn), (Kk), 0, nullptr, nullptr}; pg8::StaticOrder S; S.init(M, (Nn), F.G, cid); EpiT E EpiInit; \
        pg8::gemm_phase<EpiT, pg8::StaticOrder, false, (F0_FP8 != 0)>(ring, g, S, E, F.wave); } while (0)
#define W8(base, bytes) ((bf16_t*)((unsigned char*)(base) + (size_t)(bytes)))

    if (IN(PH_PRO)) { p0_prologue(F, args); REPB(PH_PRO, p0_prologue(F, args)); } SEAM(PH_PRO);
    if (IN(PH_NORM0)) { thin_phase<4>(F, args, args.in[I_X], 0, 0, 0, 0); REPB(PH_NORM0, thin_phase<4>(F, args, args.in[I_X], 0, 0, 0, 0)); } SEAM(PH_NORM0);

    if (IN(L0_G1)) { GEMM_STATIC(F.HB, WCI, 3072, DM, pg8::EpiConvIn, {F.BUF}); REPB(L0_G1, GEMM_STATIC(F.HB, WCI, 3072, DM, pg8::EpiConvIn, {F.BUF})); } SEAM(L0_G1);
    if (IN(L0_CONV)) { conv_phase(F, args.in[I_CW]); REPB(L0_CONV, conv_phase(F, args.in[I_CW])); } SEAM(L0_CONV);
    if (IN(L0_G2)) { if (fuse) GEMM_STATIC(F.HB, WCO, DM, DM, pg8::EpiResNorm, FUSED_EPI(0, MODP(0, 2), args.in[I_X], 0, 1, (fuse ? F.BUF : F.HB), 1.0f, F1L0_FP8)); else GEMM_STATIC(F.HB, WCO, DM, DM, pg8::EpiRes, ({F.out, MODP(0, 2), args.in[I_X], 1.0f})); } SEAM(L0_G2);
    if (!fuse) { if (IN(L0_NORM)) { thin_phase<4>(F, args, F.out, 0, 1, 0, 0); } SEAM(L0_NORM); }
    if (IN(L0_F1)) { pg8::Gemm g{(fuse ? F.BUF : F.HB), WFG, M, 2 * FF, DM, 0, nullptr, nullptr}; pg8::StaticOrder S; S.init(M, 2 * FF, F.G, cid); EPAIR0S E{F.ACT, FF};
        pg8::gemm_phase<EPAIR0S, pg8::StaticOrder, false, (F1L0_FP8 != 0)>(ring, g, S, E, F.wave); } SEAM(L0_F1);
    if (IN(L0_F2)) { if (fuse) GEMM_STATICF0(F.ACT, WFD, DM, FF, pg8::EpiResNorm, FUSED_EPI(1, MODP(0, 5), F.out, 1, 0, F.HB, F2L0_ASC, 0)); else GEMM_STATICF0(F.ACT, WFD, DM, FF, pg8::EpiRes, ({F.out, MODP(0, 5), F.out, F2L0_ASC})); } SEAM(L0_F2);
    if (!fuse) { if (IN(L0_NORMN)) { thin_phase<4>(F, args, F.out, 1, 0, 0, 0); } SEAM(L0_NORMN); }

    if (IN(L1_G1)) { GEMM_STATIC(F.HB, WAI, ATT_NP, DM, pg8::EpiAttnIn, ({(bf16_t*)(F.ws + WS_Q), (bf16_t*)(F.ws + WS_K), (bf16_t*)(F.ws + WS_V), (bf16_t*)(F.ws + WS_QI), (bf16_t*)(F.ws + WS_KI), (float*)(F.ws + WS_WI), args.in[I_QG], args.in[I_KG]})); REPB(L1_G1, GEMM_STATIC(F.HB, WAI, ATT_NP, DM, pg8::EpiAttnIn, ({(bf16_t*)(F.ws + WS_Q), (bf16_t*)(F.ws + WS_K), (bf16_t*)(F.ws + WS_V), (bf16_t*)(F.ws + WS_QI), (bf16_t*)(F.ws + WS_KI), (float*)(F.ws + WS_WI), args.in[I_QG], args.in[I_KG]}))); } SEAM(L1_G1);
    if (IN(L1_ATTN)) { attn_phase(F, args); REPB(L1_ATTN, attn_phase(F, args)); } SEAM(L1_ATTN);
    if (IN(L1_G2)) { if (fuseR) GEMM_STATIC((bf16_t*)(F.ws + WS_O), WAO, DM, DM, pg8::EpiResNormRouter, FUSED_RT(3, MODP(1, 2), 1, 0, 0, F.HB, M1L1_FP8)); else GEMM_STATIC((bf16_t*)(F.ws + WS_O), WAO, DM, DM, pg8::EpiRes, ({F.out, MODP(1, 2), F.out, 1.0f})); } SEAM(L1_G2);
    if (!fuseR) { if (IN(L1_NORMR)) { thin_phase<4 | 8>(F, args, F.out, 1, 1, 0, 0); } SEAM(L1_NORMR); }
    if (IN(L1_M1)) { pg8::Gemm g{F.HB, WMG, M, 2 * FF, DM, (size_t)2 * FF * DM * (M1L1_FP8 ? 1 : 2), (const int*)(F.ws + WS_ROWIDX), (const unsigned*)(F.ctl + CW_CNT)}; pg8::MoeOrder S; S.init((const unsigned*)(F.ctl + CW_CNT), 22, F.G, cid);
        EPAIR8L1 E{F.ACT, FF}; pg8::gemm_phase<EPAIR8L1, pg8::MoeOrder, true, (M1L1_FP8 != 0)>(ring, g, S, E, F.wave); REPB(L1_M1, pg8::gemm_phase<EPAIR8L1, pg8::MoeOrder, true, (M1L1_FP8 != 0)>(ring, g, S, E, F.wave)); } SEAM(L1_M1);
    if (IN(L1_M2)) { pg8::Gemm g{F.ACT, WMD, M, DM, FF, (size_t)DM * FF * M2_B, nullptr, nullptr}; pg8::MoeOrder S; S.init((const unsigned*)(F.ctl + CW_CNT), 4, F.G, cid);
        pg8::EpiMoeDn E{F.BUF, (const float*)(F.ws + WS_GATEP)}; pg8::gemm_phase<pg8::EpiMoeDn, pg8::MoeOrder, false, (M2_FP8 != 0)>(ring, g, S, E, F.wave); REPB(L1_M2, pg8::gemm_phase<pg8::EpiMoeDn, pg8::MoeOrder, false, (M2_FP8 != 0)>(ring, g, S, E, F.wave)); } SEAM(L1_M2);
    if (IN(L1_COMB)) { thin_phase<2 | 4>(F, args, F.out, 2, 0, 1, 0); REPB(L1_COMB, thin_phase<2 | 4>(F, args, F.out, 2, 0, -1, 0)); } SEAM(L1_COMB);

    if (IN(L2_SSM)) { ssm_phase(F, args); REPB(L2_SSM, ssm_phase(F, args)); } SEAM(L2_SSM);
    if (IN(L2_G2)) { GEMM_STATIC(F.ACT, WGL, 2048, DM, pg8::EpiGluRes, ({F.out, MODP(2, 2)})); REPB(L2_G2, GEMM_STATIC(F.ACT, WGL, 2048, DM, pg8::EpiGluRes, ({F.out, ZEROG}))); } SEAM(L2_G2);
    if (IN(L2_NORM)) { thin_phase<4>(F, args, F.out, 2, 1, 0, 0); REPB(L2_NORM, thin_phase<4>(F, args, F.out, 2, 1, 0, 0)); } SEAM(L2_NORM);
    if (IN(L2_F1)) { GEMM_STATIC(F.HB, WFG + (size_t)2 * FF * DM, 2 * FF, DM, EPAIRF, ({F.ACT, FF})); REPB(L2_F1, GEMM_STATIC(F.HB, WFG + (size_t)2 * FF * DM, 2 * FF, DM, EPAIRF, ({F.ACT, FF}))); } SEAM(L2_F1);
    if (IN(L2_F2)) { if (fuse) GEMM_STATICF(F.ACT, W8(WFD, (size_t)DM * FF * (F2_FP8 ? 1 : 2)), DM, FF, pg8::EpiResNorm, FUSED_EPI(2, MODP(2, 5), F.out, 3, 0, F.HB, F2_ASC, 0)); else GEMM_STATICF(F.ACT, W8(WFD, (size_t)DM * FF * (F2_FP8 ? 1 : 2)), DM, FF, pg8::EpiRes, ({F.out, MODP(2, 5), F.out, F2_ASC})); } SEAM(L2_F2);
    if (!fuse) { if (IN(L2_NORMN)) { thin_phase<4>(F, args, F.out, 3, 0, 0, 0); } SEAM(L2_NORMN); }

    if (IN(L3_G1)) { GEMM_STATIC(F.HB, WCI + (size_t)3072 * DM, 3072, DM, pg8::EpiConvIn, {F.BUF}); REPB(L3_G1, GEMM_STATIC(F.HB, WCI + (size_t)3072 * DM, 3072, DM, pg8::EpiConvIn, {F.BUF})); } SEAM(L3_G1);
    if (IN(L3_CONV)) { conv_phase(F, args.in[I_CW] + 3 * DM); REPB(L3_CONV, conv_phase(F, args.in[I_CW] + 3 * DM)); } SEAM(L3_CONV);
    if (IN(L3_G2)) { if (fuseR) GEMM_STATIC(F.HB, WCO + (size_t)DM * DM, DM, DM, pg8::EpiResNormRouter, FUSED_RT(4, MODP(3, 2), 3, 1, 2 * MiB, F.BUF, M1_FP8)); else GEMM_STATIC(F.HB, WCO + (size_t)DM * DM, DM, DM, pg8::EpiRes, ({F.out, MODP(3, 2), F.out, 1.0f})); } SEAM(L3_G2);
    if (!fuseR) { if (IN(L3_NORMR)) { thin_phase<4 | 8>(F, args, F.out, 3, 1, 0, 1, 1, 2 * MiB); } SEAM(L3_NORMR); }
    if (IN(L3_M1)) { pg8::Gemm g{(fuseR ? F.BUF : F.HB), W8(WMG, (size_t)8 * 2 * FF * DM * 2), M, 2 * FF, DM, (size_t)2 * FF * DM * M1_B, (const int*)(F.ws + 2 * MiB + WS_ROWIDX), (const unsigned*)(F.ctl + CW_CNT + 512)}; pg8::MoeOrder S; S.init((const unsigned*)(F.ctl + CW_CNT + 512), 22, F.G, cid);
        EPAIR8 E{F.ACT, FF}; pg8::gemm_phase<EPAIR8, pg8::MoeOrder, true, (M1_FP8 != 0)>(ring, g, S, E, F.wave); REPB(L3_M1, pg8::gemm_phase<EPAIR8, pg8::MoeOrder, true, (M1_FP8 != 0)>(ring, g, S, E, F.wave)); } SEAM(L3_M1);
    if (IN(L3_M2)) { pg8::Gemm g{F.ACT, W8(WMD, (size_t)8 * DM * FF * M2_B), M, DM, FF, (size_t)DM * FF * M2_B, nullptr, nullptr}; pg8::MoeOrder S; S.init((const unsigned*)(F.ctl + CW_CNT + 512), 4, F.G, cid);
        pg8::EpiMoeDn E{F.BUF, (const float*)(F.ws + 2 * MiB + WS_GATEP)}; pg8::gemm_phase<pg8::EpiMoeDn, pg8::MoeOrder, false, (M2_FP8 != 0)>(ring, g, S, E, F.wave); REPB(L3_M2, pg8::gemm_phase<pg8::EpiMoeDn, pg8::MoeOrder, false, (M2_FP8 != 0)>(ring, g, S, E, F.wave)); } SEAM(L3_M2);
    if (IN(L3_COMB)) { thin_phase<2>(F, args, F.out, 0, 0, 3, 1, 1, 2 * MiB); }
#undef IN
#undef SEAM
}

extern "C" void kernel_launch(void* const* d_in, const int* in_sizes, int n_in, void* d_out, int out_size, void* d_ws, size_t ws_size, hipStream_t stream) {
    static int grid = 0;
    if (grid == 0) {
        if (n_in != 28 || in_sizes[0] != M * DM || out_size != M * DM || ws_size < WS_END) { fprintf(stderr, "kernel_launch: unexpected shapes / workspace (n_in %d, ws %zu, need %zu)\n", n_in, ws_size, (size_t)WS_END); grid = -1; return; }
        int dev = 0, cus = 0, per_cu = 0;
        if (hipGetDevice(&dev) != hipSuccess || hipDeviceGetAttribute(&cus, hipDeviceAttributeMultiprocessorCount, dev) != hipSuccess) { grid = -1; return; }
        if (hipFuncSetAttribute((const void*)mega_fwd, hipFuncAttributeMaxDynamicSharedMemorySize, LDS_BYTES) != hipSuccess) { fprintf(stderr, "kernel_launch: hipFuncSetAttribute failed\n"); grid = -1; return; }
        if (hipOccupancyMaxActiveBlocksPerMultiprocessor(&per_cu, (const void*)mega_fwd, NTHREADS, LDS_BYTES) != hipSuccess || per_cu < 1) fprintf(stderr, "kernel_launch: occupancy query reports %d\n", per_cu);
        (void)hipGetLastError();
        grid = cus;
    }
    if (grid < 0) return;
    (void)hipMemsetAsync((char*)d_ws + WS_CTL, 0, CTL_ZERO_BYTES, stream);
    Args a{};
    for (int i = 0; i < 28; ++i) a.in[i] = (const float*)d_in[i];
    a.out = (float*)d_out; a.ws = (unsigned char*)d_ws;
#if MK_PER_PHASE
    for (int p = 0; p < NPH; ++p) { a.ph_lo = p; a.ph_hi = p + 1; hipLaunchKernelGGL(mega_fwd, dim3(grid), dim3(NTHREADS), LDS_BYTES, stream, a); }
#else
    a.ph_lo = 0; a.ph_hi = NPH; hipLaunchKernelGGL(mega_fwd, dim3(grid), dim3(NTHREADS), LDS_BYTES, stream, a);
#endif
}
```

```cpp
#include <hip/hip_runtime.h>
#include <cstdio>
#include <cstdint>
#include <cmath>

#ifndef MK_PER_PHASE
#define MK_PER_PHASE 0
#endif

#define GAS __attribute__((address_space(1)))
#define LAS __attribute__((address_space(3)))
typedef unsigned short bf16_t;
typedef short bf16x8 __attribute__((ext_vector_type(8)));
typedef float f32x4 __attribute__((ext_vector_type(4)));
typedef float f32x2 __attribute__((ext_vector_type(2)));
typedef float f32x16 __attribute__((ext_vector_type(16)));
typedef unsigned u32x4 __attribute__((ext_vector_type(4)));
typedef unsigned u32x2 __attribute__((ext_vector_type(2)));
typedef GAS unsigned gu32;
#define RLX_AGENT __ATOMIC_RELAXED, __HIP_MEMORY_SCOPE_AGENT
#define LDS_WAIT() asm volatile("s_waitcnt lgkmcnt(0)" ::: "memory")
#define VM_WAIT() asm volatile("s_waitcnt vmcnt(0)" ::: "memory")
#define CFENCE() asm volatile("" ::: "memory")

constexpr int DM = 1024, NB = 4, SEQ = 4096, M = NB * SEQ, FF = 2816, NEXP = 8;
constexpr int NH = 16, NKV = 4, HD = 64, IH = 8, IDIM = 64, TOPK = 256;
constexpr int ATT_N = 2120, ATT_NP = 2304;
constexpr float EPS = 1e-6f;
constexpr int NWAVES = 8, NTHREADS = 512;

__device__ __forceinline__ unsigned f2bf(float f) { unsigned u = __builtin_bit_cast(unsigned, f); return (u + 0x7fffu + ((u >> 16) & 1u)) >> 16; }
__device__ __forceinline__ unsigned pk2(float lo, float hi) { return f2bf(lo) | (f2bf(hi) << 16); }
__device__ __forceinline__ unsigned cvt_pk_bf16(float lo, float hi) { unsigned r; asm volatile("v_cvt_pk_bf16_f32 %0, %1, %2" : "=v"(r) : "v"(lo), "v"(hi)); return r; }
__device__ __forceinline__ float bflo(unsigned u) { return __uint_as_float(u << 16); }
__device__ __forceinline__ float bfhi(unsigned u) { return __uint_as_float(u & 0xffff0000u); }
__device__ __forceinline__ float wave_sum(float v) {
#pragma unroll
    for (int o = 1; o < 64; o <<= 1) v += __shfl_xor(v, o);
    return v;
}
__device__ __forceinline__ float fast_rcp(float x) { return __builtin_amdgcn_rcpf(x); }
__device__ __forceinline__ float silu_f(float g) { return g * fast_rcp(1.f + __expf(-g)); }
__device__ __forceinline__ float sigmoid_f(float g) { return fast_rcp(1.f + __expf(-g)); }
__device__ __forceinline__ float gelu_tanh_f(float y) { const float z = 0.7978845608028654f * (y + 0.044715f * y * y * y); const float t = 1.f - 2.f * fast_rcp(__expf(2.f * z) + 1.f); return 0.5f * y * (1.f + t); }

constexpr size_t WS_ROWIDX_B = 2u << 20, WS_GATEP_B = (2u << 20) + 512 * 1024, WS_SLOT_B = 3u << 20;
__device__ __forceinline__ int lane_id_fresh() { int l; asm volatile("v_mbcnt_lo_u32_b32 %0, -1, 0\n\tv_mbcnt_hi_u32_b32 %0, -1, %0" : "=v"(l)); return l; }
#ifndef FUSE_R
#define FUSE_R 1
#endif
#ifndef FUSE_N
#define FUSE_N 1
#endif
#ifndef M2_FP8
#define M2_FP8 1
#endif
#ifndef F1L0_FP8
#define F1L0_FP8 1
#endif
#ifndef M1L1_FP8
#define M1L1_FP8 1
#endif
#ifndef M1_FP8
#define M1_FP8 1
#endif
#ifndef F2L0_FP8
#define F2L0_FP8 1
#endif
#ifndef F2_FP8
#define F2_FP8 1
#endif
namespace pg8 {
constexpr int BM = 256, BK = 64, HALF = 128, HTB = HALF * BK * 2, STAGE_BYTES = 8 * HTB, NXCD = 8, WGM = 8;
__host__ __device__ __forceinline__ int lds_byte(int r, int c) { const int st = (r >> 4) * 2 + (c >> 5), rr = r & 15, cc = c & 31, ob = rr * 64 + cc * 2; return st * 1024 + (ob ^ (((ob >> 9) & 1) << 5)); }
__host__ __device__ __forceinline__ void stage_rc(int b, int& R, int& C) { const int st = b / 1024, sb = b % 1024, swz = sb ^ (((sb >> 9) & 1) << 5); R = (st >> 1) * 16 + swz / 64; C = (st & 1) * 32 + (swz % 64) / 2; }
__host__ __device__ __forceinline__ int perm32(int rho) { const int n = rho >> 4, i = rho & 15; return 8 * (i >> 2) + 4 * n + (i & 3); }

struct Unit { int pm, pn, e, aux; };
struct Gemm { const bf16_t* A; const bf16_t* Bt; int M, N, K; size_t bstride_e; const int* rowidx; const unsigned* cnt; };

struct StaticOrder {
    int nM, nN, nwg, G, c;
    __device__ __forceinline__ void init(int M_, int N_, int G_, int c_) { nM = M_ / BM; nN = N_ / BM; nwg = nM * nN; G = G_; c = c_; }
    __device__ __forceinline__ bool next(int i, Unit& u) const {
        const long L = (long)i * G + c; if (L >= nwg) return false;
        int wgid = (int)L; { const int q = nwg / NXCD, r = nwg % NXCD, xcd = wgid % NXCD, off = wgid / NXCD; wgid = (xcd < r ? xcd * (q + 1) : r * (q + 1) + (xcd - r) * q) + off; }
        const int nig = WGM * nN, gid = wgid / nig, fm = gid * WGM, gsz = (nM - fm) < WGM ? (nM - fm) : WGM;
        u.pm = fm + ((wgid % nig) % gsz); u.pn = (wgid % nig) / gsz; u.e = 0; u.aux = 0; return true;
    }
};
struct MoeOrder {
    int T1, T2, T3, T4, T5, T6, T7, T8, NT, W, r, lo, ntl;
    static constexpr int RG = 4;
    __device__ __forceinline__ void init(const unsigned* cnt, int NT_, int G_, int c_) {
        int t[9]; int acc = 0;
#pragma unroll
        for (int e = 0; e < 8; ++e) { t[e] = acc; acc += (int)((__hip_atomic_load(cnt + 64 * e, RLX_AGENT) + 255u) >> 8); }
        t[8] = acc; T1 = t[1]; T2 = t[2]; T3 = t[3]; T4 = t[4]; T5 = t[5]; T6 = t[6]; T7 = t[7]; T8 = t[8]; NT = NT_;
        if (G_ % 8 == 0) { const int xv = c_ % 8; W = G_ / 8; r = c_ / 8; lo = (T8 * xv) / 8; ntl = (T8 * (xv + 1)) / 8 - lo; }
        else { W = G_; r = c_; lo = 0; ntl = T8; }
    }
    __device__ __forceinline__ bool next(int i, Unit& u) const {
        const int q = i * W + r; if (q >= ntl * NT) return false;
        const int nig = RG * NT, gid = q / nig, fm = gid * RG, gsz = (ntl - fm) < RG ? (ntl - fm) : RG, w = q - gid * nig;
        const int tt = lo + fm + (w % gsz), pn = w / gsz;
        int e = 0, te = 0;
        if (tt >= T1) { e = 1; te = T1; } if (tt >= T2) { e = 2; te = T2; } if (tt >= T3) { e = 3; te = T3; } if (tt >= T4) { e = 4; te = T4; }
        if (tt >= T5) { e = 5; te = T5; } if (tt >= T6) { e = 6; te = T6; } if (tt >= T7) { e = 7; te = T7; }
        u.pm = tt; u.pn = pn; u.e = e; u.aux = e * 16384 + 256 * (tt - te); return true;
    }
};

typedef int v8i32 __attribute__((ext_vector_type(8)));
typedef int v4i32 __attribute__((ext_vector_type(4)));
constexpr float W8_MUL = 32.0f, W8_INV = 1.0f / 32.0f;
__device__ __forceinline__ void mfma8(f32x4& c, const v8i32 a, const v8i32 b) { asm volatile("v_mfma_f32_16x16x128_f8f6f4 %0, %1, %2, %0" : "+v"(c) : "v"(a), "v"(b)); }
__device__ __forceinline__ v8i32 cat8(const bf16x8 a, const bf16x8 b) { return __builtin_shufflevector(__builtin_bit_cast(v4i32, a), __builtin_bit_cast(v4i32, b), 0, 1, 2, 3, 4, 5, 6, 7); }
template <class Epi, class Sched, bool GATHER, bool FP8 = false>
__device__ __forceinline__ void gemm_phase(LAS unsigned char* lds, const Gemm g, const Sched& S, const Epi& E, const int wid) {
    const int lane = lane_id_fresh(), tid = wid * 64 + lane, wr = wid >> 2, wc = wid & 3, fr = lane & 15, fq = lane >> 4;
    const int K = FP8 ? g.K / 2 : g.K, nt = K / BK;
    unsigned voffB[2]; int stR[2], stC[2];
#pragma unroll
    for (int i = 0; i < 2; ++i) { int R, C; stage_rc(tid * 16 + i * 8192, R, C); const int Rb = (R & ~31) + perm32(R & 31);
        stR[i] = R; stC[i] = C; voffB[i] = (unsigned)(Rb * K + C) * 2u; }
    const size_t kstep = (size_t)(BK * 2);
    const size_t hstep = (size_t)HALF * K * 2;
    const size_t tstep = 2 * hstep;
    const unsigned ldsw = (unsigned)wid * 1024u;
    const int aoff = lds_byte(wr * 64 + fr, fq * 8), boff = lds_byte(wc * 32 + fr, fq * 8);
#define PG8_SA(b, h) (((b) * 2 + (h)) * HTB)
#define PG8_SB(b, h) ((4 + (b) * 2 + (h)) * HTB)
#define PG8_STAGE(bufoff, gbase, voff) do { _Pragma("unroll") for (int _i = 0; _i < 2; ++_i) \
        __builtin_amdgcn_global_load_lds((const unsigned*)((const char*)(gbase) + (voff)[_i]), (LAS unsigned*)(lds + (bufoff) + ldsw + _i * 8192), 16, 0, 0); } while (0)
#define PG8_LDA(dst, b, h) do { _Pragma("unroll") for (int m = 0; m < 4; ++m) _Pragma("unroll") for (int k = 0; k < 2; ++k) dst[m][k] = *(const LAS bf16x8*)(lds + PG8_SA(b, h) + aoff + m * 2048 + k * 1024); } while (0)
#define PG8_LDB(dst, b, h) do { _Pragma("unroll") for (int n = 0; n < 2; ++n) _Pragma("unroll") for (int k = 0; k < 2; ++k) dst[n][k] = *(const LAS bf16x8*)(lds + PG8_SB(b, h) + boff + n * 2048 + k * 1024); } while (0)
#define PG8_MMA(ai, bj, At, Bt) do { __builtin_amdgcn_s_setprio(1); _Pragma("unroll") for (int m = 0; m < 4; ++m) _Pragma("unroll") for (int n = 0; n < 2; ++n) { \
        if (FP8) mfma8(acc[ai][bj][m][n], cat8(Bt[n][0], Bt[n][1]), cat8(At[m][0], At[m][1])); \
        else { _Pragma("unroll") for (int k = 0; k < 2; ++k) acc[ai][bj][m][n] = __builtin_amdgcn_mfma_f32_16x16x32_bf16(Bt[n][k], At[m][k], acc[ai][bj][m][n], 0, 0, 0); } } \
        __builtin_amdgcn_s_setprio(0); } while (0)
#define PG8_MMA_END(At, B0, B1) do { if (FP8) { asm volatile("s_nop 15\n\ts_nop 15\n\ts_nop 15\n\ts_nop 15" :: "v"(cat8(At[0][0], At[0][1])), "v"(cat8(At[1][0], At[1][1])), "v"(cat8(At[2][0], At[2][1])), "v"(cat8(At[3][0], At[3][1])), \
        "v"(cat8(B0[0][0], B0[0][1])), "v"(cat8(B0[1][0], B0[1][1])), "v"(cat8(B1[0][0], B1[0][1])), "v"(cat8(B1[1][0], B1[1][1]))); } } while (0)
#define PG8_WAIT_V(n) asm volatile("s_waitcnt vmcnt(" #n ")" ::: "memory")
#define PG8_WAIT_L(n) asm volatile("s_waitcnt lgkmcnt(" #n ")" ::: "memory")
#define PG8_BAR __builtin_amdgcn_s_barrier()
#define PG8_SCHED __builtin_amdgcn_sched_barrier(0)
#define PG8_AOFFS(v, U) do { _Pragma("unroll") for (int _h = 0; _h < 2; ++_h) _Pragma("unroll") for (int _i = 0; _i < 2; ++_i) { \
        if (GATHER) { const int _loc = ((U).aux & 16383) + _h * HALF + stR[_i]; const int _e = (U).aux >> 14; \
            const int _row = (_loc < (int)g.cnt[64 * _e]) ? g.rowidx[(U).aux + _h * HALF + stR[_i]] : 0; \
            v[_h][_i] = (unsigned)(_row * K + stC[_i]) * 2u; } \
        else v[_h][_i] = (unsigned)((_h * HALF + stR[_i]) * K + stC[_i]) * 2u; } } while (0)
    int cn8[8];
#pragma unroll
    for (int e = 0; e < 8; ++e) cn8[e] = GATHER ? __builtin_amdgcn_readfirstlane((int)g.cnt[64 * e]) : 0;
    Unit cur, nxt; int ui = 0;
    if (!S.next(0, cur)) return;
    f32x4 acc[2][2][4][2];
#pragma unroll
    for (int a = 0; a < 2; ++a)
#pragma unroll
        for (int b = 0; b < 2; ++b)
#pragma unroll
            for (int m = 0; m < 4; ++m)
#pragma unroll
                for (int n = 0; n < 2; ++n) acc[a][b][m][n] = (f32x4){0.f, 0.f, 0.f, 0.f};
    bf16x8 At[4][2], B0[2][2], B1[2][2];
    unsigned vAc[2][2], vAn[2][2];
    PG8_AOFFS(vAc, cur);
    const char* cA = (const char*)g.A + (GATHER ? (size_t)0 : (size_t)cur.pm * tstep);
    const char* cB = (const char*)g.Bt + (size_t)cur.e * g.bstride_e + (size_t)cur.pn * tstep;
    PG8_STAGE(PG8_SB(0, 0), cB, voffB); PG8_STAGE(PG8_SB(0, 1), cB + hstep, voffB); PG8_STAGE(PG8_SA(0, 0), cA, vAc[0]); PG8_STAGE(PG8_SA(0, 1), cA, vAc[1]);
    if (wr == 1) PG8_BAR;
    PG8_WAIT_V(2); PG8_BAR;
    PG8_STAGE(PG8_SB(1, 0), cB + kstep, voffB); PG8_STAGE(PG8_SA(1, 0), cA + kstep, vAc[0]); PG8_STAGE(PG8_SB(1, 1), cB + hstep + kstep, voffB);
    PG8_WAIT_V(6); PG8_BAR;
    for (;;) {
        const bool has_next = S.next(ui + 1, nxt);
        const char* nA = cA; const char* nB = cB;
        int rn[2][2];
        if (has_next) { if (GATHER) {
#pragma unroll
                for (int h = 0; h < 2; ++h)
#pragma unroll
                    for (int i = 0; i < 2; ++i) rn[h][i] = g.rowidx[nxt.aux + h * HALF + stR[i]]; }
            else PG8_AOFFS(vAn, nxt);
            nA = (const char*)g.A + (GATHER ? (size_t)0 : (size_t)nxt.pm * tstep); nB = (const char*)g.Bt + (size_t)nxt.e * g.bstride_e + (size_t)nxt.pn * tstep; }
        else {
#pragma unroll
            for (int h = 0; h < 2; ++h)
#pragma unroll
                for (int i = 0; i < 2; ++i) vAn[h][i] = vAc[h][i];
        }
#pragma nounroll
        for (int t = 0; t < nt; t += 2) {
            const bool last = (t == nt - 2);
            const char* a1 = cA + (size_t)(t + 1) * kstep;
            const char* a2 = last ? nA : cA + (size_t)(t + 2) * kstep; const char* b2 = last ? nB : cB + (size_t)(t + 2) * kstep;
            const char* a3 = a2 + kstep; const char* b3 = b2 + kstep;
            if (GATHER && last && has_next) { const int _e = nxt.aux >> 14;
                const int _cn = _e == 0 ? cn8[0] : _e == 1 ? cn8[1] : _e == 2 ? cn8[2] : _e == 3 ? cn8[3] : _e == 4 ? cn8[4] : _e == 5 ? cn8[5] : _e == 6 ? cn8[6] : cn8[7];
#pragma unroll
                for (int h = 0; h < 2; ++h)
#pragma unroll
                    for (int i = 0; i < 2; ++i) { int r_ = rn[h][i]; asm volatile("" : "+v"(r_)); const int _loc = (nxt.aux & 16383) + h * HALF + stR[i];
                        r_ = _loc < _cn ? r_ : 0; vAn[h][i] = (unsigned)(r_ * K + stC[i]) * 2u; } }
            unsigned v2[2][2];
#pragma unroll
            for (int h = 0; h < 2; ++h)
#pragma unroll
                for (int i = 0; i < 2; ++i) v2[h][i] = last ? vAn[h][i] : vAc[h][i];
            PG8_LDB(B0, 0, 0); PG8_LDB(B1, 0, 1); PG8_SCHED; PG8_LDA(At, 0, 0); PG8_STAGE(PG8_SA(1, 1), a1, vAc[1]);
            PG8_WAIT_V(8); PG8_WAIT_L(0); PG8_BAR; PG8_MMA(0, 0, At, B0); PG8_MMA(0, 1, At, B1); PG8_MMA_END(At, B0, B1); PG8_BAR; PG8_SCHED;
            PG8_LDA(At, 0, 1); PG8_STAGE(PG8_SB(0, 0), b2, voffB); PG8_STAGE(PG8_SB(0, 1), b2 + hstep, voffB); PG8_STAGE(PG8_SA(0, 0), a2, v2[0]);
            PG8_WAIT_V(8); PG8_WAIT_L(0); PG8_BAR; PG8_MMA(1, 0, At, B0); PG8_MMA(1, 1, At, B1); PG8_MMA_END(At, B0, B1); PG8_BAR; PG8_SCHED;
            PG8_LDB(B0, 1, 0); PG8_LDB(B1, 1, 1); PG8_SCHED; PG8_LDA(At, 1, 0); PG8_STAGE(PG8_SA(0, 1), a2, v2[1]);
            PG8_WAIT_V(8); PG8_WAIT_L(0); PG8_BAR; PG8_MMA(0, 0, At, B0); PG8_MMA(0, 1, At, B1); PG8_MMA_END(At, B0, B1); PG8_BAR; PG8_SCHED;
            PG8_LDA(At, 1, 1); PG8_STAGE(PG8_SB(1, 0), b3, voffB); PG8_STAGE(PG8_SB(1, 1), b3 + hstep, voffB); PG8_STAGE(PG8_SA(1, 0), a3, v2[0]);
            PG8_WAIT_V(8); PG8_WAIT_L(0); PG8_BAR; PG8_MMA(1, 0, At, B0); PG8_MMA(1, 1, At, B1); PG8_MMA_END(At, B0, B1); PG8_BAR; PG8_SCHED;
        }
        if (wr == 0) PG8_BAR;
        if (FP8) asm volatile("s_nop 15\n\ts_nop 15\n\ts_nop 15\n\ts_nop 15\n\ts_nop 15\n\ts_nop 15" ::: "memory");
        if constexpr (!Epi::FUSED) E(acc, cur, wr, wc, fr, fq);
        if (!has_next) break;
#pragma unroll
        for (int a = 0; a < 2; ++a)
#pragma unroll
            for (int b = 0; b < 2; ++b)
#pragma unroll
                for (int m = 0; m < 4; ++m)
#pragma unroll
                    for (int n = 0; n < 2; ++n) acc[a][b][m][n] = (f32x4){0.f, 0.f, 0.f, 0.f};
        cur = nxt; cA = nA; cB = nB; ++ui;
#pragma unroll
        for (int h = 0; h < 2; ++h)
#pragma unroll
            for (int i = 0; i < 2; ++i) vAc[h][i] = vAn[h][i];
        if (wr == 1) PG8_BAR;
    }
    PG8_WAIT_V(0);
    PG8_BAR;
    if constexpr (Epi::FUSED) E.fused(acc, cur, wr, wc, fr, fq, lds, wid, lane);
#undef PG8_SA
#undef PG8_SB
#undef PG8_STAGE
#undef PG8_LDA
#undef PG8_LDB
#undef PG8_MMA
#undef PG8_MMA_END
#undef PG8_WAIT_V
#undef PG8_WAIT_L
#undef PG8_BAR
#undef PG8_SCHED
#undef PG8_AOFFS
}

__device__ __forceinline__ f32x4 ldx16(const float* p) { return *(const f32x4*)p; }
typedef f32x4 Acc[2][2][4][2];
__device__ __forceinline__ u32x4 pack8(const f32x4 a, const f32x4 b) { u32x4 w; w.x = cvt_pk_bf16(a[0], a[1]); w.y = cvt_pk_bf16(a[2], a[3]); w.z = cvt_pk_bf16(b[0], b[1]); w.w = cvt_pk_bf16(b[2], b[3]); return w; }

template <int MODE, bool OUT8 = false, bool SC8 = OUT8> struct EpiPair {
    static constexpr bool FUSED = false;
    bf16_t* O; int ldo;
    __device__ __forceinline__ void operator()(const Acc& acc, const Unit& u, int wr, int wc, int fr, int fq) const {
        const int row0 = u.pm * BM + wr * 64 + fr, col0 = u.pn * HALF + wc * 32 + 8 * fq;
#pragma unroll
        for (int ai = 0; ai < 2; ++ai)
#pragma unroll
            for (int m = 0; m < 4; ++m) { f32x4 r0, r1;
#pragma unroll
                for (int e = 0; e < 4; ++e) { const float sc8 = SC8 ? W8_INV : 1.0f; const float a0 = acc[ai][0][m][0][e] * sc8, a1 = acc[ai][0][m][1][e] * sc8, b0 = acc[ai][1][m][0][e] * sc8, b1 = acc[ai][1][m][1][e] * sc8;
                    r0[e] = (MODE == 1 ? silu_f(a0) : a0) * b0; r1[e] = (MODE == 1 ? silu_f(a1) : a1) * b1; }
                if (OUT8) { u32x2 w; int t0 = 0, t1 = 0; t0 = __builtin_amdgcn_cvt_pk_fp8_f32(r0[0], r0[1], t0, false); t0 = __builtin_amdgcn_cvt_pk_fp8_f32(r0[2], r0[3], t0, true);
                    t1 = __builtin_amdgcn_cvt_pk_fp8_f32(r1[0], r1[1], t1, false); t1 = __builtin_amdgcn_cvt_pk_fp8_f32(r1[2], r1[3], t1, true); w.x = (unsigned)t0; w.y = (unsigned)t1;
                    *(u32x2*)((unsigned char*)O + (size_t)(row0 + ai * HALF + m * 16) * ldo + col0) = w; }
                else *(u32x4*)(O + (size_t)(row0 + ai * HALF + m * 16) * ldo + col0) = pack8(r0, r1); }
    }
};
struct EpiConvIn {
    static constexpr bool FUSED = false;
    bf16_t* UB;
    __device__ __forceinline__ void operator()(const Acc& acc, const Unit& u, int wr, int wc, int fr, int fq) const {
        const int row0 = u.pm * BM + wr * 64 + fr;
        if (u.pn < 8) { EpiPair<0, false, false> P{UB, 2048}; P(acc, u, wr, wc, fr, fq); }
        else { const int col0 = 1024 + (u.pn - 8) * BM + wc * 32 + 8 * fq;
#pragma unroll
            for (int ai = 0; ai < 2; ++ai)
#pragma unroll
                for (int m = 0; m < 4; ++m)
#pragma unroll
                    for (int bj = 0; bj < 2; ++bj) *(u32x4*)(UB + (size_t)(row0 + ai * HALF + m * 16) * 2048 + col0 + bj * HALF) = pack8(acc[ai][bj][m][0], acc[ai][bj][m][1]); }
    }
};
struct EpiRes {
    static constexpr bool FUSED = false;
    float* X; const float* gate; const float* Xin; float asc;
    __device__ __forceinline__ void operator()(const Acc& acc, const Unit& u, int wr, int wc, int fr, int fq) const {
        const int row0 = u.pm * BM + wr * 64 + fr, col0 = u.pn * BM + wc * 32 + 8 * fq; const int b = (u.pm * BM) / SEQ;
        f32x4 gv[2][2];
#pragma unroll
        for (int bj = 0; bj < 2; ++bj)
#pragma unroll
            for (int n = 0; n < 2; ++n) gv[bj][n] = *(const f32x4*)(gate + (size_t)b * 6144 + col0 + bj * HALF + 4 * n) * asc;
#pragma unroll
        for (int ai = 0; ai < 2; ++ai) {
            f32x4 xv[4][2][2];
#pragma unroll
            for (int m = 0; m < 4; ++m) { const float* ri = Xin + (size_t)(row0 + ai * HALF + m * 16) * DM + col0;
#pragma unroll
                for (int bj = 0; bj < 2; ++bj)
#pragma unroll
                    for (int n = 0; n < 2; ++n) xv[m][bj][n] = ldx16(ri + bj * HALF + 4 * n); }
            asm volatile("" ::: "memory");
#pragma unroll
            for (int m = 0; m < 4; ++m) { float* rp = X + (size_t)(row0 + ai * HALF + m * 16) * DM + col0;
#pragma unroll
                for (int bj = 0; bj < 2; ++bj)
#pragma unroll
                    for (int n = 0; n < 2; ++n) *(f32x4*)(rp + bj * HALF + 4 * n) = xv[m][bj][n] + gv[bj][n] * acc[ai][bj][m][n]; }
            asm volatile("" ::: "memory");
        }
    }
};
struct EpiResNorm {
    static constexpr bool FUSED = true;
    float* X; const float* gate; const float* Xin; const float* ng; const float* shb; bf16_t* H; float* xs; gu32* cnt; gu32* tmo; float asc; int h8;
    __device__ __forceinline__ void fused(Acc& acc, const Unit& u, int wr, int wc, int fr, int fq, LAS unsigned char* lds, int wid, int lane) const {
        const int row0 = u.pm * BM + wr * 64 + fr, col0 = u.pn * BM + wc * 32 + 8 * fq; const int b = (u.pm * BM) / SEQ;
        LAS float* P = (LAS float*)lds; LAS float* S = (LAS float*)(lds + 4096);
        { f32x4 gv[2][2];
#pragma unroll
          for (int bj = 0; bj < 2; ++bj)
#pragma unroll
              for (int n = 0; n < 2; ++n) gv[bj][n] = *(const f32x4*)(gate + (size_t)b * 6144 + col0 + bj * HALF + 4 * n) * asc;
#pragma unroll
          for (int ai = 0; ai < 2; ++ai) {
              f32x4 xv[4][2][2];
#pragma unroll
              for (int m = 0; m < 4; ++m) { const float* ri = Xin + (size_t)(row0 + ai * HALF + m * 16) * DM + col0;
#pragma unroll
                  for (int bj = 0; bj < 2; ++bj)
#pragma unroll
                      for (int n = 0; n < 2; ++n) xv[m][bj][n] = ldx16(ri + bj * HALF + 4 * n); }
              asm volatile("" ::: "memory");
#pragma unroll
              for (int m = 0; m < 4; ++m) { float* rp = X + (size_t)(row0 + ai * HALF + m * 16) * DM + col0; float ss = 0.f;
#pragma unroll
                  for (int bj = 0; bj < 2; ++bj)
#pragma unroll
                      for (int n = 0; n < 2; ++n) { const f32x4 x = xv[m][bj][n] + gv[bj][n] * acc[ai][bj][m][n]; acc[ai][bj][m][n] = x; *(f32x4*)(rp + bj * HALF + 4 * n) = x;
                          ss += (x[0] * x[0] + x[1] * x[1]) + (x[2] * x[2] + x[3] * x[3]); }
                  ss += __shfl_xor(ss, 16); ss += __shfl_xor(ss, 32);
                  if (fq == 0) P[(ai * HALF + wr * 64 + m * 16 + fr) * 4 + wc] = ss; }
              asm volatile("" ::: "memory");
          } }
        asm volatile("s_waitcnt lgkmcnt(0)" ::: "memory"); __builtin_amdgcn_s_barrier(); asm volatile("" ::: "memory");
        const int tid = wid * 64 + lane;
        if (tid < 256) { const f32x4 p4 = *(const LAS f32x4*)(P + tid * 4); const float sp = (p4[0] + p4[1]) + (p4[2] + p4[3]);
            __hip_atomic_store((gu32*)xs + ((size_t)(u.pm * BM + tid) * 4 + u.pn), __float_as_uint(sp), RLX_AGENT); }
        asm volatile("s_waitcnt vmcnt(0)" ::: "memory");
        if (wid < 4 && lane == 0) __hip_atomic_fetch_add(cnt + 64 * u.pm, 1u, RLX_AGENT);
        if (wid == 0) { unsigned spins = 0;
            while ((unsigned)__builtin_amdgcn_readfirstlane(__hip_atomic_load(cnt + 64 * u.pm, RLX_AGENT)) < 16u) { __builtin_amdgcn_s_sleep(2);
                if (++spins > (1u << 20)) { if (lane == 0) __hip_atomic_store(tmo, 1u, RLX_AGENT); break; } } }
        asm volatile("s_waitcnt vmcnt(0) lgkmcnt(0)" ::: "memory"); __builtin_amdgcn_s_barrier(); asm volatile("" ::: "memory");
        if (tid < 256) { const GAS unsigned long long* q = (const GAS unsigned long long*)xs + (size_t)(u.pm * BM + tid) * 2;
            const unsigned long long a = __hip_atomic_load(q, RLX_AGENT), c = __hip_atomic_load(q + 1, RLX_AGENT);
            const float tot = (__uint_as_float((unsigned)a) + __uint_as_float((unsigned)(a >> 32))) + (__uint_as_float((unsigned)c) + __uint_as_float((unsigned)(c >> 32)));
            S[tid] = 1.0f / sqrtf(tot * (1.0f / DM) + EPS); }
        asm volatile("s_waitcnt vmcnt(0) lgkmcnt(0)" ::: "memory"); __builtin_amdgcn_s_barrier(); asm volatile("" ::: "memory");
        f32x4 gm[2][2], sf[2][2];
#pragma unroll
        for (int bj = 0; bj < 2; ++bj)
#pragma unroll
            for (int n = 0; n < 2; ++n) { const int c = col0 + bj * HALF + 4 * n; const f32x4 g4 = *(const f32x4*)(ng + c), s1 = *(const f32x4*)(shb + (size_t)b * 6144 + DM + c);
                gm[bj][n] = g4 * (s1 + 1.0f); sf[bj][n] = *(const f32x4*)(shb + (size_t)b * 6144 + c); }
#pragma unroll
        for (int ai = 0; ai < 2; ++ai)
#pragma unroll
            for (int m = 0; m < 4; ++m) { const float r = S[ai * HALF + wr * 64 + m * 16 + fr]; bf16_t* hp = H + (size_t)(row0 + ai * HALF + m * 16) * DM + col0;
#pragma unroll
                for (int bj = 0; bj < 2; ++bj) { const f32x4 h0 = (acc[ai][bj][m][0] * r) * gm[bj][0] + sf[bj][0], h1 = (acc[ai][bj][m][1] * r) * gm[bj][1] + sf[bj][1];
                    if (F1L0_FP8 && h8) { int t0 = 0, t1 = 0; t0 = __builtin_amdgcn_cvt_pk_fp8_f32(h0[0], h0[1], t0, false); t0 = __builtin_amdgcn_cvt_pk_fp8_f32(h0[2], h0[3], t0, true);
                        t1 = __builtin_amdgcn_cvt_pk_fp8_f32(h1[0], h1[1], t1, false); t1 = __builtin_amdgcn_cvt_pk_fp8_f32(h1[2], h1[3], t1, true); u32x2 w; w.x = (unsigned)t0; w.y = (unsigned)t1;
                        *(u32x2*)((unsigned char*)H + (size_t)(row0 + ai * HALF + m * 16) * DM + col0 + bj * HALF) = w; }
                    else *(u32x4*)(hp + bj * HALF) = pack8(h0, h1); } }
    }
};
struct EpiResNormRouter {
    static constexpr bool FUSED = true;
    float* X; const float* gate; const float* ng; const float* shb; bf16_t* H; float* xs9; gu32* cnt; gu32* tmo;
    const float* rw; const float* rb; gu32* ecnt; unsigned char* meta; int h8;
    __device__ __forceinline__ void fused(Acc& acc, const Unit& u, int wr, int wc, int fr, int fq, LAS unsigned char* lds, int wid, int lane) const {
        const int row0 = u.pm * BM + wr * 64 + fr, col0 = u.pn * BM + wc * 32 + 8 * fq; const int b = (u.pm * BM) / SEQ; const int tid = wid * 64 + lane;
        LAS float* P9 = (LAS float*)lds; LAS float* RWT = (LAS float*)(lds + 36864); LAS float* S = (LAS float*)(lds + 45056); LAS float* CE = (LAS float*)(lds + 46080);
        LAS int* rE = (LAS int*)(lds + 46144); LAS float* red = (LAS float*)(lds + 47360);
        const float* shp = shb + (size_t)b * 6144;
        for (int i = tid; i < 2048; i += NTHREADS) { const int c = i >> 3, e = i & 7; RWT[e * 256 + c] = rw[(size_t)(u.pn * BM + c) * 8 + e]; }
        { float ce[8]; const float s0 = shp[tid], s1 = shp[tid + 512];
#pragma unroll
          for (int e = 0; e < 8; ++e) ce[e] = wave_sum(s0 * rw[(size_t)tid * 8 + e] + s1 * rw[(size_t)(tid + 512) * 8 + e]);
          if (lane == 0) {
#pragma unroll
              for (int e = 0; e < 8; ++e) red[wid * 8 + e] = ce[e]; } }
        { f32x4 gv[2][2];
#pragma unroll
          for (int bj = 0; bj < 2; ++bj)
#pragma unroll
              for (int n = 0; n < 2; ++n) gv[bj][n] = *(const f32x4*)(gate + (size_t)b * 6144 + col0 + bj * HALF + 4 * n);
#pragma unroll
          for (int ai = 0; ai < 2; ++ai) {
              f32x4 xv[4][2][2];
#pragma unroll
              for (int m = 0; m < 4; ++m) { const float* ri = X + (size_t)(row0 + ai * HALF + m * 16) * DM + col0;
#pragma unroll
                  for (int bj = 0; bj < 2; ++bj)
#pragma unroll
                      for (int n = 0; n < 2; ++n) xv[m][bj][n] = ldx16(ri + bj * HALF + 4 * n); }
              asm volatile("" ::: "memory");
#pragma unroll
              for (int m = 0; m < 4; ++m) { float* rp = X + (size_t)(row0 + ai * HALF + m * 16) * DM + col0; float ss = 0.f;
#pragma unroll
                  for (int bj = 0; bj < 2; ++bj)
#pragma unroll
                      for (int n = 0; n < 2; ++n) { const f32x4 x = xv[m][bj][n] + gv[bj][n] * acc[ai][bj][m][n]; acc[ai][bj][m][n] = x; *(f32x4*)(rp + bj * HALF + 4 * n) = x;
                          ss += (x[0] * x[0] + x[1] * x[1]) + (x[2] * x[2] + x[3] * x[3]); }
                  ss += __shfl_xor(ss, 16); ss += __shfl_xor(ss, 32);
                  if (fq == 0) P9[((ai * HALF + wr * 64 + m * 16 + fr) * 4 + wc) * 9] = ss; }
              asm volatile("" ::: "memory");
          } }
        f32x4 sf[2][2];
#pragma unroll
        for (int bj = 0; bj < 2; ++bj)
#pragma unroll
            for (int n = 0; n < 2; ++n) { const int c = col0 + bj * HALF + 4 * n; const f32x4 gm = *(const f32x4*)(ng + c) * (*(const f32x4*)(shp + DM + c) + 1.0f); sf[bj][n] = *(const f32x4*)(shp + c);
#pragma unroll
                for (int ai = 0; ai < 2; ++ai)
#pragma unroll
                    for (int m = 0; m < 4; ++m) acc[ai][bj][m][n] = acc[ai][bj][m][n] * gm; }
        asm volatile("s_waitcnt lgkmcnt(0)" ::: "memory"); __builtin_amdgcn_s_barrier(); asm volatile("" ::: "memory");
        if (tid < 8) { float c = rb[tid];
#pragma unroll
            for (int w = 0; w < 8; ++w) c += red[w * 8 + tid];
            CE[tid] = c; }
#pragma unroll
        for (int e = 0; e < 8; ++e) { f32x4 rwe[2][2];
#pragma unroll
            for (int bj = 0; bj < 2; ++bj)
#pragma unroll
                for (int n = 0; n < 2; ++n) rwe[bj][n] = *(const LAS f32x4*)(RWT + e * 256 + bj * HALF + wc * 32 + 8 * fq + 4 * n);
#pragma unroll
            for (int ai = 0; ai < 2; ++ai)
#pragma unroll
                for (int m = 0; m < 4; ++m) { float a = 0.f;
#pragma unroll
                    for (int bj = 0; bj < 2; ++bj)
#pragma unroll
                        for (int n = 0; n < 2; ++n) { const f32x4 x = acc[ai][bj][m][n], w4 = rwe[bj][n]; a += (x[0] * w4[0] + x[1] * w4[1]) + (x[2] * w4[2] + x[3] * w4[3]); }
                    a += __shfl_xor(a, 16); a += __shfl_xor(a, 32);
                    if (fq == 0) P9[((ai * HALF + wr * 64 + m * 16 + fr) * 4 + wc) * 9 + 1 + e] = a; } }
        asm volatile("s_waitcnt lgkmcnt(0)" ::: "memory"); __builtin_amdgcn_s_barrier(); asm volatile("" ::: "memory");
        if (tid < 256) { gu32* q = (gu32*)xs9 + ((size_t)(u.pm * BM + tid) * 4 + u.pn) * 9;
#pragma unroll
            for (int k = 0; k < 9; ++k) { const float v = (P9[(tid * 4 + 0) * 9 + k] + P9[(tid * 4 + 1) * 9 + k]) + (P9[(tid * 4 + 2) * 9 + k] + P9[(tid * 4 + 3) * 9 + k]);
                __hip_atomic_store(q + k, __float_as_uint(v), RLX_AGENT); } }
        asm volatile("s_waitcnt vmcnt(0)" ::: "memory");
        if (wid < 4 && lane == 0) __hip_atomic_fetch_add(cnt + 64 * u.pm, 1u, RLX_AGENT);
        if (wid == 0) { unsigned spins = 0;
            while ((unsigned)__builtin_amdgcn_readfirstlane(__hip_atomic_load(cnt + 64 * u.pm, RLX_AGENT)) < 16u) { __builtin_amdgcn_s_sleep(2);
                if (++spins > (1u << 20)) { if (lane == 0) __hip_atomic_store(tmo, 1u, RLX_AGENT); break; } } }
        asm volatile("s_waitcnt vmcnt(0) lgkmcnt(0)" ::: "memory"); __builtin_amdgcn_s_barrier(); asm volatile("" ::: "memory");
        if (tid < 256) { const gu32* q = (const gu32*)xs9 + (size_t)(u.pm * BM + tid) * 36; float tot[9];
#pragma unroll
            for (int k = 0; k < 9; ++k) tot[k] = (__uint_as_float(__hip_atomic_load(q + k, RLX_AGENT)) + __uint_as_float(__hip_atomic_load(q + 9 + k, RLX_AGENT)))
                                               + (__uint_as_float(__hip_atomic_load(q + 18 + k, RLX_AGENT)) + __uint_as_float(__hip_atomic_load(q + 27 + k, RLX_AGENT)));
            const float r = 1.0f / sqrtf(tot[0] * (1.0f / DM) + EPS); S[tid] = r;
            if (wid == u.pn) {
                float lg[8];
#pragma unroll
                for (int e = 0; e < 8; ++e) lg[e] = r * tot[1 + e] + CE[e];
                int e0 = 0; float l0 = lg[0];
#pragma unroll
                for (int e = 1; e < 8; ++e) if (lg[e] > l0) { l0 = lg[e]; e0 = e; }
                int e1 = -1; float l1 = -3.0e38f;
#pragma unroll
                for (int e = 0; e < 8; ++e) if (e != e0 && lg[e] > l1) { l1 = lg[e]; e1 = e; }
                const float g0 = 1.0f / (1.0f + __expf(l1 - l0)), g1 = 1.0f - g0;
                int cmine = 0, r0 = 0, r1 = 0;
#pragma unroll
                for (int e = 0; e < 8; ++e) { const unsigned long long m0 = __ballot(e0 == e), m1 = __ballot(e1 == e);
                    const int below = (int)__builtin_amdgcn_mbcnt_hi((unsigned)(m0 >> 32), __builtin_amdgcn_mbcnt_lo((unsigned)m0, 0u)) + (int)__builtin_amdgcn_mbcnt_hi((unsigned)(m1 >> 32), __builtin_amdgcn_mbcnt_lo((unsigned)m1, 0u));
                    if (e0 == e) r0 = below; if (e1 == e) r1 = below; if (lane == e) cmine = __popcll(m0) + __popcll(m1); }
                unsigned base = 0u; if (lane < 8 && cmine) base = __hip_atomic_fetch_add(ecnt + 64 * lane, (unsigned)cmine, RLX_AGENT);
                const int p0 = (int)__shfl(base, e0) + r0, p1 = (int)__shfl(base, e1) + r1, grow = u.pm * BM + 64 * u.pn + lane;
                gu32* ri = (gu32*)(meta + WS_ROWIDX_B); gu32* gp = (gu32*)(meta + WS_GATEP_B); gu32* sl = (gu32*)(meta + WS_SLOT_B);
                __hip_atomic_store(ri + e0 * 16384 + p0, (unsigned)grow, RLX_AGENT); __hip_atomic_store(ri + e1 * 16384 + p1, (unsigned)grow, RLX_AGENT);
                __hip_atomic_store(gp + e0 * 16384 + p0, __float_as_uint(g0), RLX_AGENT); __hip_atomic_store(gp + e1 * 16384 + p1, __float_as_uint(g1), RLX_AGENT);
                __hip_atomic_store(sl + grow * 2, (unsigned)((e0 << 16) | p0), RLX_AGENT); __hip_atomic_store(sl + grow * 2 + 1, (unsigned)((e1 << 16) | p1), RLX_AGENT); } }
        asm volatile("s_waitcnt vmcnt(0) lgkmcnt(0)" ::: "memory"); __builtin_amdgcn_s_barrier(); asm volatile("" ::: "memory");
#pragma unroll
        for (int ai = 0; ai < 2; ++ai)
#pragma unroll
            for (int m = 0; m < 4; ++m) { const float r = S[ai * HALF + wr * 64 + m * 16 + fr]; bf16_t* hp = H + (size_t)(row0 + ai * HALF + m * 16) * DM + col0;
#pragma unroll
                for (int bj = 0; bj < 2; ++bj) { const f32x4 h0 = acc[ai][bj][m][0] * r + sf[bj][0], h1 = acc[ai][bj][m][1] * r + sf[bj][1];
                    if ((M1_FP8 || M1L1_FP8) && h8) { int t0 = 0, t1 = 0; t0 = __builtin_amdgcn_cvt_pk_fp8_f32(h0[0], h0[1], t0, false); t0 = __builtin_amdgcn_cvt_pk_fp8_f32(h0[2], h0[3], t0, true);
                        t1 = __builtin_amdgcn_cvt_pk_fp8_f32(h1[0], h1[1], t1, false); t1 = __builtin_amdgcn_cvt_pk_fp8_f32(h1[2], h1[3], t1, true); u32x2 w; w.x = (unsigned)t0; w.y = (unsigned)t1;
                        *(u32x2*)((unsigned char*)H + (size_t)(row0 + ai * HALF + m * 16) * DM + col0 + bj * HALF) = w; }
                    else *(u32x4*)(hp + bj * HALF) = pack8(h0, h1); } }
    }
};
struct EpiGluRes {
    static constexpr bool FUSED = false;
    float* X; const float* gate;
    __device__ __forceinline__ void operator()(const Acc& acc, const Unit& u, int wr, int wc, int fr, int fq) const {
        const int row0 = u.pm * BM + wr * 64 + fr, col0 = u.pn * HALF + wc * 32 + 8 * fq; const int b = (u.pm * BM) / SEQ;
        f32x4 gv[2];
#pragma unroll
        for (int n = 0; n < 2; ++n) gv[n] = *(const f32x4*)(gate + (size_t)b * 6144 + col0 + 4 * n);
        f32x4 xv[2][4][2];
#pragma unroll
        for (int ai = 0; ai < 2; ++ai)
#pragma unroll
            for (int m = 0; m < 4; ++m)
#pragma unroll
                for (int n = 0; n < 2; ++n) xv[ai][m][n] = ldx16(X + (size_t)(row0 + ai * HALF + m * 16) * DM + col0 + 4 * n);
        asm volatile("" ::: "memory");
#pragma unroll
        for (int ai = 0; ai < 2; ++ai)
#pragma unroll
            for (int m = 0; m < 4; ++m) { float* rp = X + (size_t)(row0 + ai * HALF + m * 16) * DM + col0;
#pragma unroll
                for (int n = 0; n < 2; ++n) { f32x4 x = xv[ai][m][n]; const f32x4 l = acc[ai][0][m][n], gg = acc[ai][1][m][n];
#pragma unroll
                    for (int e = 0; e < 4; ++e) x[e] += gv[n][e] * l[e] * sigmoid_f(gg[e]);
                    *(f32x4*)(rp + 4 * n) = x; } }
    }
};
struct EpiAttnIn {
    static constexpr bool FUSED = false;
    bf16_t *Q, *Kn, *V, *QI, *KI; float* WI; const float *qg, *kg;
    __device__ __forceinline__ void operator()(const Acc& acc, const Unit& u, int wr, int wc, int fr, int fq) const {
        const int row0 = u.pm * BM + wr * 64 + fr;
        if (u.pn < 5) {
            const bool isq = u.pn < 4; const float* gp = isq ? qg : kg; const float sc = isq ? 0.125f : 1.0f;
            f32x4 gn[2][2];
#pragma unroll
            for (int bj = 0; bj < 2; ++bj)
#pragma unroll
                for (int n = 0; n < 2; ++n) gn[bj][n] = *(const f32x4*)(gp + 32 * bj + 8 * fq + 4 * n) * sc;
            bf16_t* base = isq ? (Q + (size_t)(4 * u.pn + wc) * 64) : (Kn + (size_t)wc * 64); const int ldo = isq ? 1024 : 256;
#pragma unroll
            for (int ai = 0; ai < 2; ++ai)
#pragma unroll
                for (int m = 0; m < 4; ++m) { float ss = 0.f;
#pragma unroll
                    for (int bj = 0; bj < 2; ++bj)
#pragma unroll
                        for (int n = 0; n < 2; ++n) { const f32x4 x = acc[ai][bj][m][n]; ss += (x[0] * x[0] + x[1] * x[1]) + (x[2] * x[2] + x[3] * x[3]); }
                    ss += __shfl_xor(ss, 16); ss += __shfl_xor(ss, 32);
                    const float r = 1.0f / sqrtf(ss * (1.0f / 64.0f) + EPS);
#pragma unroll
                    for (int bj = 0; bj < 2; ++bj) *(u32x4*)(base + (size_t)(row0 + ai * HALF + m * 16) * ldo + 32 * bj + 8 * fq) = pack8(acc[ai][bj][m][0] * r * gn[bj][0], acc[ai][bj][m][1] * r * gn[bj][1]); }
        } else if (u.pn < 8) {
            bf16_t* base = (u.pn == 5) ? V : QI + (size_t)(u.pn - 6) * 256; const int ldo = (u.pn == 5) ? 256 : 512; const int col0 = wc * 32 + 8 * fq;
#pragma unroll
            for (int ai = 0; ai < 2; ++ai)
#pragma unroll
                for (int m = 0; m < 4; ++m)
#pragma unroll
                    for (int bj = 0; bj < 2; ++bj) *(u32x4*)(base + (size_t)(row0 + ai * HALF + m * 16) * ldo + col0 + bj * HALF) = pack8(acc[ai][bj][m][0], acc[ai][bj][m][1]);
        } else {
            if (wc < 2) {
#pragma unroll
                for (int ai = 0; ai < 2; ++ai)
#pragma unroll
                    for (int m = 0; m < 4; ++m) *(u32x4*)(KI + (size_t)(row0 + ai * HALF + m * 16) * 64 + wc * 32 + 8 * fq) = pack8(acc[ai][0][m][0], acc[ai][0][m][1]);
            } else if (wc == 2 && fq == 0) {
                const float s = 0.04419417382415922f;
#pragma unroll
                for (int ai = 0; ai < 2; ++ai)
#pragma unroll
                    for (int m = 0; m < 4; ++m) { float* wp = WI + (size_t)(row0 + ai * HALF + m * 16) * 8; *(f32x4*)wp = acc[ai][0][m][0] * s; *(f32x4*)(wp + 4) = acc[ai][0][m][1] * s; }
            }
        }
    }
};
struct EpiMoeDn {
    static constexpr bool FUSED = false;
    bf16_t* Y; const float* gatep;
    __device__ __forceinline__ void operator()(const Acc& acc, const Unit& u, int wr, int wc, int fr, int fq) const {
        const int row0 = u.pm * BM + wr * 64 + fr, col0 = u.pn * BM + wc * 32 + 8 * fq;
#pragma unroll
        for (int ai = 0; ai < 2; ++ai)
#pragma unroll
            for (int m = 0; m < 4; ++m) { const float gt = gatep[u.aux + ai * HALF + wr * 64 + m * 16 + fr] * (M2_FP8 ? W8_INV : 1.0f);
#pragma unroll
                for (int bj = 0; bj < 2; ++bj) *(u32x4*)(Y + (size_t)(row0 + ai * HALF + m * 16) * DM + col0 + bj * HALF) = pack8(acc[ai][bj][m][0] * gt, acc[ai][bj][m][1] * gt); }
    }
};
}

constexpr size_t MiB = 1u << 20;
constexpr size_t WS_CTL = 0, CTL_ZERO_BYTES = 1 * MiB;
constexpr size_t WS_MOD = 1 * MiB;
constexpr size_t WS_ROWIDX = 2 * MiB;
constexpr size_t WS_GATEP = 2 * MiB + 512 * 1024;
constexpr size_t WS_SLOT = 3 * MiB;
static_assert(WS_ROWIDX_B == WS_ROWIDX && WS_GATEP_B == WS_GATEP && WS_SLOT_B == WS_SLOT, "metadata offsets");
constexpr size_t WS_WCI = 8 * MiB;
constexpr size_t WS_WCO = 20 * MiB;
constexpr size_t WS_WAI = 24 * MiB;
constexpr size_t WS_WAO = 29 * MiB;
constexpr size_t WS_WGL = 31 * MiB;
constexpr size_t WS_WFG = 35 * MiB;
constexpr size_t WS_WFD = 57 * MiB;
constexpr size_t WS_WMG = 68 * MiB;
constexpr size_t WS_WMD = 244 * MiB;
constexpr size_t WS_HB = 332 * MiB;
constexpr size_t WS_BUF = 364 * MiB;
constexpr size_t WS_ACT = 432 * MiB;
constexpr size_t WS_END = 619 * MiB;
constexpr int MOE_ROWS = 2 * M + NEXP * 256;
constexpr size_t WS_Q = WS_BUF, WS_K = WS_BUF + 32 * MiB, WS_V = WS_BUF + 40 * MiB, WS_QI = WS_BUF + 48 * MiB;
constexpr size_t WS_SC = WS_ACT, WS_O = WS_ACT + 128 * MiB, WS_KI = WS_ACT + 160 * MiB, WS_WI = WS_ACT + 162 * MiB;
static_assert(WS_WMD + (size_t)16 * 1024 * 2816 * 2 <= WS_HB && WS_ACT + (size_t)MOE_ROWS * FF * 2 <= WS_END && WS_BUF + (size_t)MOE_ROWS * DM * 2 <= WS_ACT, "d_ws map");
constexpr int CW_TMO = 0;
constexpr int CW_CNT = 64;
constexpr int CW_BAR = 4096;
constexpr int CW_PAN = 16384;
constexpr size_t WS_XS9 = 5 * MiB + 768 * 1024;
constexpr size_t WS_XS = 5 * MiB + 512 * 1024;

constexpr int RING_BYTES = 131072;
constexpr int LDSCTL_OFF = RING_BYTES, MISC_OFF = LDSCTL_OFF + 320;
constexpr int LDS_BYTES = 147456;

#define XB_TMO      128
#define XB_XCNT(j)  (256  + 64 * (j))
#define XB_XSUB(j)  (1280 + 64 * (j))
#define XB_XGEN(j)  (2304 + 64 * (j))
#define XB_TOP      3328
#define XB_TOPGEN   3392
#define XCD_BAR_WORDS 3456
#define XB_SPIN_CAP (1u << 18)
__device__ __forceinline__ unsigned xb_ld(unsigned* p)              { return __hip_atomic_load(p, __ATOMIC_RELAXED, __HIP_MEMORY_SCOPE_AGENT); }
__device__ __forceinline__ unsigned xb_add(unsigned* p, unsigned v) { return __hip_atomic_fetch_add(p, v, __ATOMIC_RELAXED, __HIP_MEMORY_SCOPE_AGENT); }
__device__ __forceinline__ unsigned xb_xcc_id() { return (unsigned)__builtin_amdgcn_s_getreg((3 << 11) | 20) & 0xFu; }
#define XB_SPIN(cond, bar) do { unsigned _sp = 0; while (cond) { __builtin_amdgcn_s_sleep(1); \
    if ((++_sp & 255u) == 0u) { if (xb_ld(&(bar)[XB_TMO])) break; if (_sp > XB_SPIN_CAP) { atomicAdd(&(bar)[XB_TMO], 1u); break; } } } } while (0)
struct XcdBarrier { unsigned* bar; unsigned x; volatile LAS unsigned* st; int w; };
__device__ __forceinline__ bool xb_thread0(int w) { return w == 0 && lane_id_fresh() == 0; }
__device__ __forceinline__ XcdBarrier xcd_barrier_post(unsigned* bar, volatile LAS unsigned* st, int w) {
    XcdBarrier b; b.bar = bar; b.x = xb_xcc_id(); b.st = st; b.w = w;
    if (xb_thread0(w)) (void)xb_add(&bar[XB_XCNT(b.x)], 1u);
    return b;
}
__device__ __forceinline__ void xcd_barrier_complete(unsigned* bar, unsigned x, unsigned& nloc, unsigned& nx) {
    const unsigned G = gridDim.x * gridDim.y * gridDim.z;
    unsigned sum, cnt, mine, sp = 0u;
    for (;;) {
        sum = 0u; cnt = 0u; mine = 0u;
#pragma unroll
        for (unsigned j = 0; j < 16; ++j) { const unsigned c = xb_ld(&bar[XB_XCNT(j)]); sum += c; cnt += (c > 0u) ? 1u : 0u; mine = (j == x) ? c : mine; }
        if (sum == G) break;
        __builtin_amdgcn_s_sleep(1);
        if ((++sp & 255u) == 0u) { if (xb_ld(&bar[XB_TMO])) break; if (sp > XB_SPIN_CAP) { atomicAdd(&bar[XB_TMO], 1u); break; } }
    }
    nloc = mine > 0u ? mine : 1u; nx = cnt > 0u ? cnt : 1u;
}
__device__ __forceinline__ int lane_probe() { return (int)__builtin_amdgcn_mbcnt_hi(~0u, __builtin_amdgcn_mbcnt_lo(~0u, 0u)); }
__device__ __forceinline__ int lane_probe2() { return (int)__builtin_amdgcn_mbcnt_hi(~0u, __builtin_amdgcn_mbcnt_lo(~0u, 0u)); }
__device__ __forceinline__ void xcd_barrier(const XcdBarrier& b) {
    asm volatile("s_waitcnt vmcnt(0)" ::: "memory");
    __syncthreads();
    if (xb_thread0(b.w)) {
        unsigned* bar = b.bar;
        __builtin_amdgcn_s_waitcnt(0);
        unsigned nloc = b.st[0], nx = b.st[1];
        if (nloc == 0u) { xcd_barrier_complete(bar, b.x, nloc, nx); b.st[0] = nloc; b.st[1] = nx; }
        const unsigned old = xb_add(&bar[XB_XSUB(b.x)], 1u);
        const unsigned gen = old / nloc;
        if (old + 1u == (gen + 1u) * nloc) {
            __builtin_amdgcn_fence(__ATOMIC_RELEASE, "agent");
            asm volatile("s_waitcnt vmcnt(0)" ::: "memory");
            const unsigned og = xb_add(&bar[XB_TOP], 1u);
            const unsigned tg = og / nx;
            if (og + 1u == (tg + 1u) * nx) xb_add(&bar[XB_TOPGEN], 1u);
            else XB_SPIN(xb_ld(&bar[XB_TOPGEN]) == tg, bar);
            __builtin_amdgcn_fence(__ATOMIC_ACQUIRE, "agent");
            xb_add(&bar[XB_XGEN(b.x)], 1u);
        } else {
            XB_SPIN(xb_ld(&bar[XB_XGEN(b.x)]) == gen, bar);
            __builtin_amdgcn_fence(__ATOMIC_ACQUIRE, "agent");
        }
    }
    __syncthreads();
}

struct Args { const float* in[28]; float* out; unsigned char* ws; int ph_lo, ph_hi; };
enum { I_X = 0, I_C, I_ADAW, I_ADAB, I_NORMG, I_CWIN, I_CW, I_CWOUT, I_AWIN, I_QG, I_KG, I_AWOUT, I_RELB, I_SLRE, I_SLIM, I_SLOG, I_SBRE, I_SBIM, I_SCRE, I_SCIM, I_SD, I_SGLU,
       I_FGU, I_FDN, I_RW, I_RB, I_MGU, I_MDN };
struct Frame {
    LAS unsigned char* lds; unsigned char* ws; gu32* ctl;
    int tid, lane, wave, vcu, G;
    float* out; const float* mod;
    bf16_t *HB, *BUF, *ACT;
};

enum { MAP_NAT = 0, MAP_PAIR = 1, MAP_CONV = 2, MAP_ATTN = 3 };
__device__ __forceinline__ int map_row(int map, int half, int n) {
    if (map == MAP_NAT) return n;
    if (map == MAP_PAIR) { return n < half ? 256 * (n / 128) + (n % 128) : 256 * ((n - half) / 128) + 128 + ((n - half) % 128); }
    if (map == MAP_CONV) { if (n < 1024) return 2048 + n; if (n < 2048) { const int q = n - 1024; return 256 * (q / 128) + (q % 128); } const int q = n - 2048; return 256 * (q / 128) + 128 + (q % 128); }
    if (n < 1280) { const int hd = n / 64, d = n % 64; return 256 * (hd / 4) + 128 * (d / 32) + 32 * (hd % 4) + (d % 32); }
    return n;
}
__device__ __forceinline__ void p0_transpose_item(const float* W, int K, int N, bf16_t* WT, int map, int half, LAS float* scr, int item, int lane) {
    const int nblk = (N + 31) / 32, kb = item / nblk, nb = item % nblk, k0 = 64 * kb, n0 = 32 * nb;
    const bool cin = (n0 + (lane & 31)) < N;
    float tv[32];
#pragma unroll
    for (int i = 0; i < 32; ++i) { const int kk = 2 * i + (lane >> 5); tv[i] = cin ? W[(size_t)(k0 + kk) * N + n0 + (lane & 31)] : 0.f; }
#pragma unroll
    for (int i = 0; i < 32; ++i) { const int kk = 2 * i + (lane >> 5); scr[kk * 33 + (lane & 31)] = tv[i]; }
    LDS_WAIT(); CFENCE();
    const int c = lane & 7; const int r0 = map_row(map, half, n0);
#pragma unroll
    for (int j = 0; j < 4; ++j) { const int n = (lane >> 3) + 8 * j; const LAS float* s = scr + (8 * c) * 33 + n;
        u32x4 o; o.x = pk2(s[0 * 33], s[1 * 33]); o.y = pk2(s[2 * 33], s[3 * 33]); o.z = pk2(s[4 * 33], s[5 * 33]); o.w = pk2(s[6 * 33], s[7 * 33]);
        *(GAS u32x4*)(WT + (size_t)(r0 + n) * K + k0 + 8 * c) = o; }
    LDS_WAIT(); CFENCE();
}
__device__ __forceinline__ void p0_transpose_item8(const float* W, int K, int N, unsigned char* WT, int map, int half, LAS float* scr, int item, int lane, int sub) {
    const int nblk = (N + 31) / 32, kb = 2 * (item / nblk) + sub, nb = item % nblk, k0 = 64 * kb, n0 = 32 * nb;
    float tv[32];
#pragma unroll
    for (int i = 0; i < 32; ++i) { const int kk = 2 * i + (lane >> 5); tv[i] = W[(size_t)(k0 + kk) * N + n0 + (lane & 31)]; }
#pragma unroll
    for (int i = 0; i < 32; ++i) { const int kk = 2 * i + (lane >> 5); scr[kk * 33 + (lane & 31)] = tv[i] * pg8::W8_MUL; }
    LDS_WAIT(); CFENCE();
    const int c = lane & 3; const int r0 = map_row(map, half, n0);
#pragma unroll
    for (int j = 0; j < 2; ++j) { const int n = (lane >> 2) + 16 * j; const LAS float* sp = scr + (16 * c) * 33 + n; u32x4 o;
#pragma unroll
        for (int q = 0; q < 4; ++q) { int t = 0; t = __builtin_amdgcn_cvt_pk_fp8_f32(sp[(4 * q) * 33], sp[(4 * q + 1) * 33], t, false); t = __builtin_amdgcn_cvt_pk_fp8_f32(sp[(4 * q + 2) * 33], sp[(4 * q + 3) * 33], t, true); o[q] = (unsigned)t; }
        *(GAS u32x4*)(WT + (size_t)(r0 + n) * K + k0 + 16 * c) = o; }
    LDS_WAIT(); CFENCE();
}
__device__ __forceinline__ void p0_transpose_item8x2(const float* W, int K, int N, unsigned char* WT, int map, int half, LAS float* scr, int item, int lane) {
    const int nblk = (N + 31) / 32, kb2 = item / nblk, nb = item % nblk, k0 = 128 * kb2, n0 = 32 * nb;
    float ta[32], tb[32];
#pragma unroll
    for (int i = 0; i < 32; ++i) { const int kk = 2 * i + (lane >> 5); ta[i] = W[(size_t)(k0 + kk) * N + n0 + (lane & 31)]; }
#pragma unroll
    for (int i = 0; i < 32; ++i) { const int kk = 2 * i + (lane >> 5); tb[i] = W[(size_t)(k0 + 64 + kk) * N + n0 + (lane & 31)]; }
    const int c = lane & 7; const int r0 = map_row(map, half, n0);
    u32x4 o8[4];
#pragma unroll
    for (int h = 0; h < 2; ++h) {
#pragma unroll
        for (int i = 0; i < 32; ++i) { const int kk = 2 * i + (lane >> 5); scr[kk * 33 + (lane & 31)] = (h ? tb[i] : ta[i]) * pg8::W8_MUL; }
        LDS_WAIT(); CFENCE();
#pragma unroll
        for (int j = 0; j < 4; ++j) { const int n = (lane >> 3) + 8 * j; const LAS float* sp = scr + (16 * (c & 3)) * 33 + n; u32x4 o;
#pragma unroll
            for (int q = 0; q < 4; ++q) { int t = 0; t = __builtin_amdgcn_cvt_pk_fp8_f32(sp[(4 * q) * 33], sp[(4 * q + 1) * 33], t, false); t = __builtin_amdgcn_cvt_pk_fp8_f32(sp[(4 * q + 2) * 33], sp[(4 * q + 3) * 33], t, true); o[q] = (unsigned)t; }
            if ((c >> 2) == h) o8[j] = o; }
        LDS_WAIT(); CFENCE();
    }
#pragma unroll
    for (int j = 0; j < 4; ++j) { const int n = (lane >> 3) + 8 * j; *(GAS u32x4*)(WT + (size_t)(r0 + n) * K + k0 + 16 * c) = o8[j]; }
}
__device__ __forceinline__ void p0_prologue(Frame& F, const Args& A) {
    {
        LAS float* cs = (LAS float*)F.lds;
        LAS float* red = (LAS float*)(F.lds + 16384);
        for (int i = F.tid; i < NB * DM; i += NTHREADS) { const float c = A.in[I_C][i]; cs[i] = c / (1.f + __expf(-c)); }
        __syncthreads();
        const int kg = F.tid >> 6, cj = F.tid & 63;
        for (int un = blockIdx.x; un < 4 * 96; un += F.G) {
            const int l = un / 96, jb = un % 96, j = jb * 64 + cj;
            const float* w = A.in[I_ADAW] + (size_t)l * DM * 6144 + j;
            float a0 = 0.f, a1 = 0.f, a2 = 0.f, a3 = 0.f;
#pragma unroll 8
            for (int k = kg * 128; k < kg * 128 + 128; ++k) { const float wv = w[(size_t)k * 6144]; a0 += cs[k] * wv; a1 += cs[1024 + k] * wv; a2 += cs[2048 + k] * wv; a3 += cs[3072 + k] * wv; }
            *(LAS f32x4*)(red + (kg * 64 + cj) * 4) = (f32x4){a0, a1, a2, a3};
            __syncthreads();
            if (F.tid < 256) { const int b = F.tid >> 6, cc = F.tid & 63; float s = 0.f;
#pragma unroll
                for (int q = 0; q < 8; ++q) s += red[(q * 64 + cc) * 4 + b];
                ((float*)(F.ws + WS_MOD))[((size_t)l * NB + b) * 6144 + jb * 64 + cc] = s + A.in[I_ADAB][l * 6144 + jb * 64 + cc]; }
            __syncthreads();
        }
    }
    LAS float* scr = (LAS float*)(F.lds + 32768 + F.wave * 8704);
    const int gw = F.vcu * NWAVES + F.wave, NGW = F.G * NWAVES;
    constexpr int I_CI = (DM / 64) * (3072 / 32), I_SQ = (DM / 64) * (DM / 32), I_AI = (DM / 64) * ((ATT_N + 31) / 32), I_GL = (DM / 64) * (2048 / 32), I_GU = (DM / 64) * (2 * FF / 32), I_DN = (FF / 128) * (DM / 32), I_DNB = (FF / 64) * (DM / 32), I_GU8 = (DM / 128) * (2 * FF / 32);
    constexpr int NITEMS = 2 * I_CI + 2 * I_SQ + I_AI + I_SQ + I_GL + (F1L0_FP8 ? I_GU8 : I_GU) + I_GU + (F2_FP8 ? 2 * I_DN : ((F2L0_FP8 ? I_DN : I_DNB) + I_DNB)) + 8 * (M1L1_FP8 ? I_GU8 : I_GU) + 8 * (M1_FP8 ? I_GU8 : I_GU) + 16 * (M2_FP8 ? I_DN : I_DNB);
    for (int it = gw; it < NITEMS; it += NGW) {
        int r = it;
        if (r < 2 * I_CI) { const int q = r / I_CI; p0_transpose_item(A.in[I_CWIN] + (size_t)q * DM * 3072, DM, 3072, (bf16_t*)(F.ws + WS_WCI) + (size_t)q * 3072 * DM, MAP_CONV, 0, scr, r % I_CI, F.lane); continue; } r -= 2 * I_CI;
        if (r < 2 * I_SQ) { const int q = r / I_SQ; p0_transpose_item(A.in[I_CWOUT] + (size_t)q * DM * DM, DM, DM, (bf16_t*)(F.ws + WS_WCO) + (size_t)q * DM * DM, MAP_NAT, 0, scr, r % I_SQ, F.lane); continue; } r -= 2 * I_SQ;
        if (r < I_AI) { p0_transpose_item(A.in[I_AWIN], DM, ATT_N, (bf16_t*)(F.ws + WS_WAI), MAP_ATTN, 0, scr, r, F.lane); continue; } r -= I_AI;
        if (r < I_SQ) { p0_transpose_item(A.in[I_AWOUT], DM, DM, (bf16_t*)(F.ws + WS_WAO), MAP_NAT, 0, scr, r, F.lane); continue; } r -= I_SQ;
        if (r < I_GL) { p0_transpose_item(A.in[I_SGLU], DM, 2048, (bf16_t*)(F.ws + WS_WGL), MAP_PAIR, 1024, scr, r, F.lane); continue; } r -= I_GL;
        if (F1L0_FP8) { if (r < I_GU8) { p0_transpose_item8x2(A.in[I_FGU], DM, 2 * FF, (unsigned char*)(F.ws + WS_WFG), MAP_PAIR, FF, scr, r, F.lane); continue; } r -= I_GU8; }
        else { if (r < I_GU) { p0_transpose_item(A.in[I_FGU], DM, 2 * FF, (bf16_t*)(F.ws + WS_WFG), MAP_PAIR, FF, scr, r, F.lane); continue; } r -= I_GU; }
        if (r < I_GU) { p0_transpose_item(A.in[I_FGU] + (size_t)DM * 2 * FF, DM, 2 * FF, (bf16_t*)(F.ws + WS_WFG) + (size_t)2 * FF * DM, MAP_PAIR, FF, scr, r, F.lane); continue; } r -= I_GU;
        if (F2_FP8) { if (r < 2 * I_DN) { const int q = r / I_DN; p0_transpose_item8x2(A.in[I_FDN] + (size_t)q * FF * DM, FF, DM, (unsigned char*)(F.ws + WS_WFD) + (size_t)q * DM * FF, MAP_NAT, 0, scr, r % I_DN, F.lane); continue; } r -= 2 * I_DN; }
        else if (F2L0_FP8) {
            if (r < I_DN) { p0_transpose_item8x2(A.in[I_FDN], FF, DM, (unsigned char*)(F.ws + WS_WFD), MAP_NAT, 0, scr, r, F.lane); continue; } r -= I_DN;
            if (r < I_DNB) { p0_transpose_item(A.in[I_FDN] + (size_t)FF * DM, FF, DM, (bf16_t*)(F.ws + WS_WFD) + (size_t)DM * FF, MAP_NAT, 0, scr, r, F.lane); continue; } r -= I_DNB; }
        else { if (r < 2 * I_DNB) { const int q = r / I_DNB; p0_transpose_item(A.in[I_FDN] + (size_t)q * FF * DM, FF, DM, (bf16_t*)(F.ws + WS_WFD) + (size_t)q * DM * FF, MAP_NAT, 0, scr, r % I_DNB, F.lane); continue; } r -= 2 * I_DNB; }
        if (M1L1_FP8) { if (r < 8 * I_GU8) { const int q = r / I_GU8; unsigned char* dst = (unsigned char*)(F.ws + WS_WMG) + (size_t)q * 2 * FF * DM;
                p0_transpose_item8x2(A.in[I_MGU] + (size_t)q * DM * 2 * FF, DM, 2 * FF, dst, MAP_PAIR, FF, scr, r % I_GU8, F.lane); continue; } r -= 8 * I_GU8; }
        else { if (r < 8 * I_GU) { const int q = r / I_GU; p0_transpose_item(A.in[I_MGU] + (size_t)q * DM * 2 * FF, DM, 2 * FF, (bf16_t*)(F.ws + WS_WMG) + (size_t)q * 2 * FF * DM, MAP_PAIR, FF, scr, r % I_GU, F.lane); continue; } r -= 8 * I_GU; }
        if (M1_FP8) { if (r < 8 * I_GU8) { const int q = 8 + r / I_GU8; unsigned char* dst = (unsigned char*)(F.ws + WS_WMG) + (size_t)8 * 2 * FF * DM * 2 + (size_t)(q - 8) * 2 * FF * DM;
                p0_transpose_item8x2(A.in[I_MGU] + (size_t)q * DM * 2 * FF, DM, 2 * FF, dst, MAP_PAIR, FF, scr, r % I_GU8, F.lane); continue; } r -= 8 * I_GU8; }
        else { if (r < 8 * I_GU) { const int q = 8 + r / I_GU; p0_transpose_item(A.in[I_MGU] + (size_t)q * DM * 2 * FF, DM, 2 * FF, (bf16_t*)(F.ws + WS_WMG) + (size_t)q * 2 * FF * DM, MAP_PAIR, FF, scr, r % I_GU, F.lane); continue; } r -= 8 * I_GU; }
        if (M2_FP8) { const int q = r / I_DN; p0_transpose_item8x2(A.in[I_MDN] + (size_t)q * FF * DM, FF, DM, (unsigned char*)(F.ws + WS_WMD) + (size_t)q * DM * FF, MAP_NAT, 0, scr, r % I_DN, F.lane); }
        else { const int q = r / I_DNB; p0_transpose_item(A.in[I_MDN] + (size_t)q * FF * DM, FF, DM, (bf16_t*)(F.ws + WS_WMD) + (size_t)q * DM * FF, MAP_NAT, 0, scr, r % I_DNB, F.lane); }
    }
    { u32x4* z = (u32x4*)((bf16_t*)(F.ws + WS_WAI) + (size_t)2144 * DM); const int n16 = (ATT_NP - 2144) * DM * 2 / 16;
      for (int i = blockIdx.x * NTHREADS + F.tid; i < n16; i += F.G * NTHREADS) z[i] = (u32x4){0u, 0u, 0u, 0u}; }
}

template <int FLAGS>
__device__ __forceinline__ void thin_phase(Frame& F, const Args& A, const float* src, int nl  , int ns  , int cl  , int rl  , int cs = -1  , size_t roff = 0  ) {
    if (cs < 0) cs = rl;
    const int gw = F.vcu * NWAVES + F.wave, NGW = F.G * NWAVES;
    LAS float* rwt = (LAS float*)F.lds;
    if (FLAGS & 8) {
        const float* rw = A.in[I_RW] + (size_t)rl * DM * NEXP;
        for (int i = F.tid; i < DM * NEXP; i += NTHREADS) rwt[(i & 7) * DM + (i >> 3)] = rw[i];
        __syncthreads();
    }
    int Tb[8];
    if (FLAGS & 2) { int acc = 0;
#pragma unroll
        for (int e = 0; e < 8; ++e) { Tb[e] = acc; acc += (int)((__hip_atomic_load(F.ctl + CW_CNT + 64 * (8 * rl + e), RLX_AGENT) + 255u) >> 8); } }
    const float* ng = A.in[I_NORMG] + (size_t)(nl * 2 + ns) * DM;
    constexpr bool RT = (FLAGS & 8) != 0;
    LAS int* rE = (LAS int*)(F.lds + 32768);
    const int nit = RT ? ((M / 64 - (int)blockIdx.x + F.G - 1) / F.G) * 8 : (M - gw + NGW - 1) / NGW;
    for (int it = 0; it < nit; ++it) {
        const int chunk = (int)blockIdx.x + (it >> 3) * F.G;
        const int row = RT ? chunk * 64 + F.wave * 8 + (it & 7) : gw + it * NGW;
        const int b = row / SEQ;
        f32x4 v[4];
        const f32x4* xr = (const f32x4*)(src + (size_t)row * DM) + F.lane;
#pragma unroll
        for (int j = 0; j < 4; ++j) v[j] = xr[64 * j];
        if (FLAGS & 2) {
            const int s0 = ((const int*)(F.ws + roff + WS_SLOT))[row * 2], s1 = ((const int*)(F.ws + roff + WS_SLOT))[row * 2 + 1];
            int t0 = 0, t1 = 0;
#pragma unroll
            for (int e = 0; e < 8; ++e) { if ((s0 >> 16) == e) t0 = Tb[e]; if ((s1 >> 16) == e) t1 = Tb[e]; }
            const bf16_t* y0 = (const bf16_t*)(F.ws + WS_BUF) + (size_t)(256 * t0 + (s0 & 0xffff)) * DM;
            const bf16_t* y1 = (const bf16_t*)(F.ws + WS_BUF) + (size_t)(256 * t1 + (s1 & 0xffff)) * DM;
            const float* g2 = cl >= 0 ? F.mod + ((size_t)cl * NB + b) * 6144 + 5 * DM : (const float*)(F.ws + 512 * 1024);
#pragma unroll
            for (int j = 0; j < 4; ++j) { const int col = 4 * F.lane + 256 * j; const u32x2 a = *(const u32x2*)(y0 + col), c = *(const u32x2*)(y1 + col); const f32x4 g = *(const f32x4*)(g2 + col);
                v[j][0] += g[0] * (bflo(a.x) + bflo(c.x)); v[j][1] += g[1] * (bfhi(a.x) + bfhi(c.x)); v[j][2] += g[2] * (bflo(a.y) + bflo(c.y)); v[j][3] += g[3] * (bfhi(a.y) + bfhi(c.y)); }
        }
        if (FLAGS & 3) { GAS f32x4* xo = (GAS f32x4*)(F.out + (size_t)row * DM) + F.lane;
#pragma unroll
            for (int j = 0; j < 4; ++j) xo[64 * j] = v[j]; }
        if (FLAGS & 4) {
            float ss = 0.f;
#pragma unroll
            for (int j = 0; j < 4; ++j) ss += (v[j][0] * v[j][0] + v[j][1] * v[j][1]) + (v[j][2] * v[j][2] + v[j][3] * v[j][3]);
            const float r = 1.0f / sqrtf(wave_sum(ss) * (1.0f / DM) + EPS);
            const float* sh = F.mod + ((size_t)nl * NB + b) * 6144 + (ns ? 3 : 0) * DM; const float* sc = sh + DM;
            GAS u32x2* ho = (GAS u32x2*)(F.HB + (size_t)row * DM) + F.lane;
#pragma unroll
            for (int j = 0; j < 4; ++j) { const int col = 4 * F.lane + 256 * j; const f32x4 g = *(const f32x4*)(ng + col), s1 = *(const f32x4*)(sc + col), s0 = *(const f32x4*)(sh + col);
                v[j] = (v[j] * r) * g * (s1 + 1.0f) + s0;
                if ((RT && ((M1_FP8 && nl == 3) || (M1L1_FP8 && nl == 1))) || (FLAGS == 4 && F1L0_FP8 && nl == 0 && ns == 1)) { int t = 0; t = __builtin_amdgcn_cvt_pk_fp8_f32(v[j][0], v[j][1], t, false); t = __builtin_amdgcn_cvt_pk_fp8_f32(v[j][2], v[j][3], t, true);
                    *(unsigned*)((unsigned char*)F.HB + (size_t)row * DM + col) = (unsigned)t; }
                else { u32x2 w; w.x = pk2(v[j][0], v[j][1]); w.y = pk2(v[j][2], v[j][3]); ho[64 * j] = w; } }
            if (FLAGS & 8) {
                float lg[8];
#pragma unroll
                for (int e = 0; e < 8; ++e) { float s = 0.f;
#pragma unroll
                    for (int j = 0; j < 4; ++j) { const f32x4 w = *(const LAS f32x4*)(rwt + e * DM + 4 * F.lane + 256 * j); s += (v[j][0] * w[0] + v[j][1] * w[1]) + (v[j][2] * w[2] + v[j][3] * w[3]); }
                    lg[e] = wave_sum(s) + A.in[I_RB][rl * NEXP + e]; }
                int e0 = 0; float l0 = lg[0];
#pragma unroll
                for (int e = 1; e < 8; ++e) if (lg[e] > l0) { l0 = lg[e]; e0 = e; }
                int e1 = -1; float l1 = -3.0e38f;
#pragma unroll
                for (int e = 0; e < 8; ++e) if (e != e0 && lg[e] > l1) { l1 = lg[e]; e1 = e; }
                const float g0 = 1.0f / (1.0f + __expf(l1 - l0)), g1 = 1.0f - g0;
                const int lr = F.wave * 8 + (it & 7);
                if (F.lane == 0) { rE[lr] = e0; rE[64 + lr] = e1; rE[128 + lr] = __float_as_int(g0); rE[192 + lr] = __float_as_int(g1); }
            }
        }
        if (RT && (it & 7) == 7) {
            __syncthreads();
            if (F.tid < 8) { int cnt = 0; for (int q = 0; q < 64; ++q) cnt += (rE[q] == F.tid) + (rE[64 + q] == F.tid);
                rE[256 + F.tid] = cnt ? (int)__hip_atomic_fetch_add(F.ctl + CW_CNT + 64 * (8 * cs + F.tid), (unsigned)cnt, RLX_AGENT) : 0; }
            __syncthreads();
            if (F.tid < 64) { const int e0 = rE[F.tid], e1 = rE[64 + F.tid]; int r0 = 0, r1 = 0;
                for (int q = 0; q < F.tid; ++q) { r0 += (rE[q] == e0) + (rE[64 + q] == e0); r1 += (rE[q] == e1) + (rE[64 + q] == e1); }
                const int p0 = rE[256 + e0] + r0, p1 = rE[256 + e1] + r1, grow = chunk * 64 + F.tid;
                gu32* ri = (gu32*)(F.ws + roff + WS_ROWIDX); gu32* gp = (gu32*)(F.ws + roff + WS_GATEP); gu32* sl = (gu32*)(F.ws + roff + WS_SLOT);
                __hip_atomic_store(ri + e0 * 16384 + p0, (unsigned)grow, RLX_AGENT); __hip_atomic_store(ri + e1 * 16384 + p1, (unsigned)grow, RLX_AGENT);
                __hip_atomic_store(gp + e0 * 16384 + p0, (unsigned)rE[128 + F.tid], RLX_AGENT); __hip_atomic_store(gp + e1 * 16384 + p1, (unsigned)rE[192 + F.tid], RLX_AGENT);
                __hip_atomic_store(sl + grow * 2, (unsigned)((e0 << 16) | p0), RLX_AGENT); __hip_atomic_store(sl + grow * 2 + 1, (unsigned)((e1 << 16) | p1), RLX_AGENT); }
            __syncthreads();
        }
    }
}

__device__ __forceinline__ void unpack8(const u32x4 w, float (&f)[8]) { f[0] = bflo(w.x); f[1] = bfhi(w.x); f[2] = bflo(w.y); f[3] = bfhi(w.y); f[4] = bflo(w.z); f[5] = bfhi(w.z); f[6] = bflo(w.w); f[7] = bfhi(w.w); }
__device__ __forceinline__ void conv_phase(Frame& F, const float* cw  ) {
    const int gw = F.vcu * NWAVES + F.wave, NGW = F.G * NWAVES;
    const bf16_t* UB = F.BUF;
    for (int task = gw; task < M / 8; task += NGW) {
        const int r0 = task * 8; const bool first = (r0 % SEQ) == 0;
#pragma unroll
        for (int j = 0; j < 2; ++j) {
            const int ch = 8 * F.lane + 512 * j;
            float w0[8], w1[8], w2[8];
#pragma unroll
            for (int e = 0; e < 8; ++e) { w0[e] = cw[ch + e]; w1[e] = cw[DM + ch + e]; w2[e] = cw[2 * DM + ch + e]; }
            float um2[8], um1[8];
            if (first) {
#pragma unroll
                for (int e = 0; e < 8; ++e) { um2[e] = 0.f; um1[e] = 0.f; }
            } else { unpack8(*(const u32x4*)(UB + (size_t)(r0 - 2) * 2048 + ch), um2); unpack8(*(const u32x4*)(UB + (size_t)(r0 - 1) * 2048 + ch), um1); }
#pragma unroll
            for (int i = 0; i < 8; ++i) {
                float u0[8], bb[8]; unpack8(*(const u32x4*)(UB + (size_t)(r0 + i) * 2048 + ch), u0); unpack8(*(const u32x4*)(UB + (size_t)(r0 + i) * 2048 + 1024 + ch), bb);
                float z[8];
#pragma unroll
                for (int e = 0; e < 8; ++e) z[e] = bb[e] * (w0[e] * um2[e] + w1[e] * um1[e] + w2[e] * u0[e]);
                u32x4 o; o.x = pk2(z[0], z[1]); o.y = pk2(z[2], z[3]); o.z = pk2(z[4], z[5]); o.w = pk2(z[6], z[7]);
                *(u32x4*)(F.HB + (size_t)(r0 + i) * DM + ch) = o;
#pragma unroll
                for (int e = 0; e < 8; ++e) { um2[e] = um1[e]; um1[e] = u0[e]; }
            }
        }
    }
}

constexpr int QIP = 1040;
constexpr int AL_QI = 0, AL_WI = 33280, AL_SEL = 34304, AL_V = 42496, AL_BIASD = 108032, AL_SUM = 116288, AL_END = 116800;
typedef short v4i16_t __attribute__((ext_vector_type(4)));
__device__ __forceinline__ unsigned okey(float f) { const unsigned u = __float_as_uint(f); return u ^ ((u >> 31) ? 0xFFFFFFFFu : 0x80000000u); }
__device__ __forceinline__ void attn_phase(Frame& F, const Args& A) {
    LAS unsigned char* L = F.lds;
    const bf16_t* Qb = (const bf16_t*)(F.ws + WS_Q); const bf16_t* Kb = (const bf16_t*)(F.ws + WS_K); const bf16_t* Vb = (const bf16_t*)(F.ws + WS_V);
    const bf16_t* QIb = (const bf16_t*)(F.ws + WS_QI); const bf16_t* KIb = (const bf16_t*)(F.ws + WS_KI); const float* WIb = (const float*)(F.ws + WS_WI);
    bf16_t* Ob = (bf16_t*)(F.ws + WS_O);
    float* SC = (float*)(F.ws + WS_SC) + (size_t)blockIdx.x * 32 * SEQ;
    const int lane = F.lane, wave = F.wave;
    { LAS float* bd = (LAS float*)(L + AL_BIASD);
      for (int i = F.tid; i < 129 * 16; i += NTHREADS) { const int d = i >> 4; int bkt; if (d < 16) bkt = d; else { const float dd = (float)d; const int lg2 = 16 + (int)(logf(dd / 16.0f) / 2.0794415416798357f * 16.0f); bkt = lg2 < 31 ? lg2 : 31; }
          bd[i] = A.in[I_RELB][bkt * 16 + (i & 15)]; }
    }
    __syncthreads();
    for (int pass = 0; pass < 2; ++pass) {
        const int un = pass == 0 ? (int)blockIdx.x : 511 - (int)blockIdx.x;
        for (int uu = un; uu >= 0 && uu < 512; uu += (pass == 0 ? F.G * 2 : -F.G * 2)) {
        if ((pass == 0 && uu >= 256) || (pass == 1 && uu < 256)) break;
        const int b = uu & 3, qb = uu >> 2, t0 = qb * 32; const size_t rb = (size_t)b * SEQ;
        for (int i = F.tid; i < 32 * 64; i += NTHREADS) { const int q = i >> 6, c = i & 63; *(LAS u32x4*)(L + AL_QI + q * QIP + c * 16) = *(const u32x4*)(QIb + (rb + t0 + q) * 512 + c * 8); }
        if (F.tid < 256) ((LAS float*)(L + AL_WI))[F.tid] = WIb[(rb + t0) * 8 + F.tid];
        __syncthreads();
        {
            for (int kt = wave; kt <= qb; kt += NWAVES) {
                int ln1 = lane; asm volatile("" : "+v"(ln1));
                const int r = ln1 & 31, hh = ln1 >> 5;
                float wi[8];
#pragma unroll
                for (int h = 0; h < 8; ++h) wi[h] = ((LAS float*)(L + AL_WI))[r * 8 + h];
                bf16x8 ka[4];
#pragma unroll
                for (int ks = 0; ks < 4; ++ks) ka[ks] = *(const bf16x8*)(KIb + (rb + kt * 32 + r) * 64 + 16 * ks + 8 * hh);
                f32x16 sc;
#pragma unroll
                for (int i = 0; i < 16; ++i) sc[i] = 0.f;
#pragma unroll
                for (int h = 0; h < 8; ++h) {
                    f32x16 d;
#pragma unroll
                    for (int i = 0; i < 16; ++i) d[i] = 0.f;
#pragma unroll
                    for (int ks = 0; ks < 4; ++ks) { const bf16x8 qf = *(const LAS bf16x8*)(L + AL_QI + r * QIP + (h * 64 + 16 * ks + 8 * hh) * 2); d = __builtin_amdgcn_mfma_f32_32x32x16_bf16(ka[ks], qf, d, 0, 0, 0); }
#pragma unroll
                    for (int i = 0; i < 16; ++i) sc[i] += wi[h] * fmaxf(d[i], 0.f);
                }
#pragma unroll
                for (int a = 0; a < 4; ++a) { f32x4 o;
#pragma unroll
                    for (int e = 0; e < 4; ++e) { const int krow = 8 * a + 4 * hh + e; o[e] = (kt == qb && krow > r) ? -INFINITY : sc[4 * a + e]; }
                    *(f32x4*)(SC + (size_t)r * SEQ + kt * 32 + 8 * a + 4 * hh) = o; }
            }
        }
        VM_WAIT(); __syncthreads();
        for (int qq = 0; qq < 4; ++qq) {
            const int c = wave + 8 * qq, t = t0 + c; const int nvalid = t + 1;
            int lane = F.lane; asm volatile("" : "+v"(lane));
            LAS int* sel = (LAS int*)(L + AL_SEL) + wave * 256;
            int count;
            if (nvalid <= TOPK) {
                count = nvalid;
#pragma unroll
                for (int j = 0; j < 4; ++j) { const int idx = 64 * j + lane; sel[idx] = idx < nvalid ? idx : 0; }
            } else {
                count = TOPK;
                const int nj = (nvalid + 63) >> 6;
                unsigned key[64];
                const float* srow = SC + (size_t)c * SEQ;
#define SEL_GROUPS(BODY) do { BODY(0) if (nj > 16) { BODY(1) if (nj > 32) { BODY(2) if (nj > 48) { BODY(3) } } } } while (0)
#define SEL_LOAD(g) { _Pragma("unroll") for (int j = 16 * (g); j < 16 * (g) + 16; ++j) { const int idx = 64 * j + lane; const float sv = __uint_as_float(__hip_atomic_load((const gu32*)(srow + idx), RLX_AGENT)); key[j] = idx <= t ? okey(sv) : 0u;     } }
#pragma unroll
                for (int j = 0; j < 64; ++j) key[j] = 0u;
                SEL_GROUPS(SEL_LOAD);
                unsigned T = 0u;
                for (int bit = 31; bit >= 0; --bit) {
                    const unsigned cand = T | (1u << bit); int cnt = 0;
#define SEL_CNT(g) { _Pragma("unroll") for (int j = 16 * (g); j < 16 * (g) + 16; ++j) cnt += __popcll(__ballot(key[j] >= cand)); }
                    SEL_GROUPS(SEL_CNT);
                    if (cnt >= TOPK) T = cand;
                    if (cnt == TOPK) break;
                }
                int base = 0;
#define SEL_GT(g) { _Pragma("unroll") for (int j = 16 * (g); j < 16 * (g) + 16; ++j) { const bool gt = key[j] > T; const unsigned long long mk = __ballot(gt); \
                    const int pos = base + (int)__builtin_amdgcn_mbcnt_hi((unsigned)(mk >> 32), __builtin_amdgcn_mbcnt_lo((unsigned)mk, 0u)); if (gt) sel[pos] = 64 * j + lane; base += __popcll(mk); } }
                SEL_GROUPS(SEL_GT);
                const int need = TOPK - base; int eb = 0;
#define SEL_EQ(g) { _Pragma("unroll") for (int j = 16 * (g); j < 16 * (g) + 16; ++j) { const bool eq = key[j] == T; const unsigned long long mk = __ballot(eq); \
                    const int rank = eb + (int)__builtin_amdgcn_mbcnt_hi((unsigned)(mk >> 32), __builtin_amdgcn_mbcnt_lo((unsigned)mk, 0u)); if (eq && rank < need) sel[base + rank] = 64 * j + lane; eb += __popcll(mk); } }
                SEL_GROUPS(SEL_EQ);
#undef SEL_GROUPS
#undef SEL_LOAD
#undef SEL_CNT
#undef SEL_GT
#undef SEL_EQ
            }
            LDS_WAIT(); CFENCE();
            asm volatile("" : "+v"(lane));
            const int hd = lane & 15, kq = lane >> 4;
            bf16x8 bq[8];
            { bf16x8 qf[2];
#pragma unroll
              for (int s2 = 0; s2 < 2; ++s2) qf[s2] = *(const bf16x8*)(Qb + (rb + t) * 1024 + hd * 64 + 32 * s2 + 8 * kq);
              const bf16x8 zf = (bf16x8){0, 0, 0, 0, 0, 0, 0, 0};
#pragma unroll
              for (int ks = 0; ks < 8; ++ks) bq[ks] = ((ks >> 1) == (hd >> 2)) ? qf[ks & 1] : zf; }
            f32x4 lg[16];
            float mx = -INFINITY;
            bf16x8 kf[3][8];
#pragma unroll
            for (int pre = 0; pre < 2; ++pre) { const int krow = sel[16 * pre + hd]; const bf16_t* kp = Kb + (rb + krow) * 256 + 8 * kq;
#pragma unroll
              for (int ks = 0; ks < 8; ++ks) kf[pre][ks] = *(const bf16x8*)(kp + 32 * ks); }
            const LAS float* biasd = (const LAS float*)(L + AL_BIASD);
#pragma unroll
            for (int kt = 0; kt < 16; ++kt) {
                if (kt < 14) { const int krow = sel[16 * (kt + 2) + hd]; const bf16_t* kp = Kb + (rb + krow) * 256 + 8 * kq;
#pragma unroll
                    for (int ks = 0; ks < 8; ++ks) kf[(kt + 2) % 3][ks] = *(const bf16x8*)(kp + 32 * ks); }
                f32x4 d = (f32x4){0.f, 0.f, 0.f, 0.f};
#pragma unroll
                for (int ks = 0; ks < 8; ++ks) d = __builtin_amdgcn_mfma_f32_16x16x32_bf16(kf[kt % 3][ks], bq[ks], d, 0, 0, 0);
                const u32x4 ks4 = *(const LAS u32x4*)(sel + 16 * kt + 4 * kq);
#pragma unroll
                for (int i = 0; i < 4; ++i) { const int pos = 16 * kt + 4 * kq + i; int dist = t - (int)ks4[i]; dist = dist < 0 ? 0 : (dist > 128 ? 128 : dist);
                    const float bs = biasd[dist * 16 + hd];
                    d[i] = pos < count ? d[i] + bs : -INFINITY; mx = fmaxf(mx, d[i]); }
                lg[kt] = d;
            }
            mx = fmaxf(mx, __shfl_xor(mx, 16)); mx = fmaxf(mx, __shfl_xor(mx, 32));
            float sum = 0.f;
            bf16x8 pa[8];
#pragma unroll
            for (int ks = 0; ks < 8; ++ks) { float p[8];
#pragma unroll
                for (int i = 0; i < 4; ++i) { p[i] = __expf(lg[2 * ks][i] - mx); p[4 + i] = __expf(lg[2 * ks + 1][i] - mx); }
                sum += ((p[0] + p[1]) + (p[2] + p[3])) + ((p[4] + p[5]) + (p[6] + p[7]));
                u32x4 w; w.x = cvt_pk_bf16(p[0], p[1]); w.y = cvt_pk_bf16(p[2], p[3]); w.z = cvt_pk_bf16(p[4], p[5]); w.w = cvt_pk_bf16(p[6], p[7]);
                pa[ks] = __builtin_bit_cast(bf16x8, w); }
            sum += __shfl_xor(sum, 16); sum += __shfl_xor(sum, 32);
            if (kq == 0) ((LAS float*)(L + AL_SUM))[wave * 16 + hd] = sum;
            LDS_WAIT(); CFENCE();
            {
                asm volatile("" : "+v"(lane));
                const int rs = lane >> 3, ch = lane & 7, i16 = lane & 15, tq = i16 >> 2, tp = i16 & 3, kq2 = lane >> 4;
                LAS unsigned char* vb = L + AL_V + wave * 8192;
                const unsigned wr_off = (unsigned)lane * 16u, tr_off = (unsigned)((4 * kq2 + tq) * 128 + 8 * tp);
                f32x4 O[4][4];
#pragma unroll
                for (int n = 0; n < 4; ++n)
#pragma unroll
                    for (int dt = 0; dt < 4; ++dt) O[n][dt] = (f32x4){0.f, 0.f, 0.f, 0.f};
                u32x4 vr[2][4]; int kr[4];
                const bf16_t* vbase = Vb + rb * 256 + 8 * ch;
#pragma unroll
                for (int i = 0; i < 4; ++i) kr[i] = sel[8 * i + rs];
#pragma unroll
                for (int pre = 0; pre < 2; ++pre)
#pragma unroll
                    for (int i = 0; i < 4; ++i) vr[pre][i] = *(const u32x4*)(vbase + (size_t)kr[i] * 256 + pre * 64);
#pragma unroll
                for (int st = 0; st < 32; ++st) {
                    const int ks = st >> 2, n = st & 3;
                    LAS unsigned char* buf = vb + (st & 1) * 4096;
#pragma unroll
                    for (int i = 0; i < 4; ++i) *(LAS u32x4*)(buf + wr_off + i * 1024) = vr[st & 1][i];
                    if (st < 30) { const int ks2 = (st + 2) >> 2, n2 = (st + 2) & 3;
                        if (n2 == 0) {
#pragma unroll
                            for (int i = 0; i < 4; ++i) kr[i] = sel[32 * ks2 + 8 * i + rs]; }
#pragma unroll
                        for (int i = 0; i < 4; ++i) vr[st & 1][i] = *(const u32x4*)(vbase + (size_t)kr[i] * 256 + n2 * 64); }
#pragma unroll
                    for (int dt = 0; dt < 4; ++dt) {
                        const v4i16_t t0 = __builtin_amdgcn_ds_read_tr16_b64_v4i16((LAS v4i16_t*)(buf + tr_off + 32 * dt));
                        const v4i16_t t1 = __builtin_amdgcn_ds_read_tr16_b64_v4i16((LAS v4i16_t*)(buf + tr_off + 2048 + 32 * dt));
                        const bf16x8 bfr = (bf16x8){t0[0], t0[1], t0[2], t0[3], t1[0], t1[1], t1[2], t1[3]};
                        O[n][dt] = __builtin_amdgcn_mfma_f32_16x16x32_bf16(pa[ks], bfr, O[n][dt], 0, 0, 0); }
                    CFENCE();
                }
                const f32x4 sm = *(const LAS f32x4*)(L + AL_SUM + (wave * 16 + 4 * kq2) * 4);
                bf16_t* op = Ob + (rb + t) * 1024 + (4 * kq2) * 64 + i16;
#pragma unroll
                for (int dt = 0; dt < 4; ++dt)
#pragma unroll
                    for (int i = 0; i < 4; ++i) { const float v = kq2 == 0 ? O[0][dt][i] : (kq2 == 1 ? O[1][dt][i] : (kq2 == 2 ? O[2][dt][i] : O[3][dt][i]));
                        op[i * 64 + 16 * dt] = (bf16_t)f2bf(v / sm[i]); }
            }
            LDS_WAIT(); CFENCE();
        }
        __syncthreads();
        }
    }
}

constexpr int SL_BMT = 0;
constexpr int SL_CMA = 4096;
constexpr int SL_AB = 12288;
constexpr int SL_E = 12800;
constexpr int SL_S = 16896;
constexpr int SPITCH = 272;
__device__ __forceinline__ void cmul(float ar, float ai, float br, float bi, float& cr, float& ci) { cr = ar * br - ai * bi; ci = ar * bi + ai * br; }
__device__ __forceinline__ void ssm_phase(Frame& F, const Args& A) {
    LAS unsigned char* L = F.lds;
    const int lane = F.lane, wave = F.wave;
    bf16_t* G = (bf16_t*)(F.ws + WS_ACT);
    for (int un = F.vcu; un < NB * 64; un += F.G) {
        const int b = un >> 6, g = un & 63; const size_t rb = (size_t)b * SEQ;
        __syncthreads();
        if (F.tid < 64) {
            const int p = F.tid;
            const float lr = fminf(A.in[I_SLRE][g * 64 + p], -1e-4f), li = A.in[I_SLIM][g * 64 + p];
            const float step = expf(A.in[I_SLOG][g]);
            const float mag = expf(lr * step); float sn, cs; sincosf(li * step, &sn, &cs);
            const float ar = mag * cs, ai = mag * sn;
            ((LAS float*)(L + SL_AB))[2 * p] = ar; ((LAS float*)(L + SL_AB))[2 * p + 1] = ai;
            const float nr = ar - 1.0f, ni = ai, den = lr * lr + li * li;
            const float cr = (nr * lr + ni * li) / den, ci = (ni * lr - nr * li) / den;
            LAS bf16_t* bm = (LAS bf16_t*)(L + SL_BMT);
#pragma unroll
            for (int c = 0; c < 16; ++c) { const float br = A.in[I_SBRE][((size_t)g * 64 + p) * 16 + c], bi = A.in[I_SBIM][((size_t)g * 64 + p) * 16 + c];
                float xr, xi; cmul(cr, ci, br, bi, xr, xi); bm[p * 16 + c] = (bf16_t)f2bf(xr); bm[(64 + p) * 16 + c] = (bf16_t)f2bf(xi); }
        }
        { LAS bf16_t* cm = (LAS bf16_t*)(L + SL_CMA);
          for (int i = F.tid; i < 32 * 128; i += NTHREADS) { const int c = i >> 7, k = i & 127; float v = 0.f;
              if (c < 16) v = (k < 64) ? A.in[I_SCRE][((size_t)g * 16 + c) * 64 + k] : -A.in[I_SCIM][((size_t)g * 16 + c) * 64 + (k - 64)];
              cm[i] = (bf16_t)f2bf(v); } }
        __syncthreads();
        const int r = lane & 31, hh = lane >> 5;
        bf16x8 bfr[4];
#pragma unroll
        for (int n = 0; n < 4; ++n) bfr[n] = *(const LAS bf16x8*)(L + SL_BMT + ((32 * n + r) * 16 + 8 * hh) * 2);
        bf16x8 cfr[8];
#pragma unroll
        for (int ks = 0; ks < 8; ++ks) cfr[ks] = *(const LAS bf16x8*)(L + SL_CMA + (r * 128 + 16 * ks + 8 * hh) * 2);
        float ar[2], ai[2], a16r[2], a16i[2], a512r[2], a512i[2];
#pragma unroll
        for (int s = 0; s < 2; ++s) { ar[s] = ((LAS float*)(L + SL_AB))[2 * (32 * s + r)]; ai[s] = ((LAS float*)(L + SL_AB))[2 * (32 * s + r) + 1];
            float pr = ar[s], pi = ai[s];
#pragma unroll
            for (int q = 0; q < 4; ++q) { float nr, ni; cmul(pr, pi, pr, pi, nr, ni); pr = nr; pi = ni; }
            a16r[s] = pr; a16i[s] = pi;
#pragma unroll
            for (int q = 0; q < 5; ++q) { float nr, ni; cmul(pr, pi, pr, pi, nr, ni); pr = nr; pi = ni; }
            a512r[s] = pr; a512i[s] = pi; }
        const int tokperm = 16 * ((r >> 2) & 1) + 4 * (r >> 3) + (r & 3);
        const float dsk0 = 0.f; (void)dsk0;
        float cin_r[2] = {0.f, 0.f}, cin_i[2] = {0.f, 0.f};
        LAS unsigned char* Sw = L + SL_S + wave * (32 * SPITCH);
        for (int pass = 0; pass < 2; ++pass) {
            if (pass == 1) {
                __syncthreads();
#pragma unroll
                for (int s = 0; s < 2; ++s) { float cr = 0.f, ci = 0.f;
                    for (int w = 0; w < wave; ++w) { float nr, ni; cmul(a512r[s], a512i[s], cr, ci, nr, ni); cr = nr + ((LAS float*)(L + SL_E))[(w * 64 + 32 * s + r) * 2]; ci = ni + ((LAS float*)(L + SL_E))[(w * 64 + 32 * s + r) * 2 + 1]; }
                    cin_r[s] = cr; cin_i[s] = ci; }
            }
            bf16x8 ufn = *(const bf16x8*)(F.HB + (rb + wave * 512 + tokperm) * DM + 16 * g + 8 * hh);
            for (int tile = 0; tile < 16; ++tile) {
                asm volatile("s_waitcnt vmcnt(0) lgkmcnt(0)" ::: "memory"); __builtin_amdgcn_s_barrier(); asm volatile("" ::: "memory");
                const int tk0 = wave * 512 + tile * 32;
                const bf16x8 uf = ufn;
                if (tile < 15) ufn = *(const bf16x8*)(F.HB + (rb + tk0 + 32 + tokperm) * DM + 16 * g + 8 * hh);

                f32x16 d[4];
#pragma unroll
                for (int n = 0; n < 4; ++n) {
#pragma unroll
                    for (int i = 0; i < 16; ++i) d[n][i] = 0.f;
                    d[n] = __builtin_amdgcn_mfma_f32_32x32x16_bf16(uf, bfr[n], d[n], 0, 0, 0); }
                asm volatile("s_nop 15\n\ts_nop 15\n\ts_nop 15" : "+v"(d[0]), "+v"(d[1]), "+v"(d[2]), "+v"(d[3]));
#pragma unroll
                for (int s = 0; s < 2; ++s) {
                    float sr = hh == 0 ? cin_r[s] : 0.f, si = hh == 0 ? cin_i[s] : 0.f;
#pragma unroll
                    for (int i = 0; i < 16; ++i) { const float nr = ar[s] * sr - ai[s] * si + d[s][i], ni = ar[s] * si + ai[s] * sr + d[2 + s][i]; sr = nr; si = ni; d[s][i] = sr; d[2 + s][i] = si; }
                    const float e0r = __shfl_xor(sr, 32), e0i = __shfl_xor(si, 32);
                    float cr = hh == 1 ? e0r : 0.f, ci = hh == 1 ? e0i : 0.f;
                    if (pass == 1) {
#pragma unroll
                        for (int i = 0; i < 16; ++i) { float nr, ni; cmul(ar[s], ai[s], cr, ci, nr, ni); cr = nr; ci = ni; d[s][i] += cr; d[2 + s][i] += ci; }
                    } else { float nr, ni; cmul(a16r[s], a16i[s], cr, ci, nr, ni); cr = nr; ci = ni; }
                    const float endr = (pass == 1) ? d[s][15] : sr + cr, endi = (pass == 1) ? d[2 + s][15] : si + ci;
                    const float xr = __shfl_xor(endr, 32), xi = __shfl_xor(endi, 32);
                    cin_r[s] = hh == 1 ? endr : xr; cin_i[s] = hh == 1 ? endi : xi;
                }
                if (pass == 1) {
#pragma unroll
                    for (int s = 0; s < 2; ++s)
#pragma unroll
                        for (int i = 0; i < 16; ++i) { *(LAS bf16_t*)(Sw + (16 * hh + i) * SPITCH + (32 * s + r) * 2) = (bf16_t)f2bf(d[s][i]); *(LAS bf16_t*)(Sw + (16 * hh + i) * SPITCH + (64 + 32 * s + r) * 2) = (bf16_t)f2bf(d[2 + s][i]); }
                    LDS_WAIT(); CFENCE();
                    f32x16 y;
#pragma unroll
                    for (int i = 0; i < 16; ++i) y[i] = 0.f;
#pragma unroll
                    for (int ks = 0; ks < 8; ++ks) { const bf16x8 sf = *(const LAS bf16x8*)(Sw + r * SPITCH + (16 * ks + 8 * hh) * 2); y = __builtin_amdgcn_mfma_f32_32x32x16_bf16(cfr[ks], sf, y, 0, 0, 0); }
                    LDS_WAIT(); CFENCE();
                    const size_t trow = rb + tk0 + r;
#pragma unroll
                    for (int q = 0; q < 2; ++q) { const int ch = 16 * g + 8 * q + 4 * hh;
                        const u32x2 hv = *(const u32x2*)(F.HB + trow * DM + ch); const f32x4 dk = *(const f32x4*)(A.in[I_SD] + ch);
                        const float y0 = gelu_tanh_f(y[4 * q + 0] + dk[0] * bflo(hv.x)), y1 = gelu_tanh_f(y[4 * q + 1] + dk[1] * bfhi(hv.x)), y2 = gelu_tanh_f(y[4 * q + 2] + dk[2] * bflo(hv.y)), y3 = gelu_tanh_f(y[4 * q + 3] + dk[3] * bfhi(hv.y));
                        u32x2 w; w.x = pk2(y0, y1); w.y = pk2(y2, y3); *(u32x2*)(G + trow * DM + ch) = w; }
                }
            }
            if (pass == 0) {
                if (hh == 1) {
#pragma unroll
                    for (int s = 0; s < 2; ++s) { ((LAS float*)(L + SL_E))[(wave * 64 + 32 * s + r) * 2] = cin_r[s]; ((LAS float*)(L + SL_E))[(wave * 64 + 32 * s + r) * 2 + 1] = cin_i[s]; } }
                cin_r[0] = cin_r[1] = cin_i[0] = cin_i[1] = 0.f;
            }
        }
    }
}

enum { PH_PRO = 0, PH_NORM0,
       L0_G1, L0_CONV, L0_G2, L0_NORM, L0_F1, L0_F2, L0_NORMN,
       L1_G1, L1_ATTN, L1_G2, L1_NORMR, L1_M1, L1_M2, L1_COMB,
       L2_SSM, L2_G2, L2_NORM, L2_F1, L2_F2, L2_NORMN,
       L3_G1, L3_CONV, L3_G2, L3_NORMR, L3_M1, L3_M2, L3_COMB, NPH };

__device__ __forceinline__ bool fresh_ids(Frame& F) { const int l = lane_id_fresh(); F.lane = l; F.tid = F.wave * 64 + l; return true; }
__global__ void __launch_bounds__(NTHREADS, 2) mega_fwd(Args args) {
    extern __shared__ __attribute__((aligned(16))) unsigned char lds_raw[];
    Frame F;
    F.lds = (LAS unsigned char*)lds_raw;
    volatile LAS unsigned* MISC = (volatile LAS unsigned*)(F.lds + MISC_OFF);
    F.tid = threadIdx.x; F.lane = F.tid & 63; F.wave = __builtin_amdgcn_readfirstlane(F.tid >> 6);
    F.G = gridDim.x; { const int bx = blockIdx.x; F.vcu = (F.G % 8 == 0) ? (bx % 8) * (F.G / 8) + bx / 8 : bx; }
    F.ws = args.ws; F.ctl = (gu32*)(args.ws + WS_CTL); F.out = args.out; F.mod = (const float*)(args.ws + WS_MOD);
    F.HB = (bf16_t*)(args.ws + WS_HB); F.BUF = (bf16_t*)(args.ws + WS_BUF); F.ACT = (bf16_t*)(args.ws + WS_ACT);
    for (int u = F.tid; u < (LDS_BYTES - LDSCTL_OFF) / 4; u += NTHREADS) ((LAS unsigned*)(F.lds + LDSCTL_OFF))[u] = 0u;
    __syncthreads();
    XcdBarrier bar; bar.bar = (unsigned*)(F.ctl + CW_BAR); bar.x = 0; bar.st = nullptr; bar.w = F.wave;
    const int lo = args.ph_lo, hi = args.ph_hi;
    if (hi - lo > 1) bar = xcd_barrier_post((unsigned*)(F.ctl + CW_BAR), MISC + 8, F.wave);
#ifndef PH_ONLY
#define PH_EN(k) true
#else
#define PH_EN(k) ((k) == PH_ONLY)
#endif
#define IN(k) (PH_EN(k) && lo <= (k) && (k) < hi && fresh_ids(F))
#define SEAM(k) do { if (IN(k) && IN((k) + 1)) xcd_barrier(bar); } while (0)
#ifndef PH_REP
#define PH_REP (-1)
#endif
#ifndef PH_REPMASK
#define PH_REPMASK 0ull
#endif
#define REPB(k, ...) do { if (PH_REP == (k) || ((PH_REPMASK >> (k)) & 1ull)) { xcd_barrier(bar); __VA_ARGS__; } } while (0)
    LAS unsigned char* ring = F.lds;
    const int cid = (int)blockIdx.x;
    bf16_t* const WCI = (bf16_t*)(F.ws + WS_WCI); bf16_t* const WCO = (bf16_t*)(F.ws + WS_WCO); bf16_t* const WAI = (bf16_t*)(F.ws + WS_WAI); bf16_t* const WAO = (bf16_t*)(F.ws + WS_WAO);
    bf16_t* const WGL = (bf16_t*)(F.ws + WS_WGL); bf16_t* const WFG = (bf16_t*)(F.ws + WS_WFG); bf16_t* const WFD = (bf16_t*)(F.ws + WS_WFD); bf16_t* const WMG = (bf16_t*)(F.ws + WS_WMG); bf16_t* const WMD = (bf16_t*)(F.ws + WS_WMD);

#define ZEROG ((const float*)(F.ws + 512 * 1024))
    const bool fuseR = (F.G == 256) && FUSE_R;
    const bool fuse = (F.G == 256) && FUSE_N;
#define FUSED_EPI(inst, gatep, xin, nl, ns, hout, asc, h8_) ({F.out, (gatep), (xin), args.in[I_NORMG] + (size_t)((nl) * 2 + (ns)) * DM, F.mod + (size_t)(nl) * NB * 6144 + ((ns) ? 3 : 0) * DM, (hout), (float*)(F.ws + WS_XS), F.ctl + CW_PAN + 64 * 64 * (inst), F.ctl + CW_TMO, (asc), (h8_)})
#define FUSED_RT(inst, gatep, nl, rl, roff, hout, h8_) ({F.out, (gatep), args.in[I_NORMG] + (size_t)((nl) * 2 + 1) * DM, F.mod + (size_t)(nl) * NB * 6144 + 3 * DM, (hout), (float*)(F.ws + WS_XS9), F.ctl + CW_PAN + 64 * 64 * (inst), F.ctl + CW_TMO, \
        args.in[I_RW] + (size_t)(rl) * DM * NEXP, args.in[I_RB] + (rl) * NEXP, F.ctl + CW_CNT + 64 * 8 * (rl), F.ws + (roff), (h8_)})
#define MODP(l, chunk) (F.mod + (size_t)(l) * NB * 6144 + (chunk) * DM)
#define GEMM_STATIC(Aptr, Bptr, Nn, Kk, EpiT, EpiInit) do { pg8::Gemm g{(Aptr), (Bptr), M, (Nn), (Kk), 0, nullptr, nullptr}; pg8::StaticOrder S; S.init(M, (Nn), F.G, cid); EpiT E EpiInit; \
        pg8::gemm_phase<EpiT, pg8::StaticOrder, false>(ring, g, S, E, F.wave); } while (0)
#define GEMM_STATIC8(Aptr, Bptr, Nn, Kk, EpiT, EpiInit) do { pg8::Gemm g{(Aptr), (Bptr), M, (Nn), (Kk), 0, nullptr, nullptr}; pg8::StaticOrder S; S.init(M, (Nn), F.G, cid); EpiT E EpiInit; \
        pg8::gemm_phase<EpiT, pg8::StaticOrder, false, true>(ring, g, S, E, F.wave); } while (0)
#define EPAIR8 pg8::EpiPair<1, (M2_FP8 != 0), (M1_FP8 != 0)>
#define M1_B (M1_FP8 ? 1 : 2)
#define EPAIR8L1 pg8::EpiPair<1, (M2_FP8 != 0), (M1L1_FP8 != 0)>
#define M2_B (M2_FP8 ? 1 : 2)
#define F2_ASC (F2_FP8 ? pg8::W8_INV : 1.0f)
#define GEMM_STATICF(Aptr, Bptr, Nn, Kk, EpiT, EpiInit) do { pg8::Gemm g{(Aptr), (Bptr), M, (Nn), (Kk), 0, nullptr, nullptr}; pg8::StaticOrder S; S.init(M, (Nn), F.G, cid); EpiT E EpiInit; \
        pg8::gemm_phase<EpiT, pg8::StaticOrder, false, (F2_FP8 != 0)>(ring, g, S, E, F.wave); } while (0)
#define EPAIRF pg8::EpiPair<1, (F2_FP8 != 0), false>
#define F0_FP8 (F2_FP8 || F2L0_FP8)
#define F2L0_ASC (F0_FP8 ? pg8::W8_INV : 1.0f)
#define EPAIR0 pg8::EpiPair<1, (F0_FP8 != 0), false>
#define EPAIR0S pg8::EpiPair<1, (F0_FP8 != 0), (F1L0_FP8 != 0)>
#define GEMM_STATICF0(Aptr, Bptr, Nn, Kk, EpiT, EpiInit) do { pg8::Gemm g{(Aptr), (Bptr), M, (Nn), (Kk), 0, nullptr, nullptr}; pg8::StaticOrder S; S.init(M, (Nn), F.G, cid); EpiT E EpiInit; \
        pg8::gemm_phase<EpiT, pg8::StaticOrder, false, (F0_FP8 != 0)>(ring, g, S, E, F.wave); } while (0)
#define W8(base, bytes) ((bf16_t*)((unsigned char*)(base) + (size_t)(bytes)))

    if (IN(PH_PRO)) { p0_prologue(F, args); REPB(PH_PRO, p0_prologue(F, args)); } SEAM(PH_PRO);
    if (IN(PH_NORM0)) { thin_phase<4>(F, args, args.in[I_X], 0, 0, 0, 0); REPB(PH_NORM0, thin_phase<4>(F, args, args.in[I_X], 0, 0, 0, 0)); } SEAM(PH_NORM0);

    if (IN(L0_G1)) { GEMM_STATIC(F.HB, WCI, 3072, DM, pg8::EpiConvIn, {F.BUF}); REPB(L0_G1, GEMM_STATIC(F.HB, WCI, 3072, DM, pg8::EpiConvIn, {F.BUF})); } SEAM(L0_G1);
    if (IN(L0_CONV)) { conv_phase(F, args.in[I_CW]); REPB(L0_CONV, conv_phase(F, args.in[I_CW])); } SEAM(L0_CONV);
    if (IN(L0_G2)) { if (fuse) GEMM_STATIC(F.HB, WCO, DM, DM, pg8::EpiResNorm, FUSED_EPI(0, MODP(0, 2), args.in[I_X], 0, 1, (fuse ? F.BUF : F.HB), 1.0f, F1L0_FP8)); else GEMM_STATIC(F.HB, WCO, DM, DM, pg8::EpiRes, ({F.out, MODP(0, 2), args.in[I_X], 1.0f})); } SEAM(L0_G2);
    if (!fuse) { if (IN(L0_NORM)) { thin_phase<4>(F, args, F.out, 0, 1, 0, 0); } SEAM(L0_NORM); }
    if (IN(L0_F1)) { pg8::Gemm g{(fuse ? F.BUF : F.HB), WFG, M, 2 * FF, DM, 0, nullptr, nullptr}; pg8::StaticOrder S; S.init(M, 2 * FF, F.G, cid); EPAIR0S E{F.ACT, FF};
        pg8::gemm_phase<EPAIR0S, pg8::StaticOrder, false, (F1L0_FP8 != 0)>(ring, g, S, E, F.wave); } SEAM(L0_F1);
    if (IN(L0_F2)) { if (fuse) GEMM_STATICF0(F.ACT, WFD, DM, FF, pg8::EpiResNorm, FUSED_EPI(1, MODP(0, 5), F.out, 1, 0, F.HB, F2L0_ASC, 0)); else GEMM_STATICF0(F.ACT, WFD, DM, FF, pg8::EpiRes, ({F.out, MODP(0, 5), F.out, F2L0_ASC})); } SEAM(L0_F2);
    if (!fuse) { if (IN(L0_NORMN)) { thin_phase<4>(F, args, F.out, 1, 0, 0, 0); } SEAM(L0_NORMN); }

    if (IN(L1_G1)) { GEMM_STATIC(F.HB, WAI, ATT_NP, DM, pg8::EpiAttnIn, ({(bf16_t*)(F.ws + WS_Q), (bf16_t*)(F.ws + WS_K), (bf16_t*)(F.ws + WS_V), (bf16_t*)(F.ws + WS_QI), (bf16_t*)(F.ws + WS_KI), (float*)(F.ws + WS_WI), args.in[I_QG], args.in[I_KG]})); REPB(L1_G1, GEMM_STATIC(F.HB, WAI, ATT_NP, DM, pg8::EpiAttnIn, ({(bf16_t*)(F.ws + WS_Q), (bf16_t*)(F.ws + WS_K), (bf16_t*)(F.ws + WS_V), (bf16_t*)(F.ws + WS_QI), (bf16_t*)(F.ws + WS_KI), (float*)(F.ws + WS_WI), args.in[I_QG], args.in[I_KG]}))); } SEAM(L1_G1);
    if (IN(L1_ATTN)) { attn_phase(F, args); REPB(L1_ATTN, attn_phase(F, args)); } SEAM(L1_ATTN);
    if (IN(L1_G2)) { if (fuseR) GEMM_STATIC((bf16_t*)(F.ws + WS_O), WAO, DM, DM, pg8::EpiResNormRouter, FUSED_RT(3, MODP(1, 2), 1, 0, 0, F.HB, M1L1_FP8)); else GEMM_STATIC((bf16_t*)(F.ws + WS_O), WAO, DM, DM, pg8::EpiRes, ({F.out, MODP(1, 2), F.out, 1.0f})); } SEAM(L1_G2);
    if (!fuseR) { if (IN(L1_NORMR)) { thin_phase<4 | 8>(F, args, F.out, 1, 1, 0, 0); } SEAM(L1_NORMR); }
    if (IN(L1_M1)) { pg8::Gemm g{F.HB, WMG, M, 2 * FF, DM, (size_t)2 * FF * DM * (M1L1_FP8 ? 1 : 2), (const int*)(F.ws + WS_ROWIDX), (const unsigned*)(F.ctl + CW_CNT)}; pg8::MoeOrder S; S.init((const unsigned*)(F.ctl + CW_CNT), 22, F.G, cid);
        EPAIR8L1 E{F.ACT, FF}; pg8::gemm_phase<EPAIR8L1, pg8::MoeOrder, true, (M1L1_FP8 != 0)>(ring, g, S, E, F.wave); REPB(L1_M1, pg8::gemm_phase<EPAIR8L1, pg8::MoeOrder, true, (M1L1_FP8 != 0)>(ring, g, S, E, F.wave)); } SEAM(L1_M1);
    if (IN(L1_M2)) { pg8::Gemm g{F.ACT, WMD, M, DM, FF, (size_t)DM * FF * M2_B, nullptr, nullptr}; pg8::MoeOrder S; S.init((const unsigned*)(F.ctl + CW_CNT), 4, F.G, cid);
        pg8::EpiMoeDn E{F.BUF, (const float*)(F.ws + WS_GATEP)}; pg8::gemm_phase<pg8::EpiMoeDn, pg8::MoeOrder, false, (M2_FP8 != 0)>(ring, g, S, E, F.wave); REPB(L1_M2, pg8::gemm_phase<pg8::EpiMoeDn, pg8::MoeOrder, false, (M2_FP8 != 0)>(ring, g, S, E, F.wave)); } SEAM(L1_M2);
    if (IN(L1_COMB)) { thin_phase<2 | 4>(F, args, F.out, 2, 0, 1, 0); REPB(L1_COMB, thin_phase<2 | 4>(F, args, F.out, 2, 0, -1, 0)); } SEAM(L1_COMB);

    if (IN(L2_SSM)) { ssm_phase(F, args); REPB(L2_SSM, ssm_phase(F, args)); } SEAM(L2_SSM);
    if (IN(L2_G2)) { GEMM_STATIC(F.ACT, WGL, 2048, DM, pg8::EpiGluRes, ({F.out, MODP(2, 2)})); REPB(L2_G2, GEMM_STATIC(F.ACT, WGL, 2048, DM, pg8::EpiGluRes, ({F.out, ZEROG}))); } SEAM(L2_G2);
    if (IN(L2_NORM)) { thin_phase<4>(F, args, F.out, 2, 1, 0, 0); REPB(L2_NORM, thin_phase<4>(F, args, F.out, 2, 1, 0, 0)); } SEAM(L2_NORM);
    if (IN(L2_F1)) { GEMM_STATIC(F.HB, WFG + (size_t)2 * FF * DM, 2 * FF, DM, EPAIRF, ({F.ACT, FF})); REPB(L2_F1, GEMM_STATIC(F.HB, WFG + (size_t)2 * FF * DM, 2 * FF, DM, EPAIRF, ({F.ACT, FF}))); } SEAM(L2_F1);
    if (IN(L2_F2)) { if (fuse) GEMM_STATICF(F.ACT, W8(WFD, (size_t)DM * FF * (F2_FP8 ? 1 : 2)), DM, FF, pg8::EpiResNorm, FUSED_EPI(2, MODP(2, 5), F.out, 3, 0, F.HB, F2_ASC, 0)); else GEMM_STATICF(F.ACT, W8(WFD, (size_t)DM * FF * (F2_FP8 ? 1 : 2)), DM, FF, pg8::EpiRes, ({F.out, MODP(2, 5), F.out, F2_ASC})); } SEAM(L2_F2);
    if (!fuse) { if (IN(L2_NORMN)) { thin_phase<4>(F, args, F.out, 3, 0, 0, 0); } SEAM(L2_NORMN); }

    if (IN(L3_G1)) { GEMM_STATIC(F.HB, WCI + (size_t)3072 * DM, 3072, DM, pg8::EpiConvIn, {F.BUF}); REPB(L3_G1, GEMM_STATIC(F.HB, WCI + (size_t)3072 * DM, 3072, DM, pg8::EpiConvIn, {F.BUF})); } SEAM(L3_G1);
    if (IN(L3_CONV)) { conv_phase(F, args.in[I_CW] + 3 * DM); REPB(L3_CONV, conv_phase(F, args.in[I_CW] + 3 * DM)); } SEAM(L3_CONV);
    if (IN(L3_G2)) { if (fuseR) GEMM_STATIC(F.HB, WCO + (size_t)DM * DM, DM, DM, pg8::EpiResNormRouter, FUSED_RT(4, MODP(3, 2), 3, 1, 2 * MiB, F.BUF, M1_FP8)); else GEMM_STATIC(F.HB, WCO + (size_t)DM * DM, DM, DM, pg8::EpiRes, ({F.out, MODP(3, 2), F.out, 1.0f})); } SEAM(L3_G2);
    if (!fuseR) { if (IN(L3_NORMR)) { thin_phase<4 | 8>(F, args, F.out, 3, 1, 0, 1, 1, 2 * MiB); } SEAM(L3_NORMR); }
    if (IN(L3_M1)) { pg8::Gemm g{(fuseR ? F.BUF : F.HB), W8(WMG, (size_t)8 * 2 * FF * DM * 2), M, 2 * FF, DM, (size_t)2 * FF * DM * M1_B, (const int*)(F.ws + 2 * MiB + WS_ROWIDX), (const unsigned*)(F.ctl + CW_CNT + 512)}; pg8::MoeOrder S; S.init((const unsigned*)(F.ctl + CW_CNT + 512), 22, F.G, cid);
        EPAIR8 E{F.ACT, FF}; pg8::gemm_phase<EPAIR8, pg8::MoeOrder, true, (M1_FP8 != 0)>(ring, g, S, E, F.wave); REPB(L3_M1, pg8::gemm_phase<EPAIR8, pg8::MoeOrder, true, (M1_FP8 != 0)>(ring, g, S, E, F.wave)); } SEAM(L3_M1);
    if (IN(L3_M2)) { pg8::Gemm g{F.ACT, W8(WMD, (size_t)8 * DM * FF * M2_B), M, DM, FF, (size_t)DM * FF * M2_B, nullptr, nullptr}; pg8::MoeOrder S; S.init((const unsigned*)(F.ctl + CW_CNT + 512), 4, F.G, cid);
        pg8::EpiMoeDn E{F.BUF, (const float*)(F.ws + 2 * MiB + WS_GATEP)}; pg8::gemm_phase<pg8::EpiMoeDn, pg8::MoeOrder, false, (M2_FP8 != 0)>(ring, g, S, E, F.wave); REPB(L3_M2, pg8::gemm_phase<pg8::EpiMoeDn, pg8::MoeOrder, false, (M2_FP8 != 0)>(ring, g, S, E, F.wave)); } SEAM(L3_M2);
    if (IN(L3_COMB)) { thin_phase<2>(F, args, F.out, 0, 0, 3, 1, 1, 2 * MiB); }
#undef IN
#undef SEAM
}

extern "C" void kernel_launch(void* const* d_in, const int* in_sizes, int n_in, void* d_out, int out_size, void* d_ws, size_t ws_size, hipStream_t stream) {
    static int grid = 0;
    if (grid == 0) {
        if (n_in != 28 || in_sizes[0] != M * DM || out_size != M * DM || ws_size < WS_END) { fprintf(stderr, "kernel_launch: unexpected shapes / workspace (n_in %d, ws %zu, need %zu)\n", n_in, ws_size, (size_t)WS_END); grid = -1; return; }
        int dev = 0, cus = 0, per_cu = 0;
        if (hipGetDevice(&dev) != hipSuccess || hipDeviceGetAttribute(&cus, hipDeviceAttributeMultiprocessorCount, dev) != hipSuccess) { grid = -1; return; }
        if (hipFuncSetAttribute((const void*)mega_fwd, hipFuncAttributeMaxDynamicSharedMemorySize, LDS_BYTES) != hipSuccess) { fprintf(stderr, "kernel_launch: hipFuncSetAttribute failed\n"); grid = -1; return; }
        if (hipOccupancyMaxActiveBlocksPerMultiprocessor(&per_cu, (const void*)mega_fwd, NTHREADS, LDS_BYTES) != hipSuccess || per_cu < 1) fprintf(stderr, "kernel_launch: occupancy query reports %d\n", per_cu);
        (void)hipGetLastError();
        grid = cus;
    }
    if (grid < 0) return;
    (void)hipMemsetAsync((char*)d_ws + WS_CTL, 0, CTL_ZERO_BYTES, stream);
    Args a{};
    for (int i = 0; i < 28; ++i) a.in[i] = (const float*)d_in[i];
    a.out = (float*)d_out; a.ws = (unsigned char*)d_ws;
#if MK_PER_PHASE
    for (int p = 0; p < NPH; ++p) { a.ph_lo = p; a.ph_hi = p + 1; hipLaunchKernelGGL(mega_fwd, dim3(grid), dim3(NTHREADS), LDS_BYTES, stream, a); }
#else
    a.ph_lo = 0; a.ph_hi = NPH; hipLaunchKernelGGL(mega_fwd, dim3(grid), dim3(NTHREADS), LDS_BYTES, stream, a);
#endif
}
```

```cpp
#include <hip/hip_runtime.h>
#include <cstdio>
#include <cstdint>
#include <cmath>

#ifndef MK_PER_PHASE
#define MK_PER_PHASE 0
#endif

#define GAS __attribute__((address_space(1)))
#define LAS __attribute__((address_space(3)))
typedef unsigned short bf16_t;
typedef short bf16x8 __attribute__((ext_vector_type(8)));
typedef float f32x4 __attribute__((ext_vector_type(4)));
typedef float f32x2 __attribute__((ext_vector_type(2)));
typedef float f32x16 __attribute__((ext_vector_type(16)));
typedef unsigned u32x4 __attribute__((ext_vector_type(4)));
typedef unsigned u32x2 __attribute__((ext_vector_type(2)));
typedef GAS unsigned gu32;
#define RLX_AGENT __ATOMIC_RELAXED, __HIP_MEMORY_SCOPE_AGENT
#define LDS_WAIT() asm volatile("s_waitcnt lgkmcnt(0)" ::: "memory")
#define VM_WAIT() asm volatile("s_waitcnt vmcnt(0)" ::: "memory")
#define CFENCE() asm volatile("" ::: "memory")

constexpr int DM = 1024, NB = 4, SEQ = 4096, M = NB * SEQ, FF = 2816, NEXP = 8;
constexpr int NH = 16, NKV = 4, HD = 64, IH = 8, IDIM = 64, TOPK = 256;
constexpr int ATT_N = 2120, ATT_NP = 2304;
constexpr float EPS = 1e-6f;
constexpr int NWAVES = 8, NTHREADS = 512;

__device__ __forceinline__ unsigned f2bf(float f) { unsigned u = __builtin_bit_cast(unsigned, f); return (u + 0x7fffu + ((u >> 16) & 1u)) >> 16; }
__device__ __forceinline__ unsigned pk2(float lo, float hi) { return f2bf(lo) | (f2bf(hi) << 16); }
__device__ __forceinline__ unsigned cvt_pk_bf16(float lo, float hi) { unsigned r; asm volatile("v_cvt_pk_bf16_f32 %0, %1, %2" : "=v"(r) : "v"(lo), "v"(hi)); return r; }
__device__ __forceinline__ float bflo(unsigned u) { return __uint_as_float(u << 16); }
__device__ __forceinline__ float bfhi(unsigned u) { return __uint_as_float(u & 0xffff0000u); }
__device__ __forceinline__ float wave_sum(float v) {
#pragma unroll
    for (int o = 1; o < 64; o <<= 1) v += __shfl_xor(v, o);
    return v;
}
__device__ __forceinline__ float fast_rcp(float x) { return __builtin_amdgcn_rcpf(x); }
__device__ __forceinline__ float silu_f(float g) { return g * fast_rcp(1.f + __expf(-g)); }
__device__ __forceinline__ float sigmoid_f(float g) { return fast_rcp(1.f + __expf(-g)); }
__device__ __forceinline__ float gelu_tanh_f(float y) { const float z = 0.7978845608028654f * (y + 0.044715f * y * y * y); const float t = 1.f - 2.f * fast_rcp(__expf(2.f * z) + 1.f); return 0.5f * y * (1.f + t); }

constexpr size_t WS_ROWIDX_B = 2u << 20, WS_GATEP_B = (2u << 20) + 512 * 1024, WS_SLOT_B = 3u << 20;
__device__ __forceinline__ int lane_id_fresh() { int l; asm volatile("v_mbcnt_lo_u32_b32 %0, -1, 0\n\tv_mbcnt_hi_u32_b32 %0, -1, %0" : "=v"(l)); return l; }
#ifndef FUSE_R
#define FUSE_R 1
#endif
#ifndef FUSE_N
#define FUSE_N 1
#endif
#ifndef M2_FP8
#define M2_FP8 1
#endif
#ifndef F1L0_FP8
#define F1L0_FP8 1
#endif
#ifndef M1L1_FP8
#define M1L1_FP8 1
#endif
#ifndef M1_FP8
#define M1_FP8 1
#endif
#ifndef F2L0_FP8
#define F2L0_FP8 1
#endif
#ifndef F2_FP8
#define F2_FP8 1
#endif
namespace pg8 {
constexpr int BM = 256, BK = 64, HALF = 128, HTB = HALF * BK * 2, STAGE_BYTES = 8 * HTB, NXCD = 8, WGM = 8;
__host__ __device__ __forceinline__ int lds_byte(int r, int c) { const int st = (r >> 4) * 2 + (c >> 5), rr = r & 15, cc = c & 31, ob = rr * 64 + cc * 2; return st * 1024 + (ob ^ (((ob >> 9) & 1) << 5)); }
__host__ __device__ __forceinline__ void stage_rc(int b, int& R, int& C) { const int st = b / 1024, sb = b % 1024, swz = sb ^ (((sb >> 9) & 1) << 5); R = (st >> 1) * 16 + swz / 64; C = (st & 1) * 32 + (swz % 64) / 2; }
__host__ __device__ __forceinline__ int perm32(int rho) { const int n = rho >> 4, i = rho & 15; return 8 * (i >> 2) + 4 * n + (i & 3); }

struct Unit { int pm, pn, e, aux; };
struct Gemm { const bf16_t* A; const bf16_t* Bt; int M, N, K; size_t bstride_e; const int* rowidx; const unsigned* cnt; };

struct StaticOrder {
    int nM, nN, nwg, G, c;
    __device__ __forceinline__ void init(int M_, int N_, int G_, int c_) { nM = M_ / BM; nN = N_ / BM; nwg = nM * nN; G = G_; c = c_; }
    __device__ __forceinline__ bool next(int i, Unit& u) const {
        const long L = (long)i * G + c; if (L >= nwg) return false;
        int wgid = (int)L; { const int q = nwg / NXCD, r = nwg % NXCD, xcd = wgid % NXCD, off = wgid / NXCD; wgid = (xcd < r ? xcd * (q + 1) : r * (q + 1) + (xcd - r) * q) + off; }
        const int nig = WGM * nN, gid = wgid / nig, fm = gid * WGM, gsz = (nM - fm) < WGM ? (nM - fm) : WGM;
        u.pm = fm + ((wgid % nig) % gsz); u.pn = (wgid % nig) / gsz; u.e = 0; u.aux = 0; return true;
    }
};
struct MoeOrder {
    int T1, T2, T3, T4, T5, T6, T7, T8, NT, W, r, lo, ntl;
    static constexpr int RG = 4;
    __device__ __forceinline__ void init(const unsigned* cnt, int NT_, int G_, int c_) {
        int t[9]; int acc = 0;
#pragma unroll
        for (int e = 0; e < 8; ++e) { t[e] = acc; acc += (int)((__hip_atomic_load(cnt + 64 * e, RLX_AGENT) + 255u) >> 8); }
        t[8] = acc; T1 = t[1]; T2 = t[2]; T3 = t[3]; T4 = t[4]; T5 = t[5]; T6 = t[6]; T7 = t[7]; T8 = t[8]; NT = NT_;
        if (G_ % 8 == 0) { const int xv = c_ % 8; W = G_ / 8; r = c_ / 8; lo = (T8 * xv) / 8; ntl = (T8 * (xv + 1)) / 8 - lo; }
        else { W = G_; r = c_; lo = 0; ntl = T8; }
    }
    __device__ __forceinline__ bool next(int i, Unit& u) const {
        const int q = i * W + r; if (q >= ntl * NT) return false;
        const int nig = RG * NT, gid = q / nig, fm = gid * RG, gsz = (ntl - fm) < RG ? (ntl - fm) : RG, w = q - gid * nig;
        const int tt = lo + fm + (w % gsz), pn = w / gsz;
        int e = 0, te = 0;
        if (tt >= T1) { e = 1; te = T1; } if (tt >= T2) { e = 2; te = T2; } if (tt >= T3) { e = 3; te = T3; } if (tt >= T4) { e = 4; te = T4; }
        if (tt >= T5) { e = 5; te = T5; } if (tt >= T6) { e = 6; te = T6; } if (tt >= T7) { e = 7; te = T7; }
        u.pm = tt; u.pn = pn; u.e = e; u.aux = e * 16384 + 256 * (tt - te); return true;
    }
};

typedef int v8i32 __attribute__((ext_vector_type(8)));
typedef int v4i32 __attribute__((ext_vector_type(4)));
constexpr float W8_MUL = 32.0f, W8_INV = 1.0f / 32.0f;
__device__ __forceinline__ void mfma8(f32x4& c, const v8i32 a, const v8i32 b) { asm volatile("v_mfma_f32_16x16x128_f8f6f4 %0, %1, %2, %0" : "+v"(c) : "v"(a), "v"(b)); }
__device__ __forceinline__ v8i32 cat8(const bf16x8 a, const bf16x8 b) { return __builtin_shufflevector(__builtin_bit_cast(v4i32, a), __builtin_bit_cast(v4i32, b), 0, 1, 2, 3, 4, 5, 6, 7); }
template <class Epi, class Sched, bool GATHER, bool FP8 = false>
__device__ __forceinline__ void gemm_phase(LAS unsigned char* lds, const Gemm g, const Sched& S, const Epi& E, const int wid) {
    const int lane = lane_id_fresh(), tid = wid * 64 + lane, wr = wid >> 2, wc = wid & 3, fr = lane & 15, fq = lane >> 4;
    const int K = FP8 ? g.K / 2 : g.K, nt = K / BK;
    unsigned voffB[2]; int stR[2], stC[2];
#pragma unroll
    for (int i = 0; i < 2; ++i) { int R, C; stage_rc(tid * 16 + i * 8192, R, C); const int Rb = (R & ~31) + perm32(R & 31);
        stR[i] = R; stC[i] = C; voffB[i] = (unsigned)(Rb * K + C) * 2u; }
    const size_t kstep = (size_t)(BK * 2);
    const size_t hstep = (size_t)HALF * K * 2;
    const size_t tstep = 2 * hstep;
    const unsigned ldsw = (unsigned)wid * 1024u;
    const int aoff = lds_byte(wr * 64 + fr, fq * 8), boff = lds_byte(wc * 32 + fr, fq * 8);
#define PG8_SA(b, h) (((b) * 2 + (h)) * HTB)
#define PG8_SB(b, h) ((4 + (b) * 2 + (h)) * HTB)
#define PG8_STAGE(bufoff, gbase, voff) do { _Pragma("unroll") for (int _i = 0; _i < 2; ++_i) \
        __builtin_amdgcn_global_load_lds((const unsigned*)((const char*)(gbase) + (voff)[_i]), (LAS unsigned*)(lds + (bufoff) + ldsw + _i * 8192), 16, 0, 0); } while (0)
#define PG8_LDA(dst, b, h) do { _Pragma("unroll") for (int m = 0; m < 4; ++m) _Pragma("unroll") for (int k = 0; k < 2; ++k) dst[m][k] = *(const LAS bf16x8*)(lds + PG8_SA(b, h) + aoff + m * 2048 + k * 1024); } while (0)
#define PG8_LDB(dst, b, h) do { _Pragma("unroll") for (int n = 0; n < 2; ++n) _Pragma("unroll") for (int k = 0; k < 2; ++k) dst[n][k] = *(const LAS bf16x8*)(lds + PG8_SB(b, h) + boff + n * 2048 + k * 1024); } while (0)
#define PG8_MMA(ai, bj, At, Bt) do { __builtin_amdgcn_s_setprio(1); _Pragma("unroll") for (int m = 0; m < 4; ++m) _Pragma("unroll") for (int n = 0; n < 2; ++n) { \
        if (FP8) mfma8(acc[ai][bj][m][n], cat8(Bt[n][0], Bt[n][1]), cat8(At[m][0], At[m][1])); \
        else { _Pragma("unroll") for (int k = 0; k < 2; ++k) acc[ai][bj][m][n] = __builtin_amdgcn_mfma_f32_16x16x32_bf16(Bt[n][k], At[m][k], acc[ai][bj][m][n], 0, 0, 0); } } \
        __builtin_amdgcn_s_setprio(0); } while (0)
#define PG8_MMA_END(At, B0, B1) do { if (FP8) { asm volatile("s_nop 15\n\ts_nop 15\n\ts_nop 15\n\ts_nop 15" :: "v"(cat8(At[0][0], At[0][1])), "v"(cat8(At[1][0], At[1][1])), "v"(cat8(At[2][0], At[2][1])), "v"(cat8(At[3][0], At[3][1])), \
        "v"(cat8(B0[0][0], B0[0][1])), "v"(cat8(B0[1][0], B0[1][1])), "v"(cat8(B1[0][0], B1[0][1])), "v"(cat8(B1[1][0], B1[1][1]))); } } while (0)
#define PG8_WAIT_V(n) asm volatile("s_waitcnt vmcnt(" #n ")" ::: "memory")
#define PG8_WAIT_L(n) asm volatile("s_waitcnt lgkmcnt(" #n ")" ::: "memory")
#define PG8_BAR __builtin_amdgcn_s_barrier()
#define PG8_SCHED __builtin_amdgcn_sched_barrier(0)
#define PG8_AOFFS(v, U) do { _Pragma("unroll") for (int _h = 0; _h < 2; ++_h) _Pragma("unroll") for (int _i = 0; _i < 2; ++_i) { \
        if (GATHER) { const int _loc = ((U).aux & 16383) + _h * HALF + stR[_i]; const int _e = (U).aux >> 14; \
            const int _row = (_loc < (int)g.cnt[64 * _e]) ? g.rowidx[(U).aux + _h * HALF + stR[_i]] : 0; \
            v[_h][_i] = (unsigned)(_row * K + stC[_i]) * 2u; } \
        else v[_h][_i] = (unsigned)((_h * HALF + stR[_i]) * K + stC[_i]) * 2u; } } while (0)
    int cn8[8];
#pragma unroll
    for (int e = 0; e < 8; ++e) cn8[e] = GATHER ? __builtin_amdgcn_readfirstlane((int)g.cnt[64 * e]) : 0;
    Unit cur, nxt; int ui = 0;
    if (!S.next(0, cur)) return;
    f32x4 acc[2][2][4][2];
#pragma unroll
    for (int a = 0; a < 2; ++a)
#pragma unroll
        for (int b = 0; b < 2; ++b)
#pragma unroll
            for (int m = 0; m < 4; ++m)
#pragma unroll
                for (int n = 0; n < 2; ++n) acc[a][b][m][n] = (f32x4){0.f, 0.f, 0.f, 0.f};
    bf16x8 At[4][2], B0[2][2], B1[2][2];
    unsigned vAc[2][2], vAn[2][2];
    PG8_AOFFS(vAc, cur);
    const char* cA = (const char*)g.A + (GATHER ? (size_t)0 : (size_t)cur.pm * tstep);
    const char* cB = (const char*)g.Bt + (size_t)cur.e * g.bstride_e + (size_t)cur.pn * tstep;
    PG8_STAGE(PG8_SB(0, 0), cB, voffB); PG8_STAGE(PG8_SB(0, 1), cB + hstep, voffB); PG8_STAGE(PG8_SA(0, 0), cA, vAc[0]); PG8_STAGE(PG8_SA(0, 1), cA, vAc[1]);
    if (wr == 1) PG8_BAR;
    PG8_WAIT_V(2); PG8_BAR;
    PG8_STAGE(PG8_SB(1, 0), cB + kstep, voffB); PG8_STAGE(PG8_SA(1, 0), cA + kstep, vAc[0]); PG8_STAGE(PG8_SB(1, 1), cB + hstep + kstep, voffB);
    PG8_WAIT_V(6); PG8_BAR;
    for (;;) {
        const bool has_next = S.next(ui + 1, nxt);
        const char* nA = cA; const char* nB = cB;
        int rn[2][2];
        if (has_next) { if (GATHER) {
#pragma unroll
                for (int h = 0; h < 2; ++h)
#pragma unroll
                    for (int i = 0; i < 2; ++i) rn[h][i] = g.rowidx[nxt.aux + h * HALF + stR[i]]; }
            else PG8_AOFFS(vAn, nxt);
            nA = (const char*)g.A + (GATHER ? (size_t)0 : (size_t)nxt.pm * tstep); nB = (const char*)g.Bt + (size_t)nxt.e * g.bstride_e + (size_t)nxt.pn * tstep; }
        else {
#pragma unroll
            for (int h = 0; h < 2; ++h)
#pragma unroll
                for (int i = 0; i < 2; ++i) vAn[h][i] = vAc[h][i];
        }
#pragma nounroll
        for (int t = 0; t < nt; t += 2) {
            const bool last = (t == nt - 2);
            const char* a1 = cA + (size_t)(t + 1) * kstep;
            const char* a2 = last ? nA : cA + (size_t)(t + 2) * kstep; const char* b2 = last ? nB : cB + (size_t)(t + 2) * kstep;
            const char* a3 = a2 + kstep; const char* b3 = b2 + kstep;
            if (GATHER && last && has_next) { const int _e = nxt.aux >> 14;
                const int _cn = _e == 0 ? cn8[0] : _e == 1 ? cn8[1] : _e == 2 ? cn8[2] : _e == 3 ? cn8[3] : _e == 4 ? cn8[4] : _e == 5 ? cn8[5] : _e == 6 ? cn8[6] : cn8[7];
#pragma unroll
                for (int h = 0; h < 2; ++h)
#pragma unroll
                    for (int i = 0; i < 2; ++i) { int r_ = rn[h][i]; asm volatile("" : "+v"(r_)); const int _loc = (nxt.aux & 16383) + h * HALF + stR[i];
                        r_ = _loc < _cn ? r_ : 0; vAn[h][i] = (unsigned)(r_ * K + stC[i]) * 2u; } }
            unsigned v2[2][2];
#pragma unroll
            for (int h = 0; h < 2; ++h)
#pragma unroll
                for (int i = 0; i < 2; ++i) v2[h][i] = last ? vAn[h][i] : vAc[h][i];
            PG8_LDB(B0, 0, 0); PG8_LDB(B1, 0, 1); PG8_SCHED; PG8_LDA(At, 0, 0); PG8_STAGE(PG8_SA(1, 1), a1, vAc[1]);
            PG8_WAIT_V(8); PG8_WAIT_L(0); PG8_BAR; PG8_MMA(0, 0, At, B0); PG8_MMA(0, 1, At, B1); PG8_MMA_END(At, B0, B1); PG8_BAR; PG8_SCHED;
            PG8_LDA(At, 0, 1); PG8_STAGE(PG8_SB(0, 0), b2, voffB); PG8_STAGE(PG8_SB(0, 1), b2 + hstep, voffB); PG8_STAGE(PG8_SA(0, 0), a2, v2[0]);
            PG8_WAIT_V(8); PG8_WAIT_L(0); PG8_BAR; PG8_MMA(1, 0, At, B0); PG8_MMA(1, 1, At, B1); PG8_MMA_END(At, B0, B1); PG8_BAR; PG8_SCHED;
            PG8_LDB(B0, 1, 0); PG8_LDB(B1, 1, 1); PG8_SCHED; PG8_LDA(At, 1, 0); PG8_STAGE(PG8_SA(0, 1), a2, v2[1]);
            PG8_WAIT_V(8); PG8_WAIT_L(0); PG8_BAR; PG8_MMA(0, 0, At, B0); PG8_MMA(0, 1, At, B1); PG8_MMA_END(At, B0, B1); PG8_BAR; PG8_SCHED;
            PG8_LDA(At, 1, 1); PG8_STAGE(PG8_SB(1, 0), b3, voffB); PG8_STAGE(PG8_SB(1, 1), b3 + hstep, voffB); PG8_STAGE(PG8_SA(1, 0), a3, v2[0]);
            PG8_WAIT_V(8); PG8_WAIT_L(0); PG8_BAR; PG8_MMA(1, 0, At, B0); PG8_MMA(1, 1, At, B1); PG8_MMA_END(At, B0, B1); PG8_BAR; PG8_SCHED;
        }
        if (wr == 0) PG8_BAR;
        if (FP8) asm volatile("s_nop 15\n\ts_nop 15\n\ts_nop 15\n\ts_nop 15\n\ts_nop 15\n\ts_nop 15" ::: "memory");
        if constexpr (!Epi::FUSED) E(acc, cur, wr, wc, fr, fq);
        if (!has_next) break;
#pragma unroll
        for (int a = 0; a < 2; ++a)
#pragma unroll
            for (int b = 0; b < 2; ++b)
#pragma unroll
                for (int m = 0; m < 4; ++m)
#pragma unroll
                    for (int n = 0; n < 2; ++n) acc[a][b][m][n] = (f32x4){0.f, 0.f, 0.f, 0.f};
        cur = nxt; cA = nA; cB = nB; ++ui;
#pragma unroll
        for (int h = 0; h < 2; ++h)
#pragma unroll
            for (int i = 0; i < 2; ++i) vAc[h][i] = vAn[h][i];
        if (wr == 1) PG8_BAR;
    }
    PG8_WAIT_V(0);
    PG8_BAR;
    if constexpr (Epi::FUSED) E.fused(acc, cur, wr, wc, fr, fq, lds, wid, lane);
#undef PG8_SA
#undef PG8_SB
#undef PG8_STAGE
#undef PG8_LDA
#undef PG8_LDB
#undef PG8_MMA
#undef PG8_MMA_END
#undef PG8_WAIT_V
#undef PG8_WAIT_L
#undef PG8_BAR
#undef PG8_SCHED
#undef PG8_AOFFS
}

__device__ __forceinline__ f32x4 ldx16(const float* p) { return *(const f32x4*)p; }
typedef f32x4 Acc[2][2][4][2];
__device__ __forceinline__ u32x4 pack8(const f32x4 a, const f32x4 b) { u32x4 w; w.x = cvt_pk_bf16(a[0], a[1]); w.y = cvt_pk_bf16(a[2], a[3]); w.z = cvt_pk_bf16(b[0], b[1]); w.w = cvt_pk_bf16(b[2], b[3]); return w; }

template <int MODE, bool OUT8 = false, bool SC8 = OUT8> struct EpiPair {
    static constexpr bool FUSED = false;
    bf16_t* O; int ldo;
    __device__ __forceinline__ void operator()(const Acc& acc, const Unit& u, int wr, int wc, int fr, int fq) const {
        const int row0 = u.pm * BM + wr * 64 + fr, col0 = u.pn * HALF + wc * 32 + 8 * fq;
#pragma unroll
        for (int ai = 0; ai < 2; ++ai)
#pragma unroll
            for (int m = 0; m < 4; ++m) { f32x4 r0, r1;
#pragma unroll
                for (int e = 0; e < 4; ++e) { const float sc8 = SC8 ? W8_INV : 1.0f; const float a0 = acc[ai][0][m][0][e] * sc8, a1 = acc[ai][0][m][1][e] * sc8, b0 = acc[ai][1][m][0][e] * sc8, b1 = acc[ai][1][m][1][e] * sc8;
                    r0[e] = (MODE == 1 ? silu_f(a0) : a0) * b0; r1[e] = (MODE == 1 ? silu_f(a1) : a1) * b1; }
                if (OUT8) { u32x2 w; int t0 = 0, t1 = 0; t0 = __builtin_amdgcn_cvt_pk_fp8_f32(r0[0], r0[1], t0, false); t0 = __builtin_amdgcn_cvt_pk_fp8_f32(r0[2], r0[3], t0, true);
                    t1 = __builtin_amdgcn_cvt_pk_fp8_f32(r1[0], r1[1], t1, false); t1 = __builtin_amdgcn_cvt_pk_fp8_f32(r1[2], r1[3], t1, true); w.x = (unsigned)t0; w.y = (unsigned)t1;
                    *(u32x2*)((unsigned char*)O + (size_t)(row0 + ai * HALF + m * 16) * ldo + col0) = w; }
                else *(u32x4*)(O + (size_t)(row0 + ai * HALF + m * 16) * ldo + col0) = pack8(r0, r1); }
    }
};
struct EpiConvIn {
    static constexpr bool FUSED = false;
    bf16_t* UB;
    __device__ __forceinline__ void operator()(const Acc& acc, const Unit& u, int wr, int wc, int fr, int fq) const {
        const int row0 = u.pm * BM + wr * 64 + fr;
        if (u.pn < 8) { EpiPair<0, false, false> P{UB, 2048}; P(acc, u, wr, wc, fr, fq); }
        else { const int col0 = 1024 + (u.pn - 8) * BM + wc * 32 + 8 * fq;
#pragma unroll
            for (int ai = 0; ai < 2; ++ai)
#pragma unroll
                for (int m = 0; m < 4; ++m)
#pragma unroll
                    for (int bj = 0; bj < 2; ++bj) *(u32x4*)(UB + (size_t)(row0 + ai * HALF + m * 16) * 2048 + col0 + bj * HALF) = pack8(acc[ai][bj][m][0], acc[ai][bj][m][1]); }
    }
};
struct EpiRes {
    static constexpr bool FUSED = false;
    float* X; const float* gate; const float* Xin; float asc;
    __device__ __forceinline__ void operator()(const Acc& acc, const Unit& u, int wr, int wc, int fr, int fq) const {
        const int row0 = u.pm * BM + wr * 64 + fr, col0 = u.pn * BM + wc * 32 + 8 * fq; const int b = (u.pm * BM) / SEQ;
        f32x4 gv[2][2];
#pragma unroll
        for (int bj = 0; bj < 2; ++bj)
#pragma unroll
            for (int n = 0; n < 2; ++n) gv[bj][n] = *(const f32x4*)(gate + (size_t)b * 6144 + col0 + bj * HALF + 4 * n) * asc;
#pragma unroll
        for (int ai = 0; ai < 2; ++ai) {
            f32x4 xv[4][2][2];
#pragma unroll
            for (int m = 0; m < 4; ++m) { const float* ri = Xin + (size_t)(row0 + ai * HALF + m * 16) * DM + col0;
#pragma unroll
                for (int bj = 0; bj < 2; ++bj)
#pragma unroll
                    for (int n = 0; n < 2; ++n) xv[m][bj][n] = ldx16(ri + bj * HALF + 4 * n); }
            asm volatile("" ::: "memory");
#pragma unroll
            for (int m = 0; m < 4; ++m) { float* rp = X + (size_t)(row0 + ai * HALF + m * 16) * DM + col0;
#pragma unroll
                for (int bj = 0; bj < 2; ++bj)
#pragma unroll
                    for (int n = 0; n < 2; ++n) *(f32x4*)(rp + bj * HALF + 4 * n) = xv[m][bj][n] + gv[bj][n] * acc[ai][bj][m][n]; }
            asm volatile("" ::: "memory");
        }
    }
};
struct EpiResNorm {
    static constexpr bool FUSED = true;
    float* X; const float* gate; const float* Xin; const float* ng; const float* shb; bf16_t* H; float* xs; gu32* cnt; gu32* tmo; float asc; int h8;
    __device__ __forceinline__ void fused(Acc& acc, const Unit& u, int wr, int wc, int fr, int fq, LAS unsigned char* lds, int wid, int lane) const {
        const int row0 = u.pm * BM + wr * 64 + fr, col0 = u.pn * BM + wc * 32 + 8 * fq; const int b = (u.pm * BM) / SEQ;
        LAS float* P = (LAS float*)lds; LAS float* S = (LAS float*)(lds + 4096);
        { f32x4 gv[2][2];
#pragma unroll
          for (int bj = 0; bj < 2; ++bj)
#pragma unroll
              for (int n = 0; n < 2; ++n) gv[bj][n] = *(const f32x4*)(gate + (size_t)b * 6144 + col0 + bj * HALF + 4 * n) * asc;
#pragma unroll
          for (int ai = 0; ai < 2; ++ai) {
              f32x4 xv[4][2][2];
#pragma unroll
              for (int m = 0; m < 4; ++m) { const float* ri = Xin + (size_t)(row0 + ai * HALF + m * 16) * DM + col0;
#pragma unroll
                  for (int bj = 0; bj < 2; ++bj)
#pragma unroll
                      for (int n = 0; n < 2; ++n) xv[m][bj][n] = ldx16(ri + bj * HALF + 4 * n); }
              asm volatile("" ::: "memory");
#pragma unroll
              for (int m = 0; m < 4; ++m) { float* rp = X + (size_t)(row0 + ai * HALF + m * 16) * DM + col0; float ss = 0.f;
#pragma unroll
                  for (int bj = 0; bj < 2; ++bj)
#pragma unroll
                      for (int n = 0; n < 2; ++n) { const f32x4 x = xv[m][bj][n] + gv[bj][n] * acc[ai][bj][m][n]; acc[ai][bj][m][n] = x; *(f32x4*)(rp + bj * HALF + 4 * n) = x;
                          ss += (x[0] * x[0] + x[1] * x[1]) + (x[2] * x[2] + x[3] * x[3]); }
                  ss += __shfl_xor(ss, 16); ss += __shfl_xor(ss, 32);
                  if (fq == 0) P[(ai * HALF + wr * 64 + m * 16 + fr) * 4 + wc] = ss; }
              asm volatile("" ::: "memory");
          } }
        asm volatile("s_waitcnt lgkmcnt(0)" ::: "memory"); __builtin_amdgcn_s_barrier(); asm volatile("" ::: "memory");
        const int tid = wid * 64 + lane;
        if (tid < 256) { const f32x4 p4 = *(const LAS f32x4*)(P + tid * 4); const float sp = (p4[0] + p4[1]) + (p4[2] + p4[3]);
            __hip_atomic_store((gu32*)xs + ((size_t)(u.pm * BM + tid) * 4 + u.pn), __float_as_uint(sp), RLX_AGENT); }
        asm volatile("s_waitcnt vmcnt(0)" ::: "memory");
        if (wid < 4 && lane == 0) __hip_atomic_fetch_add(cnt + 64 * u.pm, 1u, RLX_AGENT);
        if (wid == 0) { unsigned spins = 0;
            while ((unsigned)__builtin_amdgcn_readfirstlane(__hip_atomic_load(cnt + 64 * u.pm, RLX_AGENT)) < 16u) { __builtin_amdgcn_s_sleep(2);
                if (++spins > (1u << 20)) { if (lane == 0) __hip_atomic_store(tmo, 1u, RLX_AGENT); break; } } }
        asm volatile("s_waitcnt vmcnt(0) lgkmcnt(0)" ::: "memory"); __builtin_amdgcn_s_barrier(); asm volatile("" ::: "memory");
        if (tid < 256) { const GAS unsigned long long* q = (const GAS unsigned long long*)xs + (size_t)(u.pm * BM + tid) * 2;
            const unsigned long long a = __hip_atomic_load(q, RLX_AGENT), c = __hip_atomic_load(q + 1, RLX_AGENT);
            const float tot = (__uint_as_float((unsigned)a) + __uint_as_float((unsigned)(a >> 32))) + (__uint_as_float((unsigned)c) + __uint_as_float((unsigned)(c >> 32)));
            S[tid] = 1.0f / sqrtf(tot * (1.0f / DM) + EPS); }
        asm volatile("s_waitcnt vmcnt(0) lgkmcnt(0)" ::: "memory"); __builtin_amdgcn_s_barrier(); asm volatile("" ::: "memory");
        f32x4 gm[2][2], sf[2][2];
#pragma unroll
        for (int bj = 0; bj < 2; ++bj)
#pragma unroll
            for (int n = 0; n < 2; ++n) { const int c = col0 + bj * HALF + 4 * n; const f32x4 g4 = *(const f32x4*)(ng + c), s1 = *(const f32x4*)(shb + (size_t)b * 6144 + DM + c);
                gm[bj][n] = g4 * (s1 + 1.0f); sf[bj][n] = *(const f32x4*)(shb + (size_t)b * 6144 + c); }
#pragma unroll
        for (int ai = 0; ai < 2; ++ai)
#pragma unroll
            for (int m = 0; m < 4; ++m) { const float r = S[ai * HALF + wr * 64 + m * 16 + fr]; bf16_t* hp = H + (size_t)(row0 + ai * HALF + m * 16) * DM + col0;
#pragma unroll
                for (int bj = 0; bj < 2; ++bj) { const f32x4 h0 = (acc[ai][bj][m][0] * r) * gm[bj][0] + sf[bj][0], h1 = (acc[ai][bj][m][1] * r) * gm[bj][1] + sf[bj][1];
                    if (F1L0_FP8 && h8) { int t0 = 0, t1 = 0; t0 = __builtin_amdgcn_cvt_pk_fp8_f32(h0[0], h0[1], t0, false); t0 = __builtin_amdgcn_cvt_pk_fp8_f32(h0[2], h0[3], t0, true);
                        t1 = __builtin_amdgcn_cvt_pk_fp8_f32(h1[0], h1[1], t1, false); t1 = __builtin_amdgcn_cvt_pk_fp8_f32(h1[2], h1[3], t1, true); u32x2 w; w.x = (unsigned)t0; w.y = (unsigned)t1;
                        *(u32x2*)((unsigned char*)H + (size_t)(row0 + ai * HALF + m * 16) * DM + col0 + bj * HALF) = w; }
                    else *(u32x4*)(hp + bj * HALF) = pack8(h0, h1); } }
    }
};
struct EpiResNormRouter {
    static constexpr bool FUSED = true;
    float* X; const float* gate; const float* ng; const float* shb; bf16_t* H; float* xs9; gu32* cnt; gu32* tmo;
    const float* rw; const float* rb; gu32* ecnt; unsigned char* meta; int h8;
    __device__ __forceinline__ void fused(Acc& acc, const Unit& u, int wr, int wc, int fr, int fq, LAS unsigned char* lds, int wid, int lane) const {
        const int row0 = u.pm * BM + wr * 64 + fr, col0 = u.pn * BM + wc * 32 + 8 * fq; const int b = (u.pm * BM) / SEQ; const int tid = wid * 64 + lane;
        LAS float* P9 = (LAS float*)lds; LAS float* RWT = (LAS float*)(lds + 36864); LAS float* S = (LAS float*)(lds + 45056); LAS float* CE = (LAS float*)(lds + 46080);
        LAS int* rE = (LAS int*)(lds + 46144); LAS float* red = (LAS float*)(lds + 47360);
        const float* shp = shb + (size_t)b * 6144;
        for (int i = tid; i < 2048; i += NTHREADS) { const int c = i >> 3, e = i & 7; RWT[e * 256 + c] = rw[(size_t)(u.pn * BM + c) * 8 + e]; }
        { float ce[8]; const float s0 = shp[tid], s1 = shp[tid + 512];
#pragma unroll
          for (int e = 0; e < 8; ++e) ce[e] = wave_sum(s0 * rw[(size_t)tid * 8 + e] + s1 * rw[(size_t)(tid + 512) * 8 + e]);
          if (lane == 0) {
#pragma unroll
              for (int e = 0; e < 8; ++e) red[wid * 8 + e] = ce[e]; } }
        { f32x4 gv[2][2];
#pragma unroll
          for (int bj = 0; bj < 2; ++bj)
#pragma unroll
              for (int n = 0; n < 2; ++n) gv[bj][n] = *(const f32x4*)(gate + (size_t)b * 6144 + col0 + bj * HALF + 4 * n);
#pragma unroll
          for (int ai = 0; ai < 2; ++ai) {
              f32x4 xv[4][2][2];
#pragma unroll
              for (int m = 0; m < 4; ++m) { const float* ri = X + (size_t)(row0 + ai * HALF + m * 16) * DM + col0;
#pragma unroll
                  for (int bj = 0; bj < 2; ++bj)
#pragma unroll
                      for (int n = 0; n < 2; ++n) xv[m][bj][n] = ldx16(ri + bj * HALF + 4 * n); }
              asm volatile("" ::: "memory");
#pragma unroll
              for (int m = 0; m < 4; ++m) { float* rp = X + (size_t)(row0 + ai * HALF + m * 16) * DM + col0; float ss = 0.f;
#pragma unroll
                  for (int bj = 0; bj < 2; ++bj)
#pragma unroll
                      for (int n = 0; n < 2; ++n) { const f32x4 x = xv[m][bj][n] + gv[bj][n] * acc[ai][bj][m][n]; acc[ai][bj][m][n] = x; *(f32x4*)(rp + bj * HALF + 4 * n) = x;
                          ss += (x[0] * x[0] + x[1] * x[1]) + (x[2] * x[2] + x[3] * x[3]); }
                  ss += __shfl_xor(ss, 16); ss += __shfl_xor(ss, 32);
                  if (fq == 0) P9[((ai * HALF + wr * 64 + m * 16 + fr) * 4 + wc) * 9] = ss; }
              asm volatile("" ::: "memory");
          } }
        f32x4 sf[2][2];
#pragma unroll
        for (int bj = 0; bj < 2; ++bj)
#pragma unroll
            for (int n = 0; n < 2; ++n) { const int c = col0 + bj * HALF + 4 * n; const f32x4 gm = *(const f32x4*)(ng + c) * (*(const f32x4*)(shp + DM + c) + 1.0f); sf[bj][n] = *(const f32x4*)(shp + c);
#pragma unroll
                for (int ai = 0; ai < 2; ++ai)
#pragma unroll
                    for (int m = 0; m < 4; ++m) acc[ai][bj][m][n] = acc[ai][bj][m][n] * gm; }
        asm volatile("s_waitcnt lgkmcnt(0)" ::: "memory"); __builtin_amdgcn_s_barrier(); asm volatile("" ::: "memory");
        if (tid < 8) { float c = rb[tid];
#pragma unroll
            for (int w = 0; w < 8; ++w) c += red[w * 8 + tid];
            CE[tid] = c; }
#pragma unroll
        for (int e = 0; e < 8; ++e) { f32x4 rwe[2][2];
#pragma unroll
            for (int bj = 0; bj < 2; ++bj)
#pragma unroll
                for (int n = 0; n < 2; ++n) rwe[bj][n] = *(const LAS f32x4*)(RWT + e * 256 + bj * HALF + wc * 32 + 8 * fq + 4 * n);
#pragma unroll
            for (int ai = 0; ai < 2; ++ai)
#pragma unroll
                for (int m = 0; m < 4; ++m) { float a = 0.f;
#pragma unroll
                    for (int bj = 0; bj < 2; ++bj)
#pragma unroll
                        for (int n = 0; n < 2; ++n) { const f32x4 x = acc[ai][bj][m][n], w4 = rwe[bj][n]; a += (x[0] * w4[0] + x[1] * w4[1]) + (x[2] * w4[2] + x[3] * w4[3]); }
                    a += __shfl_xor(a, 16); a += __shfl_xor(a, 32);
                    if (fq == 0) P9[((ai * HALF + wr * 64 + m * 16 + fr) * 4 + wc) * 9 + 1 + e] = a; } }
        asm volatile("s_waitcnt lgkmcnt(0)" ::: "memory"); __builtin_amdgcn_s_barrier(); asm volatile("" ::: "memory");
        if (tid < 256) { gu32* q = (gu32*)xs9 + ((size_t)(u.pm * BM + tid) * 4 + u.pn) * 9;
#pragma unroll
            for (int k = 0; k < 9; ++k) { const float v = (P9[(tid * 4 + 0) * 9 + k] + P9[(tid * 4 + 1) * 9 + k]) + (P9[(tid * 4 + 2) * 9 + k] + P9[(tid * 4 + 3) * 9 + k]);
                __hip_atomic_store(q + k, __float_as_uint(v), RLX_AGENT); } }
        asm volatile("s_waitcnt vmcnt(0)" ::: "memory");
        if (wid < 4 && lane == 0) __hip_atomic_fetch_add(cnt + 64 * u.pm, 1u, RLX_AGENT);
        if (wid == 0) { unsigned spins = 0;
            while ((unsigned)__builtin_amdgcn_readfirstlane(__hip_atomic_load(cnt + 64 * u.pm, RLX_AGENT)) < 16u) { __builtin_amdgcn_s_sleep(2);
                if (++spins > (1u << 20)) { if (lane == 0) __hip_atomic_store(tmo, 1u, RLX_AGENT); break; } } }
        asm volatile("s_waitcnt vmcnt(0) lgkmcnt(0)" ::: "memory"); __builtin_amdgcn_s_barrier(); asm volatile("" ::: "memory");
        if (tid < 256) { const gu32* q = (const gu32*)xs9 + (size_t)(u.pm * BM + tid) * 36; float tot[9];
#pragma unroll
            for (int k = 0; k < 9; ++k) tot[k] = (__uint_as_float(__hip_atomic_load(q + k, RLX_AGENT)) + __uint_as_float(__hip_atomic_load(q + 9 + k, RLX_AGENT)))
                                               + (__uint_as_float(__hip_atomic_load(q + 18 + k, RLX_AGENT)) + __uint_as_float(__hip_atomic_load(q + 27 + k, RLX_AGENT)));
            const float r = 1.0f / sqrtf(tot[0] * (1.0f / DM) + EPS); S[tid] = r;
            if (wid == u.pn) {
                float lg[8];
#pragma unroll
                for (int e = 0; e < 8; ++e) lg[e] = r * tot[1 + e] + CE[e];
                int e0 = 0; float l0 = lg[0];
#pragma unroll
                for (int e = 1; e < 8; ++e) if (lg[e] > l0) { l0 = lg[e]; e0 = e; }
                int e1 = -1; float l1 = -3.0e38f;
#pragma unroll
                for (int e = 0; e < 8; ++e) if (e != e0 && lg[e] > l1) { l1 = lg[e]; e1 = e; }
                const float g0 = 1.0f / (1.0f + __expf(l1 - l0)), g1 = 1.0f - g0;
                int cmine = 0, r0 = 0, r1 = 0;
#pragma unroll
                for (int e = 0; e < 8; ++e) { const unsigned long long m0 = __ballot(e0 == e), m1 = __ballot(e1 == e);
                    const int below = (int)__builtin_amdgcn_mbcnt_hi((unsigned)(m0 >> 32), __builtin_amdgcn_mbcnt_lo((unsigned)m0, 0u)) + (int)__builtin_amdgcn_mbcnt_hi((unsigned)(m1 >> 32), __builtin_amdgcn_mbcnt_lo((unsigned)m1, 0u));
                    if (e0 == e) r0 = below; if (e1 == e) r1 = below; if (lane == e) cmine = __popcll(m0) + __popcll(m1); }
                unsigned base = 0u; if (lane < 8 && cmine) base = __hip_atomic_fetch_add(ecnt + 64 * lane, (unsigned)cmine, RLX_AGENT);
                const int p0 = (int)__shfl(base, e0) + r0, p1 = (int)__shfl(base, e1) + r1, grow = u.pm * BM + 64 * u.pn + lane;
                gu32* ri = (gu32*)(meta + WS_ROWIDX_B); gu32* gp = (gu32*)(meta + WS_GATEP_B); gu32* sl = (gu32*)(meta + WS_SLOT_B);
                __hip_atomic_store(ri + e0 * 16384 + p0, (unsigned)grow, RLX_AGENT); __hip_atomic_store(ri + e1 * 16384 + p1, (unsigned)grow, RLX_AGENT);
                __hip_atomic_store(gp + e0 * 16384 + p0, __float_as_uint(g0), RLX_AGENT); __hip_atomic_store(gp + e1 * 16384 + p1, __float_as_uint(g1), RLX_AGENT);
                __hip_atomic_store(sl + grow * 2, (unsigned)((e0 << 16) | p0), RLX_AGENT); __hip_atomic_store(sl + grow * 2 + 1, (unsigned)((e1 << 16) | p1), RLX_AGENT); } }
        asm volatile("s_waitcnt vmcnt(0) lgkmcnt(0)" ::: "memory"); __builtin_amdgcn_s_barrier(); asm volatile("" ::: "memory");
#pragma unroll
        for (int ai = 0; ai < 2; ++ai)
#pragma unroll
            for (int m = 0; m < 4; ++m) { const float r = S[ai * HALF + wr * 64 + m * 16 + fr]; bf16_t* hp = H + (size_t)(row0 + ai * HALF + m * 16) * DM + col0;
#pragma unroll
                for (int bj = 0; bj < 2; ++bj) { const f32x4 h0 = acc[ai][bj][m][0] * r + sf[bj][0], h1 = acc[ai][bj][m][1] * r + sf[bj][1];
                    if ((M1_FP8 || M1L1_FP8) && h8) { int t0 = 0, t1 = 0; t0 = __builtin_amdgcn_cvt_pk_fp8_f32(h0[0], h0[1], t0, false); t0 = __builtin_amdgcn_cvt_pk_fp8_f32(h0[2], h0[3], t0, true);
                        t1 = __builtin_amdgcn_cvt_pk_fp8_f32(h1[0], h1[1], t1, false); t1 = __builtin_amdgcn_cvt_pk_fp8_f32(h1[2], h1[3], t1, true); u32x2 w; w.x = (unsigned)t0; w.y = (unsigned)t1;
                        *(u32x2*)((unsigned char*)H + (size_t)(row0 + ai * HALF + m * 16) * DM + col0 + bj * HALF) = w; }
                    else *(u32x4*)(hp + bj * HALF) = pack8(h0, h1); } }
    }
};
struct EpiGluRes {
    static constexpr bool FUSED = false;
    float* X; const float* gate;
    __device__ __forceinline__ void operator()(const Acc& acc, const Unit& u, int wr, int wc, int fr, int fq) const {
        const int row0 = u.pm * BM + wr * 64 + fr, col0 = u.pn * HALF + wc * 32 + 8 * fq; const int b = (u.pm * BM) / SEQ;
        f32x4 gv[2];
#pragma unroll
        for (int n = 0; n < 2; ++n) gv[n] = *(const f32x4*)(gate + (size_t)b * 6144 + col0 + 4 * n);
        f32x4 xv[2][4][2];
#pragma unroll
        for (int ai = 0; ai < 2; ++ai)
#pragma unroll
            for (int m = 0; m < 4; ++m)
#pragma unroll
                for (int n = 0; n < 2; ++n) xv[ai][m][n] = ldx16(X + (size_t)(row0 + ai * HALF + m * 16) * DM + col0 + 4 * n);
        asm volatile("" ::: "memory");
#pragma unroll
        for (int ai = 0; ai < 2; ++ai)
#pragma unroll
            for (int m = 0; m < 4; ++m) { float* rp = X + (size_t)(row0 + ai * HALF + m * 16) * DM + col0;
#pragma unroll
                for (int n = 0; n < 2; ++n) { f32x4 x = xv[ai][m][n]; const f32x4 l = acc[ai][0][m][n], gg = acc[ai][1][m][n];
#pragma unroll
                    for (int e = 0; e < 4; ++e) x[e] += gv[n][e] * l[e] * sigmoid_f(gg[e]);
                    *(f32x4*)(rp + 4 * n) = x; } }
    }
};
struct EpiAttnIn {
    static constexpr bool FUSED = false;
    bf16_t *Q, *Kn, *V, *QI, *KI; float* WI; const float *qg, *kg;
    __device__ __forceinline__ void operator()(const Acc& acc, const Unit& u, int wr, int wc, int fr, int fq) const {
        const int row0 = u.pm * BM + wr * 64 + fr;
        if (u.pn < 5) {
            const bool isq = u.pn < 4; const float* gp = isq ? qg : kg; const float sc = isq ? 0.125f : 1.0f;
            f32x4 gn[2][2];
#pragma unroll
            for (int bj = 0; bj < 2; ++bj)
#pragma unroll
                for (int n = 0; n < 2; ++n) gn[bj][n] = *(const f32x4*)(gp + 32 * bj + 8 * fq + 4 * n) * sc;
            bf16_t* base = isq ? (Q + (size_t)(4 * u.pn + wc) * 64) : (Kn + (size_t)wc * 64); const int ldo = isq ? 1024 : 256;
#pragma unroll
            for (int ai = 0; ai < 2; ++ai)
#pragma unroll
                for (int m = 0; m < 4; ++m) { float ss = 0.f;
#pragma unroll
                    for (int bj = 0; bj < 2; ++bj)
#pragma unroll
                        for (int n = 0; n < 2; ++n) { const f32x4 x = acc[ai][bj][m][n]; ss += (x[0] * x[0] + x[1] * x[1]) + (x[2] * x[2] + x[3] * x[3]); }
                    ss += __shfl_xor(ss, 16); ss += __shfl_xor(ss, 32);
                    const float r = 1.0f / sqrtf(ss * (1.0f / 64.0f) + EPS);
#pragma unroll
                    for (int bj = 0; bj < 2; ++bj) *(u32x4*)(base + (size_t)(row0 + ai * HALF + m * 16) * ldo + 32 * bj + 8 * fq) = pack8(acc[ai][bj][m][0] * r * gn[bj][0], acc[ai][bj][m][1] * r * gn[bj][1]); }
        } else if (u.pn < 8) {
            bf16_t* base = (u.pn == 5) ? V : QI + (size_t)(u.pn - 6) * 256; const int ldo = (u.pn == 5) ? 256 : 512; const int col0 = wc * 32 + 8 * fq;
#pragma unroll
            for (int ai = 0; ai < 2; ++ai)
#pragma unroll
                for (int m = 0; m < 4; ++m)
#pragma unroll
                    for (int bj = 0; bj < 2; ++bj) *(u32x4*)(base + (size_t)(row0 + ai * HALF + m * 16) * ldo + col0 + bj * HALF) = pack8(acc[ai][bj][m][0], acc[ai][bj][m][1]);
        } else {
            if (wc < 2) {
#pragma unroll
                for (int ai = 0; ai < 2; ++ai)
#pragma unroll
                    for (int m = 0; m < 4; ++m) *(u32x4*)(KI + (size_t)(row0 + ai * HALF + m * 16) * 64 + wc * 32 + 8 * fq) = pack8(acc[ai][0][m][0], acc[ai][0][m][1]);
            } else if (wc == 2 && fq == 0) {
                const float s = 0.04419417382415922f;
#pragma unroll
                for (int ai = 0; ai < 2; ++ai)
#pragma unroll
                    for (int m = 0; m < 4; ++m) { float* wp = WI + (size_t)(row0 + ai * HALF + m * 16) * 8; *(f32x4*)wp = acc[ai][0][m][0] * s; *(f32x4*)(wp + 4) = acc[ai][0][m][1] * s; }
            }
        }
    }
};
struct EpiMoeDn {
    static constexpr bool FUSED = false;
    bf16_t* Y; const float* gatep;
    __device__ __forceinline__ void operator()(const Acc& acc, const Unit& u, int wr, int wc, int fr, int fq) const {
        const int row0 = u.pm * BM + wr * 64 + fr, col0 = u.pn * BM + wc * 32 + 8 * fq;
#pragma unroll
        for (int ai = 0; ai < 2; ++ai)
#pragma unroll
            for (int m = 0; m < 4; ++m) { const float gt = gatep[u.aux + ai * HALF + wr * 64 + m * 16 + fr] * (M2_FP8 ? W8_INV : 1.0f);
#pragma unroll
                for (int bj = 0; bj < 2; ++bj) *(u32x4*)(Y + (size_t)(row0 + ai * HALF + m * 16) * DM + col0 + bj * HALF) = pack8(acc[ai][bj][m][0] * gt, acc[ai][bj][m][1] * gt); }
    }
};
}

constexpr size_t MiB = 1u << 20;
constexpr size_t WS_CTL = 0, CTL_ZERO_BYTES = 1 * MiB;
constexpr size_t WS_MOD = 1 * MiB;
constexpr size_t WS_ROWIDX = 2 * MiB;
constexpr size_t WS_GATEP = 2 * MiB + 512 * 1024;
constexpr size_t WS_SLOT = 3 * MiB;
static_assert(WS_ROWIDX_B == WS_ROWIDX && WS_GATEP_B == WS_GATEP && WS_SLOT_B == WS_SLOT, "metadata offsets");
constexpr size_t WS_WCI = 8 * MiB;
constexpr size_t WS_WCO = 20 * MiB;
constexpr size_t WS_WAI = 24 * MiB;
constexpr size_t WS_WAO = 29 * MiB;
constexpr size_t WS_WGL = 31 * MiB;
constexpr size_t WS_WFG = 35 * MiB;
constexpr size_t WS_WFD = 57 * MiB;
constexpr size_t WS_WMG = 68 * MiB;
constexpr size_t WS_WMD = 244 * MiB;
constexpr size_t WS_HB = 332 * MiB;
constexpr size_t WS_BUF = 364 * MiB;
constexpr size_t WS_ACT = 432 * MiB;
constexpr size_t WS_END = 619 * MiB;
constexpr int MOE_ROWS = 2 * M + NEXP * 256;
constexpr size_t WS_Q = WS_BUF, WS_K = WS_BUF + 32 * MiB, WS_V = WS_BUF + 40 * MiB, WS_QI = WS_BUF + 48 * MiB;
constexpr size_t WS_SC = WS_ACT, WS_O = WS_ACT + 128 * MiB, WS_KI = WS_ACT + 160 * MiB, WS_WI = WS_ACT + 162 * MiB;
static_assert(WS_WMD + (size_t)16 * 1024 * 2816 * 2 <= WS_HB && WS_ACT + (size_t)MOE_ROWS * FF * 2 <= WS_END && WS_BUF + (size_t)MOE_ROWS * DM * 2 <= WS_ACT, "d_ws map");
constexpr int CW_TMO = 0;
constexpr int CW_CNT = 64;
constexpr int CW_BAR = 4096;
constexpr int CW_PAN = 16384;
constexpr size_t WS_XS9 = 5 * MiB + 768 * 1024;
constexpr size_t WS_XS = 5 * MiB + 512 * 1024;

constexpr int RING_BYTES = 131072;
constexpr int LDSCTL_OFF = RING_BYTES, MISC_OFF = LDSCTL_OFF + 320;
constexpr int LDS_BYTES = 147456;

#define XB_TMO      128
#define XB_XCNT(j)  (256  + 64 * (j))
#define XB_XSUB(j)  (1280 + 64 * (j))
#define XB_XGEN(j)  (2304 + 64 * (j))
#define XB_TOP      3328
#define XB_TOPGEN   3392
#define XCD_BAR_WORDS 3456
#define XB_SPIN_CAP (1u << 18)
__device__ __forceinline__ unsigned xb_ld(unsigned* p)              { return __hip_atomic_load(p, __ATOMIC_RELAXED, __HIP_MEMORY_SCOPE_AGENT); }
__device__ __forceinline__ unsigned xb_add(unsigned* p, unsigned v) { return __hip_atomic_fetch_add(p, v, __ATOMIC_RELAXED, __HIP_MEMORY_SCOPE_AGENT); }
__device__ __forceinline__ unsigned xb_xcc_id() { return (unsigned)__builtin_amdgcn_s_getreg((3 << 11) | 20) & 0xFu; }
#define XB_SPIN(cond, bar) do { unsigned _sp = 0; while (cond) { __builtin_amdgcn_s_sleep(1); \
    if ((++_sp & 255u) == 0u) { if (xb_ld(&(bar)[XB_TMO])) break; if (_sp > XB_SPIN_CAP) { atomicAdd(&(bar)[XB_TMO], 1u); break; } } } } while (0)
struct XcdBarrier { unsigned* bar; unsigned x; volatile LAS unsigned* st; int w; };
__device__ __forceinline__ bool xb_thread0(int w) { return w == 0 && lane_id_fresh() == 0; }
__device__ __forceinline__ XcdBarrier xcd_barrier_post(unsigned* bar, volatile LAS unsigned* st, int w) {
    XcdBarrier b; b.bar = bar; b.x = xb_xcc_id(); b.st = st; b.w = w;
    if (xb_thread0(w)) (void)xb_add(&bar[XB_XCNT(b.x)], 1u);
    return b;
}
__device__ __forceinline__ void xcd_barrier_complete(unsigned* bar, unsigned x, unsigned& nloc, unsigned& nx) {
    const unsigned G = gridDim.x * gridDim.y * gridDim.z;
    unsigned sum, cnt, mine, sp = 0u;
    for (;;) {
        sum = 0u; cnt = 0u; mine = 0u;
#pragma unroll
        for (unsigned j = 0; j < 16; ++j) { const unsigned c = xb_ld(&bar[XB_XCNT(j)]); sum += c; cnt += (c > 0u) ? 1u : 0u; mine = (j == x) ? c : mine; }
        if (sum == G) break;
        __builtin_amdgcn_s_sleep(1);
        if ((++sp & 255u) == 0u) { if (xb_ld(&bar[XB_TMO])) break; if (sp > XB_SPIN_CAP) { atomicAdd(&bar[XB_TMO], 1u); break; } }
    }
    nloc = mine > 0u ? mine : 1u; nx = cnt > 0u ? cnt : 1u;
}
__device__ __forceinline__ int lane_probe() { return (int)__builtin_amdgcn_mbcnt_hi(~0u, __builtin_amdgcn_mbcnt_lo(~0u, 0u)); }
__device__ __forceinline__ int lane_probe2() { return (int)__builtin_amdgcn_mbcnt_hi(~0u, __builtin_amdgcn_mbcnt_lo(~0u, 0u)); }
__device__ __forceinline__ void xcd_barrier(const XcdBarrier& b) {
    asm volatile("s_waitcnt vmcnt(0)" ::: "memory");
    __syncthreads();
    if (xb_thread0(b.w)) {
        unsigned* bar = b.bar;
        __builtin_amdgcn_s_waitcnt(0);
        unsigned nloc = b.st[0], nx = b.st[1];
        if (nloc == 0u) { xcd_barrier_complete(bar, b.x, nloc, nx); b.st[0] = nloc; b.st[1] = nx; }
        const unsigned old = xb_add(&bar[XB_XSUB(b.x)], 1u);
        const unsigned gen = old / nloc;
        if (old + 1u == (gen + 1u) * nloc) {
            __builtin_amdgcn_fence(__ATOMIC_RELEASE, "agent");
            asm volatile("s_waitcnt vmcnt(0)" ::: "memory");
            const unsigned og = xb_add(&bar[XB_TOP], 1u);
            const unsigned tg = og / nx;
            if (og + 1u == (tg + 1u) * nx) xb_add(&bar[XB_TOPGEN], 1u);
            else XB_SPIN(xb_ld(&bar[XB_TOPGEN]) == tg, bar);
            __builtin_amdgcn_fence(__ATOMIC_ACQUIRE, "agent");
            xb_add(&bar[XB_XGEN(b.x)], 1u);
        } else {
            XB_SPIN(xb_ld(&bar[XB_XGEN(b.x)]) == gen, bar);
            __builtin_amdgcn_fence(__ATOMIC_ACQUIRE, "agent");
        }
    }
    __syncthreads();
}

struct Args { const float* in[28]; float* out; unsigned char* ws; int ph_lo, ph_hi; };
enum { I_X = 0, I_C, I_ADAW, I_ADAB, I_NORMG, I_CWIN, I_CW, I_CWOUT, I_AWIN, I_QG, I_KG, I_AWOUT, I_RELB, I_SLRE, I_SLIM, I_SLOG, I_SBRE, I_SBIM, I_SCRE, I_SCIM, I_SD, I_SGLU,
       I_FGU, I_FDN, I_RW, I_RB, I_MGU, I_MDN };
struct Frame {
    LAS unsigned char* lds; unsigned char* ws; gu32* ctl;
    int tid, lane, wave, vcu, G;
    float* out; const float* mod;
    bf16_t *HB, *BUF, *ACT;
};

enum { MAP_NAT = 0, MAP_PAIR = 1, MAP_CONV = 2, MAP_ATTN = 3 };
__device__ __forceinline__ int map_row(int map, int half, int n) {
    if (map == MAP_NAT) return n;
    if (map == MAP_PAIR) { return n < half ? 256 * (n / 128) + (n % 128) : 256 * ((n - half) / 128) + 128 + ((n - half) % 128); }
    if (map == MAP_CONV) { if (n < 1024) return 2048 + n; if (n < 2048) { const int q = n - 1024; return 256 * (q / 128) + (q % 128); } const int q = n - 2048; return 256 * (q / 128) + 128 + (q % 128); }
    if (n < 1280) { const int hd = n / 64, d = n % 64; return 256 * (hd / 4) + 128 * (d / 32) + 32 * (hd % 4) + (d % 32); }
    return n;
}
__device__ __forceinline__ void p0_transpose_item(const float* W, int K, int N, bf16_t* WT, int map, int half, LAS float* scr, int item, int lane) {
    const int nblk = (N + 31) / 32, kb = item / nblk, nb = item % nblk, k0 = 64 * kb, n0 = 32 * nb;
    const bool cin = (n0 + (lane & 31)) < N;
    float tv[32];
#pragma unroll
    for (int i = 0; i < 32; ++i) { const int kk = 2 * i + (lane >> 5); tv[i] = cin ? W[(size_t)(k0 + kk) * N + n0 + (lane & 31)] : 0.f; }
#pragma unroll
    for (int i = 0; i < 32; ++i) { const int kk = 2 * i + (lane >> 5); scr[kk * 33 + (lane & 31)] = tv[i]; }
    LDS_WAIT(); CFENCE();
    const int c = lane & 7; const int r0 = map_row(map, half, n0);
#pragma unroll
    for (int j = 0; j < 4; ++j) { const int n = (lane >> 3) + 8 * j; const LAS float* s = scr + (8 * c) * 33 + n;
        u32x4 o; o.x = pk2(s[0 * 33], s[1 * 33]); o.y = pk2(s[2 * 33], s[3 * 33]); o.z = pk2(s[4 * 33], s[5 * 33]); o.w = pk2(s[6 * 33], s[7 * 33]);
        *(GAS u32x4*)(WT + (size_t)(r0 + n) * K + k0 + 8 * c) = o; }
    LDS_WAIT(); CFENCE();
}
__device__ __forceinline__ void p0_transpose_item8(const float* W, int K, int N, unsigned char* WT, int map, int half, LAS float* scr, int item, int lane, int sub) {
    const int nblk = (N + 31) / 32, kb = 2 * (item / nblk) + sub, nb = item % nblk, k0 = 64 * kb, n0 = 32 * nb;
    float tv[32];
#pragma unroll
    for (int i = 0; i < 32; ++i) { const int kk = 2 * i + (lane >> 5); tv[i] = W[(size_t)(k0 + kk) * N + n0 + (lane & 31)]; }
#pragma unroll
    for (int i = 0; i < 32; ++i) { const int kk = 2 * i + (lane >> 5); scr[kk * 33 + (lane & 31)] = tv[i] * pg8::W8_MUL; }
    LDS_WAIT(); CFENCE();
    const int c = lane & 3; const int r0 = map_row(map, half, n0);
#pragma unroll
    for (int j = 0; j < 2; ++j) { const int n = (lane >> 2) + 16 * j; const LAS float* sp = scr + (16 * c) * 33 + n; u32x4 o;
#pragma unroll
        for (int q = 0; q < 4; ++q) { int t = 0; t = __builtin_amdgcn_cvt_pk_fp8_f32(sp[(4 * q) * 33], sp[(4 * q + 1) * 33], t, false); t = __builtin_amdgcn_cvt_pk_fp8_f32(sp[(4 * q + 2) * 33], sp[(4 * q + 3) * 33], t, true); o[q] = (unsigned)t; }
        *(GAS u32x4*)(WT + (size_t)(r0 + n) * K + k0 + 16 * c) = o; }
    LDS_WAIT(); CFENCE();
}
__device__ __forceinline__ void p0_transpose_item8x2(const float* W, int K, int N, unsigned char* WT, int map, int half, LAS float* scr, int item, int lane) {
    const int nblk = (N + 31) / 32, kb2 = item / nblk, nb = item % nblk, k0 = 128 * kb2, n0 = 32 * nb;
    float ta[32], tb[32];
#pragma unroll
    for (int i = 0; i < 32; ++i) { const int kk = 2 * i + (lane >> 5); ta[i] = W[(size_t)(k0 + kk) * N + n0 + (lane & 31)]; }
#pragma unroll
    for (int i = 0; i < 32; ++i) { const int kk = 2 * i + (lane >> 5); tb[i] = W[(size_t)(k0 + 64 + kk) * N + n0 + (lane & 31)]; }
    const int c = lane & 7; const int r0 = map_row(map, half, n0);
    u32x4 o8[4];
#pragma unroll
    for (int h = 0; h < 2; ++h) {
#pragma unroll
        for (int i = 0; i < 32; ++i) { const int kk = 2 * i + (lane >> 5); scr[kk * 33 + (lane & 31)] = (h ? tb[i] : ta[i]) * pg8::W8_MUL; }
        LDS_WAIT(); CFENCE();
#pragma unroll
        for (int j = 0; j < 4; ++j) { const int n = (lane >> 3) + 8 * j; const LAS float* sp = scr + (16 * (c & 3)) * 33 + n; u32x4 o;
#pragma unroll
            for (int q = 0; q < 4; ++q) { int t = 0; t = __builtin_amdgcn_cvt_pk_fp8_f32(sp[(4 * q) * 33], sp[(4 * q + 1) * 33], t, false); t = __builtin_amdgcn_cvt_pk_fp8_f32(sp[(4 * q + 2) * 33], sp[(4 * q + 3) * 33], t, true); o[q] = (unsigned)t; }
            if ((c >> 2) == h) o8[j] = o; }
        LDS_WAIT(); CFENCE();
    }
#pragma unroll
    for (int j = 0; j < 4; ++j) { const int n = (lane >> 3) + 8 * j; *(GAS u32x4*)(WT + (size_t)(r0 + n) * K + k0 + 16 * c) = o8[j]; }
}
__device__ __forceinline__ void p0_prologue(Frame& F, const Args& A) {
    {
        LAS float* cs = (LAS float*)F.lds;
        LAS float* red = (LAS float*)(F.lds + 16384);
        for (int i = F.tid; i < NB * DM; i += NTHREADS) { const float c = A.in[I_C][i]; cs[i] = c / (1.f + __expf(-c)); }
        __syncthreads();
        const int kg = F.tid >> 6, cj = F.tid & 63;
        for (int un = blockIdx.x; un < 4 * 96; un += F.G) {
            const int l = un / 96, jb = un % 96, j = jb * 64 + cj;
            const float* w = A.in[I_ADAW] + (size_t)l * DM * 6144 + j;
            float a0 = 0.f, a1 = 0.f, a2 = 0.f, a3 = 0.f;
            for (int k0 = kg * 128; k0 < kg * 128 + 128; k0 += 32) { float wv[32];
#pragma unroll
                for (int i = 0; i < 32; ++i) wv[i] = w[(size_t)(k0 + i) * 6144];
#pragma unroll
                for (int i = 0; i < 32; ++i) { const int k = k0 + i; a0 += cs[k] * wv[i]; a1 += cs[1024 + k] * wv[i]; a2 += cs[2048 + k] * wv[i]; a3 += cs[3072 + k] * wv[i]; } }
            *(LAS f32x4*)(red + (kg * 64 + cj) * 4) = (f32x4){a0, a1, a2, a3};
            __syncthreads();
            if (F.tid < 256) { const int b = F.tid >> 6, cc = F.tid & 63; float s = 0.f;
#pragma unroll
                for (int q = 0; q < 8; ++q) s += red[(q * 64 + cc) * 4 + b];
                ((float*)(F.ws + WS_MOD))[((size_t)l * NB + b) * 6144 + jb * 64 + cc] = s + A.in[I_ADAB][l * 6144 + jb * 64 + cc]; }
            __syncthreads();
        }
    }
    LAS float* scr = (LAS float*)(F.lds + 32768 + F.wave * 8704);
    const int gw = F.vcu * NWAVES + F.wave, NGW = F.G * NWAVES;
    constexpr int I_CI = (DM / 64) * (3072 / 32), I_SQ = (DM / 64) * (DM / 32), I_AI = (DM / 64) * ((ATT_N + 31) / 32), I_GL = (DM / 64) * (2048 / 32), I_GU = (DM / 64) * (2 * FF / 32), I_DN = (FF / 128) * (DM / 32), I_DNB = (FF / 64) * (DM / 32), I_GU8 = (DM / 128) * (2 * FF / 32);
    constexpr int NITEMS = 2 * I_CI + 2 * I_SQ + I_AI + I_SQ + I_GL + (F1L0_FP8 ? I_GU8 : I_GU) + I_GU + (F2_FP8 ? 2 * I_DN : ((F2L0_FP8 ? I_DN : I_DNB) + I_DNB)) + 8 * (M1L1_FP8 ? I_GU8 : I_GU) + 8 * (M1_FP8 ? I_GU8 : I_GU) + 16 * (M2_FP8 ? I_DN : I_DNB);
    for (int it = gw; it < NITEMS; it += NGW) {
        int r = it;
        if (r < 2 * I_CI) { const int q = r / I_CI; p0_transpose_item(A.in[I_CWIN] + (size_t)q * DM * 3072, DM, 3072, (bf16_t*)(F.ws + WS_WCI) + (size_t)q * 3072 * DM, MAP_CONV, 0, scr, r % I_CI, F.lane); continue; } r -= 2 * I_CI;
        if (r < 2 * I_SQ) { const int q = r / I_SQ; p0_transpose_item(A.in[I_CWOUT] + (size_t)q * DM * DM, DM, DM, (bf16_t*)(F.ws + WS_WCO) + (size_t)q * DM * DM, MAP_NAT, 0, scr, r % I_SQ, F.lane); continue; } r -= 2 * I_SQ;
        if (r < I_AI) { p0_transpose_item(A.in[I_AWIN], DM, ATT_N, (bf16_t*)(F.ws + WS_WAI), MAP_ATTN, 0, scr, r, F.lane); continue; } r -= I_AI;
        if (r < I_SQ) { p0_transpose_item(A.in[I_AWOUT], DM, DM, (bf16_t*)(F.ws + WS_WAO), MAP_NAT, 0, scr, r, F.lane); continue; } r -= I_SQ;
        if (r < I_GL) { p0_transpose_item(A.in[I_SGLU], DM, 2048, (bf16_t*)(F.ws + WS_WGL), MAP_PAIR, 1024, scr, r, F.lane); continue; } r -= I_GL;
        if (F1L0_FP8) { if (r < I_GU8) { p0_transpose_item8x2(A.in[I_FGU], DM, 2 * FF, (unsigned char*)(F.ws + WS_WFG), MAP_PAIR, FF, scr, r, F.lane); continue; } r -= I_GU8; }
        else { if (r < I_GU) { p0_transpose_item(A.in[I_FGU], DM, 2 * FF, (bf16_t*)(F.ws + WS_WFG), MAP_PAIR, FF, scr, r, F.lane); continue; } r -= I_GU; }
        if (r < I_GU) { p0_transpose_item(A.in[I_FGU] + (size_t)DM * 2 * FF, DM, 2 * FF, (bf16_t*)(F.ws + WS_WFG) + (size_t)2 * FF * DM, MAP_PAIR, FF, scr, r, F.lane); continue; } r -= I_GU;
        if (F2_FP8) { if (r < 2 * I_DN) { const int q = r / I_DN; p0_transpose_item8x2(A.in[I_FDN] + (size_t)q * FF * DM, FF, DM, (unsigned char*)(F.ws + WS_WFD) + (size_t)q * DM * FF, MAP_NAT, 0, scr, r % I_DN, F.lane); continue; } r -= 2 * I_DN; }
        else if (F2L0_FP8) {
            if (r < I_DN) { p0_transpose_item8x2(A.in[I_FDN], FF, DM, (unsigned char*)(F.ws + WS_WFD), MAP_NAT, 0, scr, r, F.lane); continue; } r -= I_DN;
            if (r < I_DNB) { p0_transpose_item(A.in[I_FDN] + (size_t)FF * DM, FF, DM, (bf16_t*)(F.ws + WS_WFD) + (size_t)DM * FF, MAP_NAT, 0, scr, r, F.lane); continue; } r -= I_DNB; }
        else { if (r < 2 * I_DNB) { const int q = r / I_DNB; p0_transpose_item(A.in[I_FDN] + (size_t)q * FF * DM, FF, DM, (bf16_t*)(F.ws + WS_WFD) + (size_t)q * DM * FF, MAP_NAT, 0, scr, r % I_DNB, F.lane); continue; } r -= 2 * I_DNB; }
        if (M1L1_FP8) { if (r < 8 * I_GU8) { const int q = r / I_GU8; unsigned char* dst = (unsigned char*)(F.ws + WS_WMG) + (size_t)q * 2 * FF * DM;
                p0_transpose_item8x2(A.in[I_MGU] + (size_t)q * DM * 2 * FF, DM, 2 * FF, dst, MAP_PAIR, FF, scr, r % I_GU8, F.lane); continue; } r -= 8 * I_GU8; }
        else { if (r < 8 * I_GU) { const int q = r / I_GU; p0_transpose_item(A.in[I_MGU] + (size_t)q * DM * 2 * FF, DM, 2 * FF, (bf16_t*)(F.ws + WS_WMG) + (size_t)q * 2 * FF * DM, MAP_PAIR, FF, scr, r % I_GU, F.lane); continue; } r -= 8 * I_GU; }
        if (M1_FP8) { if (r < 8 * I_GU8) { const int q = 8 + r / I_GU8; unsigned char* dst = (unsigned char*)(F.ws + WS_WMG) + (size_t)8 * 2 * FF * DM * 2 + (size_t)(q - 8) * 2 * FF * DM;
                p0_transpose_item8x2(A.in[I_MGU] + (size_t)q * DM * 2 * FF, DM, 2 * FF, dst, MAP_PAIR, FF, scr, r % I_GU8, F.lane); continue; } r -= 8 * I_GU8; }
        else { if (r < 8 * I_GU) { const int q = 8 + r / I_GU; p0_transpose_item(A.in[I_MGU] + (size_t)q * DM * 2 * FF, DM, 2 * FF, (bf16_t*)(F.ws + WS_WMG) + (size_t)q * 2 * FF * DM, MAP_PAIR, FF, scr, r % I_GU, F.lane); continue; } r -= 8 * I_GU; }
        if (M2_FP8) { const int q = r / I_DN; p0_transpose_item8x2(A.in[I_MDN] + (size_t)q * FF * DM, FF, DM, (unsigned char*)(F.ws + WS_WMD) + (size_t)q * DM * FF, MAP_NAT, 0, scr, r % I_DN, F.lane); }
        else { const int q = r / I_DNB; p0_transpose_item(A.in[I_MDN] + (size_t)q * FF * DM, FF, DM, (bf16_t*)(F.ws + WS_WMD) + (size_t)q * DM * FF, MAP_NAT, 0, scr, r % I_DNB, F.lane); }
    }
    { u32x4* z = (u32x4*)((bf16_t*)(F.ws + WS_WAI) + (size_t)2144 * DM); const int n16 = (ATT_NP - 2144) * DM * 2 / 16;
      for (int i = blockIdx.x * NTHREADS + F.tid; i < n16; i += F.G * NTHREADS) z[i] = (u32x4){0u, 0u, 0u, 0u}; }
}

template <int FLAGS>
__device__ __forceinline__ void thin_phase(Frame& F, const Args& A, const float* src, int nl  , int ns  , int cl  , int rl  , int cs = -1  , size_t roff = 0  ) {
    if (cs < 0) cs = rl;
    const int gw = F.vcu * NWAVES + F.wave, NGW = F.G * NWAVES;
    LAS float* rwt = (LAS float*)F.lds;
    if (FLAGS & 8) {
        const float* rw = A.in[I_RW] + (size_t)rl * DM * NEXP;
        for (int i = F.tid; i < DM * NEXP; i += NTHREADS) rwt[(i & 7) * DM + (i >> 3)] = rw[i];
        __syncthreads();
    }
    int Tb[8];
    if (FLAGS & 2) { int acc = 0;
#pragma unroll
        for (int e = 0; e < 8; ++e) { Tb[e] = acc; acc += (int)((__hip_atomic_load(F.ctl + CW_CNT + 64 * (8 * rl + e), RLX_AGENT) + 255u) >> 8); } }
    const float* ng = A.in[I_NORMG] + (size_t)(nl * 2 + ns) * DM;
    constexpr bool RT = (FLAGS & 8) != 0;
    LAS int* rE = (LAS int*)(F.lds + 32768);
    const int nit = RT ? ((M / 64 - (int)blockIdx.x + F.G - 1) / F.G) * 8 : (M - gw + NGW - 1) / NGW;
    for (int it = 0; it < nit; ++it) {
        const int chunk = (int)blockIdx.x + (it >> 3) * F.G;
        const int row = RT ? chunk * 64 + F.wave * 8 + (it & 7) : gw + it * NGW;
        const int b = row / SEQ;
        f32x4 v[4];
        const f32x4* xr = (const f32x4*)(src + (size_t)row * DM) + F.lane;
#pragma unroll
        for (int j = 0; j < 4; ++j) v[j] = xr[64 * j];
        if (FLAGS & 2) {
            const int s0 = ((const int*)(F.ws + roff + WS_SLOT))[row * 2], s1 = ((const int*)(F.ws + roff + WS_SLOT))[row * 2 + 1];
            int t0 = 0, t1 = 0;
#pragma unroll
            for (int e = 0; e < 8; ++e) { if ((s0 >> 16) == e) t0 = Tb[e]; if ((s1 >> 16) == e) t1 = Tb[e]; }
            const bf16_t* y0 = (const bf16_t*)(F.ws + WS_BUF) + (size_t)(256 * t0 + (s0 & 0xffff)) * DM;
            const bf16_t* y1 = (const bf16_t*)(F.ws + WS_BUF) + (size_t)(256 * t1 + (s1 & 0xffff)) * DM;
            const float* g2 = cl >= 0 ? F.mod + ((size_t)cl * NB + b) * 6144 + 5 * DM : (const float*)(F.ws + 512 * 1024);
#pragma unroll
            for (int j = 0; j < 4; ++j) { const int col = 4 * F.lane + 256 * j; const u32x2 a = *(const u32x2*)(y0 + col), c = *(const u32x2*)(y1 + col); const f32x4 g = *(const f32x4*)(g2 + col);
                v[j][0] += g[0] * (bflo(a.x) + bflo(c.x)); v[j][1] += g[1] * (bfhi(a.x) + bfhi(c.x)); v[j][2] += g[2] * (bflo(a.y) + bflo(c.y)); v[j][3] += g[3] * (bfhi(a.y) + bfhi(c.y)); }
        }
        if (FLAGS & 3) { GAS f32x4* xo = (GAS f32x4*)(F.out + (size_t)row * DM) + F.lane;
#pragma unroll
            for (int j = 0; j < 4; ++j) xo[64 * j] = v[j]; }
        if (FLAGS & 4) {
            float ss = 0.f;
#pragma unroll
            for (int j = 0; j < 4; ++j) ss += (v[j][0] * v[j][0] + v[j][1] * v[j][1]) + (v[j][2] * v[j][2] + v[j][3] * v[j][3]);
            const float r = 1.0f / sqrtf(wave_sum(ss) * (1.0f / DM) + EPS);
            const float* sh = F.mod + ((size_t)nl * NB + b) * 6144 + (ns ? 3 : 0) * DM; const float* sc = sh + DM;
            GAS u32x2* ho = (GAS u32x2*)(F.HB + (size_t)row * DM) + F.lane;
#pragma unroll
            for (int j = 0; j < 4; ++j) { const int col = 4 * F.lane + 256 * j; const f32x4 g = *(const f32x4*)(ng + col), s1 = *(const f32x4*)(sc + col), s0 = *(const f32x4*)(sh + col);
                v[j] = (v[j] * r) * g * (s1 + 1.0f) + s0;
                if ((RT && ((M1_FP8 && nl == 3) || (M1L1_FP8 && nl == 1))) || (FLAGS == 4 && F1L0_FP8 && nl == 0 && ns == 1)) { int t = 0; t = __builtin_amdgcn_cvt_pk_fp8_f32(v[j][0], v[j][1], t, false); t = __builtin_amdgcn_cvt_pk_fp8_f32(v[j][2], v[j][3], t, true);
                    *(unsigned*)((unsigned char*)F.HB + (size_t)row * DM + col) = (unsigned)t; }
                else { u32x2 w; w.x = pk2(v[j][0], v[j][1]); w.y = pk2(v[j][2], v[j][3]); ho[64 * j] = w; } }
            if (FLAGS & 8) {
                float lg[8];
#pragma unroll
                for (int e = 0; e < 8; ++e) { float s = 0.f;
#pragma unroll
                    for (int j = 0; j < 4; ++j) { const f32x4 w = *(const LAS f32x4*)(rwt + e * DM + 4 * F.lane + 256 * j); s += (v[j][0] * w[0] + v[j][1] * w[1]) + (v[j][2] * w[2] + v[j][3] * w[3]); }
                    lg[e] = wave_sum(s) + A.in[I_RB][rl * NEXP + e]; }
                int e0 = 0; float l0 = lg[0];
#pragma unroll
                for (int e = 1; e < 8; ++e) if (lg[e] > l0) { l0 = lg[e]; e0 = e; }
                int e1 = -1; float l1 = -3.0e38f;
#pragma unroll
                for (int e = 0; e < 8; ++e) if (e != e0 && lg[e] > l1) { l1 = lg[e]; e1 = e; }
                const float g0 = 1.0f / (1.0f + __expf(l1 - l0)), g1 = 1.0f - g0;
                const int lr = F.wave * 8 + (it & 7);
                if (F.lane == 0) { rE[lr] = e0; rE[64 + lr] = e1; rE[128 + lr] = __float_as_int(g0); rE[192 + lr] = __float_as_int(g1); }
            }
        }
        if (RT && (it & 7) == 7) {
            __syncthreads();
            if (F.tid < 8) { int cnt = 0; for (int q = 0; q < 64; ++q) cnt += (rE[q] == F.tid) + (rE[64 + q] == F.tid);
                rE[256 + F.tid] = cnt ? (int)__hip_atomic_fetch_add(F.ctl + CW_CNT + 64 * (8 * cs + F.tid), (unsigned)cnt, RLX_AGENT) : 0; }
            __syncthreads();
            if (F.tid < 64) { const int e0 = rE[F.tid], e1 = rE[64 + F.tid]; int r0 = 0, r1 = 0;
                for (int q = 0; q < F.tid; ++q) { r0 += (rE[q] == e0) + (rE[64 + q] == e0); r1 += (rE[q] == e1) + (rE[64 + q] == e1); }
                const int p0 = rE[256 + e0] + r0, p1 = rE[256 + e1] + r1, grow = chunk * 64 + F.tid;
                gu32* ri = (gu32*)(F.ws + roff + WS_ROWIDX); gu32* gp = (gu32*)(F.ws + roff + WS_GATEP); gu32* sl = (gu32*)(F.ws + roff + WS_SLOT);
                __hip_atomic_store(ri + e0 * 16384 + p0, (unsigned)grow, RLX_AGENT); __hip_atomic_store(ri + e1 * 16384 + p1, (unsigned)grow, RLX_AGENT);
                __hip_atomic_store(gp + e0 * 16384 + p0, (unsigned)rE[128 + F.tid], RLX_AGENT); __hip_atomic_store(gp + e1 * 16384 + p1, (unsigned)rE[192 + F.tid], RLX_AGENT);
                __hip_atomic_store(sl + grow * 2, (unsigned)((e0 << 16) | p0), RLX_AGENT); __hip_atomic_store(sl + grow * 2 + 1, (unsigned)((e1 << 16) | p1), RLX_AGENT); }
            __syncthreads();
        }
    }
}

__device__ __forceinline__ void unpack8(const u32x4 w, float (&f)[8]) { f[0] = bflo(w.x); f[1] = bfhi(w.x); f[2] = bflo(w.y); f[3] = bfhi(w.y); f[4] = bflo(w.z); f[5] = bfhi(w.z); f[6] = bflo(w.w); f[7] = bfhi(w.w); }
__device__ __forceinline__ void conv_phase(Frame& F, const float* cw  ) {
    const int gw = F.vcu * NWAVES + F.wave, NGW = F.G * NWAVES;
    const bf16_t* UB = F.BUF;
    for (int task = gw; task < M / 8; task += NGW) {
        const int r0 = task * 8; const bool first = (r0 % SEQ) == 0;
#pragma unroll
        for (int j = 0; j < 2; ++j) {
            const int ch = 8 * F.lane + 512 * j;
            float w0[8], w1[8], w2[8];
#pragma unroll
            for (int e = 0; e < 8; ++e) { w0[e] = cw[ch + e]; w1[e] = cw[DM + ch + e]; w2[e] = cw[2 * DM + ch + e]; }
            float um2[8], um1[8];
            if (first) {
#pragma unroll
                for (int e = 0; e < 8; ++e) { um2[e] = 0.f; um1[e] = 0.f; }
            } else { unpack8(*(const u32x4*)(UB + (size_t)(r0 - 2) * 2048 + ch), um2); unpack8(*(const u32x4*)(UB + (size_t)(r0 - 1) * 2048 + ch), um1); }
#pragma unroll
            for (int i = 0; i < 8; ++i) {
                float u0[8], bb[8]; unpack8(*(const u32x4*)(UB + (size_t)(r0 + i) * 2048 + ch), u0); unpack8(*(const u32x4*)(UB + (size_t)(r0 + i) * 2048 + 1024 + ch), bb);
                float z[8];
#pragma unroll
                for (int e = 0; e < 8; ++e) z[e] = bb[e] * (w0[e] * um2[e] + w1[e] * um1[e] + w2[e] * u0[e]);
                u32x4 o; o.x = pk2(z[0], z[1]); o.y = pk2(z[2], z[3]); o.z = pk2(z[4], z[5]); o.w = pk2(z[6], z[7]);
                *(u32x4*)(F.HB + (size_t)(r0 + i) * DM + ch) = o;
#pragma unroll
                for (int e = 0; e < 8; ++e) { um2[e] = um1[e]; um1[e] = u0[e]; }
            }
        }
    }
}

constexpr int QIP = 1040;
constexpr int AL_QI = 0, AL_WI = 33280, AL_SEL = 34304, AL_V = 42496, AL_BIASD = 108032, AL_SUM = 116288, AL_END = 116800;
typedef short v4i16_t __attribute__((ext_vector_type(4)));
__device__ __forceinline__ unsigned okey(float f) { const unsigned u = __float_as_uint(f); return u ^ ((u >> 31) ? 0xFFFFFFFFu : 0x80000000u); }
__device__ __forceinline__ void attn_phase(Frame& F, const Args& A) {
    LAS unsigned char* L = F.lds;
    const bf16_t* Qb = (const bf16_t*)(F.ws + WS_Q); const bf16_t* Kb = (const bf16_t*)(F.ws + WS_K); const bf16_t* Vb = (const bf16_t*)(F.ws + WS_V);
    const bf16_t* QIb = (const bf16_t*)(F.ws + WS_QI); const bf16_t* KIb = (const bf16_t*)(F.ws + WS_KI); const float* WIb = (const float*)(F.ws + WS_WI);
    bf16_t* Ob = (bf16_t*)(F.ws + WS_O);
    float* SC = (float*)(F.ws + WS_SC) + (size_t)blockIdx.x * 32 * SEQ;
    const int lane = F.lane, wave = F.wave;
    { LAS float* bd = (LAS float*)(L + AL_BIASD);
      for (int i = F.tid; i < 129 * 16; i += NTHREADS) { const int d = i >> 4; int bkt; if (d < 16) bkt = d; else { const float dd = (float)d; const int lg2 = 16 + (int)(logf(dd / 16.0f) / 2.0794415416798357f * 16.0f); bkt = lg2 < 31 ? lg2 : 31; }
          bd[i] = A.in[I_RELB][bkt * 16 + (i & 15)]; }
    }
    __syncthreads();
    for (int pass = 0; pass < 2; ++pass) {
        const int un = pass == 0 ? (int)blockIdx.x : 511 - (int)blockIdx.x;
        for (int uu = un; uu >= 0 && uu < 512; uu += (pass == 0 ? F.G * 2 : -F.G * 2)) {
        if ((pass == 0 && uu >= 256) || (pass == 1 && uu < 256)) break;
        const int b = uu & 3, qb = uu >> 2, t0 = qb * 32; const size_t rb = (size_t)b * SEQ;
        for (int i = F.tid; i < 32 * 64; i += NTHREADS) { const int q = i >> 6, c = i & 63; *(LAS u32x4*)(L + AL_QI + q * QIP + c * 16) = *(const u32x4*)(QIb + (rb + t0 + q) * 512 + c * 8); }
        if (F.tid < 256) ((LAS float*)(L + AL_WI))[F.tid] = WIb[(rb + t0) * 8 + F.tid];
        __syncthreads();
        {
            for (int kt = wave; kt <= qb; kt += NWAVES) {
                int ln1 = lane; asm volatile("" : "+v"(ln1));
                const int r = ln1 & 31, hh = ln1 >> 5;
                float wi[8];
#pragma unroll
                for (int h = 0; h < 8; ++h) wi[h] = ((LAS float*)(L + AL_WI))[r * 8 + h];
                bf16x8 ka[4];
#pragma unroll
                for (int ks = 0; ks < 4; ++ks) ka[ks] = *(const bf16x8*)(KIb + (rb + kt * 32 + r) * 64 + 16 * ks + 8 * hh);
                f32x16 sc;
#pragma unroll
                for (int i = 0; i < 16; ++i) sc[i] = 0.f;
#pragma unroll
                for (int h = 0; h < 8; ++h) {
                    f32x16 d;
#pragma unroll
                    for (int i = 0; i < 16; ++i) d[i] = 0.f;
#pragma unroll
                    for (int ks = 0; ks < 4; ++ks) { const bf16x8 qf = *(const LAS bf16x8*)(L + AL_QI + r * QIP + (h * 64 + 16 * ks + 8 * hh) * 2); d = __builtin_amdgcn_mfma_f32_32x32x16_bf16(ka[ks], qf, d, 0, 0, 0); }
#pragma unroll
                    for (int i = 0; i < 16; ++i) sc[i] += wi[h] * fmaxf(d[i], 0.f);
                }
#pragma unroll
                for (int a = 0; a < 4; ++a) { f32x4 o;
#pragma unroll
                    for (int e = 0; e < 4; ++e) { const int krow = 8 * a + 4 * hh + e; o[e] = (kt == qb && krow > r) ? -INFINITY : sc[4 * a + e]; }
                    *(f32x4*)(SC + (size_t)r * SEQ + kt * 32 + 8 * a + 4 * hh) = o; }
            }
        }
        VM_WAIT(); __syncthreads();
        for (int qq = 0; qq < 4; ++qq) {
            const int c = wave + 8 * qq, t = t0 + c; const int nvalid = t + 1;
            int lane = F.lane; asm volatile("" : "+v"(lane));
            LAS int* sel = (LAS int*)(L + AL_SEL) + wave * 256;
            int count;
            if (nvalid <= TOPK) {
                count = nvalid;
#pragma unroll
                for (int j = 0; j < 4; ++j) { const int idx = 64 * j + lane; sel[idx] = idx < nvalid ? idx : 0; }
            } else {
                count = TOPK;
                const int nj = (nvalid + 63) >> 6;
                unsigned key[64];
                const float* srow = SC + (size_t)c * SEQ;
#define SEL_GROUPS(BODY) do { BODY(0) if (nj > 16) { BODY(1) if (nj > 32) { BODY(2) if (nj > 48) { BODY(3) } } } } while (0)
#define SEL_LOAD(g) { _Pragma("unroll") for (int j = 16 * (g); j < 16 * (g) + 16; ++j) { const int idx = 64 * j + lane; const float sv = __uint_as_float(__hip_atomic_load((const gu32*)(srow + idx), RLX_AGENT)); key[j] = idx <= t ? okey(sv) : 0u;     } }
#pragma unroll
                for (int j = 0; j < 64; ++j) key[j] = 0u;
                SEL_GROUPS(SEL_LOAD);
                unsigned T = 0u;
                for (int bit = 31; bit >= 0; --bit) {
                    const unsigned cand = T | (1u << bit); int cnt = 0;
#define SEL_CNT(g) { _Pragma("unroll") for (int j = 16 * (g); j < 16 * (g) + 16; ++j) cnt += __popcll(__ballot(key[j] >= cand)); }
                    SEL_GROUPS(SEL_CNT);
                    if (cnt >= TOPK) T = cand;
                    if (cnt == TOPK) break;
                }
                int base = 0;
#define SEL_GT(g) { _Pragma("unroll") for (int j = 16 * (g); j < 16 * (g) + 16; ++j) { const bool gt = key[j] > T; const unsigned long long mk = __ballot(gt); \
                    const int pos = base + (int)__builtin_amdgcn_mbcnt_hi((unsigned)(mk >> 32), __builtin_amdgcn_mbcnt_lo((unsigned)mk, 0u)); if (gt) sel[pos] = 64 * j + lane; base += __popcll(mk); } }
                SEL_GROUPS(SEL_GT);
                const int need = TOPK - base; int eb = 0;
#define SEL_EQ(g) { _Pragma("unroll") for (int j = 16 * (g); j < 16 * (g) + 16; ++j) { const bool eq = key[j] == T; const unsigned long long mk = __ballot(eq); \
                    const int rank = eb + (int)__builtin_amdgcn_mbcnt_hi((unsigned)(mk >> 32), __builtin_amdgcn_mbcnt_lo((unsigned)mk, 0u)); if (eq && rank < need) sel[base + rank] = 64 * j + lane; eb += __popcll(mk); } }
                SEL_GROUPS(SEL_EQ);
#undef SEL_GROUPS
#undef SEL_LOAD
#undef SEL_CNT
#undef SEL_GT
#undef SEL_EQ
            }
            LDS_WAIT(); CFENCE();
            asm volatile("" : "+v"(lane));
            const int hd = lane & 15, kq = lane >> 4;
            bf16x8 bq[8];
            { bf16x8 qf[2];
#pragma unroll
              for (int s2 = 0; s2 < 2; ++s2) qf[s2] = *(const bf16x8*)(Qb + (rb + t) * 1024 + hd * 64 + 32 * s2 + 8 * kq);
              const bf16x8 zf = (bf16x8){0, 0, 0, 0, 0, 0, 0, 0};
#pragma unroll
              for (int ks = 0; ks < 8; ++ks) bq[ks] = ((ks >> 1) == (hd >> 2)) ? qf[ks & 1] : zf; }
            f32x4 lg[16];
            float mx = -INFINITY;
            bf16x8 kf[3][8];
#pragma unroll
            for (int pre = 0; pre < 2; ++pre) { const int krow = sel[16 * pre + hd]; const bf16_t* kp = Kb + (rb + krow) * 256 + 8 * kq;
#pragma unroll
              for (int ks = 0; ks < 8; ++ks) kf[pre][ks] = *(const bf16x8*)(kp + 32 * ks); }
            const LAS float* biasd = (const LAS float*)(L + AL_BIASD);
#pragma unroll
            for (int kt = 0; kt < 16; ++kt) {
                if (kt < 14) { const int krow = sel[16 * (kt + 2) + hd]; const bf16_t* kp = Kb + (rb + krow) * 256 + 8 * kq;
#pragma unroll
                    for (int ks = 0; ks < 8; ++ks) kf[(kt + 2) % 3][ks] = *(const bf16x8*)(kp + 32 * ks); }
                f32x4 d = (f32x4){0.f, 0.f, 0.f, 0.f};
#pragma unroll
                for (int ks = 0; ks < 8; ++ks) d = __builtin_amdgcn_mfma_f32_16x16x32_bf16(kf[kt % 3][ks], bq[ks], d, 0, 0, 0);
                const u32x4 ks4 = *(const LAS u32x4*)(sel + 16 * kt + 4 * kq);
#pragma unroll
                for (int i = 0; i < 4; ++i) { const int pos = 16 * kt + 4 * kq + i; int dist = t - (int)ks4[i]; dist = dist < 0 ? 0 : (dist > 128 ? 128 : dist);
                    const float bs = biasd[dist * 16 + hd];
                    d[i] = pos < count ? d[i] + bs : -INFINITY; mx = fmaxf(mx, d[i]); }
                lg[kt] = d;
            }
            mx = fmaxf(mx, __shfl_xor(mx, 16)); mx = fmaxf(mx, __shfl_xor(mx, 32));
            float sum = 0.f;
            bf16x8 pa[8];
#pragma unroll
            for (int ks = 0; ks < 8; ++ks) { float p[8];
#pragma unroll
                for (int i = 0; i < 4; ++i) { p[i] = __expf(lg[2 * ks][i] - mx); p[4 + i] = __expf(lg[2 * ks + 1][i] - mx); }
                sum += ((p[0] + p[1]) + (p[2] + p[3])) + ((p[4] + p[5]) + (p[6] + p[7]));
                u32x4 w; w.x = cvt_pk_bf16(p[0], p[1]); w.y = cvt_pk_bf16(p[2], p[3]); w.z = cvt_pk_bf16(p[4], p[5]); w.w = cvt_pk_bf16(p[6], p[7]);
                pa[ks] = __builtin_bit_cast(bf16x8, w); }
            sum += __shfl_xor(sum, 16); sum += __shfl_xor(sum, 32);
            if (kq == 0) ((LAS float*)(L + AL_SUM))[wave * 16 + hd] = sum;
            LDS_WAIT(); CFENCE();
            {
                asm volatile("" : "+v"(lane));
                const int rs = lane >> 3, ch = lane & 7, i16 = lane & 15, tq = i16 >> 2, tp = i16 & 3, kq2 = lane >> 4;
                LAS unsigned char* vb = L + AL_V + wave * 8192;
                const unsigned wr_off = (unsigned)lane * 16u, tr_off = (unsigned)((4 * kq2 + tq) * 128 + 8 * tp);
                f32x4 O[4][4];
#pragma unroll
                for (int n = 0; n < 4; ++n)
#pragma unroll
                    for (int dt = 0; dt < 4; ++dt) O[n][dt] = (f32x4){0.f, 0.f, 0.f, 0.f};
                u32x4 vr[2][4]; int kr[4];
                const bf16_t* vbase = Vb + rb * 256 + 8 * ch;
#pragma unroll
                for (int i = 0; i < 4; ++i) kr[i] = sel[8 * i + rs];
#pragma unroll
                for (int pre = 0; pre < 2; ++pre)
#pragma unroll
                    for (int i = 0; i < 4; ++i) vr[pre][i] = *(const u32x4*)(vbase + (size_t)kr[i] * 256 + pre * 64);
#pragma unroll
                for (int st = 0; st < 32; ++st) {
                    const int ks = st >> 2, n = st & 3;
                    LAS unsigned char* buf = vb + (st & 1) * 4096;
#pragma unroll
                    for (int i = 0; i < 4; ++i) *(LAS u32x4*)(buf + wr_off + i * 1024) = vr[st & 1][i];
                    if (st < 30) { const int ks2 = (st + 2) >> 2, n2 = (st + 2) & 3;
                        if (n2 == 0) {
#pragma unroll
                            for (int i = 0; i < 4; ++i) kr[i] = sel[32 * ks2 + 8 * i + rs]; }
#pragma unroll
                        for (int i = 0; i < 4; ++i) vr[st & 1][i] = *(const u32x4*)(vbase + (size_t)kr[i] * 256 + n2 * 64); }
#pragma unroll
                    for (int dt = 0; dt < 4; ++dt) {
                        const v4i16_t t0 = __builtin_amdgcn_ds_read_tr16_b64_v4i16((LAS v4i16_t*)(buf + tr_off + 32 * dt));
                        const v4i16_t t1 = __builtin_amdgcn_ds_read_tr16_b64_v4i16((LAS v4i16_t*)(buf + tr_off + 2048 + 32 * dt));
                        const bf16x8 bfr = (bf16x8){t0[0], t0[1], t0[2], t0[3], t1[0], t1[1], t1[2], t1[3]};
                        O[n][dt] = __builtin_amdgcn_mfma_f32_16x16x32_bf16(pa[ks], bfr, O[n][dt], 0, 0, 0); }
                    CFENCE();
                }
                const f32x4 sm = *(const LAS f32x4*)(L + AL_SUM + (wave * 16 + 4 * kq2) * 4);
                bf16_t* op = Ob + (rb + t) * 1024 + (4 * kq2) * 64 + i16;
#pragma unroll
                for (int dt = 0; dt < 4; ++dt)
#pragma unroll
                    for (int i = 0; i < 4; ++i) { const float v = kq2 == 0 ? O[0][dt][i] : (kq2 == 1 ? O[1][dt][i] : (kq2 == 2 ? O[2][dt][i] : O[3][dt][i]));
                        op[i * 64 + 16 * dt] = (bf16_t)f2bf(v / sm[i]); }
            }
            LDS_WAIT(); CFENCE();
        }
        __syncthreads();
        }
    }
}

constexpr int SL_BMT = 0;
constexpr int SL_CMA = 4096;
constexpr int SL_AB = 12288;
constexpr int SL_E = 12800;
constexpr int SL_S = 16896;
constexpr int SPITCH = 272;
__device__ __forceinline__ void cmul(float ar, float ai, float br, float bi, float& cr, float& ci) { cr = ar * br - ai * bi; ci = ar * bi + ai * br; }
__device__ __forceinline__ void ssm_phase(Frame& F, const Args& A) {
    LAS unsigned char* L = F.lds;
    const int lane = F.lane, wave = F.wave;
    bf16_t* G = (bf16_t*)(F.ws + WS_ACT);
    for (int un = F.vcu; un < NB * 64; un += F.G) {
        const int b = un >> 6, g = un & 63; const size_t rb = (size_t)b * SEQ;
        __syncthreads();
        if (F.tid < 64) {
            const int p = F.tid;
            const float lr = fminf(A.in[I_SLRE][g * 64 + p], -1e-4f), li = A.in[I_SLIM][g * 64 + p];
            const float step = expf(A.in[I_SLOG][g]);
            const float mag = expf(lr * step); float sn, cs; sincosf(li * step, &sn, &cs);
            const float ar = mag * cs, ai = mag * sn;
            ((LAS float*)(L + SL_AB))[2 * p] = ar; ((LAS float*)(L + SL_AB))[2 * p + 1] = ai;
            const float nr = ar - 1.0f, ni = ai, den = lr * lr + li * li;
            const float cr = (nr * lr + ni * li) / den, ci = (ni * lr - nr * li) / den;
            LAS bf16_t* bm = (LAS bf16_t*)(L + SL_BMT);
#pragma unroll
            for (int c = 0; c < 16; ++c) { const float br = A.in[I_SBRE][((size_t)g * 64 + p) * 16 + c], bi = A.in[I_SBIM][((size_t)g * 64 + p) * 16 + c];
                float xr, xi; cmul(cr, ci, br, bi, xr, xi); bm[p * 16 + c] = (bf16_t)f2bf(xr); bm[(64 + p) * 16 + c] = (bf16_t)f2bf(xi); }
        }
        { LAS bf16_t* cm = (LAS bf16_t*)(L + SL_CMA);
          for (int i = F.tid; i < 32 * 128; i += NTHREADS) { const int c = i >> 7, k = i & 127; float v = 0.f;
              if (c < 16) v = (k < 64) ? A.in[I_SCRE][((size_t)g * 16 + c) * 64 + k] : -A.in[I_SCIM][((size_t)g * 16 + c) * 64 + (k - 64)];
              cm[i] = (bf16_t)f2bf(v); } }
        __syncthreads();
        const int r = lane & 31, hh = lane >> 5;
        bf16x8 bfr[4];
#pragma unroll
        for (int n = 0; n < 4; ++n) bfr[n] = *(const LAS bf16x8*)(L + SL_BMT + ((32 * n + r) * 16 + 8 * hh) * 2);
        bf16x8 cfr[8];
#pragma unroll
        for (int ks = 0; ks < 8; ++ks) cfr[ks] = *(const LAS bf16x8*)(L + SL_CMA + (r * 128 + 16 * ks + 8 * hh) * 2);
        float ar[2], ai[2], a16r[2], a16i[2], a512r[2], a512i[2];
#pragma unroll
        for (int s = 0; s < 2; ++s) { ar[s] = ((LAS float*)(L + SL_AB))[2 * (32 * s + r)]; ai[s] = ((LAS float*)(L + SL_AB))[2 * (32 * s + r) + 1];
            float pr = ar[s], pi = ai[s];
#pragma unroll
            for (int q = 0; q < 4; ++q) { float nr, ni; cmul(pr, pi, pr, pi, nr, ni); pr = nr; pi = ni; }
            a16r[s] = pr; a16i[s] = pi;
#pragma unroll
            for (int q = 0; q < 5; ++q) { float nr, ni; cmul(pr, pi, pr, pi, nr, ni); pr = nr; pi = ni; }
            a512r[s] = pr; a512i[s] = pi; }
        const int tokperm = 16 * ((r >> 2) & 1) + 4 * (r >> 3) + (r & 3);
        const float dsk0 = 0.f; (void)dsk0;
        float cin_r[2] = {0.f, 0.f}, cin_i[2] = {0.f, 0.f};
        LAS unsigned char* Sw = L + SL_S + wave * (32 * SPITCH);
        for (int pass = 0; pass < 2; ++pass) {
            if (pass == 1) {
                __syncthreads();
#pragma unroll
                for (int s = 0; s < 2; ++s) { float cr = 0.f, ci = 0.f;
                    for (int w = 0; w < wave; ++w) { float nr, ni; cmul(a512r[s], a512i[s], cr, ci, nr, ni); cr = nr + ((LAS float*)(L + SL_E))[(w * 64 + 32 * s + r) * 2]; ci = ni + ((LAS float*)(L + SL_E))[(w * 64 + 32 * s + r) * 2 + 1]; }
                    cin_r[s] = cr; cin_i[s] = ci; }
            }
            bf16x8 ufn = *(const bf16x8*)(F.HB + (rb + wave * 512 + tokperm) * DM + 16 * g + 8 * hh);
            for (int tile = 0; tile < 16; ++tile) {
                asm volatile("s_waitcnt vmcnt(0) lgkmcnt(0)" ::: "memory"); __builtin_amdgcn_s_barrier(); asm volatile("" ::: "memory");
                const int tk0 = wave * 512 + tile * 32;
                const bf16x8 uf = ufn;
                if (tile < 15) ufn = *(const bf16x8*)(F.HB + (rb + tk0 + 32 + tokperm) * DM + 16 * g + 8 * hh);

                f32x16 d[4];
#pragma unroll
                for (int n = 0; n < 4; ++n) {
#pragma unroll
                    for (int i = 0; i < 16; ++i) d[n][i] = 0.f;
                    d[n] = __builtin_amdgcn_mfma_f32_32x32x16_bf16(uf, bfr[n], d[n], 0, 0, 0); }
                asm volatile("s_nop 15\n\ts_nop 15\n\ts_nop 15" : "+v"(d[0]), "+v"(d[1]), "+v"(d[2]), "+v"(d[3]));
#pragma unroll
                for (int s = 0; s < 2; ++s) {
                    float sr = hh == 0 ? cin_r[s] : 0.f, si = hh == 0 ? cin_i[s] : 0.f;
#pragma unroll
                    for (int i = 0; i < 16; ++i) { const float nr = ar[s] * sr - ai[s] * si + d[s][i], ni = ar[s] * si + ai[s] * sr + d[2 + s][i]; sr = nr; si = ni; d[s][i] = sr; d[2 + s][i] = si; }
                    const float e0r = __shfl_xor(sr, 32), e0i = __shfl_xor(si, 32);
                    float cr = hh == 1 ? e0r : 0.f, ci = hh == 1 ? e0i : 0.f;
                    if (pass == 1) {
#pragma unroll
                        for (int i = 0; i < 16; ++i) { float nr, ni; cmul(ar[s], ai[s], cr, ci, nr, ni); cr = nr; ci = ni; d[s][i] += cr; d[2 + s][i] += ci; }
                    } else { float nr, ni; cmul(a16r[s], a16i[s], cr, ci, nr, ni); cr = nr; ci = ni; }
                    const float endr = (pass == 1) ? d[s][15] : sr + cr, endi = (pass == 1) ? d[2 + s][15] : si + ci;
                    const float xr = __shfl_xor(endr, 32), xi = __shfl_xor(endi, 32);
                    cin_r[s] = hh == 1 ? endr : xr; cin_i[s] = hh == 1 ? endi : xi;
                }
                if (pass == 1) {
#pragma unroll
                    for (int s = 0; s < 2; ++s)
#pragma unroll
                        for (int i = 0; i < 16; ++i) { *(LAS bf16_t*)(Sw + (16 * hh + i) * SPITCH + (32 * s + r) * 2) = (bf16_t)f2bf(d[s][i]); *(LAS bf16_t*)(Sw + (16 * hh + i) * SPITCH + (64 + 32 * s + r) * 2) = (bf16_t)f2bf(d[2 + s][i]); }
                    LDS_WAIT(); CFENCE();
                    f32x16 y;
#pragma unroll
                    for (int i = 0; i < 16; ++i) y[i] = 0.f;
#pragma unroll
                    for (int ks = 0; ks < 8; ++ks) { const bf16x8 sf = *(const LAS bf16x8*)(Sw + r * SPITCH + (16 * ks + 8 * hh) * 2); y = __builtin_amdgcn_mfma_f32_32x32x16_bf16(cfr[ks], sf, y, 0, 0, 0); }
                    LDS_WAIT(); CFENCE();
                    const size_t trow = rb + tk0 + r;
#pragma unroll
                    for (int q = 0; q < 2; ++q) { const int ch = 16 * g + 8 * q + 4 * hh;
                        const u32x2 hv = *(const u32x2*)(F.HB + trow * DM + ch); const f32x4 dk = *(const f32x4*)(A.in[I_SD] + ch);
                        const float y0 = gelu_tanh_f(y[4 * q + 0] + dk[0] * bflo(hv.x)), y1 = gelu_tanh_f(y[4 * q + 1] + dk[1] * bfhi(hv.x)), y2 = gelu_tanh_f(y[4 * q + 2] + dk[2] * bflo(hv.y)), y3 = gelu_tanh_f(y[4 * q + 3] + dk[3] * bfhi(hv.y));
                        u32x2 w; w.x = pk2(y0, y1); w.y = pk2(y2, y3); *(u32x2*)(G + trow * DM + ch) = w; }
                }
            }
            if (pass == 0) {
                if (hh == 1) {
#pragma unroll
                    for (int s = 0; s < 2; ++s) { ((LAS float*)(L + SL_E))[(wave * 64 + 32 * s + r) * 2] = cin_r[s]; ((LAS float*)(L + SL_E))[(wave * 64 + 32 * s + r) * 2 + 1] = cin_i[s]; } }
                cin_r[0] = cin_r[1] = cin_i[0] = cin_i[1] = 0.f;
            }
        }
    }
}

enum { PH_PRO = 0, PH_NORM0,
       L0_G1, L0_CONV, L0_G2, L0_NORM, L0_F1, L0_F2, L0_NORMN,
       L1_G1, L1_ATTN, L1_G2, L1_NORMR, L1_M1, L1_M2, L1_COMB,
       L2_SSM, L2_G2, L2_NORM, L2_F1, L2_F2, L2_NORMN,
       L3_G1, L3_CONV, L3_G2, L3_NORMR, L3_M1, L3_M2, L3_COMB, NPH };

__device__ __forceinline__ bool fresh_ids(Frame& F) { const int l = lane_id_fresh(); F.lane = l; F.tid = F.wave * 64 + l; return true; }
__global__ void __launch_bounds__(NTHREADS, 2) mega_fwd(Args args) {
    extern __shared__ __attribute__((aligned(16))) unsigned char lds_raw[];
    Frame F;
    F.lds = (LAS unsigned char*)lds_raw;
    volatile LAS unsigned* MISC = (volatile LAS unsigned*)(F.lds + MISC_OFF);
    F.tid = threadIdx.x; F.lane = F.tid & 63; F.wave = __builtin_amdgcn_readfirstlane(F.tid >> 6);
    F.G = gridDim.x; { const int bx = blockIdx.x; F.vcu = (F.G % 8 == 0) ? (bx % 8) * (F.G / 8) + bx / 8 : bx; }
    F.ws = args.ws; F.ctl = (gu32*)(args.ws + WS_CTL); F.out = args.out; F.mod = (const float*)(args.ws + WS_MOD);
    F.HB = (bf16_t*)(args.ws + WS_HB); F.BUF = (bf16_t*)(args.ws + WS_BUF); F.ACT = (bf16_t*)(args.ws + WS_ACT);
    for (int u = F.tid; u < (LDS_BYTES - LDSCTL_OFF) / 4; u += NTHREADS) ((LAS unsigned*)(F.lds + LDSCTL_OFF))[u] = 0u;
    __syncthreads();
    XcdBarrier bar; bar.bar = (unsigned*)(F.ctl + CW_BAR); bar.x = 0; bar.st = nullptr; bar.w = F.wave;
    const int lo = args.ph_lo, hi = args.ph_hi;
    if (hi - lo > 1) bar = xcd_barrier_post((unsigned*)(F.ctl + CW_BAR), MISC + 8, F.wave);
#ifndef PH_ONLY
#define PH_EN(k) true
#else
#define PH_EN(k) ((k) == PH_ONLY)
#endif
#define IN(k) (PH_EN(k) && lo <= (k) && (k) < hi && fresh_ids(F))
#define SEAM(k) do { if (IN(k) && IN((k) + 1)) xcd_barrier(bar); } while (0)
#ifndef PH_REP
#define PH_REP (-1)
#endif
#ifndef PH_REPMASK
#define PH_REPMASK 0ull
#endif
#define REPB(k, ...) do { if (PH_REP == (k) || ((PH_REPMASK >> (k)) & 1ull)) { xcd_barrier(bar); __VA_ARGS__; } } while (0)
    LAS unsigned char* ring = F.lds;
    const int cid = (int)blockIdx.x;
    bf16_t* const WCI = (bf16_t*)(F.ws + WS_WCI); bf16_t* const WCO = (bf16_t*)(F.ws + WS_WCO); bf16_t* const WAI = (bf16_t*)(F.ws + WS_WAI); bf16_t* const WAO = (bf16_t*)(F.ws + WS_WAO);
    bf16_t* const WGL = (bf16_t*)(F.ws + WS_WGL); bf16_t* const WFG = (bf16_t*)(F.ws + WS_WFG); bf16_t* const WFD = (bf16_t*)(F.ws + WS_WFD); bf16_t* const WMG = (bf16_t*)(F.ws + WS_WMG); bf16_t* const WMD = (bf16_t*)(F.ws + WS_WMD);

#define ZEROG ((const float*)(F.ws + 512 * 1024))
    const bool fuseR = (F.G == 256) && FUSE_R;
    const bool fuse = (F.G == 256) && FUSE_N;
#define FUSED_EPI(inst, gatep, xin, nl, ns, hout, asc, h8_) ({F.out, (gatep), (xin), args.in[I_NORMG] + (size_t)((nl) * 2 + (ns)) * DM, F.mod + (size_t)(nl) * NB * 6144 + ((ns) ? 3 : 0) * DM, (hout), (float*)(F.ws + WS_XS), F.ctl + CW_PAN + 64 * 64 * (inst), F.ctl + CW_TMO, (asc), (h8_)})
#define FUSED_RT(inst, gatep, nl, rl, roff, hout, h8_) ({F.out, (gatep), args.in[I_NORMG] + (size_t)((nl) * 2 + 1) * DM, F.mod + (size_t)(nl) * NB * 6144 + 3 * DM, (hout), (float*)(F.ws + WS_XS9), F.ctl + CW_PAN + 64 * 64 * (inst), F.ctl + CW_TMO, \
        args.in[I_RW] + (size_t)(rl) * DM * NEXP, args.in[I_RB] + (rl) * NEXP, F.ctl + CW_CNT + 64 * 8 * (rl), F.ws + (roff), (h8_)})
#define MODP(l, chunk) (F.mod + (size_t)(l) * NB * 6144 + (chunk) * DM)
#define GEMM_STATIC(Aptr, Bptr, Nn, Kk, EpiT, EpiInit) do { pg8::Gemm g{(Aptr), (Bptr), M, (Nn), (Kk), 0, nullptr, nullptr}; pg8::StaticOrder S; S.init(M, (Nn), F.G, cid); EpiT E EpiInit; \
        pg8::gemm_phase<EpiT, pg8::StaticOrder, false>(ring, g, S, E, F.wave); } while (0)
#define GEMM_STATIC8(Aptr, Bptr, Nn, Kk, EpiT, EpiInit) do { pg8::Gemm g{(Aptr), (Bptr), M, (Nn), (Kk), 0, nullptr, nullptr}; pg8::StaticOrder S; S.init(M, (Nn), F.G, cid); EpiT E EpiInit; \
        pg8::gemm_phase<EpiT, pg8::StaticOrder, false, true>(ring, g, S, E, F.wave); } while (0)
#define EPAIR8 pg8::EpiPair<1, (M2_FP8 != 0), (M1_FP8 != 0)>
#define M1_B (M1_FP8 ? 1 : 2)
#define EPAIR8L1 pg8::EpiPair<1, (M2_FP8 != 0), (M1L1_FP8 != 0)>
#define M2_B (M2_FP8 ? 1 : 2)
#define F2_ASC (F2_FP8 ? pg8::W8_INV : 1.0f)
#define GEMM_STATICF(Aptr, Bptr, Nn, Kk, EpiT, EpiInit) do { pg8::Gemm g{(Aptr), (Bptr), M, (Nn), (Kk), 0, nullptr, nullptr}; pg8::StaticOrder S; S.init(M, (Nn), F.G, cid); EpiT E EpiInit; \
        pg8::gemm_phase<EpiT, pg8::StaticOrder, false, (F2_FP8 != 0)>(ring, g, S, E, F.wave); } while (0)
#define EPAIRF pg8::EpiPair<1, (F2_FP8 != 0), false>
#define F0_FP8 (F2_FP8 || F2L0_FP8)
#define F2L0_ASC (F0_FP8 ? pg8::W8_INV : 1.0f)
#define EPAIR0 pg8::EpiPair<1, (F0_FP8 != 0), false>
#define EPAIR0S pg8::EpiPair<1, (F0_FP8 != 0), (F1L0_FP8 != 0)>
#define GEMM_STATICF0(Aptr, Bptr, Nn, Kk, EpiT, EpiInit) do { pg8::Gemm g{(Aptr), (Bptr), M, (Nn), (Kk), 0, nullptr, nullptr}; pg8::StaticOrder S; S.init(M, (Nn), F.G, cid); EpiT E EpiInit; \
        pg8::gemm_phase<EpiT, pg8::StaticOrder, false, (F0_FP8 != 0)>(ring, g, S, E, F.wave); } while (0)
#define W8(base, bytes) ((bf16_t*)((unsigned char*)(base) + (size_t)(bytes)))

    if (IN(PH_PRO)) { p0_prologue(F, args); REPB(PH_PRO, p0_prologue(F, args)); } SEAM(PH_PRO);
    if (IN(PH_NORM0)) { thin_phase<4>(F, args, args.in[I_X], 0, 0, 0, 0); REPB(PH_NORM0, thin_phase<4>(F, args, args.in[I_X], 0, 0, 0, 0)); } SEAM(PH_NORM0);

    if (IN(L0_G1)) { GEMM_STATIC(F.HB, WCI, 3072, DM, pg8::EpiConvIn, {F.BUF}); REPB(L0_G1, GEMM_STATIC(F.HB, WCI, 3072, DM, pg8::EpiConvIn, {F.BUF})); } SEAM(L0_G1);
    if (IN(L0_CONV)) { conv_phase(F, args.in[I_CW]); REPB(L0_CONV, conv_phase(F, args.in[I_CW])); } SEAM(L0_CONV);
    if (IN(L0_G2)) { if (fuse) GEMM_STATIC(F.HB, WCO, DM, DM, pg8::EpiResNorm, FUSED_EPI(0, MODP(0, 2), args.in[I_X], 0, 1, (fuse ? F.BUF : F.HB), 1.0f, F1L0_FP8)); else GEMM_STATIC(F.HB, WCO, DM, DM, pg8::EpiRes, ({F.out, MODP(0, 2), args.in[I_X], 1.0f})); } SEAM(L0_G2);
    if (!fuse) { if (IN(L0_NORM)) { thin_phase<4>(F, args, F.out, 0, 1, 0, 0); } SEAM(L0_NORM); }
    if (IN(L0_F1)) { pg8::Gemm g{(fuse ? F.BUF : F.HB), WFG, M, 2 * FF, DM, 0, nullptr, nullptr}; pg8::StaticOrder S; S.init(M, 2 * FF, F.G, cid); EPAIR0S E{F.ACT, FF};
        pg8::gemm_phase<EPAIR0S, pg8::StaticOrder, false, (F1L0_FP8 != 0)>(ring, g, S, E, F.wave); } SEAM(L0_F1);
    if (IN(L0_F2)) { if (fuse) GEMM_STATICF0(F.ACT, WFD, DM, FF, pg8::EpiResNorm, FUSED_EPI(1, MODP(0, 5), F.out, 1, 0, F.HB, F2L0_ASC, 0)); else GEMM_STATICF0(F.ACT, WFD, DM, FF, pg8::EpiRes, ({F.out, MODP(0, 5), F.out, F2L0_ASC})); } SEAM(L0_F2);
    if (!fuse) { if (IN(L0_NORMN)) { thin_phase<4>(F, args, F.out, 1, 0, 0, 0); } SEAM(L0_NORMN); }

    if (IN(L1_G1)) { GEMM_STATIC(F.HB, WAI, ATT_NP, DM, pg8::EpiAttnIn, ({(bf16_t*)(F.ws + WS_Q), (bf16_t*)(F.ws + WS_K), (bf16_t*)(F.ws + WS_V), (bf16_t*)(F.ws + WS_QI), (bf16_t*)(F.ws + WS_KI), (float*)(F.ws + WS_WI), args.in[I_QG], args.in[I_KG]})); REPB(L1_G1, GEMM_STATIC(F.HB, WAI, ATT_NP, DM, pg8::EpiAttnIn, ({(bf16_t*)(F.ws + WS_Q), (bf16_t*)(F.ws + WS_K), (bf16_t*)(F.ws + WS_V), (bf16_t*)(F.ws + WS_QI), (bf16_t*)(F.ws + WS_KI), (float*)(F.ws + WS_WI), args.in[I_QG], args.in[I_KG]}))); } SEAM(L1_G1);
    if (IN(L1_ATTN)) { attn_phase(F, args); REPB(L1_ATTN, attn_phase(F, args)); } SEAM(L1_ATTN);
    if (IN(L1_G2)) { if (fuseR) GEMM_STATIC((bf16_t*)(F.ws + WS_O), WAO, DM, DM, pg8::EpiResNormRouter, FUSED_RT(3, MODP(1, 2), 1, 0, 0, F.HB, M1L1_FP8)); else GEMM_STATIC((bf16_t*)(F.ws + WS_O), WAO, DM, DM, pg8::EpiRes, ({F.out, MODP(1, 2), F.out, 1.0f})); } SEAM(L1_G2);
    if (!fuseR) { if (IN(L1_NORMR)) { thin_phase<4 | 8>(F, args, F.out, 1, 1, 0, 0); } SEAM(L1_NORMR); }
    if (IN(L1_M1)) { pg8::Gemm g{F.HB, WMG, M, 2 * FF, DM, (size_t)2 * FF * DM * (M1L1_FP8 ? 1 : 2), (const int*)(F.ws + WS_ROWIDX), (const unsigned*)(F.ctl + CW_CNT)}; pg8::MoeOrder S; S.init((const unsigned*)(F.ctl + CW_CNT), 22, F.G, cid);
        EPAIR8L1 E{F.ACT, FF}; pg8::gemm_phase<EPAIR8L1, pg8::MoeOrder, true, (M1L1_FP8 != 0)>(ring, g, S, E, F.wave); REPB(L1_M1, pg8::gemm_phase<EPAIR8L1, pg8::MoeOrder, true, (M1L1_FP8 != 0)>(ring, g, S, E, F.wave)); } SEAM(L1_M1);
    if (IN(L1_M2)) { pg8::Gemm g{F.ACT, WMD, M, DM, FF, (size_t)DM * FF * M2_B, nullptr, nullptr}; pg8::MoeOrder S; S.init((const unsigned*)(F.ctl + CW_CNT), 4, F.G, cid);
        pg8::EpiMoeDn E{F.BUF, (const float*)(F.ws + WS_GATEP)}; pg8::gemm_phase<pg8::EpiMoeDn, pg8::MoeOrder, false, (M2_FP8 != 0)>(ring, g, S, E, F.wave); REPB(L1_M2, pg8::gemm_phase<pg8::EpiMoeDn, pg8::MoeOrder, false, (M2_FP8 != 0)>(ring, g, S, E, F.wave)); } SEAM(L1_M2);
    if (IN(L1_COMB)) { thin_phase<2 | 4>(F, args, F.out, 2, 0, 1, 0); REPB(L1_COMB, thin_phase<2 | 4>(F, args, F.out, 2, 0, -1, 0)); } SEAM(L1_COMB);

    if (IN(L2_SSM)) { ssm_phase(F, args); REPB(L2_SSM, ssm_phase(F, args)); } SEAM(L2_SSM);
    if (IN(L2_G2)) { GEMM_STATIC(F.ACT, WGL, 2048, DM, pg8::EpiGluRes, ({F.out, MODP(2, 2)})); REPB(L2_G2, GEMM_STATIC(F.ACT, WGL, 2048, DM, pg8::EpiGluRes, ({F.out, ZEROG}))); } SEAM(L2_G2);
    if (IN(L2_NORM)) { thin_phase<4>(F, args, F.out, 2, 1, 0, 0); REPB(L2_NORM, thin_phase<4>(F, args, F.out, 2, 1, 0, 0)); } SEAM(L2_NORM);
    if (IN(L2_F1)) { GEMM_STATIC(F.HB, WFG + (size_t)2 * FF * DM, 2 * FF, DM, EPAIRF, ({F.ACT, FF})); REPB(L2_F1, GEMM_STATIC(F.HB, WFG + (size_t)2 * FF * DM, 2 * FF, DM, EPAIRF, ({F.ACT, FF}))); } SEAM(L2_F1);
    if (IN(L2_F2)) { if (fuse) GEMM_STATICF(F.ACT, W8(WFD, (size_t)DM * FF * (F2_FP8 ? 1 : 2)), DM, FF, pg8::EpiResNorm, FUSED_EPI(2, MODP(2, 5), F.out, 3, 0, F.HB, F2_ASC, 0)); else GEMM_STATICF(F.ACT, W8(WFD, (size_t)DM * FF * (F2_FP8 ? 1 : 2)), DM, FF, pg8::EpiRes, ({F.out, MODP(2, 5), F.out, F2_ASC})); } SEAM(L2_F2);
    if (!fuse) { if (IN(L2_NORMN)) { thin_phase<4>(F, args, F.out, 3, 0, 0, 0); } SEAM(L2_NORMN); }

    if (IN(L3_G1)) { GEMM_STATIC(F.HB, WCI + (size_t)3072 * DM, 3072, DM, pg8::EpiConvIn, {F.BUF}); REPB(L3_G1, GEMM_STATIC(F.HB, WCI + (size_t)3072 * DM, 3072, DM, pg8::EpiConvIn, {F.BUF})); } SEAM(L3_G1);
    if (IN(L3_CONV)) { conv_phase(F, args.in[I_CW] + 3 * DM); REPB(L3_CONV, conv_phase(F, args.in[I_CW] + 3 * DM)); } SEAM(L3_CONV);
    if (IN(L3_G2)) { if (fuseR) GEMM_STATIC(F.HB, WCO + (size_t)DM * DM, DM, DM, pg8::EpiResNormRouter, FUSED_RT(4, MODP(3, 2), 3, 1, 2 * MiB, F.BUF, M1_FP8)); else GEMM_STATIC(F.HB, WCO + (size_t)DM * DM, DM, DM, pg8::EpiRes, ({F.out, MODP(3, 2), F.out, 1.0f})); } SEAM(L3_G2);
    if (!fuseR) { if (IN(L3_NORMR)) { thin_phase<4 | 8>(F, args, F.out, 3, 1, 0, 1, 1, 2 * MiB); } SEAM(L3_NORMR); }
    if (IN(L3_M1)) { pg8::Gemm g{(fuseR ? F.BUF : F.HB), W8(WMG, (size_t)8 * 2 * FF * DM * 2), M, 2 * FF, DM, (size_t)2 * FF * DM * M1_B, (const int*)(F.ws + 2 * MiB + WS_ROWIDX), (const unsigned*)(F.ctl + CW_CNT + 512)}; pg8::MoeOrder S; S.init((const unsigned*)(F.ctl + CW_CNT + 512), 22, F.G, cid);
        EPAIR8 E{F.ACT, FF}; pg8::gemm_phase<EPAIR8, pg8::MoeOrder, true, (M1_FP8 != 0)>(ring, g, S, E, F.wave); REPB(L3_M1, pg8::gemm_phase<EPAIR8, pg8::MoeOrder, true, (M1_FP8 != 0)>(ring, g, S, E, F.wave)); } SEAM(L3_M1);
    if (IN(L3_M2)) { pg8::Gemm g{F.ACT, W8(WMD, (size_t)8 * DM * FF * M2_B), M, DM, FF, (size_t)DM * FF * M2_B, nullptr, nullptr}; pg8::MoeOrder S; S.init((const unsigned*)(F.ctl + CW_CNT + 512), 4, F.G, cid);
        pg8::EpiMoeDn E{F.BUF, (const float*)(F.ws + 2 * MiB + WS_GATEP)}; pg8::gemm_phase<pg8::EpiMoeDn, pg8::MoeOrder, false, (M2_FP8 != 0)>(ring, g, S, E, F.wave); REPB(L3_M2, pg8::gemm_phase<pg8::EpiMoeDn, pg8::MoeOrder, false, (M2_FP8 != 0)>(ring, g, S, E, F.wave)); } SEAM(L3_M2);
    if (IN(L3_COMB)) { thin_phase<2>(F, args, F.out, 0, 0, 3, 1, 1, 2 * MiB); }
#undef IN
#undef SEAM
}

extern "C" void kernel_launch(void* const* d_in, const int* in_sizes, int n_in, void* d_out, int out_size, void* d_ws, size_t ws_size, hipStream_t stream) {
    static int grid = 0;
    if (grid == 0) {
        if (n_in != 28 || in_sizes[0] != M * DM || out_size != M * DM || ws_size < WS_END) { fprintf(stderr, "kernel_launch: unexpected shapes / workspace (n_in %d, ws %zu, need %zu)\n", n_in, ws_size, (size_t)WS_END); grid = -1; return; }
        int dev = 0, cus = 0, per_cu = 0;
        if (hipGetDevice(&dev) != hipSuccess || hipDeviceGetAttribute(&cus, hipDeviceAttributeMultiprocessorCount, dev) != hipSuccess) { grid = -1; return; }
        if (hipFuncSetAttribute((const void*)mega_fwd, hipFuncAttributeMaxDynamicSharedMemorySize, LDS_BYTES) != hipSuccess) { fprintf(stderr, "kernel_launch: hipFuncSetAttribute failed\n"); grid = -1; return; }
        if (hipOccupancyMaxActiveBlocksPerMultiprocessor(&per_cu, (const void*)mega_fwd, NTHREADS, LDS_BYTES) != hipSuccess || per_cu < 1) fprintf(stderr, "kernel_launch: occupancy query reports %d\n", per_cu);
        (void)hipGetLastError();
        grid = cus;
    }
    if (grid < 0) return;
    (void)hipMemsetAsync((char*)d_ws + WS_CTL, 0, CTL_ZERO_BYTES, stream);
    Args a{};
    for (int i = 0; i < 28; ++i) a.in[i] = (const float*)d_in[i];
    a.out = (float*)d_out; a.ws = (unsigned char*)d_ws;
#if MK_PER_PHASE
    for (int p = 0; p < NPH; ++p) { a.ph_lo = p; a.ph_hi = p + 1; hipLaunchKernelGGL(mega_fwd, dim3(grid), dim3(NTHREADS), LDS_BYTES, stream, a); }
#else
    a.ph_lo = 0; a.ph_hi = NPH; hipLaunchKernelGGL(mega_fwd, dim3(grid), dim3(NTHREADS), LDS_BYTES, stream, a);
#endif
}
```

```cpp
#include <hip/hip_runtime.h>
#include <cstdio>
#include <cstdint>
#include <cmath>

#ifndef MK_PER_PHASE
#define MK_PER_PHASE 0
#endif

#define GAS __attribute__((address_space(1)))
#define LAS __attribute__((address_space(3)))
typedef unsigned short bf16_t;
typedef short bf16x8 __attribute__((ext_vector_type(8)));
typedef float f32x4 __attribute__((ext_vector_type(4)));
typedef float f32x2 __attribute__((ext_vector_type(2)));
typedef float f32x16 __attribute__((ext_vector_type(16)));
typedef unsigned u32x4 __attribute__((ext_vector_type(4)));
typedef unsigned u32x2 __attribute__((ext_vector_type(2)));
typedef GAS unsigned gu32;
#define RLX_AGENT __ATOMIC_RELAXED, __HIP_MEMORY_SCOPE_AGENT
#define LDS_WAIT() asm volatile("s_waitcnt lgkmcnt(0)" ::: "memory")
#define VM_WAIT() asm volatile("s_waitcnt vmcnt(0)" ::: "memory")
#define CFENCE() asm volatile("" ::: "memory")

constexpr int DM = 1024, NB = 4, SEQ = 4096, M = NB * SEQ, FF = 2816, NEXP = 8;
constexpr int NH = 16, NKV = 4, HD = 64, IH = 8, IDIM = 64, TOPK = 256;
constexpr int ATT_N = 2120, ATT_NP = 2304;
constexpr float EPS = 1e-6f;
constexpr int NWAVES = 8, NTHREADS = 512;

__device__ __forceinline__ unsigned f2bf(float f) { unsigned u = __builtin_bit_cast(unsigned, f); return (u + 0x7fffu + ((u >> 16) & 1u)) >> 16; }
__device__ __forceinline__ unsigned pk2(float lo, float hi) { return f2bf(lo) | (f2bf(hi) << 16); }
__device__ __forceinline__ unsigned cvt_pk_bf16(float lo, float hi) { unsigned r; asm volatile("v_cvt_pk_bf16_f32 %0, %1, %2" : "=v"(r) : "v"(lo), "v"(hi)); return r; }
__device__ __forceinline__ float bflo(unsigned u) { return __uint_as_float(u << 16); }
__device__ __forceinline__ float bfhi(unsigned u) { return __uint_as_float(u & 0xffff0000u); }
__device__ __forceinline__ float wave_sum(float v) {
#pragma unroll
    for (int o = 1; o < 64; o <<= 1) v += __shfl_xor(v, o);
    return v;
}
__device__ __forceinline__ float fast_rcp(float x) { return __builtin_amdgcn_rcpf(x); }
__device__ __forceinline__ float silu_f(float g) { return g * fast_rcp(1.f + __expf(-g)); }
__device__ __forceinline__ float sigmoid_f(float g) { return fast_rcp(1.f + __expf(-g)); }
__device__ __forceinline__ float gelu_tanh_f(float y) { const float z = 0.7978845608028654f * (y + 0.044715f * y * y * y); const float t = 1.f - 2.f * fast_rcp(__expf(2.f * z) + 1.f); return 0.5f * y * (1.f + t); }

constexpr size_t WS_ROWIDX_B = 2u << 20, WS_GATEP_B = (2u << 20) + 512 * 1024, WS_SLOT_B = 3u << 20;
__device__ __forceinline__ int lane_id_fresh() { int l; asm volatile("v_mbcnt_lo_u32_b32 %0, -1, 0\n\tv_mbcnt_hi_u32_b32 %0, -1, %0" : "=v"(l)); return l; }
#ifndef FUSE_R
#define FUSE_R 1
#endif
#ifndef FUSE_N
#define FUSE_N 1
#endif
#ifndef M2_FP8
#define M2_FP8 1
#endif
#ifndef F1L0_FP8
#define F1L0_FP8 1
#endif
#ifndef M1L1_FP8
#define M1L1_FP8 1
#endif
#ifndef M1_FP8
#define M1_FP8 1
#endif
#ifndef F2L0_FP8
#define F2L0_FP8 1
#endif
#ifndef F2_FP8
#define F2_FP8 1
#endif
namespace pg8 {
constexpr int BM = 256, BK = 64, HALF = 128, HTB = HALF * BK * 2, STAGE_BYTES = 8 * HTB, NXCD = 8, WGM = 8;
__host__ __device__ __forceinline__ int lds_byte(int r, int c) { const int st = (r >> 4) * 2 + (c >> 5), rr = r & 15, cc = c & 31, ob = rr * 64 + cc * 2; return st * 1024 + (ob ^ (((ob >> 9) & 1) << 5)); }
__host__ __device__ __forceinline__ void stage_rc(int b, int& R, int& C) { const int st = b / 1024, sb = b % 1024, swz = sb ^ (((sb >> 9) & 1) << 5); R = (st >> 1) * 16 + swz / 64; C = (st & 1) * 32 + (swz % 64) / 2; }
__host__ __device__ __forceinline__ int perm32(int rho) { const int n = rho >> 4, i = rho & 15; return 8 * (i >> 2) + 4 * n + (i & 3); }

struct Unit { int pm, pn, e, aux; };
struct Gemm { const bf16_t* A; const bf16_t* Bt; int M, N, K; size_t bstride_e; const int* rowidx; const unsigned* cnt; };

struct StaticOrder {
    int nM, nN, nwg, G, c;
    __device__ __forceinline__ void init(int M_, int N_, int G_, int c_) { nM = M_ / BM; nN = N_ / BM; nwg = nM * nN; G = G_; c = c_; }
    __device__ __forceinline__ bool next(int i, Unit& u) const {
        const long L = (long)i * G + c; if (L >= nwg) return false;
        int wgid = (int)L; { const int q = nwg / NXCD, r = nwg % NXCD, xcd = wgid % NXCD, off = wgid / NXCD; wgid = (xcd < r ? xcd * (q + 1) : r * (q + 1) + (xcd - r) * q) + off; }
        const int nig = WGM * nN, gid = wgid / nig, fm = gid * WGM, gsz = (nM - fm) < WGM ? (nM - fm) : WGM;
        u.pm = fm + ((wgid % nig) % gsz); u.pn = (wgid % nig) / gsz; u.e = 0; u.aux = 0; return true;
    }
};
struct MoeOrder {
    int T1, T2, T3, T4, T5, T6, T7, T8, NT, W, r, lo, ntl;
    static constexpr int RG = 4;
    __device__ __forceinline__ void init(const unsigned* cnt, int NT_, int G_, int c_) {
        int t[9]; int acc = 0;
#pragma unroll
        for (int e = 0; e < 8; ++e) { t[e] = acc; acc += (int)((__hip_atomic_load(cnt + 64 * e, RLX_AGENT) + 255u) >> 8); }
        t[8] = acc; T1 = t[1]; T2 = t[2]; T3 = t[3]; T4 = t[4]; T5 = t[5]; T6 = t[6]; T7 = t[7]; T8 = t[8]; NT = NT_;
        if (G_ % 8 == 0) { const int xv = c_ % 8; W = G_ / 8; r = c_ / 8; lo = (T8 * xv) / 8; ntl = (T8 * (xv + 1)) / 8 - lo; }
        else { W = G_; r = c_; lo = 0; ntl = T8; }
    }
    __device__ __forceinline__ bool next(int i, Unit& u) const {
        const int q = i * W + r; if (q >= ntl * NT) return false;
        const int nig = RG * NT, gid = q / nig, fm = gid * RG, gsz = (ntl - fm) < RG ? (ntl - fm) : RG, w = q - gid * nig;
        const int tt = lo + fm + (w % gsz), pn = w / gsz;
        int e = 0, te = 0;
        if (tt >= T1) { e = 1; te = T1; } if (tt >= T2) { e = 2; te = T2; } if (tt >= T3) { e = 3; te = T3; } if (tt >= T4) { e = 4; te = T4; }
        if (tt >= T5) { e = 5; te = T5; } if (tt >= T6) { e = 6; te = T6; } if (tt >= T7) { e = 7; te = T7; }
        u.pm = tt; u.pn = pn; u.e = e; u.aux = e * 16384 + 256 * (tt - te); return true;
    }
};

typedef int v8i32 __attribute__((ext_vector_type(8)));
typedef int v4i32 __attribute__((ext_vector_type(4)));
constexpr float W8_MUL = 32.0f, W8_INV = 1.0f / 32.0f;
__device__ __forceinline__ void mfma8(f32x4& c, const v8i32 a, const v8i32 b) { asm volatile("v_mfma_f32_16x16x128_f8f6f4 %0, %1, %2, %0" : "+v"(c) : "v"(a), "v"(b)); }
__device__ __forceinline__ v8i32 cat8(const bf16x8 a, const bf16x8 b) { return __builtin_shufflevector(__builtin_bit_cast(v4i32, a), __builtin_bit_cast(v4i32, b), 0, 1, 2, 3, 4, 5, 6, 7); }
template <class Epi, class Sched, bool GATHER, bool FP8 = false>
__device__ __forceinline__ void gemm_phase(LAS unsigned char* lds, const Gemm g, const Sched& S, const Epi& E, const int wid) {
    const int lane = lane_id_fresh(), tid = wid * 64 + lane, wr = wid >> 2, wc = wid & 3, fr = lane & 15, fq = lane >> 4;
    const int K = FP8 ? g.K / 2 : g.K, nt = K / BK;
    unsigned voffB[2]; int stR[2], stC[2];
#pragma unroll
    for (int i = 0; i < 2; ++i) { int R, C; stage_rc(tid * 16 + i * 8192, R, C); const int Rb = (R & ~31) + perm32(R & 31);
        stR[i] = R; stC[i] = C; voffB[i] = (unsigned)(Rb * K + C) * 2u; }
    const size_t kstep = (size_t)(BK * 2);
    const size_t hstep = (size_t)HALF * K * 2;
    const size_t tstep = 2 * hstep;
    const unsigned ldsw = (unsigned)wid * 1024u;
    const int aoff = lds_byte(wr * 64 + fr, fq * 8), boff = lds_byte(wc * 32 + fr, fq * 8);
#define PG8_SA(b, h) (((b) * 2 + (h)) * HTB)
#define PG8_SB(b, h) ((4 + (b) * 2 + (h)) * HTB)
#define PG8_STAGE(bufoff, gbase, voff) do { _Pragma("unroll") for (int _i = 0; _i < 2; ++_i) \
        __builtin_amdgcn_global_load_lds((const unsigned*)((const char*)(gbase) + (voff)[_i]), (LAS unsigned*)(lds + (bufoff) + ldsw + _i * 8192), 16, 0, 0); } while (0)
#define PG8_LDA(dst, b, h) do { _Pragma("unroll") for (int m = 0; m < 4; ++m) _Pragma("unroll") for (int k = 0; k < 2; ++k) dst[m][k] = *(const LAS bf16x8*)(lds + PG8_SA(b, h) + aoff + m * 2048 + k * 1024); } while (0)
#define PG8_LDB(dst, b, h) do { _Pragma("unroll") for (int n = 0; n < 2; ++n) _Pragma("unroll") for (int k = 0; k < 2; ++k) dst[n][k] = *(const LAS bf16x8*)(lds + PG8_SB(b, h) + boff + n * 2048 + k * 1024); } while (0)
#define PG8_MMA(ai, bj, At, Bt) do { __builtin_amdgcn_s_setprio(1); _Pragma("unroll") for (int m = 0; m < 4; ++m) _Pragma("unroll") for (int n = 0; n < 2; ++n) { \
        if (FP8) mfma8(acc[ai][bj][m][n], cat8(Bt[n][0], Bt[n][1]), cat8(At[m][0], At[m][1])); \
        else { _Pragma("unroll") for (int k = 0; k < 2; ++k) acc[ai][bj][m][n] = __builtin_amdgcn_mfma_f32_16x16x32_bf16(Bt[n][k], At[m][k], acc[ai][bj][m][n], 0, 0, 0); } } \
        __builtin_amdgcn_s_setprio(0); } while (0)
#define PG8_MMA_END(At, B0, B1) do { if (FP8) { asm volatile("s_nop 15\n\ts_nop 15\n\ts_nop 15\n\ts_nop 15" :: "v"(cat8(At[0][0], At[0][1])), "v"(cat8(At[1][0], At[1][1])), "v"(cat8(At[2][0], At[2][1])), "v"(cat8(At[3][0], At[3][1])), \
        "v"(cat8(B0[0][0], B0[0][1])), "v"(cat8(B0[1][0], B0[1][1])), "v"(cat8(B1[0][0], B1[0][1])), "v"(cat8(B1[1][0], B1[1][1]))); } } while (0)
#define PG8_WAIT_V(n) asm volatile("s_waitcnt vmcnt(" #n ")" ::: "memory")
#define PG8_WAIT_L(n) asm volatile("s_waitcnt lgkmcnt(" #n ")" ::: "memory")
#define PG8_BAR __builtin_amdgcn_s_barrier()
#define PG8_SCHED __builtin_amdgcn_sched_barrier(0)
#define PG8_AOFFS(v, U) do { _Pragma("unroll") for (int _h = 0; _h < 2; ++_h) _Pragma("unroll") for (int _i = 0; _i < 2; ++_i) { \
        if (GATHER) { const int _loc = ((U).aux & 16383) + _h * HALF + stR[_i]; const int _e = (U).aux >> 14; \
            const int _row = (_loc < (int)g.cnt[64 * _e]) ? g.rowidx[(U).aux + _h * HALF + stR[_i]] : 0; \
            v[_h][_i] = (unsigned)(_row * K + stC[_i]) * 2u; } \
        else v[_h][_i] = (unsigned)((_h * HALF + stR[_i]) * K + stC[_i]) * 2u; } } while (0)
    int cn8[8];
#pragma unroll
    for (int e = 0; e < 8; ++e) cn8[e] = GATHER ? __builtin_amdgcn_readfirstlane((int)g.cnt[64 * e]) : 0;
    Unit cur, nxt; int ui = 0;
    if (!S.next(0, cur)) return;
    f32x4 acc[2][2][4][2];
#pragma unroll
    for (int a = 0; a < 2; ++a)
#pragma unroll
        for (int b = 0; b < 2; ++b)
#pragma unroll
            for (int m = 0; m < 4; ++m)
#pragma unroll
                for (int n = 0; n < 2; ++n) acc[a][b][m][n] = (f32x4){0.f, 0.f, 0.f, 0.f};
    bf16x8 At[4][2], B0[2][2], B1[2][2];
    unsigned vAc[2][2], vAn[2][2];
    PG8_AOFFS(vAc, cur);
    const char* cA = (const char*)g.A + (GATHER ? (size_t)0 : (size_t)cur.pm * tstep);
    const char* cB = (const char*)g.Bt + (size_t)cur.e * g.bstride_e + (size_t)cur.pn * tstep;
    PG8_STAGE(PG8_SB(0, 0), cB, voffB); PG8_STAGE(PG8_SB(0, 1), cB + hstep, voffB); PG8_STAGE(PG8_SA(0, 0), cA, vAc[0]); PG8_STAGE(PG8_SA(0, 1), cA, vAc[1]);
    if (wr == 1) PG8_BAR;
    PG8_WAIT_V(2); PG8_BAR;
    PG8_STAGE(PG8_SB(1, 0), cB + kstep, voffB); PG8_STAGE(PG8_SA(1, 0), cA + kstep, vAc[0]); PG8_STAGE(PG8_SB(1, 1), cB + hstep + kstep, voffB);
    PG8_WAIT_V(6); PG8_BAR;
    for (;;) {
        const bool has_next = S.next(ui + 1, nxt);
        const char* nA = cA; const char* nB = cB;
        int rn[2][2];
        if (has_next) { if (GATHER) {
#pragma unroll
                for (int h = 0; h < 2; ++h)
#pragma unroll
                    for (int i = 0; i < 2; ++i) rn[h][i] = g.rowidx[nxt.aux + h * HALF + stR[i]]; }
            else PG8_AOFFS(vAn, nxt);
            nA = (const char*)g.A + (GATHER ? (size_t)0 : (size_t)nxt.pm * tstep); nB = (const char*)g.Bt + (size_t)nxt.e * g.bstride_e + (size_t)nxt.pn * tstep; }
        else {
#pragma unroll
            for (int h = 0; h < 2; ++h)
#pragma unroll
                for (int i = 0; i < 2; ++i) vAn[h][i] = vAc[h][i];
        }
#pragma nounroll
        for (int t = 0; t < nt; t += 2) {
            const bool last = (t == nt - 2);
            const char* a1 = cA + (size_t)(t + 1) * kstep;
            const char* a2 = last ? nA : cA + (size_t)(t + 2) * kstep; const char* b2 = last ? nB : cB + (size_t)(t + 2) * kstep;
            const char* a3 = a2 + kstep; const char* b3 = b2 + kstep;
            if (GATHER && last && has_next) { const int _e = nxt.aux >> 14;
                const int _cn = _e == 0 ? cn8[0] : _e == 1 ? cn8[1] : _e == 2 ? cn8[2] : _e == 3 ? cn8[3] : _e == 4 ? cn8[4] : _e == 5 ? cn8[5] : _e == 6 ? cn8[6] : cn8[7];
#pragma unroll
                for (int h = 0; h < 2; ++h)
#pragma unroll
                    for (int i = 0; i < 2; ++i) { int r_ = rn[h][i]; asm volatile("" : "+v"(r_)); const int _loc = (nxt.aux & 16383) + h * HALF + stR[i];
                        r_ = _loc < _cn ? r_ : 0; vAn[h][i] = (unsigned)(r_ * K + stC[i]) * 2u; } }
            unsigned v2[2][2];
#pragma unroll
            for (int h = 0; h < 2; ++h)
#pragma unroll
                for (int i = 0; i < 2; ++i) v2[h][i] = last ? vAn[h][i] : vAc[h][i];
            PG8_LDB(B0, 0, 0); PG8_LDB(B1, 0, 1); PG8_SCHED; PG8_LDA(At, 0, 0); PG8_STAGE(PG8_SA(1, 1), a1, vAc[1]);
            PG8_WAIT_V(8); PG8_WAIT_L(0); PG8_BAR; PG8_MMA(0, 0, At, B0); PG8_MMA(0, 1, At, B1); PG8_MMA_END(At, B0, B1); PG8_BAR; PG8_SCHED;
            PG8_LDA(At, 0, 1); PG8_STAGE(PG8_SB(0, 0), b2, voffB); PG8_STAGE(PG8_SB(0, 1), b2 + hstep, voffB); PG8_STAGE(PG8_SA(0, 0), a2, v2[0]);
            PG8_WAIT_V(8); PG8_WAIT_L(0); PG8_BAR; PG8_MMA(1, 0, At, B0); PG8_MMA(1, 1, At, B1); PG8_MMA_END(At, B0, B1); PG8_BAR; PG8_SCHED;
            PG8_LDB(B0, 1, 0); PG8_LDB(B1, 1, 1); PG8_SCHED; PG8_LDA(At, 1, 0); PG8_STAGE(PG8_SA(0, 1), a2, v2[1]);
            PG8_WAIT_V(8); PG8_WAIT_L(0); PG8_BAR; PG8_MMA(0, 0, At, B0); PG8_MMA(0, 1, At, B1); PG8_MMA_END(At, B0, B1); PG8_BAR; PG8_SCHED;
            PG8_LDA(At, 1, 1); PG8_STAGE(PG8_SB(1, 0), b3, voffB); PG8_STAGE(PG8_SB(1, 1), b3 + hstep, voffB); PG8_STAGE(PG8_SA(1, 0), a3, v2[0]);
            PG8_WAIT_V(8); PG8_WAIT_L(0); PG8_BAR; PG8_MMA(1, 0, At, B0); PG8_MMA(1, 1, At, B1); PG8_MMA_END(At, B0, B1); PG8_BAR; PG8_SCHED;
        }
        if (wr == 0) PG8_BAR;
        if (FP8) asm volatile("s_nop 15\n\ts_nop 15\n\ts_nop 15\n\ts_nop 15\n\ts_nop 15\n\ts_nop 15" ::: "memory");
        if constexpr (!Epi::FUSED) E(acc, cur, wr, wc, fr, fq);
        if (!has_next) break;
#pragma unroll
        for (int a = 0; a < 2; ++a)
#pragma unroll
            for (int b = 0; b < 2; ++b)
#pragma unroll
                for (int m = 0; m < 4; ++m)
#pragma unroll
                    for (int n = 0; n < 2; ++n) acc[a][b][m][n] = (f32x4){0.f, 0.f, 0.f, 0.f};
        cur = nxt; cA = nA; cB = nB; ++ui;
#pragma unroll
        for (int h = 0; h < 2; ++h)
#pragma unroll
            for (int i = 0; i < 2; ++i) vAc[h][i] = vAn[h][i];
        if (wr == 1) PG8_BAR;
    }
    PG8_WAIT_V(0);
    PG8_BAR;
    if constexpr (Epi::FUSED) E.fused(acc, cur, wr, wc, fr, fq, lds, wid, lane);
#undef PG8_SA
#undef PG8_SB
#undef PG8_STAGE
#undef PG8_LDA
#undef PG8_LDB
#undef PG8_MMA
#undef PG8_MMA_END
#undef PG8_WAIT_V
#undef PG8_WAIT_L
#undef PG8_BAR
#undef PG8_SCHED
#undef PG8_AOFFS
}

__device__ __forceinline__ f32x4 ldx16(const float* p) { return *(const f32x4*)p; }
typedef f32x4 Acc[2][2][4][2];
__device__ __forceinline__ u32x4 pack8(const f32x4 a, const f32x4 b) { u32x4 w; w.x = cvt_pk_bf16(a[0], a[1]); w.y = cvt_pk_bf16(a[2], a[3]); w.z = cvt_pk_bf16(b[0], b[1]); w.w = cvt_pk_bf16(b[2], b[3]); return w; }

template <int MODE, bool OUT8 = false, bool SC8 = OUT8> struct EpiPair {
    static constexpr bool FUSED = false;
    bf16_t* O; int ldo;
    __device__ __forceinline__ void operator()(const Acc& acc, const Unit& u, int wr, int wc, int fr, int fq) const {
        const int row0 = u.pm * BM + wr * 64 + fr, col0 = u.pn * HALF + wc * 32 + 8 * fq;
#pragma unroll
        for (int ai = 0; ai < 2; ++ai)
#pragma unroll
            for (int m = 0; m < 4; ++m) { f32x4 r0, r1;
#pragma unroll
                for (int e = 0; e < 4; ++e) { const float sc8 = SC8 ? W8_INV : 1.0f; const float a0 = acc[ai][0][m][0][e] * sc8, a1 = acc[ai][0][m][1][e] * sc8, b0 = acc[ai][1][m][0][e] * sc8, b1 = acc[ai][1][m][1][e] * sc8;
                    r0[e] = (MODE == 1 ? silu_f(a0) : a0) * b0; r1[e] = (MODE == 1 ? silu_f(a1) : a1) * b1; }
                if (OUT8) { u32x2 w; int t0 = 0, t1 = 0; t0 = __builtin_amdgcn_cvt_pk_fp8_f32(r0[0], r0[1], t0, false); t0 = __builtin_amdgcn_cvt_pk_fp8_f32(r0[2], r0[3], t0, true);
                    t1 = __builtin_amdgcn_cvt_pk_fp8_f32(r1[0], r1[1], t1, false); t1 = __builtin_amdgcn_cvt_pk_fp8_f32(r1[2], r1[3], t1, true); w.x = (unsigned)t0; w.y = (unsigned)t1;
                    *(u32x2*)((unsigned char*)O + (size_t)(row0 + ai * HALF + m * 16) * ldo + col0) = w; }
                else *(u32x4*)(O + (size_t)(row0 + ai * HALF + m * 16) * ldo + col0) = pack8(r0, r1); }
    }
};
struct EpiConvIn {
    static constexpr bool FUSED = false;
    bf16_t* UB;
    __device__ __forceinline__ void operator()(const Acc& acc, const Unit& u, int wr, int wc, int fr, int fq) const {
        const int row0 = u.pm * BM + wr * 64 + fr;
        if (u.pn < 8) { EpiPair<0, false, false> P{UB, 2048}; P(acc, u, wr, wc, fr, fq); }
        else { const int col0 = 1024 + (u.pn - 8) * BM + wc * 32 + 8 * fq;
#pragma unroll
            for (int ai = 0; ai < 2; ++ai)
#pragma unroll
                for (int m = 0; m < 4; ++m)
#pragma unroll
                    for (int bj = 0; bj < 2; ++bj) *(u32x4*)(UB + (size_t)(row0 + ai * HALF + m * 16) * 2048 + col0 + bj * HALF) = pack8(acc[ai][bj][m][0], acc[ai][bj][m][1]); }
    }
};
struct EpiRes {
    static constexpr bool FUSED = false;
    float* X; const float* gate; const float* Xin; float asc;
    __device__ __forceinline__ void operator()(const Acc& acc, const Unit& u, int wr, int wc, int fr, int fq) const {
        const int row0 = u.pm * BM + wr * 64 + fr, col0 = u.pn * BM + wc * 32 + 8 * fq; const int b = (u.pm * BM) / SEQ;
        f32x4 gv[2][2];
#pragma unroll
        for (int bj = 0; bj < 2; ++bj)
#pragma unroll
            for (int n = 0; n < 2; ++n) gv[bj][n] = *(const f32x4*)(gate + (size_t)b * 6144 + col0 + bj * HALF + 4 * n) * asc;
#pragma unroll
        for (int ai = 0; ai < 2; ++ai) {
            f32x4 xv[4][2][2];
#pragma unroll
            for (int m = 0; m < 4; ++m) { const float* ri = Xin + (size_t)(row0 + ai * HALF + m * 16) * DM + col0;
#pragma unroll
                for (int bj = 0; bj < 2; ++bj)
#pragma unroll
                    for (int n = 0; n < 2; ++n) xv[m][bj][n] = ldx16(ri + bj * HALF + 4 * n); }
            asm volatile("" ::: "memory");
#pragma unroll
            for (int m = 0; m < 4; ++m) { float* rp = X + (size_t)(row0 + ai * HALF + m * 16) * DM + col0;
#pragma unroll
                for (int bj = 0; bj < 2; ++bj)
#pragma unroll
                    for (int n = 0; n < 2; ++n) *(f32x4*)(rp + bj * HALF + 4 * n) = xv[m][bj][n] + gv[bj][n] * acc[ai][bj][m][n]; }
            asm volatile("" ::: "memory");
        }
    }
};
struct EpiResNorm {
    static constexpr bool FUSED = true;
    float* X; const float* gate; const float* Xin; const float* ng; const float* shb; bf16_t* H; float* xs; gu32* cnt; gu32* tmo; float asc; int h8;
    __device__ __forceinline__ void fused(Acc& acc, const Unit& u, int wr, int wc, int fr, int fq, LAS unsigned char* lds, int wid, int lane) const {
        const int row0 = u.pm * BM + wr * 64 + fr, col0 = u.pn * BM + wc * 32 + 8 * fq; const int b = (u.pm * BM) / SEQ;
        LAS float* P = (LAS float*)lds; LAS float* S = (LAS float*)(lds + 4096);
        { f32x4 gv[2][2];
#pragma unroll
          for (int bj = 0; bj < 2; ++bj)
#pragma unroll
              for (int n = 0; n < 2; ++n) gv[bj][n] = *(const f32x4*)(gate + (size_t)b * 6144 + col0 + bj * HALF + 4 * n) * asc;
#pragma unroll
          for (int ai = 0; ai < 2; ++ai) {
              f32x4 xv[4][2][2];
#pragma unroll
              for (int m = 0; m < 4; ++m) { const float* ri = Xin + (size_t)(row0 + ai * HALF + m * 16) * DM + col0;
#pragma unroll
                  for (int bj = 0; bj < 2; ++bj)
#pragma unroll
                      for (int n = 0; n < 2; ++n) xv[m][bj][n] = ldx16(ri + bj * HALF + 4 * n); }
              asm volatile("" ::: "memory");
#pragma unroll
              for (int m = 0; m < 4; ++m) { float* rp = X + (size_t)(row0 + ai * HALF + m * 16) * DM + col0; float ss = 0.f;
#pragma unroll
                  for (int bj = 0; bj < 2; ++bj)
#pragma unroll
                      for (int n = 0; n < 2; ++n) { const f32x4 x = xv[m][bj][n] + gv[bj][n] * acc[ai][bj][m][n]; acc[ai][bj][m][n] = x; *(f32x4*)(rp + bj * HALF + 4 * n) = x;
                          ss += (x[0] * x[0] + x[1] * x[1]) + (x[2] * x[2] + x[3] * x[3]); }
                  ss += __shfl_xor(ss, 16); ss += __shfl_xor(ss, 32);
                  if (fq == 0) P[(ai * HALF + wr * 64 + m * 16 + fr) * 4 + wc] = ss; }
              asm volatile("" ::: "memory");
          } }
        asm volatile("s_waitcnt lgkmcnt(0)" ::: "memory"); __builtin_amdgcn_s_barrier(); asm volatile("" ::: "memory");
        const int tid = wid * 64 + lane;
        if (tid < 256) { const f32x4 p4 = *(const LAS f32x4*)(P + tid * 4); const float sp = (p4[0] + p4[1]) + (p4[2] + p4[3]);
            __hip_atomic_store((gu32*)xs + ((size_t)(u.pm * BM + tid) * 4 + u.pn), __float_as_uint(sp), RLX_AGENT); }
        asm volatile("s_waitcnt vmcnt(0)" ::: "memory");
        if (wid < 4 && lane == 0) __hip_atomic_fetch_add(cnt + 64 * u.pm, 1u, RLX_AGENT);
        if (wid == 0) { unsigned spins = 0;
            while ((unsigned)__builtin_amdgcn_readfirstlane(__hip_atomic_load(cnt + 64 * u.pm, RLX_AGENT)) < 16u) { __builtin_amdgcn_s_sleep(2);
                if (++spins > (1u << 20)) { if (lane == 0) __hip_atomic_store(tmo, 1u, RLX_AGENT); break; } } }
        asm volatile("s_waitcnt vmcnt(0) lgkmcnt(0)" ::: "memory"); __builtin_amdgcn_s_barrier(); asm volatile("" ::: "memory");
        if (tid < 256) { const GAS unsigned long long* q = (const GAS unsigned long long*)xs + (size_t)(u.pm * BM + tid) * 2;
            const unsigned long long a = __hip_atomic_load(q, RLX_AGENT), c = __hip_atomic_load(q + 1, RLX_AGENT);
            const float tot = (__uint_as_float((unsigned)a) + __uint_as_float((unsigned)(a >> 32))) + (__uint_as_float((unsigned)c) + __uint_as_float((unsigned)(c >> 32)));
            S[tid] = 1.0f / sqrtf(tot * (1.0f / DM) + EPS); }
        asm volatile("s_waitcnt vmcnt(0) lgkmcnt(0)" ::: "memory"); __builtin_amdgcn_s_barrier(); asm volatile("" ::: "memory");
        f32x4 gm[2][2], sf[2][2];
#pragma unroll
        for (int bj = 0; bj < 2; ++bj)
#pragma unroll
            for (int n = 0; n < 2; ++n) { const int c = col0 + bj * HALF + 4 * n; const f32x4 g4 = *(const f32x4*)(ng + c), s1 = *(const f32x4*)(shb + (size_t)b * 6144 + DM + c);
                gm[bj][n] = g4 * (s1 + 1.0f); sf[bj][n] = *(const f32x4*)(shb + (size_t)b * 6144 + c); }
#pragma unroll
        for (int ai = 0; ai < 2; ++ai)
#pragma unroll
            for (int m = 0; m < 4; ++m) { const float r = S[ai * HALF + wr * 64 + m * 16 + fr]; bf16_t* hp = H + (size_t)(row0 + ai * HALF + m * 16) * DM + col0;
#pragma unroll
                for (int bj = 0; bj < 2; ++bj) { const f32x4 h0 = (acc[ai][bj][m][0] * r) * gm[bj][0] + sf[bj][0], h1 = (acc[ai][bj][m][1] * r) * gm[bj][1] + sf[bj][1];
                    if (F1L0_FP8 && h8) { int t0 = 0, t1 = 0; t0 = __builtin_amdgcn_cvt_pk_fp8_f32(h0[0], h0[1], t0, false); t0 = __builtin_amdgcn_cvt_pk_fp8_f32(h0[2], h0[3], t0, true);
                        t1 = __builtin_amdgcn_cvt_pk_fp8_f32(h1[0], h1[1], t1, false); t1 = __builtin_amdgcn_cvt_pk_fp8_f32(h1[2], h1[3], t1, true); u32x2 w; w.x = (unsigned)t0; w.y = (unsigned)t1;
                        *(u32x2*)((unsigned char*)H + (size_t)(row0 + ai * HALF + m * 16) * DM + col0 + bj * HALF) = w; }
                    else *(u32x4*)(hp + bj * HALF) = pack8(h0, h1); } }
    }
};
struct EpiResNormRouter {
    static constexpr bool FUSED = true;
    float* X; const float* gate; const float* ng; const float* shb; bf16_t* H; float* xs9; gu32* cnt; gu32* tmo;
    const float* rw; const float* rb; gu32* ecnt; unsigned char* meta; int h8;
    __device__ __forceinline__ void fused(Acc& acc, const Unit& u, int wr, int wc, int fr, int fq, LAS unsigned char* lds, int wid, int lane) const {
        const int row0 = u.pm * BM + wr * 64 + fr, col0 = u.pn * BM + wc * 32 + 8 * fq; const int b = (u.pm * BM) / SEQ; const int tid = wid * 64 + lane;
        LAS float* P9 = (LAS float*)lds; LAS float* RWT = (LAS float*)(lds + 36864); LAS float* S = (LAS float*)(lds + 45056); LAS float* CE = (LAS float*)(lds + 46080);
        LAS int* rE = (LAS int*)(lds + 46144); LAS float* red = (LAS float*)(lds + 47360);
        const float* shp = shb + (size_t)b * 6144;
        for (int i = tid; i < 2048; i += NTHREADS) { const int c = i >> 3, e = i & 7; RWT[e * 256 + c] = rw[(size_t)(u.pn * BM + c) * 8 + e]; }
        { float ce[8]; const float s0 = shp[tid], s1 = shp[tid + 512];
#pragma unroll
          for (int e = 0; e < 8; ++e) ce[e] = wave_sum(s0 * rw[(size_t)tid * 8 + e] + s1 * rw[(size_t)(tid + 512) * 8 + e]);
          if (lane == 0) {
#pragma unroll
              for (int e = 0; e < 8; ++e) red[wid * 8 + e] = ce[e]; } }
        { f32x4 gv[2][2];
#pragma unroll
          for (int bj = 0; bj < 2; ++bj)
#pragma unroll
              for (int n = 0; n < 2; ++n) gv[bj][n] = *(const f32x4*)(gate + (size_t)b * 6144 + col0 + bj * HALF + 4 * n);
#pragma unroll
          for (int ai = 0; ai < 2; ++ai) {
              f32x4 xv[4][2][2];
#pragma unroll
              for (int m = 0; m < 4; ++m) { const float* ri = X + (size_t)(row0 + ai * HALF + m * 16) * DM + col0;
#pragma unroll
                  for (int bj = 0; bj < 2; ++bj)
#pragma unroll
                      for (int n = 0; n < 2; ++n) xv[m][bj][n] = ldx16(ri + bj * HALF + 4 * n); }
              asm volatile("" ::: "memory");
#pragma unroll
              for (int m = 0; m < 4; ++m) { float* rp = X + (size_t)(row0 + ai * HALF + m * 16) * DM + col0; float ss = 0.f;
#pragma unroll
                  for (int bj = 0; bj < 2; ++bj)
#pragma unroll
                      for (int n = 0; n < 2; ++n) { const f32x4 x = xv[m][bj][n] + gv[bj][n] * acc[ai][bj][m][n]; acc[ai][bj][m][n] = x; *(f32x4*)(rp + bj * HALF + 4 * n) = x;
                          ss += (x[0] * x[0] + x[1] * x[1]) + (x[2] * x[2] + x[3] * x[3]); }
                  ss += __shfl_xor(ss, 16); ss += __shfl_xor(ss, 32);
                  if (fq == 0) P9[((ai * HALF + wr * 64 + m * 16 + fr) * 4 + wc) * 9] = ss; }
              asm volatile("" ::: "memory");
          } }
        f32x4 sf[2][2];
#pragma unroll
        for (int bj = 0; bj < 2; ++bj)
#pragma unroll
            for (int n = 0; n < 2; ++n) { const int c = col0 + bj * HALF + 4 * n; const f32x4 gm = *(const f32x4*)(ng + c) * (*(const f32x4*)(shp + DM + c) + 1.0f); sf[bj][n] = *(const f32x4*)(shp + c);
#pragma unroll
                for (int ai = 0; ai < 2; ++ai)
#pragma unroll
                    for (int m = 0; m < 4; ++m) acc[ai][bj][m][n] = acc[ai][bj][m][n] * gm; }
        asm volatile("s_waitcnt lgkmcnt(0)" ::: "memory"); __builtin_amdgcn_s_barrier(); asm volatile("" ::: "memory");
        if (tid < 8) { float c = rb[tid];
#pragma unroll
            for (int w = 0; w < 8; ++w) c += red[w * 8 + tid];
            CE[tid] = c; }
#pragma unroll
        for (int e = 0; e < 8; ++e) { f32x4 rwe[2][2];
#pragma unroll
            for (int bj = 0; bj < 2; ++bj)
#pragma unroll
                for (int n = 0; n < 2; ++n) rwe[bj][n] = *(const LAS f32x4*)(RWT + e * 256 + bj * HALF + wc * 32 + 8 * fq + 4 * n);
#pragma unroll
            for (int ai = 0; ai < 2; ++ai)
#pragma unroll
                for (int m = 0; m < 4; ++m) { float a = 0.f;
#pragma unroll
                    for (int bj = 0; bj < 2; ++bj)
#pragma unroll
                        for (int n = 0; n < 2; ++n) { const f32x4 x = acc[ai][bj][m][n], w4 = rwe[bj][n]; a += (x[0] * w4[0] + x[1] * w4[1]) + (x[2] * w4[2] + x[3] * w4[3]); }
                    a += __shfl_xor(a, 16); a += __shfl_xor(a, 32);
                    if (fq == 0) P9[((ai * HALF + wr * 64 + m * 16 + fr) * 4 + wc) * 9 + 1 + e] = a; } }
        asm volatile("s_waitcnt lgkmcnt(0)" ::: "memory"); __builtin_amdgcn_s_barrier(); asm volatile("" ::: "memory");
        if (tid < 256) { gu32* q = (gu32*)xs9 + ((size_t)(u.pm * BM + tid) * 4 + u.pn) * 9;
#pragma unroll
            for (int k = 0; k < 9; ++k) { const float v = (P9[(tid * 4 + 0) * 9 + k] + P9[(tid * 4 + 1) * 9 + k]) + (P9[(tid * 4 + 2) * 9 + k] + P9[(tid * 4 + 3) * 9 + k]);
                __hip_atomic_store(q + k, __float_as_uint(v), RLX_AGENT); } }
        asm volatile("s_waitcnt vmcnt(0)" ::: "memory");
        if (wid < 4 && lane == 0) __hip_atomic_fetch_add(cnt + 64 * u.pm, 1u, RLX_AGENT);
        if (wid == 0) { unsigned spins = 0;
            while ((unsigned)__builtin_amdgcn_readfirstlane(__hip_atomic_load(cnt + 64 * u.pm, RLX_AGENT)) < 16u) { __builtin_amdgcn_s_sleep(2);
                if (++spins > (1u << 20)) { if (lane == 0) __hip_atomic_store(tmo, 1u, RLX_AGENT); break; } } }
        asm volatile("s_waitcnt vmcnt(0) lgkmcnt(0)" ::: "memory"); __builtin_amdgcn_s_barrier(); asm volatile("" ::: "memory");
        if (tid < 256) { const gu32* q = (const gu32*)xs9 + (size_t)(u.pm * BM + tid) * 36; float tot[9];
#pragma unroll
            for (int k = 0; k < 9; ++k) tot[k] = (__uint_as_float(__hip_atomic_load(q + k, RLX_AGENT)) + __uint_as_float(__hip_atomic_load(q + 9 + k, RLX_AGENT)))
                                               + (__uint_as_float(__hip_atomic_load(q + 18 + k, RLX_AGENT)) + __uint_as_float(__hip_atomic_load(q + 27 + k, RLX_AGENT)));
            const float r = 1.0f / sqrtf(tot[0] * (1.0f / DM) + EPS); S[tid] = r;
            if (wid == u.pn) {
                float lg[8];
#pragma unroll
                for (int e = 0; e < 8; ++e) lg[e] = r * tot[1 + e] + CE[e];
                int e0 = 0; float l0 = lg[0];
#pragma unroll
                for (int e = 1; e < 8; ++e) if (lg[e] > l0) { l0 = lg[e]; e0 = e; }
                int e1 = -1; float l1 = -3.0e38f;
#pragma unroll
                for (int e = 0; e < 8; ++e) if (e != e0 && lg[e] > l1) { l1 = lg[e]; e1 = e; }
                const float g0 = 1.0f / (1.0f + __expf(l1 - l0)), g1 = 1.0f - g0;
                int cmine = 0, r0 = 0, r1 = 0;
#pragma unroll
                for (int e = 0; e < 8; ++e) { const unsigned long long m0 = __ballot(e0 == e), m1 = __ballot(e1 == e);
                    const int below = (int)__builtin_amdgcn_mbcnt_hi((unsigned)(m0 >> 32), __builtin_amdgcn_mbcnt_lo((unsigned)m0, 0u)) + (int)__builtin_amdgcn_mbcnt_hi((unsigned)(m1 >> 32), __builtin_amdgcn_mbcnt_lo((unsigned)m1, 0u));
                    if (e0 == e) r0 = below; if (e1 == e) r1 = below; if (lane == e) cmine = __popcll(m0) + __popcll(m1); }
                unsigned base = 0u; if (lane < 8 && cmine) base = __hip_atomic_fetch_add(ecnt + 64 * lane, (unsigned)cmine, RLX_AGENT);
                const int p0 = (int)__shfl(base, e0) + r0, p1 = (int)__shfl(base, e1) + r1, grow = u.pm * BM + 64 * u.pn + lane;
                gu32* ri = (gu32*)(meta + WS_ROWIDX_B); gu32* gp = (gu32*)(meta + WS_GATEP_B); gu32* sl = (gu32*)(meta + WS_SLOT_B);
                __hip_atomic_store(ri + e0 * 16384 + p0, (unsigned)grow, RLX_AGENT); __hip_atomic_store(ri + e1 * 16384 + p1, (unsigned)grow, RLX_AGENT);
                __hip_atomic_store(gp + e0 * 16384 + p0, __float_as_uint(g0), RLX_AGENT); __hip_atomic_store(gp + e1 * 16384 + p1, __float_as_uint(g1), RLX_AGENT);
                __hip_atomic_store(sl + grow * 2, (unsigned)((e0 << 16) | p0), RLX_AGENT); __hip_atomic_store(sl + grow * 2 + 1, (unsigned)((e1 << 16) | p1), RLX_AGENT); } }
        asm volatile("s_waitcnt vmcnt(0) lgkmcnt(0)" ::: "memory"); __builtin_amdgcn_s_barrier(); asm volatile("" ::: "memory");
#pragma unroll
        for (int ai = 0; ai < 2; ++ai)
#pragma unroll
            for (int m = 0; m < 4; ++m) { const float r = S[ai * HALF + wr * 64 + m * 16 + fr]; bf16_t* hp = H + (size_t)(row0 + ai * HALF + m * 16) * DM + col0;
#pragma unroll
                for (int bj = 0; bj < 2; ++bj) { const f32x4 h0 = acc[ai][bj][m][0] * r + sf[bj][0], h1 = acc[ai][bj][m][1] * r + sf[bj][1];
                    if ((M1_FP8 || M1L1_FP8) && h8) { int t0 = 0, t1 = 0; t0 = __builtin_amdgcn_cvt_pk_fp8_f32(h0[0], h0[1], t0, false); t0 = __builtin_amdgcn_cvt_pk_fp8_f32(h0[2], h0[3], t0, true);
                        t1 = __builtin_amdgcn_cvt_pk_fp8_f32(h1[0], h1[1], t1, false); t1 = __builtin_amdgcn_cvt_pk_fp8_f32(h1[2], h1[3], t1, true); u32x2 w; w.x = (unsigned)t0; w.y = (unsigned)t1;
                        *(u32x2*)((unsigned char*)H + (size_t)(row0 + ai * HALF + m * 16) * DM + col0 + bj * HALF) = w; }
                    else *(u32x4*)(hp + bj * HALF) = pack8(h0, h1); } }
    }
};
struct EpiGluRes {
    static constexpr bool FUSED = false;
    float* X; const float* gate;
    __device__ __forceinline__ void operator()(const Acc& acc, const Unit& u, int wr, int wc, int fr, int fq) const {
        const int row0 = u.pm * BM + wr * 64 + fr, col0 = u.pn * HALF + wc * 32 + 8 * fq; const int b = (u.pm * BM) / SEQ;
        f32x4 gv[2];
#pragma unroll
        for (int n = 0; n < 2; ++n) gv[n] = *(const f32x4*)(gate + (size_t)b * 6144 + col0 + 4 * n);
        f32x4 xv[2][4][2];
#pragma unroll
        for (int ai = 0; ai < 2; ++ai)
#pragma unroll
            for (int m = 0; m < 4; ++m)
#pragma unroll
                for (int n = 0; n < 2; ++n) xv[ai][m][n] = ldx16(X + (size_t)(row0 + ai * HALF + m * 16) * DM + col0 + 4 * n);
        asm volatile("" ::: "memory");
#pragma unroll
        for (int ai = 0; ai < 2; ++ai)
#pragma unroll
            for (int m = 0; m < 4; ++m) { float* rp = X + (size_t)(row0 + ai * HALF + m * 16) * DM + col0;
#pragma unroll
                for (int n = 0; n < 2; ++n) { f32x4 x = xv[ai][m][n]; const f32x4 l = acc[ai][0][m][n], gg = acc[ai][1][m][n];
#pragma unroll
                    for (int e = 0; e < 4; ++e) x[e] += gv[n][e] * l[e] * sigmoid_f(gg[e]);
                    *(f32x4*)(rp + 4 * n) = x; } }
    }
};
struct EpiAttnIn {
    static constexpr bool FUSED = false;
    bf16_t *Q, *Kn, *V, *QI, *KI; float* WI; const float *qg, *kg;
    __device__ __forceinline__ void operator()(const Acc& acc, const Unit& u, int wr, int wc, int fr, int fq) const {
        const int row0 = u.pm * BM + wr * 64 + fr;
        if (u.pn < 5) {
            const bool isq = u.pn < 4; const float* gp = isq ? qg : kg; const float sc = isq ? 0.125f : 1.0f;
            f32x4 gn[2][2];
#pragma unroll
            for (int bj = 0; bj < 2; ++bj)
#pragma unroll
                for (int n = 0; n < 2; ++n) gn[bj][n] = *(const f32x4*)(gp + 32 * bj + 8 * fq + 4 * n) * sc;
            bf16_t* base = isq ? (Q + (size_t)(4 * u.pn + wc) * 64) : (Kn + (size_t)wc * 64); const int ldo = isq ? 1024 : 256;
#pragma unroll
            for (int ai = 0; ai < 2; ++ai)
#pragma unroll
                for (int m = 0; m < 4; ++m) { float ss = 0.f;
#pragma unroll
                    for (int bj = 0; bj < 2; ++bj)
#pragma unroll
                        for (int n = 0; n < 2; ++n) { const f32x4 x = acc[ai][bj][m][n]; ss += (x[0] * x[0] + x[1] * x[1]) + (x[2] * x[2] + x[3] * x[3]); }
                    ss += __shfl_xor(ss, 16); ss += __shfl_xor(ss, 32);
                    const float r = 1.0f / sqrtf(ss * (1.0f / 64.0f) + EPS);
#pragma unroll
                    for (int bj = 0; bj < 2; ++bj) *(u32x4*)(base + (size_t)(row0 + ai * HALF + m * 16) * ldo + 32 * bj + 8 * fq) = pack8(acc[ai][bj][m][0] * r * gn[bj][0], acc[ai][bj][m][1] * r * gn[bj][1]); }
        } else if (u.pn < 8) {
            bf16_t* base = (u.pn == 5) ? V : QI + (size_t)(u.pn - 6) * 256; const int ldo = (u.pn == 5) ? 256 : 512; const int col0 = wc * 32 + 8 * fq;
#pragma unroll
            for (int ai = 0; ai < 2; ++ai)
#pragma unroll
                for (int m = 0; m < 4; ++m)
#pragma unroll
                    for (int bj = 0; bj < 2; ++bj) *(u32x4*)(base + (size_t)(row0 + ai * HALF + m * 16) * ldo + col0 + bj * HALF) = pack8(acc[ai][bj][m][0], acc[ai][bj][m][1]);
        } else {
            if (wc < 2) {
#pragma unroll
                for (int ai = 0; ai < 2; ++ai)
#pragma unroll
                    for (int m = 0; m < 4; ++m) *(u32x4*)(KI + (size_t)(row0 + ai * HALF + m * 16) * 64 + wc * 32 + 8 * fq) = pack8(acc[ai][0][m][0], acc[ai][0][m][1]);
            } else if (wc == 2 && fq == 0) {
                const float s = 0.04419417382415922f;
#pragma unroll
                for (int ai = 0; ai < 2; ++ai)
#pragma unroll
                    for (int m = 0; m < 4; ++m) { float* wp = WI + (size_t)(row0 + ai * HALF + m * 16) * 8; *(f32x4*)wp = acc[ai][0][m][0] * s; *(f32x4*)(wp + 4) = acc[ai][0][m][1] * s; }
            }
        }
    }
};
struct EpiMoeDn {
    static constexpr bool FUSED = false;
    bf16_t* Y; const float* gatep;
    __device__ __forceinline__ void operator()(const Acc& acc, const Unit& u, int wr, int wc, int fr, int fq) const {
        const int row0 = u.pm * BM + wr * 64 + fr, col0 = u.pn * BM + wc * 32 + 8 * fq;
#pragma unroll
        for (int ai = 0; ai < 2; ++ai)
#pragma unroll
            for (int m = 0; m < 4; ++m) { const float gt = gatep[u.aux + ai * HALF + wr * 64 + m * 16 + fr] * (M2_FP8 ? W8_INV : 1.0f);
#pragma unroll
                for (int bj = 0; bj < 2; ++bj) *(u32x4*)(Y + (size_t)(row0 + ai * HALF + m * 16) * DM + col0 + bj * HALF) = pack8(acc[ai][bj][m][0] * gt, acc[ai][bj][m][1] * gt); }
    }
};
}

constexpr size_t MiB = 1u << 20;
constexpr size_t WS_CTL = 0, CTL_ZERO_BYTES = 1 * MiB;
constexpr size_t WS_MOD = 1 * MiB;
constexpr size_t WS_ROWIDX = 2 * MiB;
constexpr size_t WS_GATEP = 2 * MiB + 512 * 1024;
constexpr size_t WS_SLOT = 3 * MiB;
static_assert(WS_ROWIDX_B == WS_ROWIDX && WS_GATEP_B == WS_GATEP && WS_SLOT_B == WS_SLOT, "metadata offsets");
constexpr size_t WS_WCI = 8 * MiB;
constexpr size_t WS_WCO = 20 * MiB;
constexpr size_t WS_WAI = 24 * MiB;
constexpr size_t WS_WAO = 29 * MiB;
constexpr size_t WS_WGL = 31 * MiB;
constexpr size_t WS_WFG = 35 * MiB;
constexpr size_t WS_WFD = 57 * MiB;
constexpr size_t WS_WMG = 68 * MiB;
constexpr size_t WS_WMD = 244 * MiB;
constexpr size_t WS_HB = 332 * MiB;
constexpr size_t WS_BUF = 364 * MiB;
constexpr size_t WS_ACT = 432 * MiB;
constexpr size_t WS_END = 619 * MiB;
constexpr int MOE_ROWS = 2 * M + NEXP * 256;
constexpr size_t WS_Q = WS_BUF, WS_K = WS_BUF + 32 * MiB, WS_V = WS_BUF + 40 * MiB, WS_QI = WS_BUF + 48 * MiB;
constexpr size_t WS_SC = WS_ACT, WS_O = WS_ACT + 128 * MiB, WS_KI = WS_ACT + 160 * MiB, WS_WI = WS_ACT + 162 * MiB;
static_assert(WS_WMD + (size_t)16 * 1024 * 2816 * 2 <= WS_HB && WS_ACT + (size_t)MOE_ROWS * FF * 2 <= WS_END && WS_BUF + (size_t)MOE_ROWS * DM * 2 <= WS_ACT, "d_ws map");
constexpr int CW_TMO = 0;
constexpr int CW_CNT = 64;
constexpr int CW_BAR = 4096;
constexpr int CW_PAN = 16384;
constexpr size_t WS_XS9 = 5 * MiB + 768 * 1024;
constexpr size_t WS_XS = 5 * MiB + 512 * 1024;

constexpr int RING_BYTES = 131072;
constexpr int LDSCTL_OFF = RING_BYTES, MISC_OFF = LDSCTL_OFF + 320;
constexpr int LDS_BYTES = 147456;

#define XB_TMO      128
#define XB_XCNT(j)  (256  + 64 * (j))
#define XB_XSUB(j)  (1280 + 64 * (j))
#define XB_XGEN(j)  (2304 + 64 * (j))
#define XB_TOP      3328
#define XB_TOPGEN   3392
#define XCD_BAR_WORDS 3456
#define XB_SPIN_CAP (1u << 18)
__device__ __forceinline__ unsigned xb_ld(unsigned* p)              { return __hip_atomic_load(p, __ATOMIC_RELAXED, __HIP_MEMORY_SCOPE_AGENT); }
__device__ __forceinline__ unsigned xb_add(unsigned* p, unsigned v) { return __hip_atomic_fetch_add(p, v, __ATOMIC_RELAXED, __HIP_MEMORY_SCOPE_AGENT); }
__device__ __forceinline__ unsigned xb_xcc_id() { return (unsigned)__builtin_amdgcn_s_getreg((3 << 11) | 20) & 0xFu; }
#define XB_SPIN(cond, bar) do { unsigned _sp = 0; while (cond) { __builtin_amdgcn_s_sleep(1); \
    if ((++_sp & 255u) == 0u) { if (xb_ld(&(bar)[XB_TMO])) break; if (_sp > XB_SPIN_CAP) { atomicAdd(&(bar)[XB_TMO], 1u); break; } } } } while (0)
struct XcdBarrier { unsigned* bar; unsigned x; volatile LAS unsigned* st; int w; };
__device__ __forceinline__ bool xb_thread0(int w) { return w == 0 && lane_id_fresh() == 0; }
__device__ __forceinline__ XcdBarrier xcd_barrier_post(unsigned* bar, volatile LAS unsigned* st, int w) {
    XcdBarrier b; b.bar = bar; b.x = xb_xcc_id(); b.st = st; b.w = w;
    if (xb_thread0(w)) (void)xb_add(&bar[XB_XCNT(b.x)], 1u);
    return b;
}
__device__ __forceinline__ void xcd_barrier_complete(unsigned* bar, unsigned x, unsigned& nloc, unsigned& nx) {
    const unsigned G = gridDim.x * gridDim.y * gridDim.z;
    unsigned sum, cnt, mine, sp = 0u;
    for (;;) {
        sum = 0u; cnt = 0u; mine = 0u;
#pragma unroll
        for (unsigned j = 0; j < 16; ++j) { const unsigned c = xb_ld(&bar[XB_XCNT(j)]); sum += c; cnt += (c > 0u) ? 1u : 0u; mine = (j == x) ? c : mine; }
        if (sum == G) break;
        __builtin_amdgcn_s_sleep(1);
        if ((++sp & 255u) == 0u) { if (xb_ld(&bar[XB_TMO])) break; if (sp > XB_SPIN_CAP) { atomicAdd(&bar[XB_TMO], 1u); break; } }
    }
    nloc = mine > 0u ? mine : 1u; nx = cnt > 0u ? cnt : 1u;
}
__device__ __forceinline__ int lane_probe() { return (int)__builtin_amdgcn_mbcnt_hi(~0u, __builtin_amdgcn_mbcnt_lo(~0u, 0u)); }
__device__ __forceinline__ int lane_probe2() { return (int)__builtin_amdgcn_mbcnt_hi(~0u, __builtin_amdgcn_mbcnt_lo(~0u, 0u)); }
__device__ __forceinline__ void xcd_barrier(const XcdBarrier& b) {
    asm volatile("s_waitcnt vmcnt(0)" ::: "memory");
    __syncthreads();
    if (xb_thread0(b.w)) {
        unsigned* bar = b.bar;
        __builtin_amdgcn_s_waitcnt(0);
        unsigned nloc = b.st[0], nx = b.st[1];
        if (nloc == 0u) { xcd_barrier_complete(bar, b.x, nloc, nx); b.st[0] = nloc; b.st[1] = nx; }
        const unsigned old = xb_add(&bar[XB_XSUB(b.x)], 1u);
        const unsigned gen = old / nloc;
        if (old + 1u == (gen + 1u) * nloc) {
            __builtin_amdgcn_fence(__ATOMIC_RELEASE, "agent");
            asm volatile("s_waitcnt vmcnt(0)" ::: "memory");
            const unsigned og = xb_add(&bar[XB_TOP], 1u);
            const unsigned tg = og / nx;
            if (og + 1u == (tg + 1u) * nx) xb_add(&bar[XB_TOPGEN], 1u);
            else XB_SPIN(xb_ld(&bar[XB_TOPGEN]) == tg, bar);
            __builtin_amdgcn_fence(__ATOMIC_ACQUIRE, "agent");
            xb_add(&bar[XB_XGEN(b.x)], 1u);
        } else {
            XB_SPIN(xb_ld(&bar[XB_XGEN(b.x)]) == gen, bar);
            __builtin_amdgcn_fence(__ATOMIC_ACQUIRE, "agent");
        }
    }
    __syncthreads();
}

struct Args { const float* in[28]; float* out; unsigned char* ws; int ph_lo, ph_hi; };
enum { I_X = 0, I_C, I_ADAW, I_ADAB, I_NORMG, I_CWIN, I_CW, I_CWOUT, I_AWIN, I_QG, I_KG, I_AWOUT, I_RELB, I_SLRE, I_SLIM, I_SLOG, I_SBRE, I_SBIM, I_SCRE, I_SCIM, I_SD, I_SGLU,
       I_FGU, I_FDN, I_RW, I_RB, I_MGU, I_MDN };
struct Frame {
    LAS unsigned char* lds; unsigned char* ws; gu32* ctl;
    int tid, lane, wave, vcu, G;
    float* out; const float* mod;
    bf16_t *HB, *BUF, *ACT;
};

enum { MAP_NAT = 0, MAP_PAIR = 1, MAP_CONV = 2, MAP_ATTN = 3 };
__device__ __forceinline__ int map_row(int map, int half, int n) {
    if (map == MAP_NAT) return n;
    if (map == MAP_PAIR) { return n < half ? 256 * (n / 128) + (n % 128) : 256 * ((n - half) / 128) + 128 + ((n - half) % 128); }
    if (map == MAP_CONV) { if (n < 1024) return 2048 + n; if (n < 2048) { const int q = n - 1024; return 256 * (q / 128) + (q % 128); } const int q = n - 2048; return 256 * (q / 128) + 128 + (q % 128); }
    if (n < 1280) { const int hd = n / 64, d = n % 64; return 256 * (hd / 4) + 128 * (d / 32) + 32 * (hd % 4) + (d % 32); }
    return n;
}
__device__ __forceinline__ void p0_transpose_item(const float* W, int K, int N, bf16_t* WT, int map, int half, LAS float* scr, int item, int lane) {
    const int nblk = (N + 31) / 32, kb = item / nblk, nb = item % nblk, k0 = 64 * kb, n0 = 32 * nb;
    const bool cin = (n0 + (lane & 31)) < N;
    float tv[32];
#pragma unroll
    for (int i = 0; i < 32; ++i) { const int kk = 2 * i + (lane >> 5); tv[i] = cin ? W[(size_t)(k0 + kk) * N + n0 + (lane & 31)] : 0.f; }
#pragma unroll
    for (int i = 0; i < 32; ++i) { const int kk = 2 * i + (lane >> 5); scr[kk * 33 + (lane & 31)] = tv[i]; }
    LDS_WAIT(); CFENCE();
    const int c = lane & 7; const int r0 = map_row(map, half, n0);
#pragma unroll
    for (int j = 0; j < 4; ++j) { const int n = (lane >> 3) + 8 * j; const LAS float* s = scr + (8 * c) * 33 + n;
        u32x4 o; o.x = pk2(s[0 * 33], s[1 * 33]); o.y = pk2(s[2 * 33], s[3 * 33]); o.z = pk2(s[4 * 33], s[5 * 33]); o.w = pk2(s[6 * 33], s[7 * 33]);
        *(GAS u32x4*)(WT + (size_t)(r0 + n) * K + k0 + 8 * c) = o; }
    LDS_WAIT(); CFENCE();
}
__device__ __forceinline__ void p0_transpose_item8(const float* W, int K, int N, unsigned char* WT, int map, int half, LAS float* scr, int item, int lane, int sub) {
    const int nblk = (N + 31) / 32, kb = 2 * (item / nblk) + sub, nb = item % nblk, k0 = 64 * kb, n0 = 32 * nb;
    float tv[32];
#pragma unroll
    for (int i = 0; i < 32; ++i) { const int kk = 2 * i + (lane >> 5); tv[i] = W[(size_t)(k0 + kk) * N + n0 + (lane & 31)]; }
#pragma unroll
    for (int i = 0; i < 32; ++i) { const int kk = 2 * i + (lane >> 5); scr[kk * 33 + (lane & 31)] = tv[i] * pg8::W8_MUL; }
    LDS_WAIT(); CFENCE();
    const int c = lane & 3; const int r0 = map_row(map, half, n0);
#pragma unroll
    for (int j = 0; j < 2; ++j) { const int n = (lane >> 2) + 16 * j; const LAS float* sp = scr + (16 * c) * 33 + n; u32x4 o;
#pragma unroll
        for (int q = 0; q < 4; ++q) { int t = 0; t = __builtin_amdgcn_cvt_pk_fp8_f32(sp[(4 * q) * 33], sp[(4 * q + 1) * 33], t, false); t = __builtin_amdgcn_cvt_pk_fp8_f32(sp[(4 * q + 2) * 33], sp[(4 * q + 3) * 33], t, true); o[q] = (unsigned)t; }
        *(GAS u32x4*)(WT + (size_t)(r0 + n) * K + k0 + 16 * c) = o; }
    LDS_WAIT(); CFENCE();
}
__device__ __forceinline__ void p0_transpose_item8x2(const float* W, int K, int N, unsigned char* WT, int map, int half, LAS float* scr, int item, int lane) {
    const int nblk = (N + 31) / 32, kb2 = item / nblk, nb = item % nblk, k0 = 128 * kb2, n0 = 32 * nb;
    float ta[32], tb[32];
#pragma unroll
    for (int i = 0; i < 32; ++i) { const int kk = 2 * i + (lane >> 5); ta[i] = W[(size_t)(k0 + kk) * N + n0 + (lane & 31)]; }
#pragma unroll
    for (int i = 0; i < 32; ++i) { const int kk = 2 * i + (lane >> 5); tb[i] = W[(size_t)(k0 + 64 + kk) * N + n0 + (lane & 31)]; }
    const int c = lane & 7; const int r0 = map_row(map, half, n0);
    u32x4 o8[4];
#pragma unroll
    for (int h = 0; h < 2; ++h) {
#pragma unroll
        for (int i = 0; i < 32; ++i) { const int kk = 2 * i + (lane >> 5); scr[kk * 33 + (lane & 31)] = (h ? tb[i] : ta[i]) * pg8::W8_MUL; }
        LDS_WAIT(); CFENCE();
#pragma unroll
        for (int j = 0; j < 4; ++j) { const int n = (lane >> 3) + 8 * j; const LAS float* sp = scr + (16 * (c & 3)) * 33 + n; u32x4 o;
#pragma unroll
            for (int q = 0; q < 4; ++q) { int t = 0; t = __builtin_amdgcn_cvt_pk_fp8_f32(sp[(4 * q) * 33], sp[(4 * q + 1) * 33], t, false); t = __builtin_amdgcn_cvt_pk_fp8_f32(sp[(4 * q + 2) * 33], sp[(4 * q + 3) * 33], t, true); o[q] = (unsigned)t; }
            if ((c >> 2) == h) o8[j] = o; }
        LDS_WAIT(); CFENCE();
    }
#pragma unroll
    for (int j = 0; j < 4; ++j) { const int n = (lane >> 3) + 8 * j; *(GAS u32x4*)(WT + (size_t)(r0 + n) * K + k0 + 16 * c) = o8[j]; }
}
__device__ __forceinline__ void p0_prologue(Frame& F, const Args& A) {
    {
        LAS float* cs = (LAS float*)F.lds;
        LAS float* red = (LAS float*)(F.lds + 16384);
        for (int i = F.tid; i < NB * DM; i += NTHREADS) { const float c = A.in[I_C][i]; cs[i] = c / (1.f + __expf(-c)); }
        __syncthreads();
        const int kg = F.tid >> 6, cj = F.tid & 63;
        for (int un = blockIdx.x; un < 4 * 96; un += F.G) {
            const int l = un / 96, jb = un % 96, j = jb * 64 + cj;
            const float* w = A.in[I_ADAW] + (size_t)l * DM * 6144 + j;
            float a0 = 0.f, a1 = 0.f, a2 = 0.f, a3 = 0.f;
            for (int k0 = kg * 128; k0 < kg * 128 + 128; k0 += 32) { float wv[32];
#pragma unroll
                for (int i = 0; i < 32; ++i) wv[i] = w[(size_t)(k0 + i) * 6144];
#pragma unroll
                for (int i = 0; i < 32; ++i) { const int k = k0 + i; a0 += cs[k] * wv[i]; a1 += cs[1024 + k] * wv[i]; a2 += cs[2048 + k] * wv[i]; a3 += cs[3072 + k] * wv[i]; } }
            *(LAS f32x4*)(red + (kg * 64 + cj) * 4) = (f32x4){a0, a1, a2, a3};
            __syncthreads();
            if (F.tid < 256) { const int b = F.tid >> 6, cc = F.tid & 63; float s = 0.f;
#pragma unroll
                for (int q = 0; q < 8; ++q) s += red[(q * 64 + cc) * 4 + b];
                ((float*)(F.ws + WS_MOD))[((size_t)l * NB + b) * 6144 + jb * 64 + cc] = s + A.in[I_ADAB][l * 6144 + jb * 64 + cc]; }
            __syncthreads();
        }
    }
    LAS float* scr = (LAS float*)(F.lds + 32768 + F.wave * 8704);
    const int gw = F.vcu * NWAVES + F.wave, NGW = F.G * NWAVES;
    constexpr int I_CI = (DM / 64) * (3072 / 32), I_SQ = (DM / 64) * (DM / 32), I_AI = (DM / 64) * ((ATT_N + 31) / 32), I_GL = (DM / 64) * (2048 / 32), I_GU = (DM / 64) * (2 * FF / 32), I_DN = (FF / 128) * (DM / 32), I_DNB = (FF / 64) * (DM / 32), I_GU8 = (DM / 128) * (2 * FF / 32);
    constexpr int NITEMS = 2 * I_CI + 2 * I_SQ + I_AI + I_SQ + I_GL + (F1L0_FP8 ? I_GU8 : I_GU) + I_GU + (F2_FP8 ? 2 * I_DN : ((F2L0_FP8 ? I_DN : I_DNB) + I_DNB)) + 8 * (M1L1_FP8 ? I_GU8 : I_GU) + 8 * (M1_FP8 ? I_GU8 : I_GU) + 16 * (M2_FP8 ? I_DN : I_DNB);
    for (int it = gw; it < NITEMS; it += NGW) {
        int r = it;
        if (r < 2 * I_CI) { const int q = r / I_CI; p0_transpose_item(A.in[I_CWIN] + (size_t)q * DM * 3072, DM, 3072, (bf16_t*)(F.ws + WS_WCI) + (size_t)q * 3072 * DM, MAP_CONV, 0, scr, r % I_CI, F.lane); continue; } r -= 2 * I_CI;
        if (r < 2 * I_SQ) { const int q = r / I_SQ; p0_transpose_item(A.in[I_CWOUT] + (size_t)q * DM * DM, DM, DM, (bf16_t*)(F.ws + WS_WCO) + (size_t)q * DM * DM, MAP_NAT, 0, scr, r % I_SQ, F.lane); continue; } r -= 2 * I_SQ;
        if (r < I_AI) { p0_transpose_item(A.in[I_AWIN], DM, ATT_N, (bf16_t*)(F.ws + WS_WAI), MAP_ATTN, 0, scr, r, F.lane); continue; } r -= I_AI;
        if (r < I_SQ) { p0_transpose_item(A.in[I_AWOUT], DM, DM, (bf16_t*)(F.ws + WS_WAO), MAP_NAT, 0, scr, r, F.lane); continue; } r -= I_SQ;
        if (r < I_GL) { p0_transpose_item(A.in[I_SGLU], DM, 2048, (bf16_t*)(F.ws + WS_WGL), MAP_PAIR, 1024, scr, r, F.lane); continue; } r -= I_GL;
        if (F1L0_FP8) { if (r < I_GU8) { p0_transpose_item8x2(A.in[I_FGU], DM, 2 * FF, (unsigned char*)(F.ws + WS_WFG), MAP_PAIR, FF, scr, r, F.lane); continue; } r -= I_GU8; }
        else { if (r < I_GU) { p0_transpose_item(A.in[I_FGU], DM, 2 * FF, (bf16_t*)(F.ws + WS_WFG), MAP_PAIR, FF, scr, r, F.lane); continue; } r -= I_GU; }
        if (r < I_GU) { p0_transpose_item(A.in[I_FGU] + (size_t)DM * 2 * FF, DM, 2 * FF, (bf16_t*)(F.ws + WS_WFG) + (size_t)2 * FF * DM, MAP_PAIR, FF, scr, r, F.lane); continue; } r -= I_GU;
        if (F2_FP8) { if (r < 2 * I_DN) { const int q = r / I_DN; p0_transpose_item8x2(A.in[I_FDN] + (size_t)q * FF * DM, FF, DM, (unsigned char*)(F.ws + WS_WFD) + (size_t)q * DM * FF, MAP_NAT, 0, scr, r % I_DN, F.lane); continue; } r -= 2 * I_DN; }
        else if (F2L0_FP8) {
            if (r < I_DN) { p0_transpose_item8x2(A.in[I_FDN], FF, DM, (unsigned char*)(F.ws + WS_WFD), MAP_NAT, 0, scr, r, F.lane); continue; } r -= I_DN;
            if (r < I_DNB) { p0_transpose_item(A.in[I_FDN] + (size_t)FF * DM, FF, DM, (bf16_t*)(F.ws + WS_WFD) + (size_t)DM * FF, MAP_NAT, 0, scr, r, F.lane); continue; } r -= I_DNB; }
        else { if (r < 2 * I_DNB) { const int q = r / I_DNB; p0_transpose_item(A.in[I_FDN] + (size_t)q * FF * DM, FF, DM, (bf16_t*)(F.ws + WS_WFD) + (size_t)q * DM * FF, MAP_NAT, 0, scr, r % I_DNB, F.lane); continue; } r -= 2 * I_DNB; }
        if (M1L1_FP8) { if (r < 8 * I_GU8) { const int q = r / I_GU8; unsigned char* dst = (unsigned char*)(F.ws + WS_WMG) + (size_t)q * 2 * FF * DM;
                p0_transpose_item8x2(A.in[I_MGU] + (size_t)q * DM * 2 * FF, DM, 2 * FF, dst, MAP_PAIR, FF, scr, r % I_GU8, F.lane); continue; } r -= 8 * I_GU8; }
        else { if (r < 8 * I_GU) { const int q = r / I_GU; p0_transpose_item(A.in[I_MGU] + (size_t)q * DM * 2 * FF, DM, 2 * FF, (bf16_t*)(F.ws + WS_WMG) + (size_t)q * 2 * FF * DM, MAP_PAIR, FF, scr, r % I_GU, F.lane); continue; } r -= 8 * I_GU; }
        if (M1_FP8) { if (r < 8 * I_GU8) { const int q = 8 + r / I_GU8; unsigned char* dst = (unsigned char*)(F.ws + WS_WMG) + (size_t)8 * 2 * FF * DM * 2 + (size_t)(q - 8) * 2 * FF * DM;
                p0_transpose_item8x2(A.in[I_MGU] + (size_t)q * DM * 2 * FF, DM, 2 * FF, dst, MAP_PAIR, FF, scr, r % I_GU8, F.lane); continue; } r -= 8 * I_GU8; }
        else { if (r < 8 * I_GU) { const int q = 8 + r / I_GU; p0_transpose_item(A.in[I_MGU] + (size_t)q * DM * 2 * FF, DM, 2 * FF, (bf16_t*)(F.ws + WS_WMG) + (size_t)q * 2 * FF * DM, MAP_PAIR, FF, scr, r % I_GU, F.lane); continue; } r -= 8 * I_GU; }
        if (M2_FP8) { const int q = r / I_DN; p0_transpose_item8x2(A.in[I_MDN] + (size_t)q * FF * DM, FF, DM, (unsigned char*)(F.ws + WS_WMD) + (size_t)q * DM * FF, MAP_NAT, 0, scr, r % I_DN, F.lane); }
        else { const int q = r / I_DNB; p0_transpose_item(A.in[I_MDN] + (size_t)q * FF * DM, FF, DM, (bf16_t*)(F.ws + WS_WMD) + (size_t)q * DM * FF, MAP_NAT, 0, scr, r % I_DNB, F.lane); }
    }
    { u32x4* z = (u32x4*)((bf16_t*)(F.ws + WS_WAI) + (size_t)2144 * DM); const int n16 = (ATT_NP - 2144) * DM * 2 / 16;
      for (int i = blockIdx.x * NTHREADS + F.tid; i < n16; i += F.G * NTHREADS) z[i] = (u32x4){0u, 0u, 0u, 0u}; }
}

template <int FLAGS>
__device__ __forceinline__ void thin_phase(Frame& F, const Args& A, const float* src, int nl  , int ns  , int cl  , int rl  , int cs = -1  , size_t roff = 0  ) {
    if (cs < 0) cs = rl;
    const int gw = F.vcu * NWAVES + F.wave, NGW = F.G * NWAVES;
    LAS float* rwt = (LAS float*)F.lds;
    if (FLAGS & 8) {
        const float* rw = A.in[I_RW] + (size_t)rl * DM * NEXP;
        for (int i = F.tid; i < DM * NEXP; i += NTHREADS) rwt[(i & 7) * DM + (i >> 3)] = rw[i];
        __syncthreads();
    }
    int Tb[8];
    if (FLAGS & 2) { int acc = 0;
#pragma unroll
        for (int e = 0; e < 8; ++e) { Tb[e] = acc; acc += (int)((__hip_atomic_load(F.ctl + CW_CNT + 64 * (8 * rl + e), RLX_AGENT) + 255u) >> 8); } }
    const float* ng = A.in[I_NORMG] + (size_t)(nl * 2 + ns) * DM;
    constexpr bool RT = (FLAGS & 8) != 0;
    LAS int* rE = (LAS int*)(F.lds + 32768);
    const int nit = RT ? ((M / 64 - (int)blockIdx.x + F.G - 1) / F.G) * 8 : (M - gw + NGW - 1) / NGW;
    unsigned long long slot_nx = 0ull;
    if ((FLAGS & 2) && !RT && nit > 0) slot_nx = *((const unsigned long long*)(F.ws + roff + WS_SLOT) + gw);
    for (int it = 0; it < nit; ++it) {
        const int chunk = (int)blockIdx.x + (it >> 3) * F.G;
        const int row = RT ? chunk * 64 + F.wave * 8 + (it & 7) : gw + it * NGW;
        const int b = row / SEQ;
        f32x4 v[4];
        const f32x4* xr = (const f32x4*)(src + (size_t)row * DM) + F.lane;
#pragma unroll
        for (int j = 0; j < 4; ++j) v[j] = xr[64 * j];
        if (FLAGS & 2) {
            const unsigned long long slot_cur = slot_nx;
            if (it + 1 < nit) slot_nx = *((const unsigned long long*)(F.ws + roff + WS_SLOT) + (gw + (it + 1) * NGW));
            const int s0 = (int)(unsigned)slot_cur, s1 = (int)(unsigned)(slot_cur >> 32);
            int t0 = 0, t1 = 0;
#pragma unroll
            for (int e = 0; e < 8; ++e) { if ((s0 >> 16) == e) t0 = Tb[e]; if ((s1 >> 16) == e) t1 = Tb[e]; }
            const bf16_t* y0 = (const bf16_t*)(F.ws + WS_BUF) + (size_t)(256 * t0 + (s0 & 0xffff)) * DM;
            const bf16_t* y1 = (const bf16_t*)(F.ws + WS_BUF) + (size_t)(256 * t1 + (s1 & 0xffff)) * DM;
            const float* g2 = cl >= 0 ? F.mod + ((size_t)cl * NB + b) * 6144 + 5 * DM : (const float*)(F.ws + 512 * 1024);
#pragma unroll
            for (int j = 0; j < 4; ++j) { const int col = 4 * F.lane + 256 * j; const u32x2 a = *(const u32x2*)(y0 + col), c = *(const u32x2*)(y1 + col); const f32x4 g = *(const f32x4*)(g2 + col);
                v[j][0] += g[0] * (bflo(a.x) + bflo(c.x)); v[j][1] += g[1] * (bfhi(a.x) + bfhi(c.x)); v[j][2] += g[2] * (bflo(a.y) + bflo(c.y)); v[j][3] += g[3] * (bfhi(a.y) + bfhi(c.y)); }
        }
        if (FLAGS & 3) { GAS f32x4* xo = (GAS f32x4*)(F.out + (size_t)row * DM) + F.lane;
#pragma unroll
            for (int j = 0; j < 4; ++j) xo[64 * j] = v[j]; }
        if (FLAGS & 4) {
            float ss = 0.f;
#pragma unroll
            for (int j = 0; j < 4; ++j) ss += (v[j][0] * v[j][0] + v[j][1] * v[j][1]) + (v[j][2] * v[j][2] + v[j][3] * v[j][3]);
            const float r = 1.0f / sqrtf(wave_sum(ss) * (1.0f / DM) + EPS);
            const float* sh = F.mod + ((size_t)nl * NB + b) * 6144 + (ns ? 3 : 0) * DM; const float* sc = sh + DM;
            GAS u32x2* ho = (GAS u32x2*)(F.HB + (size_t)row * DM) + F.lane;
#pragma unroll
            for (int j = 0; j < 4; ++j) { const int col = 4 * F.lane + 256 * j; const f32x4 g = *(const f32x4*)(ng + col), s1 = *(const f32x4*)(sc + col), s0 = *(const f32x4*)(sh + col);
                v[j] = (v[j] * r) * g * (s1 + 1.0f) + s0;
                if ((RT && ((M1_FP8 && nl == 3) || (M1L1_FP8 && nl == 1))) || (FLAGS == 4 && F1L0_FP8 && nl == 0 && ns == 1)) { int t = 0; t = __builtin_amdgcn_cvt_pk_fp8_f32(v[j][0], v[j][1], t, false); t = __builtin_amdgcn_cvt_pk_fp8_f32(v[j][2], v[j][3], t, true);
                    *(unsigned*)((unsigned char*)F.HB + (size_t)row * DM + col) = (unsigned)t; }
                else { u32x2 w; w.x = pk2(v[j][0], v[j][1]); w.y = pk2(v[j][2], v[j][3]); ho[64 * j] = w; } }
            if (FLAGS & 8) {
                float lg[8];
#pragma unroll
                for (int e = 0; e < 8; ++e) { float s = 0.f;
#pragma unroll
                    for (int j = 0; j < 4; ++j) { const f32x4 w = *(const LAS f32x4*)(rwt + e * DM + 4 * F.lane + 256 * j); s += (v[j][0] * w[0] + v[j][1] * w[1]) + (v[j][2] * w[2] + v[j][3] * w[3]); }
                    lg[e] = wave_sum(s) + A.in[I_RB][rl * NEXP + e]; }
                int e0 = 0; float l0 = lg[0];
#pragma unroll
                for (int e = 1; e < 8; ++e) if (lg[e] > l0) { l0 = lg[e]; e0 = e; }
                int e1 = -1; float l1 = -3.0e38f;
#pragma unroll
                for (int e = 0; e < 8; ++e) if (e != e0 && lg[e] > l1) { l1 = lg[e]; e1 = e; }
                const float g0 = 1.0f / (1.0f + __expf(l1 - l0)), g1 = 1.0f - g0;
                const int lr = F.wave * 8 + (it & 7);
                if (F.lane == 0) { rE[lr] = e0; rE[64 + lr] = e1; rE[128 + lr] = __float_as_int(g0); rE[192 + lr] = __float_as_int(g1); }
            }
        }
        if (RT && (it & 7) == 7) {
            __syncthreads();
            if (F.tid < 8) { int cnt = 0; for (int q = 0; q < 64; ++q) cnt += (rE[q] == F.tid) + (rE[64 + q] == F.tid);
                rE[256 + F.tid] = cnt ? (int)__hip_atomic_fetch_add(F.ctl + CW_CNT + 64 * (8 * cs + F.tid), (unsigned)cnt, RLX_AGENT) : 0; }
            __syncthreads();
            if (F.tid < 64) { const int e0 = rE[F.tid], e1 = rE[64 + F.tid]; int r0 = 0, r1 = 0;
                for (int q = 0; q < F.tid; ++q) { r0 += (rE[q] == e0) + (rE[64 + q] == e0); r1 += (rE[q] == e1) + (rE[64 + q] == e1); }
                const int p0 = rE[256 + e0] + r0, p1 = rE[256 + e1] + r1, grow = chunk * 64 + F.tid;
                gu32* ri = (gu32*)(F.ws + roff + WS_ROWIDX); gu32* gp = (gu32*)(F.ws + roff + WS_GATEP); gu32* sl = (gu32*)(F.ws + roff + WS_SLOT);
                __hip_atomic_store(ri + e0 * 16384 + p0, (unsigned)grow, RLX_AGENT); __hip_atomic_store(ri + e1 * 16384 + p1, (unsigned)grow, RLX_AGENT);
                __hip_atomic_store(gp + e0 * 16384 + p0, (unsigned)rE[128 + F.tid], RLX_AGENT); __hip_atomic_store(gp + e1 * 16384 + p1, (unsigned)rE[192 + F.tid], RLX_AGENT);
                __hip_atomic_store(sl + grow * 2, (unsigned)((e0 << 16) | p0), RLX_AGENT); __hip_atomic_store(sl + grow * 2 + 1, (unsigned)((e1 << 16) | p1), RLX_AGENT); }
            __syncthreads();
        }
    }
}

__device__ __forceinline__ void unpack8(const u32x4 w, float (&f)[8]) { f[0] = bflo(w.x); f[1] = bfhi(w.x); f[2] = bflo(w.y); f[3] = bfhi(w.y); f[4] = bflo(w.z); f[5] = bfhi(w.z); f[6] = bflo(w.w); f[7] = bfhi(w.w); }
__device__ __forceinline__ void conv_phase(Frame& F, const float* cw  ) {
    const int gw = F.vcu * NWAVES + F.wave, NGW = F.G * NWAVES;
    const bf16_t* UB = F.BUF;
    for (int task = gw; task < M / 8; task += NGW) {
        const int r0 = task * 8; const bool first = (r0 % SEQ) == 0;
#pragma unroll
        for (int j = 0; j < 2; ++j) {
            const int ch = 8 * F.lane + 512 * j;
            float w0[8], w1[8], w2[8];
#pragma unroll
            for (int e = 0; e < 8; ++e) { w0[e] = cw[ch + e]; w1[e] = cw[DM + ch + e]; w2[e] = cw[2 * DM + ch + e]; }
            float um2[8], um1[8];
            if (first) {
#pragma unroll
                for (int e = 0; e < 8; ++e) { um2[e] = 0.f; um1[e] = 0.f; }
            } else { unpack8(*(const u32x4*)(UB + (size_t)(r0 - 2) * 2048 + ch), um2); unpack8(*(const u32x4*)(UB + (size_t)(r0 - 1) * 2048 + ch), um1); }
#pragma unroll
            for (int i = 0; i < 8; ++i) {
                float u0[8], bb[8]; unpack8(*(const u32x4*)(UB + (size_t)(r0 + i) * 2048 + ch), u0); unpack8(*(const u32x4*)(UB + (size_t)(r0 + i) * 2048 + 1024 + ch), bb);
                float z[8];
#pragma unroll
                for (int e = 0; e < 8; ++e) z[e] = bb[e] * (w0[e] * um2[e] + w1[e] * um1[e] + w2[e] * u0[e]);
                u32x4 o; o.x = pk2(z[0], z[1]); o.y = pk2(z[2], z[3]); o.z = pk2(z[4], z[5]); o.w = pk2(z[6], z[7]);
                *(u32x4*)(F.HB + (size_t)(r0 + i) * DM + ch) = o;
#pragma unroll
                for (int e = 0; e < 8; ++e) { um2[e] = um1[e]; um1[e] = u0[e]; }
            }
        }
    }
}

constexpr int QIP = 1040;
constexpr int AL_QI = 0, AL_WI = 33280, AL_SEL = 34304, AL_V = 42496, AL_BIASD = 108032, AL_SUM = 116288, AL_END = 116800;
typedef short v4i16_t __attribute__((ext_vector_type(4)));
__device__ __forceinline__ unsigned okey(float f) { const unsigned u = __float_as_uint(f); return u ^ ((u >> 31) ? 0xFFFFFFFFu : 0x80000000u); }
__device__ __forceinline__ void attn_phase(Frame& F, const Args& A) {
    LAS unsigned char* L = F.lds;
    const bf16_t* Qb = (const bf16_t*)(F.ws + WS_Q); const bf16_t* Kb = (const bf16_t*)(F.ws + WS_K); const bf16_t* Vb = (const bf16_t*)(F.ws + WS_V);
    const bf16_t* QIb = (const bf16_t*)(F.ws + WS_QI); const bf16_t* KIb = (const bf16_t*)(F.ws + WS_KI); const float* WIb = (const float*)(F.ws + WS_WI);
    bf16_t* Ob = (bf16_t*)(F.ws + WS_O);
    float* SC = (float*)(F.ws + WS_SC) + (size_t)blockIdx.x * 32 * SEQ;
    const int lane = F.lane, wave = F.wave;
    { LAS float* bd = (LAS float*)(L + AL_BIASD);
      for (int i = F.tid; i < 129 * 16; i += NTHREADS) { const int d = i >> 4; int bkt; if (d < 16) bkt = d; else { const float dd = (float)d; const int lg2 = 16 + (int)(logf(dd / 16.0f) / 2.0794415416798357f * 16.0f); bkt = lg2 < 31 ? lg2 : 31; }
          bd[i] = A.in[I_RELB][bkt * 16 + (i & 15)]; }
    }
    __syncthreads();
    for (int pass = 0; pass < 2; ++pass) {
        const int un = pass == 0 ? (int)blockIdx.x : 511 - (int)blockIdx.x;
        for (int uu = un; uu >= 0 && uu < 512; uu += (pass == 0 ? F.G * 2 : -F.G * 2)) {
        if ((pass == 0 && uu >= 256) || (pass == 1 && uu < 256)) break;
        const int b = uu & 3, qb = uu >> 2, t0 = qb * 32; const size_t rb = (size_t)b * SEQ;
        for (int i = F.tid; i < 32 * 64; i += NTHREADS) { const int q = i >> 6, c = i & 63; *(LAS u32x4*)(L + AL_QI + q * QIP + c * 16) = *(const u32x4*)(QIb + (rb + t0 + q) * 512 + c * 8); }
        if (F.tid < 256) ((LAS float*)(L + AL_WI))[F.tid] = WIb[(rb + t0) * 8 + F.tid];
        __syncthreads();
        {
            for (int kt = wave; kt <= qb; kt += NWAVES) {
                int ln1 = lane; asm volatile("" : "+v"(ln1));
                const int r = ln1 & 31, hh = ln1 >> 5;
                float wi[8];
#pragma unroll
                for (int h = 0; h < 8; ++h) wi[h] = ((LAS float*)(L + AL_WI))[r * 8 + h];
                bf16x8 ka[4];
#pragma unroll
                for (int ks = 0; ks < 4; ++ks) ka[ks] = *(const bf16x8*)(KIb + (rb + kt * 32 + r) * 64 + 16 * ks + 8 * hh);
                f32x16 sc;
#pragma unroll
                for (int i = 0; i < 16; ++i) sc[i] = 0.f;
#pragma unroll
                for (int h = 0; h < 8; ++h) {
                    f32x16 d;
#pragma unroll
                    for (int i = 0; i < 16; ++i) d[i] = 0.f;
#pragma unroll
                    for (int ks = 0; ks < 4; ++ks) { const bf16x8 qf = *(const LAS bf16x8*)(L + AL_QI + r * QIP + (h * 64 + 16 * ks + 8 * hh) * 2); d = __builtin_amdgcn_mfma_f32_32x32x16_bf16(ka[ks], qf, d, 0, 0, 0); }
#pragma unroll
                    for (int i = 0; i < 16; ++i) sc[i] += wi[h] * fmaxf(d[i], 0.f);
                }
#pragma unroll
                for (int a = 0; a < 4; ++a) { f32x4 o;
#pragma unroll
                    for (int e = 0; e < 4; ++e) { const int krow = 8 * a + 4 * hh + e; o[e] = (kt == qb && krow > r) ? -INFINITY : sc[4 * a + e]; }
                    *(f32x4*)(SC + (size_t)r * SEQ + kt * 32 + 8 * a + 4 * hh) = o; }
            }
        }
        VM_WAIT(); __syncthreads();
        for (int qq = 0; qq < 4; ++qq) {
            const int c = wave + 8 * qq, t = t0 + c; const int nvalid = t + 1;
            int lane = F.lane; asm volatile("" : "+v"(lane));
            LAS int* sel = (LAS int*)(L + AL_SEL) + wave * 256;
            int count;
            if (nvalid <= TOPK) {
                count = nvalid;
#pragma unroll
                for (int j = 0; j < 4; ++j) { const int idx = 64 * j + lane; sel[idx] = idx < nvalid ? idx : 0; }
            } else {
                count = TOPK;
                const int nj = (nvalid + 63) >> 6;
                unsigned key[64];
                const float* srow = SC + (size_t)c * SEQ;
#define SEL_GROUPS(BODY) do { BODY(0) if (nj > 16) { BODY(1) if (nj > 32) { BODY(2) if (nj > 48) { BODY(3) } } } } while (0)
#define SEL_LOAD(g) { _Pragma("unroll") for (int j = 16 * (g); j < 16 * (g) + 16; ++j) { const int idx = 64 * j + lane; const float sv = __uint_as_float(__hip_atomic_load((const gu32*)(srow + idx), RLX_AGENT)); key[j] = idx <= t ? okey(sv) : 0u;     } }
#pragma unroll
                for (int j = 0; j < 64; ++j) key[j] = 0u;
                SEL_GROUPS(SEL_LOAD);
                unsigned T = 0u;
                for (int bit = 31; bit >= 0; --bit) {
                    const unsigned cand = T | (1u << bit); int cnt = 0;
#define SEL_CNT(g) { _Pragma("unroll") for (int j = 16 * (g); j < 16 * (g) + 16; ++j) cnt += __popcll(__ballot(key[j] >= cand)); }
                    SEL_GROUPS(SEL_CNT);
                    if (cnt >= TOPK) T = cand;
                    if (cnt == TOPK) break;
                }
                int base = 0;
#define SEL_GT(g) { _Pragma("unroll") for (int j = 16 * (g); j < 16 * (g) + 16; ++j) { const bool gt = key[j] > T; const unsigned long long mk = __ballot(gt); \
                    const int pos = base + (int)__builtin_amdgcn_mbcnt_hi((unsigned)(mk >> 32), __builtin_amdgcn_mbcnt_lo((unsigned)mk, 0u)); if (gt) sel[pos] = 64 * j + lane; base += __popcll(mk); } }
                SEL_GROUPS(SEL_GT);
                const int need = TOPK - base; int eb = 0;
#define SEL_EQ(g) { _Pragma("unroll") for (int j = 16 * (g); j < 16 * (g) + 16; ++j) { const bool eq = key[j] == T; const unsigned long long mk = __ballot(eq); \
                    const int rank = eb + (int)__builtin_amdgcn_mbcnt_hi((unsigned)(mk >> 32), __builtin_amdgcn_mbcnt_lo((unsigned)mk, 0u)); if (eq && rank < need) sel[base + rank] = 64 * j + lane; eb += __popcll(mk); } }
                SEL_GROUPS(SEL_EQ);
#undef SEL_GROUPS
#undef SEL_LOAD
#undef SEL_CNT
#undef SEL_GT
#undef SEL_EQ
            }
            LDS_WAIT(); CFENCE();
            asm volatile("" : "+v"(lane));
            const int hd = lane & 15, kq = lane >> 4;
            bf16x8 bq[8];
            { bf16x8 qf[2];
#pragma unroll
              for (int s2 = 0; s2 < 2; ++s2) qf[s2] = *(const bf16x8*)(Qb + (rb + t) * 1024 + hd * 64 + 32 * s2 + 8 * kq);
              const bf16x8 zf = (bf16x8){0, 0, 0, 0, 0, 0, 0, 0};
#pragma unroll
              for (int ks = 0; ks < 8; ++ks) bq[ks] = ((ks >> 1) == (hd >> 2)) ? qf[ks & 1] : zf; }
            f32x4 lg[16];
            float mx = -INFINITY;
            bf16x8 kf[3][8];
#pragma unroll
            for (int pre = 0; pre < 2; ++pre) { const int krow = sel[16 * pre + hd]; const bf16_t* kp = Kb + (rb + krow) * 256 + 8 * kq;
#pragma unroll
              for (int ks = 0; ks < 8; ++ks) kf[pre][ks] = *(const bf16x8*)(kp + 32 * ks); }
            const LAS float* biasd = (const LAS float*)(L + AL_BIASD);
#pragma unroll
            for (int kt = 0; kt < 16; ++kt) {
                if (kt < 14) { const int krow = sel[16 * (kt + 2) + hd]; const bf16_t* kp = Kb + (rb + krow) * 256 + 8 * kq;
#pragma unroll
                    for (int ks = 0; ks < 8; ++ks) kf[(kt + 2) % 3][ks] = *(const bf16x8*)(kp + 32 * ks); }
                f32x4 d = (f32x4){0.f, 0.f, 0.f, 0.f};
#pragma unroll
                for (int ks = 0; ks < 8; ++ks) d = __builtin_amdgcn_mfma_f32_16x16x32_bf16(kf[kt % 3][ks], bq[ks], d, 0, 0, 0);
                const u32x4 ks4 = *(const LAS u32x4*)(sel + 16 * kt + 4 * kq);
#pragma unroll
                for (int i = 0; i < 4; ++i) { const int pos = 16 * kt + 4 * kq + i; int dist = t - (int)ks4[i]; dist = dist < 0 ? 0 : (dist > 128 ? 128 : dist);
                    const float bs = biasd[dist * 16 + hd];
                    d[i] = pos < count ? d[i] + bs : -INFINITY; mx = fmaxf(mx, d[i]); }
                lg[kt] = d;
            }
            mx = fmaxf(mx, __shfl_xor(mx, 16)); mx = fmaxf(mx, __shfl_xor(mx, 32));
            float sum = 0.f;
            bf16x8 pa[8];
#pragma unroll
            for (int ks = 0; ks < 8; ++ks) { float p[8];
#pragma unroll
                for (int i = 0; i < 4; ++i) { p[i] = __expf(lg[2 * ks][i] - mx); p[4 + i] = __expf(lg[2 * ks + 1][i] - mx); }
                sum += ((p[0] + p[1]) + (p[2] + p[3])) + ((p[4] + p[5]) + (p[6] + p[7]));
                u32x4 w; w.x = cvt_pk_bf16(p[0], p[1]); w.y = cvt_pk_bf16(p[2], p[3]); w.z = cvt_pk_bf16(p[4], p[5]); w.w = cvt_pk_bf16(p[6], p[7]);
                pa[ks] = __builtin_bit_cast(bf16x8, w); }
            sum += __shfl_xor(sum, 16); sum += __shfl_xor(sum, 32);
            if (kq == 0) ((LAS float*)(L + AL_SUM))[wave * 16 + hd] = sum;
            LDS_WAIT(); CFENCE();
            {
                asm volatile("" : "+v"(lane));
                const int rs = lane >> 3, ch = lane & 7, i16 = lane & 15, tq = i16 >> 2, tp = i16 & 3, kq2 = lane >> 4;
                LAS unsigned char* vb = L + AL_V + wave * 8192;
                const unsigned wr_off = (unsigned)lane * 16u, tr_off = (unsigned)((4 * kq2 + tq) * 128 + 8 * tp);
                f32x4 O[4][4];
#pragma unroll
                for (int n = 0; n < 4; ++n)
#pragma unroll
                    for (int dt = 0; dt < 4; ++dt) O[n][dt] = (f32x4){0.f, 0.f, 0.f, 0.f};
                u32x4 vr[2][4]; int kr[4];
                const bf16_t* vbase = Vb + rb * 256 + 8 * ch;
#pragma unroll
                for (int i = 0; i < 4; ++i) kr[i] = sel[8 * i + rs];
#pragma unroll
                for (int pre = 0; pre < 2; ++pre)
#pragma unroll
                    for (int i = 0; i < 4; ++i) vr[pre][i] = *(const u32x4*)(vbase + (size_t)kr[i] * 256 + pre * 64);
#pragma unroll
                for (int st = 0; st < 32; ++st) {
                    const int ks = st >> 2, n = st & 3;
                    LAS unsigned char* buf = vb + (st & 1) * 4096;
#pragma unroll
                    for (int i = 0; i < 4; ++i) *(LAS u32x4*)(buf + wr_off + i * 1024) = vr[st & 1][i];
                    if (st < 30) { const int ks2 = (st + 2) >> 2, n2 = (st + 2) & 3;
                        if (n2 == 0) {
#pragma unroll
                            for (int i = 0; i < 4; ++i) kr[i] = sel[32 * ks2 + 8 * i + rs]; }
#pragma unroll
                        for (int i = 0; i < 4; ++i) vr[st & 1][i] = *(const u32x4*)(vbase + (size_t)kr[i] * 256 + n2 * 64); }
#pragma unroll
                    for (int dt = 0; dt < 4; ++dt) {
                        const v4i16_t t0 = __builtin_amdgcn_ds_read_tr16_b64_v4i16((LAS v4i16_t*)(buf + tr_off + 32 * dt));
                        const v4i16_t t1 = __builtin_amdgcn_ds_read_tr16_b64_v4i16((LAS v4i16_t*)(buf + tr_off + 2048 + 32 * dt));
                        const bf16x8 bfr = (bf16x8){t0[0], t0[1], t0[2], t0[3], t1[0], t1[1], t1[2], t1[3]};
                        O[n][dt] = __builtin_amdgcn_mfma_f32_16x16x32_bf16(pa[ks], bfr, O[n][dt], 0, 0, 0); }
                    CFENCE();
                }
                const f32x4 sm = *(const LAS f32x4*)(L + AL_SUM + (wave * 16 + 4 * kq2) * 4);
                bf16_t* op = Ob + (rb + t) * 1024 + (4 * kq2) * 64 + i16;
#pragma unroll
                for (int dt = 0; dt < 4; ++dt)
#pragma unroll
                    for (int i = 0; i < 4; ++i) { const float v = kq2 == 0 ? O[0][dt][i] : (kq2 == 1 ? O[1][dt][i] : (kq2 == 2 ? O[2][dt][i] : O[3][dt][i]));
                        op[i * 64 + 16 * dt] = (bf16_t)f2bf(v / sm[i]); }
            }
            LDS_WAIT(); CFENCE();
        }
        __syncthreads();
        }
    }
}

constexpr int SL_BMT = 0;
constexpr int SL_CMA = 4096;
constexpr int SL_AB = 12288;
constexpr int SL_E = 12800;
constexpr int SL_S = 16896;
constexpr int SPITCH = 272;
__device__ __forceinline__ void cmul(float ar, float ai, float br, float bi, float& cr, float& ci) { cr = ar * br - ai * bi; ci = ar * bi + ai * br; }
__device__ __forceinline__ void ssm_phase(Frame& F, const Args& A) {
    LAS unsigned char* L = F.lds;
    const int lane = F.lane, wave = F.wave;
    bf16_t* G = (bf16_t*)(F.ws + WS_ACT);
    for (int un = F.vcu; un < NB * 64; un += F.G) {
        const int b = un >> 6, g = un & 63; const size_t rb = (size_t)b * SEQ;
        __syncthreads();
        if (F.tid < 64) {
            const int p = F.tid;
            const float lr = fminf(A.in[I_SLRE][g * 64 + p], -1e-4f), li = A.in[I_SLIM][g * 64 + p];
            const float step = expf(A.in[I_SLOG][g]);
            const float mag = expf(lr * step); float sn, cs; sincosf(li * step, &sn, &cs);
            const float ar = mag * cs, ai = mag * sn;
            ((LAS float*)(L + SL_AB))[2 * p] = ar; ((LAS float*)(L + SL_AB))[2 * p + 1] = ai;
            const float nr = ar - 1.0f, ni = ai, den = lr * lr + li * li;
            const float cr = (nr * lr + ni * li) / den, ci = (ni * lr - nr * li) / den;
            LAS bf16_t* bm = (LAS bf16_t*)(L + SL_BMT);
#pragma unroll
            for (int c = 0; c < 16; ++c) { const float br = A.in[I_SBRE][((size_t)g * 64 + p) * 16 + c], bi = A.in[I_SBIM][((size_t)g * 64 + p) * 16 + c];
                float xr, xi; cmul(cr, ci, br, bi, xr, xi); bm[p * 16 + c] = (bf16_t)f2bf(xr); bm[(64 + p) * 16 + c] = (bf16_t)f2bf(xi); }
        }
        { LAS bf16_t* cm = (LAS bf16_t*)(L + SL_CMA);
          for (int i = F.tid; i < 32 * 128; i += NTHREADS) { const int c = i >> 7, k = i & 127; float v = 0.f;
              if (c < 16) v = (k < 64) ? A.in[I_SCRE][((size_t)g * 16 + c) * 64 + k] : -A.in[I_SCIM][((size_t)g * 16 + c) * 64 + (k - 64)];
              cm[i] = (bf16_t)f2bf(v); } }
        __syncthreads();
        const int r = lane & 31, hh = lane >> 5;
        bf16x8 bfr[4];
#pragma unroll
        for (int n = 0; n < 4; ++n) bfr[n] = *(const LAS bf16x8*)(L + SL_BMT + ((32 * n + r) * 16 + 8 * hh) * 2);
        bf16x8 cfr[8];
#pragma unroll
        for (int ks = 0; ks < 8; ++ks) cfr[ks] = *(const LAS bf16x8*)(L + SL_CMA + (r * 128 + 16 * ks + 8 * hh) * 2);
        float ar[2], ai[2], a16r[2], a16i[2], a512r[2], a512i[2];
#pragma unroll
        for (int s = 0; s < 2; ++s) { ar[s] = ((LAS float*)(L + SL_AB))[2 * (32 * s + r)]; ai[s] = ((LAS float*)(L + SL_AB))[2 * (32 * s + r) + 1];
            float pr = ar[s], pi = ai[s];
#pragma unroll
            for (int q = 0; q < 4; ++q) { float nr, ni; cmul(pr, pi, pr, pi, nr, ni); pr = nr; pi = ni; }
            a16r[s] = pr; a16i[s] = pi;
#pragma unroll
            for (int q = 0; q < 5; ++q) { float nr, ni; cmul(pr, pi, pr, pi, nr, ni); pr = nr; pi = ni; }
            a512r[s] = pr; a512i[s] = pi; }
        const int tokperm = 16 * ((r >> 2) & 1) + 4 * (r >> 3) + (r & 3);
        const float dsk0 = 0.f; (void)dsk0;
        float cin_r[2] = {0.f, 0.f}, cin_i[2] = {0.f, 0.f};
        LAS unsigned char* Sw = L + SL_S + wave * (32 * SPITCH);
        for (int pass = 0; pass < 2; ++pass) {
            if (pass == 1) {
                __syncthreads();
#pragma unroll
                for (int s = 0; s < 2; ++s) { float cr = 0.f, ci = 0.f;
                    for (int w = 0; w < wave; ++w) { float nr, ni; cmul(a512r[s], a512i[s], cr, ci, nr, ni); cr = nr + ((LAS float*)(L + SL_E))[(w * 64 + 32 * s + r) * 2]; ci = ni + ((LAS float*)(L + SL_E))[(w * 64 + 32 * s + r) * 2 + 1]; }
                    cin_r[s] = cr; cin_i[s] = ci; }
            }
            bf16x8 ufn = *(const bf16x8*)(F.HB + (rb + wave * 512 + tokperm) * DM + 16 * g + 8 * hh);
            for (int tile = 0; tile < 16; ++tile) {
                asm volatile("s_waitcnt vmcnt(0) lgkmcnt(0)" ::: "memory"); __builtin_amdgcn_s_barrier(); asm volatile("" ::: "memory");
                const int tk0 = wave * 512 + tile * 32;
                const bf16x8 uf = ufn;
                if (tile < 15) ufn = *(const bf16x8*)(F.HB + (rb + tk0 + 32 + tokperm) * DM + 16 * g + 8 * hh);

                f32x16 d[4];
#pragma unroll
                for (int n = 0; n < 4; ++n) {
#pragma unroll
                    for (int i = 0; i < 16; ++i) d[n][i] = 0.f;
                    d[n] = __builtin_amdgcn_mfma_f32_32x32x16_bf16(uf, bfr[n], d[n], 0, 0, 0); }
                asm volatile("s_nop 15\n\ts_nop 15\n\ts_nop 15" : "+v"(d[0]), "+v"(d[1]), "+v"(d[2]), "+v"(d[3]));
#pragma unroll
                for (int s = 0; s < 2; ++s) {
                    float sr = hh == 0 ? cin_r[s] : 0.f, si = hh == 0 ? cin_i[s] : 0.f;
#pragma unroll
                    for (int i = 0; i < 16; ++i) { const float nr = ar[s] * sr - ai[s] * si + d[s][i], ni = ar[s] * si + ai[s] * sr + d[2 + s][i]; sr = nr; si = ni; d[s][i] = sr; d[2 + s][i] = si; }
                    const float e0r = __shfl_xor(sr, 32), e0i = __shfl_xor(si, 32);
                    float cr = hh == 1 ? e0r : 0.f, ci = hh == 1 ? e0i : 0.f;
                    if (pass == 1) {
#pragma unroll
                        for (int i = 0; i < 16; ++i) { float nr, ni; cmul(ar[s], ai[s], cr, ci, nr, ni); cr = nr; ci = ni; d[s][i] += cr; d[2 + s][i] += ci; }
                    } else { float nr, ni; cmul(a16r[s], a16i[s], cr, ci, nr, ni); cr = nr; ci = ni; }
                    const float endr = (pass == 1) ? d[s][15] : sr + cr, endi = (pass == 1) ? d[2 + s][15] : si + ci;
                    const float xr = __shfl_xor(endr, 32), xi = __shfl_xor(endi, 32);
                    cin_r[s] = hh == 1 ? endr : xr; cin_i[s] = hh == 1 ? endi : xi;
                }
                if (pass == 1) {
#pragma unroll
                    for (int s = 0; s < 2; ++s)
#pragma unroll
                        for (int i = 0; i < 16; ++i) { *(LAS bf16_t*)(Sw + (16 * hh + i) * SPITCH + (32 * s + r) * 2) = (bf16_t)f2bf(d[s][i]); *(LAS bf16_t*)(Sw + (16 * hh + i) * SPITCH + (64 + 32 * s + r) * 2) = (bf16_t)f2bf(d[2 + s][i]); }
                    LDS_WAIT(); CFENCE();
                    f32x16 y;
#pragma unroll
                    for (int i = 0; i < 16; ++i) y[i] = 0.f;
#pragma unroll
                    for (int ks = 0; ks < 8; ++ks) { const bf16x8 sf = *(const LAS bf16x8*)(Sw + r * SPITCH + (16 * ks + 8 * hh) * 2); y = __builtin_amdgcn_mfma_f32_32x32x16_bf16(cfr[ks], sf, y, 0, 0, 0); }
                    LDS_WAIT(); CFENCE();
                    const size_t trow = rb + tk0 + r;
#pragma unroll
                    for (int q = 0; q < 2; ++q) { const int ch = 16 * g + 8 * q + 4 * hh;
                        const u32x2 hv = *(const u32x2*)(F.HB + trow * DM + ch); const f32x4 dk = *(const f32x4*)(A.in[I_SD] + ch);
                        const float y0 = gelu_tanh_f(y[4 * q + 0] + dk[0] * bflo(hv.x)), y1 = gelu_tanh_f(y[4 * q + 1] + dk[1] * bfhi(hv.x)), y2 = gelu_tanh_f(y[4 * q + 2] + dk[2] * bflo(hv.y)), y3 = gelu_tanh_f(y[4 * q + 3] + dk[3] * bfhi(hv.y));
                        u32x2 w; w.x = pk2(y0, y1); w.y = pk2(y2, y3); *(u32x2*)(G + trow * DM + ch) = w; }
                }
            }
            if (pass == 0) {
                if (hh == 1) {
#pragma unroll
                    for (int s = 0; s < 2; ++s) { ((LAS float*)(L + SL_E))[(wave * 64 + 32 * s + r) * 2] = cin_r[s]; ((LAS float*)(L + SL_E))[(wave * 64 + 32 * s + r) * 2 + 1] = cin_i[s]; } }
                cin_r[0] = cin_r[1] = cin_i[0] = cin_i[1] = 0.f;
            }
        }
    }
}

enum { PH_PRO = 0, PH_NORM0,
       L0_G1, L0_CONV, L0_G2, L0_NORM, L0_F1, L0_F2, L0_NORMN,
       L1_G1, L1_ATTN, L1_G2, L1_NORMR, L1_M1, L1_M2, L1_COMB,
       L2_SSM, L2_G2, L2_NORM, L2_F1, L2_F2, L2_NORMN,
       L3_G1, L3_CONV, L3_G2, L3_NORMR, L3_M1, L3_M2, L3_COMB, NPH };

__device__ __forceinline__ bool fresh_ids(Frame& F) { const int l = lane_id_fresh(); F.lane = l; F.tid = F.wave * 64 + l; return true; }
__global__ void __launch_bounds__(NTHREADS, 2) mega_fwd(Args args) {
    extern __shared__ __attribute__((aligned(16))) unsigned char lds_raw[];
    Frame F;
    F.lds = (LAS unsigned char*)lds_raw;
    volatile LAS unsigned* MISC = (volatile LAS unsigned*)(F.lds + MISC_OFF);
    F.tid = threadIdx.x; F.lane = F.tid & 63; F.wave = __builtin_amdgcn_readfirstlane(F.tid >> 6);
    F.G = gridDim.x; { const int bx = blockIdx.x; F.vcu = (F.G % 8 == 0) ? (bx % 8) * (F.G / 8) + bx / 8 : bx; }
    F.ws = args.ws; F.ctl = (gu32*)(args.ws + WS_CTL); F.out = args.out; F.mod = (const float*)(args.ws + WS_MOD);
    F.HB = (bf16_t*)(args.ws + WS_HB); F.BUF = (bf16_t*)(args.ws + WS_BUF); F.ACT = (bf16_t*)(args.ws + WS_ACT);
    for (int u = F.tid; u < (LDS_BYTES - LDSCTL_OFF) / 4; u += NTHREADS) ((LAS unsigned*)(F.lds + LDSCTL_OFF))[u] = 0u;
    __syncthreads();
    XcdBarrier bar; bar.bar = (unsigned*)(F.ctl + CW_BAR); bar.x = 0; bar.st = nullptr; bar.w = F.wave;
    const int lo = args.ph_lo, hi = args.ph_hi;
    if (hi - lo > 1) bar = xcd_barrier_post((unsigned*)(F.ctl + CW_BAR), MISC + 8, F.wave);
#ifndef PH_ONLY
#define PH_EN(k) true
#else
#define PH_EN(k) ((k) == PH_ONLY)
#endif
#define IN(k) (PH_EN(k) && lo <= (k) && (k) < hi && fresh_ids(F))
#define SEAM(k) do { if (IN(k) && IN((k) + 1)) xcd_barrier(bar); } while (0)
#ifndef PH_REP
#define PH_REP (-1)
#endif
#ifndef PH_REPMASK
#define PH_REPMASK 0ull
#endif
#define REPB(k, ...) do { if (PH_REP == (k) || ((PH_REPMASK >> (k)) & 1ull)) { xcd_barrier(bar); __VA_ARGS__; } } while (0)
    LAS unsigned char* ring = F.lds;
    const int cid = (int)blockIdx.x;
    bf16_t* const WCI = (bf16_t*)(F.ws + WS_WCI); bf16_t* const WCO = (bf16_t*)(F.ws + WS_WCO); bf16_t* const WAI = (bf16_t*)(F.ws + WS_WAI); bf16_t* const WAO = (bf16_t*)(F.ws + WS_WAO);
    bf16_t* const WGL = (bf16_t*)(F.ws + WS_WGL); bf16_t* const WFG = (bf16_t*)(F.ws + WS_WFG); bf16_t* const WFD = (bf16_t*)(F.ws + WS_WFD); bf16_t* const WMG = (bf16_t*)(F.ws + WS_WMG); bf16_t* const WMD = (bf16_t*)(F.ws + WS_WMD);

#define ZEROG ((const float*)(F.ws + 512 * 1024))
    const bool fuseR = (F.G == 256) && FUSE_R;
    const bool fuse = (F.G == 256) && FUSE_N;
#define FUSED_EPI(inst, gatep, xin, nl, ns, hout, asc, h8_) ({F.out, (gatep), (xin), args.in[I_NORMG] + (size_t)((nl) * 2 + (ns)) * DM, F.mod + (size_t)(nl) * NB * 6144 + ((ns) ? 3 : 0) * DM, (hout), (float*)(F.ws + WS_XS), F.ctl + CW_PAN + 64 * 64 * (inst), F.ctl + CW_TMO, (asc), (h8_)})
#define FUSED_RT(inst, gatep, nl, rl, roff, hout, h8_) ({F.out, (gatep), args.in[I_NORMG] + (size_t)((nl) * 2 + 1) * DM, F.mod + (size_t)(nl) * NB * 6144 + 3 * DM, (hout), (float*)(F.ws + WS_XS9), F.ctl + CW_PAN + 64 * 64 * (inst), F.ctl + CW_TMO, \
        args.in[I_RW] + (size_t)(rl) * DM * NEXP, args.in[I_RB] + (rl) * NEXP, F.ctl + CW_CNT + 64 * 8 * (rl), F.ws + (roff), (h8_)})
#define MODP(l, chunk) (F.mod + (size_t)(l) * NB * 6144 + (chunk) * DM)
#define GEMM_STATIC(Aptr, Bptr, Nn, Kk, EpiT, EpiInit) do { pg8::Gemm g{(Aptr), (Bptr), M, (Nn), (Kk), 0, nullptr, nullptr}; pg8::StaticOrder S; S.init(M, (Nn), F.G, cid); EpiT E EpiInit; \
        pg8::gemm_phase<EpiT, pg8::StaticOrder, false>(ring, g, S, E, F.wave); } while (0)
#define GEMM_STATIC8(Aptr, Bptr, Nn, Kk, EpiT, EpiInit) do { pg8::Gemm g{(Aptr), (Bptr), M, (Nn), (Kk), 0, nullptr, nullptr}; pg8::StaticOrder S; S.init(M, (Nn), F.G, cid); EpiT E EpiInit; \
        pg8::gemm_phase<EpiT, pg8::StaticOrder, false, true>(ring, g, S, E, F.wave); } while (0)
#define EPAIR8 pg8::EpiPair<1, (M2_FP8 != 0), (M1_FP8 != 0)>
#define M1_B (M1_FP8 ? 1 : 2)
#define EPAIR8L1 pg8::EpiPair<1, (M2_FP8 != 0), (M1L1_FP8 != 0)>
#define M2_B (M2_FP8 ? 1 : 2)
#define F2_ASC (F2_FP8 ? pg8::W8_INV : 1.0f)
#define GEMM_STATICF(Aptr, Bptr, Nn, Kk, EpiT, EpiInit) do { pg8::Gemm g{(Aptr), (Bptr), M, (Nn), (Kk), 0, nullptr, nullptr}; pg8::StaticOrder S; S.init(M, (Nn), F.G, cid); EpiT E EpiInit; \
        pg8::gemm_phase<EpiT, pg8::StaticOrder, false, (F2_FP8 != 0)>(ring, g, S, E, F.wave); } while (0)
#define EPAIRF pg8::EpiPair<1, (F2_FP8 != 0), false>
#define F0_FP8 (F2_FP8 || F2L0_FP8)
#define F2L0_ASC (F0_FP8 ? pg8::W8_INV : 1.0f)
#define EPAIR0 pg8::EpiPair<1, (F0_FP8 != 0), false>
#define EPAIR0S pg8::EpiPair<1, (F0_FP8 != 0), (F1L0_FP8 != 0)>
#define GEMM_STATICF0(Aptr, Bptr, Nn, Kk, EpiT, EpiInit) do { pg8::Gemm g{(Aptr), (Bptr), M, (Nn), (Kk), 0, nullptr, nullptr}; pg8::StaticOrder S; S.init(M, (Nn), F.G, cid); EpiT E EpiInit; \
        pg8::gemm_phase<EpiT, pg8::StaticOrder, false, (F0_FP8 != 0)>(ring, g, S, E, F.wave); } while (0)
#define W8(base, bytes) ((bf16_t*)((unsigned char*)(base) + (size_t)(bytes)))

    if (IN(PH_PRO)) { p0_prologue(F, args); REPB(PH_PRO, p0_prologue(F, args)); } SEAM(PH_PRO);
    if (IN(PH_NORM0)) { thin_phase<4>(F, args, args.in[I_X], 0, 0, 0, 0); REPB(PH_NORM0, thin_phase<4>(F, args, args.in[I_X], 0, 0, 0, 0)); } SEAM(PH_NORM0);

    if (IN(L0_G1)) { GEMM_STATIC(F.HB, WCI, 3072, DM, pg8::EpiConvIn, {F.BUF}); REPB(L0_G1, GEMM_STATIC(F.HB, WCI, 3072, DM, pg8::EpiConvIn, {F.BUF})); } SEAM(L0_G1);
    if (IN(L0_CONV)) { conv_phase(F, args.in[I_CW]); REPB(L0_CONV, conv_phase(F, args.in[I_CW])); } SEAM(L0_CONV);
    if (IN(L0_G2)) { if (fuse) GEMM_STATIC(F.HB, WCO, DM, DM, pg8::EpiResNorm, FUSED_EPI(0, MODP(0, 2), args.in[I_X], 0, 1, (fuse ? F.BUF : F.HB), 1.0f, F1L0_FP8)); else GEMM_STATIC(F.HB, WCO, DM, DM, pg8::EpiRes, ({F.out, MODP(0, 2), args.in[I_X], 1.0f})); } SEAM(L0_G2);
    if (!fuse) { if (IN(L0_NORM)) { thin_phase<4>(F, args, F.out, 0, 1, 0, 0); } SEAM(L0_NORM); }
    if (IN(L0_F1)) { pg8::Gemm g{(fuse ? F.BUF : F.HB), WFG, M, 2 * FF, DM, 0, nullptr, nullptr}; pg8::StaticOrder S; S.init(M, 2 * FF, F.G, cid); EPAIR0S E{F.ACT, FF};
        pg8::gemm_phase<EPAIR0S, pg8::StaticOrder, false, (F1L0_FP8 != 0)>(ring, g, S, E, F.wave); } SEAM(L0_F1);
    if (IN(L0_F2)) { if (fuse) GEMM_STATICF0(F.ACT, WFD, DM, FF, pg8::EpiResNorm, FUSED_EPI(1, MODP(0, 5), F.out, 1, 0, F.HB, F2L0_ASC, 0)); else GEMM_STATICF0(F.ACT, WFD, DM, FF, pg8::EpiRes, ({F.out, MODP(0, 5), F.out, F2L0_ASC})); } SEAM(L0_F2);
    if (!fuse) { if (IN(L0_NORMN)) { thin_phase<4>(F, args, F.out, 1, 0, 0, 0); } SEAM(L0_NORMN); }

    if (IN(L1_G1)) { GEMM_STATIC(F.HB, WAI, ATT_NP, DM, pg8::EpiAttnIn, ({(bf16_t*)(F.ws + WS_Q), (bf16_t*)(F.ws + WS_K), (bf16_t*)(F.ws + WS_V), (bf16_t*)(F.ws + WS_QI), (bf16_t*)(F.ws + WS_KI), (float*)(F.ws + WS_WI), args.in[I_QG], args.in[I_KG]})); REPB(L1_G1, GEMM_STATIC(F.HB, WAI, ATT_NP, DM, pg8::EpiAttnIn, ({(bf16_t*)(F.ws + WS_Q), (bf16_t*)(F.ws + WS_K), (bf16_t*)(F.ws + WS_V), (bf16_t*)(F.ws + WS_QI), (bf16_t*)(F.ws + WS_KI), (float*)(F.ws + WS_WI), args.in[I_QG], args.in[I_KG]}))); } SEAM(L1_G1);
    if (IN(L1_ATTN)) { attn_phase(F, args); REPB(L1_ATTN, attn_phase(F, args)); } SEAM(L1_ATTN);
    if (IN(L1_G2)) { if (fuseR) GEMM_STATIC((bf16_t*)(F.ws + WS_O), WAO, DM, DM, pg8::EpiResNormRouter, FUSED_RT(3, MODP(1, 2), 1, 0, 0, F.HB, M1L1_FP8)); else GEMM_STATIC((bf16_t*)(F.ws + WS_O), WAO, DM, DM, pg8::EpiRes, ({F.out, MODP(1, 2), F.out, 1.0f})); } SEAM(L1_G2);
    if (!fuseR) { if (IN(L1_NORMR)) { thin_phase<4 | 8>(F, args, F.out, 1, 1, 0, 0); } SEAM(L1_NORMR); }
    if (IN(L1_M1)) { pg8::Gemm g{F.HB, WMG, M, 2 * FF, DM, (size_t)2 * FF * DM * (M1L1_FP8 ? 1 : 2), (const int*)(F.ws + WS_ROWIDX), (const unsigned*)(F.ctl + CW_CNT)}; pg8::MoeOrder S; S.init((const unsigned*)(F.ctl + CW_CNT), 22, F.G, cid);
        EPAIR8L1 E{F.ACT, FF}; pg8::gemm_phase<EPAIR8L1, pg8::MoeOrder, true, (M1L1_FP8 != 0)>(ring, g, S, E, F.wave); REPB(L1_M1, pg8::gemm_phase<EPAIR8L1, pg8::MoeOrder, true, (M1L1_FP8 != 0)>(ring, g, S, E, F.wave)); } SEAM(L1_M1);
    if (IN(L1_M2)) { pg8::Gemm g{F.ACT, WMD, M, DM, FF, (size_t)DM * FF * M2_B, nullptr, nullptr}; pg8::MoeOrder S; S.init((const unsigned*)(F.ctl + CW_CNT), 4, F.G, cid);
        pg8::EpiMoeDn E{F.BUF, (const float*)(F.ws + WS_GATEP)}; pg8::gemm_phase<pg8::EpiMoeDn, pg8::MoeOrder, false, (M2_FP8 != 0)>(ring, g, S, E, F.wave); REPB(L1_M2, pg8::gemm_phase<pg8::EpiMoeDn, pg8::MoeOrder, false, (M2_FP8 != 0)>(ring, g, S, E, F.wave)); } SEAM(L1_M2);
    if (IN(L1_COMB)) { thin_phase<2 | 4>(F, args, F.out, 2, 0, 1, 0); REPB(L1_COMB, thin_phase<2 | 4>(F, args, F.out, 2, 0, -1, 0)); } SEAM(L1_COMB);

    if (IN(L2_SSM)) { ssm_phase(F, args); REPB(L2_SSM, ssm_phase(F, args)); } SEAM(L2_SSM);
    if (IN(L2_G2)) { GEMM_STATIC(F.ACT, WGL, 2048, DM, pg8::EpiGluRes, ({F.out, MODP(2, 2)})); REPB(L2_G2, GEMM_STATIC(F.ACT, WGL, 2048, DM, pg8::EpiGluRes, ({F.out, ZEROG}))); } SEAM(L2_G2);
    if (IN(L2_NORM)) { thin_phase<4>(F, args, F.out, 2, 1, 0, 0); REPB(L2_NORM, thin_phase<4>(F, args, F.out, 2, 1, 0, 0)); } SEAM(L2_NORM);
    if (IN(L2_F1)) { GEMM_STATIC(F.HB, WFG + (size_t)2 * FF * DM, 2 * FF, DM, EPAIRF, ({F.ACT, FF})); REPB(L2_F1, GEMM_STATIC(F.HB, WFG + (size_t)2 * FF * DM, 2 * FF, DM, EPAIRF, ({F.ACT, FF}))); } SEAM(L2_F1);
    if (IN(L2_F2)) { if (fuse) GEMM_STATICF(F.ACT, W8(WFD, (size_t)DM * FF * (F2_FP8 ? 1 : 2)), DM, FF, pg8::EpiResNorm, FUSED_EPI(2, MODP(2, 5), F.out, 3, 0, F.HB, F2_ASC, 0)); else GEMM_STATICF(F.ACT, W8(WFD, (size_t)DM * FF * (F2_FP8 ? 1 : 2)), DM, FF, pg8::EpiRes, ({F.out, MODP(2, 5), F.out, F2_ASC})); } SEAM(L2_F2);
    if (!fuse) { if (IN(L2_NORMN)) { thin_phase<4>(F, args, F.out, 3, 0, 0, 0); } SEAM(L2_NORMN); }

    if (IN(L3_G1)) { GEMM_STATIC(F.HB, WCI + (size_t)3072 * DM, 3072, DM, pg8::EpiConvIn, {F.BUF}); REPB(L3_G1, GEMM_STATIC(F.HB, WCI + (size_t)3072 * DM, 3072, DM, pg8::EpiConvIn, {F.BUF})); } SEAM(L3_G1);
    if (IN(L3_CONV)) { conv_phase(F, args.in[I_CW] + 3 * DM); REPB(L3_CONV, conv_phase(F, args.in[I_CW] + 3 * DM)); } SEAM(L3_CONV);
    if (IN(L3_G2)) { if (fuseR) GEMM_STATIC(F.HB, WCO + (size_t)DM * DM, DM, DM, pg8::EpiResNormRouter, FUSED_RT(4, MODP(3, 2), 3, 1, 2 * MiB, F.BUF, M1_FP8)); else GEMM_STATIC(F.HB, WCO + (size_t)DM * DM, DM, DM, pg8::EpiRes, ({F.out, MODP(3, 2), F.out, 1.0f})); } SEAM(L3_G2);
    if (!fuseR) { if (IN(L3_NORMR)) { thin_phase<4 | 8>(F, args, F.out, 3, 1, 0, 1, 1, 2 * MiB); } SEAM(L3_NORMR); }
    if (IN(L3_M1)) { pg8::Gemm g{(fuseR ? F.BUF : F.HB), W8(WMG, (size_t)8 * 2 * FF * DM * 2), M, 2 * FF, DM, (size_t)2 * FF * DM * M1_B, (const int*)(F.ws + 2 * MiB + WS_ROWIDX), (const unsigned*)(F.ctl + CW_CNT + 512)}; pg8::MoeOrder S; S.init((const unsigned*)(F.ctl + CW_CNT + 512), 22, F.G, cid);
        EPAIR8 E{F.ACT, FF}; pg8::gemm_phase<EPAIR8, pg8::MoeOrder, true, (M1_FP8 != 0)>(ring, g, S, E, F.wave); REPB(L3_M1, pg8::gemm_phase<EPAIR8, pg8::MoeOrder, true, (M1_FP8 != 0)>(ring, g, S, E, F.wave)); } SEAM(L3_M1);
    if (IN(L3_M2)) { pg8::Gemm g{F.ACT, W8(WMD, (size_t)8 * DM * FF * M2_B), M, DM, FF, (size_t)DM * FF * M2_B, nullptr, nullptr}; pg8::MoeOrder S; S.init((const unsigned*)(F.ctl + CW_CNT + 512), 4, F.G, cid);
        pg8::EpiMoeDn E{F.BUF, (const float*)(F.ws + 2 * MiB + WS_GATEP)}; pg8::gemm_phase<pg8::EpiMoeDn, pg8::MoeOrder, false, (M2_FP8 != 0)>(ring, g, S, E, F.wave); REPB(L3_M2, pg8::gemm_phase<pg8::EpiMoeDn, pg8::MoeOrder, false, (M2_FP8 != 0)>(ring, g, S, E, F.wave)); } SEAM(L3_M2);
    if (IN(L3_COMB)) { thin_phase<2>(F, args, F.out, 0, 0, 3, 1, 1, 2 * MiB); }
#undef IN
#undef SEAM
}

extern "C" void kernel_launch(void* const* d_in, const int* in_sizes, int n_in, void* d_out, int out_size, void* d_ws, size_t ws_size, hipStream_t stream) {
    static int grid = 0;
    if (grid == 0) {
        if (n_in != 28 || in_sizes[0] != M * DM || out_size != M * DM || ws_size < WS_END) { fprintf(stderr, "kernel_launch: unexpected shapes / workspace (n_in %d, ws %zu, need %zu)\n", n_in, ws_size, (size_t)WS_END); grid = -1; return; }
        int dev = 0, cus = 0, per_cu = 0;
        if (hipGetDevice(&dev) != hipSuccess || hipDeviceGetAttribute(&cus, hipDeviceAttributeMultiprocessorCount, dev) != hipSuccess) { grid = -1; return; }
        if (hipFuncSetAttribute((const void*)mega_fwd, hipFuncAttributeMaxDynamicSharedMemorySize, LDS_BYTES) != hipSuccess) { fprintf(stderr, "kernel_launch: hipFuncSetAttribute failed\n"); grid = -1; return; }
        if (hipOccupancyMaxActiveBlocksPerMultiprocessor(&per_cu, (const void*)mega_fwd, NTHREADS, LDS_BYTES) != hipSuccess || per_cu < 1) fprintf(stderr, "kernel_launch: occupancy query reports %d\n", per_cu);
        (void)hipGetLastError();
        grid = cus;
    }
    if (grid < 0) return;
    (void)hipMemsetAsync((char*)d_ws + WS_CTL, 0, CTL_ZERO_BYTES, stream);
    Args a{};
    for (int i = 0; i < 28; ++i) a.in[i] = (const float*)d_in[i];
    a.out = (float*)d_out; a.ws = (unsigned char*)d_ws;
#if MK_PER_PHASE
    for (int p = 0; p < NPH; ++p) { a.ph_lo = p; a.ph_hi = p + 1; hipLaunchKernelGGL(mega_fwd, dim3(grid), dim3(NTHREADS), LDS_BYTES, stream, a); }
#else
    a.ph_lo = 0; a.ph_hi = NPH; hipLaunchKernelGGL(mega_fwd, dim3(grid), dim3(NTHREADS), LDS_BYTES, stream, a);
#endif
}
```

```cpp
#include <hip/hip_runtime.h>
#include <cstdio>
#include <cstdint>
#include <cmath>

#ifndef MK_PER_PHASE
#define MK_PER_PHASE 0
#endif

#define GAS __attribute__((address_space(1)))
#define LAS __attribute__((address_space(3)))
typedef unsigned short bf16_t;
typedef short bf16x8 __attribute__((ext_vector_type(8)));
typedef float f32x4 __attribute__((ext_vector_type(4)));
typedef float f32x2 __attribute__((ext_vector_type(2)));
typedef float f32x16 __attribute__((ext_vector_type(16)));
typedef unsigned u32x4 __attribute__((ext_vector_type(4)));
typedef unsigned u32x2 __attribute__((ext_vector_type(2)));
typedef GAS unsigned gu32;
#define RLX_AGENT __ATOMIC_RELAXED, __HIP_MEMORY_SCOPE_AGENT
#define LDS_WAIT() asm volatile("s_waitcnt lgkmcnt(0)" ::: "memory")
#define VM_WAIT() asm volatile("s_waitcnt vmcnt(0)" ::: "memory")
#define CFENCE() asm volatile("" ::: "memory")

constexpr int DM = 1024, NB = 4, SEQ = 4096, M = NB * SEQ, FF = 2816, NEXP = 8;
constexpr int NH = 16, NKV = 4, HD = 64, IH = 8, IDIM = 64, TOPK = 256;
constexpr int ATT_N = 2120, ATT_NP = 2304;
constexpr float EPS = 1e-6f;
constexpr int NWAVES = 8, NTHREADS = 512;

__device__ __forceinline__ unsigned f2bf(float f) { unsigned u = __builtin_bit_cast(unsigned, f); return (u + 0x7fffu + ((u >> 16) & 1u)) >> 16; }
__device__ __forceinline__ unsigned pk2(float lo, float hi) { return f2bf(lo) | (f2bf(hi) << 16); }
__device__ __forceinline__ unsigned cvt_pk_bf16(float lo, float hi) { unsigned r; asm volatile("v_cvt_pk_bf16_f32 %0, %1, %2" : "=v"(r) : "v"(lo), "v"(hi)); return r; }
__device__ __forceinline__ float bflo(unsigned u) { return __uint_as_float(u << 16); }
__device__ __forceinline__ float bfhi(unsigned u) { return __uint_as_float(u & 0xffff0000u); }
__device__ __forceinline__ float wave_sum(float v) {
#pragma unroll
    for (int o = 1; o < 64; o <<= 1) v += __shfl_xor(v, o);
    return v;
}
__device__ __forceinline__ float fast_rcp(float x) { return __builtin_amdgcn_rcpf(x); }
__device__ __forceinline__ float silu_f(float g) { return g * fast_rcp(1.f + __expf(-g)); }
__device__ __forceinline__ float sigmoid_f(float g) { return fast_rcp(1.f + __expf(-g)); }
__device__ __forceinline__ float gelu_tanh_f(float y) { const float z = 0.7978845608028654f * (y + 0.044715f * y * y * y); const float t = 1.f - 2.f * fast_rcp(__expf(2.f * z) + 1.f); return 0.5f * y * (1.f + t); }

constexpr size_t WS_ROWIDX_B = 2u << 20, WS_GATEP_B = (2u << 20) + 512 * 1024, WS_SLOT_B = 3u << 20;
__device__ __forceinline__ int lane_id_fresh() { int l; asm volatile("v_mbcnt_lo_u32_b32 %0, -1, 0\n\tv_mbcnt_hi_u32_b32 %0, -1, %0" : "=v"(l)); return l; }
#ifndef FUSE_R
#define FUSE_R 1
#endif
#ifndef FUSE_N
#define FUSE_N 1
#endif
#ifndef M2_FP8
#define M2_FP8 1
#endif
#ifndef F1L0_FP8
#define F1L0_FP8 1
#endif
#ifndef M1L1_FP8
#define M1L1_FP8 1
#endif
#ifndef M1_FP8
#define M1_FP8 1
#endif
#ifndef F2L0_FP8
#define F2L0_FP8 1
#endif
#ifndef F2_FP8
#define F2_FP8 1
#endif
namespace pg8 {
constexpr int BM = 256, BK = 64, HALF = 128, HTB = HALF * BK * 2, STAGE_BYTES = 8 * HTB, NXCD = 8, WGM = 8;
__host__ __device__ __forceinline__ int lds_byte(int r, int c) { const int st = (r >> 4) * 2 + (c >> 5), rr = r & 15, cc = c & 31, ob = rr * 64 + cc * 2; return st * 1024 + (ob ^ (((ob >> 9) & 1) << 5)); }
__host__ __device__ __forceinline__ void stage_rc(int b, int& R, int& C) { const int st = b / 1024, sb = b % 1024, swz = sb ^ (((sb >> 9) & 1) << 5); R = (st >> 1) * 16 + swz / 64; C = (st & 1) * 32 + (swz % 64) / 2; }
__host__ __device__ __forceinline__ int perm32(int rho) { const int n = rho >> 4, i = rho & 15; return 8 * (i >> 2) + 4 * n + (i & 3); }

struct Unit { int pm, pn, e, aux; };
struct Gemm { const bf16_t* A; const bf16_t* Bt; int M, N, K; size_t bstride_e; const int* rowidx; const unsigned* cnt; };

struct StaticOrder {
    int nM, nN, nwg, G, c;
    __device__ __forceinline__ void init(int M_, int N_, int G_, int c_) { nM = M_ / BM; nN = N_ / BM; nwg = nM * nN; G = G_; c = c_; }
    __device__ __forceinline__ bool next(int i, Unit& u) const {
        const long L = (long)i * G + c; if (L >= nwg) return false;
        int wgid = (int)L; { const int q = nwg / NXCD, r = nwg % NXCD, xcd = wgid % NXCD, off = wgid / NXCD; wgid = (xcd < r ? xcd * (q + 1) : r * (q + 1) + (xcd - r) * q) + off; }
        const int nig = WGM * nN, gid = wgid / nig, fm = gid * WGM, gsz = (nM - fm) < WGM ? (nM - fm) : WGM;
        u.pm = fm + ((wgid % nig) % gsz); u.pn = (wgid % nig) / gsz; u.e = 0; u.aux = 0; return true;
    }
};
struct MoeOrder {
    int T1, T2, T3, T4, T5, T6, T7, T8, NT, W, r, lo, ntl;
    static constexpr int RG = 4;
    __device__ __forceinline__ void init(const unsigned* cnt, int NT_, int G_, int c_) {
        int t[9]; int acc = 0;
#pragma unroll
        for (int e = 0; e < 8; ++e) { t[e] = acc; acc += (int)((__hip_atomic_load(cnt + 64 * e, RLX_AGENT) + 255u) >> 8); }
        t[8] = acc; T1 = t[1]; T2 = t[2]; T3 = t[3]; T4 = t[4]; T5 = t[5]; T6 = t[6]; T7 = t[7]; T8 = t[8]; NT = NT_;
        if (G_ % 8 == 0) { const int xv = c_ % 8; W = G_ / 8; r = c_ / 8; lo = (T8 * xv) / 8; ntl = (T8 * (xv + 1)) / 8 - lo; }
        else { W = G_; r = c_; lo = 0; ntl = T8; }
    }
    __device__ __forceinline__ bool next(int i, Unit& u) const {
        const int q = i * W + r; if (q >= ntl * NT) return false;
        const int nig = RG * NT, gid = q / nig, fm = gid * RG, gsz = (ntl - fm) < RG ? (ntl - fm) : RG, w = q - gid * nig;
        const int tt = lo + fm + (w % gsz), pn = w / gsz;
        int e = 0, te = 0;
        if (tt >= T1) { e = 1; te = T1; } if (tt >= T2) { e = 2; te = T2; } if (tt >= T3) { e = 3; te = T3; } if (tt >= T4) { e = 4; te = T4; }
        if (tt >= T5) { e = 5; te = T5; } if (tt >= T6) { e = 6; te = T6; } if (tt >= T7) { e = 7; te = T7; }
        u.pm = tt; u.pn = pn; u.e = e; u.aux = e * 16384 + 256 * (tt - te); return true;
    }
};

typedef int v8i32 __attribute__((ext_vector_type(8)));
typedef int v4i32 __attribute__((ext_vector_type(4)));
constexpr float W8_MUL = 32.0f, W8_INV = 1.0f / 32.0f;
__device__ __forceinline__ void mfma8(f32x4& c, const v8i32 a, const v8i32 b) { asm volatile("v_mfma_f32_16x16x128_f8f6f4 %0, %1, %2, %0" : "+v"(c) : "v"(a), "v"(b)); }
__device__ __forceinline__ v8i32 cat8(const bf16x8 a, const bf16x8 b) { return __builtin_shufflevector(__builtin_bit_cast(v4i32, a), __builtin_bit_cast(v4i32, b), 0, 1, 2, 3, 4, 5, 6, 7); }
template <class Epi, class Sched, bool GATHER, bool FP8 = false>
__device__ __forceinline__ void gemm_phase(LAS unsigned char* lds, const Gemm g, const Sched& S, const Epi& E, const int wid) {
    const int lane = lane_id_fresh(), tid = wid * 64 + lane, wr = wid >> 2, wc = wid & 3, fr = lane & 15, fq = lane >> 4;
    const int K = FP8 ? g.K / 2 : g.K, nt = K / BK;
    unsigned voffB[2]; int stR[2], stC[2];
#pragma unroll
    for (int i = 0; i < 2; ++i) { int R, C; stage_rc(tid * 16 + i * 8192, R, C); const int Rb = (R & ~31) + perm32(R & 31);
        stR[i] = R; stC[i] = C; voffB[i] = (unsigned)(Rb * K + C) * 2u; }
    const size_t kstep = (size_t)(BK * 2);
    const size_t hstep = (size_t)HALF * K * 2;
    const size_t tstep = 2 * hstep;
    const unsigned ldsw = (unsigned)wid * 1024u;
    const int aoff = lds_byte(wr * 64 + fr, fq * 8), boff = lds_byte(wc * 32 + fr, fq * 8);
#define PG8_SA(b, h) (((b) * 2 + (h)) * HTB)
#define PG8_SB(b, h) ((4 + (b) * 2 + (h)) * HTB)
#define PG8_STAGE(bufoff, gbase, voff) do { _Pragma("unroll") for (int _i = 0; _i < 2; ++_i) \
        __builtin_amdgcn_global_load_lds((const unsigned*)((const char*)(gbase) + (voff)[_i]), (LAS unsigned*)(lds + (bufoff) + ldsw + _i * 8192), 16, 0, 0); } while (0)
#define PG8_LDA(dst, b, h) do { _Pragma("unroll") for (int m = 0; m < 4; ++m) _Pragma("unroll") for (int k = 0; k < 2; ++k) dst[m][k] = *(const LAS bf16x8*)(lds + PG8_SA(b, h) + aoff + m * 2048 + k * 1024); } while (0)
#define PG8_LDB(dst, b, h) do { _Pragma("unroll") for (int n = 0; n < 2; ++n) _Pragma("unroll") for (int k = 0; k < 2; ++k) dst[n][k] = *(const LAS bf16x8*)(lds + PG8_SB(b, h) + boff + n * 2048 + k * 1024); } while (0)
#define PG8_MMA(ai, bj, At, Bt) do { __builtin_amdgcn_s_setprio(1); _Pragma("unroll") for (int m = 0; m < 4; ++m) _Pragma("unroll") for (int n = 0; n < 2; ++n) { \
        if (FP8) mfma8(acc[ai][bj][m][n], cat8(Bt[n][0], Bt[n][1]), cat8(At[m][0], At[m][1])); \
        else { _Pragma("unroll") for (int k = 0; k < 2; ++k) acc[ai][bj][m][n] = __builtin_amdgcn_mfma_f32_16x16x32_bf16(Bt[n][k], At[m][k], acc[ai][bj][m][n], 0, 0, 0); } } \
        __builtin_amdgcn_s_setprio(0); } while (0)
#define PG8_MMA_END(At, B0, B1) do { if (FP8) { asm volatile("s_nop 15" :: "v"(cat8(At[0][0], At[0][1])), "v"(cat8(At[1][0], At[1][1])), "v"(cat8(At[2][0], At[2][1])), "v"(cat8(At[3][0], At[3][1])), \
        "v"(cat8(B0[0][0], B0[0][1])), "v"(cat8(B0[1][0], B0[1][1])), "v"(cat8(B1[0][0], B1[0][1])), "v"(cat8(B1[1][0], B1[1][1]))); } } while (0)
#define PG8_WAIT_V(n) asm volatile("s_waitcnt vmcnt(" #n ")" ::: "memory")
#define PG8_WAIT_L(n) asm volatile("s_waitcnt lgkmcnt(" #n ")" ::: "memory")
#define PG8_BAR __builtin_amdgcn_s_barrier()
#define PG8_SCHED __builtin_amdgcn_sched_barrier(0)
#define PG8_AOFFS(v, U) do { _Pragma("unroll") for (int _h = 0; _h < 2; ++_h) _Pragma("unroll") for (int _i = 0; _i < 2; ++_i) { \
        if (GATHER) { const int _loc = ((U).aux & 16383) + _h * HALF + stR[_i]; const int _e = (U).aux >> 14; \
            const int _row = (_loc < (int)g.cnt[64 * _e]) ? g.rowidx[(U).aux + _h * HALF + stR[_i]] : 0; \
            v[_h][_i] = (unsigned)(_row * K + stC[_i]) * 2u; } \
        else v[_h][_i] = (unsigned)((_h * HALF + stR[_i]) * K + stC[_i]) * 2u; } } while (0)
    int cn8[8];
#pragma unroll
    for (int e = 0; e < 8; ++e) cn8[e] = GATHER ? __builtin_amdgcn_readfirstlane((int)g.cnt[64 * e]) : 0;
    Unit cur, nxt; int ui = 0;
    if (!S.next(0, cur)) return;
    f32x4 acc[2][2][4][2];
#pragma unroll
    for (int a = 0; a < 2; ++a)
#pragma unroll
        for (int b = 0; b < 2; ++b)
#pragma unroll
            for (int m = 0; m < 4; ++m)
#pragma unroll
                for (int n = 0; n < 2; ++n) acc[a][b][m][n] = (f32x4){0.f, 0.f, 0.f, 0.f};
    bf16x8 At[4][2], B0[2][2], B1[2][2];
    unsigned vAc[2][2], vAn[2][2];
    PG8_AOFFS(vAc, cur);
    const char* cA = (const char*)g.A + (GATHER ? (size_t)0 : (size_t)cur.pm * tstep);
    const char* cB = (const char*)g.Bt + (size_t)cur.e * g.bstride_e + (size_t)cur.pn * tstep;
    PG8_STAGE(PG8_SB(0, 0), cB, voffB); PG8_STAGE(PG8_SB(0, 1), cB + hstep, voffB); PG8_STAGE(PG8_SA(0, 0), cA, vAc[0]); PG8_STAGE(PG8_SA(0, 1), cA, vAc[1]);
    if (wr == 1) PG8_BAR;
    PG8_WAIT_V(2); PG8_BAR;
    PG8_STAGE(PG8_SB(1, 0), cB + kstep, voffB); PG8_STAGE(PG8_SA(1, 0), cA + kstep, vAc[0]); PG8_STAGE(PG8_SB(1, 1), cB + hstep + kstep, voffB);
    PG8_WAIT_V(6); PG8_BAR;
    for (;;) {
        const bool has_next = S.next(ui + 1, nxt);
        const char* nA = cA; const char* nB = cB;
        int rn[2][2];
        if (has_next) { if (GATHER) {
#pragma unroll
                for (int h = 0; h < 2; ++h)
#pragma unroll
                    for (int i = 0; i < 2; ++i) rn[h][i] = g.rowidx[nxt.aux + h * HALF + stR[i]]; }
            else PG8_AOFFS(vAn, nxt);
            nA = (const char*)g.A + (GATHER ? (size_t)0 : (size_t)nxt.pm * tstep); nB = (const char*)g.Bt + (size_t)nxt.e * g.bstride_e + (size_t)nxt.pn * tstep; }
        else {
#pragma unroll
            for (int h = 0; h < 2; ++h)
#pragma unroll
                for (int i = 0; i < 2; ++i) vAn[h][i] = vAc[h][i];
        }
#pragma nounroll
        for (int t = 0; t < nt; t += 2) {
            const bool last = (t == nt - 2);
            const char* a1 = cA + (size_t)(t + 1) * kstep;
            const char* a2 = last ? nA : cA + (size_t)(t + 2) * kstep; const char* b2 = last ? nB : cB + (size_t)(t + 2) * kstep;
            const char* a3 = a2 + kstep; const char* b3 = b2 + kstep;
            if (GATHER && last && has_next) { const int _e = nxt.aux >> 14;
                const int _cn = _e == 0 ? cn8[0] : _e == 1 ? cn8[1] : _e == 2 ? cn8[2] : _e == 3 ? cn8[3] : _e == 4 ? cn8[4] : _e == 5 ? cn8[5] : _e == 6 ? cn8[6] : cn8[7];
#pragma unroll
                for (int h = 0; h < 2; ++h)
#pragma unroll
                    for (int i = 0; i < 2; ++i) { int r_ = rn[h][i]; asm volatile("" : "+v"(r_)); const int _loc = (nxt.aux & 16383) + h * HALF + stR[i];
                        r_ = _loc < _cn ? r_ : 0; vAn[h][i] = (unsigned)(r_ * K + stC[i]) * 2u; } }
            unsigned v2[2][2];
#pragma unroll
            for (int h = 0; h < 2; ++h)
#pragma unroll
                for (int i = 0; i < 2; ++i) v2[h][i] = last ? vAn[h][i] : vAc[h][i];
            PG8_LDB(B0, 0, 0); PG8_LDB(B1, 0, 1); PG8_SCHED; PG8_LDA(At, 0, 0); PG8_STAGE(PG8_SA(1, 1), a1, vAc[1]);
            PG8_WAIT_V(8); PG8_WAIT_L(0); PG8_BAR; PG8_MMA(0, 0, At, B0); PG8_MMA(0, 1, At, B1); PG8_MMA_END(At, B0, B1); PG8_BAR; PG8_SCHED;
            PG8_LDA(At, 0, 1); PG8_STAGE(PG8_SB(0, 0), b2, voffB); PG8_STAGE(PG8_SB(0, 1), b2 + hstep, voffB); PG8_STAGE(PG8_SA(0, 0), a2, v2[0]);
            PG8_WAIT_V(8); PG8_WAIT_L(0); PG8_BAR; PG8_MMA(1, 0, At, B0); PG8_MMA(1, 1, At, B1); PG8_MMA_END(At, B0, B1); PG8_BAR; PG8_SCHED;
            PG8_LDB(B0, 1, 0); PG8_LDB(B1, 1, 1); PG8_SCHED; PG8_LDA(At, 1, 0); PG8_STAGE(PG8_SA(0, 1), a2, v2[1]);
            PG8_WAIT_V(8); PG8_WAIT_L(0); PG8_BAR; PG8_MMA(0, 0, At, B0); PG8_MMA(0, 1, At, B1); PG8_MMA_END(At, B0, B1); PG8_BAR; PG8_SCHED;
            PG8_LDA(At, 1, 1); PG8_STAGE(PG8_SB(1, 0), b3, voffB); PG8_STAGE(PG8_SB(1, 1), b3 + hstep, voffB); PG8_STAGE(PG8_SA(1, 0), a3, v2[0]);
            PG8_WAIT_V(8); PG8_WAIT_L(0); PG8_BAR; PG8_MMA(1, 0, At, B0); PG8_MMA(1, 1, At, B1); PG8_MMA_END(At, B0, B1); PG8_BAR; PG8_SCHED;
        }
        if (wr == 0) PG8_BAR;
        if (FP8) asm volatile("s_nop 15\n\ts_nop 15\n\ts_nop 15\n\ts_nop 15\n\ts_nop 15\n\ts_nop 15" ::: "memory");
        if constexpr (!Epi::FUSED) E(acc, cur, wr, wc, fr, fq);
        if (!has_next) break;
#pragma unroll
        for (int a = 0; a < 2; ++a)
#pragma unroll
            for (int b = 0; b < 2; ++b)
#pragma unroll
                for (int m = 0; m < 4; ++m)
#pragma unroll
                    for (int n = 0; n < 2; ++n) acc[a][b][m][n] = (f32x4){0.f, 0.f, 0.f, 0.f};
        cur = nxt; cA = nA; cB = nB; ++ui;
#pragma unroll
        for (int h = 0; h < 2; ++h)
#pragma unroll
            for (int i = 0; i < 2; ++i) vAc[h][i] = vAn[h][i];
        if (wr == 1) PG8_BAR;
    }
    PG8_WAIT_V(0);
    PG8_BAR;
    if constexpr (Epi::FUSED) E.fused(acc, cur, wr, wc, fr, fq, lds, wid, lane);
#undef PG8_SA
#undef PG8_SB
#undef PG8_STAGE
#undef PG8_LDA
#undef PG8_LDB
#undef PG8_MMA
#undef PG8_MMA_END
#undef PG8_WAIT_V
#undef PG8_WAIT_L
#undef PG8_BAR
#undef PG8_SCHED
#undef PG8_AOFFS
}

__device__ __forceinline__ f32x4 ldx16(const float* p) { return *(const f32x4*)p; }
typedef f32x4 Acc[2][2][4][2];
__device__ __forceinline__ u32x4 pack8(const f32x4 a, const f32x4 b) { u32x4 w; w.x = cvt_pk_bf16(a[0], a[1]); w.y = cvt_pk_bf16(a[2], a[3]); w.z = cvt_pk_bf16(b[0], b[1]); w.w = cvt_pk_bf16(b[2], b[3]); return w; }

template <int MODE, bool OUT8 = false, bool SC8 = OUT8> struct EpiPair {
    static constexpr bool FUSED = false;
    bf16_t* O; int ldo;
    __device__ __forceinline__ void operator()(const Acc& acc, const Unit& u, int wr, int wc, int fr, int fq) const {
        const int row0 = u.pm * BM + wr * 64 + fr, col0 = u.pn * HALF + wc * 32 + 8 * fq;
#pragma unroll
        for (int ai = 0; ai < 2; ++ai)
#pragma unroll
            for (int m = 0; m < 4; ++m) { f32x4 r0, r1;
#pragma unroll
                for (int e = 0; e < 4; ++e) { const float sc8 = SC8 ? W8_INV : 1.0f; const float a0 = acc[ai][0][m][0][e] * sc8, a1 = acc[ai][0][m][1][e] * sc8, b0 = acc[ai][1][m][0][e] * sc8, b1 = acc[ai][1][m][1][e] * sc8;
                    r0[e] = (MODE == 1 ? silu_f(a0) : a0) * b0; r1[e] = (MODE == 1 ? silu_f(a1) : a1) * b1; }
                if (OUT8) { u32x2 w; int t0 = 0, t1 = 0; t0 = __builtin_amdgcn_cvt_pk_fp8_f32(r0[0], r0[1], t0, false); t0 = __builtin_amdgcn_cvt_pk_fp8_f32(r0[2], r0[3], t0, true);
                    t1 = __builtin_amdgcn_cvt_pk_fp8_f32(r1[0], r1[1], t1, false); t1 = __builtin_amdgcn_cvt_pk_fp8_f32(r1[2], r1[3], t1, true); w.x = (unsigned)t0; w.y = (unsigned)t1;
                    *(u32x2*)((unsigned char*)O + (size_t)(row0 + ai * HALF + m * 16) * ldo + col0) = w; }
                else *(u32x4*)(O + (size_t)(row0 + ai * HALF + m * 16) * ldo + col0) = pack8(r0, r1); }
    }
};
struct EpiConvIn {
    static constexpr bool FUSED = false;
    bf16_t* UB;
    __device__ __forceinline__ void operator()(const Acc& acc, const Unit& u, int wr, int wc, int fr, int fq) const {
        const int row0 = u.pm * BM + wr * 64 + fr;
        if (u.pn < 8) { EpiPair<0, false, false> P{UB, 2048}; P(acc, u, wr, wc, fr, fq); }
        else { const int col0 = 1024 + (u.pn - 8) * BM + wc * 32 + 8 * fq;
#pragma unroll
            for (int ai = 0; ai < 2; ++ai)
#pragma unroll
                for (int m = 0; m < 4; ++m)
#pragma unroll
                    for (int bj = 0; bj < 2; ++bj) *(u32x4*)(UB + (size_t)(row0 + ai * HALF + m * 16) * 2048 + col0 + bj * HALF) = pack8(acc[ai][bj][m][0], acc[ai][bj][m][1]); }
    }
};
struct EpiRes {
    static constexpr bool FUSED = false;
    float* X; const float* gate; const float* Xin; float asc;
    __device__ __forceinline__ void operator()(const Acc& acc, const Unit& u, int wr, int wc, int fr, int fq) const {
        const int row0 = u.pm * BM + wr * 64 + fr, col0 = u.pn * BM + wc * 32 + 8 * fq; const int b = (u.pm * BM) / SEQ;
        f32x4 gv[2][2];
#pragma unroll
        for (int bj = 0; bj < 2; ++bj)
#pragma unroll
            for (int n = 0; n < 2; ++n) gv[bj][n] = *(const f32x4*)(gate + (size_t)b * 6144 + col0 + bj * HALF + 4 * n) * asc;
#pragma unroll
        for (int ai = 0; ai < 2; ++ai) {
            f32x4 xv[4][2][2];
#pragma unroll
            for (int m = 0; m < 4; ++m) { const float* ri = Xin + (size_t)(row0 + ai * HALF + m * 16) * DM + col0;
#pragma unroll
                for (int bj = 0; bj < 2; ++bj)
#pragma unroll
                    for (int n = 0; n < 2; ++n) xv[m][bj][n] = ldx16(ri + bj * HALF + 4 * n); }
            asm volatile("" ::: "memory");
#pragma unroll
            for (int m = 0; m < 4; ++m) { float* rp = X + (size_t)(row0 + ai * HALF + m * 16) * DM + col0;
#pragma unroll
                for (int bj = 0; bj < 2; ++bj)
#pragma unroll
                    for (int n = 0; n < 2; ++n) *(f32x4*)(rp + bj * HALF + 4 * n) = xv[m][bj][n] + gv[bj][n] * acc[ai][bj][m][n]; }
            asm volatile("" ::: "memory");
        }
    }
};
struct EpiResNorm {
    static constexpr bool FUSED = true;
    float* X; const float* gate; const float* Xin; const float* ng; const float* shb; bf16_t* H; float* xs; gu32* cnt; gu32* tmo; float asc; int h8;
    __device__ __forceinline__ void fused(Acc& acc, const Unit& u, int wr, int wc, int fr, int fq, LAS unsigned char* lds, int wid, int lane) const {
        const int row0 = u.pm * BM + wr * 64 + fr, col0 = u.pn * BM + wc * 32 + 8 * fq; const int b = (u.pm * BM) / SEQ;
        LAS float* P = (LAS float*)lds; LAS float* S = (LAS float*)(lds + 4096);
        { f32x4 gv[2][2];
#pragma unroll
          for (int bj = 0; bj < 2; ++bj)
#pragma unroll
              for (int n = 0; n < 2; ++n) gv[bj][n] = *(const f32x4*)(gate + (size_t)b * 6144 + col0 + bj * HALF + 4 * n) * asc;
#pragma unroll
          for (int ai = 0; ai < 2; ++ai) {
              f32x4 xv[4][2][2];
#pragma unroll
              for (int m = 0; m < 4; ++m) { const float* ri = Xin + (size_t)(row0 + ai * HALF + m * 16) * DM + col0;
#pragma unroll
                  for (int bj = 0; bj < 2; ++bj)
#pragma unroll
                      for (int n = 0; n < 2; ++n) xv[m][bj][n] = ldx16(ri + bj * HALF + 4 * n); }
              asm volatile("" ::: "memory");
#pragma unroll
              for (int m = 0; m < 4; ++m) { float* rp = X + (size_t)(row0 + ai * HALF + m * 16) * DM + col0; float ss = 0.f;
#pragma unroll
                  for (int bj = 0; bj < 2; ++bj)
#pragma unroll
                      for (int n = 0; n < 2; ++n) { const f32x4 x = xv[m][bj][n] + gv[bj][n] * acc[ai][bj][m][n]; acc[ai][bj][m][n] = x; *(f32x4*)(rp + bj * HALF + 4 * n) = x;
                          ss += (x[0] * x[0] + x[1] * x[1]) + (x[2] * x[2] + x[3] * x[3]); }
                  ss += __shfl_xor(ss, 16); ss += __shfl_xor(ss, 32);
                  if (fq == 0) P[(ai * HALF + wr * 64 + m * 16 + fr) * 4 + wc] = ss; }
              asm volatile("" ::: "memory");
          } }
        asm volatile("s_waitcnt lgkmcnt(0)" ::: "memory"); __builtin_amdgcn_s_barrier(); asm volatile("" ::: "memory");
        const int tid = wid * 64 + lane;
        if (tid < 256) { const f32x4 p4 = *(const LAS f32x4*)(P + tid * 4); const float sp = (p4[0] + p4[1]) + (p4[2] + p4[3]);
            __hip_atomic_store((gu32*)xs + ((size_t)(u.pm * BM + tid) * 4 + u.pn), __float_as_uint(sp), RLX_AGENT); }
        asm volatile("s_waitcnt vmcnt(0)" ::: "memory");
        if (wid < 4 && lane == 0) __hip_atomic_fetch_add(cnt + 64 * u.pm, 1u, RLX_AGENT);
        if (wid == 0) { unsigned spins = 0;
            while ((unsigned)__builtin_amdgcn_readfirstlane(__hip_atomic_load(cnt + 64 * u.pm, RLX_AGENT)) < 16u) { __builtin_amdgcn_s_sleep(2);
                if (++spins > (1u << 20)) { if (lane == 0) __hip_atomic_store(tmo, 1u, RLX_AGENT); break; } } }
        asm volatile("s_waitcnt vmcnt(0) lgkmcnt(0)" ::: "memory"); __builtin_amdgcn_s_barrier(); asm volatile("" ::: "memory");
        if (tid < 256) { const GAS unsigned long long* q = (const GAS unsigned long long*)xs + (size_t)(u.pm * BM + tid) * 2;
            const unsigned long long a = __hip_atomic_load(q, RLX_AGENT), c = __hip_atomic_load(q + 1, RLX_AGENT);
            const float tot = (__uint_as_float((unsigned)a) + __uint_as_float((unsigned)(a >> 32))) + (__uint_as_float((unsigned)c) + __uint_as_float((unsigned)(c >> 32)));
            S[tid] = 1.0f / sqrtf(tot * (1.0f / DM) + EPS); }
        asm volatile("s_waitcnt vmcnt(0) lgkmcnt(0)" ::: "memory"); __builtin_amdgcn_s_barrier(); asm volatile("" ::: "memory");
        f32x4 gm[2][2], sf[2][2];
#pragma unroll
        for (int bj = 0; bj < 2; ++bj)
#pragma unroll
            for (int n = 0; n < 2; ++n) { const int c = col0 + bj * HALF + 4 * n; const f32x4 g4 = *(const f32x4*)(ng + c), s1 = *(const f32x4*)(shb + (size_t)b * 6144 + DM + c);
                gm[bj][n] = g4 * (s1 + 1.0f); sf[bj][n] = *(const f32x4*)(shb + (size_t)b * 6144 + c); }
#pragma unroll
        for (int ai = 0; ai < 2; ++ai)
#pragma unroll
            for (int m = 0; m < 4; ++m) { const float r = S[ai * HALF + wr * 64 + m * 16 + fr]; bf16_t* hp = H + (size_t)(row0 + ai * HALF + m * 16) * DM + col0;
#pragma unroll
                for (int bj = 0; bj < 2; ++bj) { const f32x4 h0 = (acc[ai][bj][m][0] * r) * gm[bj][0] + sf[bj][0], h1 = (acc[ai][bj][m][1] * r) * gm[bj][1] + sf[bj][1];
                    if (F1L0_FP8 && h8) { int t0 = 0, t1 = 0; t0 = __builtin_amdgcn_cvt_pk_fp8_f32(h0[0], h0[1], t0, false); t0 = __builtin_amdgcn_cvt_pk_fp8_f32(h0[2], h0[3], t0, true);
                        t1 = __builtin_amdgcn_cvt_pk_fp8_f32(h1[0], h1[1], t1, false); t1 = __builtin_amdgcn_cvt_pk_fp8_f32(h1[2], h1[3], t1, true); u32x2 w; w.x = (unsigned)t0; w.y = (unsigned)t1;
                        *(u32x2*)((unsigned char*)H + (size_t)(row0 + ai * HALF + m * 16) * DM + col0 + bj * HALF) = w; }
                    else *(u32x4*)(hp + bj * HALF) = pack8(h0, h1); } }
    }
};
struct EpiResNormRouter {
    static constexpr bool FUSED = true;
    float* X; const float* gate; const float* ng; const float* shb; bf16_t* H; float* xs9; gu32* cnt; gu32* tmo;
    const float* rw; const float* rb; gu32* ecnt; unsigned char* meta; int h8;
    __device__ __forceinline__ void fused(Acc& acc, const Unit& u, int wr, int wc, int fr, int fq, LAS unsigned char* lds, int wid, int lane) const {
        const int row0 = u.pm * BM + wr * 64 + fr, col0 = u.pn * BM + wc * 32 + 8 * fq; const int b = (u.pm * BM) / SEQ; const int tid = wid * 64 + lane;
        LAS float* P9 = (LAS float*)lds; LAS float* RWT = (LAS float*)(lds + 36864); LAS float* S = (LAS float*)(lds + 45056); LAS float* CE = (LAS float*)(lds + 46080);
        LAS int* rE = (LAS int*)(lds + 46144); LAS float* red = (LAS float*)(lds + 47360);
        const float* shp = shb + (size_t)b * 6144;
        for (int i = tid; i < 2048; i += NTHREADS) { const int c = i >> 3, e = i & 7; RWT[e * 256 + c] = rw[(size_t)(u.pn * BM + c) * 8 + e]; }
        { float ce[8]; const float s0 = shp[tid], s1 = shp[tid + 512];
#pragma unroll
          for (int e = 0; e < 8; ++e) ce[e] = wave_sum(s0 * rw[(size_t)tid * 8 + e] + s1 * rw[(size_t)(tid + 512) * 8 + e]);
          if (lane == 0) {
#pragma unroll
              for (int e = 0; e < 8; ++e) red[wid * 8 + e] = ce[e]; } }
        { f32x4 gv[2][2];
#pragma unroll
          for (int bj = 0; bj < 2; ++bj)
#pragma unroll
              for (int n = 0; n < 2; ++n) gv[bj][n] = *(const f32x4*)(gate + (size_t)b * 6144 + col0 + bj * HALF + 4 * n);
#pragma unroll
          for (int ai = 0; ai < 2; ++ai) {
              f32x4 xv[4][2][2];
#pragma unroll
              for (int m = 0; m < 4; ++m) { const float* ri = X + (size_t)(row0 + ai * HALF + m * 16) * DM + col0;
#pragma unroll
                  for (int bj = 0; bj < 2; ++bj)
#pragma unroll
                      for (int n = 0; n < 2; ++n) xv[m][bj][n] = ldx16(ri + bj * HALF + 4 * n); }
              asm volatile("" ::: "memory");
#pragma unroll
              for (int m = 0; m < 4; ++m) { float* rp = X + (size_t)(row0 + ai * HALF + m * 16) * DM + col0; float ss = 0.f;
#pragma unroll
                  for (int bj = 0; bj < 2; ++bj)
#pragma unroll
                      for (int n = 0; n < 2; ++n) { const f32x4 x = xv[m][bj][n] + gv[bj][n] * acc[ai][bj][m][n]; acc[ai][bj][m][n] = x; *(f32x4*)(rp + bj * HALF + 4 * n) = x;
                          ss += (x[0] * x[0] + x[1] * x[1]) + (x[2] * x[2] + x[3] * x[3]); }
                  ss += __shfl_xor(ss, 16); ss += __shfl_xor(ss, 32);
                  if (fq == 0) P9[((ai * HALF + wr * 64 + m * 16 + fr) * 4 + wc) * 9] = ss; }
              asm volatile("" ::: "memory");
          } }
        f32x4 sf[2][2];
#pragma unroll
        for (int bj = 0; bj < 2; ++bj)
#pragma unroll
            for (int n = 0; n < 2; ++n) { const int c = col0 + bj * HALF + 4 * n; const f32x4 gm = *(const f32x4*)(ng + c) * (*(const f32x4*)(shp + DM + c) + 1.0f); sf[bj][n] = *(const f32x4*)(shp + c);
#pragma unroll
                for (int ai = 0; ai < 2; ++ai)
#pragma unroll
                    for (int m = 0; m < 4; ++m) acc[ai][bj][m][n] = acc[ai][bj][m][n] * gm; }
        asm volatile("s_waitcnt lgkmcnt(0)" ::: "memory"); __builtin_amdgcn_s_barrier(); asm volatile("" ::: "memory");
        if (tid < 8) { float c = rb[tid];
#pragma unroll
            for (int w = 0; w < 8; ++w) c += red[w * 8 + tid];
            CE[tid] = c; }
#pragma unroll
        for (int e = 0; e < 8; ++e) { f32x4 rwe[2][2];
#pragma unroll
            for (int bj = 0; bj < 2; ++bj)
#pragma unroll
                for (int n = 0; n < 2; ++n) rwe[bj][n] = *(const LAS f32x4*)(RWT + e * 256 + bj * HALF + wc * 32 + 8 * fq + 4 * n);
#pragma unroll
            for (int ai = 0; ai < 2; ++ai)
#pragma unroll
                for (int m = 0; m < 4; ++m) { float a = 0.f;
#pragma unroll
                    for (int bj = 0; bj < 2; ++bj)
#pragma unroll
                        for (int n = 0; n < 2; ++n) { const f32x4 x = acc[ai][bj][m][n], w4 = rwe[bj][n]; a += (x[0] * w4[0] + x[1] * w4[1]) + (x[2] * w4[2] + x[3] * w4[3]); }
                    a += __shfl_xor(a, 16); a += __shfl_xor(a, 32);
                    if (fq == 0) P9[((ai * HALF + wr * 64 + m * 16 + fr) * 4 + wc) * 9 + 1 + e] = a; } }
        asm volatile("s_waitcnt lgkmcnt(0)" ::: "memory"); __builtin_amdgcn_s_barrier(); asm volatile("" ::: "memory");
        if (tid < 256) { gu32* q = (gu32*)xs9 + ((size_t)(u.pm * BM + tid) * 4 + u.pn) * 9;
#pragma unroll
            for (int k = 0; k < 9; ++k) { const float v = (P9[(tid * 4 + 0) * 9 + k] + P9[(tid * 4 + 1) * 9 + k]) + (P9[(tid * 4 + 2) * 9 + k] + P9[(tid * 4 + 3) * 9 + k]);
                __hip_atomic_store(q + k, __float_as_uint(v), RLX_AGENT); } }
        asm volatile("s_waitcnt vmcnt(0)" ::: "memory");
        if (wid < 4 && lane == 0) __hip_atomic_fetch_add(cnt + 64 * u.pm, 1u, RLX_AGENT);
        if (wid == 0) { unsigned spins = 0;
            while ((unsigned)__builtin_amdgcn_readfirstlane(__hip_atomic_load(cnt + 64 * u.pm, RLX_AGENT)) < 16u) { __builtin_amdgcn_s_sleep(2);
                if (++spins > (1u << 20)) { if (lane == 0) __hip_atomic_store(tmo, 1u, RLX_AGENT); break; } } }
        asm volatile("s_waitcnt vmcnt(0) lgkmcnt(0)" ::: "memory"); __builtin_amdgcn_s_barrier(); asm volatile("" ::: "memory");
        if (tid < 256) { const gu32* q = (const gu32*)xs9 + (size_t)(u.pm * BM + tid) * 36; float tot[9];
#pragma unroll
            for (int k = 0; k < 9; ++k) tot[k] = (__uint_as_float(__hip_atomic_load(q + k, RLX_AGENT)) + __uint_as_float(__hip_atomic_load(q + 9 + k, RLX_AGENT)))
                                               + (__uint_as_float(__hip_atomic_load(q + 18 + k, RLX_AGENT)) + __uint_as_float(__hip_atomic_load(q + 27 + k, RLX_AGENT)));
            const float r = 1.0f / sqrtf(tot[0] * (1.0f / DM) + EPS); S[tid] = r;
            if (wid == u.pn) {
                float lg[8];
#pragma unroll
                for (int e = 0; e < 8; ++e) lg[e] = r * tot[1 + e] + CE[e];
                int e0 = 0; float l0 = lg[0];
#pragma unroll
                for (int e = 1; e < 8; ++e) if (lg[e] > l0) { l0 = lg[e]; e0 = e; }
                int e1 = -1; float l1 = -3.0e38f;
#pragma unroll
                for (int e = 0; e < 8; ++e) if (e != e0 && lg[e] > l1) { l1 = lg[e]; e1 = e; }
                const float g0 = 1.0f / (1.0f + __expf(l1 - l0)), g1 = 1.0f - g0;
                int cmine = 0, r0 = 0, r1 = 0;
#pragma unroll
                for (int e = 0; e < 8; ++e) { const unsigned long long m0 = __ballot(e0 == e), m1 = __ballot(e1 == e);
                    const int below = (int)__builtin_amdgcn_mbcnt_hi((unsigned)(m0 >> 32), __builtin_amdgcn_mbcnt_lo((unsigned)m0, 0u)) + (int)__builtin_amdgcn_mbcnt_hi((unsigned)(m1 >> 32), __builtin_amdgcn_mbcnt_lo((unsigned)m1, 0u));
                    if (e0 == e) r0 = below; if (e1 == e) r1 = below; if (lane == e) cmine = __popcll(m0) + __popcll(m1); }
                unsigned base = 0u; if (lane < 8 && cmine) base = __hip_atomic_fetch_add(ecnt + 64 * lane, (unsigned)cmine, RLX_AGENT);
                const int p0 = (int)__shfl(base, e0) + r0, p1 = (int)__shfl(base, e1) + r1, grow = u.pm * BM + 64 * u.pn + lane;
                gu32* ri = (gu32*)(meta + WS_ROWIDX_B); gu32* gp = (gu32*)(meta + WS_GATEP_B); gu32* sl = (gu32*)(meta + WS_SLOT_B);
                __hip_atomic_store(ri + e0 * 16384 + p0, (unsigned)grow, RLX_AGENT); __hip_atomic_store(ri + e1 * 16384 + p1, (unsigned)grow, RLX_AGENT);
                __hip_atomic_store(gp + e0 * 16384 + p0, __float_as_uint(g0), RLX_AGENT); __hip_atomic_store(gp + e1 * 16384 + p1, __float_as_uint(g1), RLX_AGENT);
                __hip_atomic_store(sl + grow * 2, (unsigned)((e0 << 16) | p0), RLX_AGENT); __hip_atomic_store(sl + grow * 2 + 1, (unsigned)((e1 << 16) | p1), RLX_AGENT); } }
        asm volatile("s_waitcnt vmcnt(0) lgkmcnt(0)" ::: "memory"); __builtin_amdgcn_s_barrier(); asm volatile("" ::: "memory");
#pragma unroll
        for (int ai = 0; ai < 2; ++ai)
#pragma unroll
            for (int m = 0; m < 4; ++m) { const float r = S[ai * HALF + wr * 64 + m * 16 + fr]; bf16_t* hp = H + (size_t)(row0 + ai * HALF + m * 16) * DM + col0;
#pragma unroll
                for (int bj = 0; bj < 2; ++bj) { const f32x4 h0 = acc[ai][bj][m][0] * r + sf[bj][0], h1 = acc[ai][bj][m][1] * r + sf[bj][1];
                    if ((M1_FP8 || M1L1_FP8) && h8) { int t0 = 0, t1 = 0; t0 = __builtin_amdgcn_cvt_pk_fp8_f32(h0[0], h0[1], t0, false); t0 = __builtin_amdgcn_cvt_pk_fp8_f32(h0[2], h0[3], t0, true);
                        t1 = __builtin_amdgcn_cvt_pk_fp8_f32(h1[0], h1[1], t1, false); t1 = __builtin_amdgcn_cvt_pk_fp8_f32(h1[2], h1[3], t1, true); u32x2 w; w.x = (unsigned)t0; w.y = (unsigned)t1;
                        *(u32x2*)((unsigned char*)H + (size_t)(row0 + ai * HALF + m * 16) * DM + col0 + bj * HALF) = w; }
                    else *(u32x4*)(hp + bj * HALF) = pack8(h0, h1); } }
    }
};
struct EpiGluRes {
    static constexpr bool FUSED = false;
    float* X; const float* gate;
    __device__ __forceinline__ void operator()(const Acc& acc, const Unit& u, int wr, int wc, int fr, int fq) const {
        const int row0 = u.pm * BM + wr * 64 + fr, col0 = u.pn * HALF + wc * 32 + 8 * fq; const int b = (u.pm * BM) / SEQ;
        f32x4 gv[2];
#pragma unroll
        for (int n = 0; n < 2; ++n) gv[n] = *(const f32x4*)(gate + (size_t)b * 6144 + col0 + 4 * n);
        f32x4 xv[2][4][2];
#pragma unroll
        for (int ai = 0; ai < 2; ++ai)
#pragma unroll
            for (int m = 0; m < 4; ++m)
#pragma unroll
                for (int n = 0; n < 2; ++n) xv[ai][m][n] = ldx16(X + (size_t)(row0 + ai * HALF + m * 16) * DM + col0 + 4 * n);
        asm volatile("" ::: "memory");
#pragma unroll
        for (int ai = 0; ai < 2; ++ai)
#pragma unroll
            for (int m = 0; m < 4; ++m) { float* rp = X + (size_t)(row0 + ai * HALF + m * 16) * DM + col0;
#pragma unroll
                for (int n = 0; n < 2; ++n) { f32x4 x = xv[ai][m][n]; const f32x4 l = acc[ai][0][m][n], gg = acc[ai][1][m][n];
#pragma unroll
                    for (int e = 0; e < 4; ++e) x[e] += gv[n][e] * l[e] * sigmoid_f(gg[e]);
                    *(f32x4*)(rp + 4 * n) = x; } }
    }
};
struct EpiAttnIn {
    static constexpr bool FUSED = false;
    bf16_t *Q, *Kn, *V, *QI, *KI; float* WI; const float *qg, *kg;
    __device__ __forceinline__ void operator()(const Acc& acc, const Unit& u, int wr, int wc, int fr, int fq) const {
        const int row0 = u.pm * BM + wr * 64 + fr;
        if (u.pn < 5) {
            const bool isq = u.pn < 4; const float* gp = isq ? qg : kg; const float sc = isq ? 0.125f : 1.0f;
            f32x4 gn[2][2];
#pragma unroll
            for (int bj = 0; bj < 2; ++bj)
#pragma unroll
                for (int n = 0; n < 2; ++n) gn[bj][n] = *(const f32x4*)(gp + 32 * bj + 8 * fq + 4 * n) * sc;
            bf16_t* base = isq ? (Q + (size_t)(4 * u.pn + wc) * 64) : (Kn + (size_t)wc * 64); const int ldo = isq ? 1024 : 256;
#pragma unroll
            for (int ai = 0; ai < 2; ++ai)
#pragma unroll
                for (int m = 0; m < 4; ++m) { float ss = 0.f;
#pragma unroll
                    for (int bj = 0; bj < 2; ++bj)
#pragma unroll
                        for (int n = 0; n < 2; ++n) { const f32x4 x = acc[ai][bj][m][n]; ss += (x[0] * x[0] + x[1] * x[1]) + (x[2] * x[2] + x[3] * x[3]); }
                    ss += __shfl_xor(ss, 16); ss += __shfl_xor(ss, 32);
                    const float r = 1.0f / sqrtf(ss * (1.0f / 64.0f) + EPS);
#pragma unroll
                    for (int bj = 0; bj < 2; ++bj) *(u32x4*)(base + (size_t)(row0 + ai * HALF + m * 16) * ldo + 32 * bj + 8 * fq) = pack8(acc[ai][bj][m][0] * r * gn[bj][0], acc[ai][bj][m][1] * r * gn[bj][1]); }
        } else if (u.pn < 8) {
            bf16_t* base = (u.pn == 5) ? V : QI + (size_t)(u.pn - 6) * 256; const int ldo = (u.pn == 5) ? 256 : 512; const int col0 = wc * 32 + 8 * fq;
#pragma unroll
            for (int ai = 0; ai < 2; ++ai)
#pragma unroll
                for (int m = 0; m < 4; ++m)
#pragma unroll
                    for (int bj = 0; bj < 2; ++bj) *(u32x4*)(base + (size_t)(row0 + ai * HALF + m * 16) * ldo + col0 + bj * HALF) = pack8(acc[ai][bj][m][0], acc[ai][bj][m][1]);
        } else {
            if (wc < 2) {
#pragma unroll
                for (int ai = 0; ai < 2; ++ai)
#pragma unroll
                    for (int m = 0; m < 4; ++m) *(u32x4*)(KI + (size_t)(row0 + ai * HALF + m * 16) * 64 + wc * 32 + 8 * fq) = pack8(acc[ai][0][m][0], acc[ai][0][m][1]);
            } else if (wc == 2 && fq == 0) {
                const float s = 0.04419417382415922f;
#pragma unroll
                for (int ai = 0; ai < 2; ++ai)
#pragma unroll
                    for (int m = 0; m < 4; ++m) { float* wp = WI + (size_t)(row0 + ai * HALF + m * 16) * 8; *(f32x4*)wp = acc[ai][0][m][0] * s; *(f32x4*)(wp + 4) = acc[ai][0][m][1] * s; }
            }
        }
    }
};
struct EpiMoeDn {
    static constexpr bool FUSED = false;
    bf16_t* Y; const float* gatep;
    __device__ __forceinline__ void operator()(const Acc& acc, const Unit& u, int wr, int wc, int fr, int fq) const {
        const int row0 = u.pm * BM + wr * 64 + fr, col0 = u.pn * BM + wc * 32 + 8 * fq;
#pragma unroll
        for (int ai = 0; ai < 2; ++ai)
#pragma unroll
            for (int m = 0; m < 4; ++m) { const float gt = gatep[u.aux + ai * HALF + wr * 64 + m * 16 + fr] * (M2_FP8 ? W8_INV : 1.0f);
#pragma unroll
                for (int bj = 0; bj < 2; ++bj) *(u32x4*)(Y + (size_t)(row0 + ai * HALF + m * 16) * DM + col0 + bj * HALF) = pack8(acc[ai][bj][m][0] * gt, acc[ai][bj][m][1] * gt); }
    }
};
}

constexpr size_t MiB = 1u << 20;
constexpr size_t WS_CTL = 0, CTL_ZERO_BYTES = 1 * MiB;
constexpr size_t WS_MOD = 1 * MiB;
constexpr size_t WS_ROWIDX = 2 * MiB;
constexpr size_t WS_GATEP = 2 * MiB + 512 * 1024;
constexpr size_t WS_SLOT = 3 * MiB;
static_assert(WS_ROWIDX_B == WS_ROWIDX && WS_GATEP_B == WS_GATEP && WS_SLOT_B == WS_SLOT, "metadata offsets");
constexpr size_t WS_WCI = 8 * MiB;
constexpr size_t WS_WCO = 20 * MiB;
constexpr size_t WS_WAI = 24 * MiB;
constexpr size_t WS_WAO = 29 * MiB;
constexpr size_t WS_WGL = 31 * MiB;
constexpr size_t WS_WFG = 35 * MiB;
constexpr size_t WS_WFD = 57 * MiB;
constexpr size_t WS_WMG = 68 * MiB;
constexpr size_t WS_WMD = 244 * MiB;
constexpr size_t WS_HB = 332 * MiB;
constexpr size_t WS_BUF = 364 * MiB;
constexpr size_t WS_ACT = 432 * MiB;
constexpr size_t WS_END = 619 * MiB;
constexpr int MOE_ROWS = 2 * M + NEXP * 256;
constexpr size_t WS_Q = WS_BUF, WS_K = WS_BUF + 32 * MiB, WS_V = WS_BUF + 40 * MiB, WS_QI = WS_BUF + 48 * MiB;
constexpr size_t WS_SC = WS_ACT, WS_O = WS_ACT + 128 * MiB, WS_KI = WS_ACT + 160 * MiB, WS_WI = WS_ACT + 162 * MiB;
static_assert(WS_WMD + (size_t)16 * 1024 * 2816 * 2 <= WS_HB && WS_ACT + (size_t)MOE_ROWS * FF * 2 <= WS_END && WS_BUF + (size_t)MOE_ROWS * DM * 2 <= WS_ACT, "d_ws map");
constexpr int CW_TMO = 0;
constexpr int CW_CNT = 64;
constexpr int CW_BAR = 4096;
constexpr int CW_PAN = 16384;
constexpr size_t WS_XS9 = 5 * MiB + 768 * 1024;
constexpr size_t WS_XS = 5 * MiB + 512 * 1024;

constexpr int RING_BYTES = 131072;
constexpr int LDSCTL_OFF = RING_BYTES, MISC_OFF = LDSCTL_OFF + 320;
constexpr int LDS_BYTES = 147456;

#define XB_TMO      128
#define XB_XCNT(j)  (256  + 64 * (j))
#define XB_XSUB(j)  (1280 + 64 * (j))
#define XB_XGEN(j)  (2304 + 64 * (j))
#define XB_TOP      3328
#define XB_TOPGEN   3392
#define XCD_BAR_WORDS 3456
#define XB_SPIN_CAP (1u << 18)
__device__ __forceinline__ unsigned xb_ld(unsigned* p)              { return __hip_atomic_load(p, __ATOMIC_RELAXED, __HIP_MEMORY_SCOPE_AGENT); }
__device__ __forceinline__ unsigned xb_add(unsigned* p, unsigned v) { return __hip_atomic_fetch_add(p, v, __ATOMIC_RELAXED, __HIP_MEMORY_SCOPE_AGENT); }
__device__ __forceinline__ unsigned xb_xcc_id() { return (unsigned)__builtin_amdgcn_s_getreg((3 << 11) | 20) & 0xFu; }
#define XB_SPIN(cond, bar) do { unsigned _sp = 0; while (cond) { __builtin_amdgcn_s_sleep(1); \
    if ((++_sp & 255u) == 0u) { if (xb_ld(&(bar)[XB_TMO])) break; if (_sp > XB_SPIN_CAP) { atomicAdd(&(bar)[XB_TMO], 1u); break; } } } } while (0)
struct XcdBarrier { unsigned* bar; unsigned x; volatile LAS unsigned* st; int w; };
__device__ __forceinline__ bool xb_thread0(int w) { return w == 0 && lane_id_fresh() == 0; }
__device__ __forceinline__ XcdBarrier xcd_barrier_post(unsigned* bar, volatile LAS unsigned* st, int w) {
    XcdBarrier b; b.bar = bar; b.x = xb_xcc_id(); b.st = st; b.w = w;
    if (xb_thread0(w)) (void)xb_add(&bar[XB_XCNT(b.x)], 1u);
    return b;
}
__device__ __forceinline__ void xcd_barrier_complete(unsigned* bar, unsigned x, unsigned& nloc, unsigned& nx) {
    const unsigned G = gridDim.x * gridDim.y * gridDim.z;
    unsigned sum, cnt, mine, sp = 0u;
    for (;;) {
        sum = 0u; cnt = 0u; mine = 0u;
#pragma unroll
        for (unsigned j = 0; j < 16; ++j) { const unsigned c = xb_ld(&bar[XB_XCNT(j)]); sum += c; cnt += (c > 0u) ? 1u : 0u; mine = (j == x) ? c : mine; }
        if (sum == G) break;
        __builtin_amdgcn_s_sleep(1);
        if ((++sp & 255u) == 0u) { if (xb_ld(&bar[XB_TMO])) break; if (sp > XB_SPIN_CAP) { atomicAdd(&bar[XB_TMO], 1u); break; } }
    }
    nloc = mine > 0u ? mine : 1u; nx = cnt > 0u ? cnt : 1u;
}
__device__ __forceinline__ int lane_probe() { return (int)__builtin_amdgcn_mbcnt_hi(~0u, __builtin_amdgcn_mbcnt_lo(~0u, 0u)); }
__device__ __forceinline__ int lane_probe2() { return (int)__builtin_amdgcn_mbcnt_hi(~0u, __builtin_amdgcn_mbcnt_lo(~0u, 0u)); }
__device__ __forceinline__ void xcd_barrier(const XcdBarrier& b) {
    asm volatile("s_waitcnt vmcnt(0)" ::: "memory");
    __syncthreads();
    if (xb_thread0(b.w)) {
        unsigned* bar = b.bar;
        __builtin_amdgcn_s_waitcnt(0);
        unsigned nloc = b.st[0], nx = b.st[1];
        if (nloc == 0u) { xcd_barrier_complete(bar, b.x, nloc, nx); b.st[0] = nloc; b.st[1] = nx; }
        const unsigned old = xb_add(&bar[XB_XSUB(b.x)], 1u);
        const unsigned gen = old / nloc;
        if (old + 1u == (gen + 1u) * nloc) {
            __builtin_amdgcn_fence(__ATOMIC_RELEASE, "agent");
            asm volatile("s_waitcnt vmcnt(0)" ::: "memory");
            const unsigned og = xb_add(&bar[XB_TOP], 1u);
            const unsigned tg = og / nx;
            if (og + 1u == (tg + 1u) * nx) xb_add(&bar[XB_TOPGEN], 1u);
            else XB_SPIN(xb_ld(&bar[XB_TOPGEN]) == tg, bar);
            __builtin_amdgcn_fence(__ATOMIC_ACQUIRE, "agent");
            xb_add(&bar[XB_XGEN(b.x)], 1u);
        } else {
            XB_SPIN(xb_ld(&bar[XB_XGEN(b.x)]) == gen, bar);
            __builtin_amdgcn_fence(__ATOMIC_ACQUIRE, "agent");
        }
    }
    __syncthreads();
}

struct Args { const float* in[28]; float* out; unsigned char* ws; int ph_lo, ph_hi; };
enum { I_X = 0, I_C, I_ADAW, I_ADAB, I_NORMG, I_CWIN, I_CW, I_CWOUT, I_AWIN, I_QG, I_KG, I_AWOUT, I_RELB, I_SLRE, I_SLIM, I_SLOG, I_SBRE, I_SBIM, I_SCRE, I_SCIM, I_SD, I_SGLU,
       I_FGU, I_FDN, I_RW, I_RB, I_MGU, I_MDN };
struct Frame {
    LAS unsigned char* lds; unsigned char* ws; gu32* ctl;
    int tid, lane, wave, vcu, G;
    float* out; const float* mod;
    bf16_t *HB, *BUF, *ACT;
};

enum { MAP_NAT = 0, MAP_PAIR = 1, MAP_CONV = 2, MAP_ATTN = 3 };
__device__ __forceinline__ int map_row(int map, int half, int n) {
    if (map == MAP_NAT) return n;
    if (map == MAP_PAIR) { return n < half ? 256 * (n / 128) + (n % 128) : 256 * ((n - half) / 128) + 128 + ((n - half) % 128); }
    if (map == MAP_CONV) { if (n < 1024) return 2048 + n; if (n < 2048) { const int q = n - 1024; return 256 * (q / 128) + (q % 128); } const int q = n - 2048; return 256 * (q / 128) + 128 + (q % 128); }
    if (n < 1280) { const int hd = n / 64, d = n % 64; return 256 * (hd / 4) + 128 * (d / 32) + 32 * (hd % 4) + (d % 32); }
    return n;
}
__device__ __forceinline__ void p0_transpose_item(const float* W, int K, int N, bf16_t* WT, int map, int half, LAS float* scr, int item, int lane) {
    const int nblk = (N + 31) / 32, kb = item / nblk, nb = item % nblk, k0 = 64 * kb, n0 = 32 * nb;
    const bool cin = (n0 + (lane & 31)) < N;
    float tv[32];
#pragma unroll
    for (int i = 0; i < 32; ++i) { const int kk = 2 * i + (lane >> 5); tv[i] = cin ? W[(size_t)(k0 + kk) * N + n0 + (lane & 31)] : 0.f; }
#pragma unroll
    for (int i = 0; i < 32; ++i) { const int kk = 2 * i + (lane >> 5); scr[kk * 33 + (lane & 31)] = tv[i]; }
    LDS_WAIT(); CFENCE();
    const int c = lane & 7; const int r0 = map_row(map, half, n0);
#pragma unroll
    for (int j = 0; j < 4; ++j) { const int n = (lane >> 3) + 8 * j; const LAS float* s = scr + (8 * c) * 33 + n;
        u32x4 o; o.x = pk2(s[0 * 33], s[1 * 33]); o.y = pk2(s[2 * 33], s[3 * 33]); o.z = pk2(s[4 * 33], s[5 * 33]); o.w = pk2(s[6 * 33], s[7 * 33]);
        *(GAS u32x4*)(WT + (size_t)(r0 + n) * K + k0 + 8 * c) = o; }
    LDS_WAIT(); CFENCE();
}
__device__ __forceinline__ void p0_transpose_item8(const float* W, int K, int N, unsigned char* WT, int map, int half, LAS float* scr, int item, int lane, int sub) {
    const int nblk = (N + 31) / 32, kb = 2 * (item / nblk) + sub, nb = item % nblk, k0 = 64 * kb, n0 = 32 * nb;
    float tv[32];
#pragma unroll
    for (int i = 0; i < 32; ++i) { const int kk = 2 * i + (lane >> 5); tv[i] = W[(size_t)(k0 + kk) * N + n0 + (lane & 31)]; }
#pragma unroll
    for (int i = 0; i < 32; ++i) { const int kk = 2 * i + (lane >> 5); scr[kk * 33 + (lane & 31)] = tv[i] * pg8::W8_MUL; }
    LDS_WAIT(); CFENCE();
    const int c = lane & 3; const int r0 = map_row(map, half, n0);
#pragma unroll
    for (int j = 0; j < 2; ++j) { const int n = (lane >> 2) + 16 * j; const LAS float* sp = scr + (16 * c) * 33 + n; u32x4 o;
#pragma unroll
        for (int q = 0; q < 4; ++q) { int t = 0; t = __builtin_amdgcn_cvt_pk_fp8_f32(sp[(4 * q) * 33], sp[(4 * q + 1) * 33], t, false); t = __builtin_amdgcn_cvt_pk_fp8_f32(sp[(4 * q + 2) * 33], sp[(4 * q + 3) * 33], t, true); o[q] = (unsigned)t; }
        *(GAS u32x4*)(WT + (size_t)(r0 + n) * K + k0 + 16 * c) = o; }
    LDS_WAIT(); CFENCE();
}
__device__ __forceinline__ void p0_transpose_item8x2(const float* W, int K, int N, unsigned char* WT, int map, int half, LAS float* scr, int item, int lane) {
    const int nblk = (N + 31) / 32, kb2 = item / nblk, nb = item % nblk, k0 = 128 * kb2, n0 = 32 * nb;
    float ta[32], tb[32];
#pragma unroll
    for (int i = 0; i < 32; ++i) { const int kk = 2 * i + (lane >> 5); ta[i] = W[(size_t)(k0 + kk) * N + n0 + (lane & 31)]; }
#pragma unroll
    for (int i = 0; i < 32; ++i) { const int kk = 2 * i + (lane >> 5); tb[i] = W[(size_t)(k0 + 64 + kk) * N + n0 + (lane & 31)]; }
    const int c = lane & 7; const int r0 = map_row(map, half, n0);
    u32x4 o8[4];
#pragma unroll
    for (int h = 0; h < 2; ++h) {
#pragma unroll
        for (int i = 0; i < 32; ++i) { const int kk = 2 * i + (lane >> 5); scr[kk * 33 + (lane & 31)] = (h ? tb[i] : ta[i]) * pg8::W8_MUL; }
        LDS_WAIT(); CFENCE();
#pragma unroll
        for (int j = 0; j < 4; ++j) { const int n = (lane >> 3) + 8 * j; const LAS float* sp = scr + (16 * (c & 3)) * 33 + n; u32x4 o;
#pragma unroll
            for (int q = 0; q < 4; ++q) { int t = 0; t = __builtin_amdgcn_cvt_pk_fp8_f32(sp[(4 * q) * 33], sp[(4 * q + 1) * 33], t, false); t = __builtin_amdgcn_cvt_pk_fp8_f32(sp[(4 * q + 2) * 33], sp[(4 * q + 3) * 33], t, true); o[q] = (unsigned)t; }
            if ((c >> 2) == h) o8[j] = o; }
        LDS_WAIT(); CFENCE();
    }
#pragma unroll
    for (int j = 0; j < 4; ++j) { const int n = (lane >> 3) + 8 * j; *(GAS u32x4*)(WT + (size_t)(r0 + n) * K + k0 + 16 * c) = o8[j]; }
}
__device__ __forceinline__ void p0_prologue(Frame& F, const Args& A) {
    {
        LAS float* cs = (LAS float*)F.lds;
        LAS float* red = (LAS float*)(F.lds + 16384);
        for (int i = F.tid; i < NB * DM; i += NTHREADS) { const float c = A.in[I_C][i]; cs[i] = c / (1.f + __expf(-c)); }
        __syncthreads();
        const int kg = F.tid >> 6, cj = F.tid & 63;
        for (int un = blockIdx.x; un < 4 * 96; un += F.G) {
            const int l = un / 96, jb = un % 96, j = jb * 64 + cj;
            const float* w = A.in[I_ADAW] + (size_t)l * DM * 6144 + j;
            float a0 = 0.f, a1 = 0.f, a2 = 0.f, a3 = 0.f;
            for (int k0 = kg * 128; k0 < kg * 128 + 128; k0 += 32) { float wv[32];
#pragma unroll
                for (int i = 0; i < 32; ++i) wv[i] = w[(size_t)(k0 + i) * 6144];
#pragma unroll
                for (int i = 0; i < 32; ++i) { const int k = k0 + i; a0 += cs[k] * wv[i]; a1 += cs[1024 + k] * wv[i]; a2 += cs[2048 + k] * wv[i]; a3 += cs[3072 + k] * wv[i]; } }
            *(LAS f32x4*)(red + (kg * 64 + cj) * 4) = (f32x4){a0, a1, a2, a3};
            __syncthreads();
            if (F.tid < 256) { const int b = F.tid >> 6, cc = F.tid & 63; float s = 0.f;
#pragma unroll
                for (int q = 0; q < 8; ++q) s += red[(q * 64 + cc) * 4 + b];
                ((float*)(F.ws + WS_MOD))[((size_t)l * NB + b) * 6144 + jb * 64 + cc] = s + A.in[I_ADAB][l * 6144 + jb * 64 + cc]; }
            __syncthreads();
        }
    }
    LAS float* scr = (LAS float*)(F.lds + 32768 + F.wave * 8704);
    const int gw = F.vcu * NWAVES + F.wave, NGW = F.G * NWAVES;
    constexpr int I_CI = (DM / 64) * (3072 / 32), I_SQ = (DM / 64) * (DM / 32), I_AI = (DM / 64) * ((ATT_N + 31) / 32), I_GL = (DM / 64) * (2048 / 32), I_GU = (DM / 64) * (2 * FF / 32), I_DN = (FF / 128) * (DM / 32), I_DNB = (FF / 64) * (DM / 32), I_GU8 = (DM / 128) * (2 * FF / 32);
    constexpr int NITEMS = 2 * I_CI + 2 * I_SQ + I_AI + I_SQ + I_GL + (F1L0_FP8 ? I_GU8 : I_GU) + I_GU + (F2_FP8 ? 2 * I_DN : ((F2L0_FP8 ? I_DN : I_DNB) + I_DNB)) + 8 * (M1L1_FP8 ? I_GU8 : I_GU) + 8 * (M1_FP8 ? I_GU8 : I_GU) + 16 * (M2_FP8 ? I_DN : I_DNB);
    for (int it = gw; it < NITEMS; it += NGW) {
        int r = it;
        if (r < 2 * I_CI) { const int q = r / I_CI; p0_transpose_item(A.in[I_CWIN] + (size_t)q * DM * 3072, DM, 3072, (bf16_t*)(F.ws + WS_WCI) + (size_t)q * 3072 * DM, MAP_CONV, 0, scr, r % I_CI, F.lane); continue; } r -= 2 * I_CI;
        if (r < 2 * I_SQ) { const int q = r / I_SQ; p0_transpose_item(A.in[I_CWOUT] + (size_t)q * DM * DM, DM, DM, (bf16_t*)(F.ws + WS_WCO) + (size_t)q * DM * DM, MAP_NAT, 0, scr, r % I_SQ, F.lane); continue; } r -= 2 * I_SQ;
        if (r < I_AI) { p0_transpose_item(A.in[I_AWIN], DM, ATT_N, (bf16_t*)(F.ws + WS_WAI), MAP_ATTN, 0, scr, r, F.lane); continue; } r -= I_AI;
        if (r < I_SQ) { p0_transpose_item(A.in[I_AWOUT], DM, DM, (bf16_t*)(F.ws + WS_WAO), MAP_NAT, 0, scr, r, F.lane); continue; } r -= I_SQ;
        if (r < I_GL) { p0_transpose_item(A.in[I_SGLU], DM, 2048, (bf16_t*)(F.ws + WS_WGL), MAP_PAIR, 1024, scr, r, F.lane); continue; } r -= I_GL;
        if (F1L0_FP8) { if (r < I_GU8) { p0_transpose_item8x2(A.in[I_FGU], DM, 2 * FF, (unsigned char*)(F.ws + WS_WFG), MAP_PAIR, FF, scr, r, F.lane); continue; } r -= I_GU8; }
        else { if (r < I_GU) { p0_transpose_item(A.in[I_FGU], DM, 2 * FF, (bf16_t*)(F.ws + WS_WFG), MAP_PAIR, FF, scr, r, F.lane); continue; } r -= I_GU; }
        if (r < I_GU) { p0_transpose_item(A.in[I_FGU] + (size_t)DM * 2 * FF, DM, 2 * FF, (bf16_t*)(F.ws + WS_WFG) + (size_t)2 * FF * DM, MAP_PAIR, FF, scr, r, F.lane); continue; } r -= I_GU;
        if (F2_FP8) { if (r < 2 * I_DN) { const int q = r / I_DN; p0_transpose_item8x2(A.in[I_FDN] + (size_t)q * FF * DM, FF, DM, (unsigned char*)(F.ws + WS_WFD) + (size_t)q * DM * FF, MAP_NAT, 0, scr, r % I_DN, F.lane); continue; } r -= 2 * I_DN; }
        else if (F2L0_FP8) {
            if (r < I_DN) { p0_transpose_item8x2(A.in[I_FDN], FF, DM, (unsigned char*)(F.ws + WS_WFD), MAP_NAT, 0, scr, r, F.lane); continue; } r -= I_DN;
            if (r < I_DNB) { p0_transpose_item(A.in[I_FDN] + (size_t)FF * DM, FF, DM, (bf16_t*)(F.ws + WS_WFD) + (size_t)DM * FF, MAP_NAT, 0, scr, r, F.lane); continue; } r -= I_DNB; }
        else { if (r < 2 * I_DNB) { const int q = r / I_DNB; p0_transpose_item(A.in[I_FDN] + (size_t)q * FF * DM, FF, DM, (bf16_t*)(F.ws + WS_WFD) + (size_t)q * DM * FF, MAP_NAT, 0, scr, r % I_DNB, F.lane); continue; } r -= 2 * I_DNB; }
        if (M1L1_FP8) { if (r < 8 * I_GU8) { const int q = r / I_GU8; unsigned char* dst = (unsigned char*)(F.ws + WS_WMG) + (size_t)q * 2 * FF * DM;
                p0_transpose_item8x2(A.in[I_MGU] + (size_t)q * DM * 2 * FF, DM, 2 * FF, dst, MAP_PAIR, FF, scr, r % I_GU8, F.lane); continue; } r -= 8 * I_GU8; }
        else { if (r < 8 * I_GU) { const int q = r / I_GU; p0_transpose_item(A.in[I_MGU] + (size_t)q * DM * 2 * FF, DM, 2 * FF, (bf16_t*)(F.ws + WS_WMG) + (size_t)q * 2 * FF * DM, MAP_PAIR, FF, scr, r % I_GU, F.lane); continue; } r -= 8 * I_GU; }
        if (M1_FP8) { if (r < 8 * I_GU8) { const int q = 8 + r / I_GU8; unsigned char* dst = (unsigned char*)(F.ws + WS_WMG) + (size_t)8 * 2 * FF * DM * 2 + (size_t)(q - 8) * 2 * FF * DM;
                p0_transpose_item8x2(A.in[I_MGU] + (size_t)q * DM * 2 * FF, DM, 2 * FF, dst, MAP_PAIR, FF, scr, r % I_GU8, F.lane); continue; } r -= 8 * I_GU8; }
        else { if (r < 8 * I_GU) { const int q = 8 + r / I_GU; p0_transpose_item(A.in[I_MGU] + (size_t)q * DM * 2 * FF, DM, 2 * FF, (bf16_t*)(F.ws + WS_WMG) + (size_t)q * 2 * FF * DM, MAP_PAIR, FF, scr, r % I_GU, F.lane); continue; } r -= 8 * I_GU; }
        if (M2_FP8) { const int q = r / I_DN; p0_transpose_item8x2(A.in[I_MDN] + (size_t)q * FF * DM, FF, DM, (unsigned char*)(F.ws + WS_WMD) + (size_t)q * DM * FF, MAP_NAT, 0, scr, r % I_DN, F.lane); }
        else { const int q = r / I_DNB; p0_transpose_item(A.in[I_MDN] + (size_t)q * FF * DM, FF, DM, (bf16_t*)(F.ws + WS_WMD) + (size_t)q * DM * FF, MAP_NAT, 0, scr, r % I_DNB, F.lane); }
    }
    { u32x4* z = (u32x4*)((bf16_t*)(F.ws + WS_WAI) + (size_t)2144 * DM); const int n16 = (ATT_NP - 2144) * DM * 2 / 16;
      for (int i = blockIdx.x * NTHREADS + F.tid; i < n16; i += F.G * NTHREADS) z[i] = (u32x4){0u, 0u, 0u, 0u}; }
}

template <int FLAGS>
__device__ __forceinline__ void thin_phase(Frame& F, const Args& A, const float* src, int nl  , int ns  , int cl  , int rl  , int cs = -1  , size_t roff = 0  ) {
    if (cs < 0) cs = rl;
    const int gw = F.vcu * NWAVES + F.wave, NGW = F.G * NWAVES;
    LAS float* rwt = (LAS float*)F.lds;
    if (FLAGS & 8) {
        const float* rw = A.in[I_RW] + (size_t)rl * DM * NEXP;
        for (int i = F.tid; i < DM * NEXP; i += NTHREADS) rwt[(i & 7) * DM + (i >> 3)] = rw[i];
        __syncthreads();
    }
    int Tb[8];
    if (FLAGS & 2) { int acc = 0;
#pragma unroll
        for (int e = 0; e < 8; ++e) { Tb[e] = acc; acc += (int)((__hip_atomic_load(F.ctl + CW_CNT + 64 * (8 * rl + e), RLX_AGENT) + 255u) >> 8); } }
    const float* ng = A.in[I_NORMG] + (size_t)(nl * 2 + ns) * DM;
    constexpr bool RT = (FLAGS & 8) != 0;
    LAS int* rE = (LAS int*)(F.lds + 32768);
    const int nit = RT ? ((M / 64 - (int)blockIdx.x + F.G - 1) / F.G) * 8 : (M - gw + NGW - 1) / NGW;
    for (int it = 0; it < nit; ++it) {
        const int chunk = (int)blockIdx.x + (it >> 3) * F.G;
        const int row = RT ? chunk * 64 + F.wave * 8 + (it & 7) : gw + it * NGW;
        const int b = row / SEQ;
        f32x4 v[4];
        const f32x4* xr = (const f32x4*)(src + (size_t)row * DM) + F.lane;
#pragma unroll
        for (int j = 0; j < 4; ++j) v[j] = xr[64 * j];
        if (FLAGS & 2) {
            const int s0 = ((const int*)(F.ws + roff + WS_SLOT))[row * 2], s1 = ((const int*)(F.ws + roff + WS_SLOT))[row * 2 + 1];
            int t0 = 0, t1 = 0;
#pragma unroll
            for (int e = 0; e < 8; ++e) { if ((s0 >> 16) == e) t0 = Tb[e]; if ((s1 >> 16) == e) t1 = Tb[e]; }
            const bf16_t* y0 = (const bf16_t*)(F.ws + WS_BUF) + (size_t)(256 * t0 + (s0 & 0xffff)) * DM;
            const bf16_t* y1 = (const bf16_t*)(F.ws + WS_BUF) + (size_t)(256 * t1 + (s1 & 0xffff)) * DM;
            const float* g2 = cl >= 0 ? F.mod + ((size_t)cl * NB + b) * 6144 + 5 * DM : (const float*)(F.ws + 512 * 1024);
#pragma unroll
            for (int j = 0; j < 4; ++j) { const int col = 4 * F.lane + 256 * j; const u32x2 a = *(const u32x2*)(y0 + col), c = *(const u32x2*)(y1 + col); const f32x4 g = *(const f32x4*)(g2 + col);
                v[j][0] += g[0] * (bflo(a.x) + bflo(c.x)); v[j][1] += g[1] * (bfhi(a.x) + bfhi(c.x)); v[j][2] += g[2] * (bflo(a.y) + bflo(c.y)); v[j][3] += g[3] * (bfhi(a.y) + bfhi(c.y)); }
        }
        if (FLAGS & 3) { GAS f32x4* xo = (GAS f32x4*)(F.out + (size_t)row * DM) + F.lane;
#pragma unroll
            for (int j = 0; j < 4; ++j) xo[64 * j] = v[j]; }
        if (FLAGS & 4) {
            float ss = 0.f;
#pragma unroll
            for (int j = 0; j < 4; ++j) ss += (v[j][0] * v[j][0] + v[j][1] * v[j][1]) + (v[j][2] * v[j][2] + v[j][3] * v[j][3]);
            const float r = 1.0f / sqrtf(wave_sum(ss) * (1.0f / DM) + EPS);
            const float* sh = F.mod + ((size_t)nl * NB + b) * 6144 + (ns ? 3 : 0) * DM; const float* sc = sh + DM;
            GAS u32x2* ho = (GAS u32x2*)(F.HB + (size_t)row * DM) + F.lane;
#pragma unroll
            for (int j = 0; j < 4; ++j) { const int col = 4 * F.lane + 256 * j; const f32x4 g = *(const f32x4*)(ng + col), s1 = *(const f32x4*)(sc + col), s0 = *(const f32x4*)(sh + col);
                v[j] = (v[j] * r) * g * (s1 + 1.0f) + s0;
                if ((RT && ((M1_FP8 && nl == 3) || (M1L1_FP8 && nl == 1))) || (FLAGS == 4 && F1L0_FP8 && nl == 0 && ns == 1)) { int t = 0; t = __builtin_amdgcn_cvt_pk_fp8_f32(v[j][0], v[j][1], t, false); t = __builtin_amdgcn_cvt_pk_fp8_f32(v[j][2], v[j][3], t, true);
                    *(unsigned*)((unsigned char*)F.HB + (size_t)row * DM + col) = (unsigned)t; }
                else { u32x2 w; w.x = pk2(v[j][0], v[j][1]); w.y = pk2(v[j][2], v[j][3]); ho[64 * j] = w; } }
            if (FLAGS & 8) {
                float lg[8];
#pragma unroll
                for (int e = 0; e < 8; ++e) { float s = 0.f;
#pragma unroll
                    for (int j = 0; j < 4; ++j) { const f32x4 w = *(const LAS f32x4*)(rwt + e * DM + 4 * F.lane + 256 * j); s += (v[j][0] * w[0] + v[j][1] * w[1]) + (v[j][2] * w[2] + v[j][3] * w[3]); }
                    lg[e] = wave_sum(s) + A.in[I_RB][rl * NEXP + e]; }
                int e0 = 0; float l0 = lg[0];
#pragma unroll
                for (int e = 1; e < 8; ++e) if (lg[e] > l0) { l0 = lg[e]; e0 = e; }
                int e1 = -1; float l1 = -3.0e38f;
#pragma unroll
                for (int e = 0; e < 8; ++e) if (e != e0 && lg[e] > l1) { l1 = lg[e]; e1 = e; }
                const float g0 = 1.0f / (1.0f + __expf(l1 - l0)), g1 = 1.0f - g0;
                const int lr = F.wave * 8 + (it & 7);
                if (F.lane == 0) { rE[lr] = e0; rE[64 + lr] = e1; rE[128 + lr] = __float_as_int(g0); rE[192 + lr] = __float_as_int(g1); }
            }
        }
        if (RT && (it & 7) == 7) {
            __syncthreads();
            if (F.tid < 8) { int cnt = 0; for (int q = 0; q < 64; ++q) cnt += (rE[q] == F.tid) + (rE[64 + q] == F.tid);
                rE[256 + F.tid] = cnt ? (int)__hip_atomic_fetch_add(F.ctl + CW_CNT + 64 * (8 * cs + F.tid), (unsigned)cnt, RLX_AGENT) : 0; }
            __syncthreads();
            if (F.tid < 64) { const int e0 = rE[F.tid], e1 = rE[64 + F.tid]; int r0 = 0, r1 = 0;
                for (int q = 0; q < F.tid; ++q) { r0 += (rE[q] == e0) + (rE[64 + q] == e0); r1 += (rE[q] == e1) + (rE[64 + q] == e1); }
                const int p0 = rE[256 + e0] + r0, p1 = rE[256 + e1] + r1, grow = chunk * 64 + F.tid;
                gu32* ri = (gu32*)(F.ws + roff + WS_ROWIDX); gu32* gp = (gu32*)(F.ws + roff + WS_GATEP); gu32* sl = (gu32*)(F.ws + roff + WS_SLOT);
                __hip_atomic_store(ri + e0 * 16384 + p0, (unsigned)grow, RLX_AGENT); __hip_atomic_store(ri + e1 * 16384 + p1, (unsigned)grow, RLX_AGENT);
                __hip_atomic_store(gp + e0 * 16384 + p0, (unsigned)rE[128 + F.tid], RLX_AGENT); __hip_atomic_store(gp + e1 * 16384 + p1, (unsigned)rE[192 + F.tid], RLX_AGENT);
                __hip_atomic_store(sl + grow * 2, (unsigned)((e0 << 16) | p0), RLX_AGENT); __hip_atomic_store(sl + grow * 2 + 1, (unsigned)((e1 << 16) | p1), RLX_AGENT); }
            __syncthreads();
        }
    }
}

__device__ __forceinline__ void unpack8(const u32x4 w, float (&f)[8]) { f[0] = bflo(w.x); f[1] = bfhi(w.x); f[2] = bflo(w.y); f[3] = bfhi(w.y); f[4] = bflo(w.z); f[5] = bfhi(w.z); f[6] = bflo(w.w); f[7] = bfhi(w.w); }
__device__ __forceinline__ void conv_phase(Frame& F, const float* cw  ) {
    const int gw = F.vcu * NWAVES + F.wave, NGW = F.G * NWAVES;
    const bf16_t* UB = F.BUF;
    for (int task = gw; task < M / 8; task += NGW) {
        const int r0 = task * 8; const bool first = (r0 % SEQ) == 0;
#pragma unroll
        for (int j = 0; j < 2; ++j) {
            const int ch = 8 * F.lane + 512 * j;
            float w0[8], w1[8], w2[8];
#pragma unroll
            for (int e = 0; e < 8; ++e) { w0[e] = cw[ch + e]; w1[e] = cw[DM + ch + e]; w2[e] = cw[2 * DM + ch + e]; }
            float um2[8], um1[8];
            if (first) {
#pragma unroll
                for (int e = 0; e < 8; ++e) { um2[e] = 0.f; um1[e] = 0.f; }
            } else { unpack8(*(const u32x4*)(UB + (size_t)(r0 - 2) * 2048 + ch), um2); unpack8(*(const u32x4*)(UB + (size_t)(r0 - 1) * 2048 + ch), um1); }
#pragma unroll
            for (int i = 0; i < 8; ++i) {
                float u0[8], bb[8]; unpack8(*(const u32x4*)(UB + (size_t)(r0 + i) * 2048 + ch), u0); unpack8(*(const u32x4*)(UB + (size_t)(r0 + i) * 2048 + 1024 + ch), bb);
                float z[8];
#pragma unroll
                for (int e = 0; e < 8; ++e) z[e] = bb[e] * (w0[e] * um2[e] + w1[e] * um1[e] + w2[e] * u0[e]);
                u32x4 o; o.x = pk2(z[0], z[1]); o.y = pk2(z[2], z[3]); o.z = pk2(z[4], z[5]); o.w = pk2(z[6], z[7]);
                *(u32x4*)(F.HB + (size_t)(r0 + i) * DM + ch) = o;
#pragma unroll
                for (int e = 0; e < 8; ++e) { um2[e] = um1[e]; um1[e] = u0[e]; }
            }
        }
    }
}

constexpr int QIP = 1040;
constexpr int AL_QI = 0, AL_WI = 33280, AL_SEL = 34304, AL_V = 42496, AL_BIASD = 108032, AL_SUM = 116288, AL_END = 116800;
typedef short v4i16_t __attribute__((ext_vector_type(4)));
__device__ __forceinline__ unsigned okey(float f) { const unsigned u = __float_as_uint(f); return u ^ ((u >> 31) ? 0xFFFFFFFFu : 0x80000000u); }
__device__ __forceinline__ void attn_phase(Frame& F, const Args& A) {
    LAS unsigned char* L = F.lds;
    const bf16_t* Qb = (const bf16_t*)(F.ws + WS_Q); const bf16_t* Kb = (const bf16_t*)(F.ws + WS_K); const bf16_t* Vb = (const bf16_t*)(F.ws + WS_V);
    const bf16_t* QIb = (const bf16_t*)(F.ws + WS_QI); const bf16_t* KIb = (const bf16_t*)(F.ws + WS_KI); const float* WIb = (const float*)(F.ws + WS_WI);
    bf16_t* Ob = (bf16_t*)(F.ws + WS_O);
    float* SC = (float*)(F.ws + WS_SC) + (size_t)blockIdx.x * 32 * SEQ;
    const int lane = F.lane, wave = F.wave;
    { LAS float* bd = (LAS float*)(L + AL_BIASD);
      for (int i = F.tid; i < 129 * 16; i += NTHREADS) { const int d = i >> 4; int bkt; if (d < 16) bkt = d; else { const float dd = (float)d; const int lg2 = 16 + (int)(logf(dd / 16.0f) / 2.0794415416798357f * 16.0f); bkt = lg2 < 31 ? lg2 : 31; }
          bd[i] = A.in[I_RELB][bkt * 16 + (i & 15)]; }
    }
    __syncthreads();
    for (int pass = 0; pass < 2; ++pass) {
        const int un = pass == 0 ? (int)blockIdx.x : 511 - (int)blockIdx.x;
        for (int uu = un; uu >= 0 && uu < 512; uu += (pass == 0 ? F.G * 2 : -F.G * 2)) {
        if ((pass == 0 && uu >= 256) || (pass == 1 && uu < 256)) break;
        const int b = uu & 3, qb = uu >> 2, t0 = qb * 32; const size_t rb = (size_t)b * SEQ;
        for (int i = F.tid; i < 32 * 64; i += NTHREADS) { const int q = i >> 6, c = i & 63; *(LAS u32x4*)(L + AL_QI + q * QIP + c * 16) = *(const u32x4*)(QIb + (rb + t0 + q) * 512 + c * 8); }
        if (F.tid < 256) ((LAS float*)(L + AL_WI))[F.tid] = WIb[(rb + t0) * 8 + F.tid];
        __syncthreads();
        {
            for (int kt = wave; kt <= qb; kt += NWAVES) {
                int ln1 = lane; asm volatile("" : "+v"(ln1));
                const int r = ln1 & 31, hh = ln1 >> 5;
                float wi[8];
#pragma unroll
                for (int h = 0; h < 8; ++h) wi[h] = ((LAS float*)(L + AL_WI))[r * 8 + h];
                bf16x8 ka[4];
#pragma unroll
                for (int ks = 0; ks < 4; ++ks) ka[ks] = *(const bf16x8*)(KIb + (rb + kt * 32 + r) * 64 + 16 * ks + 8 * hh);
                f32x16 sc;
#pragma unroll
                for (int i = 0; i < 16; ++i) sc[i] = 0.f;
#pragma unroll
                for (int h = 0; h < 8; ++h) {
                    f32x16 d;
#pragma unroll
                    for (int i = 0; i < 16; ++i) d[i] = 0.f;
#pragma unroll
                    for (int ks = 0; ks < 4; ++ks) { const bf16x8 qf = *(const LAS bf16x8*)(L + AL_QI + r * QIP + (h * 64 + 16 * ks + 8 * hh) * 2); d = __builtin_amdgcn_mfma_f32_32x32x16_bf16(ka[ks], qf, d, 0, 0, 0); }
#pragma unroll
                    for (int i = 0; i < 16; ++i) sc[i] += wi[h] * fmaxf(d[i], 0.f);
                }
#pragma unroll
                for (int a = 0; a < 4; ++a) { f32x4 o;
#pragma unroll
                    for (int e = 0; e < 4; ++e) { const int krow = 8 * a + 4 * hh + e; o[e] = (kt == qb && krow > r) ? -INFINITY : sc[4 * a + e]; }
                    *(f32x4*)(SC + (size_t)r * SEQ + kt * 32 + 8 * a + 4 * hh) = o; }
            }
        }
        VM_WAIT(); __syncthreads();
        for (int qq = 0; qq < 4; ++qq) {
            const int c = wave + 8 * qq, t = t0 + c; const int nvalid = t + 1;
            int lane = F.lane; asm volatile("" : "+v"(lane));
            LAS int* sel = (LAS int*)(L + AL_SEL) + wave * 256;
            int count;
            if (nvalid <= TOPK) {
                count = nvalid;
#pragma unroll
                for (int j = 0; j < 4; ++j) { const int idx = 64 * j + lane; sel[idx] = idx < nvalid ? idx : 0; }
            } else {
                count = TOPK;
                const int nj = (nvalid + 63) >> 6;
                unsigned key[64];
                const float* srow = SC + (size_t)c * SEQ;
#define SEL_GROUPS(BODY) do { BODY(0) if (nj > 16) { BODY(1) if (nj > 32) { BODY(2) if (nj > 48) { BODY(3) } } } } while (0)
#define SEL_LOAD(g) { _Pragma("unroll") for (int j = 16 * (g); j < 16 * (g) + 16; ++j) { const int idx = 64 * j + lane; const float sv = __uint_as_float(__hip_atomic_load((const gu32*)(srow + idx), RLX_AGENT)); key[j] = idx <= t ? okey(sv) : 0u;     } }
#pragma unroll
                for (int j = 0; j < 64; ++j) key[j] = 0u;
                SEL_GROUPS(SEL_LOAD);
                unsigned T = 0u;
                for (int bit = 31; bit >= 0; --bit) {
                    const unsigned cand = T | (1u << bit); int cnt = 0;
#define SEL_CNT(g) { _Pragma("unroll") for (int j = 16 * (g); j < 16 * (g) + 16; ++j) cnt += __popcll(__ballot(key[j] >= cand)); }
                    SEL_GROUPS(SEL_CNT);
                    if (cnt >= TOPK) T = cand;
                    if (cnt == TOPK) break;
                }
                int base = 0;
#define SEL_GT(g) { _Pragma("unroll") for (int j = 16 * (g); j < 16 * (g) + 16; ++j) { const bool gt = key[j] > T; const unsigned long long mk = __ballot(gt); \
                    const int pos = base + (int)__builtin_amdgcn_mbcnt_hi((unsigned)(mk >> 32), __builtin_amdgcn_mbcnt_lo((unsigned)mk, 0u)); if (gt) sel[pos] = 64 * j + lane; base += __popcll(mk); } }
                SEL_GROUPS(SEL_GT);
                const int need = TOPK - base; int eb = 0;
#define SEL_EQ(g) { _Pragma("unroll") for (int j = 16 * (g); j < 16 * (g) + 16; ++j) { const bool eq = key[j] == T; const unsigned long long mk = __ballot(eq); \
                    const int rank = eb + (int)__builtin_amdgcn_mbcnt_hi((unsigned)(mk >> 32), __builtin_amdgcn_mbcnt_lo((unsigned)mk, 0u)); if (eq && rank < need) sel[base + rank] = 64 * j + lane; eb += __popcll(mk); } }
                SEL_GROUPS(SEL_EQ);
#undef SEL_GROUPS
#undef SEL_LOAD
#undef SEL_CNT
#undef SEL_GT
#undef SEL_EQ
            }
            LDS_WAIT(); CFENCE();
            asm volatile("" : "+v"(lane));
            const int hd = lane & 15, kq = lane >> 4;
            bf16x8 bq[8];
            { bf16x8 qf[2];
#pragma unroll
              for (int s2 = 0; s2 < 2; ++s2) qf[s2] = *(const bf16x8*)(Qb + (rb + t) * 1024 + hd * 64 + 32 * s2 + 8 * kq);
              const bf16x8 zf = (bf16x8){0, 0, 0, 0, 0, 0, 0, 0};
#pragma unroll
              for (int ks = 0; ks < 8; ++ks) bq[ks] = ((ks >> 1) == (hd >> 2)) ? qf[ks & 1] : zf; }
            f32x4 lg[16];
            float mx = -INFINITY;
            bf16x8 kf[3][8];
#pragma unroll
            for (int pre = 0; pre < 2; ++pre) { const int krow = sel[16 * pre + hd]; const bf16_t* kp = Kb + (rb + krow) * 256 + 8 * kq;
#pragma unroll
              for (int ks = 0; ks < 8; ++ks) kf[pre][ks] = *(const bf16x8*)(kp + 32 * ks); }
            const LAS float* biasd = (const LAS float*)(L + AL_BIASD);
#pragma unroll
            for (int kt = 0; kt < 16; ++kt) {
                if (kt < 14) { const int krow = sel[16 * (kt + 2) + hd]; const bf16_t* kp = Kb + (rb + krow) * 256 + 8 * kq;
#pragma unroll
                    for (int ks = 0; ks < 8; ++ks) kf[(kt + 2) % 3][ks] = *(const bf16x8*)(kp + 32 * ks); }
                f32x4 d = (f32x4){0.f, 0.f, 0.f, 0.f};
#pragma unroll
                for (int ks = 0; ks < 8; ++ks) d = __builtin_amdgcn_mfma_f32_16x16x32_bf16(kf[kt % 3][ks], bq[ks], d, 0, 0, 0);
                const u32x4 ks4 = *(const LAS u32x4*)(sel + 16 * kt + 4 * kq);
#pragma unroll
                for (int i = 0; i < 4; ++i) { const int pos = 16 * kt + 4 * kq + i; int dist = t - (int)ks4[i]; dist = dist < 0 ? 0 : (dist > 128 ? 128 : dist);
                    const float bs = biasd[dist * 16 + hd];
                    d[i] = pos < count ? d[i] + bs : -INFINITY; mx = fmaxf(mx, d[i]); }
                lg[kt] = d;
            }
            mx = fmaxf(mx, __shfl_xor(mx, 16)); mx = fmaxf(mx, __shfl_xor(mx, 32));
            float sum = 0.f;
            bf16x8 pa[8];
#pragma unroll
            for (int ks = 0; ks < 8; ++ks) { float p[8];
#pragma unroll
                for (int i = 0; i < 4; ++i) { p[i] = __expf(lg[2 * ks][i] - mx); p[4 + i] = __expf(lg[2 * ks + 1][i] - mx); }
                sum += ((p[0] + p[1]) + (p[2] + p[3])) + ((p[4] + p[5]) + (p[6] + p[7]));
                u32x4 w; w.x = cvt_pk_bf16(p[0], p[1]); w.y = cvt_pk_bf16(p[2], p[3]); w.z = cvt_pk_bf16(p[4], p[5]); w.w = cvt_pk_bf16(p[6], p[7]);
                pa[ks] = __builtin_bit_cast(bf16x8, w); }
            sum += __shfl_xor(sum, 16); sum += __shfl_xor(sum, 32);
            if (kq == 0) ((LAS float*)(L + AL_SUM))[wave * 16 + hd] = sum;
            LDS_WAIT(); CFENCE();
            {
                asm volatile("" : "+v"(lane));
                const int rs = lane >> 3, ch = lane & 7, i16 = lane & 15, tq = i16 >> 2, tp = i16 & 3, kq2 = lane >> 4;
                LAS unsigned char* vb = L + AL_V + wave * 8192;
                const unsigned wr_off = (unsigned)lane * 16u, tr_off = (unsigned)((4 * kq2 + tq) * 128 + 8 * tp);
                f32x4 O[4][4];
#pragma unroll
                for (int n = 0; n < 4; ++n)
#pragma unroll
                    for (int dt = 0; dt < 4; ++dt) O[n][dt] = (f32x4){0.f, 0.f, 0.f, 0.f};
                u32x4 vr[2][4]; int kr[4];
                const bf16_t* vbase = Vb + rb * 256 + 8 * ch;
#pragma unroll
                for (int i = 0; i < 4; ++i) kr[i] = sel[8 * i + rs];
#pragma unroll
                for (int pre = 0; pre < 2; ++pre)
#pragma unroll
                    for (int i = 0; i < 4; ++i) vr[pre][i] = *(const u32x4*)(vbase + (size_t)kr[i] * 256 + pre * 64);
#pragma unroll
                for (int st = 0; st < 32; ++st) {
                    const int ks = st >> 2, n = st & 3;
                    LAS unsigned char* buf = vb + (st & 1) * 4096;
#pragma unroll
                    for (int i = 0; i < 4; ++i) *(LAS u32x4*)(buf + wr_off + i * 1024) = vr[st & 1][i];
                    if (st < 30) { const int ks2 = (st + 2) >> 2, n2 = (st + 2) & 3;
                        if (n2 == 0) {
#pragma unroll
                            for (int i = 0; i < 4; ++i) kr[i] = sel[32 * ks2 + 8 * i + rs]; }
#pragma unroll
                        for (int i = 0; i < 4; ++i) vr[st & 1][i] = *(const u32x4*)(vbase + (size_t)kr[i] * 256 + n2 * 64); }
#pragma unroll
                    for (int dt = 0; dt < 4; ++dt) {
                        const v4i16_t t0 = __builtin_amdgcn_ds_read_tr16_b64_v4i16((LAS v4i16_t*)(buf + tr_off + 32 * dt));
                        const v4i16_t t1 = __builtin_amdgcn_ds_read_tr16_b64_v4i16((LAS v4i16_t*)(buf + tr_off + 2048 + 32 * dt));
                        const bf16x8 bfr = (bf16x8){t0[0], t0[1], t0[2], t0[3], t1[0], t1[1], t1[2], t1[3]};
                        O[n][dt] = __builtin_amdgcn_mfma_f32_16x16x32_bf16(pa[ks], bfr, O[n][dt], 0, 0, 0); }
                    CFENCE();
                }
                const f32x4 sm = *(const LAS f32x4*)(L + AL_SUM + (wave * 16 + 4 * kq2) * 4);
                bf16_t* op = Ob + (rb + t) * 1024 + (4 * kq2) * 64 + i16;
#pragma unroll
                for (int dt = 0; dt < 4; ++dt)
#pragma unroll
                    for (int i = 0; i < 4; ++i) { const float v = kq2 == 0 ? O[0][dt][i] : (kq2 == 1 ? O[1][dt][i] : (kq2 == 2 ? O[2][dt][i] : O[3][dt][i]));
                        op[i * 64 + 16 * dt] = (bf16_t)f2bf(v / sm[i]); }
            }
            LDS_WAIT(); CFENCE();
        }
        __syncthreads();
        }
    }
}

constexpr int SL_BMT = 0;
constexpr int SL_CMA = 4096;
constexpr int SL_AB = 12288;
constexpr int SL_E = 12800;
constexpr int SL_S = 16896;
constexpr int SPITCH = 272;
__device__ __forceinline__ void cmul(float ar, float ai, float br, float bi, float& cr, float& ci) { cr = ar * br - ai * bi; ci = ar * bi + ai * br; }
__device__ __forceinline__ void ssm_phase(Frame& F, const Args& A) {
    LAS unsigned char* L = F.lds;
    const int lane = F.lane, wave = F.wave;
    bf16_t* G = (bf16_t*)(F.ws + WS_ACT);
    for (int un = F.vcu; un < NB * 64; un += F.G) {
        const int b = un >> 6, g = un & 63; const size_t rb = (size_t)b * SEQ;
        __syncthreads();
        if (F.tid < 64) {
            const int p = F.tid;
            const float lr = fminf(A.in[I_SLRE][g * 64 + p], -1e-4f), li = A.in[I_SLIM][g * 64 + p];
            const float step = expf(A.in[I_SLOG][g]);
            const float mag = expf(lr * step); float sn, cs; sincosf(li * step, &sn, &cs);
            const float ar = mag * cs, ai = mag * sn;
            ((LAS float*)(L + SL_AB))[2 * p] = ar; ((LAS float*)(L + SL_AB))[2 * p + 1] = ai;
            const float nr = ar - 1.0f, ni = ai, den = lr * lr + li * li;
            const float cr = (nr * lr + ni * li) / den, ci = (ni * lr - nr * li) / den;
            LAS bf16_t* bm = (LAS bf16_t*)(L + SL_BMT);
#pragma unroll
            for (int c = 0; c < 16; ++c) { const float br = A.in[I_SBRE][((size_t)g * 64 + p) * 16 + c], bi = A.in[I_SBIM][((size_t)g * 64 + p) * 16 + c];
                float xr, xi; cmul(cr, ci, br, bi, xr, xi); bm[p * 16 + c] = (bf16_t)f2bf(xr); bm[(64 + p) * 16 + c] = (bf16_t)f2bf(xi); }
        }
        { LAS bf16_t* cm = (LAS bf16_t*)(L + SL_CMA);
          for (int i = F.tid; i < 32 * 128; i += NTHREADS) { const int c = i >> 7, k = i & 127; float v = 0.f;
              if (c < 16) v = (k < 64) ? A.in[I_SCRE][((size_t)g * 16 + c) * 64 + k] : -A.in[I_SCIM][((size_t)g * 16 + c) * 64 + (k - 64)];
              cm[i] = (bf16_t)f2bf(v); } }
        __syncthreads();
        const int r = lane & 31, hh = lane >> 5;
        bf16x8 bfr[4];
#pragma unroll
        for (int n = 0; n < 4; ++n) bfr[n] = *(const LAS bf16x8*)(L + SL_BMT + ((32 * n + r) * 16 + 8 * hh) * 2);
        bf16x8 cfr[8];
#pragma unroll
        for (int ks = 0; ks < 8; ++ks) cfr[ks] = *(const LAS bf16x8*)(L + SL_CMA + (r * 128 + 16 * ks + 8 * hh) * 2);
        float ar[2], ai[2], a16r[2], a16i[2], a512r[2], a512i[2];
#pragma unroll
        for (int s = 0; s < 2; ++s) { ar[s] = ((LAS float*)(L + SL_AB))[2 * (32 * s + r)]; ai[s] = ((LAS float*)(L + SL_AB))[2 * (32 * s + r) + 1];
            float pr = ar[s], pi = ai[s];
#pragma unroll
            for (int q = 0; q < 4; ++q) { float nr, ni; cmul(pr, pi, pr, pi, nr, ni); pr = nr; pi = ni; }
            a16r[s] = pr; a16i[s] = pi;
#pragma unroll
            for (int q = 0; q < 5; ++q) { float nr, ni; cmul(pr, pi, pr, pi, nr, ni); pr = nr; pi = ni; }
            a512r[s] = pr; a512i[s] = pi; }
        const int tokperm = 16 * ((r >> 2) & 1) + 4 * (r >> 3) + (r & 3);
        const float dsk0 = 0.f; (void)dsk0;
        float cin_r[2] = {0.f, 0.f}, cin_i[2] = {0.f, 0.f};
        LAS unsigned char* Sw = L + SL_S + wave * (32 * SPITCH);
        for (int pass = 0; pass < 2; ++pass) {
            if (pass == 1) {
                __syncthreads();
#pragma unroll
                for (int s = 0; s < 2; ++s) { float cr = 0.f, ci = 0.f;
                    for (int w = 0; w < wave; ++w) { float nr, ni; cmul(a512r[s], a512i[s], cr, ci, nr, ni); cr = nr + ((LAS float*)(L + SL_E))[(w * 64 + 32 * s + r) * 2]; ci = ni + ((LAS float*)(L + SL_E))[(w * 64 + 32 * s + r) * 2 + 1]; }
                    cin_r[s] = cr; cin_i[s] = ci; }
            }
            bf16x8 ufn = *(const bf16x8*)(F.HB + (rb + wave * 512 + tokperm) * DM + 16 * g + 8 * hh);
            for (int tile = 0; tile < 16; ++tile) {
                asm volatile("s_waitcnt vmcnt(0) lgkmcnt(0)" ::: "memory"); __builtin_amdgcn_s_barrier(); asm volatile("" ::: "memory");
                const int tk0 = wave * 512 + tile * 32;
                const bf16x8 uf = ufn;
                if (tile < 15) ufn = *(const bf16x8*)(F.HB + (rb + tk0 + 32 + tokperm) * DM + 16 * g + 8 * hh);

                f32x16 d[4];
#pragma unroll
                for (int n = 0; n < 4; ++n) {
#pragma unroll
                    for (int i = 0; i < 16; ++i) d[n][i] = 0.f;
                    d[n] = __builtin_amdgcn_mfma_f32_32x32x16_bf16(uf, bfr[n], d[n], 0, 0, 0); }
                asm volatile("s_nop 15\n\ts_nop 15\n\ts_nop 15" : "+v"(d[0]), "+v"(d[1]), "+v"(d[2]), "+v"(d[3]));
#pragma unroll
                for (int s = 0; s < 2; ++s) {
                    float sr = hh == 0 ? cin_r[s] : 0.f, si = hh == 0 ? cin_i[s] : 0.f;
#pragma unroll
                    for (int i = 0; i < 16; ++i) { const float nr = ar[s] * sr - ai[s] * si + d[s][i], ni = ar[s] * si + ai[s] * sr + d[2 + s][i]; sr = nr; si = ni; d[s][i] = sr; d[2 + s][i] = si; }
                    const float e0r = __shfl_xor(sr, 32), e0i = __shfl_xor(si, 32);
                    float cr = hh == 1 ? e0r : 0.f, ci = hh == 1 ? e0i : 0.f;
                    if (pass == 1) {
#pragma unroll
                        for (int i = 0; i < 16; ++i) { float nr, ni; cmul(ar[s], ai[s], cr, ci, nr, ni); cr = nr; ci = ni; d[s][i] += cr; d[2 + s][i] += ci; }
                    } else { float nr, ni; cmul(a16r[s], a16i[s], cr, ci, nr, ni); cr = nr; ci = ni; }
                    const float endr = (pass == 1) ? d[s][15] : sr + cr, endi = (pass == 1) ? d[2 + s][15] : si + ci;
                    const float xr = __shfl_xor(endr, 32), xi = __shfl_xor(endi, 32);
                    cin_r[s] = hh == 1 ? endr : xr; cin_i[s] = hh == 1 ? endi : xi;
                }
                if (pass == 1) {
#pragma unroll
                    for (int s = 0; s < 2; ++s)
#pragma unroll
                        for (int i = 0; i < 16; ++i) { *(LAS bf16_t*)(Sw + (16 * hh + i) * SPITCH + (32 * s + r) * 2) = (bf16_t)f2bf(d[s][i]); *(LAS bf16_t*)(Sw + (16 * hh + i) * SPITCH + (64 + 32 * s + r) * 2) = (bf16_t)f2bf(d[2 + s][i]); }
                    LDS_WAIT(); CFENCE();
                    f32x16 y;
#pragma unroll
                    for (int i = 0; i < 16; ++i) y[i] = 0.f;
#pragma unroll
                    for (int ks = 0; ks < 8; ++ks) { const bf16x8 sf = *(const LAS bf16x8*)(Sw + r * SPITCH + (16 * ks + 8 * hh) * 2); y = __builtin_amdgcn_mfma_f32_32x32x16_bf16(cfr[ks], sf, y, 0, 0, 0); }
                    LDS_WAIT(); CFENCE();
                    const size_t trow = rb + tk0 + r;
#pragma unroll
                    for (int q = 0; q < 2; ++q) { const int ch = 16 * g + 8 * q + 4 * hh;
                        const u32x2 hv = *(const u32x2*)(F.HB + trow * DM + ch); const f32x4 dk = *(const f32x4*)(A.in[I_SD] + ch);
                        const float y0 = gelu_tanh_f(y[4 * q + 0] + dk[0] * bflo(hv.x)), y1 = gelu_tanh_f(y[4 * q + 1] + dk[1] * bfhi(hv.x)), y2 = gelu_tanh_f(y[4 * q + 2] + dk[2] * bflo(hv.y)), y3 = gelu_tanh_f(y[4 * q + 3] + dk[3] * bfhi(hv.y));
                        u32x2 w; w.x = pk2(y0, y1); w.y = pk2(y2, y3); *(u32x2*)(G + trow * DM + ch) = w; }
                }
            }
            if (pass == 0) {
                if (hh == 1) {
#pragma unroll
                    for (int s = 0; s < 2; ++s) { ((LAS float*)(L + SL_E))[(wave * 64 + 32 * s + r) * 2] = cin_r[s]; ((LAS float*)(L + SL_E))[(wave * 64 + 32 * s + r) * 2 + 1] = cin_i[s]; } }
                cin_r[0] = cin_r[1] = cin_i[0] = cin_i[1] = 0.f;
            }
        }
    }
}

enum { PH_PRO = 0, PH_NORM0,
       L0_G1, L0_CONV, L0_G2, L0_NORM, L0_F1, L0_F2, L0_NORMN,
       L1_G1, L1_ATTN, L1_G2, L1_NORMR, L1_M1, L1_M2, L1_COMB,
       L2_SSM, L2_G2, L2_NORM, L2_F1, L2_F2, L2_NORMN,
       L3_G1, L3_CONV, L3_G2, L3_NORMR, L3_M1, L3_M2, L3_COMB, NPH };

__device__ __forceinline__ bool fresh_ids(Frame& F) { const int l = lane_id_fresh(); F.lane = l; F.tid = F.wave * 64 + l; return true; }
__global__ void __launch_bounds__(NTHREADS, 2) mega_fwd(Args args) {
    extern __shared__ __attribute__((aligned(16))) unsigned char lds_raw[];
    Frame F;
    F.lds = (LAS unsigned char*)lds_raw;
    volatile LAS unsigned* MISC = (volatile LAS unsigned*)(F.lds + MISC_OFF);
    F.tid = threadIdx.x; F.lane = F.tid & 63; F.wave = __builtin_amdgcn_readfirstlane(F.tid >> 6);
    F.G = gridDim.x; { const int bx = blockIdx.x; F.vcu = (F.G % 8 == 0) ? (bx % 8) * (F.G / 8) + bx / 8 : bx; }
    F.ws = args.ws; F.ctl = (gu32*)(args.ws + WS_CTL); F.out = args.out; F.mod = (const float*)(args.ws + WS_MOD);
    F.HB = (bf16_t*)(args.ws + WS_HB); F.BUF = (bf16_t*)(args.ws + WS_BUF); F.ACT = (bf16_t*)(args.ws + WS_ACT);
    for (int u = F.tid; u < (LDS_BYTES - LDSCTL_OFF) / 4; u += NTHREADS) ((LAS unsigned*)(F.lds + LDSCTL_OFF))[u] = 0u;
    __syncthreads();
    XcdBarrier bar; bar.bar = (unsigned*)(F.ctl + CW_BAR); bar.x = 0; bar.st = nullptr; bar.w = F.wave;
    const int lo = args.ph_lo, hi = args.ph_hi;
    if (hi - lo > 1) bar = xcd_barrier_post((unsigned*)(F.ctl + CW_BAR), MISC + 8, F.wave);
#ifndef PH_ONLY
#define PH_EN(k) true
#else
#define PH_EN(k) ((k) == PH_ONLY)
#endif
#define IN(k) (PH_EN(k) && lo <= (k) && (k) < hi && fresh_ids(F))
#define SEAM(k) do { if (IN(k) && IN((k) + 1)) xcd_barrier(bar); } while (0)
#ifndef PH_REP
#define PH_REP (-1)
#endif
#ifndef PH_REPMASK
#define PH_REPMASK 0ull
#endif
#define REPB(k, ...) do { if (PH_REP == (k) || ((PH_REPMASK >> (k)) & 1ull)) { xcd_barrier(bar); __VA_ARGS__; } } while (0)
    LAS unsigned char* ring = F.lds;
    const int cid = (int)blockIdx.x;
    bf16_t* const WCI = (bf16_t*)(F.ws + WS_WCI); bf16_t* const WCO = (bf16_t*)(F.ws + WS_WCO); bf16_t* const WAI = (bf16_t*)(F.ws + WS_WAI); bf16_t* const WAO = (bf16_t*)(F.ws + WS_WAO);
    bf16_t* const WGL = (bf16_t*)(F.ws + WS_WGL); bf16_t* const WFG = (bf16_t*)(F.ws + WS_WFG); bf16_t* const WFD = (bf16_t*)(F.ws + WS_WFD); bf16_t* const WMG = (bf16_t*)(F.ws + WS_WMG); bf16_t* const WMD = (bf16_t*)(F.ws + WS_WMD);

#define ZEROG ((const float*)(F.ws + 512 * 1024))
    const bool fuseR = (F.G == 256) && FUSE_R;
    const bool fuse = (F.G == 256) && FUSE_N;
#define FUSED_EPI(inst, gatep, xin, nl, ns, hout, asc, h8_) ({F.out, (gatep), (xin), args.in[I_NORMG] + (size_t)((nl) * 2 + (ns)) * DM, F.mod + (size_t)(nl) * NB * 6144 + ((ns) ? 3 : 0) * DM, (hout), (float*)(F.ws + WS_XS), F.ctl + CW_PAN + 64 * 64 * (inst), F.ctl + CW_TMO, (asc), (h8_)})
#define FUSED_RT(inst, gatep, nl, rl, roff, hout, h8_) ({F.out, (gatep), args.in[I_NORMG] + (size_t)((nl) * 2 + 1) * DM, F.mod + (size_t)(nl) * NB * 6144 + 3 * DM, (hout), (float*)(F.ws + WS_XS9), F.ctl + CW_PAN + 64 * 64 * (inst), F.ctl + CW_TMO, \
        args.in[I_RW] + (size_t)(rl) * DM * NEXP, args.in[I_RB] + (rl) * NEXP, F.ctl + CW_CNT + 64 * 8 * (rl), F.ws + (roff), (h8_)})
#define MODP(l, chunk) (F.mod + (size_t)(l) * NB * 6144 + (chunk) * DM)
#define GEMM_STATIC(Aptr, Bptr, Nn, Kk, EpiT, EpiInit) do { pg8::Gemm g{(Aptr), (Bptr), M, (Nn), (Kk), 0, nullptr, nullptr}; pg8::StaticOrder S; S.init(M, (Nn), F.G, cid); EpiT E EpiInit; \
        pg8::gemm_phase<EpiT, pg8::StaticOrder, false>(ring, g, S, E, F.wave); } while (0)
#define GEMM_STATIC8(Aptr, Bptr, Nn, Kk, EpiT, EpiInit) do { pg8::Gemm g{(Aptr), (Bptr), M, (Nn), (Kk), 0, nullptr, nullptr}; pg8::StaticOrder S; S.init(M, (Nn), F.G, cid); EpiT E EpiInit; \
        pg8::gemm_phase<EpiT, pg8::StaticOrder, false, true>(ring, g, S, E, F.wave); } while (0)
#define EPAIR8 pg8::EpiPair<1, (M2_FP8 != 0), (M1_FP8 != 0)>
#define M1_B (M1_FP8 ? 1 : 2)
#define EPAIR8L1 pg8::EpiPair<1, (M2_FP8 != 0), (M1L1_FP8 != 0)>
#define M2_B (M2_FP8 ? 1 : 2)
#define F2_ASC (F2_FP8 ? pg8::W8_INV : 1.0f)
#define GEMM_STATICF(Aptr, Bptr, Nn, Kk, EpiT, EpiInit) do { pg8::Gemm g{(Aptr), (Bptr), M, (Nn), (Kk), 0, nullptr, nullptr}; pg8::StaticOrder S; S.init(M, (Nn), F.G, cid); EpiT E EpiInit; \
        pg8::gemm_phase<EpiT, pg8::StaticOrder, false, (F2_FP8 != 0)>(ring, g, S, E, F.wave); } while (0)
#define EPAIRF pg8::EpiPair<1, (F2_FP8 != 0), false>
#define F0_FP8 (F2_FP8 || F2L0_FP8)
#define F2L0_ASC (F0_FP8 ? pg8::W8_INV : 1.0f)
#define EPAIR0 pg8::EpiPair<1, (F0_FP8 != 0), false>
#define EPAIR0S pg8::EpiPair<1, (F0_FP8 != 0), (F1L0_FP8 != 0)>
#define GEMM_STATICF0(Aptr, Bptr, Nn, Kk, EpiT, EpiInit) do { pg8::Gemm g{(Aptr), (Bptr), M, (Nn), (Kk), 0, nullptr, nullptr}; pg8::StaticOrder S; S.init(M, (Nn), F.G, cid); EpiT E EpiInit; \
        pg8::gemm_phase<EpiT, pg8::StaticOrder, false, (F0_FP8 != 0)>(ring, g, S, E, F.wave); } while (0)
#define W8(base, bytes) ((bf16_t*)((unsigned char*)(base) + (size_t)(bytes)))

    if (IN(PH_PRO)) { p0_prologue(F, args); REPB(PH_PRO, p0_prologue(F, args)); } SEAM(PH_PRO);
    if (IN(PH_NORM0)) { thin_phase<4>(F, args, args.in[I_X], 0, 0, 0, 0); REPB(PH_NORM0, thin_phase<4>(F, args, args.in[I_X], 0, 0, 0, 0)); } SEAM(PH_NORM0);

    if (IN(L0_G1)) { GEMM_STATIC(F.HB, WCI, 3072, DM, pg8::EpiConvIn, {F.BUF}); REPB(L0_G1, GEMM_STATIC(F.HB, WCI, 3072, DM, pg8::EpiConvIn, {F.BUF})); } SEAM(L0_G1);
    if (IN(L0_CONV)) { conv_phase(F, args.in[I_CW]); REPB(L0_CONV, conv_phase(F, args.in[I_CW])); } SEAM(L0_CONV);
    if (IN(L0_G2)) { if (fuse) GEMM_STATIC(F.HB, WCO, DM, DM, pg8::EpiResNorm, FUSED_EPI(0, MODP(0, 2), args.in[I_X], 0, 1, (fuse ? F.BUF : F.HB), 1.0f, F1L0_FP8)); else GEMM_STATIC(F.HB, WCO, DM, DM, pg8::EpiRes, ({F.out, MODP(0, 2), args.in[I_X], 1.0f})); } SEAM(L0_G2);
    if (!fuse) { if (IN(L0_NORM)) { thin_phase<4>(F, args, F.out, 0, 1, 0, 0); } SEAM(L0_NORM); }
    if (IN(L0_F1)) { pg8::Gemm g{(fuse ? F.BUF : F.HB), WFG, M, 2 * FF, DM, 0, nullptr, nullptr}; pg8::StaticOrder S; S.init(M, 2 * FF, F.G, cid); EPAIR0S E{F.ACT, FF};
        pg8::gemm_phase<EPAIR0S, pg8::StaticOrder, false, (F1L0_FP8 != 0)>(ring, g, S, E, F.wave); } SEAM(L0_F1);
    if (IN(L0_F2)) { if (fuse) GEMM_STATICF0(F.ACT, WFD, DM, FF, pg8::EpiResNorm, FUSED_EPI(1, MODP(0, 5), F.out, 1, 0, F.HB, F2L0_ASC, 0)); else GEMM_STATICF0(F.ACT, WFD, DM, FF, pg8::EpiRes, ({F.out, MODP(0, 5), F.out, F2L0_ASC})); } SEAM(L0_F2);
    if (!fuse) { if (IN(L0_NORMN)) { thin_phase<4>(F, args, F.out, 1, 0, 0, 0); } SEAM(L0_NORMN); }

    if (IN(L1_G1)) { GEMM_STATIC(F.HB, WAI, ATT_NP, DM, pg8::EpiAttnIn, ({(bf16_t*)(F.ws + WS_Q), (bf16_t*)(F.ws + WS_K), (bf16_t*)(F.ws + WS_V), (bf16_t*)(F.ws + WS_QI), (bf16_t*)(F.ws + WS_KI), (float*)(F.ws + WS_WI), args.in[I_QG], args.in[I_KG]})); REPB(L1_G1, GEMM_STATIC(F.HB, WAI, ATT_NP, DM, pg8::EpiAttnIn, ({(bf16_t*)(F.ws + WS_Q), (bf16_t*)(F.ws + WS_K), (bf16_t*)(F.ws + WS_V), (bf16_t*)(F.ws + WS_QI), (bf16_t*)(F.ws + WS_KI), (float*)(F.ws + WS_WI), args.in[I_QG], args.in[I_KG]}))); } SEAM(L1_G1);
    if (IN(L1_ATTN)) { attn_phase(F, args); REPB(L1_ATTN, attn_phase(F, args)); } SEAM(L1_ATTN);
    if (IN(L1_G2)) { if (fuseR) GEMM_STATIC((bf16_t*)(F.ws + WS_O), WAO, DM, DM, pg8::EpiResNormRouter, FUSED_RT(3, MODP(1, 2), 1, 0, 0, F.HB, M1L1_FP8)); else GEMM_STATIC((bf16_t*)(F.ws + WS_O), WAO, DM, DM, pg8::EpiRes, ({F.out, MODP(1, 2), F.out, 1.0f})); } SEAM(L1_G2);
    if (!fuseR) { if (IN(L1_NORMR)) { thin_phase<4 | 8>(F, args, F.out, 1, 1, 0, 0); } SEAM(L1_NORMR); }
    if (IN(L1_M1)) { pg8::Gemm g{F.HB, WMG, M, 2 * FF, DM, (size_t)2 * FF * DM * (M1L1_FP8 ? 1 : 2), (const int*)(F.ws + WS_ROWIDX), (const unsigned*)(F.ctl + CW_CNT)}; pg8::MoeOrder S; S.init((const unsigned*)(F.ctl + CW_CNT), 22, F.G, cid);
        EPAIR8L1 E{F.ACT, FF}; pg8::gemm_phase<EPAIR8L1, pg8::MoeOrder, true, (M1L1_FP8 != 0)>(ring, g, S, E, F.wave); REPB(L1_M1, pg8::gemm_phase<EPAIR8L1, pg8::MoeOrder, true, (M1L1_FP8 != 0)>(ring, g, S, E, F.wave)); } SEAM(L1_M1);
    if (IN(L1_M2)) { pg8::Gemm g{F.ACT, WMD, M, DM, FF, (size_t)DM * FF * M2_B, nullptr, nullptr}; pg8::MoeOrder S; S.init((const unsigned*)(F.ctl + CW_CNT), 4, F.G, cid);
        pg8::EpiMoeDn E{F.BUF, (const float*)(F.ws + WS_GATEP)}; pg8::gemm_phase<pg8::EpiMoeDn, pg8::MoeOrder, false, (M2_FP8 != 0)>(ring, g, S, E, F.wave); REPB(L1_M2, pg8::gemm_phase<pg8::EpiMoeDn, pg8::MoeOrder, false, (M2_FP8 != 0)>(ring, g, S, E, F.wave)); } SEAM(L1_M2);
    if (IN(L1_COMB)) { thin_phase<2 | 4>(F, args, F.out, 2, 0, 1, 0); REPB(L1_COMB, thin_phase<2 | 4>(F, args, F.out, 2, 0, -1, 0)); } SEAM(L1_COMB);

    if (IN(L2_SSM)) { ssm_phase(F, args); REPB(L2_SSM, ssm_phase(F, args)); } SEAM(L2_SSM);
    if (IN(L2_G2)) { GEMM_STATIC(F.ACT, WGL, 2048, DM, pg8::EpiGluRes, ({F.out, MODP(2, 2)})); REPB(L2_G2, GEMM_STATIC(F.ACT, WGL, 2048, DM, pg8::EpiGluRes, ({F.out, ZEROG}))); } SEAM(L2_G2);
    if (IN(L2_NORM)) { thin_phase<4>(F, args, F.out, 2, 1, 0, 0); REPB(L2_NORM, thin_phase<4>(F, args, F.out, 2, 1, 0, 0)); } SEAM(L2_NORM);
    if (IN(L2_F1)) { GEMM_STATIC(F.HB, WFG + (size_t)2 * FF * DM, 2 * FF, DM, EPAIRF, ({F.ACT, FF})); REPB(L2_F1, GEMM_STATIC(F.HB, WFG + (size_t)2 * FF * DM, 2 * FF, DM, EPAIRF, ({F.ACT, FF}))); } SEAM(L2_F1);
    if (IN(L2_F2)) { if (fuse) GEMM_STATICF(F.ACT, W8(WFD, (size_t)DM * FF * (F2_FP8 ? 1 : 2)), DM, FF, pg8::EpiResNorm, FUSED_EPI(2, MODP(2, 5), F.out, 3, 0, F.HB, F2_ASC, 0)); else GEMM_STATICF(F.ACT, W8(WFD, (size_t)DM * FF * (F2_FP8 ? 1 : 2)), DM, FF, pg8::EpiRes, ({F.out, MODP(2, 5), F.out, F2_ASC})); } SEAM(L2_F2);
    if (!fuse) { if (IN(L2_NORMN)) { thin_phase<4>(F, args, F.out, 3, 0, 0, 0); } SEAM(L2_NORMN); }

    if (IN(L3_G1)) { GEMM_STATIC(F.HB, WCI + (size_t)3072 * DM, 3072, DM, pg8::EpiConvIn, {F.BUF}); REPB(L3_G1, GEMM_STATIC(F.HB, WCI + (size_t)3072 * DM, 3072, DM, pg8::EpiConvIn, {F.BUF})); } SEAM(L3_G1);
    if (IN(L3_CONV)) { conv_phase(F, args.in[I_CW] + 3 * DM); REPB(L3_CONV, conv_phase(F, args.in[I_CW] + 3 * DM)); } SEAM(L3_CONV);
    if (IN(L3_G2)) { if (fuseR) GEMM_STATIC(F.HB, WCO + (size_t)DM * DM, DM, DM, pg8::EpiResNormRouter, FUSED_RT(4, MODP(3, 2), 3, 1, 2 * MiB, F.BUF, M1_FP8)); else GEMM_STATIC(F.HB, WCO + (size_t)DM * DM, DM, DM, pg8::EpiRes, ({F.out, MODP(3, 2), F.out, 1.0f})); } SEAM(L3_G2);
    if (!fuseR) { if (IN(L3_NORMR)) { thin_phase<4 | 8>(F, args, F.out, 3, 1, 0, 1, 1, 2 * MiB); } SEAM(L3_NORMR); }
    if (IN(L3_M1)) { pg8::Gemm g{(fuseR ? F.BUF : F.HB), W8(WMG, (size_t)8 * 2 * FF * DM * 2), M, 2 * FF, DM, (size_t)2 * FF * DM * M1_B, (const int*)(F.ws + 2 * MiB + WS_ROWIDX), (const unsigned*)(F.ctl + CW_CNT + 512)}; pg8::MoeOrder S; S.init((const unsigned*)(F.ctl + CW_CNT + 512), 22, F.G, cid);
        EPAIR8 E{F.ACT, FF}; pg8::gemm_phase<EPAIR8, pg8::MoeOrder, true, (M1_FP8 != 0)>(ring, g, S, E, F.wave); REPB(L3_M1, pg8::gemm_phase<EPAIR8, pg8::MoeOrder, true, (M1_FP8 != 0)>(ring, g, S, E, F.wave)); } SEAM(L3_M1);
    if (IN(L3_M2)) { pg8::Gemm g{F.ACT, W8(WMD, (size_t)8 * DM * FF * M2_B), M, DM, FF, (size_t)DM * FF * M2_B, nullptr, nullptr}; pg8::MoeOrder S; S.init((const unsigned*)(F.ctl + CW_CNT + 512), 4, F.G, cid);
        pg8::EpiMoeDn E{F.BUF, (const float*)(F.ws + 2 * MiB + WS_GATEP)}; pg8::gemm_phase<pg8::EpiMoeDn, pg8::MoeOrder, false, (M2_FP8 != 0)>(ring, g, S, E, F.wave); REPB(L3_M2, pg8::gemm_phase<pg8::EpiMoeDn, pg8::MoeOrder, false, (M2_FP8 != 0)>(ring, g, S, E, F.wave)); } SEAM(L3_M2);
    if (IN(L3_COMB)) { thin_phase<2>(F, args, F.out, 0, 0, 3, 1, 1, 2 * MiB); }
#undef IN
#undef SEAM
}

extern "C" void kernel_launch(void* const* d_in, const int* in_sizes, int n_in, void* d_out, int out_size, void* d_ws, size_t ws_size, hipStream_t stream) {
    static int grid = 0;
    if (grid == 0) {
        if (n_in != 28 || in_sizes[0] != M * DM || out_size != M * DM || ws_size < WS_END) { fprintf(stderr, "kernel_launch: unexpected shapes / workspace (n_in %d, ws %zu, need %zu)\n", n_in, ws_size, (size_t)WS_END); grid = -1; return; }
        int dev = 0, cus = 0, per_cu = 0;
        if (hipGetDevice(&dev) != hipSuccess || hipDeviceGetAttribute(&cus, hipDeviceAttributeMultiprocessorCount, dev) != hipSuccess) { grid = -1; return; }
        if (hipFuncSetAttribute((const void*)mega_fwd, hipFuncAttributeMaxDynamicSharedMemorySize, LDS_BYTES) != hipSuccess) { fprintf(stderr, "kernel_launch: hipFuncSetAttribute failed\n"); grid = -1; return; }
        if (hipOccupancyMaxActiveBlocksPerMultiprocessor(&per_cu, (const void*)mega_fwd, NTHREADS, LDS_BYTES) != hipSuccess || per_cu < 1) fprintf(stderr, "kernel_launch: occupancy query reports %d\n", per_cu);
        (void)hipGetLastError();
        grid = cus;
    }
    if (grid < 0) return;
    (void)hipMemsetAsync((char*)d_ws + WS_CTL, 0, CTL_ZERO_BYTES, stream);
    Args a{};
    for (int i = 0; i < 28; ++i) a.in[i] = (const float*)d_in[i];
    a.out = (float*)d_out; a.ws = (unsigned char*)d_ws;
#if MK_PER_PHASE
    for (int p = 0; p < NPH; ++p) { a.ph_lo = p; a.ph_hi = p + 1; hipLaunchKernelGGL(mega_fwd, dim3(grid), dim3(NTHREADS), LDS_BYTES, stream, a); }
#else
    a.ph_lo = 0; a.ph_hi = NPH; hipLaunchKernelGGL(mega_fwd, dim3(grid), dim3(NTHREADS), LDS_BYTES, stream, a);
#endif
}
```
